# Optimizing an MI355X kernel written in HIP

```python
import math
import jax, jax.numpy as jnp
from jax import lax
import numpy as np

D_MODEL = 1024
BATCH = 8
SEQ = 4096
DEPTH = 2

GDN_HEADS = 4
GDN_DK = 128
GDN_DV = 128
GDN_CONV = 4
GDN_CHUNK = 64
RWKV_HEADS = 8
RWKV_N = 64
RWKV_DECAY_LORA = 64
RWKV_AAA_LORA = 64
RWKV_GATE_LORA = 128
RWKV_LN_EPS = 64e-5
NSA_HEADS = 16
NSA_GROUPS = 2
NSA_HD = 64
CMP_LEN = 32
CMP_STRIDE = 16
CMP_HIDDEN = 256
SEL_BLOCK = 64
SEL_TOPN = 16
WINDOW = 512
NSA_QBLOCK = 64
ROPE_THETA = 500000.0
ROPE_DIM = NSA_HD // 4
D_FF = 4 * D_MODEL
NORM_EPS = 1e-6

GDN_QK_W = GDN_HEADS * GDN_DK
GDN_V_W = GDN_HEADS * GDN_DV
GDN_CONV_W = 2 * GDN_QK_W + GDN_V_W
GDN_W = GDN_CONV_W + GDN_V_W + 2 * GDN_HEADS
RWKV_W = RWKV_HEADS * RWKV_N
RWKV_IN_W = 3 * RWKV_W + RWKV_DECAY_LORA + RWKV_AAA_LORA + RWKV_GATE_LORA
AB_IN_W = GDN_W + RWKV_IN_W
AB_OUT_W = GDN_V_W + RWKV_W
NSA_KV_W = NSA_GROUPS * NSA_HD
NSA_IN_W = NSA_HEADS * NSA_HD + 6 * NSA_KV_W + 3 * NSA_HEADS
NSA_OUT_W = NSA_HEADS * NSA_HD
N_EVEN = (DEPTH + 1) // 2
N_ODD = DEPTH // 2

kernel_name = 'hybrid_gdn_rwkv7_nsa_trunk'


def rmsnorm(x, w):
    x32 = x.astype(jnp.float32)
    y = x32 * lax.rsqrt(jnp.mean(x32 * x32, axis=-1, keepdims=True) + NORM_EPS)
    return (y * w.astype(jnp.float32)).astype(x.dtype)


def l2norm(x):
    return x * lax.rsqrt(jnp.sum(x * x, axis=-1, keepdims=True) + 1e-6)


def partial_rotary(x, pos):
    half = ROPE_DIM // 2
    inv_freq = ROPE_THETA ** (-jnp.arange(half, dtype=jnp.float32) * (2.0 / ROPE_DIM))
    ang = pos.astype(jnp.float32)[:, None, :, None] * inv_freq
    cos = jnp.cos(ang).astype(x.dtype)
    sin = jnp.sin(ang).astype(x.dtype)
    x1, x2, rest = x[..., :half], x[..., half:ROPE_DIM], x[..., ROPE_DIM:]
    return jnp.concatenate([x1 * cos - x2 * sin, x2 * cos + x1 * sin, rest], axis=-1)


def masked_softmax(s, mask):
    s = jnp.where(mask, s.astype(jnp.float32), -jnp.inf)
    m = jnp.max(s, axis=-1, keepdims=True)
    m = jnp.where(jnp.isfinite(m), m, 0.0)
    e = jnp.where(mask, jnp.exp(s - m), 0.0)
    return e / jnp.maximum(jnp.sum(e, axis=-1, keepdims=True), 1e-30)


def causal_dwconv(x, w):
    return lax.conv_general_dilated(
        x, w[:, None, :].astype(x.dtype), window_strides=(1,),
        padding=[(w.shape[0] - 1, 0)], dimension_numbers=('NWC', 'WIO', 'NWC'),
        feature_group_count=x.shape[-1])


def gated_delta_chunked(q, k, v, beta, g):
    B_, H_, T_, dk = q.shape
    dv = v.shape[-1]
    C = GDN_CHUNK
    NC = T_ // C
    q = q.reshape(B_, H_, NC, C, dk)
    k = k.reshape(B_, H_, NC, C, dk)
    v = v.reshape(B_, H_, NC, C, dv)
    beta = beta.reshape(B_, H_, NC, C)
    gc = jnp.cumsum(g.reshape(B_, H_, NC, C), axis=-1)
    tril = jnp.tril(jnp.ones((C, C), bool))
    strict = jnp.tril(jnp.ones((C, C), bool), -1)
    decay = jnp.exp(jnp.where(tril, gc[..., :, None] - gc[..., None, :], -jnp.inf))
    a_mat = jnp.where(strict, beta[..., :, None] * jnp.einsum('bhncd,bhned->bhnce', k, k) * decay, 0.0)
    rhs = jnp.concatenate([v * beta[..., None], k * (beta * jnp.exp(gc))[..., None]], axis=-1)
    sol = lax.linalg.triangular_solve(a_mat + jnp.eye(C, dtype=a_mat.dtype), rhs,
                                      left_side=True, lower=True, unit_diagonal=True)
    u, w = sol[..., :dv], sol[..., dv:]
    intra = jnp.where(tril, jnp.einsum('bhncd,bhned->bhnce', q, k) * decay, 0.0)
    q_g = q * jnp.exp(gc)[..., None]
    k_g = k * jnp.exp(gc[..., -1:] - gc)[..., None]
    g_last = jnp.exp(gc[..., -1])

    def step(S, inp):
        u_n, w_n, q_n, k_n, a_n, gl = inp
        v_new = u_n - jnp.einsum('bhcd,bhdv->bhcv', w_n, S)
        o = jnp.einsum('bhcd,bhdv->bhcv', q_n, S) + jnp.einsum('bhce,bhev->bhcv', a_n, v_new)
        S = S * gl[..., None, None] + jnp.einsum('bhcd,bhcv->bhdv', k_n, v_new)
        return S, o

    xs = tuple(jnp.moveaxis(t, 2, 0) for t in (u, w, q_g, k_g, intra, g_last))
    S0 = jnp.zeros((B_, H_, dk, dv), jnp.float32)
    _, o = lax.scan(step, S0, xs)
    return jnp.moveaxis(o, 0, 2).reshape(B_, H_, T_, dv)


def gdn_mixer(f, conv_w, a_log, dt_bias, norm_w):
    B_, T_, _ = f.shape
    qkv = jax.nn.silu(causal_dwconv(f[..., :GDN_CONV_W], conv_w))
    q = qkv[..., :GDN_QK_W]
    k = qkv[..., GDN_QK_W:2 * GDN_QK_W]
    v = qkv[..., 2 * GDN_QK_W:]
    z = f[..., GDN_CONV_W:GDN_CONV_W + GDN_V_W]
    b = f[..., GDN_CONV_W + GDN_V_W:GDN_CONV_W + GDN_V_W + GDN_HEADS]
    a = f[..., GDN_CONV_W + GDN_V_W + GDN_HEADS:]

    def heads(t, d):
        return t.reshape(B_, T_, GDN_HEADS, d).transpose(0, 2, 1, 3)

    q = l2norm(heads(q, GDN_DK)) * GDN_DK ** -0.5
    k = l2norm(heads(k, GDN_DK))
    v = heads(v, GDN_DV)
    beta = jax.nn.sigmoid(b).transpose(0, 2, 1)
    g = (-jnp.exp(a_log) * jax.nn.softplus(a + dt_bias)).transpose(0, 2, 1)
    o = gated_delta_chunked(q, k, v, beta, g).transpose(0, 2, 1, 3)
    o = rmsnorm(o, norm_w) * jax.nn.silu(z.reshape(B_, T_, GDN_HEADS, GDN_DV))
    return o.reshape(B_, T_, GDN_V_W)


def rwkv7_mixer(f, mu, w0, w2, a0, a2, g2, k_k, k_a, r_k, ln_w, ln_b):
    B_, T_, _ = f.shape
    f_prev = jnp.concatenate([jnp.zeros_like(f[:, :1]), f[:, :-1]], axis=1)
    f = f + (f_prev - f) * mu
    W = RWKV_W
    r, k, v = f[..., :W], f[..., W:2 * W], f[..., 2 * W:3 * W]
    o0 = 3 * W
    wd = f[..., o0:o0 + RWKV_DECAY_LORA]
    ad = f[..., o0 + RWKV_DECAY_LORA:o0 + RWKV_DECAY_LORA + RWKV_AAA_LORA]
    gd = f[..., o0 + RWKV_DECAY_LORA + RWKV_AAA_LORA:]
    w_log = -jax.nn.softplus(-(w0 + jnp.tanh(wd) @ w2)) - 0.5
    decay = jnp.exp(-jnp.exp(w_log))
    a = jax.nn.sigmoid(a0 + ad @ a2)
    g = jax.nn.sigmoid(gd) @ g2

    def heads(t):
        return t.reshape(B_, T_, RWKV_HEADS, RWKV_N)

    kk = l2norm(heads(k * k_k))
    k = k * (1.0 + (a - 1.0) * k_a)
    r_h, k_h, v_h, w_h, a_h = heads(r), heads(k), heads(v), heads(decay), heads(a)

    def step(S, inp):
        r_t, w_t, k_t, v_t, kk_t, a_t = inp
        sa = jnp.einsum('bhvk,bhk->bhv', S, -kk_t)
        S = (S * w_t[:, :, None, :] + sa[..., None] * (kk_t * a_t)[:, :, None, :]
             + v_t[..., None] * k_t[:, :, None, :])
        return S, jnp.einsum('bhvk,bhk->bhv', S, r_t)

    xs = tuple(jnp.moveaxis(t, 1, 0) for t in (r_h, w_h, k_h, v_h, kk, a_h))
    S0 = jnp.zeros((B_, RWKV_HEADS, RWKV_N, RWKV_N), jnp.float32)
    _, y = lax.scan(step, S0, xs)
    y = jnp.moveaxis(y, 0, 1)
    mean = jnp.mean(y, axis=-1, keepdims=True)
    var = jnp.mean(jnp.square(y - mean), axis=-1, keepdims=True)
    y = ((y - mean) * lax.rsqrt(var + RWKV_LN_EPS)).reshape(B_, T_, W) * ln_w + ln_b
    bonus = jnp.sum(r_h * k_h * r_k, axis=-1, keepdims=True) * v_h
    return (y + bonus.reshape(B_, T_, W)) * g


def compress_blocks(t, pe, w1, w2):
    B_, G_, T_, d = t.shape
    c = t.reshape(B_, G_, T_ // CMP_STRIDE, CMP_STRIDE, d)
    blocks = jnp.concatenate([c[:, :, :-1], c[:, :, 1:]], axis=3) + pe
    h = jax.nn.silu(blocks.reshape(B_, G_, -1, CMP_LEN * d) @ w1)
    return h @ w2


def nsa_mixer(f, pos, pe_k, w1_k, w2_k, pe_v, w1_v, w2_v):
    B_, T_, _ = f.shape
    H, G, D = NSA_HEADS, NSA_GROUPS, NSA_HD
    HPG = H // G
    QW, KV = H * D, G * D
    q = f[..., :QW].reshape(B_, T_, H, D).transpose(0, 2, 1, 3)
    k_c, v_c, k_s, v_s, k_w, v_w = [
        f[..., QW + i * KV:QW + (i + 1) * KV].reshape(B_, T_, G, D).transpose(0, 2, 1, 3)
        for i in range(6)]
    gates = jax.nn.sigmoid(f[..., QW + 6 * KV:]).reshape(B_, T_, H, 3).transpose(0, 2, 1, 3)
    q = partial_rotary(q, pos) * D ** -0.5
    k_s = partial_rotary(k_s, pos)
    k_w = partial_rotary(k_w, pos)
    n_cmp = T_ // CMP_STRIDE - 1
    kc = partial_rotary(compress_blocks(k_c, pe_k, w1_k, w2_k), pos[:, CMP_LEN - 1::CMP_STRIDE])
    vc = compress_blocks(v_c, pe_v, w1_v, w2_v)
    n_sel = T_ // SEL_BLOCK
    n_top = min(SEL_TOPN, n_sel)
    ks_blk = k_s.reshape(B_, G, n_sel, SEL_BLOCK, D)
    vs_blk = v_s.reshape(B_, G, n_sel, SEL_BLOCK, D)
    pad = ((0, 0), (0, 0), (WINDOW, 0), (0, 0))
    kw_pad = jnp.pad(k_w, pad)
    vw_pad = jnp.pad(v_w, pad)
    c_start = jnp.arange(n_cmp) * CMP_STRIDE
    s_start = jnp.arange(n_sel) * SEL_BLOCK
    overlap = jnp.clip(jnp.minimum(c_start[:, None] + CMP_LEN, s_start[None, :] + SEL_BLOCK)
                       - jnp.maximum(c_start[:, None], s_start[None, :]), 0, None).astype(jnp.float32) / CMP_LEN
    cmp_end = c_start + CMP_LEN - 1
    sel_id = jnp.arange(n_sel)
    bi = jnp.arange(B_)[:, None, None, None]
    gi = jnp.arange(G)[None, :, None, None]

    def q_block(i):
        s = i * NSA_QBLOCK
        t = s + jnp.arange(NSA_QBLOCK)
        qb = lax.dynamic_slice_in_dim(q, s, NSA_QBLOCK, axis=2).reshape(B_, G, HPG, NSA_QBLOCK, D)
        sc = jnp.einsum('bghqd,bgnd->bghqn', qb, kc, preferred_element_type=jnp.float32)
        p_c = masked_softmax(sc, cmp_end[None, :] <= t[:, None])
        o_c = jnp.einsum('bghqn,bgnd->bghqd', p_c, vc)
        imp = jnp.einsum('bghqn,nj->bgqj', p_c, overlap)
        cur = t[:, None] // SEL_BLOCK
        valid = sel_id[None, :] <= cur
        forced = (sel_id[None, :] == 0) | (sel_id[None, :] == cur) | (sel_id[None, :] == cur - 1)
        score = jnp.where(valid, jnp.where(forced, jnp.inf, imp), -jnp.inf)
        _, idx = lax.top_k(score, n_top)
        ksel = ks_blk[bi, gi, idx].reshape(B_, G, NSA_QBLOCK, n_top * SEL_BLOCK, D)
        vsel = vs_blk[bi, gi, idx].reshape(B_, G, NSA_QBLOCK, n_top * SEL_BLOCK, D)
        kpos = (idx[..., None] * SEL_BLOCK + jnp.arange(SEL_BLOCK)).reshape(B_, G, NSA_QBLOCK, -1)
        ss = jnp.einsum('bghqd,bgqkd->bghqk', qb, ksel, preferred_element_type=jnp.float32)
        p_s = masked_softmax(ss, (kpos <= t[:, None])[:, :, None])
        o_s = jnp.einsum('bghqk,bgqkd->bghqd', p_s, vsel)
        kwb = lax.dynamic_slice_in_dim(kw_pad, s, WINDOW + NSA_QBLOCK, axis=2)
        vwb = lax.dynamic_slice_in_dim(vw_pad, s, WINDOW + NSA_QBLOCK, axis=2)
        kp = s - WINDOW + jnp.arange(WINDOW + NSA_QBLOCK)
        wmask = (kp[None, :] >= 0) & (kp[None, :] <= t[:, None]) & (kp[None, :] > t[:, None] - WINDOW)
        sw = jnp.einsum('bghqd,bgkd->bghqk', qb, kwb, preferred_element_type=jnp.float32)
        p_w = masked_softmax(sw, wmask)
        o_w = jnp.einsum('bghqk,bgkd->bghqd', p_w, vwb)
        gb = lax.dynamic_slice_in_dim(gates, s, NSA_QBLOCK, axis=2).reshape(B_, G, HPG, NSA_QBLOCK, 3)
        o = gb[..., 0:1] * o_c + gb[..., 1:2] * o_s + gb[..., 2:3] * o_w
        return o.reshape(B_, H, NSA_QBLOCK, D)

    o = lax.map(q_block, jnp.arange(T_ // NSA_QBLOCK))
    return o.transpose(1, 0, 3, 2, 4).reshape(B_, T_, H * D)


def setup_inputs(seed: int = 0) -> dict:
    key = jax.random.key(seed)
    keys = iter(jax.random.split(key, 40))

    def nrm(shape, scale):
        return jax.random.normal(next(keys), shape, jnp.float32) * scale

    def gain(shape):
        return 1.0 + 0.05 * jax.random.normal(next(keys), shape, jnp.float32)

    def unif(shape, lo, hi):
        return jax.random.uniform(next(keys), shape, jnp.float32, lo, hi)

    E, O = N_EVEN, N_ODD
    x = nrm((BATCH, SEQ, D_MODEL), 1.0)
    positions = (jax.random.randint(next(keys), (BATCH, 1), 0, 1024, dtype=jnp.int32)
                 + jnp.arange(SEQ, dtype=jnp.int32)[None, :])
    dt = jnp.exp(unif((E, GDN_HEADS), math.log(1e-3), math.log(1e-1)))
    return {
        'x': x,
        'positions': positions,
        'norm_mix_pre': gain((DEPTH, D_MODEL)),
        'norm_mix_post': gain((DEPTH, D_MODEL)),
        'norm_ffn_pre': gain((DEPTH, D_MODEL)),
        'norm_ffn_post': gain((DEPTH, D_MODEL)),
        'w_ffn_up': nrm((DEPTH, D_MODEL, D_FF), D_MODEL ** -0.5),
        'w_ffn_down': nrm((DEPTH, D_FF, D_MODEL), D_FF ** -0.5),
        'ab_w_in': nrm((E, D_MODEL, AB_IN_W), D_MODEL ** -0.5),
        'ab_w_out': nrm((E, AB_OUT_W, D_MODEL), AB_OUT_W ** -0.5),
        'gdn_conv': nrm((E, GDN_CONV, GDN_CONV_W), GDN_CONV ** -0.5),
        'gdn_a_log': jnp.log(unif((E, GDN_HEADS), 1.0, 16.0)),
        'gdn_dt_bias': dt + jnp.log(-jnp.expm1(-dt)),
        'gdn_norm': gain((E, GDN_DV)),
        'rwkv_mu': unif((E, RWKV_IN_W), 0.0, 1.0),
        'rwkv_w0': unif((E, RWKV_W), -6.0, -1.0),
        'rwkv_w2': nrm((E, RWKV_DECAY_LORA, RWKV_W), 0.5 * RWKV_DECAY_LORA ** -0.5),
        'rwkv_a0': nrm((E, RWKV_W), 0.1),
        'rwkv_a2': nrm((E, RWKV_AAA_LORA, RWKV_W), 0.5 * RWKV_AAA_LORA ** -0.5),
        'rwkv_g2': nrm((E, RWKV_GATE_LORA, RWKV_W), RWKV_GATE_LORA ** -0.5),
        'rwkv_k_k': 0.85 + nrm((E, RWKV_W), 0.05),
        'rwkv_k_a': gain((E, RWKV_W)),
        'rwkv_r_k': nrm((E, RWKV_HEADS, RWKV_N), 0.1),
        'rwkv_ln_w': gain((E, RWKV_W)),
        'rwkv_ln_b': nrm((E, RWKV_W), 0.01),
        'nsa_w_in': nrm((O, D_MODEL, NSA_IN_W), D_MODEL ** -0.5),
        'nsa_w_out': nrm((O, NSA_OUT_W, D_MODEL), NSA_OUT_W ** -0.5),
        'nsa_pe_k': nrm((O, CMP_LEN, NSA_HD), 0.1),
        'nsa_w1_k': nrm((O, CMP_LEN * NSA_HD, CMP_HIDDEN), (CMP_LEN * NSA_HD) ** -0.5),
        'nsa_w2_k': nrm((O, CMP_HIDDEN, NSA_HD), CMP_HIDDEN ** -0.5),
        'nsa_pe_v': nrm((O, CMP_LEN, NSA_HD), 0.1),
        'nsa_w1_v': nrm((O, CMP_LEN * NSA_HD, CMP_HIDDEN), (CMP_LEN * NSA_HD) ** -0.5),
        'nsa_w2_v': nrm((O, CMP_HIDDEN, NSA_HD), CMP_HIDDEN ** -0.5),
    }


def reference(x, positions, norm_mix_pre, norm_mix_post, norm_ffn_pre, norm_ffn_post,
              w_ffn_up, w_ffn_down, ab_w_in, ab_w_out, gdn_conv, gdn_a_log, gdn_dt_bias,
              gdn_norm, rwkv_mu, rwkv_w0, rwkv_w2, rwkv_a0, rwkv_a2, rwkv_g2, rwkv_k_k,
              rwkv_k_a, rwkv_r_k, rwkv_ln_w, rwkv_ln_b, nsa_w_in, nsa_w_out, nsa_pe_k,
              nsa_w1_k, nsa_w2_k, nsa_pe_v, nsa_w1_v, nsa_w2_v):
    h = x
    for layer in range(DEPTH):
        u = rmsnorm(h, norm_mix_pre[layer])
        j = layer // 2
        if layer % 2 == 0:
            f = (u @ ab_w_in[j]).astype(jnp.float32)
            o_a = gdn_mixer(f[..., :GDN_W], gdn_conv[j], gdn_a_log[j], gdn_dt_bias[j], gdn_norm[j])
            o_b = rwkv7_mixer(f[..., GDN_W:], rwkv_mu[j], rwkv_w0[j], rwkv_w2[j], rwkv_a0[j],
                              rwkv_a2[j], rwkv_g2[j], rwkv_k_k[j], rwkv_k_a[j], rwkv_r_k[j],
                              rwkv_ln_w[j], rwkv_ln_b[j])
            mix = jnp.concatenate([o_a, o_b], axis=-1).astype(h.dtype) @ ab_w_out[j]
        else:
            f = u @ nsa_w_in[j]
            o_c = nsa_mixer(f, positions, nsa_pe_k[j], nsa_w1_k[j], nsa_w2_k[j],
                            nsa_pe_v[j], nsa_w1_v[j], nsa_w2_v[j])
            mix = o_c.astype(h.dtype) @ nsa_w_out[j]
        h = h + rmsnorm(mix, norm_mix_post[layer])
        u = rmsnorm(h, norm_ffn_pre[layer])
        ff = jnp.square(jax.nn.relu(u @ w_ffn_up[layer])) @ w_ffn_down[layer]
        h = h + rmsnorm(ff, norm_ffn_post[layer])
    return h
```

```cpp
#include <hip/hip_runtime.h>
#include <hip/hip_cooperative_groups.h>
#include <cstdio>
#include <cstdint>
namespace cg = cooperative_groups;

constexpr int D_MODEL = 1024, BATCH = 8, SEQ = 4096, MTOK = BATCH * SEQ;
constexpr int GDN_HEADS = 4, GDN_DK = 128, GDN_DV = 128, GDN_CHUNK = 64;
constexpr int RWKV_HEADS = 8, RWKV_N = 64;
constexpr int NSA_HEADS = 16, NSA_GROUPS = 2, NSA_HD = 64, CMP_LEN = 32, CMP_STRIDE = 16, CMP_HIDDEN = 256;
constexpr int SEL_BLOCK = 64, SEL_TOPN = 16, WINDOW = 512;
constexpr int D_FF = 4096;
constexpr float NORM_EPS = 1e-6f, RWKV_LN_EPS = 64e-5f;
constexpr int AB_IN_W = 3848, NSA_IN_W = 1840;
constexpr int F0_LD = 4096;
constexpr int F1_LD = 2048;
constexpr int F0_RWKV = 2048, F0_BA = 3840;

typedef unsigned short bf16_t;
typedef short bf16x8 __attribute__((ext_vector_type(8)));
typedef float f32x4 __attribute__((ext_vector_type(4)));
typedef float f32x2 __attribute__((ext_vector_type(2)));
typedef unsigned u32x4 __attribute__((ext_vector_type(4)));
typedef unsigned u32x2 __attribute__((ext_vector_type(2)));
#define LAS __attribute__((address_space(3)))

typedef __bf16 hwbf16x2 __attribute__((ext_vector_type(2)));
__device__ __forceinline__ unsigned pk2(float lo, float hi) { const f32x2 v = {lo, hi}; const hwbf16x2 b = __builtin_convertvector(v, hwbf16x2); return __builtin_bit_cast(unsigned, b); }
__device__ __forceinline__ unsigned f2bf(float f) { return pk2(f, 0.f) & 0xffffu; }
__device__ __forceinline__ float bf2f(bf16_t h) { return __builtin_bit_cast(float, (unsigned)h << 16); }
__device__ __forceinline__ float bflo(unsigned u) { return __builtin_bit_cast(float, u << 16); }
__device__ __forceinline__ float bfhi(unsigned u) { return __builtin_bit_cast(float, u & 0xffff0000u); }
__device__ __forceinline__ float wave_sum(float v) {
#pragma unroll
    for (int o = 1; o < 64; o <<= 1) v += __shfl_xor(v, o);
    return v;
}
__device__ __forceinline__ float sigmoidf_(float x) { return 1.f / (1.f + __expf(-x)); }
__device__ __forceinline__ float siluf_(float x) { return x / (1.f + __expf(-x)); }
__device__ __forceinline__ float softplusf_(float x) { return x > 20.f ? x : log1pf(__expf(x)); }

__device__ __forceinline__ float fast_tanhf(float x) { const float e = __expf(2.f * x); return 1.f - 2.f / (e + 1.f); }
__device__ __forceinline__ float fast_softplusf(float x) { return x > 20.f ? x : __logf(1.f + __expf(x)); }
__device__ __forceinline__ float dpp_f(float v, const int ctrl_sel) {
    const int i = __builtin_bit_cast(int, v);
    int r;
    if (ctrl_sel == 0) r = __builtin_amdgcn_update_dpp(i, i, 0xB1, 0xF, 0xF, false);
    else if (ctrl_sel == 1) r = __builtin_amdgcn_update_dpp(i, i, 0x4E, 0xF, 0xF, false);
    else r = __builtin_amdgcn_update_dpp(i, i, 0x141, 0xF, 0xF, false);
    return __builtin_bit_cast(float, r);
}
__device__ __forceinline__ float red8_dpp(float v) { v += dpp_f(v, 0); v += dpp_f(v, 1); v += dpp_f(v, 2); return v; }
namespace pg8 {
#define PG8_LAS __attribute__((address_space(3)))
constexpr int BM = 256, BK = 64, HALF = 128, HTB = HALF * BK * 2  , STAGE_BYTES = 8 * HTB, NXCD = 8, WGM = 8;

__host__ __device__ __forceinline__ int lds_byte(int r, int c) { const int st = (r >> 4) * 2 + (c >> 5), rr = r & 15, cc = c & 31, ob = rr * 64 + cc * 2; return st * 1024 + (ob ^ (((ob >> 9) & 1) << 5)); }
__host__ __device__ __forceinline__ void stage_rc(int b, int& R, int& C) { const int st = b / 1024, sb = b % 1024, swz = sb ^ (((sb >> 9) & 1) << 5); R = (st >> 1) * 16 + swz / 64; C = (st & 1) * 32 + (swz % 64) / 2; }
__host__ __device__ __forceinline__ int perm32(int rho) { const int n = rho >> 4, i = rho & 15; return 8 * (i >> 2) + 4 * n + (i & 3); }

struct Unit { int pm, pn; };
struct Gemm { const bf16_t* A; const bf16_t* Bt; int M, N, K; };

struct StaticOrder {
    int nM, nN, nwg, G, c;
    __host__ __device__ void init(int M, int N, int G_, int c_) { nM = M / BM; nN = N / BM; nwg = nM * nN; G = G_; c = c_; }
    __host__ __device__ bool next(int i, Unit& u) const {
        const long L = (long)i * G + c; if (L >= nwg) return false;
        int wgid = (int)L; { const int q = nwg / NXCD, r = nwg % NXCD, xcd = wgid % NXCD, off = wgid / NXCD; wgid = (xcd < r ? xcd * (q + 1) : r * (q + 1) + (xcd - r) * q) + off; }
        const int nig = WGM * nN, gid = wgid / nig, fm = gid * WGM, gsz = (nM - fm) < WGM ? (nM - fm) : WGM;
        u.pm = fm + ((wgid % nig) % gsz); u.pn = (wgid % nig) / gsz; return true;
    }
    __device__ __forceinline__ void a_ready(const Unit&) const {}
    __device__ __forceinline__ void done(const Unit&) const {}
};


__device__ __forceinline__ unsigned cvt_pk_bf16(float lo, float hi) { unsigned r; asm volatile("v_cvt_pk_bf16_f32 %0, %1, %2" : "=v"(r) : "v"(lo), "v"(hi)); return r; }
template <int ACT  > struct EpiBf16 {
    static constexpr bool PERM = true, AFTER_DRAIN = false;
    bf16_t* O; int ldc;
    __device__ __forceinline__ void operator()(const f32x4 (&acc)[2][2][4][2], const Unit& u, int wr, int wc, int fr, int fq) const {
        const int row0 = u.pm * BM + wr * 64 + fr; const int col0 = u.pn * BM + wc * 32 + 8 * fq;
#pragma unroll
        for (int ai = 0; ai < 2; ++ai)
#pragma unroll
            for (int m = 0; m < 4; ++m) { bf16_t* rowp = O + (size_t)(row0 + ai * HALF + m * 16) * ldc + col0;
#pragma unroll
                for (int bj = 0; bj < 2; ++bj) { f32x4 v0 = acc[ai][bj][m][0], v1 = acc[ai][bj][m][1];
                    if (ACT == 2) {
#pragma unroll
                        for (int e = 0; e < 4; ++e) { float a = v0[e] > 0.f ? v0[e] : 0.f; v0[e] = a * a; float b = v1[e] > 0.f ? v1[e] : 0.f; v1[e] = b * b; } }
                    if (ACT == 3) {
#pragma unroll
                        for (int e = 0; e < 4; ++e) { v0[e] = v0[e] / (1.f + __expf(-v0[e])); v1[e] = v1[e] / (1.f + __expf(-v1[e])); } }
                    u32x4 w; w.x = cvt_pk_bf16(v0[0], v0[1]); w.y = cvt_pk_bf16(v0[2], v0[3]); w.z = cvt_pk_bf16(v1[0], v1[1]); w.w = cvt_pk_bf16(v1[2], v1[3]);
                    *(u32x4*)(rowp + bj * HALF) = w; } }
    }
};
template <class Epi, class Sched, bool ALIGN_EPI = false, bool SP2 = false>
__device__ __forceinline__ void gemm_phase(PG8_LAS unsigned char* lds, const Gemm g, const Sched& S, const Epi& E) {
    int tid_ = threadIdx.x; asm volatile("" : "+v"(tid_));
    const int tid = tid_, wid = __builtin_amdgcn_readfirstlane(tid >> 6), lane = tid & 63, wr = wid >> 2, wc = wid & 3, fr = lane & 15, fq = lane >> 4;
    const int K = g.K, nt = K / BK;
    unsigned voffA[2], voffB[2];
#pragma unroll
    for (int i = 0; i < 2; ++i) { int R, C; stage_rc(tid * 16 + i * 8192, R, C); const int Rb = Epi::PERM ? ((R & ~31) + perm32(R & 31)) : R;
        voffA[i] = (unsigned)(R * K + C) * 2u; voffB[i] = (unsigned)(Rb * K + C) * 2u; }
    const size_t kstep = (size_t)(BK * 2);
    const size_t hstep = (size_t)HALF * K * 2;
    const size_t tstep = 2 * hstep;
    const unsigned ldsw = (unsigned)wid * 1024u;
    const int aoff = lds_byte(wr * 64 + fr, fq * 8), boff = lds_byte(wc * 32 + fr, fq * 8);
#define PG8_SA(b, h) (((b) * 2 + (h)) * HTB)
#define PG8_SB(b, h) ((4 + (b) * 2 + (h)) * HTB)
#define PG8_STAGE(bufoff, gbase, voff) do { _Pragma("unroll") for (int _i = 0; _i < 2; ++_i) \
        __builtin_amdgcn_global_load_lds((const unsigned*)((const char*)(gbase) + (voff)[_i]), (PG8_LAS unsigned*)(lds + (bufoff) + ldsw + _i * 8192), 16, 0, 0); } while (0)
#define PG8_LDA(dst, b, h) do { _Pragma("unroll") for (int m = 0; m < 4; ++m) _Pragma("unroll") for (int k = 0; k < 2; ++k) dst[m][k] = *(const PG8_LAS bf16x8*)(lds + PG8_SA(b, h) + aoff + m * 2048 + k * 1024); } while (0)
#define PG8_LDB(dst, b, h) do { _Pragma("unroll") for (int n = 0; n < 2; ++n) _Pragma("unroll") for (int k = 0; k < 2; ++k) dst[n][k] = *(const PG8_LAS bf16x8*)(lds + PG8_SB(b, h) + boff + n * 2048 + k * 1024); } while (0)
#define PG8_MMA(ai, bj, At, Bt) do { __builtin_amdgcn_s_setprio(1); _Pragma("unroll") for (int m = 0; m < 4; ++m) _Pragma("unroll") for (int n = 0; n < 2; ++n) _Pragma("unroll") for (int k = 0; k < 2; ++k) \
        acc[ai][bj][m][n] = __builtin_amdgcn_mfma_f32_16x16x32_bf16(Bt[n][k], At[m][k], acc[ai][bj][m][n], 0, 0, 0); __builtin_amdgcn_s_setprio(0); } while (0)
#define PG8_WAIT_V(n) asm volatile("s_waitcnt vmcnt(" #n ")" ::: "memory")
#define PG8_WAIT_L(n) asm volatile("s_waitcnt lgkmcnt(" #n ")" ::: "memory")
#define PG8_BAR __builtin_amdgcn_s_barrier()
#define PG8_SCHED __builtin_amdgcn_sched_barrier(0)
    Unit cur, nxt; int ui = 0;
    if (!S.next(0, cur)) return;
    f32x4 acc[2][2][4][2];
#pragma unroll
    for (int a = 0; a < 2; ++a)
#pragma unroll
        for (int b = 0; b < 2; ++b)
#pragma unroll
            for (int m = 0; m < 4; ++m)
#pragma unroll
                for (int n = 0; n < 2; ++n) acc[a][b][m][n] = (f32x4){0.f, 0.f, 0.f, 0.f};
    bf16x8 At[4][2], B0[2][2], B1[2][2];
    const char* cA = (const char*)g.A + (size_t)cur.pm * tstep; const char* cB = (const char*)g.Bt + (size_t)cur.pn * tstep;
    S.a_ready(cur);
    if constexpr (SP2) {
        PG8_STAGE(PG8_SB(0, 0), cB, voffB); PG8_STAGE(PG8_SB(0, 1), cB + hstep, voffB); PG8_STAGE(PG8_SA(0, 0), cA, voffA); PG8_STAGE(PG8_SA(0, 1), cA + hstep, voffA);
        if (wr == 1) PG8_BAR;
        PG8_WAIT_V(2); PG8_BAR;
        PG8_STAGE(PG8_SB(1, 0), cB + kstep, voffB); PG8_STAGE(PG8_SA(1, 0), cA + kstep, voffA); PG8_STAGE(PG8_SB(1, 1), cB + hstep + kstep, voffB);
        PG8_WAIT_V(6); PG8_BAR;
    } else {
        PG8_STAGE(PG8_SB(0, 0), cB, voffB); PG8_STAGE(PG8_SA(0, 0), cA, voffA); PG8_STAGE(PG8_SB(0, 1), cB + hstep, voffB); PG8_STAGE(PG8_SA(0, 1), cA + hstep, voffA);
        if (wr == 1) PG8_BAR;
        PG8_WAIT_V(4); PG8_BAR;
        PG8_STAGE(PG8_SB(1, 0), cB + kstep, voffB); PG8_STAGE(PG8_SA(1, 0), cA + kstep, voffA); PG8_STAGE(PG8_SB(1, 1), cB + hstep + kstep, voffB);
        PG8_WAIT_V(6); PG8_BAR;
    }
    for (;;) {
        const bool has_next = S.next(ui + 1, nxt);
        const char* nA = has_next ? (const char*)g.A + (size_t)nxt.pm * tstep : cA; const char* nB = has_next ? (const char*)g.Bt + (size_t)nxt.pn * tstep : cB;
        for (int t = 0; t < nt; t += 2) {
            const bool last = (t == nt - 2);
            const char* a1 = cA + (size_t)(t + 1) * kstep;
            const char* a2 = last ? nA : cA + (size_t)(t + 2) * kstep; const char* b2 = last ? nB : cB + (size_t)(t + 2) * kstep;
            const char* a3 = a2 + kstep; const char* b3 = b2 + kstep;
            if (last && has_next) S.a_ready(nxt);
            if constexpr (SP2) {
            PG8_LDB(B0, 0, 0); PG8_LDB(B1, 0, 1); PG8_SCHED; PG8_LDA(At, 0, 0); PG8_STAGE(PG8_SA(1, 1), a1 + hstep, voffA);
            PG8_WAIT_V(8); PG8_WAIT_L(0); PG8_BAR; PG8_MMA(0, 0, At, B0); PG8_MMA(0, 1, At, B1); PG8_BAR; PG8_SCHED;
            PG8_LDA(At, 0, 1); PG8_STAGE(PG8_SB(0, 0), b2, voffB); PG8_STAGE(PG8_SB(0, 1), b2 + hstep, voffB); PG8_STAGE(PG8_SA(0, 0), a2, voffA);
            PG8_WAIT_V(8); PG8_WAIT_L(0); PG8_BAR; PG8_MMA(1, 0, At, B0); PG8_MMA(1, 1, At, B1); PG8_BAR; PG8_SCHED;
            PG8_LDB(B0, 1, 0); PG8_LDB(B1, 1, 1); PG8_SCHED; PG8_LDA(At, 1, 0); PG8_STAGE(PG8_SA(0, 1), a2 + hstep, voffA);
            PG8_WAIT_V(8); PG8_WAIT_L(0); PG8_BAR; PG8_MMA(0, 0, At, B0); PG8_MMA(0, 1, At, B1); PG8_BAR; PG8_SCHED;
            PG8_LDA(At, 1, 1); PG8_STAGE(PG8_SB(1, 0), b3, voffB); PG8_STAGE(PG8_SB(1, 1), b3 + hstep, voffB); PG8_STAGE(PG8_SA(1, 0), a3, voffA);
            PG8_WAIT_V(8); PG8_WAIT_L(0); PG8_BAR; PG8_MMA(1, 0, At, B0); PG8_MMA(1, 1, At, B1); PG8_BAR; PG8_SCHED;
            } else {
            PG8_LDB(B0, 0, 0); PG8_SCHED; PG8_LDA(At, 0, 0); PG8_STAGE(PG8_SA(1, 1), a1 + hstep, voffA);
            PG8_WAIT_L(8); PG8_BAR; PG8_WAIT_L(0); PG8_MMA(0, 0, At, B0); PG8_BAR; PG8_SCHED;
            PG8_LDB(B1, 0, 1); PG8_STAGE(PG8_SB(0, 0), b2, voffB);
            PG8_BAR; PG8_WAIT_L(0); PG8_MMA(0, 1, At, B1); PG8_BAR;
            PG8_LDA(At, 0, 1); PG8_STAGE(PG8_SA(0, 0), a2, voffA);
            PG8_BAR; PG8_WAIT_L(0); PG8_MMA(1, 0, At, B0); PG8_BAR; PG8_SCHED;
            PG8_STAGE(PG8_SB(0, 1), b2 + hstep, voffB);
            PG8_WAIT_V(6); PG8_BAR; PG8_MMA(1, 1, At, B1); PG8_BAR;
            PG8_LDB(B0, 1, 0); PG8_SCHED; PG8_LDA(At, 1, 0); PG8_STAGE(PG8_SA(0, 1), a2 + hstep, voffA);
            PG8_WAIT_L(8); PG8_BAR; PG8_WAIT_L(0); PG8_MMA(0, 0, At, B0); PG8_BAR; PG8_SCHED;
            PG8_LDB(B1, 1, 1); PG8_STAGE(PG8_SB(1, 0), b3, voffB);
            PG8_BAR; PG8_WAIT_L(0); PG8_MMA(0, 1, At, B1); PG8_BAR;
            PG8_LDA(At, 1, 1); PG8_STAGE(PG8_SA(1, 0), a3, voffA);
            PG8_BAR; PG8_WAIT_L(0); PG8_MMA(1, 0, At, B0); PG8_BAR; PG8_SCHED;
            PG8_STAGE(PG8_SB(1, 1), b3 + hstep, voffB);
            PG8_WAIT_V(6); PG8_BAR; PG8_MMA(1, 1, At, B1); PG8_BAR;
            }
        }
        if constexpr (ALIGN_EPI) { if (wr == 0) PG8_BAR; }
        if constexpr (!Epi::AFTER_DRAIN) { E(acc, cur, wr, wc, fr, fq); S.done(cur); }
        if (!has_next) break;
#pragma unroll
        for (int a = 0; a < 2; ++a)
#pragma unroll
            for (int b = 0; b < 2; ++b)
#pragma unroll
                for (int m = 0; m < 4; ++m)
#pragma unroll
                    for (int n = 0; n < 2; ++n) acc[a][b][m][n] = (f32x4){0.f, 0.f, 0.f, 0.f};
        cur = nxt; cA = nA; cB = nB; ++ui;
        if constexpr (ALIGN_EPI) { if (wr == 1) PG8_BAR; }
    }
    PG8_WAIT_V(0);
    if constexpr (!ALIGN_EPI) { if (wr == 0) PG8_BAR; }
    PG8_BAR;
    if constexpr (Epi::AFTER_DRAIN) { E.fused(acc, cur, wr, wc, fr, fq, lds, wid, lane); S.done(cur); }
#undef PG8_SA
#undef PG8_SB
#undef PG8_STAGE
#undef PG8_LDA
#undef PG8_LDB
#undef PG8_MMA
#undef PG8_WAIT_V
#undef PG8_WAIT_L
#undef PG8_BAR
#undef PG8_SCHED
}
}

constexpr size_t MiB = 1u << 20;
constexpr size_t WS_CTL = 0;
constexpr size_t WS_W_IN0 = 1 * MiB, WS_W_OUT0 = 9 * MiB, WS_W_UP0 = 11 * MiB, WS_W_DN0 = 19 * MiB;
constexpr size_t WS_W_IN1 = 27 * MiB, WS_W_OUT1 = 31 * MiB, WS_W_UP1 = 33 * MiB, WS_W_DN1 = 41 * MiB;
constexpr size_t WS_W_C1K = 49 * MiB, WS_W_C1V = 50 * MiB, WS_W_C2K = 51 * MiB, WS_W_C2V = 51 * MiB + 65536;
constexpr size_t WS_XN = 56 * MiB;
constexpr size_t WS_BIG = 120 * MiB;
constexpr size_t WS_R2 = 376 * MiB;
constexpr size_t WS_END = 440 * MiB;
constexpr int NWAVES = 8, NTHREADS = 512;
constexpr int LDS_BYTES = 147456;
constexpr int XB_LDS_OFF = LDS_BYTES - 64;
constexpr int CW_BAR = 4096;

struct Args {
    const float* in[33]; float* out; unsigned char* ws; int ph_lo, ph_hi;
};
struct Frame {
    LAS unsigned char* lds;
    int tid, lane, wave, G, bid;
    unsigned char* ws;
    unsigned* ctl;
};
__device__ __forceinline__ Frame fresh(const Frame& F) { Frame G = F; int t = threadIdx.x; asm volatile("" : "+v"(t)); G.tid = t; G.lane = t & 63; G.wave = __builtin_amdgcn_readfirstlane(t >> 6); return G; }
enum { IN_X = 0, IN_POS, IN_NMPRE, IN_NMPOST, IN_NFPRE, IN_NFPOST, IN_WUP, IN_WDN, IN_ABIN, IN_ABOUT, IN_GCONV, IN_GALOG, IN_GDT, IN_GNORM,
       IN_RMU, IN_RW0, IN_RW2, IN_RA0, IN_RA2, IN_RG2, IN_RKK, IN_RKA, IN_RRK, IN_RLNW, IN_RLNB, IN_NWIN, IN_NWOUT, IN_NPEK, IN_NW1K, IN_NW2K, IN_NPEV, IN_NW1V, IN_NW2V };

template <bool LIGHT = false> __device__ __forceinline__ void transpose_item(const float* W, int K, int Nsrc, int src_col0, int cnt, bf16_t* WT, int dst_row0, LAS float* scr, int item, int lane) {
    const int nblk = (cnt + 31) / 32, kb = item / nblk, nb = item % nblk, k0 = 64 * kb, n0 = 32 * nb;
    const int nl = lane & 31; const bool okn = (n0 + nl) < cnt;
    const float* wp = W + (size_t)(k0 + (lane >> 5)) * Nsrc + src_col0 + n0 + nl;
    if constexpr (LIGHT) {
#pragma unroll 8
        for (int i = 0; i < 32; ++i) scr[(2 * i + (lane >> 5)) * 33 + nl] = okn ? wp[(size_t)(2 * i) * Nsrc] : 0.f;
    } else {
        float wv[32];
#pragma unroll
        for (int i = 0; i < 32; ++i) wv[i] = okn ? wp[(size_t)(2 * i) * Nsrc] : 0.f;
#pragma unroll
        for (int i = 0; i < 32; ++i) scr[(2 * i + (lane >> 5)) * 33 + nl] = wv[i];
    }
    asm volatile("s_waitcnt lgkmcnt(0)" ::: "memory");
    const int c = lane & 7;
#pragma unroll
    for (int j = 0; j < 4; ++j) { const int n = (lane >> 3) + 8 * j; const LAS float* s = scr + (8 * c) * 33 + n;
        u32x4 o; o.x = pk2(s[0 * 33], s[1 * 33]); o.y = pk2(s[2 * 33], s[3 * 33]); o.z = pk2(s[4 * 33], s[5 * 33]); o.w = pk2(s[6 * 33], s[7 * 33]);
        if (n0 + n < cnt) *(u32x4*)(WT + (size_t)(dst_row0 + n0 + n) * K + k0 + 8 * c) = o; }
    asm volatile("s_waitcnt lgkmcnt(0)" ::: "memory");
}
template <bool LIGHT = false> __device__ __forceinline__ void transpose_seg(const Frame& F, const float* W, int K, int Nsrc, int src_col0, int cnt, bf16_t* WT, int dst_row0, int bid0 = 0, int nb = 0) {
    LAS float* scr = (LAS float*)(F.lds + F.wave * 16384);
    const int gw = (F.bid - bid0) * NWAVES + F.wave, NGW = (nb ? nb : F.G) * NWAVES;
    const int nitems = (K / 64) * ((cnt + 31) / 32);
    for (int it = gw; it < nitems; it += NGW) transpose_item<LIGHT>(W, K, Nsrc, src_col0, cnt, WT, dst_row0, scr, it, F.lane);
}
__device__ __forceinline__ void zero_rows(const Frame& F, bf16_t* WT, int K, int row0, int nrows, int bid0 = 0, int nb = 0) {
    const int gw = (F.bid - bid0) * NWAVES + F.wave, NGW = (nb ? nb : F.G) * NWAVES;
    for (int r = gw; r < nrows; r += NGW) { u32x4* p = (u32x4*)(WT + (size_t)(row0 + r) * K); for (int j = F.lane; j < K / 8; j += 64) p[j] = (u32x4){0u, 0u, 0u, 0u}; }
}
__device__ __forceinline__ void rms_row_to_bf16(const float* xrow, const float* w, bf16_t* orow, int lane) {
    const f32x4* xr = (const f32x4*)xrow + lane; const f32x4* wr = (const f32x4*)w + lane;
    f32x4 v[4]; float s = 0.f;
#pragma unroll
    for (int j = 0; j < 4; ++j) { v[j] = xr[64 * j]; s += (v[j].x * v[j].x + v[j].y * v[j].y) + (v[j].z * v[j].z + v[j].w * v[j].w); }
    const float rstd = 1.f / sqrtf(wave_sum(s) * (1.f / D_MODEL) + NORM_EPS);
    unsigned long long* o8 = (unsigned long long*)orow + lane;
#pragma unroll
    for (int j = 0; j < 4; ++j) { const f32x4 g = wr[64 * j];
        o8[64 * j] = (unsigned long long)pk2(v[j].x * rstd * g.x, v[j].y * rstd * g.y) | ((unsigned long long)pk2(v[j].z * rstd * g.z, v[j].w * rstd * g.w) << 32); }
}
__device__ __forceinline__ void p0_prologue(const Frame& F, const Args& a) {
    unsigned char* ws = F.ws;
    const float* abin = a.in[IN_ABIN];
    transpose_seg(F, abin, 1024, AB_IN_W, 0, 2048, (bf16_t*)(ws + WS_W_IN0), 0);
    transpose_seg(F, abin, 1024, AB_IN_W, 2056, 1792, (bf16_t*)(ws + WS_W_IN0), 2048);
    transpose_seg(F, abin, 1024, AB_IN_W, 2048, 8, (bf16_t*)(ws + WS_W_IN0), 3840);
    zero_rows(F, (bf16_t*)(ws + WS_W_IN0), 1024, 3848, 4096 - 3848);
    transpose_seg(F, a.in[IN_ABOUT], 1024, 1024, 0, 1024, (bf16_t*)(ws + WS_W_OUT0), 0);
    transpose_seg(F, a.in[IN_WUP], 1024, 4096, 0, 4096, (bf16_t*)(ws + WS_W_UP0), 0);
    transpose_seg(F, a.in[IN_WDN], 4096, 1024, 0, 1024, (bf16_t*)(ws + WS_W_DN0), 0);
    const int gw = F.bid * NWAVES + F.wave, NGW = F.G * NWAVES;
    const float* x = a.in[IN_X]; bf16_t* XN = (bf16_t*)(ws + WS_XN);
    for (int m = gw; m < MTOK; m += 2 * NGW) {
        const int m2 = m + NGW;
        const f32x4* xr0 = (const f32x4*)(x + (size_t)m * D_MODEL) + F.lane; const f32x4* xr1 = (const f32x4*)(x + (size_t)(m2 < MTOK ? m2 : m) * D_MODEL) + F.lane; const f32x4* wr = (const f32x4*)a.in[IN_NMPRE] + F.lane;
        f32x4 v0[4], v1[4]; float s0 = 0.f, s1 = 0.f;
#pragma unroll
        for (int j = 0; j < 4; ++j) { v0[j] = xr0[64 * j]; v1[j] = xr1[64 * j]; }
#pragma unroll
        for (int j = 0; j < 4; ++j) { s0 += (v0[j].x * v0[j].x + v0[j].y * v0[j].y) + (v0[j].z * v0[j].z + v0[j].w * v0[j].w); s1 += (v1[j].x * v1[j].x + v1[j].y * v1[j].y) + (v1[j].z * v1[j].z + v1[j].w * v1[j].w); }
        const float r0 = 1.f / sqrtf(wave_sum(s0) * (1.f / D_MODEL) + NORM_EPS), r1 = 1.f / sqrtf(wave_sum(s1) * (1.f / D_MODEL) + NORM_EPS);
        unsigned long long* o0 = (unsigned long long*)(XN + (size_t)m * D_MODEL) + F.lane; unsigned long long* o1 = (unsigned long long*)(XN + (size_t)m2 * D_MODEL) + F.lane;
#pragma unroll
        for (int j = 0; j < 4; ++j) { const f32x4 g = wr[64 * j];
            o0[64 * j] = (unsigned long long)pk2(v0[j].x * r0 * g.x, v0[j].y * r0 * g.y) | ((unsigned long long)pk2(v0[j].z * r0 * g.z, v0[j].w * r0 * g.w) << 32);
            if (m2 < MTOK) o1[64 * j] = (unsigned long long)pk2(v1[j].x * r1 * g.x, v1[j].y * r1 * g.y) | ((unsigned long long)pk2(v1[j].z * r1 * g.z, v1[j].w * r1 * g.w) << 32); }
    }
}

__device__ __forceinline__ void p0_layer1_weights(const Frame& F, const Args& a, int bid0, int nb, int part) {
    unsigned char* ws = F.ws;
    if (part < 0 || part == 0) {
        transpose_seg<true>(F, a.in[IN_NWIN], 1024, NSA_IN_W, 0, NSA_IN_W, (bf16_t*)(ws + WS_W_IN1), 0, bid0, nb);
        zero_rows(F, (bf16_t*)(ws + WS_W_IN1), 1024, NSA_IN_W, 2048 - NSA_IN_W, bid0, nb);
        transpose_seg<true>(F, a.in[IN_NWOUT], 1024, 1024, 0, 1024, (bf16_t*)(ws + WS_W_OUT1), 0, bid0, nb); }
    if (part < 0 || part == 1) transpose_seg<true>(F, a.in[IN_WUP] + (size_t)1024 * 4096, 1024, 4096, 0, 4096, (bf16_t*)(ws + WS_W_UP1), 0, bid0, nb);
    if (part < 0 || part == 2) transpose_seg<true>(F, a.in[IN_WDN] + (size_t)1024 * 4096, 4096, 1024, 0, 1024, (bf16_t*)(ws + WS_W_DN1), 0, bid0, nb);
    if (part < 0 || part == 3) {
        transpose_seg<true>(F, a.in[IN_NW1K], 2048, 256, 0, 256, (bf16_t*)(ws + WS_W_C1K), 0, bid0, nb);
        transpose_seg<true>(F, a.in[IN_NW1V], 2048, 256, 0, 256, (bf16_t*)(ws + WS_W_C1V), 0, bid0, nb);
        transpose_seg<true>(F, a.in[IN_NW2K], 256, 64, 0, 64, (bf16_t*)(ws + WS_W_C2K), 0, bid0, nb);
        transpose_seg<true>(F, a.in[IN_NW2V], 256, 64, 0, 64, (bf16_t*)(ws + WS_W_C2V), 0, bid0, nb); }
}

#define XB_TMO      128
#define XB_XCNT(j)  (256  + 64 * (j))
#define XB_XSUB(j)  (1280 + 64 * (j))
#define XB_XGEN(j)  (2304 + 64 * (j))
#define XB_TOP      3328
#define XB_TOPGEN   3392
#define XCD_BAR_WORDS 3456
#define XB_SPIN_CAP (1u << 18)

__device__ __forceinline__ unsigned xb_ld(unsigned* p)              { return __hip_atomic_load(p, __ATOMIC_RELAXED, __HIP_MEMORY_SCOPE_AGENT); }
__device__ __forceinline__ unsigned xb_add(unsigned* p, unsigned v) { return __hip_atomic_fetch_add(p, v, __ATOMIC_RELAXED, __HIP_MEMORY_SCOPE_AGENT); }
__device__ __forceinline__ unsigned xb_xcc_id() { return (unsigned)__builtin_amdgcn_s_getreg((3 << 11) | 20) & 0xFu; }
#define XB_SPIN(cond, bar) do { unsigned _sp = 0; while (cond) { __builtin_amdgcn_s_sleep(1); \
    if ((++_sp & 255u) == 0u) { if (xb_ld(&(bar)[XB_TMO])) break; if (_sp > XB_SPIN_CAP) { atomicAdd(&(bar)[XB_TMO], 1u); break; } } } } while (0)

struct XcdBarrier {
    unsigned* bar; unsigned x;
    volatile LAS unsigned* st;
};

__device__ __forceinline__ XcdBarrier xcd_barrier_post(unsigned* bar, volatile LAS unsigned* st) {
    XcdBarrier b; b.bar = bar; b.x = xb_xcc_id(); b.st = st;
    if (threadIdx.x == 0) (void)xb_add(&bar[XB_XCNT(b.x)], 1u);
    return b;
}
__device__ __forceinline__ void xcd_barrier_complete(unsigned* bar, unsigned x, unsigned& nloc, unsigned& nx) {
    const unsigned G = gridDim.x * gridDim.y * gridDim.z;
    unsigned sum, cnt, mine, sp = 0u;
    for (;;) {
        sum = 0u; cnt = 0u; mine = 0u;
#pragma unroll
        for (unsigned j = 0; j < 16; ++j) { const unsigned c = xb_ld(&bar[XB_XCNT(j)]); sum += c; cnt += (c > 0u) ? 1u : 0u; mine = (j == x) ? c : mine; }
        if (sum == G) break;
        __builtin_amdgcn_s_sleep(1);
        if ((++sp & 255u) == 0u) { if (xb_ld(&bar[XB_TMO])) break; if (sp > XB_SPIN_CAP) { atomicAdd(&bar[XB_TMO], 1u); break; } }
    }
    nloc = mine > 0u ? mine : 1u; nx = cnt > 0u ? cnt : 1u;
}

__device__ __forceinline__ void xcd_barrier(const XcdBarrier& b) {
    asm volatile("s_waitcnt vmcnt(0)" ::: "memory");
    __syncthreads();
    if (threadIdx.x == 0) {
        unsigned* bar = b.bar; const unsigned bx = xb_xcc_id();
        __builtin_amdgcn_s_waitcnt(0);
        unsigned nloc = b.st[0], nx = b.st[1];
        if (nloc == 0u) { xcd_barrier_complete(bar, bx, nloc, nx); b.st[0] = nloc; b.st[1] = nx; }
        const unsigned old = xb_add(&bar[XB_XSUB(bx)], 1u);
        const unsigned gen = old / nloc;
        if (old + 1u == (gen + 1u) * nloc) {
            __builtin_amdgcn_fence(__ATOMIC_RELEASE, "agent");
            asm volatile("s_waitcnt vmcnt(0)" ::: "memory");
            const unsigned og = xb_add(&bar[XB_TOP], 1u);
            const unsigned tg = og / nx;
            if (og + 1u == (tg + 1u) * nx) xb_add(&bar[XB_TOPGEN], 1u);
            else XB_SPIN(xb_ld(&bar[XB_TOPGEN]) == tg, bar);
            __builtin_amdgcn_fence(__ATOMIC_ACQUIRE, "agent");
            xb_add(&bar[XB_XGEN(bx)], 1u);
            asm volatile("s_waitcnt vmcnt(0)" ::: "memory");
        } else {
            XB_SPIN(xb_ld(&bar[XB_XGEN(bx)]) == gen, bar);
            __builtin_amdgcn_fence(__ATOMIC_ACQUIRE, "agent");
            asm volatile("s_waitcnt vmcnt(0)" ::: "memory");
        }
    }
    __syncthreads();
}
constexpr size_t GDN_UNIT_ELEMS = 8192;
constexpr size_t WS_INTRA = WS_R2, WS_GLAST = WS_R2 + 16 * MiB;
constexpr int GP_ROWB = 272;
constexpr int GP_QB = 0, GP_KB = 17408, GP_VB = 34816, GP_AM = 52224, GP_SC = 68608, GP_HALF = 69632;
#define MFMA16(a, b, c) __builtin_amdgcn_mfma_f32_16x16x32_bf16((a), (b), (c), 0, 0, 0)

__device__ __forceinline__ void gdn_prep_phase(const Frame& F, const Args& a) {
    const bf16_t* F0 = (const bf16_t*)(F.ws + WS_BIG);
    bf16_t* Ut = (bf16_t*)a.out; bf16_t* Wm = Ut + (size_t)2048 * GDN_UNIT_ELEMS; bf16_t* QG = Wm + (size_t)2048 * GDN_UNIT_ELEMS; bf16_t* KGt = QG + (size_t)2048 * GDN_UNIT_ELEMS;
    bf16_t* INTRA = (bf16_t*)(F.ws + WS_INTRA); float* GLAST = (float*)(F.ws + WS_GLAST);
    const float* convw = a.in[IN_GCONV];
    const int hb = F.wave >> 2, wq = F.wave & 3, lane = F.lane, fr = lane & 15, fq = lane >> 4;
    LAS unsigned char* L = F.lds + hb * GP_HALF;
    LAS float* betaL = (LAS float*)(L + GP_SC); LAS float* gcL = betaL + 64;
    LAS float* Am = (LAS float*)(L + GP_AM);
    const int nhalf = F.G * 2, hid = F.bid * 2 + hb;
    for (int u = hid; u < 2048; u += nhalf) {
        const int n = u & 63, h = (u >> 6) & 3, b = u >> 8;
        const size_t m0 = (size_t)b * SEQ + (size_t)n * 64;
        if (wq == 0) {
            const size_t m = m0 + lane;
            const float bb = bf2f(F0[m * F0_LD + F0_BA + h]), aa = bf2f(F0[m * F0_LD + F0_BA + 4 + h]);
            const float beta = sigmoidf_(bb);
            float g = -__expf(a.in[IN_GALOG][h]) * softplusf_(aa + a.in[IN_GDT][h]);
#pragma unroll
            for (int o = 1; o < 64; o <<= 1) { const float t = __shfl_up(g, o); if (lane >= o) g += t; }
            betaL[lane] = beta; gcL[lane] = g;
            if (lane == 63) GLAST[u] = __expf(g);
        }
        __syncthreads();
#pragma unroll 1
        for (int it = 0; it < 4; ++it) {
            const int tl = 16 * wq + 4 * it + fq;
            const int tseq = n * 64 + tl;
            const size_t m = m0 + tl;
            float res[3][8];
#pragma unroll
            for (int X = 0; X < 3; ++X) {
                const int col = X * 512 + h * 128 + 8 * fr;
                float acc[8];
#pragma unroll
                for (int e = 0; e < 8; ++e) acc[e] = 0.f;
#pragma unroll
                for (int i = 0; i < 4; ++i) {
                    u32x4 xv = (u32x4){0u, 0u, 0u, 0u};
                    if (tseq - 3 + i >= 0) xv = *(const u32x4*)(F0 + (m - 3 + i) * F0_LD + col);
                    const f32x4 w0 = *(const f32x4*)(convw + i * 1536 + col), w1 = *(const f32x4*)(convw + i * 1536 + col + 4);
                    acc[0] += w0[0] * bflo(xv.x); acc[1] += w0[1] * bfhi(xv.x); acc[2] += w0[2] * bflo(xv.y); acc[3] += w0[3] * bfhi(xv.y);
                    acc[4] += w1[0] * bflo(xv.z); acc[5] += w1[1] * bfhi(xv.z); acc[6] += w1[2] * bflo(xv.w); acc[7] += w1[3] * bfhi(xv.w);
                }
#pragma unroll
                for (int e = 0; e < 8; ++e) res[X][e] = siluf_(acc[e]);
            }
            float sq = 0.f, sk = 0.f;
#pragma unroll
            for (int e = 0; e < 8; ++e) { sq += res[0][e] * res[0][e]; sk += res[1][e] * res[1][e]; }
#pragma unroll
            for (int o = 1; o < 16; o <<= 1) { sq += __shfl_xor(sq, o); sk += __shfl_xor(sk, o); }
            const float rq = rsqrtf(sq + 1e-6f) * 0.08838834764831845f, rk = rsqrtf(sk + 1e-6f);
            const float eg = __expf(gcL[tl]);
            u32x4 qv, kv, vv, qg;
            qv.x = pk2(res[0][0] * rq, res[0][1] * rq); qv.y = pk2(res[0][2] * rq, res[0][3] * rq); qv.z = pk2(res[0][4] * rq, res[0][5] * rq); qv.w = pk2(res[0][6] * rq, res[0][7] * rq);
            kv.x = pk2(res[1][0] * rk, res[1][1] * rk); kv.y = pk2(res[1][2] * rk, res[1][3] * rk); kv.z = pk2(res[1][4] * rk, res[1][5] * rk); kv.w = pk2(res[1][6] * rk, res[1][7] * rk);
            vv.x = pk2(res[2][0], res[2][1]); vv.y = pk2(res[2][2], res[2][3]); vv.z = pk2(res[2][4], res[2][5]); vv.w = pk2(res[2][6], res[2][7]);
            const float rqg = rq * eg;
            qg.x = pk2(res[0][0] * rqg, res[0][1] * rqg); qg.y = pk2(res[0][2] * rqg, res[0][3] * rqg); qg.z = pk2(res[0][4] * rqg, res[0][5] * rqg); qg.w = pk2(res[0][6] * rqg, res[0][7] * rqg);
            *(LAS u32x4*)(L + GP_QB + tl * GP_ROWB + fr * 16) = qv;
            *(LAS u32x4*)(L + GP_KB + tl * GP_ROWB + fr * 16) = kv;
            *(LAS u32x4*)(L + GP_VB + tl * GP_ROWB + fr * 16) = vv;
            *(u32x4*)(QG + (size_t)u * GDN_UNIT_ELEMS + tl * 128 + fr * 8) = qg;
        }
        __syncthreads();
        {
            bf16x8 ka[4], qa[4];
#pragma unroll
            for (int ks = 0; ks < 4; ++ks) { ka[ks] = *(const LAS bf16x8*)(L + GP_KB + (16 * wq + fr) * GP_ROWB + (32 * ks + 8 * fq) * 2);
                                             qa[ks] = *(const LAS bf16x8*)(L + GP_QB + (16 * wq + fr) * GP_ROWB + (32 * ks + 8 * fq) * 2); }
            bf16_t* intra_u = INTRA + (size_t)u * 4096;
#pragma unroll
            for (int nt = 0; nt < 4; ++nt) {
                if (nt <= wq) {
                    f32x4 ckk = (f32x4){0.f, 0.f, 0.f, 0.f}, cqk = (f32x4){0.f, 0.f, 0.f, 0.f};
#pragma unroll
                    for (int ks = 0; ks < 4; ++ks) { const bf16x8 kb = *(const LAS bf16x8*)(L + GP_KB + (16 * nt + fr) * GP_ROWB + (32 * ks + 8 * fq) * 2);
                        ckk = MFMA16(ka[ks], kb, ckk); cqk = MFMA16(qa[ks], kb, cqk); }
                    const int j = 16 * nt + fr; const float gj = gcL[j];
#pragma unroll
                    for (int r = 0; r < 4; ++r) { const int i = 16 * wq + 4 * fq + r; const float d = __expf(gcL[i] - gj);
                        Am[i * 64 + j] = (i > j) ? betaL[i] * ckk[r] * d : 0.f;
                        intra_u[i * 64 + j] = (bf16_t)f2bf((i >= j) ? cqk[r] * d : 0.f); }
                } else {
#pragma unroll
                    for (int r = 0; r < 4; ++r) intra_u[(16 * wq + 4 * fq + r) * 64 + 16 * nt + fr] = 0;
                }
            }
        }
        __syncthreads();
        {
            const bool isk = wq >= 2; const int ch = (wq & 1) * 64 + lane;
            LAS unsigned char* X = L + (isk ? GP_KB : GP_VB);
            float sol[64];
#pragma unroll
            for (int t = 0; t < 64; ++t) sol[t] = bf2f(*(const LAS bf16_t*)(X + t * GP_ROWB + ch * 2));
            if (isk) {
                const float gl = gcL[63];
                u32x4* dst = (u32x4*)(KGt + (size_t)u * GDN_UNIT_ELEMS + ch * 64);
#pragma unroll
                for (int q8 = 0; q8 < 8; ++q8) { u32x4 o;
                    o.x = pk2(sol[8 * q8 + 0] * __expf(gl - gcL[8 * q8 + 0]), sol[8 * q8 + 1] * __expf(gl - gcL[8 * q8 + 1]));
                    o.y = pk2(sol[8 * q8 + 2] * __expf(gl - gcL[8 * q8 + 2]), sol[8 * q8 + 3] * __expf(gl - gcL[8 * q8 + 3]));
                    o.z = pk2(sol[8 * q8 + 4] * __expf(gl - gcL[8 * q8 + 4]), sol[8 * q8 + 5] * __expf(gl - gcL[8 * q8 + 5]));
                    o.w = pk2(sol[8 * q8 + 6] * __expf(gl - gcL[8 * q8 + 6]), sol[8 * q8 + 7] * __expf(gl - gcL[8 * q8 + 7]));
                    dst[q8] = o; }
#pragma unroll
                for (int t = 0; t < 64; ++t) sol[t] *= betaL[t] * __expf(gcL[t]);
            } else {
#pragma unroll
                for (int t = 0; t < 64; ++t) sol[t] *= betaL[t];
            }
#pragma unroll
            for (int i = 1; i < 64; ++i) {
                float s = sol[i];
#pragma unroll
                for (int j = 0; j < i; ++j) s -= Am[i * 64 + j] * sol[j];
                sol[i] = s;
            }
            if (isk) { bf16_t* dst = Wm + (size_t)u * GDN_UNIT_ELEMS + ch;
#pragma unroll
                for (int t = 0; t < 64; ++t) dst[t * 128] = (bf16_t)f2bf(sol[t]);
            } else { u32x4* dst = (u32x4*)(Ut + (size_t)u * GDN_UNIT_ELEMS + ch * 64);
#pragma unroll
                for (int q8 = 0; q8 < 8; ++q8) { u32x4 o; o.x = pk2(sol[8 * q8], sol[8 * q8 + 1]); o.y = pk2(sol[8 * q8 + 2], sol[8 * q8 + 3]); o.z = pk2(sol[8 * q8 + 4], sol[8 * q8 + 5]); o.w = pk2(sol[8 * q8 + 6], sol[8 * q8 + 7]); dst[q8] = o; }
            }
        }
        __syncthreads();
    }
}

constexpr int GS_W = 0, GS_Q = 17408, GS_I = 34816, GS_K = 44032, GS_U = 62464, GS_Z = 80896;
constexpr int GS_SSQ = GS_Z + 17408;
static_assert(GS_SSQ + 4096 <= XB_LDS_OFF, "gdn scan lds");
__device__ __forceinline__ float red16_dpp(float v) {
    v += dpp_f(v, 0); v += dpp_f(v, 1); v += dpp_f(v, 2);
    const int i = __builtin_bit_cast(int, v); v += __builtin_bit_cast(float, __builtin_amdgcn_update_dpp(i, i, 0x140, 0xF, 0xF, false));
    return v;
}
constexpr size_t WS_GSTATE = WS_R2 + 18 * MiB;
__device__ __forceinline__ bf16x8 lds_aperm(const LAS unsigned char* rowp, int k0, int fq) {
    const u32x2 a = *(const LAS u32x2*)(rowp + (k0 + 4 * fq) * 2), b = *(const LAS u32x2*)(rowp + (k0 + 16 + 4 * fq) * 2);
    u32x4 v; v.x = a.x; v.y = a.y; v.z = b.x; v.w = b.y; return __builtin_bit_cast(bf16x8, v);
}
__device__ __forceinline__ bf16x8 acc_bperm(const f32x4& lo, const f32x4& hi) {
    u32x4 v; v.x = pk2(lo[0], lo[1]); v.y = pk2(lo[2], lo[3]); v.z = pk2(hi[0], hi[1]); v.w = pk2(hi[2], hi[3]); return __builtin_bit_cast(bf16x8, v);
}
__device__ __forceinline__ void gdn_scan_unit(const Frame& F, const Args& a, int bh, int n0, int n1, bool dry = false) {
    const bf16_t* F0 = (const bf16_t*)(F.ws + WS_BIG);
    const bf16_t* Ut = (const bf16_t*)a.out; const bf16_t* Wm = Ut + (size_t)2048 * GDN_UNIT_ELEMS; const bf16_t* QG = Wm + (size_t)2048 * GDN_UNIT_ELEMS; const bf16_t* KGt = QG + (size_t)2048 * GDN_UNIT_ELEMS;
    const bf16_t* INTRA = (const bf16_t*)(F.ws + WS_INTRA); const float* GLAST = (const float*)(F.ws + WS_GLAST);
    bf16_t* OAB = (bf16_t*)(F.ws + WS_XN);
    const int w = F.wave, lane = F.lane, tid = F.tid, fr = lane & 15, fq = lane >> 4;
    const int h = bh & 3, b = bh >> 2;
    LAS unsigned char* L = F.lds;
    LAS float* ssq = (LAS float*)(L + GS_SSQ);
    f32x4 S[8]; f32x4* GST = (f32x4*)(F.ws + WS_GSTATE) + ((size_t)bh * 8 + w) * 512;
#pragma unroll
    for (int d = 0; d < 8; ++d) S[d] = (n0 == 0) ? (f32x4){0.f, 0.f, 0.f, 0.f} : GST[d * 64 + lane];
    const float gnw = a.in[IN_GNORM][16 * w + fr];
    u32x4 pw[2], pq[2], pi, pk[2], pu[2], pz[2]; float pgl;
#define GS_FETCH(n_) do { const size_t u_ = (size_t)bh * 64 + (n_); \
        _Pragma("unroll") for (int i_ = 0; i_ < 2; ++i_) { const int e_ = tid + 512 * i_; pw[i_] = *(const u32x4*)(Wm + u_ * GDN_UNIT_ELEMS + (size_t)e_ * 8); pq[i_] = *(const u32x4*)(QG + u_ * GDN_UNIT_ELEMS + (size_t)e_ * 8); \
            pk[i_] = *(const u32x4*)(KGt + u_ * GDN_UNIT_ELEMS + (size_t)e_ * 8); pu[i_] = *(const u32x4*)(Ut + u_ * GDN_UNIT_ELEMS + (size_t)e_ * 8); \
            pz[i_] = *(const u32x4*)(F0 + ((size_t)b * SEQ + (size_t)(n_) * 64 + (e_ >> 4)) * F0_LD + 1536 + h * 128 + (e_ & 15) * 8); } \
        pi = *(const u32x4*)(INTRA + u_ * 4096 + (size_t)tid * 8); pgl = GLAST[u_]; } while (0)
#define GS_STORE() do { \
        _Pragma("unroll") for (int i_ = 0; i_ < 2; ++i_) { const int e_ = tid + 512 * i_; \
            *(LAS u32x4*)(L + GS_W + (e_ >> 4) * 272 + (e_ & 15) * 16) = pw[i_]; *(LAS u32x4*)(L + GS_Q + (e_ >> 4) * 272 + (e_ & 15) * 16) = pq[i_]; *(LAS u32x4*)(L + GS_Z + (e_ >> 4) * 272 + (e_ & 15) * 16) = pz[i_]; \
            *(LAS u32x4*)(L + GS_K + (e_ >> 3) * 144 + (e_ & 7) * 16) = pk[i_]; *(LAS u32x4*)(L + GS_U + (e_ >> 3) * 144 + (e_ & 7) * 16) = pu[i_]; } \
        *(LAS u32x4*)(L + GS_I + (tid >> 3) * 144 + (tid & 7) * 16) = pi; } while (0)
    GS_FETCH(n0);
    __syncthreads();
    GS_STORE();
    float gl = pgl;
    __syncthreads();
#pragma unroll 1
    for (int n = n0; n < n1; ++n) {
        if (n + 1 < n1) GS_FETCH(n + 1);
        bf16x8 Sb[4];
#pragma unroll
        for (int ks = 0; ks < 4; ++ks) Sb[ks] = acc_bperm(S[2 * ks], S[2 * ks + 1]);
        f32x4 vn[4], o[4];
#pragma unroll
        for (int mt = 0; mt < 4; ++mt) { f32x4 p = (f32x4){0.f, 0.f, 0.f, 0.f}, q = (f32x4){0.f, 0.f, 0.f, 0.f};
            const LAS unsigned char* wrow = L + GS_W + (16 * mt + fr) * 272; const LAS unsigned char* qrow = L + GS_Q + (16 * mt + fr) * 272;
#pragma unroll
            for (int ks = 0; ks < 4; ++ks) { p = MFMA16(lds_aperm(wrow, 32 * ks, fq), Sb[ks], p); q = MFMA16(lds_aperm(qrow, 32 * ks, fq), Sb[ks], q); }
            const u32x2 uu = *(const LAS u32x2*)(L + GS_U + (16 * w + fr) * 144 + (16 * mt + 4 * fq) * 2);
            vn[mt][0] = bflo(uu.x) - p[0]; vn[mt][1] = bfhi(uu.x) - p[1]; vn[mt][2] = bflo(uu.y) - p[2]; vn[mt][3] = bfhi(uu.y) - p[3];
            o[mt] = q; }
        bf16x8 Vb[2];
#pragma unroll
        for (int ks = 0; ks < 2; ++ks) Vb[ks] = acc_bperm(vn[2 * ks], vn[2 * ks + 1]);
#pragma unroll
        for (int mt = 0; mt < 4; ++mt) { const LAS unsigned char* irow = L + GS_I + (16 * mt + fr) * 144;
#pragma unroll
            for (int ks = 0; ks < 2; ++ks) o[mt] = MFMA16(lds_aperm(irow, 32 * ks, fq), Vb[ks], o[mt]); }
#pragma unroll
        for (int d = 0; d < 8; ++d) { S[d] = S[d] * gl; const LAS unsigned char* krow = L + GS_K + (16 * d + fr) * 144;
#pragma unroll
            for (int ks = 0; ks < 2; ++ks) S[d] = MFMA16(lds_aperm(krow, 32 * ks, fq), Vb[ks], S[d]); }
        LAS float* sq = ssq + (n & 1) * 512;
        float zv[16];
#pragma unroll
        for (int mt = 0; mt < 4; ++mt)
#pragma unroll
            for (int r = 0; r < 4; ++r) { const float s = red16_dpp(o[mt][r] * o[mt][r]); if (fr == 0) sq[w * 64 + 16 * mt + 4 * fq + r] = s;
                zv[4 * mt + r] = bf2f(*(const LAS bf16_t*)(L + GS_Z + (16 * mt + 4 * fq + r) * 272 + (16 * w + fr) * 2)); }
        __syncthreads();
        if (n + 1 < n1) GS_STORE();
#pragma unroll
        for (int mt = 0; mt < 4; ++mt)
#pragma unroll
            for (int r = 0; r < 4; ++r) { const int t = 16 * mt + 4 * fq + r; float s = 0.f;
#pragma unroll
                for (int ww = 0; ww < 8; ++ww) s += sq[ww * 64 + t];
                const float rstd = rsqrtf(s * (1.f / 128.f) + NORM_EPS);
                const size_t m = (size_t)b * SEQ + (size_t)n * 64 + t;
                if (!dry) OAB[m * 1024 + h * 128 + 16 * w + fr] = (bf16_t)f2bf(o[mt][r] * rstd * gnw * siluf_(zv[4 * mt + r])); }
        gl = pgl;
        __syncthreads();
    }
#pragma unroll
    for (int d = 0; d < 8; ++d) if (!dry) GST[d * 64 + lane] = S[d];
#undef GS_FETCH
#undef GS_STORE
}
constexpr int RW_L = 16;
constexpr int RW_W2T = 0, RW_A2T = 9216, RW_G2T = 18432;
constexpr int RW_OPS = 35840, RW_OPS_SZ = 24576;
constexpr int RW_YB = RW_OPS + 2 * RW_OPS_SZ, RW_YB_SZ = 4096;
constexpr int RW_XS = RW_YB + 2 * RW_YB_SZ, RW_XS_W = 2240;
constexpr int RW_XS_AD = 576, RW_XS_GD = 1152;
constexpr int RW_POST = RW_XS + 4 * RW_XS_W, RW_POST_SZ = 8192;
static_assert(RW_POST + 3 * RW_POST_SZ <= XB_LDS_OFF, "rwkv lds");
#define RW_BAR() do { asm volatile("s_waitcnt lgkmcnt(0)" ::: "memory"); __builtin_amdgcn_s_barrier(); asm volatile("" ::: "memory"); } while (0)
__device__ __forceinline__ float wave_sum_rl(float v) {
    v = red16_dpp(v);
    const int i = __builtin_bit_cast(int, v);
    return (__builtin_bit_cast(float, __builtin_amdgcn_readlane(i, 0)) + __builtin_bit_cast(float, __builtin_amdgcn_readlane(i, 16))) + (__builtin_bit_cast(float, __builtin_amdgcn_readlane(i, 32)) + __builtin_bit_cast(float, __builtin_amdgcn_readlane(i, 48)));
}

__device__ __forceinline__ void rwkv_unit(const Frame& F, const Args& a, int bh) {
    const bf16_t* F0 = (const bf16_t*)(F.ws + WS_BIG);
    bf16_t* OAB = (bf16_t*)(F.ws + WS_XN);
    const int h = bh & 7, b = bh >> 3, tid = F.tid, lane = F.lane, wave = F.wave, fr = lane & 15, fq = lane >> 4;
    LAS unsigned char* L = F.lds;
    for (int idx = tid; idx < 64 * 64; idx += NTHREADS) { const int j = idx >> 6, c = idx & 63;
        *(LAS bf16_t*)(L + RW_W2T + c * 144 + j * 2) = (bf16_t)f2bf(a.in[IN_RW2][j * 512 + h * 64 + c]);
        *(LAS bf16_t*)(L + RW_A2T + c * 144 + j * 2) = (bf16_t)f2bf(a.in[IN_RA2][j * 512 + h * 64 + c]); }
    for (int idx = tid; idx < 128 * 64; idx += NTHREADS) { const int j = idx >> 6, c = idx & 63;
        *(LAS bf16_t*)(L + RW_G2T + c * 272 + j * 2) = (bf16_t)f2bf(a.in[IN_RG2][j * 512 + h * 64 + c]); }
    RW_BAR();
    const size_t mb = (size_t)b * SEQ;
    if (wave < 4) {
        f32x2 S0[4], S1[4];
#pragma unroll
        for (int k = 0; k < 4; ++k) { S0[k] = (f32x2){0.f, 0.f}; S1[k] = (f32x2){0.f, 0.f}; }
        const int cg = lane & 7, row0 = 16 * wave + 2 * (lane >> 3);
        RW_BAR();
#pragma unroll 1
        for (int c = 0; c < SEQ / RW_L; ++c) {
            LAS unsigned char* ops = L + RW_OPS + (c & 1) * RW_OPS_SZ; LAS float* yb = (LAS float*)(L + RW_YB + (c & 1) * RW_YB_SZ);
            f32x4 wA, wB, kkA, kkB, bA, bB, kA, kB, rA, rB; f32x2 vv;
#define RW_LOADOPS(s_) do { const LAS float* po_ = (const LAS float*)(ops + (s_) * 1536) + 8 * cg; \
                wA = *(const LAS f32x4*)(po_); wB = *(const LAS f32x4*)(po_ + 4); kkA = *(const LAS f32x4*)(po_ + 64); kkB = *(const LAS f32x4*)(po_ + 68); \
                bA = *(const LAS f32x4*)(po_ + 128); bB = *(const LAS f32x4*)(po_ + 132); kA = *(const LAS f32x4*)(po_ + 192); kB = *(const LAS f32x4*)(po_ + 196); \
                rA = *(const LAS f32x4*)(po_ + 256); rB = *(const LAS f32x4*)(po_ + 260); vv = *(const LAS f32x2*)((const LAS float*)(ops + (s_) * 1536) + 320 + row0); } while (0)
            RW_LOADOPS(0);
#pragma unroll 1
            for (int s = 0; s < RW_L; ++s) {
                const f32x2 kk2[4] = {{kkA[0], kkA[1]}, {kkA[2], kkA[3]}, {kkB[0], kkB[1]}, {kkB[2], kkB[3]}};
                const f32x2 w2[4] = {{wA[0], wA[1]}, {wA[2], wA[3]}, {wB[0], wB[1]}, {wB[2], wB[3]}};
                const f32x2 b2[4] = {{bA[0], bA[1]}, {bA[2], bA[3]}, {bB[0], bB[1]}, {bB[2], bB[3]}};
                const f32x2 k2[4] = {{kA[0], kA[1]}, {kA[2], kA[3]}, {kB[0], kB[1]}, {kB[2], kB[3]}};
                const f32x2 r2[4] = {{rA[0], rA[1]}, {rA[2], rA[3]}, {rB[0], rB[1]}, {rB[2], rB[3]}};
                const f32x2 v0 = {vv[0], vv[0]}, v1 = {vv[1], vv[1]};
                if (s + 1 < RW_L) RW_LOADOPS(s + 1);
                f32x2 a0 = S0[0] * kk2[0] + S0[1] * kk2[1], a1 = S1[0] * kk2[0] + S1[1] * kk2[1];
                a0 = a0 + S0[2] * kk2[2] + S0[3] * kk2[3]; a1 = a1 + S1[2] * kk2[2] + S1[3] * kk2[3];
                const float sa0 = red8_dpp(a0[0] + a0[1]), sa1 = red8_dpp(a1[0] + a1[1]);
                const f32x2 n0 = {-sa0, -sa0}, n1 = {-sa1, -sa1};
                f32x2 y0 = {0.f, 0.f}, y1 = {0.f, 0.f};
#pragma unroll
                for (int q = 0; q < 4; ++q) { S0[q] = S0[q] * w2[q] + n0 * b2[q] + v0 * k2[q]; S1[q] = S1[q] * w2[q] + n1 * b2[q] + v1 * k2[q]; y0 = y0 + S0[q] * r2[q]; y1 = y1 + S1[q] * r2[q]; }
                const float ys0 = red8_dpp(y0[0] + y0[1]), ys1 = red8_dpp(y1[0] + y1[1]);
                if (cg == 0) *(LAS f32x2*)(yb + s * 64 + row0) = (f32x2){ys0, ys1};
            }
#undef RW_LOADOPS
            RW_BAR();
        }
        RW_BAR();
    } else {
        const int p = wave - 4, hc = h * 64 + lane;
        LAS unsigned char* XS = L + RW_XS + p * RW_XS_W;
        const float w0c = a.in[IN_RW0][hc], a0c = a.in[IN_RA0][hc], kkc = a.in[IN_RKK][hc], kac = a.in[IN_RKA][hc], rkc = a.in[IN_RRK][hc], lnw = a.in[IN_RLNW][hc], lnb = a.in[IN_RLNB][hc];
        float mu[7];
#pragma unroll
        for (int g = 0; g < 3; ++g) mu[g] = a.in[IN_RMU][g * 512 + hc];
#pragma unroll
        for (int g = 3; g < 7; ++g) mu[g] = a.in[IN_RMU][1536 + (g - 3) * 64 + lane];
        bf16_t fv[5][7];
#define RW_FETCH(cn_) do { const long t0_ = (long)(cn_) * RW_L + 4 * p - 1; \
            _Pragma("unroll") for (int j_ = 0; j_ < 5; ++j_) { const long t_ = t0_ + j_; \
                _Pragma("unroll") for (int g_ = 0; g_ < 7; ++g_) { const int col_ = F0_RWKV + (g_ < 3 ? g_ * 512 + h * 64 : 1536 + (g_ - 3) * 64) + lane; fv[j_][g_] = (t_ >= 0) ? F0[(mb + t_) * F0_LD + col_] : (bf16_t)0; } } } while (0)
        RW_FETCH(0);
#pragma unroll 1
        for (int c = -1; c <= SEQ / RW_L; ++c) {
            const bool prep_on = (c + 1 < SEQ / RW_L), post_on = (c >= 1);
            if (post_on) {
                const LAS float* yb = (const LAS float*)(L + RW_YB + ((c - 1) & 1) * RW_YB_SZ); const LAS float* pg = (const LAS float*)(L + RW_POST + ((c - 1) % 3) * RW_POST_SZ);
#pragma unroll
                for (int j = 0; j < 4; ++j) { const int tau = 4 * p + j; const float y = yb[tau * 64 + lane];
                    const float mean = wave_sum_rl(y) * (1.f / 64.f); const float d = y - mean; const float var = wave_sum_rl(d * d) * (1.f / 64.f);
                    const float o = (d * rsqrtf(var + RWKV_LN_EPS) * lnw + lnb + pg[1024 + tau * 64 + lane]) * pg[tau * 64 + lane];
                    OAB[(mb + (size_t)(c - 1) * RW_L + tau) * 1024 + 512 + hc] = (bf16_t)f2bf(o); }
            }
            if (prep_on) {
                LAS unsigned char* nops = L + RW_OPS + ((c + 1) & 1) * RW_OPS_SZ; LAS float* pg_n = (LAS float*)(L + RW_POST + ((c + 1) % 3) * RW_POST_SZ);
                float xr[4], xk[4], xv[4];
#pragma unroll
                for (int j = 0; j < 4; ++j) {
                    float xs[7];
#pragma unroll
                    for (int g = 0; g < 7; ++g) { const float f = bf2f(fv[j + 1][g]), fp = bf2f(fv[j][g]); xs[g] = f + (fp - f) * mu[g]; }
                    xr[j] = xs[0]; xk[j] = xs[1]; xv[j] = xs[2];
                    *(LAS bf16_t*)(XS + j * 144 + lane * 2) = (bf16_t)f2bf(fast_tanhf(xs[3]));
                    *(LAS bf16_t*)(XS + RW_XS_AD + j * 144 + lane * 2) = (bf16_t)f2bf(xs[4]);
                    *(LAS bf16_t*)(XS + RW_XS_GD + j * 272 + lane * 2) = (bf16_t)f2bf(sigmoidf_(xs[5]));
                    *(LAS bf16_t*)(XS + RW_XS_GD + j * 272 + 128 + lane * 2) = (bf16_t)f2bf(sigmoidf_(xs[6]));
                }
                if (c + 2 < SEQ / RW_L) RW_FETCH(c + 2);
                asm volatile("s_waitcnt lgkmcnt(0)" ::: "memory");
                f32x4 cw = (f32x4){0.f, 0.f, 0.f, 0.f}, ca = cw, cgt = cw;
                {
                    bf16x8 xa[2], xb[2], xg[4];
#pragma unroll
                    for (int ks = 0; ks < 2; ++ks) { xa[ks] = *(const LAS bf16x8*)(XS + (fr & 3) * 144 + (32 * ks + 8 * fq) * 2); xb[ks] = *(const LAS bf16x8*)(XS + RW_XS_AD + (fr & 3) * 144 + (32 * ks + 8 * fq) * 2); }
#pragma unroll
                    for (int ks = 0; ks < 4; ++ks) xg[ks] = *(const LAS bf16x8*)(XS + RW_XS_GD + (fr & 3) * 272 + (32 * ks + 8 * fq) * 2);
#pragma unroll
                    for (int nt = 0; nt < 4; ++nt) {
                        f32x4 tw = (f32x4){0.f, 0.f, 0.f, 0.f}, ta = tw, tg = tw;
#pragma unroll
                        for (int ks = 0; ks < 2; ++ks) { tw = MFMA16(xa[ks], *(const LAS bf16x8*)(L + RW_W2T + (16 * nt + fr) * 144 + (32 * ks + 8 * fq) * 2), tw);
                                                         ta = MFMA16(xb[ks], *(const LAS bf16x8*)(L + RW_A2T + (16 * nt + fr) * 144 + (32 * ks + 8 * fq) * 2), ta); }
#pragma unroll
                        for (int ks = 0; ks < 4; ++ks) tg = MFMA16(xg[ks], *(const LAS bf16x8*)(L + RW_G2T + (16 * nt + fr) * 272 + (32 * ks + 8 * fq) * 2), tg);
                        if (fq == nt) { cw = tw; ca = ta; cgt = tg; }
                    }
                }
#pragma unroll
                for (int j = 0; j < 4; ++j) { const int tau = 4 * p + j; LAS float* o = (LAS float*)(nops + tau * 1536);
                    const float lw = cw[j] + w0c; const float wlog = -fast_softplusf(-lw) - 0.5f; const float wdec = __expf(-__expf(wlog));
                    const float av = sigmoidf_(ca[j] + a0c);
                    const float kkraw = xk[j] * kkc, kp = xk[j] * (1.f + (av - 1.f) * kac);
                    const float rinv = rsqrtf(wave_sum_rl(kkraw * kkraw) + 1e-6f);
                    const float bn = wave_sum_rl(xr[j] * kp * rkc);
                    const float kkn = kkraw * rinv;
                    o[lane] = wdec; o[64 + lane] = kkn; o[128 + lane] = kkn * av; o[192 + lane] = kp; o[256 + lane] = xr[j]; o[320 + lane] = xv[j];
                    pg_n[tau * 64 + lane] = cgt[j]; pg_n[1024 + tau * 64 + lane] = xv[j] * bn; }
            }
            RW_BAR();
        }
#undef RW_FETCH
    }
    __syncthreads();
}
constexpr int RC_KR = 0, RC_BKT = 4096, RC_VT = 8192, RC_MBB = 10240, RC_MKB = 11264, RC_MBR = 11776, RC_MKR = 12288, RC_WL = 12800, RC_PG = 13056, RC_PBV = 15104, RC_REC = 17408;
constexpr int RC_SEG_CHUNKS = 32, RC_NSEG = (SEQ / 16) / RC_SEG_CHUNKS;
constexpr size_t WS_RSCR = WS_R2 + 21 * MiB;
constexpr size_t WS_RSTATE = WS_R2 + 17 * MiB;
constexpr size_t WS_RIMG = WS_R2 + 20 * MiB;
constexpr int RP_PRM = 35840;
constexpr int RP_MU = RP_PRM + 1280;
constexpr int RP_WAVE = RP_MU + 1792, RP_WAVE_SZ = 9216;
static_assert(RP_WAVE + 8 * RP_WAVE_SZ <= XB_LDS_OFF, "rwkv prep lds");
__device__ __forceinline__ float dpp_shr_f(float v, const int n) {
    const int i = __builtin_bit_cast(int, v); int r;
    if (n == 1) r = __builtin_amdgcn_update_dpp(0, i, 0x111, 0xF, 0xF, true); else if (n == 2) r = __builtin_amdgcn_update_dpp(0, i, 0x112, 0xF, 0xF, true);
    else if (n == 4) r = __builtin_amdgcn_update_dpp(0, i, 0x114, 0xF, 0xF, true); else r = __builtin_amdgcn_update_dpp(0, i, 0x118, 0xF, 0xF, true);
    return __builtin_bit_cast(float, r);
}
__device__ __forceinline__ void rwkvc_prep_phase(const Frame& F, const Args& a, int sg) {
    const bf16_t* F0 = (const bf16_t*)(F.ws + WS_BIG);
    unsigned char* SCR = F.ws + WS_RSCR;
    const int tid = F.tid, wave = F.wave;
    LAS unsigned char* L = F.lds;
    for (int blk = F.bid; blk < 256; blk += F.G) {
        const int bh = blk >> 2, h = bh & 7, b = bh >> 3;
        __syncthreads();
        {
            const u32x4* src = (const u32x4*)(F.ws + WS_RIMG + (size_t)h * 35840);
            u32x4 t4[5];
#pragma unroll
            for (int i = 0; i < 5; ++i) { const int e = tid + NTHREADS * i; t4[i] = (e < 2240) ? src[e] : (u32x4){0u, 0u, 0u, 0u}; }
#pragma unroll
            for (int i = 0; i < 5; ++i) { const int e = tid + NTHREADS * i; if (e < 2240) *(LAS u32x4*)(L + e * 16) = t4[i]; }
        }
        if (tid < 320) { const int wh = tid >> 6, c = tid & 63; const float* src = wh == 0 ? a.in[IN_RW0] : wh == 1 ? a.in[IN_RA0] : wh == 2 ? a.in[IN_RKK] : wh == 3 ? a.in[IN_RKA] : a.in[IN_RRK];
            ((LAS float*)(L + RP_PRM))[tid] = src[h * 64 + c]; }
        if (tid < 448) ((LAS float*)(L + RP_MU))[tid] = a.in[IN_RMU][tid < 192 ? (tid >> 6) * 512 + h * 64 + (tid & 63) : 1536 + (tid - 192)];
        __syncthreads();
        const LAS float* PRM = (const LAS float*)(L + RP_PRM);
        LAS unsigned char* XS = L + RP_WAVE + wave * RP_WAVE_SZ;
        const size_t mb = (size_t)b * SEQ;
        {
            int ln_ = F.lane; asm volatile("" : "+v"(ln_));
            const int lane = ln_, fr = ln_ & 15, fq = ln_ >> 4;
            const int cs = (blk & 3) * 8 + wave;
            const int t0 = (sg * RC_SEG_CHUNKS + cs) * 16;
            unsigned char* rec = SCR + ((size_t)bh * RC_SEG_CHUNKS + cs) * RC_REC;
            const bf16_t* rowc = F0 + (mb + t0 + fr) * F0_LD + F0_RWKV;
            const bool hasp = (t0 + fr) > 0; const bf16_t* rowp = rowc - (hasp ? F0_LD : 0);
            const bf16_t* rc4 = rowc + 4 * fq; const bf16_t* rp4 = rowp + 4 * fq; const LAS float* mul4 = (const LAS float*)(L + RP_MU) + 4 * fq;
            unsigned char* pbkt = rec + RC_BKT + fq * 256 + (fr >> 2) * 16 + (fr & 3) * 2;
            unsigned char* pvt = rec + RC_VT + fq * 128 + fr * 2;
            unsigned char* pwl = rec + RC_WL + fq * 16;
            unsigned char* ppg = rec + RC_PG + fr * 128 + fq * 8;
            LAS unsigned char* xs4 = XS + fr * 144 + fq * 8;
            u32x2 rawc[7][4], rawp[7][4];
#pragma unroll
            for (int g = 3; g < 7; ++g)
#pragma unroll
                for (int mt = 0; mt < 4; ++mt) { const int coff = 1536 + 64 * (g - 3) + 16 * mt; rawc[g][mt] = *(const u32x2*)(rc4 + coff); rawp[g][mt] = *(const u32x2*)(rp4 + coff); }
#pragma unroll
            for (int g = 0; g < 4; ++g) {
                const int coff = 1536 + 64 * g;
#pragma unroll
                for (int mt = 0; mt < 4; ++mt) { const int j0 = 16 * mt + 4 * fq;
                    const u32x2 fc = rawc[3 + g][mt]; u32x2 fp = rawp[3 + g][mt]; if (!hasp) fp = (u32x2){0u, 0u};
                    const f32x4 mu = *(const LAS f32x4*)(mul4 + 192 + 64 * g + 16 * mt);
                    float x[4] = {bflo(fc.x), bfhi(fc.x), bflo(fc.y), bfhi(fc.y)}; const float xp[4] = {bflo(fp.x), bfhi(fp.x), bflo(fp.y), bfhi(fp.y)};
#pragma unroll
                    for (int e = 0; e < 4; ++e) { x[e] = x[e] + (xp[e] - x[e]) * mu[e]; x[e] = (g == 0) ? fast_tanhf(x[e]) : (g == 1) ? x[e] : sigmoidf_(x[e]); }
                    u32x2 o; o.x = pk2(x[0], x[1]); o.y = pk2(x[2], x[3]);
                    LAS unsigned char* dst = (g == 0) ? XS + fr * 144 + j0 * 2 : (g == 1) ? XS + 2304 + fr * 144 + j0 * 2 : XS + 4608 + fr * 272 + (g - 2) * 128 + j0 * 2;
                    *(LAS u32x2*)dst = o; } }
#pragma unroll
            for (int g = 0; g < 3; ++g)
#pragma unroll
                for (int mt = 0; mt < 4; ++mt) { const int coff = g * 512 + h * 64 + 16 * mt; rawc[g][mt] = *(const u32x2*)(rc4 + coff); rawp[g][mt] = *(const u32x2*)(rp4 + coff); }
            asm volatile("s_waitcnt lgkmcnt(0)" ::: "memory");
            float vr[16], vk[16], vv[16], ve[16], vkk[16], vb[16];
            float ss = 0.f, bn = 0.f;
            bf16x8 xw[2], xa[2], xg[4];
#pragma unroll
            for (int ks = 0; ks < 2; ++ks) { xw[ks] = *(const LAS bf16x8*)(XS + fr * 144 + (32 * ks + 8 * fq) * 2); xa[ks] = *(const LAS bf16x8*)(XS + 2304 + fr * 144 + (32 * ks + 8 * fq) * 2); }
#pragma unroll
            for (int ks = 0; ks < 4; ++ks) xg[ks] = *(const LAS bf16x8*)(XS + 4608 + fr * 272 + (32 * ks + 8 * fq) * 2);
#pragma unroll
            for (int mt = 0; mt < 4; ++mt) {
#pragma unroll
                for (int g = 0; g < 3; ++g) { const int coff = g * 512 + 16 * mt;
                    const u32x2 fc = rawc[g][mt]; u32x2 fp = rawp[g][mt]; if (!hasp) fp = (u32x2){0u, 0u};
                    const f32x4 mu = *(const LAS f32x4*)(mul4 + 64 * g + 16 * mt);
                    const float x[4] = {bflo(fc.x), bfhi(fc.x), bflo(fc.y), bfhi(fc.y)}; const float xp[4] = {bflo(fp.x), bfhi(fp.x), bflo(fp.y), bfhi(fp.y)};
#pragma unroll
                    for (int e = 0; e < 4; ++e) { const float xs = x[e] + (xp[e] - x[e]) * mu[e]; if (g == 0) vr[4 * mt + e] = xs; else if (g == 1) vk[4 * mt + e] = xs; else vv[4 * mt + e] = xs; } }
                f32x4 cw = (f32x4){0.f, 0.f, 0.f, 0.f}, ca = cw, cg = cw;
#pragma unroll
                for (int ks = 0; ks < 2; ++ks) { cw = MFMA16(*(const LAS bf16x8*)(L + RW_W2T + (16 * mt + fr) * 144 + (32 * ks + 8 * fq) * 2), xw[ks], cw);
                                                 ca = MFMA16(*(const LAS bf16x8*)(L + RW_A2T + (16 * mt + fr) * 144 + (32 * ks + 8 * fq) * 2), xa[ks], ca); }
#pragma unroll
                for (int ks = 0; ks < 4; ++ks) cg = MFMA16(*(const LAS bf16x8*)(L + RW_G2T + (16 * mt + fr) * 272 + (32 * ks + 8 * fq) * 2), xg[ks], cg);
#pragma unroll
                for (int r = 0; r < 4; ++r) { const int q = 4 * mt + r, c = 16 * mt + 4 * fq + r;
                    const float lw = cw[r] + PRM[c]; ve[q] = 0.6065306597126334f * sigmoidf_(lw);
                    const float av = sigmoidf_(ca[r] + PRM[64 + c]);
                    const float kraw = vk[q] * PRM[128 + c]; vk[q] = vk[q] * (1.f + (av - 1.f) * PRM[192 + c]);
                    vkk[q] = kraw; vb[q] = av; ss += kraw * kraw; bn += vr[q] * vk[q] * PRM[256 + c]; }
                { u32x2 og; og.x = pk2(cg[0], cg[1]); og.y = pk2(cg[2], cg[3]); *(u32x2*)(ppg + mt * 32) = og; }
                asm volatile("" ::: "memory");
            }
            ss += __shfl_xor(ss, 16); ss += __shfl_xor(ss, 32); bn += __shfl_xor(bn, 16); bn += __shfl_xor(bn, 32);
            const float rinv = rsqrtf(ss + 1e-6f);
#pragma unroll
            for (int mt = 0; mt < 4; ++mt) { u32x2 ob; ob.x = pk2(vv[4 * mt] * bn, vv[4 * mt + 1] * bn); ob.y = pk2(vv[4 * mt + 2] * bn, vv[4 * mt + 3] * bn); *(u32x2*)(ppg + 2048 + mt * 32) = ob; }
#pragma unroll
            for (int ks = 0; ks < 2; ++ks) {
                float kkt[8], rt[8], bh_[8], kh[8];
#pragma unroll
                for (int i = 0; i < 8; ++i) { const int q = 8 * ks + i;
                    float cl = ve[q];
                    cl += dpp_shr_f(cl, 1); cl += dpp_shr_f(cl, 2); cl += dpp_shr_f(cl, 4); cl += dpp_shr_f(cl, 8);
                    const float clL = __shfl(cl, (lane & 48) | 15);
                    const float kkn = vkk[q] * rinv, bq = kkn * vb[q];
                    const float W = __expf(-cl), Wp = __expf(ve[q] - cl), Wi = __expf(cl), WLr = __expf(cl - clL);
                    kkt[i] = kkn * Wp; rt[i] = vr[q] * W; bh_[i] = bq * Wi; kh[i] = vk[q] * Wi;
                    *(bf16_t*)(pbkt + (q >> 2) * 1024 + (q & 3) * 64) = (bf16_t)f2bf(-bq * WLr);
                    *(bf16_t*)(pbkt + (q >> 2) * 1024 + (q & 3) * 64 + 8) = (bf16_t)f2bf(vk[q] * WLr);
                    *(bf16_t*)(pvt + (q >> 2) * 512 + (q & 3) * 32) = (bf16_t)f2bf(vv[q]);
                    if (fr == 15) *(float*)(pwl + (q >> 2) * 64 + (q & 3) * 4) = W;
                }
                u32x4 o1, o2;
                o1.x = pk2(kkt[0], kkt[1]); o1.y = pk2(kkt[2], kkt[3]); o1.z = pk2(kkt[4], kkt[5]); o1.w = pk2(kkt[6], kkt[7]);
                o2.x = pk2(rt[0], rt[1]); o2.y = pk2(rt[2], rt[3]); o2.z = pk2(rt[4], rt[5]); o2.w = pk2(rt[6], rt[7]);
                *(u32x4*)(rec + RC_KR + fr * 128 + ks * 64 + fq * 16) = o1; *(u32x4*)(rec + RC_KR + 2048 + fr * 128 + ks * 64 + fq * 16) = o2;
#pragma unroll
                for (int m2 = 0; m2 < 2; ++m2) { const int mt = 2 * ks + m2; LAS unsigned char* xo = xs4 + mt * 32;
                    *(LAS u32x2*)(xo) = (u32x2){o1[2 * m2], o1[2 * m2 + 1]};
                    *(LAS u32x2*)(xo + 2304) = (u32x2){o2[2 * m2], o2[2 * m2 + 1]};
                    u32x2 o; o.x = pk2(bh_[4 * m2], bh_[4 * m2 + 1]); o.y = pk2(bh_[4 * m2 + 2], bh_[4 * m2 + 3]); *(LAS u32x2*)(xo + 4608) = o;
                    o.x = pk2(kh[4 * m2], kh[4 * m2 + 1]); o.y = pk2(kh[4 * m2 + 2], kh[4 * m2 + 3]); *(LAS u32x2*)(xo + 6912) = o; }
                asm volatile("" ::: "memory");
            }
            asm volatile("s_waitcnt lgkmcnt(0)" ::: "memory");
            f32x4 mbb = (f32x4){0.f, 0.f, 0.f, 0.f}, mkb = mbb, mbr = mbb, mkr = mbb;
#pragma unroll
            for (int ks = 0; ks < 2; ++ks) { const int off = fr * 144 + (32 * ks + 8 * fq) * 2;
                const bf16x8 akk = *(const LAS bf16x8*)(XS + off), ar = *(const LAS bf16x8*)(XS + 2304 + off), bb = *(const LAS bf16x8*)(XS + 4608 + off), bk = *(const LAS bf16x8*)(XS + 6912 + off);
                mbb = MFMA16(akk, bb, mbb); mkb = MFMA16(akk, bk, mkb); mbr = MFMA16(ar, bb, mbr); mkr = MFMA16(ar, bk, mkr); }
            {
                float T[16]; const float mf0 = mbb[0], mf1 = mbb[1], mf2 = mbb[2], mf3 = mbb[3];
                const int mb_[4] = {__builtin_bit_cast(int, mf0), __builtin_bit_cast(int, mf1), __builtin_bit_cast(int, mf2), __builtin_bit_cast(int, mf3)};
#pragma unroll
                for (int t = 0; t < 16; ++t) T[t] = (t == fr) ? 1.f : 0.f;
#pragma unroll
                for (int t = 1; t < 16; ++t) { float s0 = T[t], s1 = 0.f;
#pragma unroll
                    for (int j = 0; j < t; ++j) { const float m = __builtin_bit_cast(float, __builtin_amdgcn_readlane(mb_[t & 3], j + 16 * (t >> 2)));
                        if (j & 1) s1 -= m * T[j]; else s0 -= m * T[j]; }
                    T[t] = s0 + s1; }
                if (fq == 0) {
#pragma unroll
                    for (int t = 0; t < 16; ++t) { const bf16_t tv = (bf16_t)f2bf(T[t]); *(bf16_t*)(rec + RC_MBB + t * 64 + (fr >> 2) * 16 + (fr & 3) * 2) = tv; *(bf16_t*)(rec + RC_MBB + t * 64 + (fr >> 2) * 16 + 8 + (fr & 3) * 2) = tv; }
                }
            }
#pragma unroll
            for (int r = 0; r < 4; ++r) { const int t = 4 * fq + r, j = fr;
                *(bf16_t*)(rec + RC_MKB + t * 32 + j * 2) = (bf16_t)f2bf((j < t) ? mkb[r] : 0.f);
                *(bf16_t*)(rec + RC_MBR + t * 32 + j * 2) = (bf16_t)f2bf((j <= t) ? mbr[r] : 0.f);
                *(bf16_t*)(rec + RC_MKR + t * 32 + j * 2) = (bf16_t)f2bf((j <= t) ? mkr[r] : 0.f); }
            asm volatile("s_waitcnt lgkmcnt(0)" ::: "memory");
        }
    }
}

constexpr int RCH_X = 0;
constexpr int RCH_ST = 4096;
constexpr int RCH_RING = 8192, RCH_NSLOT = 6, RCH_PF = 5;
static_assert(RCH_RING + RCH_NSLOT * RC_REC <= XB_LDS_OFF, "rwkv chain lds");
#define RCH_BAR() do { asm volatile("s_waitcnt lgkmcnt(0)" ::: "memory"); __builtin_amdgcn_s_barrier(); asm volatile("" ::: "memory"); } while (0)
__device__ __forceinline__ void rwkvc_chain_unit(const Frame& F, const Args& a, int bh, int sg, bool dry = false) {
    const unsigned char* SCR = F.ws + WS_RSCR;
    bf16_t* OAB = (bf16_t*)(F.ws + WS_XN); f32x4* STATE = (f32x4*)(F.ws + WS_RSTATE);
    const int lane = F.lane, w = F.wave, fr = lane & 15, fq = lane >> 4, h = bh & 7, b = bh >> 3;
    LAS unsigned char* L = F.lds;
    const size_t mb = (size_t)b * SEQ;
    const unsigned char* seg = SCR + ((size_t)bh * RC_SEG_CHUNKS) * RC_REC;
    if (w >= 4) {
        const int p = w - 4;
#define RCH_ISSUE(ch_) do { int l16_ = lane * 16; asm volatile("" : "+v"(l16_)); const unsigned char* src_ = seg + (size_t)(ch_) * RC_REC + l16_; LAS unsigned char* dst_ = L + RCH_RING + ((ch_) % RCH_NSLOT) * RC_REC; \
            _Pragma("unroll") for (int i_ = 0; i_ < 5; ++i_) { const int pc_ = p + 4 * i_; if (pc_ < 17) __builtin_amdgcn_global_load_lds((const unsigned*)(src_ + pc_ * 1024), (LAS unsigned*)(dst_ + pc_ * 1024), 16, 0, 0); } } while (0)
#pragma unroll 1
        for (int ch = 0; ch < RCH_PF; ++ch) RCH_ISSUE(ch);
        if (p == 0) asm volatile("s_waitcnt vmcnt(20)" ::: "memory"); else asm volatile("s_waitcnt vmcnt(16)" ::: "memory");
        RCH_BAR();
#pragma unroll 1
        for (int cs = 0; cs < RC_SEG_CHUNKS; ++cs) {
            if (cs + RCH_PF < RC_SEG_CHUNKS) { RCH_ISSUE(cs + RCH_PF);
                if (p == 0) asm volatile("s_waitcnt vmcnt(20)" ::: "memory"); else asm volatile("s_waitcnt vmcnt(16)" ::: "memory"); }
            else asm volatile("s_waitcnt vmcnt(0)" ::: "memory");
            RCH_BAR();
        }
#undef RCH_ISSUE
    } else {
        LAS float* XT = (LAS float*)(L + RCH_X + w * 1024); LAS float* STT = (LAS float*)(L + RCH_ST);
        f32x4 acc[4];
#pragma unroll
        for (int mt = 0; mt < 4; ++mt) acc[mt] = (sg == 0) ? (f32x4){0.f, 0.f, 0.f, 0.f} : STATE[((size_t)bh * 4 + w) * 256 + mt * 64 + lane];
        const int v = 16 * w + fr, hc = h * 64 + v;
        const float lnw = a.in[IN_RLNW][hc], lnb = a.in[IN_RLNB][hc];
        RCH_BAR();
#pragma unroll 1
        for (int cs = 0; cs < RC_SEG_CHUNKS; ++cs) {
            const LAS unsigned char* rec = L + RCH_RING + (cs % RCH_NSLOT) * RC_REC;
            const u32x4 z4 = (u32x4){0u, 0u, 0u, 0u}; const int f2 = fq & 1;
            bf16x8 sb[2];
#pragma unroll
            for (int ks = 0; ks < 2; ++ks) { u32x4 pk; pk.x = pk2(acc[2 * ks][0], acc[2 * ks][1]); pk.y = pk2(acc[2 * ks][2], acc[2 * ks][3]); pk.z = pk2(acc[2 * ks + 1][0], acc[2 * ks + 1][1]); pk.w = pk2(acc[2 * ks + 1][2], acc[2 * ks + 1][3]); sb[ks] = __builtin_bit_cast(bf16x8, pk); }
            f32x4 rhs = (f32x4){0.f, 0.f, 0.f, 0.f}, y1 = rhs;
#pragma unroll
            for (int ks = 0; ks < 2; ++ks) { rhs = MFMA16(*(const LAS bf16x8*)(rec + RC_KR + fr * 128 + ks * 64 + fq * 16), sb[ks], rhs); y1 = MFMA16(*(const LAS bf16x8*)(rec + RC_KR + 2048 + fr * 128 + ks * 64 + fq * 16), sb[ks], y1); }
            u32x4 vt8 = *(const LAS u32x4*)(rec + RC_VT + v * 32 + f2 * 16), mkb = *(const LAS u32x4*)(rec + RC_MKB + fr * 32 + f2 * 16), mkr = *(const LAS u32x4*)(rec + RC_MKR + fr * 32 + f2 * 16), mbr = *(const LAS u32x4*)(rec + RC_MBR + fr * 32 + f2 * 16);
            if (fq >= 2) { vt8 = z4; mkb = z4; mkr = z4; mbr = z4; }
            rhs = MFMA16(__builtin_bit_cast(bf16x8, mkb), __builtin_bit_cast(bf16x8, vt8), rhs);
            y1 = MFMA16(__builtin_bit_cast(bf16x8, mkr), __builtin_bit_cast(bf16x8, vt8), y1);
            f32x4 u4;
            { u32x4 rb; rb.x = pk2(rhs[0], rhs[1]); rb.y = pk2(rhs[2], rhs[3]); rb.z = 0u; rb.w = 0u;
              const f32x4 zf = {0.f, 0.f, 0.f, 0.f}; u4 = MFMA16(*(const LAS bf16x8*)(rec + RC_MBB + fr * 64 + fq * 16), __builtin_bit_cast(bf16x8, rb), zf); }
            *(LAS f32x4*)(XT + fr * 16 + 4 * fq) = u4;
            asm volatile("s_waitcnt lgkmcnt(0)" ::: "memory");
            u32x4 ub;
            { const f32x4 ua = *(const LAS f32x4*)(XT + fr * 16 + 8 * f2), ubb = *(const LAS f32x4*)(XT + fr * 16 + 8 * f2 + 4);
              ub.x = pk2(ua[0], ua[1]); ub.y = pk2(ua[2], ua[3]); ub.z = pk2(ubb[0], ubb[1]); ub.w = pk2(ubb[2], ubb[3]); if (fq >= 2) ub = z4; }
            f32x4 yv = (f32x4){0.f, 0.f, 0.f, 0.f};
            yv = MFMA16(__builtin_bit_cast(bf16x8, mbr), __builtin_bit_cast(bf16x8, ub), yv);
            const f32x4 y = y1 - yv;
            u32x4 uvb; const u32x2 vt4 = *(const LAS u32x2*)(rec + RC_VT + v * 32 + fq * 8);
            uvb.x = pk2(u4[0], u4[1]); uvb.y = pk2(u4[2], u4[3]);
            uvb.z = vt4.x; uvb.w = vt4.y;
#pragma unroll
            for (int mt = 0; mt < 4; ++mt) { const f32x4 wl = *(const LAS f32x4*)(rec + RC_WL + (16 * mt + 4 * fq) * 4);
                acc[mt] = MFMA16(*(const LAS bf16x8*)(rec + RC_BKT + (16 * mt + fr) * 64 + fq * 16), __builtin_bit_cast(bf16x8, uvb), acc[mt] * wl); }
            float pgv[4], pbv[4];
#pragma unroll
            for (int r = 0; r < 4; ++r) { pgv[r] = bf2f(*(const LAS bf16_t*)(rec + RC_PG + (4 * fq + r) * 128 + v * 2)); pbv[r] = bf2f(*(const LAS bf16_t*)(rec + RC_PBV + (4 * fq + r) * 128 + v * 2)); }
            LAS float* st = STT + (cs & 1) * 128;
#pragma unroll
            for (int r = 0; r < 4; ++r) { const float s1 = red16_dpp(y[r]), s2 = red16_dpp(y[r] * y[r]); if (fr == 0) { st[(w * 16 + 4 * fq + r) * 2] = s1; st[(w * 16 + 4 * fq + r) * 2 + 1] = s2; } }
            RCH_BAR();
#pragma unroll
            for (int r = 0; r < 4; ++r) { const int t = 4 * fq + r; float s1 = 0.f, s2 = 0.f;
#pragma unroll
                for (int ww = 0; ww < 4; ++ww) { const f32x2 sv = *(const LAS f32x2*)(st + (ww * 16 + t) * 2); s1 += sv[0]; s2 += sv[1]; }
                const float mean = s1 * (1.f / 64.f), var = fmaxf(s2 * (1.f / 64.f) - mean * mean, 0.f);
                const float o = ((y[r] - mean) * rsqrtf(var + RWKV_LN_EPS) * lnw + lnb + pbv[r]) * pgv[r];
                if (!dry) OAB[(mb + (size_t)(sg * RC_SEG_CHUNKS + cs) * 16 + t) * 1024 + 512 + hc] = (bf16_t)f2bf(o); }
        }
#pragma unroll
        for (int mt = 0; mt < 4; ++mt) if (!dry) STATE[((size_t)bh * 4 + w) * 256 + mt * 64 + lane] = acc[mt];
    }
    __syncthreads();
}

__device__ __forceinline__ void rwkvc_build_images(const Frame& F, const Args& a) {
    const int gt = F.bid * NTHREADS + F.tid, NT = F.G * NTHREADS;
    for (int e = gt; e < 8 * 256 * 64; e += NT) {
        const int c = e & 63, jj = (e >> 6) & 255, h = e >> 14;
        unsigned char* img = F.ws + WS_RIMG + (size_t)h * 35840;
        if (jj < 64) *(bf16_t*)(img + RW_W2T + c * 144 + jj * 2) = (bf16_t)f2bf(a.in[IN_RW2][jj * 512 + h * 64 + c]);
        else if (jj < 128) *(bf16_t*)(img + RW_A2T + c * 144 + (jj - 64) * 2) = (bf16_t)f2bf(a.in[IN_RA2][(jj - 64) * 512 + h * 64 + c]);
        else *(bf16_t*)(img + RW_G2T + c * 272 + (jj - 128) * 2) = (bf16_t)f2bf(a.in[IN_RG2][(jj - 128) * 512 + h * 64 + c]);
    }
}
__device__ __forceinline__ void row_pass(const Frame& F, const bf16_t* mix, const float* resid, const float* w_post, float* hout, const float* w_next, bf16_t* xn) {
    const int gw = F.bid * NWAVES + F.wave, NGW = F.G * NWAVES, lane = F.lane;
    for (int mA = gw; mA < MTOK; mA += 2 * NGW) {
        const int mB = (mA + NGW < MTOK) ? mA + NGW : mA; const bool two = (mB != mA);
        const u32x2* mrA = (const u32x2*)(mix + (size_t)mA * D_MODEL) + lane; const f32x4* rrA = (const f32x4*)(resid + (size_t)mA * D_MODEL) + lane;
        const u32x2* mrB = (const u32x2*)(mix + (size_t)mB * D_MODEL) + lane; const f32x4* rrB = (const f32x4*)(resid + (size_t)mB * D_MODEL) + lane;
        u32x2 pa[4], pb[4]; f32x4 ha[4], hb[4];
#pragma unroll
        for (int j = 0; j < 4; ++j) { pa[j] = mrA[64 * j]; pb[j] = mrB[64 * j]; ha[j] = rrA[64 * j]; hb[j] = rrB[64 * j]; }
        f32x4 va[4], vb[4]; float sa = 0.f, sb = 0.f;
#pragma unroll
        for (int j = 0; j < 4; ++j) { va[j] = (f32x4){bflo(pa[j].x), bfhi(pa[j].x), bflo(pa[j].y), bfhi(pa[j].y)}; vb[j] = (f32x4){bflo(pb[j].x), bfhi(pb[j].x), bflo(pb[j].y), bfhi(pb[j].y)};
            sa += (va[j].x * va[j].x + va[j].y * va[j].y) + (va[j].z * va[j].z + va[j].w * va[j].w); sb += (vb[j].x * vb[j].x + vb[j].y * vb[j].y) + (vb[j].z * vb[j].z + vb[j].w * vb[j].w); }
        const float ra = 1.f / sqrtf(wave_sum(sa) * (1.f / D_MODEL) + NORM_EPS), rb = 1.f / sqrtf(wave_sum(sb) * (1.f / D_MODEL) + NORM_EPS);
        float s2a = 0.f, s2b = 0.f;
#pragma unroll
        for (int j = 0; j < 4; ++j) { const f32x4 g = ((const f32x4*)w_post)[lane + 64 * j]; ha[j] = ha[j] + va[j] * ra * g; hb[j] = hb[j] + vb[j] * rb * g;
            s2a += (ha[j].x * ha[j].x + ha[j].y * ha[j].y) + (ha[j].z * ha[j].z + ha[j].w * ha[j].w); s2b += (hb[j].x * hb[j].x + hb[j].y * hb[j].y) + (hb[j].z * hb[j].z + hb[j].w * hb[j].w); }
        f32x4* hoA = (f32x4*)(hout + (size_t)mA * D_MODEL) + lane; f32x4* hoB = (f32x4*)(hout + (size_t)mB * D_MODEL) + lane;
#pragma unroll
        for (int j = 0; j < 4; ++j) { hoA[64 * j] = ha[j]; if (two) hoB[64 * j] = hb[j]; }
        if (w_next) {
            const float qa = 1.f / sqrtf(wave_sum(s2a) * (1.f / D_MODEL) + NORM_EPS), qb = 1.f / sqrtf(wave_sum(s2b) * (1.f / D_MODEL) + NORM_EPS);
            unsigned long long* oA = (unsigned long long*)(xn + (size_t)mA * D_MODEL) + lane; unsigned long long* oB = (unsigned long long*)(xn + (size_t)mB * D_MODEL) + lane;
#pragma unroll
            for (int j = 0; j < 4; ++j) { const f32x4 g = ((const f32x4*)w_next)[lane + 64 * j];
                oA[64 * j] = (unsigned long long)pk2(ha[j].x * qa * g.x, ha[j].y * qa * g.y) | ((unsigned long long)pk2(ha[j].z * qa * g.z, ha[j].w * qa * g.w) << 32);
                if (two) oB[64 * j] = (unsigned long long)pk2(hb[j].x * qb * g.x, hb[j].y * qb * g.y) | ((unsigned long long)pk2(hb[j].z * qb * g.z, hb[j].w * qb * g.w) << 32); }
        }
    }
}
constexpr size_t B1_ACMPK = 128 * MiB, B1_ACMPV = 144 * MiB, B1_KS = 160 * MiB, B1_VST = 168 * MiB, B1_KW = 176 * MiB, B1_VWT = 184 * MiB, B1_QR = 192 * MiB;
constexpr size_t R2_HCMP = 0, R2_KC = 8 * MiB, R2_VCT = 9 * MiB, R2_SEL = 12 * MiB;
__device__ __constant__ float ROPE_INVF[8] = {1.0f, 0.1939227432012558f, 0.03760603070259094f, 0.007292664609849453f, 0.0014142135623842478f, 0.00027424818836152554f, 5.3182957344688475e-05f, 1.0313385246263351e-05f};

__device__ __forceinline__ void nsa_prep_phase(const Frame& F, const Args& a) {
    const bf16_t* F1 = (const bf16_t*)(F.ws + WS_BIG);
    bf16_t* ACMPK = (bf16_t*)(F.ws + WS_BIG + B1_ACMPK); bf16_t* ACMPV = (bf16_t*)(F.ws + WS_BIG + B1_ACMPV);
    bf16_t* KS = (bf16_t*)(F.ws + WS_BIG + B1_KS); bf16_t* VST = (bf16_t*)(F.ws + WS_BIG + B1_VST); bf16_t* KW = (bf16_t*)(F.ws + WS_BIG + B1_KW); bf16_t* VWT = (bf16_t*)(F.ws + WS_BIG + B1_VWT);
    bf16_t* QR = (bf16_t*)(F.ws + WS_BIG + B1_QR);
    const int* pos = (const int*)a.in[IN_POS];
    const int lane = F.lane, wave = F.wave, tid = F.tid;
    LAS unsigned char* Lvs = F.lds;
    LAS unsigned char* Lvw = F.lds + 16384;
    for (int u = F.bid; u < BATCH * 64; u += F.G) {
        const int b = u >> 6, blk = u & 63;
#pragma unroll 1
        for (int tt = 0; tt < 8; ++tt) {
            const int tl = 8 * wave + tt, t = blk * 64 + tl; const size_t m = (size_t)b * SEQ + t;
            const float p = (float)pos[m];
            const float ang = p * ROPE_INVF[lane & 7];
            const float cs = __cosf(ang), sn = __sinf(ang);
            const bf16_t* row = F1 + m * F1_LD;
            { const int hh = lane >> 2, qd = lane & 3; const u32x4 v0 = *(const u32x4*)(row + hh * 64 + qd * 16), v1 = *(const u32x4*)(row + hh * 64 + qd * 16 + 8);
              u32x4 o0 = v0, o1 = v1;
              float x1[8], x2[8], c8[8], s8[8];
#pragma unroll
              for (int i = 0; i < 8; ++i) { c8[i] = __shfl(cs, i); s8[i] = __shfl(sn, i); }
              if (qd == 0) {
                  x1[0] = bflo(v0.x); x1[1] = bfhi(v0.x); x1[2] = bflo(v0.y); x1[3] = bfhi(v0.y); x1[4] = bflo(v0.z); x1[5] = bfhi(v0.z); x1[6] = bflo(v0.w); x1[7] = bfhi(v0.w);
                  x2[0] = bflo(v1.x); x2[1] = bfhi(v1.x); x2[2] = bflo(v1.y); x2[3] = bfhi(v1.y); x2[4] = bflo(v1.z); x2[5] = bfhi(v1.z); x2[6] = bflo(v1.w); x2[7] = bfhi(v1.w);
                  float y1[8], y2[8];
#pragma unroll
                  for (int i = 0; i < 8; ++i) { y1[i] = x1[i] * c8[i] - x2[i] * s8[i]; y2[i] = x2[i] * c8[i] + x1[i] * s8[i]; }
                  o0.x = pk2(y1[0], y1[1]); o0.y = pk2(y1[2], y1[3]); o0.z = pk2(y1[4], y1[5]); o0.w = pk2(y1[6], y1[7]);
                  o1.x = pk2(y2[0], y2[1]); o1.y = pk2(y2[2], y2[3]); o1.z = pk2(y2[4], y2[5]); o1.w = pk2(y2[6], y2[7]); }
              *(u32x4*)(QR + m * 1024 + hh * 64 + qd * 16) = o0; *(u32x4*)(QR + m * 1024 + hh * 64 + qd * 16 + 8) = o1;
            }
            const int g = lane >> 5, d = 2 * (lane & 31); const int bg = b * 2 + g;
            const unsigned kc = *(const unsigned*)(row + 1024 + 0 * 128 + g * 64 + d), vc = *(const unsigned*)(row + 1024 + 1 * 128 + g * 64 + d);
            unsigned ks = *(const unsigned*)(row + 1024 + 2 * 128 + g * 64 + d); const unsigned vs = *(const unsigned*)(row + 1024 + 3 * 128 + g * 64 + d);
            unsigned kw = *(const unsigned*)(row + 1024 + 4 * 128 + g * 64 + d); const unsigned vw = *(const unsigned*)(row + 1024 + 5 * 128 + g * 64 + d);
            {
              const int l5 = lane & 31; const bool x1role = l5 < 4; const int i0 = 2 * (l5 & 3);
              const float c0 = __shfl(cs, i0), c1 = __shfl(cs, i0 + 1), s0 = __shfl(sn, i0), s1 = __shfl(sn, i0 + 1);
              const unsigned oks = __shfl_xor(ks, 4), okw = __shfl_xor(kw, 4);
              if (l5 < 8) { const float sg = x1role ? -1.f : 1.f;
                  ks = pk2(bflo(ks) * c0 + sg * bflo(oks) * s0, bfhi(ks) * c1 + sg * bfhi(oks) * s1);
                  kw = pk2(bflo(kw) * c0 + sg * bflo(okw) * s0, bfhi(kw) * c1 + sg * bfhi(okw) * s1); } }
            *(unsigned*)(KS + ((size_t)bg * SEQ + t) * 64 + d) = ks; *(unsigned*)(KW + ((size_t)bg * SEQ + t) * 64 + d) = kw;
            *(LAS unsigned*)(Lvs + tl * 256 + lane * 4) = vs; *(LAS unsigned*)(Lvw + tl * 256 + lane * 4) = vw;
            {
              const int i0 = t >> 4, s0 = t & 15;
              const float* pek = a.in[IN_NPEK]; const float* pev = a.in[IN_NPEV];
              if (i0 < 255) { *(unsigned*)(ACMPK + ((size_t)bg * 256 + i0) * 2048 + s0 * 64 + d) = pk2(bflo(kc) + pek[s0 * 64 + d], bfhi(kc) + pek[s0 * 64 + d + 1]);
                              *(unsigned*)(ACMPV + ((size_t)bg * 256 + i0) * 2048 + s0 * 64 + d) = pk2(bflo(vc) + pev[s0 * 64 + d], bfhi(vc) + pev[s0 * 64 + d + 1]); }
              if (i0 >= 1) { const int s1 = 16 + s0;
                              *(unsigned*)(ACMPK + ((size_t)bg * 256 + i0 - 1) * 2048 + s1 * 64 + d) = pk2(bflo(kc) + pek[s1 * 64 + d], bfhi(kc) + pek[s1 * 64 + d + 1]);
                              *(unsigned*)(ACMPV + ((size_t)bg * 256 + i0 - 1) * 2048 + s1 * 64 + d) = pk2(bflo(vc) + pev[s1 * 64 + d], bfhi(vc) + pev[s1 * 64 + d + 1]); }
            }
        }
        if (blk == 63) {
            for (int i = tid; i < 2 * 2048 / 8; i += NTHREADS) { const int g = i >> 8, o = (i & 255) * 8;
                *(u32x4*)(ACMPK + ((size_t)(b * 2 + g) * 256 + 255) * 2048 + o) = (u32x4){0u, 0u, 0u, 0u}; *(u32x4*)(ACMPV + ((size_t)(b * 2 + g) * 256 + 255) * 2048 + o) = (u32x4){0u, 0u, 0u, 0u}; }
        }
        __syncthreads();
        if (tid < 256) { const int which = tid >> 7, gd = tid & 127, g = gd >> 6, d = gd & 63; LAS unsigned char* Lv = which ? Lvw : Lvs;
            bf16_t* dst = (which ? VWT : VST) + (((size_t)(b * 2 + g) * 64 + blk) * 64 + d) * 64;
#pragma unroll
            for (int q8 = 0; q8 < 8; ++q8) { unsigned short e[8];
#pragma unroll
                for (int k = 0; k < 8; ++k) e[k] = *(const LAS bf16_t*)(Lv + (8 * q8 + k) * 256 + gd * 2);
                u32x4 o; o.x = e[0] | ((unsigned)e[1] << 16); o.y = e[2] | ((unsigned)e[3] << 16); o.z = e[4] | ((unsigned)e[5] << 16); o.w = e[6] | ((unsigned)e[7] << 16);
                *(u32x4*)(dst + 8 * q8) = o; } }
        __syncthreads();
    }
}

__device__ __forceinline__ void nsa_cmp2_phase(const Frame& F, const Args& a) {
    const bf16_t* HC = (const bf16_t*)(F.ws + WS_R2 + R2_HCMP); bf16_t* KC = (bf16_t*)(F.ws + WS_R2 + R2_KC); bf16_t* VCT = (bf16_t*)(F.ws + WS_R2 + R2_VCT);
    const int* pos = (const int*)a.in[IN_POS];
    const int gw = F.bid * NWAVES + F.wave, NGW = F.G * NWAVES, lane = F.lane, fr = lane & 15, fq = lane >> 4;
    for (int it = gw; it < 512; it += NGW) {
        const int which = it >> 8, rt = it & 255;
        const bf16_t* A = HC + ((size_t)which * 4096 + 16 * rt) * 256; const bf16_t* Bt = (const bf16_t*)(F.ws + (which ? WS_W_C2V : WS_W_C2K));
        f32x4 c[4];
#pragma unroll
        for (int nt = 0; nt < 4; ++nt) c[nt] = (f32x4){0.f, 0.f, 0.f, 0.f};
#pragma unroll
        for (int ks = 0; ks < 8; ++ks) { const bf16x8 af = *(const bf16x8*)(A + fr * 256 + 32 * ks + 8 * fq);
#pragma unroll
            for (int nt = 0; nt < 4; ++nt) { const bf16x8 bf = *(const bf16x8*)(Bt + (16 * nt + fr) * 256 + 32 * ks + 8 * fq); c[nt] = MFMA16(af, bf, c[nt]); } }
        const int bg = rt >> 4, b = bg >> 1;
        if (which == 0) {
#pragma unroll
            for (int r = 0; r < 4; ++r) { const int i = (16 * rt + 4 * fq + r) & 255; int pi = 31 + 16 * i; if (pi > SEQ - 1) pi = SEQ - 1;
                const float ang = (float)pos[(size_t)b * SEQ + pi] * ROPE_INVF[fr & 7]; const float cs = __cosf(ang), sn = __sinf(ang);
                const float own = c[0][r], oth = __shfl_xor(own, 8);
                c[0][r] = (fr < 8) ? own * cs - oth * sn : own * cs + oth * sn;
#pragma unroll
                for (int nt = 0; nt < 4; ++nt) KC[((size_t)bg * 256 + i) * 64 + 16 * nt + fr] = (bf16_t)f2bf(c[nt][r]); }
        } else {
            const int i0 = (16 * rt + 4 * fq) & 255;
#pragma unroll
            for (int nt = 0; nt < 4; ++nt) { u32x2 p; p.x = pk2(c[nt][0], c[nt][1]); p.y = pk2(c[nt][2], c[nt][3]); *(u32x2*)(VCT + ((size_t)bg * 64 + 16 * nt + fr) * 256 + i0) = p; }
        }
    }
}
constexpr int CA_KC = 0, CA_KC_PITCH = 144;
constexpr int CA_VT = 36864, CA_VT_PITCH = 528;
__device__ __forceinline__ void nsa_cmp_attn_phase(const Frame& F, const Args& a) {
    const bf16_t* F1 = (const bf16_t*)(F.ws + WS_BIG); const bf16_t* QR = (const bf16_t*)(F.ws + WS_BIG + B1_QR);
    const bf16_t* KC = (const bf16_t*)(F.ws + WS_R2 + R2_KC); const bf16_t* VCT = (const bf16_t*)(F.ws + WS_R2 + R2_VCT);
    unsigned long long* SEL = (unsigned long long*)(F.ws + WS_R2 + R2_SEL); bf16_t* ONSA = (bf16_t*)(F.ws + WS_XN);
    const int lane = F.lane, wave = F.wave, tid = F.tid, fr = lane & 15, fq = lane >> 4;
    LAS unsigned char* L = F.lds;
    for (int bgk = F.bid; bgk < 256; bgk += F.G) {
        const int bg = bgk & 15, kq = bgk >> 4, b = bg >> 1, g = bg & 1;
        __syncthreads();
        for (int i = tid; i < 256 * 8; i += NTHREADS) { const int key = i >> 3, ch = i & 7; *(LAS u32x4*)(L + CA_KC + key * CA_KC_PITCH + ch * 16) = *(const u32x4*)(KC + ((size_t)bg * 256 + key) * 64 + ch * 8); }
        for (int i = tid; i < 64 * 32; i += NTHREADS) { const int d = i >> 5, ch = i & 31; *(LAS u32x4*)(L + CA_VT + d * CA_VT_PITCH + ch * 16) = *(const u32x4*)(VCT + ((size_t)bg * 64 + d) * 256 + ch * 8); }
        __syncthreads();
#pragma unroll 1
        for (int rep = 0; rep < 2; ++rep) {
            const int idx = wave * 16 + kq; const int tt = rep == 0 ? idx : 255 - idx;
            const int t0 = 16 * tt, t = t0 + fr; const size_t m = (size_t)b * SEQ + t;
            const int nk = tt;
            const int nkt = (nk + 15) >> 4;
            float iaA[16], iaB[16];
#pragma unroll
            for (int kt = 0; kt < 16; ++kt) { iaA[kt] = 0.f; iaB[kt] = 0.f; }
#pragma unroll 1
            for (int hh = 0; hh < 8; ++hh) {
                const int H = g * 8 + hh;
                const bf16x8 q0 = *(const bf16x8*)(QR + m * 1024 + H * 64 + 8 * fq), q1 = *(const bf16x8*)(QR + m * 1024 + H * 64 + 32 + 8 * fq);
                float mrun = -INFINITY, lrun = 0.f;
#pragma unroll 1
                for (int kt = 0; kt < nkt; ++kt) {
                    const bf16x8 k0 = *(const LAS bf16x8*)(L + CA_KC + (16 * kt + fr) * CA_KC_PITCH + 16 * fq), k1 = *(const LAS bf16x8*)(L + CA_KC + (16 * kt + fr) * CA_KC_PITCH + 64 + 16 * fq);
                    f32x4 sv = (f32x4){0.f, 0.f, 0.f, 0.f}; sv = MFMA16(k0, q0, sv); sv = MFMA16(k1, q1, sv);
                    float tm = -INFINITY;
#pragma unroll
                    for (int r = 0; r < 4; ++r) { const int key = 16 * kt + 4 * fq + r; const bool vis = (16 * key + 31) <= t; sv[r] = vis ? sv[r] * 0.125f : -INFINITY; tm = fmaxf(tm, sv[r]); }
                    const float mn = fmaxf(mrun, tm);
                    if (mn != -INFINITY) { float add = 0.f;
#pragma unroll
                        for (int r = 0; r < 4; ++r) add += (sv[r] == -INFINITY) ? 0.f : __expf(sv[r] - mn);
                        lrun = lrun * ((mrun == -INFINITY) ? 0.f : __expf(mrun - mn)) + add; mrun = mn; }
                }
                float mx = fmaxf(mrun, __shfl_xor(mrun, 16)); mx = fmaxf(mx, __shfl_xor(mx, 32));
                const float mref = (mx == -INFINITY) ? 0.f : mx;
                float sum = (mrun == -INFINITY) ? 0.f : lrun * __expf(mrun - mref);
                sum += __shfl_xor(sum, 16); sum += __shfl_xor(sum, 32);
                const float inv = 1.f / fmaxf(sum, 1e-30f);
                f32x4 o[4];
#pragma unroll
                for (int dt = 0; dt < 4; ++dt) o[dt] = (f32x4){0.f, 0.f, 0.f, 0.f};
#pragma unroll
                for (int ks = 0; ks < 8; ++ks) if (2 * ks < nkt) {
                    float p[8];
#pragma unroll
                    for (int half = 0; half < 2; ++half) { const int kt = 2 * ks + half;
                        const bf16x8 k0 = *(const LAS bf16x8*)(L + CA_KC + (16 * kt + fr) * CA_KC_PITCH + 16 * fq), k1 = *(const LAS bf16x8*)(L + CA_KC + (16 * kt + fr) * CA_KC_PITCH + 64 + 16 * fq);
                        f32x4 sv = (f32x4){0.f, 0.f, 0.f, 0.f}; sv = MFMA16(k0, q0, sv); sv = MFMA16(k1, q1, sv);
#pragma unroll
                        for (int r = 0; r < 4; ++r) { const int key = 16 * kt + 4 * fq + r; const bool vis = (16 * key + 31) <= t; p[4 * half + r] = vis ? __expf(sv[r] * 0.125f - mref) * inv : 0.f; } }
                    iaA[2 * ks] += (p[0] + p[1]) + (p[2] + 0.5f * p[3]); iaB[2 * ks] += p[3]; iaA[2 * ks + 1] += (p[4] + p[5]) + (p[6] + 0.5f * p[7]); iaB[2 * ks + 1] += p[7];
                    u32x4 pw; pw.x = pk2(p[0], p[1]); pw.y = pk2(p[2], p[3]); pw.z = pk2(p[4], p[5]); pw.w = pk2(p[6], p[7]);
                    const bf16x8 pb = __builtin_bit_cast(bf16x8, pw);
#pragma unroll
                    for (int dt = 0; dt < 4; ++dt) { const u32x2 v0 = *(const LAS u32x2*)(L + CA_VT + (16 * dt + fr) * CA_VT_PITCH + (32 * ks + 4 * fq) * 2), v1 = *(const LAS u32x2*)(L + CA_VT + (16 * dt + fr) * CA_VT_PITCH + (32 * ks + 16 + 4 * fq) * 2);
                        u32x4 vw; vw.x = v0.x; vw.y = v0.y; vw.z = v1.x; vw.w = v1.y; o[dt] = MFMA16(__builtin_bit_cast(bf16x8, vw), pb, o[dt]); }
                    __builtin_amdgcn_sched_barrier(0); }
                const float gate = sigmoidf_(bf2f(F1[m * F1_LD + 1792 + H * 3 + 0]));
#pragma unroll
                for (int dt = 0; dt < 4; ++dt) { u32x2 w; w.x = pk2(o[dt][0] * gate, o[dt][1] * gate); w.y = pk2(o[dt][2] * gate, o[dt][3] * gate); *(u32x2*)(ONSA + m * 1024 + H * 64 + 16 * dt + 4 * fq) = w; }
            }
            float imp[16];
#pragma unroll
            for (int kt = 0; kt < 16; ++kt) { const float up = __shfl(iaB[kt], (lane + 48) & 63); imp[kt] = up; }
            { float carry = 0.f;
#pragma unroll
              for (int kt = 0; kt < 16; ++kt) { const float prev3 = (fq == 0) ? carry : imp[kt]; carry = imp[kt]; imp[kt] = 0.5f * prev3 + iaA[kt]; } }
            const int cur = t >> 6;
            unsigned long long mask = 0ull;
            if (t0 < 1024) {
#pragma unroll
                for (int kt = 0; kt < 16; ++kt) { const int j = 4 * kt + fq; if (j <= cur) mask |= 1ull << j; }
            } else {
                float cv[16];
#pragma unroll
                for (int kt = 0; kt < 16; ++kt) { const int j = 4 * kt + fq; const bool forced = (j == 0) || (j == cur) || (j == cur - 1); cv[kt] = (j <= cur && !forced) ? imp[kt] : -INFINITY; }
                int rank[16];
#pragma unroll
                for (int kt = 0; kt < 16; ++kt) rank[kt] = 0;
#pragma unroll 1
                for (int f2 = 0; f2 < 4; ++f2) {
#pragma unroll
                    for (int k2 = 0; k2 < 16; ++k2) { const float ov = __shfl(cv[k2], fr + 16 * f2); const int j2 = 4 * k2 + f2;
#pragma unroll
                        for (int kt = 0; kt < 16; ++kt) { const int j = 4 * kt + fq; rank[kt] += (ov > cv[kt] || (ov == cv[kt] && j2 < j)) ? 1 : 0; } } }
#pragma unroll
                for (int kt = 0; kt < 16; ++kt) { const int j = 4 * kt + fq; const bool forced = (j == 0) || (j == cur) || (j == cur - 1);
                    if (forced || (cv[kt] != -INFINITY && rank[kt] < SEL_TOPN - 3)) mask |= 1ull << j; }
            }
            { unsigned lo = (unsigned)mask, hi = (unsigned)(mask >> 32);
              lo |= __shfl_xor(lo, 16); hi |= __shfl_xor(hi, 16); lo |= __shfl_xor(lo, 32); hi |= __shfl_xor(hi, 32);
              if (fq == 0) SEL[(size_t)bg * SEQ + t] = ((unsigned long long)hi << 32) | lo; }
        }
    }
}

constexpr int SA_K = 0, SA_V = 8192, SA_BUF = 16384, SA_NS = 6, SA_D = 4;
#define SA_BAR() do { asm volatile("s_waitcnt lgkmcnt(0)" ::: "memory"); __builtin_amdgcn_s_barrier(); asm volatile("" ::: "memory"); } while (0)
template <int MODE  >
__device__ __forceinline__ void nsa_attn_pass(const Frame& F, const bf16_t* Kg, const bf16_t* Vtg, const bf16x8 (&qf)[2][2], const unsigned long long (&selm)[2], int tq[2], int bg, int qb, f32x4 (&outacc)[2][4], const float (&gate)[2]) {
    const int lane = F.lane, tid = F.tid, fr = lane & 15, fq = lane >> 4;
    LAS unsigned char* L = F.lds;
    const int j0 = (MODE == 0) ? 0 : (qb - 8 > 0 ? qb - 8 : 0), j1 = qb;
    f32x4 O[2][4]; float mrun[2], lrun[2];
#pragma unroll
    for (int i = 0; i < 2; ++i) { mrun[i] = -INFINITY; lrun[i] = 0.f;
#pragma unroll
        for (int dt = 0; dt < 4; ++dt) O[i][dt] = (f32x4){0.f, 0.f, 0.f, 0.f}; }
    const int wv_ = F.wave;
#define SA_ISSUE(jt_) do { LAS unsigned char* slot_ = L + (((jt_) - j0) % SA_NS) * SA_BUF; \
        _Pragma("unroll") for (int i_ = 0; i_ < 2; ++i_) { const int pc_ = 2 * wv_ + i_, P_ = pc_ & 7; const int row_ = 8 * P_ + (lane >> 3), c16_ = (lane & 7) ^ ((row_ >> 1) & 7); \
            const bf16_t* src_ = (pc_ < 8) ? Kg + ((size_t)bg * SEQ + (size_t)(jt_) * 64) * 64 + row_ * 64 + c16_ * 8 : Vtg + ((size_t)bg * 64 + (jt_)) * 4096 + row_ * 64 + c16_ * 8; \
            __builtin_amdgcn_global_load_lds((const unsigned*)src_, (LAS unsigned*)(slot_ + (pc_ < 8 ? SA_K : SA_V) + P_ * 1024), 16, 0, 0); } } while (0)
    __syncthreads();
#pragma unroll 1
    for (int d_ = 0; d_ < SA_D; ++d_) if (j0 + d_ <= j1) SA_ISSUE(j0 + d_);
    asm volatile("s_waitcnt vmcnt(0)" ::: "memory");
    SA_BAR();
#pragma unroll 1
    for (int j = j0; j <= j1; ++j) {
        LAS unsigned char* Lb = L + ((j - j0) % SA_NS) * SA_BUF;
        if (j + SA_D <= j1) SA_ISSUE(j + SA_D);
        const bool edge = (j == j1) || (MODE == 1 && j == qb - 8);
#pragma unroll
        for (int i = 0; i < 2; ++i) {
            const int t = tq[i];
            bool colok;
            if (MODE == 0) colok = (selm[i] >> j) & 1ull; else colok = true;
            if (__ballot(colok) == 0ull) continue;
            f32x4 s[4];
#pragma unroll
            for (int kt = 0; kt < 4; ++kt) { s[kt] = (f32x4){0.f, 0.f, 0.f, 0.f};
                const int key_ = 16 * kt + fr, sw_ = (key_ >> 1) & 7;
                const bf16x8 k0 = *(const LAS bf16x8*)(Lb + SA_K + key_ * 128 + ((fq ^ sw_) * 16)), k1 = *(const LAS bf16x8*)(Lb + SA_K + key_ * 128 + (((4 + fq) ^ sw_) * 16));
                s[kt] = MFMA16(k0, qf[i][0], s[kt]); s[kt] = MFMA16(k1, qf[i][1], s[kt]); }
            constexpr float SC = 0.125f * 1.4426950408889634f;
            float mx = -INFINITY;
            if (edge) {
#pragma unroll
                for (int kt = 0; kt < 4; ++kt)
#pragma unroll
                    for (int r = 0; r < 4; ++r) { const int kpos = 64 * j + 16 * kt + 4 * fq + r; bool vis = (kpos <= t); if (MODE == 1) vis = vis && (kpos > t - WINDOW);
                        s[kt][r] = vis ? s[kt][r] : -INFINITY; mx = fmaxf(mx, s[kt][r]); }
            } else {
#pragma unroll
                for (int kt = 0; kt < 4; ++kt) mx = fmaxf(fmaxf(mx, fmaxf(s[kt][0], s[kt][1])), fmaxf(s[kt][2], s[kt][3]));
            }
            mx = colok ? mx * SC : -INFINITY;
            mx = fmaxf(mx, __shfl_xor(mx, 16)); mx = fmaxf(mx, __shfl_xor(mx, 32));
            const float mnew = fmaxf(mrun[i], mx);
            const float alpha = (mrun[i] == -INFINITY) ? 0.f : __builtin_amdgcn_exp2f(mrun[i] - mnew);
            const float msub = (colok && mnew != -INFINITY) ? mnew : INFINITY;
            mrun[i] = mnew;
            float p[16]; float psum = 0.f;
#pragma unroll
            for (int kt = 0; kt < 4; ++kt)
#pragma unroll
                for (int r = 0; r < 4; ++r) { const float e = __builtin_amdgcn_exp2f(__builtin_fmaf(s[kt][r], SC, -msub)); p[4 * kt + r] = e; psum += e; }
            lrun[i] = lrun[i] * alpha + psum;
#pragma unroll
            for (int dt = 0; dt < 4; ++dt) O[i][dt] = O[i][dt] * alpha;
#pragma unroll
            for (int ks = 0; ks < 2; ++ks) { u32x4 pw; pw.x = pk2(p[8 * ks], p[8 * ks + 1]); pw.y = pk2(p[8 * ks + 2], p[8 * ks + 3]); pw.z = pk2(p[8 * ks + 4], p[8 * ks + 5]); pw.w = pk2(p[8 * ks + 6], p[8 * ks + 7]);
                const bf16x8 pb = __builtin_bit_cast(bf16x8, pw);
#pragma unroll
                for (int dt = 0; dt < 4; ++dt) { const int d_ = 16 * dt + fr, sw_ = (d_ >> 1) & 7, c_ = 4 * ks + (fq >> 1);
                    const u32x2 v0 = *(const LAS u32x2*)(Lb + SA_V + d_ * 128 + ((c_ ^ sw_) * 16) + 8 * (fq & 1)), v1 = *(const LAS u32x2*)(Lb + SA_V + d_ * 128 + (((c_ + 2) ^ sw_) * 16) + 8 * (fq & 1));
                    u32x4 vw; vw.x = v0.x; vw.y = v0.y; vw.z = v1.x; vw.w = v1.y; O[i][dt] = MFMA16(__builtin_bit_cast(bf16x8, vw), pb, O[i][dt]); } }
        }
        if (j + SA_D <= j1) asm volatile("s_waitcnt vmcnt(6)" ::: "memory");
        else asm volatile("s_waitcnt vmcnt(0)" ::: "memory");
        SA_BAR();
    }
#undef SA_ISSUE
#pragma unroll
    for (int i = 0; i < 2; ++i) { float l = lrun[i]; l += __shfl_xor(l, 16); l += __shfl_xor(l, 32); const float sc = gate[i] / fmaxf(l, 1e-30f);
#pragma unroll
        for (int dt = 0; dt < 4; ++dt) outacc[i][dt] += O[i][dt] * sc; }
}
__device__ __forceinline__ void nsa_attn_phase(const Frame& F, const Args& a, bool do_store = true) {
    const bf16_t* F1 = (const bf16_t*)(F.ws + WS_BIG); const bf16_t* QR = (const bf16_t*)(F.ws + WS_BIG + B1_QR);
    const bf16_t* KS = (const bf16_t*)(F.ws + WS_BIG + B1_KS); const bf16_t* VST = (const bf16_t*)(F.ws + WS_BIG + B1_VST); const bf16_t* KW = (const bf16_t*)(F.ws + WS_BIG + B1_KW); const bf16_t* VWT = (const bf16_t*)(F.ws + WS_BIG + B1_VWT);
    const unsigned long long* SEL = (const unsigned long long*)(F.ws + WS_R2 + R2_SEL); bf16_t* ONSA = (bf16_t*)(F.ws + WS_XN);
    const int lane = F.lane, wave = F.wave, fr = lane & 15, fq = lane >> 4;
    for (int c = F.bid; c < 256; c += F.G) {
        const int bg = c & 15, kq = c >> 4, b = bg >> 1, g = bg & 1;
#pragma unroll 1
        for (int rep = 0; rep < 8; ++rep) {
            const int hb = 16 * rep + ((rep & 1) ? 15 - kq : kq);
            const int qb = hb >> 1;
            int tq[2]; bf16x8 qf[2][2]; unsigned long long selm[2]; float gs[2], gw_[2]; f32x4 outacc[2][4]; size_t mrow[2]; int Hh;
            Hh = g * 8 + (fr & 7);
#pragma unroll
            for (int i = 0; i < 2; ++i) { tq[i] = 32 * hb + 4 * wave + 2 * i + (fr >> 3); mrow[i] = (size_t)b * SEQ + tq[i];
                qf[i][0] = *(const bf16x8*)(QR + mrow[i] * 1024 + Hh * 64 + 8 * fq); qf[i][1] = *(const bf16x8*)(QR + mrow[i] * 1024 + Hh * 64 + 32 + 8 * fq);
                selm[i] = SEL[(size_t)bg * SEQ + tq[i]];
                gs[i] = sigmoidf_(bf2f(F1[mrow[i] * F1_LD + 1792 + Hh * 3 + 1])); gw_[i] = sigmoidf_(bf2f(F1[mrow[i] * F1_LD + 1792 + Hh * 3 + 2]));
#pragma unroll
                for (int dt = 0; dt < 4; ++dt) outacc[i][dt] = (f32x4){0.f, 0.f, 0.f, 0.f}; }
            nsa_attn_pass<0>(F, KS, VST, qf, selm, tq, bg, qb, outacc, gs);
            nsa_attn_pass<1>(F, KW, VWT, qf, selm, tq, bg, qb, outacc, gw_);
            if (do_store)
#pragma unroll
            for (int i = 0; i < 2; ++i)
#pragma unroll
                for (int dt = 0; dt < 4; ++dt) { bf16_t* p = ONSA + mrow[i] * 1024 + Hh * 64 + 16 * dt + 4 * fq; const u32x2 old = *(const u32x2*)p;
                    u32x2 w; w.x = pk2(bflo(old.x) + outacc[i][dt][0], bfhi(old.x) + outacc[i][dt][1]); w.y = pk2(bflo(old.y) + outacc[i][dt][2], bfhi(old.y) + outacc[i][dt][3]); *(u32x2*)p = w; }
        }
    }
}
__device__ __forceinline__ void chk_gdn(const Frame& F, const Args& a, int b, int h, int ntok, unsigned* cnt) {
    const bf16_t* F0 = (const bf16_t*)(F.ws + WS_BIG); const bf16_t* OAB = (const bf16_t*)(F.ws + WS_XN);
    LAS float* S = (LAS float*)F.lds;
    LAS float* qkv = S + 16384;
    LAS float* kS = qkv + 384;
    LAS float* ov = kS + 128;
    const int tid = F.tid; const float* convw = a.in[IN_GCONV];

#pragma unroll 1
for (int i = tid; i < 16384; i += NTHREADS) S[i] = 0.f;
    __syncthreads();
    unsigned bad = 0;

#pragma unroll 1
for (int t = 0; t < ntok; ++t) {
        const size_t m = (size_t)b * SEQ + t;
        if (tid < 384) { const int X = tid >> 7, c = tid & 127, col = X * 512 + h * 128 + c; float acc = 0.f;

#pragma unroll 1
for (int i = 0; i < 4; ++i) if (t - 3 + i >= 0) acc += convw[i * 1536 + col] * bf2f(F0[(m - 3 + i) * F0_LD + col]);
            qkv[tid] = acc / (1.f + expf(-acc)); }
        __syncthreads();
        float sq = 0.f, sk = 0.f;
#pragma unroll 1
for (int i = 0; i < 128; ++i) { sq += qkv[i] * qkv[i]; sk += qkv[128 + i] * qkv[128 + i]; }
        const float rq = 1.f / sqrtf(sq + 1e-6f) / sqrtf(128.f), rk = 1.f / sqrtf(sk + 1e-6f);
        const float beta = 1.f / (1.f + expf(-bf2f(F0[m * F0_LD + F0_BA + h])));
        const float aa = bf2f(F0[m * F0_LD + F0_BA + 4 + h]) + a.in[IN_GDT][h];
        const float g = -expf(a.in[IN_GALOG][h]) * (aa > 20.f ? aa : log1pf(expf(aa))); const float eg = expf(g);
        if (tid < 128) { float s = 0.f;
#pragma unroll 1
for (int i = 0; i < 128; ++i) s += qkv[128 + i] * rk * S[i * 128 + tid]; kS[tid] = s; }
        __syncthreads();

#pragma unroll 1
for (int e = tid; e < 16384; e += NTHREADS) { const int i = e >> 7, j = e & 127; const float ki = qkv[128 + i] * rk;
            S[e] = eg * (S[e] - beta * ki * kS[j]) + beta * ki * qkv[256 + j]; }
        __syncthreads();
        if (tid < 128) { float s = 0.f;
#pragma unroll 1
for (int i = 0; i < 128; ++i) s += qkv[i] * rq * S[i * 128 + tid]; ov[tid] = s; }
        __syncthreads();
        if (tid < 128) { float ss = 0.f;
#pragma unroll 1
for (int i = 0; i < 128; ++i) ss += ov[i] * ov[i];
            const float rstd = 1.f / sqrtf(ss / 128.f + NORM_EPS); const float z = bf2f(F0[m * F0_LD + 1536 + h * 128 + tid]);
            const float ref = ov[tid] * rstd * a.in[IN_GNORM][tid] * (z / (1.f + expf(-z))); const float got = bf2f(OAB[m * 1024 + h * 128 + tid]);
            if (!(fabsf(got - ref) <= 0.04f + 0.04f * fabsf(ref))) bad++; }
        __syncthreads();
    }
    if (bad) atomicAdd(cnt, bad);
}
__device__ __forceinline__ void chk_rwkv(const Frame& F, const Args& a, int b, int h, int ntok, unsigned* cnt) {
    const bf16_t* F0 = (const bf16_t*)(F.ws + WS_BIG); const bf16_t* OAB = (const bf16_t*)(F.ws + WS_XN);
    LAS float* S = (LAS float*)F.lds;
    LAS float* xs = S + 4096;
    LAS float* op = xs + 448;
    const int tid = F.tid; unsigned bad = 0;

#pragma unroll 1
for (int i = tid; i < 4096; i += NTHREADS) S[i] = 0.f;
    __syncthreads();

#pragma unroll 1
for (int t = 0; t < ntok; ++t) {
        const size_t m = (size_t)b * SEQ + t;
        if (tid < 448) { int mi; if (tid < 192) mi = (tid >> 6) * 512 + h * 64 + (tid & 63); else mi = 1536 + (tid - 192);
            const float f = bf2f(F0[m * F0_LD + F0_RWKV + mi]); const float fp = t > 0 ? bf2f(F0[(m - 1) * F0_LD + F0_RWKV + mi]) : 0.f;
            xs[tid] = f + (fp - f) * a.in[IN_RMU][mi]; }
        __syncthreads();
        if (tid < 64) { const int hc = h * 64 + tid; float lw = a.in[IN_RW0][hc], la = a.in[IN_RA0][hc], gg = 0.f;

#pragma unroll 1
for (int j = 0; j < 64; ++j) { lw += tanhf(xs[192 + j]) * a.in[IN_RW2][j * 512 + hc]; la += xs[256 + j] * a.in[IN_RA2][j * 512 + hc]; }

#pragma unroll 1
for (int j = 0; j < 128; ++j) gg += (1.f / (1.f + expf(-xs[320 + j]))) * a.in[IN_RG2][j * 512 + hc];
            const float sp = (-lw > 20.f) ? -lw : log1pf(expf(-lw)); const float wlog = -sp - 0.5f;
            const float av = 1.f / (1.f + expf(-la));
            op[tid] = expf(-expf(wlog)); op[64 + tid] = xs[64 + tid] * a.in[IN_RKK][hc]; op[256 + tid] = av;
            op[192 + tid] = xs[64 + tid] * (1.f + (av - 1.f) * a.in[IN_RKA][hc]); op[320 + tid] = gg; }
        __syncthreads();
        float ss = 0.f;
#pragma unroll 1
for (int i = 0; i < 64; ++i) ss += op[64 + i] * op[64 + i];
        const float rinv = 1.f / sqrtf(ss + 1e-6f);
        float bon = 0.f;
#pragma unroll 1
for (int i = 0; i < 64; ++i) bon += xs[i] * op[192 + i] * a.in[IN_RRK][h * 64 + i];
        if (tid < 64) { float sa = 0.f;
#pragma unroll 1
for (int k = 0; k < 64; ++k) sa -= S[tid * 64 + k] * op[64 + k] * rinv;
            float y = 0.f; const float vv = xs[128 + tid];

#pragma unroll 1
for (int k = 0; k < 64; ++k) { const float kk = op[64 + k] * rinv; const float sn = S[tid * 64 + k] * op[k] + sa * kk * op[256 + k] + vv * op[192 + k]; S[tid * 64 + k] = sn; y += sn * xs[k]; }
            op[384 + tid] = y; }
        __syncthreads();
        if (tid < 64) { float mean = 0.f;
#pragma unroll 1
for (int i = 0; i < 64; ++i) mean += op[384 + i]; mean /= 64.f; float var = 0.f;
#pragma unroll 1
for (int i = 0; i < 64; ++i) { const float d = op[384 + i] - mean; var += d * d; } var /= 64.f;
            const int hc = h * 64 + tid;
            const float yn = (op[384 + tid] - mean) / sqrtf(var + RWKV_LN_EPS) * a.in[IN_RLNW][hc] + a.in[IN_RLNB][hc];
            const float ref = (yn + bon * xs[128 + tid]) * op[320 + tid]; const float got = bf2f(OAB[m * 1024 + 512 + hc]);
            if (!(fabsf(got - ref) <= 0.04f + 0.04f * fabsf(ref))) bad++; }
        __syncthreads();
    }
    if (bad) atomicAdd(cnt, bad);
}

__device__ __forceinline__ float chk_rope_val(const bf16_t* row, int base, int d, float posf) {
    if (d >= 16) return bf2f(row[base + d]);
    const int i = d & 7; const float ang = posf * ROPE_INVF[i]; const float cs = cosf(ang), sn = sinf(ang);
    const float x1 = bf2f(row[base + i]), x2 = bf2f(row[base + 8 + i]);
    return d < 8 ? x1 * cs - x2 * sn : x2 * cs + x1 * sn;
}
__device__ __forceinline__ void chk_nsa(const Frame& F, const Args& a, int b, int g, int t, unsigned* cnt) {
    const bf16_t* F1 = (const bf16_t*)(F.ws + WS_BIG); const bf16_t* ONSA = (const bf16_t*)(F.ws + WS_XN);
    const int* pos = (const int*)a.in[IN_POS];
    LAS float* kc = (LAS float*)F.lds;
    LAS float* vc = kc + 8192;
    LAS float* hb = vc + 8192;
    LAS float* sb = hb + 512;
    LAS float* red = sb + 4096;
    LAS float* qv = red + 512;
    LAS float* impv = qv + 64;
    LAS float* ocv = impv + 64;
    LAS float* misc = ocv + 512;
    LAS unsigned* selw = (LAS unsigned*)(misc + 8);
    const int tid = F.tid; const size_t mb = (size_t)b * SEQ; const size_t m = mb + t;
    const int nk = t >= 31 ? (t - 31) / 16 + 1 : 0;
    unsigned bad = 0;
#pragma unroll 1
    for (int i = 0; i < nk; ++i) {
        { const int path = tid >> 8, hid = tid & 255; const float* w1 = a.in[path ? IN_NW1V : IN_NW1K]; const float* pe = a.in[path ? IN_NPEV : IN_NPEK]; float acc = 0.f;
#pragma unroll 1
          for (int sl = 0; sl < 32; ++sl) { const bf16_t* row = F1 + (mb + 16 * i + sl) * F1_LD + 1024 + path * 128 + g * 64;
#pragma unroll 1
              for (int d = 0; d < 64; ++d) acc += (bf2f(row[d]) + pe[sl * 64 + d]) * w1[(size_t)(sl * 64 + d) * 256 + hid]; }
          hb[tid] = acc / (1.f + expf(-acc)); }
        __syncthreads();
        if (tid < 128) { const int path = tid >> 6, d = tid & 63; const float* w2 = a.in[path ? IN_NW2V : IN_NW2K]; float acc = 0.f;
#pragma unroll 1
            for (int hid = 0; hid < 256; ++hid) acc += hb[path * 256 + hid] * w2[hid * 64 + d];
            (path ? vc : kc)[i * 64 + d] = acc; }
        __syncthreads();
    }
    if (tid < nk * 8) { const int i = tid >> 3, dd = tid & 7; const float ang = (float)pos[mb + 31 + 16 * i] * ROPE_INVF[dd]; const float cs = cosf(ang), sn = sinf(ang);
        const float x1 = kc[i * 64 + dd], x2 = kc[i * 64 + 8 + dd]; kc[i * 64 + dd] = x1 * cs - x2 * sn; kc[i * 64 + 8 + dd] = x2 * cs + x1 * sn; }
    if (tid < 64) impv[tid] = 0.f;
    __syncthreads();
    const float posq = (float)pos[m];
#pragma unroll 1
    for (int hh = 0; hh < 8; ++hh) { const int H = g * 8 + hh;
        if (tid < 64) qv[tid] = chk_rope_val(F1 + m * F1_LD, H * 64, tid, posq) * 0.125f;
        __syncthreads();
        if (tid < nk) { float s = 0.f;
#pragma unroll 1
            for (int d = 0; d < 64; ++d) s += qv[d] * kc[tid * 64 + d]; sb[tid] = s; }
        __syncthreads();
        if (tid == 0) { float mx = -INFINITY;
#pragma unroll 1
            for (int i = 0; i < nk; ++i) mx = fmaxf(mx, sb[i]); float sum = 0.f;
#pragma unroll 1
            for (int i = 0; i < nk; ++i) sum += expf(sb[i] - mx); misc[0] = mx; misc[1] = fmaxf(sum, 1e-30f); }
        __syncthreads();
        if (tid < nk) sb[tid] = expf(sb[tid] - misc[0]) / misc[1];
        __syncthreads();
        if (tid < 64) { float o = 0.f;
#pragma unroll 1
            for (int i = 0; i < nk; ++i) o += sb[i] * vc[i * 64 + tid]; ocv[hh * 64 + tid] = o;
            float im = 0.f;
#pragma unroll 1
            for (int i = 4 * tid - 1; i <= 4 * tid + 3; ++i) if (i >= 0 && i < nk) im += sb[i] * ((i == 4 * tid - 1 || i == 4 * tid + 3) ? 0.5f : 1.f);
            impv[tid] += im; }
        __syncthreads();
    }
    if (tid == 0) { const int cur = t >> 6; unsigned lo = 0u, hi = 0u;
#pragma unroll 1
        for (int r = 0; r < 16; ++r) { int best = -1; float bv = 0.f;
#pragma unroll 1
            for (int j = 0; j < 64; ++j) { const bool taken = j < 32 ? ((lo >> j) & 1u) : ((hi >> (j - 32)) & 1u); if (taken) continue;
                const bool valid = j <= cur, forced = (j == 0) || (j == cur) || (j == cur - 1);
                const float sc = valid ? (forced ? INFINITY : impv[j]) : -INFINITY;
                if (best < 0 || sc > bv) { best = j; bv = sc; } }
            if (best < 32) lo |= 1u << best; else hi |= 1u << (best - 32); }
        selw[0] = lo; selw[1] = hi; }
    __syncthreads();
#pragma unroll 1
    for (int hh = 0; hh < 8; ++hh) { const int H = g * 8 + hh;
        if (tid < 64) qv[tid] = chk_rope_val(F1 + m * F1_LD, H * 64, tid, posq) * 0.125f;
        __syncthreads();
        float osw[2] = {0.f, 0.f};
#pragma unroll 1
        for (int br = 0; br < 2; ++br) {
            const int kbase = 1024 + (br == 0 ? 2 : 4) * 128 + g * 64, vbase = kbase + 128;
            float lmx = -INFINITY;
#pragma unroll 1
            for (int kp = tid; kp < 4096; kp += NTHREADS) { float s = -INFINITY; const int j = kp >> 6;
                bool vis = kp <= t; if (br == 0) vis = vis && (j < 32 ? ((selw[0] >> j) & 1u) : ((selw[1] >> (j - 32)) & 1u)); else vis = vis && (kp > t - WINDOW);
                if (vis) { s = 0.f; const float pk = (float)pos[mb + kp];
#pragma unroll 1
                    for (int d = 0; d < 64; ++d) s += qv[d] * chk_rope_val(F1 + (mb + kp) * F1_LD, kbase, d, pk); }
                sb[kp] = s; lmx = fmaxf(lmx, s); }
            red[tid] = lmx; __syncthreads();
            if (tid == 0) { float mx = -INFINITY;
#pragma unroll 1
                for (int i = 0; i < NTHREADS; ++i) mx = fmaxf(mx, red[i]); misc[0] = mx; }
            __syncthreads();
            float ls = 0.f;
#pragma unroll 1
            for (int kp = tid; kp < 4096; kp += NTHREADS) { const float e = (sb[kp] == -INFINITY) ? 0.f : expf(sb[kp] - misc[0]); sb[kp] = e; ls += e; }
            red[tid] = ls; __syncthreads();
            if (tid == 0) { float sm = 0.f;
#pragma unroll 1
                for (int i = 0; i < NTHREADS; ++i) sm += red[i]; misc[1] = fmaxf(sm, 1e-30f); }
            __syncthreads();
            if (tid < 64) { float o = 0.f;
#pragma unroll 1
                for (int kp = 0; kp <= t; ++kp) if (sb[kp] != 0.f) o += sb[kp] * bf2f(F1[(mb + kp) * F1_LD + vbase + tid]); osw[br] = o / misc[1]; }
            __syncthreads();
        }
        if (tid < 64) { const float g0 = 1.f / (1.f + expf(-bf2f(F1[m * F1_LD + 1792 + H * 3 + 0]))), g1 = 1.f / (1.f + expf(-bf2f(F1[m * F1_LD + 1792 + H * 3 + 1]))), g2 = 1.f / (1.f + expf(-bf2f(F1[m * F1_LD + 1792 + H * 3 + 2])));
            const float ref = g0 * ocv[hh * 64 + tid] + g1 * osw[0] + g2 * osw[1]; const float got = bf2f(ONSA[m * 1024 + H * 64 + tid]);
            if (!(fabsf(got - ref) <= 0.004f + 0.05f * fabsf(ref))) bad++; }
        __syncthreads();
    }
    if (bad) atomicAdd(cnt, bad);
}
#define GEMM_PHASE(ACT, Aptr, Bptr, Optr, Mrows, N, K, ldo, cshift) do { pg8::Gemm g_{(const bf16_t*)(Aptr), (const bf16_t*)(Bptr), (Mrows), (N), (K)}; pg8::StaticOrder S_; S_.init((Mrows), (N), F.G, (F.bid + (cshift)) % F.G); \
      pg8::EpiBf16<ACT> E_{(bf16_t*)(Optr), (ldo)}; pg8::gemm_phase<pg8::EpiBf16<ACT>, pg8::StaticOrder, true, true>(F.lds, g_, S_, E_); } while (0)
__global__ void __launch_bounds__(NTHREADS, 2) mk_fwd(Args args) {
    extern __shared__ __attribute__((aligned(16))) unsigned char lds[];
    cg::grid_group grid = cg::this_grid();
    Frame F; F.lds = (LAS unsigned char*)lds; F.tid = threadIdx.x; F.lane = F.tid & 63; F.wave = __builtin_amdgcn_readfirstlane(F.tid >> 6);
    F.G = gridDim.x; F.bid = blockIdx.x; F.ws = args.ws; F.ctl = (unsigned*)(args.ws + WS_CTL);
    unsigned char* ws = args.ws;
    if (F.tid < 16) ((LAS unsigned*)(F.lds + XB_LDS_OFF))[F.tid] = 0u;
    __syncthreads();
    XcdBarrier xbar = xcd_barrier_post(F.ctl + CW_BAR, (volatile LAS unsigned*)(F.lds + XB_LDS_OFF));
#define GSYNC() xcd_barrier(xbar)
    p0_prologue(fresh(F), args);
    rwkvc_build_images(fresh(F), args);
    if (F.G <= 96) p0_layer1_weights(fresh(F), args, 0, 0, -1);
    grid.sync();
    GEMM_PHASE(0, ws + WS_XN, ws + WS_W_IN0, ws + WS_BIG, MTOK, 4096, 1024, F0_LD, 0);
    GSYNC();
    gdn_prep_phase(fresh(F), args);
    GSYNC();
#pragma unroll 1
    for (int sg = 0; sg < RC_NSEG; ++sg) {
        rwkvc_prep_phase(fresh(F), args, sg);
        GSYNC();
        for (int u = F.bid; u < 96; u += F.G) {
            if (u < 64) rwkvc_chain_unit(fresh(F), args, u, sg); else gdn_scan_unit(fresh(F), args, u - 64, 8 * sg, 8 * sg + 8);
            __syncthreads(); }
        if (sg < 4 && F.G > 96 && F.bid >= 96) p0_layer1_weights(fresh(F), args, 96, F.G - 96, sg);
        GSYNC();
    }
    GEMM_PHASE(0, ws + WS_XN, ws + WS_W_OUT0, ws + WS_BIG, MTOK, 1024, 1024, 1024, 0);
    GSYNC();
    row_pass(fresh(F), (const bf16_t*)(ws + WS_BIG), args.in[IN_X], args.in[IN_NMPOST], args.out, args.in[IN_NFPRE], (bf16_t*)(ws + WS_XN));
    GSYNC();
    GEMM_PHASE(2, ws + WS_XN, ws + WS_W_UP0, ws + WS_BIG, MTOK, 4096, 1024, 4096, 0);
    GSYNC();
    GEMM_PHASE(0, ws + WS_BIG, ws + WS_W_DN0, ws + WS_R2, MTOK, 1024, 4096, 1024, 0);
    GSYNC();
    row_pass(fresh(F), (const bf16_t*)(ws + WS_R2), args.out, args.in[IN_NFPOST], args.out, args.in[IN_NMPRE] + 1024, (bf16_t*)(ws + WS_XN));
    GSYNC();
    GEMM_PHASE(0, ws + WS_XN, ws + WS_W_IN1, ws + WS_BIG, MTOK, 2048, 1024, F1_LD, 0);
    GSYNC();
    nsa_prep_phase(fresh(F), args);
    GSYNC();
    GEMM_PHASE(3, ws + WS_BIG + B1_ACMPK, ws + WS_W_C1K, ws + WS_R2 + R2_HCMP, 4096, 256, 2048, 256, 0);
    GEMM_PHASE(3, ws + WS_BIG + B1_ACMPV, ws + WS_W_C1V, ws + WS_R2 + R2_HCMP + (size_t)4096 * 256 * 2, 4096, 256, 2048, 256, 128);
    GSYNC();
    nsa_cmp2_phase(fresh(F), args);
    GSYNC();
    nsa_cmp_attn_phase(fresh(F), args);
    GSYNC();
    nsa_attn_phase(fresh(F), args);
    GSYNC();
#ifdef WITH_CHECKS
    if (F.bid == 0) chk_nsa(F, args, 0, 0, 1500, F.ctl + 2);
    else if (F.bid == 1) chk_nsa(F, args, 3, 1, 2047, F.ctl + 2);
    else if (F.bid == 2) chk_nsa(F, args, 7, 0, 40, F.ctl + 2);
    else if (F.bid == 3) chk_nsa(F, args, 5, 1, 1023, F.ctl + 2);
    else if (F.bid == 4) chk_nsa(F, args, 2, 0, 700, F.ctl + 2);
    else if (F.bid == 5) chk_nsa(F, args, 6, 1, 1777, F.ctl + 2);
    GSYNC();
#endif
    GEMM_PHASE(0, ws + WS_XN, ws + WS_W_OUT1, ws + WS_BIG, MTOK, 1024, 1024, 1024, 0);
    GSYNC();
    row_pass(fresh(F), (const bf16_t*)(ws + WS_BIG), args.out, args.in[IN_NMPOST] + 1024, args.out, args.in[IN_NFPRE] + 1024, (bf16_t*)(ws + WS_XN));
    GSYNC();
    GEMM_PHASE(2, ws + WS_XN, ws + WS_W_UP1, ws + WS_BIG, MTOK, 4096, 1024, 4096, 0);
    GSYNC();
    GEMM_PHASE(0, ws + WS_BIG, ws + WS_W_DN1, ws + WS_R2, MTOK, 1024, 4096, 1024, 0);
    GSYNC();
    row_pass(fresh(F), (const bf16_t*)(ws + WS_R2), args.out, args.in[IN_NFPOST] + 1024, args.out, nullptr, nullptr);
#ifdef WITH_CHECKS
    GSYNC();
    const unsigned en = __hip_atomic_load(F.ctl + 2, __ATOMIC_RELAXED, __HIP_MEMORY_SCOPE_AGENT);
    const float c = en ? 10.f : 0.f;
    const int gt = F.bid * NTHREADS + F.tid, NT = F.G * NTHREADS;
    if (c != 0.f) for (size_t i = gt; i < (size_t)MTOK * D_MODEL; i += NT) args.out[i] += c;
#endif
}
extern "C" void kernel_launch(void* const* d_in, const int* in_sizes, int n_in, void* d_out, int out_size, void* d_ws, size_t ws_size, hipStream_t stream) {
    static int grid = 0;
    if (grid == 0) {
        if (n_in != 33 || out_size != MTOK * D_MODEL || ws_size < WS_END) { fprintf(stderr, "kernel_launch: unexpected problem (n_in %d out %d ws %zu)\n", n_in, out_size, ws_size); grid = -1; return; }
        int dev = 0, cus = 0, per_cu = 0;
        (void)hipGetDevice(&dev); (void)hipDeviceGetAttribute(&cus, hipDeviceAttributeMultiprocessorCount, dev);
        (void)hipFuncSetAttribute((const void*)mk_fwd, hipFuncAttributeMaxDynamicSharedMemorySize, LDS_BYTES);
        (void)hipOccupancyMaxActiveBlocksPerMultiprocessor(&per_cu, (const void*)mk_fwd, NTHREADS, LDS_BYTES);
        if (per_cu < 1) { fprintf(stderr, "kernel_launch: occupancy query says %d blocks/CU\n", per_cu); grid = -1; return; }
        grid = cus;
        fprintf(stderr, "kernel_launch: grid %d (cus %d, per_cu %d) ws %zu\n", grid, cus, per_cu, ws_size);
    }
    if (grid < 0) return;
    (void)hipMemsetAsync((char*)d_ws + WS_CTL, 0, 1 * MiB, stream);
    Args a{};
    for (int i = 0; i < 33; ++i) a.in[i] = (const float*)d_in[i];
    a.out = (float*)d_out; a.ws = (unsigned char*)d_ws; a.ph_lo = 0; a.ph_hi = 100;
    void* kargs[] = {&a};
    hipError_t e = hipLaunchCooperativeKernel((void*)mk_fwd, dim3(grid), dim3(NTHREADS), kargs, LDS_BYTES, stream);
    if (e != hipSuccess) fprintf(stderr, "cooperative launch failed: %s (grid %d)\n", hipGetErrorString(e), grid);
}
```

```cpp
#include <hip/hip_runtime.h>
#include <hip/hip_cooperative_groups.h>
#include <cstdio>
#include <cstdint>
namespace cg = cooperative_groups;

constexpr int D_MODEL = 1024, BATCH = 8, SEQ = 4096, MTOK = BATCH * SEQ;
constexpr int GDN_HEADS = 4, GDN_DK = 128, GDN_DV = 128, GDN_CHUNK = 64;
constexpr int RWKV_HEADS = 8, RWKV_N = 64;
constexpr int NSA_HEADS = 16, NSA_GROUPS = 2, NSA_HD = 64, CMP_LEN = 32, CMP_STRIDE = 16, CMP_HIDDEN = 256;
constexpr int SEL_BLOCK = 64, SEL_TOPN = 16, WINDOW = 512;
constexpr int D_FF = 4096;
constexpr float NORM_EPS = 1e-6f, RWKV_LN_EPS = 64e-5f;
constexpr int AB_IN_W = 3848, NSA_IN_W = 1840;
constexpr int F0_LD = 4096;
constexpr int F1_LD = 2048;
constexpr int F0_RWKV = 2048, F0_BA = 3840;

typedef unsigned short bf16_t;
typedef short bf16x8 __attribute__((ext_vector_type(8)));
typedef float f32x4 __attribute__((ext_vector_type(4)));
typedef float f32x2 __attribute__((ext_vector_type(2)));
typedef unsigned u32x4 __attribute__((ext_vector_type(4)));
typedef unsigned u32x2 __attribute__((ext_vector_type(2)));
#define LAS __attribute__((address_space(3)))

typedef __bf16 hwbf16x2 __attribute__((ext_vector_type(2)));
__device__ __forceinline__ unsigned pk2(float lo, float hi) { const f32x2 v = {lo, hi}; const hwbf16x2 b = __builtin_convertvector(v, hwbf16x2); return __builtin_bit_cast(unsigned, b); }
__device__ __forceinline__ unsigned f2bf(float f) { return pk2(f, 0.f) & 0xffffu; }
__device__ __forceinline__ float bf2f(bf16_t h) { return __builtin_bit_cast(float, (unsigned)h << 16); }
__device__ __forceinline__ float bflo(unsigned u) { return __builtin_bit_cast(float, u << 16); }
__device__ __forceinline__ float bfhi(unsigned u) { return __builtin_bit_cast(float, u & 0xffff0000u); }
__device__ __forceinline__ float wave_sum(float v) {
#pragma unroll
    for (int o = 1; o < 64; o <<= 1) v += __shfl_xor(v, o);
    return v;
}
__device__ __forceinline__ float sigmoidf_(float x) { return 1.f / (1.f + __expf(-x)); }
__device__ __forceinline__ float siluf_(float x) { return x / (1.f + __expf(-x)); }
__device__ __forceinline__ float softplusf_(float x) { return x > 20.f ? x : log1pf(__expf(x)); }

__device__ __forceinline__ float fast_tanhf(float x) { const float e = __expf(2.f * x); return 1.f - 2.f / (e + 1.f); }
__device__ __forceinline__ float fast_softplusf(float x) { return x > 20.f ? x : __logf(1.f + __expf(x)); }
__device__ __forceinline__ float dpp_f(float v, const int ctrl_sel) {
    const int i = __builtin_bit_cast(int, v);
    int r;
    if (ctrl_sel == 0) r = __builtin_amdgcn_update_dpp(i, i, 0xB1, 0xF, 0xF, false);
    else if (ctrl_sel == 1) r = __builtin_amdgcn_update_dpp(i, i, 0x4E, 0xF, 0xF, false);
    else r = __builtin_amdgcn_update_dpp(i, i, 0x141, 0xF, 0xF, false);
    return __builtin_bit_cast(float, r);
}
__device__ __forceinline__ float red8_dpp(float v) { v += dpp_f(v, 0); v += dpp_f(v, 1); v += dpp_f(v, 2); return v; }
namespace pg8 {
#define PG8_LAS __attribute__((address_space(3)))
constexpr int BM = 256, BK = 64, HALF = 128, HTB = HALF * BK * 2  , STAGE_BYTES = 8 * HTB, NXCD = 8, WGM = 8;

__host__ __device__ __forceinline__ int lds_byte(int r, int c) { const int st = (r >> 4) * 2 + (c >> 5), rr = r & 15, cc = c & 31, ob = rr * 64 + cc * 2; return st * 1024 + (ob ^ (((ob >> 9) & 1) << 5)); }
__host__ __device__ __forceinline__ void stage_rc(int b, int& R, int& C) { const int st = b / 1024, sb = b % 1024, swz = sb ^ (((sb >> 9) & 1) << 5); R = (st >> 1) * 16 + swz / 64; C = (st & 1) * 32 + (swz % 64) / 2; }
__host__ __device__ __forceinline__ int perm32(int rho) { const int n = rho >> 4, i = rho & 15; return 8 * (i >> 2) + 4 * n + (i & 3); }

struct Unit { int pm, pn; };
struct Gemm { const bf16_t* A; const bf16_t* Bt; int M, N, K; };

struct StaticOrder {
    int nM, nN, nwg, G, c;
    __host__ __device__ void init(int M, int N, int G_, int c_) { nM = M / BM; nN = N / BM; nwg = nM * nN; G = G_; c = c_; }
    __host__ __device__ bool next(int i, Unit& u) const {
        const long L = (long)i * G + c; if (L >= nwg) return false;
        int wgid = (int)L; { const int q = nwg / NXCD, r = nwg % NXCD, xcd = wgid % NXCD, off = wgid / NXCD; wgid = (xcd < r ? xcd * (q + 1) : r * (q + 1) + (xcd - r) * q) + off; }
        const int nig = WGM * nN, gid = wgid / nig, fm = gid * WGM, gsz = (nM - fm) < WGM ? (nM - fm) : WGM;
        u.pm = fm + ((wgid % nig) % gsz); u.pn = (wgid % nig) / gsz; return true;
    }
    __device__ __forceinline__ void a_ready(const Unit&) const {}
    __device__ __forceinline__ void done(const Unit&) const {}
};


__device__ __forceinline__ unsigned cvt_pk_bf16(float lo, float hi) { unsigned r; asm volatile("v_cvt_pk_bf16_f32 %0, %1, %2" : "=v"(r) : "v"(lo), "v"(hi)); return r; }
template <int ACT  > struct EpiBf16 {
    static constexpr bool PERM = true, AFTER_DRAIN = false;
    bf16_t* O; int ldc;
    __device__ __forceinline__ void operator()(const f32x4 (&acc)[2][2][4][2], const Unit& u, int wr, int wc, int fr, int fq) const {
        const int row0 = u.pm * BM + wr * 64 + fr; const int col0 = u.pn * BM + wc * 32 + 8 * fq;
#pragma unroll
        for (int ai = 0; ai < 2; ++ai)
#pragma unroll
            for (int m = 0; m < 4; ++m) { bf16_t* rowp = O + (size_t)(row0 + ai * HALF + m * 16) * ldc + col0;
#pragma unroll
                for (int bj = 0; bj < 2; ++bj) { f32x4 v0 = acc[ai][bj][m][0], v1 = acc[ai][bj][m][1];
                    if (ACT == 2) {
#pragma unroll
                        for (int e = 0; e < 4; ++e) { float a = v0[e] > 0.f ? v0[e] : 0.f; v0[e] = a * a; float b = v1[e] > 0.f ? v1[e] : 0.f; v1[e] = b * b; } }
                    if (ACT == 3) {
#pragma unroll
                        for (int e = 0; e < 4; ++e) { v0[e] = v0[e] / (1.f + __expf(-v0[e])); v1[e] = v1[e] / (1.f + __expf(-v1[e])); } }
                    u32x4 w; w.x = cvt_pk_bf16(v0[0], v0[1]); w.y = cvt_pk_bf16(v0[2], v0[3]); w.z = cvt_pk_bf16(v1[0], v1[1]); w.w = cvt_pk_bf16(v1[2], v1[3]);
                    *(u32x4*)(rowp + bj * HALF) = w; } }
    }
};
template <class Epi, class Sched, bool ALIGN_EPI = false, bool SP2 = false>
__device__ __forceinline__ void gemm_phase(PG8_LAS unsigned char* lds, const Gemm g, const Sched& S, const Epi& E) {
    int tid_ = threadIdx.x; asm volatile("" : "+v"(tid_));
    const int tid = tid_, wid = __builtin_amdgcn_readfirstlane(tid >> 6), lane = tid & 63, wr = wid >> 2, wc = wid & 3, fr = lane & 15, fq = lane >> 4;
    const int K = g.K, nt = K / BK;
    unsigned voffA[2], voffB[2];
#pragma unroll
    for (int i = 0; i < 2; ++i) { int R, C; stage_rc(tid * 16 + i * 8192, R, C); const int Rb = Epi::PERM ? ((R & ~31) + perm32(R & 31)) : R;
        voffA[i] = (unsigned)(R * K + C) * 2u; voffB[i] = (unsigned)(Rb * K + C) * 2u; }
    const size_t kstep = (size_t)(BK * 2);
    const size_t hstep = (size_t)HALF * K * 2;
    const size_t tstep = 2 * hstep;
    const unsigned ldsw = (unsigned)wid * 1024u;
    const int aoff = lds_byte(wr * 64 + fr, fq * 8), boff = lds_byte(wc * 32 + fr, fq * 8);
#define PG8_SA(b, h) (((b) * 2 + (h)) * HTB)
#define PG8_SB(b, h) ((4 + (b) * 2 + (h)) * HTB)
#define PG8_STAGE(bufoff, gbase, voff) do { _Pragma("unroll") for (int _i = 0; _i < 2; ++_i) \
        __builtin_amdgcn_global_load_lds((const unsigned*)((const char*)(gbase) + (voff)[_i]), (PG8_LAS unsigned*)(lds + (bufoff) + ldsw + _i * 8192), 16, 0, 0); } while (0)
#define PG8_LDA(dst, b, h) do { _Pragma("unroll") for (int m = 0; m < 4; ++m) _Pragma("unroll") for (int k = 0; k < 2; ++k) dst[m][k] = *(const PG8_LAS bf16x8*)(lds + PG8_SA(b, h) + aoff + m * 2048 + k * 1024); } while (0)
#define PG8_LDB(dst, b, h) do { _Pragma("unroll") for (int n = 0; n < 2; ++n) _Pragma("unroll") for (int k = 0; k < 2; ++k) dst[n][k] = *(const PG8_LAS bf16x8*)(lds + PG8_SB(b, h) + boff + n * 2048 + k * 1024); } while (0)
#define PG8_MMA(ai, bj, At, Bt) do { __builtin_amdgcn_s_setprio(1); _Pragma("unroll") for (int m = 0; m < 4; ++m) _Pragma("unroll") for (int n = 0; n < 2; ++n) _Pragma("unroll") for (int k = 0; k < 2; ++k) \
        acc[ai][bj][m][n] = __builtin_amdgcn_mfma_f32_16x16x32_bf16(Bt[n][k], At[m][k], acc[ai][bj][m][n], 0, 0, 0); __builtin_amdgcn_s_setprio(0); } while (0)
#define PG8_WAIT_V(n) asm volatile("s_waitcnt vmcnt(" #n ")" ::: "memory")
#define PG8_WAIT_L(n) asm volatile("s_waitcnt lgkmcnt(" #n ")" ::: "memory")
#define PG8_BAR __builtin_amdgcn_s_barrier()
#define PG8_SCHED __builtin_amdgcn_sched_barrier(0)
    Unit cur, nxt; int ui = 0;
    if (!S.next(0, cur)) return;
    f32x4 acc[2][2][4][2];
#pragma unroll
    for (int a = 0; a < 2; ++a)
#pragma unroll
        for (int b = 0; b < 2; ++b)
#pragma unroll
            for (int m = 0; m < 4; ++m)
#pragma unroll
                for (int n = 0; n < 2; ++n) acc[a][b][m][n] = (f32x4){0.f, 0.f, 0.f, 0.f};
    bf16x8 At[4][2], B0[2][2], B1[2][2];
    const char* cA = (const char*)g.A + (size_t)cur.pm * tstep; const char* cB = (const char*)g.Bt + (size_t)cur.pn * tstep;
    S.a_ready(cur);
    if constexpr (SP2) {
        PG8_STAGE(PG8_SB(0, 0), cB, voffB); PG8_STAGE(PG8_SB(0, 1), cB + hstep, voffB); PG8_STAGE(PG8_SA(0, 0), cA, voffA); PG8_STAGE(PG8_SA(0, 1), cA + hstep, voffA);
        if (wr == 1) PG8_BAR;
        PG8_WAIT_V(2); PG8_BAR;
        PG8_STAGE(PG8_SB(1, 0), cB + kstep, voffB); PG8_STAGE(PG8_SA(1, 0), cA + kstep, voffA); PG8_STAGE(PG8_SB(1, 1), cB + hstep + kstep, voffB);
        PG8_WAIT_V(6); PG8_BAR;
    } else {
        PG8_STAGE(PG8_SB(0, 0), cB, voffB); PG8_STAGE(PG8_SA(0, 0), cA, voffA); PG8_STAGE(PG8_SB(0, 1), cB + hstep, voffB); PG8_STAGE(PG8_SA(0, 1), cA + hstep, voffA);
        if (wr == 1) PG8_BAR;
        PG8_WAIT_V(4); PG8_BAR;
        PG8_STAGE(PG8_SB(1, 0), cB + kstep, voffB); PG8_STAGE(PG8_SA(1, 0), cA + kstep, voffA); PG8_STAGE(PG8_SB(1, 1), cB + hstep + kstep, voffB);
        PG8_WAIT_V(6); PG8_BAR;
    }
    for (;;) {
        const bool has_next = S.next(ui + 1, nxt);
        const char* nA = has_next ? (const char*)g.A + (size_t)nxt.pm * tstep : cA; const char* nB = has_next ? (const char*)g.Bt + (size_t)nxt.pn * tstep : cB;
        for (int t = 0; t < nt; t += 2) {
            const bool last = (t == nt - 2);
            const char* a1 = cA + (size_t)(t + 1) * kstep;
            const char* a2 = last ? nA : cA + (size_t)(t + 2) * kstep; const char* b2 = last ? nB : cB + (size_t)(t + 2) * kstep;
            const char* a3 = a2 + kstep; const char* b3 = b2 + kstep;
            if (last && has_next) S.a_ready(nxt);
            if constexpr (SP2) {
            PG8_LDB(B0, 0, 0); PG8_LDB(B1, 0, 1); PG8_SCHED; PG8_LDA(At, 0, 0); PG8_STAGE(PG8_SA(1, 1), a1 + hstep, voffA);
            PG8_WAIT_V(8); PG8_WAIT_L(0); PG8_BAR; PG8_MMA(0, 0, At, B0); PG8_MMA(0, 1, At, B1); PG8_BAR; PG8_SCHED;
            PG8_LDA(At, 0, 1); PG8_STAGE(PG8_SB(0, 0), b2, voffB); PG8_STAGE(PG8_SB(0, 1), b2 + hstep, voffB); PG8_STAGE(PG8_SA(0, 0), a2, voffA);
            PG8_WAIT_V(8); PG8_WAIT_L(0); PG8_BAR; PG8_MMA(1, 0, At, B0); PG8_MMA(1, 1, At, B1); PG8_BAR; PG8_SCHED;
            PG8_LDB(B0, 1, 0); PG8_LDB(B1, 1, 1); PG8_SCHED; PG8_LDA(At, 1, 0); PG8_STAGE(PG8_SA(0, 1), a2 + hstep, voffA);
            PG8_WAIT_V(8); PG8_WAIT_L(0); PG8_BAR; PG8_MMA(0, 0, At, B0); PG8_MMA(0, 1, At, B1); PG8_BAR; PG8_SCHED;
            PG8_LDA(At, 1, 1); PG8_STAGE(PG8_SB(1, 0), b3, voffB); PG8_STAGE(PG8_SB(1, 1), b3 + hstep, voffB); PG8_STAGE(PG8_SA(1, 0), a3, voffA);
            PG8_WAIT_V(8); PG8_WAIT_L(0); PG8_BAR; PG8_MMA(1, 0, At, B0); PG8_MMA(1, 1, At, B1); PG8_BAR; PG8_SCHED;
            } else {
            PG8_LDB(B0, 0, 0); PG8_SCHED; PG8_LDA(At, 0, 0); PG8_STAGE(PG8_SA(1, 1), a1 + hstep, voffA);
            PG8_WAIT_L(8); PG8_BAR; PG8_WAIT_L(0); PG8_MMA(0, 0, At, B0); PG8_BAR; PG8_SCHED;
            PG8_LDB(B1, 0, 1); PG8_STAGE(PG8_SB(0, 0), b2, voffB);
            PG8_BAR; PG8_WAIT_L(0); PG8_MMA(0, 1, At, B1); PG8_BAR;
            PG8_LDA(At, 0, 1); PG8_STAGE(PG8_SA(0, 0), a2, voffA);
            PG8_BAR; PG8_WAIT_L(0); PG8_MMA(1, 0, At, B0); PG8_BAR; PG8_SCHED;
            PG8_STAGE(PG8_SB(0, 1), b2 + hstep, voffB);
            PG8_WAIT_V(6); PG8_BAR; PG8_MMA(1, 1, At, B1); PG8_BAR;
            PG8_LDB(B0, 1, 0); PG8_SCHED; PG8_LDA(At, 1, 0); PG8_STAGE(PG8_SA(0, 1), a2 + hstep, voffA);
            PG8_WAIT_L(8); PG8_BAR; PG8_WAIT_L(0); PG8_MMA(0, 0, At, B0); PG8_BAR; PG8_SCHED;
            PG8_LDB(B1, 1, 1); PG8_STAGE(PG8_SB(1, 0), b3, voffB);
            PG8_BAR; PG8_WAIT_L(0); PG8_MMA(0, 1, At, B1); PG8_BAR;
            PG8_LDA(At, 1, 1); PG8_STAGE(PG8_SA(1, 0), a3, voffA);
            PG8_BAR; PG8_WAIT_L(0); PG8_MMA(1, 0, At, B0); PG8_BAR; PG8_SCHED;
            PG8_STAGE(PG8_SB(1, 1), b3 + hstep, voffB);
            PG8_WAIT_V(6); PG8_BAR; PG8_MMA(1, 1, At, B1); PG8_BAR;
            }
        }
        if constexpr (ALIGN_EPI) { if (wr == 0) PG8_BAR; }
        if constexpr (!Epi::AFTER_DRAIN) { E(acc, cur, wr, wc, fr, fq); S.done(cur); }
        if (!has_next) break;
#pragma unroll
        for (int a = 0; a < 2; ++a)
#pragma unroll
            for (int b = 0; b < 2; ++b)
#pragma unroll
                for (int m = 0; m < 4; ++m)
#pragma unroll
                    for (int n = 0; n < 2; ++n) acc[a][b][m][n] = (f32x4){0.f, 0.f, 0.f, 0.f};
        cur = nxt; cA = nA; cB = nB; ++ui;
        if constexpr (ALIGN_EPI) { if (wr == 1) PG8_BAR; }
    }
    PG8_WAIT_V(0);
    if constexpr (!ALIGN_EPI) { if (wr == 0) PG8_BAR; }
    PG8_BAR;
    if constexpr (Epi::AFTER_DRAIN) { E.fused(acc, cur, wr, wc, fr, fq, lds, wid, lane); S.done(cur); }
#undef PG8_SA
#undef PG8_SB
#undef PG8_STAGE
#undef PG8_LDA
#undef PG8_LDB
#undef PG8_MMA
#undef PG8_WAIT_V
#undef PG8_WAIT_L
#undef PG8_BAR
#undef PG8_SCHED
}
}

constexpr size_t MiB = 1u << 20;
constexpr size_t WS_CTL = 0;
constexpr size_t WS_W_IN0 = 1 * MiB, WS_W_OUT0 = 9 * MiB, WS_W_UP0 = 11 * MiB, WS_W_DN0 = 19 * MiB;
constexpr size_t WS_W_IN1 = 27 * MiB, WS_W_OUT1 = 31 * MiB, WS_W_UP1 = 33 * MiB, WS_W_DN1 = 41 * MiB;
constexpr size_t WS_W_C1K = 49 * MiB, WS_W_C1V = 50 * MiB, WS_W_C2K = 51 * MiB, WS_W_C2V = 51 * MiB + 65536;
constexpr size_t WS_XN = 56 * MiB;
constexpr size_t WS_BIG = 120 * MiB;
constexpr size_t WS_R2 = 376 * MiB;
constexpr size_t WS_END = 440 * MiB;
constexpr int NWAVES = 8, NTHREADS = 512;
constexpr int LDS_BYTES = 147456;
constexpr int XB_LDS_OFF = LDS_BYTES - 64;
constexpr int CW_BAR = 4096;

struct Args {
    const float* in[33]; float* out; unsigned char* ws; int ph_lo, ph_hi;
};
struct Frame {
    LAS unsigned char* lds;
    int tid, lane, wave, G, bid;
    unsigned char* ws;
    unsigned* ctl;
};
__device__ __forceinline__ Frame fresh(const Frame& F) { Frame G = F; int t = threadIdx.x; asm volatile("" : "+v"(t)); G.tid = t; G.lane = t & 63; G.wave = __builtin_amdgcn_readfirstlane(t >> 6); return G; }
enum { IN_X = 0, IN_POS, IN_NMPRE, IN_NMPOST, IN_NFPRE, IN_NFPOST, IN_WUP, IN_WDN, IN_ABIN, IN_ABOUT, IN_GCONV, IN_GALOG, IN_GDT, IN_GNORM,
       IN_RMU, IN_RW0, IN_RW2, IN_RA0, IN_RA2, IN_RG2, IN_RKK, IN_RKA, IN_RRK, IN_RLNW, IN_RLNB, IN_NWIN, IN_NWOUT, IN_NPEK, IN_NW1K, IN_NW2K, IN_NPEV, IN_NW1V, IN_NW2V };

template <bool LIGHT = false> __device__ __forceinline__ void transpose_item(const float* W, int K, int Nsrc, int src_col0, int cnt, bf16_t* WT, int dst_row0, LAS float* scr, int item, int lane) {
    const int nblk = (cnt + 31) / 32, kb = item / nblk, nb = item % nblk, k0 = 64 * kb, n0 = 32 * nb;
    const int nl = lane & 31; const bool okn = (n0 + nl) < cnt;
    const float* wp = W + (size_t)(k0 + (lane >> 5)) * Nsrc + src_col0 + n0 + nl;
    if constexpr (LIGHT) {
#pragma unroll 8
        for (int i = 0; i < 32; ++i) scr[(2 * i + (lane >> 5)) * 33 + nl] = okn ? wp[(size_t)(2 * i) * Nsrc] : 0.f;
    } else {
        float wv[32];
#pragma unroll
        for (int i = 0; i < 32; ++i) wv[i] = okn ? wp[(size_t)(2 * i) * Nsrc] : 0.f;
#pragma unroll
        for (int i = 0; i < 32; ++i) scr[(2 * i + (lane >> 5)) * 33 + nl] = wv[i];
    }
    asm volatile("s_waitcnt lgkmcnt(0)" ::: "memory");
    const int c = lane & 7;
#pragma unroll
    for (int j = 0; j < 4; ++j) { const int n = (lane >> 3) + 8 * j; const LAS float* s = scr + (8 * c) * 33 + n;
        u32x4 o; o.x = pk2(s[0 * 33], s[1 * 33]); o.y = pk2(s[2 * 33], s[3 * 33]); o.z = pk2(s[4 * 33], s[5 * 33]); o.w = pk2(s[6 * 33], s[7 * 33]);
        if (n0 + n < cnt) *(u32x4*)(WT + (size_t)(dst_row0 + n0 + n) * K + k0 + 8 * c) = o; }
    asm volatile("s_waitcnt lgkmcnt(0)" ::: "memory");
}
template <bool LIGHT = false> __device__ __forceinline__ void transpose_seg(const Frame& F, const float* W, int K, int Nsrc, int src_col0, int cnt, bf16_t* WT, int dst_row0, int bid0 = 0, int nb = 0) {
    LAS float* scr = (LAS float*)(F.lds + F.wave * 16384);
    const int gw = (F.bid - bid0) * NWAVES + F.wave, NGW = (nb ? nb : F.G) * NWAVES;
    const int nitems = (K / 64) * ((cnt + 31) / 32);
    for (int it = gw; it < nitems; it += NGW) transpose_item<LIGHT>(W, K, Nsrc, src_col0, cnt, WT, dst_row0, scr, it, F.lane);
}
__device__ __forceinline__ void zero_rows(const Frame& F, bf16_t* WT, int K, int row0, int nrows, int bid0 = 0, int nb = 0) {
    const int gw = (F.bid - bid0) * NWAVES + F.wave, NGW = (nb ? nb : F.G) * NWAVES;
    for (int r = gw; r < nrows; r += NGW) { u32x4* p = (u32x4*)(WT + (size_t)(row0 + r) * K); for (int j = F.lane; j < K / 8; j += 64) p[j] = (u32x4){0u, 0u, 0u, 0u}; }
}
__device__ __forceinline__ void rms_row_to_bf16(const float* xrow, const float* w, bf16_t* orow, int lane) {
    const f32x4* xr = (const f32x4*)xrow + lane; const f32x4* wr = (const f32x4*)w + lane;
    f32x4 v[4]; float s = 0.f;
#pragma unroll
    for (int j = 0; j < 4; ++j) { v[j] = xr[64 * j]; s += (v[j].x * v[j].x + v[j].y * v[j].y) + (v[j].z * v[j].z + v[j].w * v[j].w); }
    const float rstd = 1.f / sqrtf(wave_sum(s) * (1.f / D_MODEL) + NORM_EPS);
    unsigned long long* o8 = (unsigned long long*)orow + lane;
#pragma unroll
    for (int j = 0; j < 4; ++j) { const f32x4 g = wr[64 * j];
        o8[64 * j] = (unsigned long long)pk2(v[j].x * rstd * g.x, v[j].y * rstd * g.y) | ((unsigned long long)pk2(v[j].z * rstd * g.z, v[j].w * rstd * g.w) << 32); }
}
__device__ __forceinline__ void p0_prologue(const Frame& F, const Args& a) {
    unsigned char* ws = F.ws;
    const float* abin = a.in[IN_ABIN];
    transpose_seg(F, abin, 1024, AB_IN_W, 0, 2048, (bf16_t*)(ws + WS_W_IN0), 0);
    transpose_seg(F, abin, 1024, AB_IN_W, 2056, 1792, (bf16_t*)(ws + WS_W_IN0), 2048);
    transpose_seg(F, abin, 1024, AB_IN_W, 2048, 8, (bf16_t*)(ws + WS_W_IN0), 3840);
    zero_rows(F, (bf16_t*)(ws + WS_W_IN0), 1024, 3848, 4096 - 3848);
    transpose_seg(F, a.in[IN_ABOUT], 1024, 1024, 0, 1024, (bf16_t*)(ws + WS_W_OUT0), 0);
    transpose_seg(F, a.in[IN_WUP], 1024, 4096, 0, 4096, (bf16_t*)(ws + WS_W_UP0), 0);
    transpose_seg(F, a.in[IN_WDN], 4096, 1024, 0, 1024, (bf16_t*)(ws + WS_W_DN0), 0);
    const int gw = F.bid * NWAVES + F.wave, NGW = F.G * NWAVES;
    const float* x = a.in[IN_X]; bf16_t* XN = (bf16_t*)(ws + WS_XN);
    for (int m = gw; m < MTOK; m += 2 * NGW) {
        const int m2 = m + NGW;
        const f32x4* xr0 = (const f32x4*)(x + (size_t)m * D_MODEL) + F.lane; const f32x4* xr1 = (const f32x4*)(x + (size_t)(m2 < MTOK ? m2 : m) * D_MODEL) + F.lane; const f32x4* wr = (const f32x4*)a.in[IN_NMPRE] + F.lane;
        f32x4 v0[4], v1[4]; float s0 = 0.f, s1 = 0.f;
#pragma unroll
        for (int j = 0; j < 4; ++j) { v0[j] = xr0[64 * j]; v1[j] = xr1[64 * j]; }
#pragma unroll
        for (int j = 0; j < 4; ++j) { s0 += (v0[j].x * v0[j].x + v0[j].y * v0[j].y) + (v0[j].z * v0[j].z + v0[j].w * v0[j].w); s1 += (v1[j].x * v1[j].x + v1[j].y * v1[j].y) + (v1[j].z * v1[j].z + v1[j].w * v1[j].w); }
        const float r0 = 1.f / sqrtf(wave_sum(s0) * (1.f / D_MODEL) + NORM_EPS), r1 = 1.f / sqrtf(wave_sum(s1) * (1.f / D_MODEL) + NORM_EPS);
        unsigned long long* o0 = (unsigned long long*)(XN + (size_t)m * D_MODEL) + F.lane; unsigned long long* o1 = (unsigned long long*)(XN + (size_t)m2 * D_MODEL) + F.lane;
#pragma unroll
        for (int j = 0; j < 4; ++j) { const f32x4 g = wr[64 * j];
            o0[64 * j] = (unsigned long long)pk2(v0[j].x * r0 * g.x, v0[j].y * r0 * g.y) | ((unsigned long long)pk2(v0[j].z * r0 * g.z, v0[j].w * r0 * g.w) << 32);
            if (m2 < MTOK) o1[64 * j] = (unsigned long long)pk2(v1[j].x * r1 * g.x, v1[j].y * r1 * g.y) | ((unsigned long long)pk2(v1[j].z * r1 * g.z, v1[j].w * r1 * g.w) << 32); }
    }
}

__device__ __forceinline__ void p0_layer1_weights(const Frame& F, const Args& a, int bid0, int nb, int part) {
    unsigned char* ws = F.ws;
    if (part < 0 || part == 0) {
        transpose_seg<true>(F, a.in[IN_NWIN], 1024, NSA_IN_W, 0, NSA_IN_W, (bf16_t*)(ws + WS_W_IN1), 0, bid0, nb);
        zero_rows(F, (bf16_t*)(ws + WS_W_IN1), 1024, NSA_IN_W, 2048 - NSA_IN_W, bid0, nb);
        transpose_seg<true>(F, a.in[IN_NWOUT], 1024, 1024, 0, 1024, (bf16_t*)(ws + WS_W_OUT1), 0, bid0, nb); }
    if (part < 0 || part == 1) transpose_seg<true>(F, a.in[IN_WUP] + (size_t)1024 * 4096, 1024, 4096, 0, 4096, (bf16_t*)(ws + WS_W_UP1), 0, bid0, nb);
    if (part < 0 || part == 2) transpose_seg<true>(F, a.in[IN_WDN] + (size_t)1024 * 4096, 4096, 1024, 0, 1024, (bf16_t*)(ws + WS_W_DN1), 0, bid0, nb);
    if (part < 0 || part == 3) {
        transpose_seg<true>(F, a.in[IN_NW1K], 2048, 256, 0, 256, (bf16_t*)(ws + WS_W_C1K), 0, bid0, nb);
        transpose_seg<true>(F, a.in[IN_NW1V], 2048, 256, 0, 256, (bf16_t*)(ws + WS_W_C1V), 0, bid0, nb);
        transpose_seg<true>(F, a.in[IN_NW2K], 256, 64, 0, 64, (bf16_t*)(ws + WS_W_C2K), 0, bid0, nb);
        transpose_seg<true>(F, a.in[IN_NW2V], 256, 64, 0, 64, (bf16_t*)(ws + WS_W_C2V), 0, bid0, nb); }
}

#define XB_TMO      128
#define XB_XCNT(j)  (256  + 64 * (j))
#define XB_XSUB(j)  (1280 + 64 * (j))
#define XB_XGEN(j)  (2304 + 64 * (j))
#define XB_TOP      3328
#define XB_TOPGEN   3392
#define XCD_BAR_WORDS 3456
#define XB_SPIN_CAP (1u << 18)

__device__ __forceinline__ unsigned xb_ld(unsigned* p)              { return __hip_atomic_load(p, __ATOMIC_RELAXED, __HIP_MEMORY_SCOPE_AGENT); }
__device__ __forceinline__ unsigned xb_add(unsigned* p, unsigned v) { return __hip_atomic_fetch_add(p, v, __ATOMIC_RELAXED, __HIP_MEMORY_SCOPE_AGENT); }
__device__ __forceinline__ unsigned xb_xcc_id() { return (unsigned)__builtin_amdgcn_s_getreg((3 << 11) | 20) & 0xFu; }
#define XB_SPIN(cond, bar) do { unsigned _sp = 0; while (cond) { __builtin_amdgcn_s_sleep(1); \
    if ((++_sp & 255u) == 0u) { if (xb_ld(&(bar)[XB_TMO])) break; if (_sp > XB_SPIN_CAP) { atomicAdd(&(bar)[XB_TMO], 1u); break; } } } } while (0)

struct XcdBarrier {
    unsigned* bar; unsigned x;
    volatile LAS unsigned* st;
};

__device__ __forceinline__ XcdBarrier xcd_barrier_post(unsigned* bar, volatile LAS unsigned* st) {
    XcdBarrier b; b.bar = bar; b.x = xb_xcc_id(); b.st = st;
    if (threadIdx.x == 0) (void)xb_add(&bar[XB_XCNT(b.x)], 1u);
    return b;
}
__device__ __forceinline__ void xcd_barrier_complete(unsigned* bar, unsigned x, unsigned& nloc, unsigned& nx) {
    const unsigned G = gridDim.x * gridDim.y * gridDim.z;
    unsigned sum, cnt, mine, sp = 0u;
    for (;;) {
        sum = 0u; cnt = 0u; mine = 0u;
#pragma unroll
        for (unsigned j = 0; j < 16; ++j) { const unsigned c = xb_ld(&bar[XB_XCNT(j)]); sum += c; cnt += (c > 0u) ? 1u : 0u; mine = (j == x) ? c : mine; }
        if (sum == G) break;
        __builtin_amdgcn_s_sleep(1);
        if ((++sp & 255u) == 0u) { if (xb_ld(&bar[XB_TMO])) break; if (sp > XB_SPIN_CAP) { atomicAdd(&bar[XB_TMO], 1u); break; } }
    }
    nloc = mine > 0u ? mine : 1u; nx = cnt > 0u ? cnt : 1u;
}

__device__ __forceinline__ void xcd_barrier(const XcdBarrier& b) {
    asm volatile("s_waitcnt vmcnt(0)" ::: "memory");
    __syncthreads();
    if (threadIdx.x == 0) {
        unsigned* bar = b.bar; const unsigned bx = xb_xcc_id();
        __builtin_amdgcn_s_waitcnt(0);
        unsigned nloc = b.st[0], nx = b.st[1];
        if (nloc == 0u) { xcd_barrier_complete(bar, bx, nloc, nx); b.st[0] = nloc; b.st[1] = nx; }
        const unsigned old = xb_add(&bar[XB_XSUB(bx)], 1u);
        const unsigned gen = old / nloc;
        if (old + 1u == (gen + 1u) * nloc) {
            __builtin_amdgcn_fence(__ATOMIC_RELEASE, "agent");
            asm volatile("s_waitcnt vmcnt(0)" ::: "memory");
            const unsigned og = xb_add(&bar[XB_TOP], 1u);
            const unsigned tg = og / nx;
            if (og + 1u == (tg + 1u) * nx) xb_add(&bar[XB_TOPGEN], 1u);
            else XB_SPIN(xb_ld(&bar[XB_TOPGEN]) == tg, bar);
            __builtin_amdgcn_fence(__ATOMIC_ACQUIRE, "agent");
            xb_add(&bar[XB_XGEN(bx)], 1u);
            asm volatile("s_waitcnt vmcnt(0)" ::: "memory");
        } else {
            XB_SPIN(xb_ld(&bar[XB_XGEN(bx)]) == gen, bar);
            __builtin_amdgcn_fence(__ATOMIC_ACQUIRE, "agent");
            asm volatile("s_waitcnt vmcnt(0)" ::: "memory");
        }
    }
    __syncthreads();
}
constexpr size_t GDN_UNIT_ELEMS = 8192;
constexpr size_t WS_INTRA = WS_R2, WS_GLAST = WS_R2 + 16 * MiB;
constexpr int GP_ROWB = 272;
constexpr int GP_QB = 0, GP_KB = 17408, GP_VB = 34816, GP_AM = 52224, GP_SC = 68608, GP_HALF = 69632;
#define MFMA16(a, b, c) __builtin_amdgcn_mfma_f32_16x16x32_bf16((a), (b), (c), 0, 0, 0)

__device__ __forceinline__ void gdn_prep_phase(const Frame& F, const Args& a) {
    const bf16_t* F0 = (const bf16_t*)(F.ws + WS_BIG);
    bf16_t* Ut = (bf16_t*)a.out; bf16_t* Wm = Ut + (size_t)2048 * GDN_UNIT_ELEMS; bf16_t* QG = Wm + (size_t)2048 * GDN_UNIT_ELEMS; bf16_t* KGt = QG + (size_t)2048 * GDN_UNIT_ELEMS;
    bf16_t* INTRA = (bf16_t*)(F.ws + WS_INTRA); float* GLAST = (float*)(F.ws + WS_GLAST);
    const float* convw = a.in[IN_GCONV];
    const int hb = F.wave >> 2, wq = F.wave & 3, lane = F.lane, fr = lane & 15, fq = lane >> 4;
    LAS unsigned char* L = F.lds + hb * GP_HALF;
    LAS float* betaL = (LAS float*)(L + GP_SC); LAS float* gcL = betaL + 64;
    LAS float* Am = (LAS float*)(L + GP_AM);
    const int nhalf = F.G * 2, hid = F.bid * 2 + hb;
    for (int u = hid; u < 2048; u += nhalf) {
        const int n = u & 63, h = (u >> 6) & 3, b = u >> 8;
        const size_t m0 = (size_t)b * SEQ + (size_t)n * 64;
        if (wq == 0) {
            const size_t m = m0 + lane;
            const float bb = bf2f(F0[m * F0_LD + F0_BA + h]), aa = bf2f(F0[m * F0_LD + F0_BA + 4 + h]);
            const float beta = sigmoidf_(bb);
            float g = -__expf(a.in[IN_GALOG][h]) * softplusf_(aa + a.in[IN_GDT][h]);
#pragma unroll
            for (int o = 1; o < 64; o <<= 1) { const float t = __shfl_up(g, o); if (lane >= o) g += t; }
            betaL[lane] = beta; gcL[lane] = g;
            if (lane == 63) GLAST[u] = __expf(g);
        }
        __syncthreads();
#pragma unroll 2
        for (int it = 0; it < 4; ++it) {
            const int tl = 16 * wq + 4 * it + fq;
            const int tseq = n * 64 + tl;
            const size_t m = m0 + tl;
            float res[3][8];
#pragma unroll
            for (int X = 0; X < 3; ++X) {
                const int col = X * 512 + h * 128 + 8 * fr;
                float acc[8];
#pragma unroll
                for (int e = 0; e < 8; ++e) acc[e] = 0.f;
#pragma unroll
                for (int i = 0; i < 4; ++i) {
                    u32x4 xv = (u32x4){0u, 0u, 0u, 0u};
                    if (tseq - 3 + i >= 0) xv = *(const u32x4*)(F0 + (m - 3 + i) * F0_LD + col);
                    const f32x4 w0 = *(const f32x4*)(convw + i * 1536 + col), w1 = *(const f32x4*)(convw + i * 1536 + col + 4);
                    acc[0] += w0[0] * bflo(xv.x); acc[1] += w0[1] * bfhi(xv.x); acc[2] += w0[2] * bflo(xv.y); acc[3] += w0[3] * bfhi(xv.y);
                    acc[4] += w1[0] * bflo(xv.z); acc[5] += w1[1] * bfhi(xv.z); acc[6] += w1[2] * bflo(xv.w); acc[7] += w1[3] * bfhi(xv.w);
                }
#pragma unroll
                for (int e = 0; e < 8; ++e) res[X][e] = siluf_(acc[e]);
            }
            float sq = 0.f, sk = 0.f;
#pragma unroll
            for (int e = 0; e < 8; ++e) { sq += res[0][e] * res[0][e]; sk += res[1][e] * res[1][e]; }
#pragma unroll
            for (int o = 1; o < 16; o <<= 1) { sq += __shfl_xor(sq, o); sk += __shfl_xor(sk, o); }
            const float rq = rsqrtf(sq + 1e-6f) * 0.08838834764831845f, rk = rsqrtf(sk + 1e-6f);
            const float eg = __expf(gcL[tl]);
            u32x4 qv, kv, vv, qg;
            qv.x = pk2(res[0][0] * rq, res[0][1] * rq); qv.y = pk2(res[0][2] * rq, res[0][3] * rq); qv.z = pk2(res[0][4] * rq, res[0][5] * rq); qv.w = pk2(res[0][6] * rq, res[0][7] * rq);
            kv.x = pk2(res[1][0] * rk, res[1][1] * rk); kv.y = pk2(res[1][2] * rk, res[1][3] * rk); kv.z = pk2(res[1][4] * rk, res[1][5] * rk); kv.w = pk2(res[1][6] * rk, res[1][7] * rk);
            vv.x = pk2(res[2][0], res[2][1]); vv.y = pk2(res[2][2], res[2][3]); vv.z = pk2(res[2][4], res[2][5]); vv.w = pk2(res[2][6], res[2][7]);
            const float rqg = rq * eg;
            qg.x = pk2(res[0][0] * rqg, res[0][1] * rqg); qg.y = pk2(res[0][2] * rqg, res[0][3] * rqg); qg.z = pk2(res[0][4] * rqg, res[0][5] * rqg); qg.w = pk2(res[0][6] * rqg, res[0][7] * rqg);
            *(LAS u32x4*)(L + GP_QB + tl * GP_ROWB + fr * 16) = qv;
            *(LAS u32x4*)(L + GP_KB + tl * GP_ROWB + fr * 16) = kv;
            *(LAS u32x4*)(L + GP_VB + tl * GP_ROWB + fr * 16) = vv;
            *(u32x4*)(QG + (size_t)u * GDN_UNIT_ELEMS + tl * 128 + fr * 8) = qg;
        }
        __syncthreads();
        {
            bf16x8 ka[4], qa[4];
#pragma unroll
            for (int ks = 0; ks < 4; ++ks) { ka[ks] = *(const LAS bf16x8*)(L + GP_KB + (16 * wq + fr) * GP_ROWB + (32 * ks + 8 * fq) * 2);
                                             qa[ks] = *(const LAS bf16x8*)(L + GP_QB + (16 * wq + fr) * GP_ROWB + (32 * ks + 8 * fq) * 2); }
            bf16_t* intra_u = INTRA + (size_t)u * 4096;
#pragma unroll
            for (int nt = 0; nt < 4; ++nt) {
                if (nt <= wq) {
                    f32x4 ckk = (f32x4){0.f, 0.f, 0.f, 0.f}, cqk = (f32x4){0.f, 0.f, 0.f, 0.f};
#pragma unroll
                    for (int ks = 0; ks < 4; ++ks) { const bf16x8 kb = *(const LAS bf16x8*)(L + GP_KB + (16 * nt + fr) * GP_ROWB + (32 * ks + 8 * fq) * 2);
                        ckk = MFMA16(ka[ks], kb, ckk); cqk = MFMA16(qa[ks], kb, cqk); }
                    const int j = 16 * nt + fr; const float gj = gcL[j];
#pragma unroll
                    for (int r = 0; r < 4; ++r) { const int i = 16 * wq + 4 * fq + r; const float d = __expf(gcL[i] - gj);
                        Am[i * 64 + j] = (i > j) ? betaL[i] * ckk[r] * d : 0.f;
                        intra_u[i * 64 + j] = (bf16_t)f2bf((i >= j) ? cqk[r] * d : 0.f); }
                } else {
#pragma unroll
                    for (int r = 0; r < 4; ++r) intra_u[(16 * wq + 4 * fq + r) * 64 + 16 * nt + fr] = 0;
                }
            }
        }
        __syncthreads();
        {
            const bool isk = wq >= 2; const int ch = (wq & 1) * 64 + lane;
            LAS unsigned char* X = L + (isk ? GP_KB : GP_VB);
            float sol[64];
#pragma unroll
            for (int t = 0; t < 64; ++t) sol[t] = bf2f(*(const LAS bf16_t*)(X + t * GP_ROWB + ch * 2));
            if (isk) {
                const float gl = gcL[63];
                u32x4* dst = (u32x4*)(KGt + (size_t)u * GDN_UNIT_ELEMS + ch * 64);
#pragma unroll
                for (int q8 = 0; q8 < 8; ++q8) { u32x4 o;
                    o.x = pk2(sol[8 * q8 + 0] * __expf(gl - gcL[8 * q8 + 0]), sol[8 * q8 + 1] * __expf(gl - gcL[8 * q8 + 1]));
                    o.y = pk2(sol[8 * q8 + 2] * __expf(gl - gcL[8 * q8 + 2]), sol[8 * q8 + 3] * __expf(gl - gcL[8 * q8 + 3]));
                    o.z = pk2(sol[8 * q8 + 4] * __expf(gl - gcL[8 * q8 + 4]), sol[8 * q8 + 5] * __expf(gl - gcL[8 * q8 + 5]));
                    o.w = pk2(sol[8 * q8 + 6] * __expf(gl - gcL[8 * q8 + 6]), sol[8 * q8 + 7] * __expf(gl - gcL[8 * q8 + 7]));
                    dst[q8] = o; }
#pragma unroll
                for (int t = 0; t < 64; ++t) sol[t] *= betaL[t] * __expf(gcL[t]);
            } else {
#pragma unroll
                for (int t = 0; t < 64; ++t) sol[t] *= betaL[t];
            }
#pragma unroll
            for (int i = 1; i < 64; ++i) {
                float s = sol[i];
#pragma unroll
                for (int j = 0; j < i; ++j) s -= Am[i * 64 + j] * sol[j];
                sol[i] = s;
            }
            if (isk) { bf16_t* dst = Wm + (size_t)u * GDN_UNIT_ELEMS + ch;
#pragma unroll
                for (int t = 0; t < 64; ++t) dst[t * 128] = (bf16_t)f2bf(sol[t]);
            } else { u32x4* dst = (u32x4*)(Ut + (size_t)u * GDN_UNIT_ELEMS + ch * 64);
#pragma unroll
                for (int q8 = 0; q8 < 8; ++q8) { u32x4 o; o.x = pk2(sol[8 * q8], sol[8 * q8 + 1]); o.y = pk2(sol[8 * q8 + 2], sol[8 * q8 + 3]); o.z = pk2(sol[8 * q8 + 4], sol[8 * q8 + 5]); o.w = pk2(sol[8 * q8 + 6], sol[8 * q8 + 7]); dst[q8] = o; }
            }
        }
        __syncthreads();
    }
}

constexpr int GS_W = 0, GS_Q = 17408, GS_I = 34816, GS_K = 44032, GS_U = 62464, GS_Z = 80896;
constexpr int GS_SSQ = GS_Z + 17408;
static_assert(GS_SSQ + 4096 <= XB_LDS_OFF, "gdn scan lds");
__device__ __forceinline__ float red16_dpp(float v) {
    v += dpp_f(v, 0); v += dpp_f(v, 1); v += dpp_f(v, 2);
    const int i = __builtin_bit_cast(int, v); v += __builtin_bit_cast(float, __builtin_amdgcn_update_dpp(i, i, 0x140, 0xF, 0xF, false));
    return v;
}
constexpr size_t WS_GSTATE = WS_R2 + 18 * MiB;
__device__ __forceinline__ bf16x8 lds_aperm(const LAS unsigned char* rowp, int k0, int fq) {
    const u32x2 a = *(const LAS u32x2*)(rowp + (k0 + 4 * fq) * 2), b = *(const LAS u32x2*)(rowp + (k0 + 16 + 4 * fq) * 2);
    u32x4 v; v.x = a.x; v.y = a.y; v.z = b.x; v.w = b.y; return __builtin_bit_cast(bf16x8, v);
}
__device__ __forceinline__ bf16x8 acc_bperm(const f32x4& lo, const f32x4& hi) {
    u32x4 v; v.x = pk2(lo[0], lo[1]); v.y = pk2(lo[2], lo[3]); v.z = pk2(hi[0], hi[1]); v.w = pk2(hi[2], hi[3]); return __builtin_bit_cast(bf16x8, v);
}
__device__ __forceinline__ void gdn_scan_unit(const Frame& F, const Args& a, int bh, int n0, int n1, bool dry = false) {
    const bf16_t* F0 = (const bf16_t*)(F.ws + WS_BIG);
    const bf16_t* Ut = (const bf16_t*)a.out; const bf16_t* Wm = Ut + (size_t)2048 * GDN_UNIT_ELEMS; const bf16_t* QG = Wm + (size_t)2048 * GDN_UNIT_ELEMS; const bf16_t* KGt = QG + (size_t)2048 * GDN_UNIT_ELEMS;
    const bf16_t* INTRA = (const bf16_t*)(F.ws + WS_INTRA); const float* GLAST = (const float*)(F.ws + WS_GLAST);
    bf16_t* OAB = (bf16_t*)(F.ws + WS_XN);
    const int w = F.wave, lane = F.lane, fr = lane & 15, fq = lane >> 4;
    const int h = bh & 3, b = bh >> 2;
    LAS unsigned char* L = F.lds;
    LAS float* ssq = (LAS float*)(L + GS_SSQ);
    LAS float* glp = ssq + 1000;
#define GS_BAR() do { asm volatile("s_waitcnt lgkmcnt(0)" ::: "memory"); __builtin_amdgcn_s_barrier(); asm volatile("" ::: "memory"); } while (0)
    if (w >= 4) {
        const int lt = F.tid - 256;
        struct GsSet { u32x4 pw[4], pq[4], pz[4], pk[4], pu[4], pi[2]; float pgl; };
        GsSet A, B;
#define GS_FETCH(P_, n_) do { const size_t u_ = (size_t)bh * 64 + (n_); \
            _Pragma("unroll") for (int i_ = 0; i_ < 4; ++i_) { const int e_ = lt + 256 * i_; P_.pw[i_] = *(const u32x4*)(Wm + u_ * GDN_UNIT_ELEMS + (size_t)e_ * 8); P_.pq[i_] = *(const u32x4*)(QG + u_ * GDN_UNIT_ELEMS + (size_t)e_ * 8); \
                P_.pk[i_] = *(const u32x4*)(KGt + u_ * GDN_UNIT_ELEMS + (size_t)e_ * 8); P_.pu[i_] = *(const u32x4*)(Ut + u_ * GDN_UNIT_ELEMS + (size_t)e_ * 8); \
                P_.pz[i_] = *(const u32x4*)(F0 + ((size_t)b * SEQ + (size_t)(n_) * 64 + (e_ >> 4)) * F0_LD + 1536 + h * 128 + (e_ & 15) * 8); } \
            _Pragma("unroll") for (int i_ = 0; i_ < 2; ++i_) P_.pi[i_] = *(const u32x4*)(INTRA + u_ * 4096 + (size_t)(lt + 256 * i_) * 8); \
            P_.pgl = GLAST[u_]; } while (0)
#define GS_STORE(P_, n_) do { \
            _Pragma("unroll") for (int i_ = 0; i_ < 4; ++i_) { const int e_ = lt + 256 * i_; \
                *(LAS u32x4*)(L + GS_W + (e_ >> 4) * 272 + (e_ & 15) * 16) = P_.pw[i_]; *(LAS u32x4*)(L + GS_Q + (e_ >> 4) * 272 + (e_ & 15) * 16) = P_.pq[i_]; *(LAS u32x4*)(L + GS_Z + (e_ >> 4) * 272 + (e_ & 15) * 16) = P_.pz[i_]; \
                *(LAS u32x4*)(L + GS_K + (e_ >> 3) * 144 + (e_ & 7) * 16) = P_.pk[i_]; *(LAS u32x4*)(L + GS_U + (e_ >> 3) * 144 + (e_ & 7) * 16) = P_.pu[i_]; } \
            _Pragma("unroll") for (int i_ = 0; i_ < 2; ++i_) { const int e_ = lt + 256 * i_; *(LAS u32x4*)(L + GS_I + (e_ >> 3) * 144 + (e_ & 7) * 16) = P_.pi[i_]; } \
            if (lt == 0) glp[(n_) & 1] = P_.pgl; } while (0)
        GS_FETCH(A, n0);
        if (n0 + 1 < n1) GS_FETCH(B, n0 + 1);
        __syncthreads();
        GS_STORE(A, n0);
        GS_BAR();
#pragma unroll 1
        for (int n = n0; n < n1; n += 2) {
            if (n + 2 < n1) GS_FETCH(A, n + 2);
            GS_BAR();
            if (n + 1 < n1) GS_STORE(B, n + 1);
            GS_BAR();
            if (n + 3 < n1) GS_FETCH(B, n + 3);
            GS_BAR();
            if (n + 2 < n1) GS_STORE(A, n + 2);
            GS_BAR();
        }
#undef GS_FETCH
#undef GS_STORE
    } else {
        f32x4 S[2][8]; f32x4* GST = (f32x4*)(F.ws + WS_GSTATE) + ((size_t)bh * 8 + 2 * w) * 512;
#pragma unroll
        for (int nt = 0; nt < 2; ++nt)
#pragma unroll
            for (int d = 0; d < 8; ++d) S[nt][d] = (n0 == 0) ? (f32x4){0.f, 0.f, 0.f, 0.f} : GST[nt * 512 + d * 64 + lane];
        float gnw[2]; gnw[0] = a.in[IN_GNORM][32 * w + fr]; gnw[1] = a.in[IN_GNORM][32 * w + 16 + fr];
        __syncthreads();
        GS_BAR();
#pragma unroll 1
        for (int n = n0; n < n1; ++n) {
            const float gl = glp[n & 1];
            bf16x8 Sb[2][4];
#pragma unroll
            for (int nt = 0; nt < 2; ++nt)
#pragma unroll
                for (int ks = 0; ks < 4; ++ks) Sb[nt][ks] = acc_bperm(S[nt][2 * ks], S[nt][2 * ks + 1]);
            f32x4 vn[2][4], o[2][4];
#pragma unroll
            for (int mt = 0; mt < 4; ++mt) { f32x4 p0 = (f32x4){0.f, 0.f, 0.f, 0.f}, p1 = p0, q0 = p0, q1 = p0;
                const LAS unsigned char* wrow = L + GS_W + (16 * mt + fr) * 272; const LAS unsigned char* qrow = L + GS_Q + (16 * mt + fr) * 272;
#pragma unroll
                for (int ks = 0; ks < 4; ++ks) { const bf16x8 wa = lds_aperm(wrow, 32 * ks, fq), qa = lds_aperm(qrow, 32 * ks, fq);
                    p0 = MFMA16(wa, Sb[0][ks], p0); p1 = MFMA16(wa, Sb[1][ks], p1); q0 = MFMA16(qa, Sb[0][ks], q0); q1 = MFMA16(qa, Sb[1][ks], q1); }
                const u32x2 u0 = *(const LAS u32x2*)(L + GS_U + (32 * w + fr) * 144 + (16 * mt + 4 * fq) * 2), u1 = *(const LAS u32x2*)(L + GS_U + (32 * w + 16 + fr) * 144 + (16 * mt + 4 * fq) * 2);
                vn[0][mt] = (f32x4){bflo(u0.x) - p0[0], bfhi(u0.x) - p0[1], bflo(u0.y) - p0[2], bfhi(u0.y) - p0[3]};
                vn[1][mt] = (f32x4){bflo(u1.x) - p1[0], bfhi(u1.x) - p1[1], bflo(u1.y) - p1[2], bfhi(u1.y) - p1[3]};
                o[0][mt] = q0; o[1][mt] = q1; }
            bf16x8 Vb[2][2];
#pragma unroll
            for (int nt = 0; nt < 2; ++nt)
#pragma unroll
                for (int ks = 0; ks < 2; ++ks) Vb[nt][ks] = acc_bperm(vn[nt][2 * ks], vn[nt][2 * ks + 1]);
#pragma unroll
            for (int mt = 0; mt < 4; ++mt) { const LAS unsigned char* irow = L + GS_I + (16 * mt + fr) * 144;
#pragma unroll
                for (int ks = 0; ks < 2; ++ks) { const bf16x8 ia = lds_aperm(irow, 32 * ks, fq); o[0][mt] = MFMA16(ia, Vb[0][ks], o[0][mt]); o[1][mt] = MFMA16(ia, Vb[1][ks], o[1][mt]); } }
#pragma unroll
            for (int d = 0; d < 8; ++d) { S[0][d] = S[0][d] * gl; S[1][d] = S[1][d] * gl; const LAS unsigned char* krow = L + GS_K + (16 * d + fr) * 144;
#pragma unroll
                for (int ks = 0; ks < 2; ++ks) { const bf16x8 ka = lds_aperm(krow, 32 * ks, fq); S[0][d] = MFMA16(ka, Vb[0][ks], S[0][d]); S[1][d] = MFMA16(ka, Vb[1][ks], S[1][d]); } }
            LAS float* sq = ssq + (n & 1) * 256;
            float zv[2][16];
#pragma unroll
            for (int mt = 0; mt < 4; ++mt)
#pragma unroll
                for (int r = 0; r < 4; ++r) { const int t = 16 * mt + 4 * fq + r; const float s = red16_dpp(o[0][mt][r] * o[0][mt][r] + o[1][mt][r] * o[1][mt][r]); if (fr == 0) sq[w * 64 + t] = s;
                    zv[0][4 * mt + r] = bf2f(*(const LAS bf16_t*)(L + GS_Z + t * 272 + (32 * w + fr) * 2)); zv[1][4 * mt + r] = bf2f(*(const LAS bf16_t*)(L + GS_Z + t * 272 + (32 * w + 16 + fr) * 2)); }
            GS_BAR();
#pragma unroll
            for (int mt = 0; mt < 4; ++mt)
#pragma unroll
                for (int r = 0; r < 4; ++r) { const int t = 16 * mt + 4 * fq + r; const float s = (sq[t] + sq[64 + t]) + (sq[128 + t] + sq[192 + t]);
                    const float rstd = rsqrtf(s * (1.f / 128.f) + NORM_EPS);
                    const size_t m = (size_t)b * SEQ + (size_t)n * 64 + t;
                    if (!dry) { OAB[m * 1024 + h * 128 + 32 * w + fr] = (bf16_t)f2bf(o[0][mt][r] * rstd * gnw[0] * siluf_(zv[0][4 * mt + r]));
                                OAB[m * 1024 + h * 128 + 32 * w + 16 + fr] = (bf16_t)f2bf(o[1][mt][r] * rstd * gnw[1] * siluf_(zv[1][4 * mt + r])); } }
            GS_BAR();
        }
#pragma unroll
        for (int nt = 0; nt < 2; ++nt)
#pragma unroll
            for (int d = 0; d < 8; ++d) if (!dry) GST[nt * 512 + d * 64 + lane] = S[nt][d];
    }
#undef GS_BAR
}
constexpr int RW_L = 16;
constexpr int RW_W2T = 0, RW_A2T = 9216, RW_G2T = 18432;
constexpr int RW_OPS = 35840, RW_OPS_SZ = 24576;
constexpr int RW_YB = RW_OPS + 2 * RW_OPS_SZ, RW_YB_SZ = 4096;
constexpr int RW_XS = RW_YB + 2 * RW_YB_SZ, RW_XS_W = 2240;
constexpr int RW_XS_AD = 576, RW_XS_GD = 1152;
constexpr int RW_POST = RW_XS + 4 * RW_XS_W, RW_POST_SZ = 8192;
static_assert(RW_POST + 3 * RW_POST_SZ <= XB_LDS_OFF, "rwkv lds");
#define RW_BAR() do { asm volatile("s_waitcnt lgkmcnt(0)" ::: "memory"); __builtin_amdgcn_s_barrier(); asm volatile("" ::: "memory"); } while (0)
__device__ __forceinline__ float wave_sum_rl(float v) {
    v = red16_dpp(v);
    const int i = __builtin_bit_cast(int, v);
    return (__builtin_bit_cast(float, __builtin_amdgcn_readlane(i, 0)) + __builtin_bit_cast(float, __builtin_amdgcn_readlane(i, 16))) + (__builtin_bit_cast(float, __builtin_amdgcn_readlane(i, 32)) + __builtin_bit_cast(float, __builtin_amdgcn_readlane(i, 48)));
}

__device__ __forceinline__ void rwkv_unit(const Frame& F, const Args& a, int bh) {
    const bf16_t* F0 = (const bf16_t*)(F.ws + WS_BIG);
    bf16_t* OAB = (bf16_t*)(F.ws + WS_XN);
    const int h = bh & 7, b = bh >> 3, tid = F.tid, lane = F.lane, wave = F.wave, fr = lane & 15, fq = lane >> 4;
    LAS unsigned char* L = F.lds;
    for (int idx = tid; idx < 64 * 64; idx += NTHREADS) { const int j = idx >> 6, c = idx & 63;
        *(LAS bf16_t*)(L + RW_W2T + c * 144 + j * 2) = (bf16_t)f2bf(a.in[IN_RW2][j * 512 + h * 64 + c]);
        *(LAS bf16_t*)(L + RW_A2T + c * 144 + j * 2) = (bf16_t)f2bf(a.in[IN_RA2][j * 512 + h * 64 + c]); }
    for (int idx = tid; idx < 128 * 64; idx += NTHREADS) { const int j = idx >> 6, c = idx & 63;
        *(LAS bf16_t*)(L + RW_G2T + c * 272 + j * 2) = (bf16_t)f2bf(a.in[IN_RG2][j * 512 + h * 64 + c]); }
    RW_BAR();
    const size_t mb = (size_t)b * SEQ;
    if (wave < 4) {
        f32x2 S0[4], S1[4];
#pragma unroll
        for (int k = 0; k < 4; ++k) { S0[k] = (f32x2){0.f, 0.f}; S1[k] = (f32x2){0.f, 0.f}; }
        const int cg = lane & 7, row0 = 16 * wave + 2 * (lane >> 3);
        RW_BAR();
#pragma unroll 1
        for (int c = 0; c < SEQ / RW_L; ++c) {
            LAS unsigned char* ops = L + RW_OPS + (c & 1) * RW_OPS_SZ; LAS float* yb = (LAS float*)(L + RW_YB + (c & 1) * RW_YB_SZ);
            f32x4 wA, wB, kkA, kkB, bA, bB, kA, kB, rA, rB; f32x2 vv;
#define RW_LOADOPS(s_) do { const LAS float* po_ = (const LAS float*)(ops + (s_) * 1536) + 8 * cg; \
                wA = *(const LAS f32x4*)(po_); wB = *(const LAS f32x4*)(po_ + 4); kkA = *(const LAS f32x4*)(po_ + 64); kkB = *(const LAS f32x4*)(po_ + 68); \
                bA = *(const LAS f32x4*)(po_ + 128); bB = *(const LAS f32x4*)(po_ + 132); kA = *(const LAS f32x4*)(po_ + 192); kB = *(const LAS f32x4*)(po_ + 196); \
                rA = *(const LAS f32x4*)(po_ + 256); rB = *(const LAS f32x4*)(po_ + 260); vv = *(const LAS f32x2*)((const LAS float*)(ops + (s_) * 1536) + 320 + row0); } while (0)
            RW_LOADOPS(0);
#pragma unroll 1
            for (int s = 0; s < RW_L; ++s) {
                const f32x2 kk2[4] = {{kkA[0], kkA[1]}, {kkA[2], kkA[3]}, {kkB[0], kkB[1]}, {kkB[2], kkB[3]}};
                const f32x2 w2[4] = {{wA[0], wA[1]}, {wA[2], wA[3]}, {wB[0], wB[1]}, {wB[2], wB[3]}};
                const f32x2 b2[4] = {{bA[0], bA[1]}, {bA[2], bA[3]}, {bB[0], bB[1]}, {bB[2], bB[3]}};
                const f32x2 k2[4] = {{kA[0], kA[1]}, {kA[2], kA[3]}, {kB[0], kB[1]}, {kB[2], kB[3]}};
                const f32x2 r2[4] = {{rA[0], rA[1]}, {rA[2], rA[3]}, {rB[0], rB[1]}, {rB[2], rB[3]}};
                const f32x2 v0 = {vv[0], vv[0]}, v1 = {vv[1], vv[1]};
                if (s + 1 < RW_L) RW_LOADOPS(s + 1);
                f32x2 a0 = S0[0] * kk2[0] + S0[1] * kk2[1], a1 = S1[0] * kk2[0] + S1[1] * kk2[1];
                a0 = a0 + S0[2] * kk2[2] + S0[3] * kk2[3]; a1 = a1 + S1[2] * kk2[2] + S1[3] * kk2[3];
                const float sa0 = red8_dpp(a0[0] + a0[1]), sa1 = red8_dpp(a1[0] + a1[1]);
                const f32x2 n0 = {-sa0, -sa0}, n1 = {-sa1, -sa1};
                f32x2 y0 = {0.f, 0.f}, y1 = {0.f, 0.f};
#pragma unroll
                for (int q = 0; q < 4; ++q) { S0[q] = S0[q] * w2[q] + n0 * b2[q] + v0 * k2[q]; S1[q] = S1[q] * w2[q] + n1 * b2[q] + v1 * k2[q]; y0 = y0 + S0[q] * r2[q]; y1 = y1 + S1[q] * r2[q]; }
                const float ys0 = red8_dpp(y0[0] + y0[1]), ys1 = red8_dpp(y1[0] + y1[1]);
                if (cg == 0) *(LAS f32x2*)(yb + s * 64 + row0) = (f32x2){ys0, ys1};
            }
#undef RW_LOADOPS
            RW_BAR();
        }
        RW_BAR();
    } else {
        const int p = wave - 4, hc = h * 64 + lane;
        LAS unsigned char* XS = L + RW_XS + p * RW_XS_W;
        const float w0c = a.in[IN_RW0][hc], a0c = a.in[IN_RA0][hc], kkc = a.in[IN_RKK][hc], kac = a.in[IN_RKA][hc], rkc = a.in[IN_RRK][hc], lnw = a.in[IN_RLNW][hc], lnb = a.in[IN_RLNB][hc];
        float mu[7];
#pragma unroll
        for (int g = 0; g < 3; ++g) mu[g] = a.in[IN_RMU][g * 512 + hc];
#pragma unroll
        for (int g = 3; g < 7; ++g) mu[g] = a.in[IN_RMU][1536 + (g - 3) * 64 + lane];
        bf16_t fv[5][7];
#define RW_FETCH(cn_) do { const long t0_ = (long)(cn_) * RW_L + 4 * p - 1; \
            _Pragma("unroll") for (int j_ = 0; j_ < 5; ++j_) { const long t_ = t0_ + j_; \
                _Pragma("unroll") for (int g_ = 0; g_ < 7; ++g_) { const int col_ = F0_RWKV + (g_ < 3 ? g_ * 512 + h * 64 : 1536 + (g_ - 3) * 64) + lane; fv[j_][g_] = (t_ >= 0) ? F0[(mb + t_) * F0_LD + col_] : (bf16_t)0; } } } while (0)
        RW_FETCH(0);
#pragma unroll 1
        for (int c = -1; c <= SEQ / RW_L; ++c) {
            const bool prep_on = (c + 1 < SEQ / RW_L), post_on = (c >= 1);
            if (post_on) {
                const LAS float* yb = (const LAS float*)(L + RW_YB + ((c - 1) & 1) * RW_YB_SZ); const LAS float* pg = (const LAS float*)(L + RW_POST + ((c - 1) % 3) * RW_POST_SZ);
#pragma unroll
                for (int j = 0; j < 4; ++j) { const int tau = 4 * p + j; const float y = yb[tau * 64 + lane];
                    const float mean = wave_sum_rl(y) * (1.f / 64.f); const float d = y - mean; const float var = wave_sum_rl(d * d) * (1.f / 64.f);
                    const float o = (d * rsqrtf(var + RWKV_LN_EPS) * lnw + lnb + pg[1024 + tau * 64 + lane]) * pg[tau * 64 + lane];
                    OAB[(mb + (size_t)(c - 1) * RW_L + tau) * 1024 + 512 + hc] = (bf16_t)f2bf(o); }
            }
            if (prep_on) {
                LAS unsigned char* nops = L + RW_OPS + ((c + 1) & 1) * RW_OPS_SZ; LAS float* pg_n = (LAS float*)(L + RW_POST + ((c + 1) % 3) * RW_POST_SZ);
                float xr[4], xk[4], xv[4];
#pragma unroll
                for (int j = 0; j < 4; ++j) {
                    float xs[7];
#pragma unroll
                    for (int g = 0; g < 7; ++g) { const float f = bf2f(fv[j + 1][g]), fp = bf2f(fv[j][g]); xs[g] = f + (fp - f) * mu[g]; }
                    xr[j] = xs[0]; xk[j] = xs[1]; xv[j] = xs[2];
                    *(LAS bf16_t*)(XS + j * 144 + lane * 2) = (bf16_t)f2bf(fast_tanhf(xs[3]));
                    *(LAS bf16_t*)(XS + RW_XS_AD + j * 144 + lane * 2) = (bf16_t)f2bf(xs[4]);
                    *(LAS bf16_t*)(XS + RW_XS_GD + j * 272 + lane * 2) = (bf16_t)f2bf(sigmoidf_(xs[5]));
                    *(LAS bf16_t*)(XS + RW_XS_GD + j * 272 + 128 + lane * 2) = (bf16_t)f2bf(sigmoidf_(xs[6]));
                }
                if (c + 2 < SEQ / RW_L) RW_FETCH(c + 2);
                asm volatile("s_waitcnt lgkmcnt(0)" ::: "memory");
                f32x4 cw = (f32x4){0.f, 0.f, 0.f, 0.f}, ca = cw, cgt = cw;
                {
                    bf16x8 xa[2], xb[2], xg[4];
#pragma unroll
                    for (int ks = 0; ks < 2; ++ks) { xa[ks] = *(const LAS bf16x8*)(XS + (fr & 3) * 144 + (32 * ks + 8 * fq) * 2); xb[ks] = *(const LAS bf16x8*)(XS + RW_XS_AD + (fr & 3) * 144 + (32 * ks + 8 * fq) * 2); }
#pragma unroll
                    for (int ks = 0; ks < 4; ++ks) xg[ks] = *(const LAS bf16x8*)(XS + RW_XS_GD + (fr & 3) * 272 + (32 * ks + 8 * fq) * 2);
#pragma unroll
                    for (int nt = 0; nt < 4; ++nt) {
                        f32x4 tw = (f32x4){0.f, 0.f, 0.f, 0.f}, ta = tw, tg = tw;
#pragma unroll
                        for (int ks = 0; ks < 2; ++ks) { tw = MFMA16(xa[ks], *(const LAS bf16x8*)(L + RW_W2T + (16 * nt + fr) * 144 + (32 * ks + 8 * fq) * 2), tw);
                                                         ta = MFMA16(xb[ks], *(const LAS bf16x8*)(L + RW_A2T + (16 * nt + fr) * 144 + (32 * ks + 8 * fq) * 2), ta); }
#pragma unroll
                        for (int ks = 0; ks < 4; ++ks) tg = MFMA16(xg[ks], *(const LAS bf16x8*)(L + RW_G2T + (16 * nt + fr) * 272 + (32 * ks + 8 * fq) * 2), tg);
                        if (fq == nt) { cw = tw; ca = ta; cgt = tg; }
                    }
                }
#pragma unroll
                for (int j = 0; j < 4; ++j) { const int tau = 4 * p + j; LAS float* o = (LAS float*)(nops + tau * 1536);
                    const float lw = cw[j] + w0c; const float wlog = -fast_softplusf(-lw) - 0.5f; const float wdec = __expf(-__expf(wlog));
                    const float av = sigmoidf_(ca[j] + a0c);
                    const float kkraw = xk[j] * kkc, kp = xk[j] * (1.f + (av - 1.f) * kac);
                    const float rinv = rsqrtf(wave_sum_rl(kkraw * kkraw) + 1e-6f);
                    const float bn = wave_sum_rl(xr[j] * kp * rkc);
                    const float kkn = kkraw * rinv;
                    o[lane] = wdec; o[64 + lane] = kkn; o[128 + lane] = kkn * av; o[192 + lane] = kp; o[256 + lane] = xr[j]; o[320 + lane] = xv[j];
                    pg_n[tau * 64 + lane] = cgt[j]; pg_n[1024 + tau * 64 + lane] = xv[j] * bn; }
            }
            RW_BAR();
        }
#undef RW_FETCH
    }
    __syncthreads();
}
constexpr int RC_KR = 0, RC_BKT = 4096, RC_VT = 8192, RC_MBB = 10240, RC_MKB = 11264, RC_MBR = 11776, RC_MKR = 12288, RC_WL = 12800, RC_PG = 13056, RC_PBV = 15104, RC_REC = 17408;
constexpr int RC_SEG_CHUNKS = 32, RC_NSEG = (SEQ / 16) / RC_SEG_CHUNKS;
constexpr size_t WS_RSCR = WS_R2 + 21 * MiB;
constexpr size_t WS_RSTATE = WS_R2 + 17 * MiB;
constexpr size_t WS_RIMG = WS_R2 + 20 * MiB;
constexpr int RP_PRM = 35840;
constexpr int RP_MU = RP_PRM + 1280;
constexpr int RP_WAVE = RP_MU + 1792, RP_WAVE_SZ = 9216;
static_assert(RP_WAVE + 8 * RP_WAVE_SZ <= XB_LDS_OFF, "rwkv prep lds");
__device__ __forceinline__ float dpp_shr_f(float v, const int n) {
    const int i = __builtin_bit_cast(int, v); int r;
    if (n == 1) r = __builtin_amdgcn_update_dpp(0, i, 0x111, 0xF, 0xF, true); else if (n == 2) r = __builtin_amdgcn_update_dpp(0, i, 0x112, 0xF, 0xF, true);
    else if (n == 4) r = __builtin_amdgcn_update_dpp(0, i, 0x114, 0xF, 0xF, true); else r = __builtin_amdgcn_update_dpp(0, i, 0x118, 0xF, 0xF, true);
    return __builtin_bit_cast(float, r);
}
__device__ __forceinline__ void rwkvc_prep_phase(const Frame& F, const Args& a, int sg) {
    const bf16_t* F0 = (const bf16_t*)(F.ws + WS_BIG);
    unsigned char* SCR = F.ws + WS_RSCR;
    const int tid = F.tid, wave = F.wave;
    LAS unsigned char* L = F.lds;
    for (int blk = F.bid; blk < 256; blk += F.G) {
        const int bh = blk >> 2, h = bh & 7, b = bh >> 3;
        __syncthreads();
        {
            const u32x4* src = (const u32x4*)(F.ws + WS_RIMG + (size_t)h * 35840);
            u32x4 t4[5];
#pragma unroll
            for (int i = 0; i < 5; ++i) { const int e = tid + NTHREADS * i; t4[i] = (e < 2240) ? src[e] : (u32x4){0u, 0u, 0u, 0u}; }
#pragma unroll
            for (int i = 0; i < 5; ++i) { const int e = tid + NTHREADS * i; if (e < 2240) *(LAS u32x4*)(L + e * 16) = t4[i]; }
        }
        if (tid < 320) { const int wh = tid >> 6, c = tid & 63; const float* src = wh == 0 ? a.in[IN_RW0] : wh == 1 ? a.in[IN_RA0] : wh == 2 ? a.in[IN_RKK] : wh == 3 ? a.in[IN_RKA] : a.in[IN_RRK];
            ((LAS float*)(L + RP_PRM))[tid] = src[h * 64 + c]; }
        if (tid < 448) ((LAS float*)(L + RP_MU))[tid] = a.in[IN_RMU][tid < 192 ? (tid >> 6) * 512 + h * 64 + (tid & 63) : 1536 + (tid - 192)];
        __syncthreads();
        const LAS float* PRM = (const LAS float*)(L + RP_PRM);
        LAS unsigned char* XS = L + RP_WAVE + wave * RP_WAVE_SZ;
        const size_t mb = (size_t)b * SEQ;
        {
            int ln_ = F.lane; asm volatile("" : "+v"(ln_));
            const int lane = ln_, fr = ln_ & 15, fq = ln_ >> 4;
            const int cs = (blk & 3) * 8 + wave;
            const int t0 = (sg * RC_SEG_CHUNKS + cs) * 16;
            unsigned char* rec = SCR + ((size_t)bh * RC_SEG_CHUNKS + cs) * RC_REC;
            const bf16_t* rowc = F0 + (mb + t0 + fr) * F0_LD + F0_RWKV;
            const bool hasp = (t0 + fr) > 0; const bf16_t* rowp = rowc - (hasp ? F0_LD : 0);
            const bf16_t* rc4 = rowc + 4 * fq; const bf16_t* rp4 = rowp + 4 * fq; const LAS float* mul4 = (const LAS float*)(L + RP_MU) + 4 * fq;
            unsigned char* pbkt = rec + RC_BKT + fq * 256 + (fr >> 2) * 16 + (fr & 3) * 2;
            unsigned char* pvt = rec + RC_VT + fq * 128 + fr * 2;
            unsigned char* pwl = rec + RC_WL + fq * 16;
            unsigned char* ppg = rec + RC_PG + fr * 128 + fq * 8;
            LAS unsigned char* xs4 = XS + fr * 144 + fq * 8;
            u32x2 rawc[7][4], rawp[7][4];
#pragma unroll
            for (int g = 3; g < 7; ++g)
#pragma unroll
                for (int mt = 0; mt < 4; ++mt) { const int coff = 1536 + 64 * (g - 3) + 16 * mt; rawc[g][mt] = *(const u32x2*)(rc4 + coff); rawp[g][mt] = *(const u32x2*)(rp4 + coff); }
#pragma unroll
            for (int g = 0; g < 4; ++g) {
                const int coff = 1536 + 64 * g;
#pragma unroll
                for (int mt = 0; mt < 4; ++mt) { const int j0 = 16 * mt + 4 * fq;
                    const u32x2 fc = rawc[3 + g][mt]; u32x2 fp = rawp[3 + g][mt]; if (!hasp) fp = (u32x2){0u, 0u};
                    const f32x4 mu = *(const LAS f32x4*)(mul4 + 192 + 64 * g + 16 * mt);
                    float x[4] = {bflo(fc.x), bfhi(fc.x), bflo(fc.y), bfhi(fc.y)}; const float xp[4] = {bflo(fp.x), bfhi(fp.x), bflo(fp.y), bfhi(fp.y)};
#pragma unroll
                    for (int e = 0; e < 4; ++e) { x[e] = x[e] + (xp[e] - x[e]) * mu[e]; x[e] = (g == 0) ? fast_tanhf(x[e]) : (g == 1) ? x[e] : sigmoidf_(x[e]); }
                    u32x2 o; o.x = pk2(x[0], x[1]); o.y = pk2(x[2], x[3]);
                    LAS unsigned char* dst = (g == 0) ? XS + fr * 144 + j0 * 2 : (g == 1) ? XS + 2304 + fr * 144 + j0 * 2 : XS + 4608 + fr * 272 + (g - 2) * 128 + j0 * 2;
                    *(LAS u32x2*)dst = o; } }
#pragma unroll
            for (int g = 0; g < 3; ++g)
#pragma unroll
                for (int mt = 0; mt < 4; ++mt) { const int coff = g * 512 + h * 64 + 16 * mt; rawc[g][mt] = *(const u32x2*)(rc4 + coff); rawp[g][mt] = *(const u32x2*)(rp4 + coff); }
            asm volatile("s_waitcnt lgkmcnt(0)" ::: "memory");
            float vr[16], vk[16], vv[16], ve[16], vkk[16], vb[16];
            float ss = 0.f, bn = 0.f;
            bf16x8 xw[2], xa[2], xg[4];
#pragma unroll
            for (int ks = 0; ks < 2; ++ks) { xw[ks] = *(const LAS bf16x8*)(XS + fr * 144 + (32 * ks + 8 * fq) * 2); xa[ks] = *(const LAS bf16x8*)(XS + 2304 + fr * 144 + (32 * ks + 8 * fq) * 2); }
#pragma unroll
            for (int ks = 0; ks < 4; ++ks) xg[ks] = *(const LAS bf16x8*)(XS + 4608 + fr * 272 + (32 * ks + 8 * fq) * 2);
#pragma unroll
            for (int mt = 0; mt < 4; ++mt) {
#pragma unroll
                for (int g = 0; g < 3; ++g) { const int coff = g * 512 + 16 * mt;
                    const u32x2 fc = rawc[g][mt]; u32x2 fp = rawp[g][mt]; if (!hasp) fp = (u32x2){0u, 0u};
                    const f32x4 mu = *(const LAS f32x4*)(mul4 + 64 * g + 16 * mt);
                    const float x[4] = {bflo(fc.x), bfhi(fc.x), bflo(fc.y), bfhi(fc.y)}; const float xp[4] = {bflo(fp.x), bfhi(fp.x), bflo(fp.y), bfhi(fp.y)};
#pragma unroll
                    for (int e = 0; e < 4; ++e) { const float xs = x[e] + (xp[e] - x[e]) * mu[e]; if (g == 0) vr[4 * mt + e] = xs; else if (g == 1) vk[4 * mt + e] = xs; else vv[4 * mt + e] = xs; } }
                f32x4 cw = (f32x4){0.f, 0.f, 0.f, 0.f}, ca = cw, cg = cw;
#pragma unroll
                for (int ks = 0; ks < 2; ++ks) { cw = MFMA16(*(const LAS bf16x8*)(L + RW_W2T + (16 * mt + fr) * 144 + (32 * ks + 8 * fq) * 2), xw[ks], cw);
                                                 ca = MFMA16(*(const LAS bf16x8*)(L + RW_A2T + (16 * mt + fr) * 144 + (32 * ks + 8 * fq) * 2), xa[ks], ca); }
#pragma unroll
                for (int ks = 0; ks < 4; ++ks) cg = MFMA16(*(const LAS bf16x8*)(L + RW_G2T + (16 * mt + fr) * 272 + (32 * ks + 8 * fq) * 2), xg[ks], cg);
#pragma unroll
                for (int r = 0; r < 4; ++r) { const int q = 4 * mt + r, c = 16 * mt + 4 * fq + r;
                    const float lw = cw[r] + PRM[c]; ve[q] = 0.6065306597126334f * sigmoidf_(lw);
                    const float av = sigmoidf_(ca[r] + PRM[64 + c]);
                    const float kraw = vk[q] * PRM[128 + c]; vk[q] = vk[q] * (1.f + (av - 1.f) * PRM[192 + c]);
                    vkk[q] = kraw; vb[q] = av; ss += kraw * kraw; bn += vr[q] * vk[q] * PRM[256 + c]; }
                { u32x2 og; og.x = pk2(cg[0], cg[1]); og.y = pk2(cg[2], cg[3]); *(u32x2*)(ppg + mt * 32) = og; }
                asm volatile("" ::: "memory");
            }
            ss += __shfl_xor(ss, 16); ss += __shfl_xor(ss, 32); bn += __shfl_xor(bn, 16); bn += __shfl_xor(bn, 32);
            const float rinv = rsqrtf(ss + 1e-6f);
#pragma unroll
            for (int mt = 0; mt < 4; ++mt) { u32x2 ob; ob.x = pk2(vv[4 * mt] * bn, vv[4 * mt + 1] * bn); ob.y = pk2(vv[4 * mt + 2] * bn, vv[4 * mt + 3] * bn); *(u32x2*)(ppg + 2048 + mt * 32) = ob; }
#pragma unroll
            for (int ks = 0; ks < 2; ++ks) {
                float kkt[8], rt[8], bh_[8], kh[8];
#pragma unroll
                for (int i = 0; i < 8; ++i) { const int q = 8 * ks + i;
                    float cl = ve[q];
                    cl += dpp_shr_f(cl, 1); cl += dpp_shr_f(cl, 2); cl += dpp_shr_f(cl, 4); cl += dpp_shr_f(cl, 8);
                    const float clL = __shfl(cl, (lane & 48) | 15);
                    const float kkn = vkk[q] * rinv, bq = kkn * vb[q];
                    const float W = __expf(-cl), Wp = __expf(ve[q] - cl), Wi = __expf(cl), WLr = __expf(cl - clL);
                    kkt[i] = kkn * Wp; rt[i] = vr[q] * W; bh_[i] = bq * Wi; kh[i] = vk[q] * Wi;
                    *(bf16_t*)(pbkt + (q >> 2) * 1024 + (q & 3) * 64) = (bf16_t)f2bf(-bq * WLr);
                    *(bf16_t*)(pbkt + (q >> 2) * 1024 + (q & 3) * 64 + 8) = (bf16_t)f2bf(vk[q] * WLr);
                    *(bf16_t*)(pvt + (q >> 2) * 512 + (q & 3) * 32) = (bf16_t)f2bf(vv[q]);
                    if (fr == 15) *(float*)(pwl + (q >> 2) * 64 + (q & 3) * 4) = W;
                }
                u32x4 o1, o2;
                o1.x = pk2(kkt[0], kkt[1]); o1.y = pk2(kkt[2], kkt[3]); o1.z = pk2(kkt[4], kkt[5]); o1.w = pk2(kkt[6], kkt[7]);
                o2.x = pk2(rt[0], rt[1]); o2.y = pk2(rt[2], rt[3]); o2.z = pk2(rt[4], rt[5]); o2.w = pk2(rt[6], rt[7]);
                *(u32x4*)(rec + RC_KR + fr * 128 + ks * 64 + fq * 16) = o1; *(u32x4*)(rec + RC_KR + 2048 + fr * 128 + ks * 64 + fq * 16) = o2;
#pragma unroll
                for (int m2 = 0; m2 < 2; ++m2) { const int mt = 2 * ks + m2; LAS unsigned char* xo = xs4 + mt * 32;
                    *(LAS u32x2*)(xo) = (u32x2){o1[2 * m2], o1[2 * m2 + 1]};
                    *(LAS u32x2*)(xo + 2304) = (u32x2){o2[2 * m2], o2[2 * m2 + 1]};
                    u32x2 o; o.x = pk2(bh_[4 * m2], bh_[4 * m2 + 1]); o.y = pk2(bh_[4 * m2 + 2], bh_[4 * m2 + 3]); *(LAS u32x2*)(xo + 4608) = o;
                    o.x = pk2(kh[4 * m2], kh[4 * m2 + 1]); o.y = pk2(kh[4 * m2 + 2], kh[4 * m2 + 3]); *(LAS u32x2*)(xo + 6912) = o; }
                asm volatile("" ::: "memory");
            }
            asm volatile("s_waitcnt lgkmcnt(0)" ::: "memory");
            f32x4 mbb = (f32x4){0.f, 0.f, 0.f, 0.f}, mkb = mbb, mbr = mbb, mkr = mbb;
#pragma unroll
            for (int ks = 0; ks < 2; ++ks) { const int off = fr * 144 + (32 * ks + 8 * fq) * 2;
                const bf16x8 akk = *(const LAS bf16x8*)(XS + off), ar = *(const LAS bf16x8*)(XS + 2304 + off), bb = *(const LAS bf16x8*)(XS + 4608 + off), bk = *(const LAS bf16x8*)(XS + 6912 + off);
                mbb = MFMA16(akk, bb, mbb); mkb = MFMA16(akk, bk, mkb); mbr = MFMA16(ar, bb, mbr); mkr = MFMA16(ar, bk, mkr); }
            {
                float T[16]; const float mf0 = mbb[0], mf1 = mbb[1], mf2 = mbb[2], mf3 = mbb[3];
                const int mb_[4] = {__builtin_bit_cast(int, mf0), __builtin_bit_cast(int, mf1), __builtin_bit_cast(int, mf2), __builtin_bit_cast(int, mf3)};
#pragma unroll
                for (int t = 0; t < 16; ++t) T[t] = (t == fr) ? 1.f : 0.f;
#pragma unroll
                for (int t = 1; t < 16; ++t) { float s0 = T[t], s1 = 0.f;
#pragma unroll
                    for (int j = 0; j < t; ++j) { const float m = __builtin_bit_cast(float, __builtin_amdgcn_readlane(mb_[t & 3], j + 16 * (t >> 2)));
                        if (j & 1) s1 -= m * T[j]; else s0 -= m * T[j]; }
                    T[t] = s0 + s1; }
                if (fq == 0) {
#pragma unroll
                    for (int t = 0; t < 16; ++t) { const bf16_t tv = (bf16_t)f2bf(T[t]); *(bf16_t*)(rec + RC_MBB + t * 64 + (fr >> 2) * 16 + (fr & 3) * 2) = tv; *(bf16_t*)(rec + RC_MBB + t * 64 + (fr >> 2) * 16 + 8 + (fr & 3) * 2) = tv; }
                }
            }
#pragma unroll
            for (int r = 0; r < 4; ++r) { const int t = 4 * fq + r, j = fr;
                *(bf16_t*)(rec + RC_MKB + t * 32 + j * 2) = (bf16_t)f2bf((j < t) ? mkb[r] : 0.f);
                *(bf16_t*)(rec + RC_MBR + t * 32 + j * 2) = (bf16_t)f2bf((j <= t) ? mbr[r] : 0.f);
                *(bf16_t*)(rec + RC_MKR + t * 32 + j * 2) = (bf16_t)f2bf((j <= t) ? mkr[r] : 0.f); }
            asm volatile("s_waitcnt lgkmcnt(0)" ::: "memory");
        }
    }
}

constexpr int RCH_X = 0;
constexpr int RCH_ST = 4096;
constexpr int RCH_RING = 8192, RCH_NSLOT = 6, RCH_PF = 5;
static_assert(RCH_RING + RCH_NSLOT * RC_REC <= XB_LDS_OFF, "rwkv chain lds");
#define RCH_BAR() do { asm volatile("s_waitcnt lgkmcnt(0)" ::: "memory"); __builtin_amdgcn_s_barrier(); asm volatile("" ::: "memory"); } while (0)
__device__ __forceinline__ void rwkvc_chain_unit(const Frame& F, const Args& a, int bh, int sg, bool dry = false) {
    const unsigned char* SCR = F.ws + WS_RSCR;
    bf16_t* OAB = (bf16_t*)(F.ws + WS_XN); f32x4* STATE = (f32x4*)(F.ws + WS_RSTATE);
    const int lane = F.lane, w = F.wave, fr = lane & 15, fq = lane >> 4, h = bh & 7, b = bh >> 3;
    LAS unsigned char* L = F.lds;
    const size_t mb = (size_t)b * SEQ;
    const unsigned char* seg = SCR + ((size_t)bh * RC_SEG_CHUNKS) * RC_REC;
    if (w >= 4) {
        const int p = w - 4;
#define RCH_ISSUE(ch_) do { int l16_ = lane * 16; asm volatile("" : "+v"(l16_)); const unsigned char* src_ = seg + (size_t)(ch_) * RC_REC + l16_; LAS unsigned char* dst_ = L + RCH_RING + ((ch_) % RCH_NSLOT) * RC_REC; \
            _Pragma("unroll") for (int i_ = 0; i_ < 5; ++i_) { const int pc_ = p + 4 * i_; if (pc_ < 17) __builtin_amdgcn_global_load_lds((const unsigned*)(src_ + pc_ * 1024), (LAS unsigned*)(dst_ + pc_ * 1024), 16, 0, 0); } } while (0)
#pragma unroll 1
        for (int ch = 0; ch < RCH_PF; ++ch) RCH_ISSUE(ch);
        if (p == 0) asm volatile("s_waitcnt vmcnt(20)" ::: "memory"); else asm volatile("s_waitcnt vmcnt(16)" ::: "memory");
        RCH_BAR();
#pragma unroll 1
        for (int cs = 0; cs < RC_SEG_CHUNKS; ++cs) {
            if (cs + RCH_PF < RC_SEG_CHUNKS) { RCH_ISSUE(cs + RCH_PF);
                if (p == 0) asm volatile("s_waitcnt vmcnt(20)" ::: "memory"); else asm volatile("s_waitcnt vmcnt(16)" ::: "memory"); }
            else asm volatile("s_waitcnt vmcnt(0)" ::: "memory");
            RCH_BAR();
        }
#undef RCH_ISSUE
    } else {
        LAS float* XT = (LAS float*)(L + RCH_X + w * 1024); LAS float* STT = (LAS float*)(L + RCH_ST);
        f32x4 acc[4];
#pragma unroll
        for (int mt = 0; mt < 4; ++mt) acc[mt] = (sg == 0) ? (f32x4){0.f, 0.f, 0.f, 0.f} : STATE[((size_t)bh * 4 + w) * 256 + mt * 64 + lane];
        const int v = 16 * w + fr, hc = h * 64 + v;
        const float lnw = a.in[IN_RLNW][hc], lnb = a.in[IN_RLNB][hc];
        RCH_BAR();
#pragma unroll 1
        for (int cs = 0; cs < RC_SEG_CHUNKS; ++cs) {
            const LAS unsigned char* rec = L + RCH_RING + (cs % RCH_NSLOT) * RC_REC;
            const u32x4 z4 = (u32x4){0u, 0u, 0u, 0u}; const int f2 = fq & 1;
            bf16x8 sb[2];
#pragma unroll
            for (int ks = 0; ks < 2; ++ks) { u32x4 pk; pk.x = pk2(acc[2 * ks][0], acc[2 * ks][1]); pk.y = pk2(acc[2 * ks][2], acc[2 * ks][3]); pk.z = pk2(acc[2 * ks + 1][0], acc[2 * ks + 1][1]); pk.w = pk2(acc[2 * ks + 1][2], acc[2 * ks + 1][3]); sb[ks] = __builtin_bit_cast(bf16x8, pk); }
            f32x4 rhs = (f32x4){0.f, 0.f, 0.f, 0.f}, y1 = rhs;
#pragma unroll
            for (int ks = 0; ks < 2; ++ks) { rhs = MFMA16(*(const LAS bf16x8*)(rec + RC_KR + fr * 128 + ks * 64 + fq * 16), sb[ks], rhs); y1 = MFMA16(*(const LAS bf16x8*)(rec + RC_KR + 2048 + fr * 128 + ks * 64 + fq * 16), sb[ks], y1); }
            u32x4 vt8 = *(const LAS u32x4*)(rec + RC_VT + v * 32 + f2 * 16), mkb = *(const LAS u32x4*)(rec + RC_MKB + fr * 32 + f2 * 16), mkr = *(const LAS u32x4*)(rec + RC_MKR + fr * 32 + f2 * 16), mbr = *(const LAS u32x4*)(rec + RC_MBR + fr * 32 + f2 * 16);
            if (fq >= 2) { vt8 = z4; mkb = z4; mkr = z4; mbr = z4; }
            rhs = MFMA16(__builtin_bit_cast(bf16x8, mkb), __builtin_bit_cast(bf16x8, vt8), rhs);
            y1 = MFMA16(__builtin_bit_cast(bf16x8, mkr), __builtin_bit_cast(bf16x8, vt8), y1);
            f32x4 u4;
            { u32x4 rb; rb.x = pk2(rhs[0], rhs[1]); rb.y = pk2(rhs[2], rhs[3]); rb.z = 0u; rb.w = 0u;
              const f32x4 zf = {0.f, 0.f, 0.f, 0.f}; u4 = MFMA16(*(const LAS bf16x8*)(rec + RC_MBB + fr * 64 + fq * 16), __builtin_bit_cast(bf16x8, rb), zf); }
            *(LAS f32x4*)(XT + fr * 16 + 4 * fq) = u4;
            asm volatile("s_waitcnt lgkmcnt(0)" ::: "memory");
            u32x4 ub;
            { const f32x4 ua = *(const LAS f32x4*)(XT + fr * 16 + 8 * f2), ubb = *(const LAS f32x4*)(XT + fr * 16 + 8 * f2 + 4);
              ub.x = pk2(ua[0], ua[1]); ub.y = pk2(ua[2], ua[3]); ub.z = pk2(ubb[0], ubb[1]); ub.w = pk2(ubb[2], ubb[3]); if (fq >= 2) ub = z4; }
            f32x4 yv = (f32x4){0.f, 0.f, 0.f, 0.f};
            yv = MFMA16(__builtin_bit_cast(bf16x8, mbr), __builtin_bit_cast(bf16x8, ub), yv);
            const f32x4 y = y1 - yv;
            u32x4 uvb; const u32x2 vt4 = *(const LAS u32x2*)(rec + RC_VT + v * 32 + fq * 8);
            uvb.x = pk2(u4[0], u4[1]); uvb.y = pk2(u4[2], u4[3]);
            uvb.z = vt4.x; uvb.w = vt4.y;
#pragma unroll
            for (int mt = 0; mt < 4; ++mt) { const f32x4 wl = *(const LAS f32x4*)(rec + RC_WL + (16 * mt + 4 * fq) * 4);
                acc[mt] = MFMA16(*(const LAS bf16x8*)(rec + RC_BKT + (16 * mt + fr) * 64 + fq * 16), __builtin_bit_cast(bf16x8, uvb), acc[mt] * wl); }
            float pgv[4], pbv[4];
#pragma unroll
            for (int r = 0; r < 4; ++r) { pgv[r] = bf2f(*(const LAS bf16_t*)(rec + RC_PG + (4 * fq + r) * 128 + v * 2)); pbv[r] = bf2f(*(const LAS bf16_t*)(rec + RC_PBV + (4 * fq + r) * 128 + v * 2)); }
            LAS float* st = STT + (cs & 1) * 128;
#pragma unroll
            for (int r = 0; r < 4; ++r) { const float s1 = red16_dpp(y[r]), s2 = red16_dpp(y[r] * y[r]); if (fr == 0) { st[(w * 16 + 4 * fq + r) * 2] = s1; st[(w * 16 + 4 * fq + r) * 2 + 1] = s2; } }
            RCH_BAR();
#pragma unroll
            for (int r = 0; r < 4; ++r) { const int t = 4 * fq + r; float s1 = 0.f, s2 = 0.f;
#pragma unroll
                for (int ww = 0; ww < 4; ++ww) { const f32x2 sv = *(const LAS f32x2*)(st + (ww * 16 + t) * 2); s1 += sv[0]; s2 += sv[1]; }
                const float mean = s1 * (1.f / 64.f), var = fmaxf(s2 * (1.f / 64.f) - mean * mean, 0.f);
                const float o = ((y[r] - mean) * rsqrtf(var + RWKV_LN_EPS) * lnw + lnb + pbv[r]) * pgv[r];
                if (!dry) OAB[(mb + (size_t)(sg * RC_SEG_CHUNKS + cs) * 16 + t) * 1024 + 512 + hc] = (bf16_t)f2bf(o); }
        }
#pragma unroll
        for (int mt = 0; mt < 4; ++mt) if (!dry) STATE[((size_t)bh * 4 + w) * 256 + mt * 64 + lane] = acc[mt];
    }
    __syncthreads();
}

__device__ __forceinline__ void rwkvc_build_images(const Frame& F, const Args& a) {
    const int gt = F.bid * NTHREADS + F.tid, NT = F.G * NTHREADS;
    for (int e = gt; e < 8 * 256 * 64; e += NT) {
        const int c = e & 63, jj = (e >> 6) & 255, h = e >> 14;
        unsigned char* img = F.ws + WS_RIMG + (size_t)h * 35840;
        if (jj < 64) *(bf16_t*)(img + RW_W2T + c * 144 + jj * 2) = (bf16_t)f2bf(a.in[IN_RW2][jj * 512 + h * 64 + c]);
        else if (jj < 128) *(bf16_t*)(img + RW_A2T + c * 144 + (jj - 64) * 2) = (bf16_t)f2bf(a.in[IN_RA2][(jj - 64) * 512 + h * 64 + c]);
        else *(bf16_t*)(img + RW_G2T + c * 272 + (jj - 128) * 2) = (bf16_t)f2bf(a.in[IN_RG2][(jj - 128) * 512 + h * 64 + c]);
    }
}
__device__ __forceinline__ void row_pass(const Frame& F, const bf16_t* mix, const float* resid, const float* w_post, float* hout, const float* w_next, bf16_t* xn) {
    const int gw = F.bid * NWAVES + F.wave, NGW = F.G * NWAVES, lane = F.lane;
    for (int mA = gw; mA < MTOK; mA += 2 * NGW) {
        const int mB = (mA + NGW < MTOK) ? mA + NGW : mA; const bool two = (mB != mA);
        const u32x2* mrA = (const u32x2*)(mix + (size_t)mA * D_MODEL) + lane; const f32x4* rrA = (const f32x4*)(resid + (size_t)mA * D_MODEL) + lane;
        const u32x2* mrB = (const u32x2*)(mix + (size_t)mB * D_MODEL) + lane; const f32x4* rrB = (const f32x4*)(resid + (size_t)mB * D_MODEL) + lane;
        u32x2 pa[4], pb[4]; f32x4 ha[4], hb[4];
#pragma unroll
        for (int j = 0; j < 4; ++j) { pa[j] = mrA[64 * j]; pb[j] = mrB[64 * j]; ha[j] = rrA[64 * j]; hb[j] = rrB[64 * j]; }
        f32x4 va[4], vb[4]; float sa = 0.f, sb = 0.f;
#pragma unroll
        for (int j = 0; j < 4; ++j) { va[j] = (f32x4){bflo(pa[j].x), bfhi(pa[j].x), bflo(pa[j].y), bfhi(pa[j].y)}; vb[j] = (f32x4){bflo(pb[j].x), bfhi(pb[j].x), bflo(pb[j].y), bfhi(pb[j].y)};
            sa += (va[j].x * va[j].x + va[j].y * va[j].y) + (va[j].z * va[j].z + va[j].w * va[j].w); sb += (vb[j].x * vb[j].x + vb[j].y * vb[j].y) + (vb[j].z * vb[j].z + vb[j].w * vb[j].w); }
        const float ra = 1.f / sqrtf(wave_sum(sa) * (1.f / D_MODEL) + NORM_EPS), rb = 1.f / sqrtf(wave_sum(sb) * (1.f / D_MODEL) + NORM_EPS);
        float s2a = 0.f, s2b = 0.f;
#pragma unroll
        for (int j = 0; j < 4; ++j) { const f32x4 g = ((const f32x4*)w_post)[lane + 64 * j]; ha[j] = ha[j] + va[j] * ra * g; hb[j] = hb[j] + vb[j] * rb * g;
            s2a += (ha[j].x * ha[j].x + ha[j].y * ha[j].y) + (ha[j].z * ha[j].z + ha[j].w * ha[j].w); s2b += (hb[j].x * hb[j].x + hb[j].y * hb[j].y) + (hb[j].z * hb[j].z + hb[j].w * hb[j].w); }
        f32x4* hoA = (f32x4*)(hout + (size_t)mA * D_MODEL) + lane; f32x4* hoB = (f32x4*)(hout + (size_t)mB * D_MODEL) + lane;
#pragma unroll
        for (int j = 0; j < 4; ++j) { hoA[64 * j] = ha[j]; if (two) hoB[64 * j] = hb[j]; }
        if (w_next) {
            const float qa = 1.f / sqrtf(wave_sum(s2a) * (1.f / D_MODEL) + NORM_EPS), qb = 1.f / sqrtf(wave_sum(s2b) * (1.f / D_MODEL) + NORM_EPS);
            unsigned long long* oA = (unsigned long long*)(xn + (size_t)mA * D_MODEL) + lane; unsigned long long* oB = (unsigned long long*)(xn + (size_t)mB * D_MODEL) + lane;
#pragma unroll
            for (int j = 0; j < 4; ++j) { const f32x4 g = ((const f32x4*)w_next)[lane + 64 * j];
                oA[64 * j] = (unsigned long long)pk2(ha[j].x * qa * g.x, ha[j].y * qa * g.y) | ((unsigned long long)pk2(ha[j].z * qa * g.z, ha[j].w * qa * g.w) << 32);
                if (two) oB[64 * j] = (unsigned long long)pk2(hb[j].x * qb * g.x, hb[j].y * qb * g.y) | ((unsigned long long)pk2(hb[j].z * qb * g.z, hb[j].w * qb * g.w) << 32); }
        }
    }
}
constexpr size_t B1_ACMPK = 128 * MiB, B1_ACMPV = 144 * MiB, B1_KS = 160 * MiB, B1_VST = 168 * MiB, B1_KW = 176 * MiB, B1_VWT = 184 * MiB, B1_QR = 192 * MiB;
constexpr size_t R2_HCMP = 0, R2_KC = 8 * MiB, R2_VCT = 9 * MiB, R2_SEL = 12 * MiB;
__device__ __constant__ float ROPE_INVF[8] = {1.0f, 0.1939227432012558f, 0.03760603070259094f, 0.007292664609849453f, 0.0014142135623842478f, 0.00027424818836152554f, 5.3182957344688475e-05f, 1.0313385246263351e-05f};

__device__ __forceinline__ void nsa_prep_phase(const Frame& F, const Args& a) {
    const bf16_t* F1 = (const bf16_t*)(F.ws + WS_BIG);
    bf16_t* ACMPK = (bf16_t*)(F.ws + WS_BIG + B1_ACMPK); bf16_t* ACMPV = (bf16_t*)(F.ws + WS_BIG + B1_ACMPV);
    bf16_t* KS = (bf16_t*)(F.ws + WS_BIG + B1_KS); bf16_t* VST = (bf16_t*)(F.ws + WS_BIG + B1_VST); bf16_t* KW = (bf16_t*)(F.ws + WS_BIG + B1_KW); bf16_t* VWT = (bf16_t*)(F.ws + WS_BIG + B1_VWT);
    bf16_t* QR = (bf16_t*)(F.ws + WS_BIG + B1_QR);
    const int* pos = (const int*)a.in[IN_POS];
    const int lane = F.lane, wave = F.wave, tid = F.tid;
    LAS unsigned char* Lvs = F.lds;
    LAS unsigned char* Lvw = F.lds + 16384;
    for (int u = F.bid; u < BATCH * 64; u += F.G) {
        const int b = u >> 6, blk = u & 63;
#pragma unroll 1
        for (int tt = 0; tt < 8; ++tt) {
            const int tl = 8 * wave + tt, t = blk * 64 + tl; const size_t m = (size_t)b * SEQ + t;
            const float p = (float)pos[m];
            const float ang = p * ROPE_INVF[lane & 7];
            const float cs = __cosf(ang), sn = __sinf(ang);
            const bf16_t* row = F1 + m * F1_LD;
            { const int hh = lane >> 2, qd = lane & 3; const u32x4 v0 = *(const u32x4*)(row + hh * 64 + qd * 16), v1 = *(const u32x4*)(row + hh * 64 + qd * 16 + 8);
              u32x4 o0 = v0, o1 = v1;
              float x1[8], x2[8], c8[8], s8[8];
#pragma unroll
              for (int i = 0; i < 8; ++i) { c8[i] = __shfl(cs, i); s8[i] = __shfl(sn, i); }
              if (qd == 0) {
                  x1[0] = bflo(v0.x); x1[1] = bfhi(v0.x); x1[2] = bflo(v0.y); x1[3] = bfhi(v0.y); x1[4] = bflo(v0.z); x1[5] = bfhi(v0.z); x1[6] = bflo(v0.w); x1[7] = bfhi(v0.w);
                  x2[0] = bflo(v1.x); x2[1] = bfhi(v1.x); x2[2] = bflo(v1.y); x2[3] = bfhi(v1.y); x2[4] = bflo(v1.z); x2[5] = bfhi(v1.z); x2[6] = bflo(v1.w); x2[7] = bfhi(v1.w);
                  float y1[8], y2[8];
#pragma unroll
                  for (int i = 0; i < 8; ++i) { y1[i] = x1[i] * c8[i] - x2[i] * s8[i]; y2[i] = x2[i] * c8[i] + x1[i] * s8[i]; }
                  o0.x = pk2(y1[0], y1[1]); o0.y = pk2(y1[2], y1[3]); o0.z = pk2(y1[4], y1[5]); o0.w = pk2(y1[6], y1[7]);
                  o1.x = pk2(y2[0], y2[1]); o1.y = pk2(y2[2], y2[3]); o1.z = pk2(y2[4], y2[5]); o1.w = pk2(y2[6], y2[7]); }
              *(u32x4*)(QR + m * 1024 + hh * 64 + qd * 16) = o0; *(u32x4*)(QR + m * 1024 + hh * 64 + qd * 16 + 8) = o1;
            }
            const int g = lane >> 5, d = 2 * (lane & 31); const int bg = b * 2 + g;
            const unsigned kc = *(const unsigned*)(row + 1024 + 0 * 128 + g * 64 + d), vc = *(const unsigned*)(row + 1024 + 1 * 128 + g * 64 + d);
            unsigned ks = *(const unsigned*)(row + 1024 + 2 * 128 + g * 64 + d); const unsigned vs = *(const unsigned*)(row + 1024 + 3 * 128 + g * 64 + d);
            unsigned kw = *(const unsigned*)(row + 1024 + 4 * 128 + g * 64 + d); const unsigned vw = *(const unsigned*)(row + 1024 + 5 * 128 + g * 64 + d);
            {
              const int l5 = lane & 31; const bool x1role = l5 < 4; const int i0 = 2 * (l5 & 3);
              const float c0 = __shfl(cs, i0), c1 = __shfl(cs, i0 + 1), s0 = __shfl(sn, i0), s1 = __shfl(sn, i0 + 1);
              const unsigned oks = __shfl_xor(ks, 4), okw = __shfl_xor(kw, 4);
              if (l5 < 8) { const float sg = x1role ? -1.f : 1.f;
                  ks = pk2(bflo(ks) * c0 + sg * bflo(oks) * s0, bfhi(ks) * c1 + sg * bfhi(oks) * s1);
                  kw = pk2(bflo(kw) * c0 + sg * bflo(okw) * s0, bfhi(kw) * c1 + sg * bfhi(okw) * s1); } }
            *(unsigned*)(KS + ((size_t)bg * SEQ + t) * 64 + d) = ks; *(unsigned*)(KW + ((size_t)bg * SEQ + t) * 64 + d) = kw;
            *(LAS unsigned*)(Lvs + tl * 256 + lane * 4) = vs; *(LAS unsigned*)(Lvw + tl * 256 + lane * 4) = vw;
            {
              const int i0 = t >> 4, s0 = t & 15;
              const float* pek = a.in[IN_NPEK]; const float* pev = a.in[IN_NPEV];
              if (i0 < 255) { *(unsigned*)(ACMPK + ((size_t)bg * 256 + i0) * 2048 + s0 * 64 + d) = pk2(bflo(kc) + pek[s0 * 64 + d], bfhi(kc) + pek[s0 * 64 + d + 1]);
                              *(unsigned*)(ACMPV + ((size_t)bg * 256 + i0) * 2048 + s0 * 64 + d) = pk2(bflo(vc) + pev[s0 * 64 + d], bfhi(vc) + pev[s0 * 64 + d + 1]); }
              if (i0 >= 1) { const int s1 = 16 + s0;
                              *(unsigned*)(ACMPK + ((size_t)bg * 256 + i0 - 1) * 2048 + s1 * 64 + d) = pk2(bflo(kc) + pek[s1 * 64 + d], bfhi(kc) + pek[s1 * 64 + d + 1]);
                              *(unsigned*)(ACMPV + ((size_t)bg * 256 + i0 - 1) * 2048 + s1 * 64 + d) = pk2(bflo(vc) + pev[s1 * 64 + d], bfhi(vc) + pev[s1 * 64 + d + 1]); }
            }
        }
        if (blk == 63) {
            for (int i = tid; i < 2 * 2048 / 8; i += NTHREADS) { const int g = i >> 8, o = (i & 255) * 8;
                *(u32x4*)(ACMPK + ((size_t)(b * 2 + g) * 256 + 255) * 2048 + o) = (u32x4){0u, 0u, 0u, 0u}; *(u32x4*)(ACMPV + ((size_t)(b * 2 + g) * 256 + 255) * 2048 + o) = (u32x4){0u, 0u, 0u, 0u}; }
        }
        __syncthreads();
        if (tid < 256) { const int which = tid >> 7, gd = tid & 127, g = gd >> 6, d = gd & 63; LAS unsigned char* Lv = which ? Lvw : Lvs;
            bf16_t* dst = (which ? VWT : VST) + (((size_t)(b * 2 + g) * 64 + blk) * 64 + d) * 64;
#pragma unroll
            for (int q8 = 0; q8 < 8; ++q8) { unsigned short e[8];
#pragma unroll
                for (int k = 0; k < 8; ++k) e[k] = *(const LAS bf16_t*)(Lv + (8 * q8 + k) * 256 + gd * 2);
                u32x4 o; o.x = e[0] | ((unsigned)e[1] << 16); o.y = e[2] | ((unsigned)e[3] << 16); o.z = e[4] | ((unsigned)e[5] << 16); o.w = e[6] | ((unsigned)e[7] << 16);
                *(u32x4*)(dst + 8 * q8) = o; } }
        __syncthreads();
    }
}

__device__ __forceinline__ void nsa_cmp2_phase(const Frame& F, const Args& a) {
    const bf16_t* HC = (const bf16_t*)(F.ws + WS_R2 + R2_HCMP); bf16_t* KC = (bf16_t*)(F.ws + WS_R2 + R2_KC); bf16_t* VCT = (bf16_t*)(F.ws + WS_R2 + R2_VCT);
    const int* pos = (const int*)a.in[IN_POS];
    const int gw = F.bid * NWAVES + F.wave, NGW = F.G * NWAVES, lane = F.lane, fr = lane & 15, fq = lane >> 4;
    for (int it = gw; it < 512; it += NGW) {
        const int which = it >> 8, rt = it & 255;
        const bf16_t* A = HC + ((size_t)which * 4096 + 16 * rt) * 256; const bf16_t* Bt = (const bf16_t*)(F.ws + (which ? WS_W_C2V : WS_W_C2K));
        f32x4 c[4];
#pragma unroll
        for (int nt = 0; nt < 4; ++nt) c[nt] = (f32x4){0.f, 0.f, 0.f, 0.f};
#pragma unroll
        for (int ks = 0; ks < 8; ++ks) { const bf16x8 af = *(const bf16x8*)(A + fr * 256 + 32 * ks + 8 * fq);
#pragma unroll
            for (int nt = 0; nt < 4; ++nt) { const bf16x8 bf = *(const bf16x8*)(Bt + (16 * nt + fr) * 256 + 32 * ks + 8 * fq); c[nt] = MFMA16(af, bf, c[nt]); } }
        const int bg = rt >> 4, b = bg >> 1;
        if (which == 0) {
#pragma unroll
            for (int r = 0; r < 4; ++r) { const int i = (16 * rt + 4 * fq + r) & 255; int pi = 31 + 16 * i; if (pi > SEQ - 1) pi = SEQ - 1;
                const float ang = (float)pos[(size_t)b * SEQ + pi] * ROPE_INVF[fr & 7]; const float cs = __cosf(ang), sn = __sinf(ang);
                const float own = c[0][r], oth = __shfl_xor(own, 8);
                c[0][r] = (fr < 8) ? own * cs - oth * sn : own * cs + oth * sn;
#pragma unroll
                for (int nt = 0; nt < 4; ++nt) KC[((size_t)bg * 256 + i) * 64 + 16 * nt + fr] = (bf16_t)f2bf(c[nt][r]); }
        } else {
            const int i0 = (16 * rt + 4 * fq) & 255;
#pragma unroll
            for (int nt = 0; nt < 4; ++nt) { u32x2 p; p.x = pk2(c[nt][0], c[nt][1]); p.y = pk2(c[nt][2], c[nt][3]); *(u32x2*)(VCT + ((size_t)bg * 64 + 16 * nt + fr) * 256 + i0) = p; }
        }
    }
}
constexpr int CA_KC = 0, CA_KC_PITCH = 144;
constexpr int CA_VT = 36864, CA_VT_PITCH = 528;
__device__ __forceinline__ void nsa_cmp_attn_phase(const Frame& F, const Args& a) {
    const bf16_t* F1 = (const bf16_t*)(F.ws + WS_BIG); const bf16_t* QR = (const bf16_t*)(F.ws + WS_BIG + B1_QR);
    const bf16_t* KC = (const bf16_t*)(F.ws + WS_R2 + R2_KC); const bf16_t* VCT = (const bf16_t*)(F.ws + WS_R2 + R2_VCT);
    unsigned long long* SEL = (unsigned long long*)(F.ws + WS_R2 + R2_SEL); bf16_t* ONSA = (bf16_t*)(F.ws + WS_XN);
    const int lane = F.lane, wave = F.wave, tid = F.tid, fr = lane & 15, fq = lane >> 4;
    LAS unsigned char* L = F.lds;
    for (int bgk = F.bid; bgk < 256; bgk += F.G) {
        const int bg = bgk & 15, kq = bgk >> 4, b = bg >> 1, g = bg & 1;
        __syncthreads();
        for (int i = tid; i < 256 * 8; i += NTHREADS) { const int key = i >> 3, ch = i & 7; *(LAS u32x4*)(L + CA_KC + key * CA_KC_PITCH + ch * 16) = *(const u32x4*)(KC + ((size_t)bg * 256 + key) * 64 + ch * 8); }
        for (int i = tid; i < 64 * 32; i += NTHREADS) { const int d = i >> 5, ch = i & 31; *(LAS u32x4*)(L + CA_VT + d * CA_VT_PITCH + ch * 16) = *(const u32x4*)(VCT + ((size_t)bg * 64 + d) * 256 + ch * 8); }
        __syncthreads();
#pragma unroll 1
        for (int rep = 0; rep < 2; ++rep) {
            const int idx = wave * 16 + kq; const int tt = rep == 0 ? idx : 255 - idx;
            const int t0 = 16 * tt, t = t0 + fr; const size_t m = (size_t)b * SEQ + t;
            const int nk = tt;
            const int nkt = (nk + 15) >> 4;
            float iaA[16], iaB[16];
#pragma unroll
            for (int kt = 0; kt < 16; ++kt) { iaA[kt] = 0.f; iaB[kt] = 0.f; }
#pragma unroll 1
            for (int hh = 0; hh < 8; ++hh) {
                const int H = g * 8 + hh;
                const bf16x8 q0 = *(const bf16x8*)(QR + m * 1024 + H * 64 + 8 * fq), q1 = *(const bf16x8*)(QR + m * 1024 + H * 64 + 32 + 8 * fq);
                float mrun = -INFINITY, lrun = 0.f;
#pragma unroll 1
                for (int kt = 0; kt < nkt; ++kt) {
                    const bf16x8 k0 = *(const LAS bf16x8*)(L + CA_KC + (16 * kt + fr) * CA_KC_PITCH + 16 * fq), k1 = *(const LAS bf16x8*)(L + CA_KC + (16 * kt + fr) * CA_KC_PITCH + 64 + 16 * fq);
                    f32x4 sv = (f32x4){0.f, 0.f, 0.f, 0.f}; sv = MFMA16(k0, q0, sv); sv = MFMA16(k1, q1, sv);
                    float tm = -INFINITY;
#pragma unroll
                    for (int r = 0; r < 4; ++r) { const int key = 16 * kt + 4 * fq + r; const bool vis = (16 * key + 31) <= t; sv[r] = vis ? sv[r] * 0.125f : -INFINITY; tm = fmaxf(tm, sv[r]); }
                    const float mn = fmaxf(mrun, tm);
                    if (mn != -INFINITY) { float add = 0.f;
#pragma unroll
                        for (int r = 0; r < 4; ++r) add += (sv[r] == -INFINITY) ? 0.f : __expf(sv[r] - mn);
                        lrun = lrun * ((mrun == -INFINITY) ? 0.f : __expf(mrun - mn)) + add; mrun = mn; }
                }
                float mx = fmaxf(mrun, __shfl_xor(mrun, 16)); mx = fmaxf(mx, __shfl_xor(mx, 32));
                const float mref = (mx == -INFINITY) ? 0.f : mx;
                float sum = (mrun == -INFINITY) ? 0.f : lrun * __expf(mrun - mref);
                sum += __shfl_xor(sum, 16); sum += __shfl_xor(sum, 32);
                const float inv = 1.f / fmaxf(sum, 1e-30f);
                f32x4 o[4];
#pragma unroll
                for (int dt = 0; dt < 4; ++dt) o[dt] = (f32x4){0.f, 0.f, 0.f, 0.f};
#pragma unroll
                for (int ks = 0; ks < 8; ++ks) if (2 * ks < nkt) {
                    float p[8];
#pragma unroll
                    for (int half = 0; half < 2; ++half) { const int kt = 2 * ks + half;
                        const bf16x8 k0 = *(const LAS bf16x8*)(L + CA_KC + (16 * kt + fr) * CA_KC_PITCH + 16 * fq), k1 = *(const LAS bf16x8*)(L + CA_KC + (16 * kt + fr) * CA_KC_PITCH + 64 + 16 * fq);
                        f32x4 sv = (f32x4){0.f, 0.f, 0.f, 0.f}; sv = MFMA16(k0, q0, sv); sv = MFMA16(k1, q1, sv);
#pragma unroll
                        for (int r = 0; r < 4; ++r) { const int key = 16 * kt + 4 * fq + r; const bool vis = (16 * key + 31) <= t; p[4 * half + r] = vis ? __expf(sv[r] * 0.125f - mref) * inv : 0.f; } }
                    iaA[2 * ks] += (p[0] + p[1]) + (p[2] + 0.5f * p[3]); iaB[2 * ks] += p[3]; iaA[2 * ks + 1] += (p[4] + p[5]) + (p[6] + 0.5f * p[7]); iaB[2 * ks + 1] += p[7];
                    u32x4 pw; pw.x = pk2(p[0], p[1]); pw.y = pk2(p[2], p[3]); pw.z = pk2(p[4], p[5]); pw.w = pk2(p[6], p[7]);
                    const bf16x8 pb = __builtin_bit_cast(bf16x8, pw);
#pragma unroll
                    for (int dt = 0; dt < 4; ++dt) { const u32x2 v0 = *(const LAS u32x2*)(L + CA_VT + (16 * dt + fr) * CA_VT_PITCH + (32 * ks + 4 * fq) * 2), v1 = *(const LAS u32x2*)(L + CA_VT + (16 * dt + fr) * CA_VT_PITCH + (32 * ks + 16 + 4 * fq) * 2);
                        u32x4 vw; vw.x = v0.x; vw.y = v0.y; vw.z = v1.x; vw.w = v1.y; o[dt] = MFMA16(__builtin_bit_cast(bf16x8, vw), pb, o[dt]); }
                    __builtin_amdgcn_sched_barrier(0); }
                const float gate = sigmoidf_(bf2f(F1[m * F1_LD + 1792 + H * 3 + 0]));
#pragma unroll
                for (int dt = 0; dt < 4; ++dt) { u32x2 w; w.x = pk2(o[dt][0] * gate, o[dt][1] * gate); w.y = pk2(o[dt][2] * gate, o[dt][3] * gate); *(u32x2*)(ONSA + m * 1024 + H * 64 + 16 * dt + 4 * fq) = w; }
            }
            float imp[16];
#pragma unroll
            for (int kt = 0; kt < 16; ++kt) { const float up = __shfl(iaB[kt], (lane + 48) & 63); imp[kt] = up; }
            { float carry = 0.f;
#pragma unroll
              for (int kt = 0; kt < 16; ++kt) { const float prev3 = (fq == 0) ? carry : imp[kt]; carry = imp[kt]; imp[kt] = 0.5f * prev3 + iaA[kt]; } }
            const int cur = t >> 6;
            unsigned long long mask = 0ull;
            if (t0 < 1024) {
#pragma unroll
                for (int kt = 0; kt < 16; ++kt) { const int j = 4 * kt + fq; if (j <= cur) mask |= 1ull << j; }
            } else {
                float cv[16];
#pragma unroll
                for (int kt = 0; kt < 16; ++kt) { const int j = 4 * kt + fq; const bool forced = (j == 0) || (j == cur) || (j == cur - 1); cv[kt] = (j <= cur && !forced) ? imp[kt] : -INFINITY; }
                int rank[16];
#pragma unroll
                for (int kt = 0; kt < 16; ++kt) rank[kt] = 0;
#pragma unroll 1
                for (int f2 = 0; f2 < 4; ++f2) {
#pragma unroll
                    for (int k2 = 0; k2 < 16; ++k2) { const float ov = __shfl(cv[k2], fr + 16 * f2); const int j2 = 4 * k2 + f2;
#pragma unroll
                        for (int kt = 0; kt < 16; ++kt) { const int j = 4 * kt + fq; rank[kt] += (ov > cv[kt] || (ov == cv[kt] && j2 < j)) ? 1 : 0; } } }
#pragma unroll
                for (int kt = 0; kt < 16; ++kt) { const int j = 4 * kt + fq; const bool forced = (j == 0) || (j == cur) || (j == cur - 1);
                    if (forced || (cv[kt] != -INFINITY && rank[kt] < SEL_TOPN - 3)) mask |= 1ull << j; }
            }
            { unsigned lo = (unsigned)mask, hi = (unsigned)(mask >> 32);
              lo |= __shfl_xor(lo, 16); hi |= __shfl_xor(hi, 16); lo |= __shfl_xor(lo, 32); hi |= __shfl_xor(hi, 32);
              if (fq == 0) SEL[(size_t)bg * SEQ + t] = ((unsigned long long)hi << 32) | lo; }
        }
    }
}

constexpr int SA_K = 0, SA_V = 8192, SA_BUF = 16384, SA_NS = 8, SA_GB = 4;
#define SA_BAR() do { asm volatile("s_waitcnt lgkmcnt(0)" ::: "memory"); __builtin_amdgcn_s_barrier(); asm volatile("" ::: "memory"); } while (0)
template <int MODE  >
__device__ __forceinline__ void nsa_attn_pass(const Frame& F, const bf16_t* Kg, const bf16_t* Vtg, const bf16x8 (&qf)[2][2], const unsigned long long (&selm)[2], int tq[2], int bg, int qb, f32x4 (&outacc)[2][4], const float (&gate)[2]) {
    const int lane = F.lane, tid = F.tid, fr = lane & 15, fq = lane >> 4;
    LAS unsigned char* L = F.lds;
    const int j0 = (MODE == 0) ? 0 : (qb - 8 > 0 ? qb - 8 : 0), j1 = qb;
    f32x4 O[2][4]; float mrun[2], lrun[2];
#pragma unroll
    for (int i = 0; i < 2; ++i) { mrun[i] = -INFINITY; lrun[i] = 0.f;
#pragma unroll
        for (int dt = 0; dt < 4; ++dt) O[i][dt] = (f32x4){0.f, 0.f, 0.f, 0.f}; }
    const int wv_ = F.wave;
#define SA_ISSUE(jt_) do { LAS unsigned char* slot_ = L + (((jt_) - j0) % SA_NS) * SA_BUF; \
        _Pragma("unroll") for (int i_ = 0; i_ < 2; ++i_) { const int pc_ = 2 * wv_ + i_, P_ = pc_ & 7; const int row_ = 8 * P_ + (lane >> 3), c16_ = (lane & 7) ^ ((row_ >> 1) & 7); \
            const bf16_t* src_ = (pc_ < 8) ? Kg + ((size_t)bg * SEQ + (size_t)(jt_) * 64) * 64 + row_ * 64 + c16_ * 8 : Vtg + ((size_t)bg * 64 + (jt_)) * 4096 + row_ * 64 + c16_ * 8; \
            __builtin_amdgcn_global_load_lds((const unsigned*)src_, (LAS unsigned*)(slot_ + (pc_ < 8 ? SA_K : SA_V) + P_ * 1024), 16, 0, 0); } } while (0)
    __syncthreads();
#pragma unroll 1
    for (int d_ = 0; d_ < 2 * SA_GB; ++d_) if (j0 + d_ <= j1) SA_ISSUE(j0 + d_);
    if (j0 + 2 * SA_GB - 1 <= j1) asm volatile("s_waitcnt vmcnt(8)" ::: "memory");
    else asm volatile("s_waitcnt vmcnt(0)" ::: "memory");
    SA_BAR();
#pragma unroll 1
    for (int jg = j0; jg <= j1; jg += SA_GB) {
#pragma unroll 1
      for (int j = jg; j < jg + SA_GB && j <= j1; ++j) {
        LAS unsigned char* Lb = L + ((j - j0) % SA_NS) * SA_BUF;
        const bool edge = (j == j1) || (MODE == 1 && j == qb - 8);
#pragma unroll
        for (int i = 0; i < 2; ++i) {
            const int t = tq[i];
            bool colok;
            if (MODE == 0) colok = (selm[i] >> j) & 1ull; else colok = true;
            if (__ballot(colok) == 0ull) continue;
            f32x4 s[4];
#pragma unroll
            for (int kt = 0; kt < 4; ++kt) { s[kt] = (f32x4){0.f, 0.f, 0.f, 0.f};
                const int key_ = 16 * kt + fr, sw_ = (key_ >> 1) & 7;
                const bf16x8 k0 = *(const LAS bf16x8*)(Lb + SA_K + key_ * 128 + ((fq ^ sw_) * 16)), k1 = *(const LAS bf16x8*)(Lb + SA_K + key_ * 128 + (((4 + fq) ^ sw_) * 16));
                s[kt] = MFMA16(k0, qf[i][0], s[kt]); s[kt] = MFMA16(k1, qf[i][1], s[kt]); }
            constexpr float SC = 0.125f * 1.4426950408889634f;
            float mx = -INFINITY;
            if (edge) {
#pragma unroll
                for (int kt = 0; kt < 4; ++kt)
#pragma unroll
                    for (int r = 0; r < 4; ++r) { const int kpos = 64 * j + 16 * kt + 4 * fq + r; bool vis = (kpos <= t); if (MODE == 1) vis = vis && (kpos > t - WINDOW);
                        s[kt][r] = vis ? s[kt][r] : -INFINITY; mx = fmaxf(mx, s[kt][r]); }
            } else {
#pragma unroll
                for (int kt = 0; kt < 4; ++kt) mx = fmaxf(fmaxf(mx, fmaxf(s[kt][0], s[kt][1])), fmaxf(s[kt][2], s[kt][3]));
            }
            mx = colok ? mx * SC : -INFINITY;
            mx = fmaxf(mx, __shfl_xor(mx, 16)); mx = fmaxf(mx, __shfl_xor(mx, 32));
            const float mnew = fmaxf(mrun[i], mx);
            const float alpha = (mrun[i] == -INFINITY) ? 0.f : __builtin_amdgcn_exp2f(mrun[i] - mnew);
            const float msub = (colok && mnew != -INFINITY) ? mnew : INFINITY;
            mrun[i] = mnew;
            float p[16]; float psum = 0.f;
#pragma unroll
            for (int kt = 0; kt < 4; ++kt)
#pragma unroll
                for (int r = 0; r < 4; ++r) { const float e = __builtin_amdgcn_exp2f(__builtin_fmaf(s[kt][r], SC, -msub)); p[4 * kt + r] = e; psum += e; }
            lrun[i] = lrun[i] * alpha + psum;
#pragma unroll
            for (int dt = 0; dt < 4; ++dt) O[i][dt] = O[i][dt] * alpha;
#pragma unroll
            for (int ks = 0; ks < 2; ++ks) { u32x4 pw; pw.x = pk2(p[8 * ks], p[8 * ks + 1]); pw.y = pk2(p[8 * ks + 2], p[8 * ks + 3]); pw.z = pk2(p[8 * ks + 4], p[8 * ks + 5]); pw.w = pk2(p[8 * ks + 6], p[8 * ks + 7]);
                const bf16x8 pb = __builtin_bit_cast(bf16x8, pw);
#pragma unroll
                for (int dt = 0; dt < 4; ++dt) { const int d_ = 16 * dt + fr, sw_ = (d_ >> 1) & 7, c_ = 4 * ks + (fq >> 1);
                    const u32x2 v0 = *(const LAS u32x2*)(Lb + SA_V + d_ * 128 + ((c_ ^ sw_) * 16) + 8 * (fq & 1)), v1 = *(const LAS u32x2*)(Lb + SA_V + d_ * 128 + (((c_ + 2) ^ sw_) * 16) + 8 * (fq & 1));
                    u32x4 vw; vw.x = v0.x; vw.y = v0.y; vw.z = v1.x; vw.w = v1.y; O[i][dt] = MFMA16(__builtin_bit_cast(bf16x8, vw), pb, O[i][dt]); } }
        }
      }
      asm volatile("s_waitcnt vmcnt(0)" ::: "memory");
      SA_BAR();
#pragma unroll 1
      for (int d_ = 0; d_ < SA_GB; ++d_) if (jg + 2 * SA_GB + d_ <= j1) SA_ISSUE(jg + 2 * SA_GB + d_);
    }
#undef SA_ISSUE
#pragma unroll
    for (int i = 0; i < 2; ++i) { float l = lrun[i]; l += __shfl_xor(l, 16); l += __shfl_xor(l, 32); const float sc = gate[i] / fmaxf(l, 1e-30f);
#pragma unroll
        for (int dt = 0; dt < 4; ++dt) outacc[i][dt] += O[i][dt] * sc; }
}
__device__ __forceinline__ void nsa_attn_phase(const Frame& F, const Args& a, bool do_store = true) {
    const bf16_t* F1 = (const bf16_t*)(F.ws + WS_BIG); const bf16_t* QR = (const bf16_t*)(F.ws + WS_BIG + B1_QR);
    const bf16_t* KS = (const bf16_t*)(F.ws + WS_BIG + B1_KS); const bf16_t* VST = (const bf16_t*)(F.ws + WS_BIG + B1_VST); const bf16_t* KW = (const bf16_t*)(F.ws + WS_BIG + B1_KW); const bf16_t* VWT = (const bf16_t*)(F.ws + WS_BIG + B1_VWT);
    const unsigned long long* SEL = (const unsigned long long*)(F.ws + WS_R2 + R2_SEL); bf16_t* ONSA = (bf16_t*)(F.ws + WS_XN);
    const int lane = F.lane, wave = F.wave, fr = lane & 15, fq = lane >> 4;
    for (int c = F.bid; c < 256; c += F.G) {
        const int bg = c & 15, kq = c >> 4, b = bg >> 1, g = bg & 1;
#pragma unroll 1
        for (int rep = 0; rep < 8; ++rep) {
            const int hb = 16 * rep + ((rep & 1) ? 15 - kq : kq);
            const int qb = hb >> 1;
            int tq[2]; bf16x8 qf[2][2]; unsigned long long selm[2]; float gs[2], gw_[2]; f32x4 outacc[2][4]; size_t mrow[2]; int Hh;
            Hh = g * 8 + (fr & 7);
#pragma unroll
            for (int i = 0; i < 2; ++i) { tq[i] = 32 * hb + 4 * wave + 2 * i + (fr >> 3); mrow[i] = (size_t)b * SEQ + tq[i];
                qf[i][0] = *(const bf16x8*)(QR + mrow[i] * 1024 + Hh * 64 + 8 * fq); qf[i][1] = *(const bf16x8*)(QR + mrow[i] * 1024 + Hh * 64 + 32 + 8 * fq);
                selm[i] = SEL[(size_t)bg * SEQ + tq[i]];
                gs[i] = sigmoidf_(bf2f(F1[mrow[i] * F1_LD + 1792 + Hh * 3 + 1])); gw_[i] = sigmoidf_(bf2f(F1[mrow[i] * F1_LD + 1792 + Hh * 3 + 2]));
#pragma unroll
                for (int dt = 0; dt < 4; ++dt) outacc[i][dt] = (f32x4){0.f, 0.f, 0.f, 0.f}; }
            nsa_attn_pass<0>(F, KS, VST, qf, selm, tq, bg, qb, outacc, gs);
            nsa_attn_pass<1>(F, KW, VWT, qf, selm, tq, bg, qb, outacc, gw_);
            if (do_store)
#pragma unroll
            for (int i = 0; i < 2; ++i)
#pragma unroll
                for (int dt = 0; dt < 4; ++dt) { bf16_t* p = ONSA + mrow[i] * 1024 + Hh * 64 + 16 * dt + 4 * fq; const u32x2 old = *(const u32x2*)p;
                    u32x2 w; w.x = pk2(bflo(old.x) + outacc[i][dt][0], bfhi(old.x) + outacc[i][dt][1]); w.y = pk2(bflo(old.y) + outacc[i][dt][2], bfhi(old.y) + outacc[i][dt][3]); *(u32x2*)p = w; }
        }
    }
}
__device__ __forceinline__ void chk_gdn(const Frame& F, const Args& a, int b, int h, int ntok, unsigned* cnt) {
    const bf16_t* F0 = (const bf16_t*)(F.ws + WS_BIG); const bf16_t* OAB = (const bf16_t*)(F.ws + WS_XN);
    LAS float* S = (LAS float*)F.lds;
    LAS float* qkv = S + 16384;
    LAS float* kS = qkv + 384;
    LAS float* ov = kS + 128;
    const int tid = F.tid; const float* convw = a.in[IN_GCONV];

#pragma unroll 1
for (int i = tid; i < 16384; i += NTHREADS) S[i] = 0.f;
    __syncthreads();
    unsigned bad = 0;

#pragma unroll 1
for (int t = 0; t < ntok; ++t) {
        const size_t m = (size_t)b * SEQ + t;
        if (tid < 384) { const int X = tid >> 7, c = tid & 127, col = X * 512 + h * 128 + c; float acc = 0.f;

#pragma unroll 1
for (int i = 0; i < 4; ++i) if (t - 3 + i >= 0) acc += convw[i * 1536 + col] * bf2f(F0[(m - 3 + i) * F0_LD + col]);
            qkv[tid] = acc / (1.f + expf(-acc)); }
        __syncthreads();
        float sq = 0.f, sk = 0.f;
#pragma unroll 1
for (int i = 0; i < 128; ++i) { sq += qkv[i] * qkv[i]; sk += qkv[128 + i] * qkv[128 + i]; }
        const float rq = 1.f / sqrtf(sq + 1e-6f) / sqrtf(128.f), rk = 1.f / sqrtf(sk + 1e-6f);
        const float beta = 1.f / (1.f + expf(-bf2f(F0[m * F0_LD + F0_BA + h])));
        const float aa = bf2f(F0[m * F0_LD + F0_BA + 4 + h]) + a.in[IN_GDT][h];
        const float g = -expf(a.in[IN_GALOG][h]) * (aa > 20.f ? aa : log1pf(expf(aa))); const float eg = expf(g);
        if (tid < 128) { float s = 0.f;
#pragma unroll 1
for (int i = 0; i < 128; ++i) s += qkv[128 + i] * rk * S[i * 128 + tid]; kS[tid] = s; }
        __syncthreads();

#pragma unroll 1
for (int e = tid; e < 16384; e += NTHREADS) { const int i = e >> 7, j = e & 127; const float ki = qkv[128 + i] * rk;
            S[e] = eg * (S[e] - beta * ki * kS[j]) + beta * ki * qkv[256 + j]; }
        __syncthreads();
        if (tid < 128) { float s = 0.f;
#pragma unroll 1
for (int i = 0; i < 128; ++i) s += qkv[i] * rq * S[i * 128 + tid]; ov[tid] = s; }
        __syncthreads();
        if (tid < 128) { float ss = 0.f;
#pragma unroll 1
for (int i = 0; i < 128; ++i) ss += ov[i] * ov[i];
            const float rstd = 1.f / sqrtf(ss / 128.f + NORM_EPS); const float z = bf2f(F0[m * F0_LD + 1536 + h * 128 + tid]);
            const float ref = ov[tid] * rstd * a.in[IN_GNORM][tid] * (z / (1.f + expf(-z))); const float got = bf2f(OAB[m * 1024 + h * 128 + tid]);
            if (!(fabsf(got - ref) <= 0.04f + 0.04f * fabsf(ref))) bad++; }
        __syncthreads();
    }
    if (bad) atomicAdd(cnt, bad);
}
__device__ __forceinline__ void chk_rwkv(const Frame& F, const Args& a, int b, int h, int ntok, unsigned* cnt) {
    const bf16_t* F0 = (const bf16_t*)(F.ws + WS_BIG); const bf16_t* OAB = (const bf16_t*)(F.ws + WS_XN);
    LAS float* S = (LAS float*)F.lds;
    LAS float* xs = S + 4096;
    LAS float* op = xs + 448;
    const int tid = F.tid; unsigned bad = 0;

#pragma unroll 1
for (int i = tid; i < 4096; i += NTHREADS) S[i] = 0.f;
    __syncthreads();

#pragma unroll 1
for (int t = 0; t < ntok; ++t) {
        const size_t m = (size_t)b * SEQ + t;
        if (tid < 448) { int mi; if (tid < 192) mi = (tid >> 6) * 512 + h * 64 + (tid & 63); else mi = 1536 + (tid - 192);
            const float f = bf2f(F0[m * F0_LD + F0_RWKV + mi]); const float fp = t > 0 ? bf2f(F0[(m - 1) * F0_LD + F0_RWKV + mi]) : 0.f;
            xs[tid] = f + (fp - f) * a.in[IN_RMU][mi]; }
        __syncthreads();
        if (tid < 64) { const int hc = h * 64 + tid; float lw = a.in[IN_RW0][hc], la = a.in[IN_RA0][hc], gg = 0.f;

#pragma unroll 1
for (int j = 0; j < 64; ++j) { lw += tanhf(xs[192 + j]) * a.in[IN_RW2][j * 512 + hc]; la += xs[256 + j] * a.in[IN_RA2][j * 512 + hc]; }

#pragma unroll 1
for (int j = 0; j < 128; ++j) gg += (1.f / (1.f + expf(-xs[320 + j]))) * a.in[IN_RG2][j * 512 + hc];
            const float sp = (-lw > 20.f) ? -lw : log1pf(expf(-lw)); const float wlog = -sp - 0.5f;
            const float av = 1.f / (1.f + expf(-la));
            op[tid] = expf(-expf(wlog)); op[64 + tid] = xs[64 + tid] * a.in[IN_RKK][hc]; op[256 + tid] = av;
            op[192 + tid] = xs[64 + tid] * (1.f + (av - 1.f) * a.in[IN_RKA][hc]); op[320 + tid] = gg; }
        __syncthreads();
        float ss = 0.f;
#pragma unroll 1
for (int i = 0; i < 64; ++i) ss += op[64 + i] * op[64 + i];
        const float rinv = 1.f / sqrtf(ss + 1e-6f);
        float bon = 0.f;
#pragma unroll 1
for (int i = 0; i < 64; ++i) bon += xs[i] * op[192 + i] * a.in[IN_RRK][h * 64 + i];
        if (tid < 64) { float sa = 0.f;
#pragma unroll 1
for (int k = 0; k < 64; ++k) sa -= S[tid * 64 + k] * op[64 + k] * rinv;
            float y = 0.f; const float vv = xs[128 + tid];

#pragma unroll 1
for (int k = 0; k < 64; ++k) { const float kk = op[64 + k] * rinv; const float sn = S[tid * 64 + k] * op[k] + sa * kk * op[256 + k] + vv * op[192 + k]; S[tid * 64 + k] = sn; y += sn * xs[k]; }
            op[384 + tid] = y; }
        __syncthreads();
        if (tid < 64) { float mean = 0.f;
#pragma unroll 1
for (int i = 0; i < 64; ++i) mean += op[384 + i]; mean /= 64.f; float var = 0.f;
#pragma unroll 1
for (int i = 0; i < 64; ++i) { const float d = op[384 + i] - mean; var += d * d; } var /= 64.f;
            const int hc = h * 64 + tid;
            const float yn = (op[384 + tid] - mean) / sqrtf(var + RWKV_LN_EPS) * a.in[IN_RLNW][hc] + a.in[IN_RLNB][hc];
            const float ref = (yn + bon * xs[128 + tid]) * op[320 + tid]; const float got = bf2f(OAB[m * 1024 + 512 + hc]);
            if (!(fabsf(got - ref) <= 0.04f + 0.04f * fabsf(ref))) bad++; }
        __syncthreads();
    }
    if (bad) atomicAdd(cnt, bad);
}

__device__ __forceinline__ float chk_rope_val(const bf16_t* row, int base, int d, float posf) {
    if (d >= 16) return bf2f(row[base + d]);
    const int i = d & 7; const float ang = posf * ROPE_INVF[i]; const float cs = cosf(ang), sn = sinf(ang);
    const float x1 = bf2f(row[base + i]), x2 = bf2f(row[base + 8 + i]);
    return d < 8 ? x1 * cs - x2 * sn : x2 * cs + x1 * sn;
}
__device__ __forceinline__ void chk_nsa(const Frame& F, const Args& a, int b, int g, int t, unsigned* cnt) {
    const bf16_t* F1 = (const bf16_t*)(F.ws + WS_BIG); const bf16_t* ONSA = (const bf16_t*)(F.ws + WS_XN);
    const int* pos = (const int*)a.in[IN_POS];
    LAS float* kc = (LAS float*)F.lds;
    LAS float* vc = kc + 8192;
    LAS float* hb = vc + 8192;
    LAS float* sb = hb + 512;
    LAS float* red = sb + 4096;
    LAS float* qv = red + 512;
    LAS float* impv = qv + 64;
    LAS float* ocv = impv + 64;
    LAS float* misc = ocv + 512;
    LAS unsigned* selw = (LAS unsigned*)(misc + 8);
    const int tid = F.tid; const size_t mb = (size_t)b * SEQ; const size_t m = mb + t;
    const int nk = t >= 31 ? (t - 31) / 16 + 1 : 0;
    unsigned bad = 0;
#pragma unroll 1
    for (int i = 0; i < nk; ++i) {
        { const int path = tid >> 8, hid = tid & 255; const float* w1 = a.in[path ? IN_NW1V : IN_NW1K]; const float* pe = a.in[path ? IN_NPEV : IN_NPEK]; float acc = 0.f;
#pragma unroll 1
          for (int sl = 0; sl < 32; ++sl) { const bf16_t* row = F1 + (mb + 16 * i + sl) * F1_LD + 1024 + path * 128 + g * 64;
#pragma unroll 1
              for (int d = 0; d < 64; ++d) acc += (bf2f(row[d]) + pe[sl * 64 + d]) * w1[(size_t)(sl * 64 + d) * 256 + hid]; }
          hb[tid] = acc / (1.f + expf(-acc)); }
        __syncthreads();
        if (tid < 128) { const int path = tid >> 6, d = tid & 63; const float* w2 = a.in[path ? IN_NW2V : IN_NW2K]; float acc = 0.f;
#pragma unroll 1
            for (int hid = 0; hid < 256; ++hid) acc += hb[path * 256 + hid] * w2[hid * 64 + d];
            (path ? vc : kc)[i * 64 + d] = acc; }
        __syncthreads();
    }
    if (tid < nk * 8) { const int i = tid >> 3, dd = tid & 7; const float ang = (float)pos[mb + 31 + 16 * i] * ROPE_INVF[dd]; const float cs = cosf(ang), sn = sinf(ang);
        const float x1 = kc[i * 64 + dd], x2 = kc[i * 64 + 8 + dd]; kc[i * 64 + dd] = x1 * cs - x2 * sn; kc[i * 64 + 8 + dd] = x2 * cs + x1 * sn; }
    if (tid < 64) impv[tid] = 0.f;
    __syncthreads();
    const float posq = (float)pos[m];
#pragma unroll 1
    for (int hh = 0; hh < 8; ++hh) { const int H = g * 8 + hh;
        if (tid < 64) qv[tid] = chk_rope_val(F1 + m * F1_LD, H * 64, tid, posq) * 0.125f;
        __syncthreads();
        if (tid < nk) { float s = 0.f;
#pragma unroll 1
            for (int d = 0; d < 64; ++d) s += qv[d] * kc[tid * 64 + d]; sb[tid] = s; }
        __syncthreads();
        if (tid == 0) { float mx = -INFINITY;
#pragma unroll 1
            for (int i = 0; i < nk; ++i) mx = fmaxf(mx, sb[i]); float sum = 0.f;
#pragma unroll 1
            for (int i = 0; i < nk; ++i) sum += expf(sb[i] - mx); misc[0] = mx; misc[1] = fmaxf(sum, 1e-30f); }
        __syncthreads();
        if (tid < nk) sb[tid] = expf(sb[tid] - misc[0]) / misc[1];
        __syncthreads();
        if (tid < 64) { float o = 0.f;
#pragma unroll 1
            for (int i = 0; i < nk; ++i) o += sb[i] * vc[i * 64 + tid]; ocv[hh * 64 + tid] = o;
            float im = 0.f;
#pragma unroll 1
            for (int i = 4 * tid - 1; i <= 4 * tid + 3; ++i) if (i >= 0 && i < nk) im += sb[i] * ((i == 4 * tid - 1 || i == 4 * tid + 3) ? 0.5f : 1.f);
            impv[tid] += im; }
        __syncthreads();
    }
    if (tid == 0) { const int cur = t >> 6; unsigned lo = 0u, hi = 0u;
#pragma unroll 1
        for (int r = 0; r < 16; ++r) { int best = -1; float bv = 0.f;
#pragma unroll 1
            for (int j = 0; j < 64; ++j) { const bool taken = j < 32 ? ((lo >> j) & 1u) : ((hi >> (j - 32)) & 1u); if (taken) continue;
                const bool valid = j <= cur, forced = (j == 0) || (j == cur) || (j == cur - 1);
                const float sc = valid ? (forced ? INFINITY : impv[j]) : -INFINITY;
                if (best < 0 || sc > bv) { best = j; bv = sc; } }
            if (best < 32) lo |= 1u << best; else hi |= 1u << (best - 32); }
        selw[0] = lo; selw[1] = hi; }
    __syncthreads();
#pragma unroll 1
    for (int hh = 0; hh < 8; ++hh) { const int H = g * 8 + hh;
        if (tid < 64) qv[tid] = chk_rope_val(F1 + m * F1_LD, H * 64, tid, posq) * 0.125f;
        __syncthreads();
        float osw[2] = {0.f, 0.f};
#pragma unroll 1
        for (int br = 0; br < 2; ++br) {
            const int kbase = 1024 + (br == 0 ? 2 : 4) * 128 + g * 64, vbase = kbase + 128;
            float lmx = -INFINITY;
#pragma unroll 1
            for (int kp = tid; kp < 4096; kp += NTHREADS) { float s = -INFINITY; const int j = kp >> 6;
                bool vis = kp <= t; if (br == 0) vis = vis && (j < 32 ? ((selw[0] >> j) & 1u) : ((selw[1] >> (j - 32)) & 1u)); else vis = vis && (kp > t - WINDOW);
                if (vis) { s = 0.f; const float pk = (float)pos[mb + kp];
#pragma unroll 1
                    for (int d = 0; d < 64; ++d) s += qv[d] * chk_rope_val(F1 + (mb + kp) * F1_LD, kbase, d, pk); }
                sb[kp] = s; lmx = fmaxf(lmx, s); }
            red[tid] = lmx; __syncthreads();
            if (tid == 0) { float mx = -INFINITY;
#pragma unroll 1
                for (int i = 0; i < NTHREADS; ++i) mx = fmaxf(mx, red[i]); misc[0] = mx; }
            __syncthreads();
            float ls = 0.f;
#pragma unroll 1
            for (int kp = tid; kp < 4096; kp += NTHREADS) { const float e = (sb[kp] == -INFINITY) ? 0.f : expf(sb[kp] - misc[0]); sb[kp] = e; ls += e; }
            red[tid] = ls; __syncthreads();
            if (tid == 0) { float sm = 0.f;
#pragma unroll 1
                for (int i = 0; i < NTHREADS; ++i) sm += red[i]; misc[1] = fmaxf(sm, 1e-30f); }
            __syncthreads();
            if (tid < 64) { float o = 0.f;
#pragma unroll 1
                for (int kp = 0; kp <= t; ++kp) if (sb[kp] != 0.f) o += sb[kp] * bf2f(F1[(mb + kp) * F1_LD + vbase + tid]); osw[br] = o / misc[1]; }
            __syncthreads();
        }
        if (tid < 64) { const float g0 = 1.f / (1.f + expf(-bf2f(F1[m * F1_LD + 1792 + H * 3 + 0]))), g1 = 1.f / (1.f + expf(-bf2f(F1[m * F1_LD + 1792 + H * 3 + 1]))), g2 = 1.f / (1.f + expf(-bf2f(F1[m * F1_LD + 1792 + H * 3 + 2])));
            const float ref = g0 * ocv[hh * 64 + tid] + g1 * osw[0] + g2 * osw[1]; const float got = bf2f(ONSA[m * 1024 + H * 64 + tid]);
            if (!(fabsf(got - ref) <= 0.004f + 0.05f * fabsf(ref))) bad++; }
        __syncthreads();
    }
    if (bad) atomicAdd(cnt, bad);
}
#define GEMM_PHASE(ACT, Aptr, Bptr, Optr, Mrows, N, K, ldo, cshift) do { pg8::Gemm g_{(const bf16_t*)(Aptr), (const bf16_t*)(Bptr), (Mrows), (N), (K)}; pg8::StaticOrder S_; S_.init((Mrows), (N), F.G, (F.bid + (cshift)) % F.G); \
      pg8::EpiBf16<ACT> E_{(bf16_t*)(Optr), (ldo)}; pg8::gemm_phase<pg8::EpiBf16<ACT>, pg8::StaticOrder, true, true>(F.lds, g_, S_, E_); } while (0)
__global__ void __launch_bounds__(NTHREADS, 2) mk_fwd(Args args) {
    extern __shared__ __attribute__((aligned(16))) unsigned char lds[];
    cg::grid_group grid = cg::this_grid();
    Frame F; F.lds = (LAS unsigned char*)lds; F.tid = threadIdx.x; F.lane = F.tid & 63; F.wave = __builtin_amdgcn_readfirstlane(F.tid >> 6);
    F.G = gridDim.x; F.bid = blockIdx.x; F.ws = args.ws; F.ctl = (unsigned*)(args.ws + WS_CTL);
    unsigned char* ws = args.ws;
    if (F.tid < 16) ((LAS unsigned*)(F.lds + XB_LDS_OFF))[F.tid] = 0u;
    __syncthreads();
    XcdBarrier xbar = xcd_barrier_post(F.ctl + CW_BAR, (volatile LAS unsigned*)(F.lds + XB_LDS_OFF));
#define GSYNC() xcd_barrier(xbar)
    p0_prologue(fresh(F), args);
    rwkvc_build_images(fresh(F), args);
    if (F.G <= 96) p0_layer1_weights(fresh(F), args, 0, 0, -1);
    grid.sync();
    GEMM_PHASE(0, ws + WS_XN, ws + WS_W_IN0, ws + WS_BIG, MTOK, 4096, 1024, F0_LD, 0);
    GSYNC();
    gdn_prep_phase(fresh(F), args);
    GSYNC();
#pragma unroll 1
    for (int sg = 0; sg < RC_NSEG; ++sg) {
        rwkvc_prep_phase(fresh(F), args, sg);
        GSYNC();
        for (int u = F.bid; u < 96; u += F.G) {
            if (u < 64) rwkvc_chain_unit(fresh(F), args, u, sg); else gdn_scan_unit(fresh(F), args, u - 64, 8 * sg, 8 * sg + 8);
            __syncthreads(); }
        if (sg < 4 && F.G > 96 && F.bid >= 96) p0_layer1_weights(fresh(F), args, 96, F.G - 96, sg);
        GSYNC();
    }
    GEMM_PHASE(0, ws + WS_XN, ws + WS_W_OUT0, ws + WS_BIG, MTOK, 1024, 1024, 1024, 0);
    GSYNC();
    row_pass(fresh(F), (const bf16_t*)(ws + WS_BIG), args.in[IN_X], args.in[IN_NMPOST], args.out, args.in[IN_NFPRE], (bf16_t*)(ws + WS_XN));
    GSYNC();
    GEMM_PHASE(2, ws + WS_XN, ws + WS_W_UP0, ws + WS_BIG, MTOK, 4096, 1024, 4096, 0);
    GSYNC();
    GEMM_PHASE(0, ws + WS_BIG, ws + WS_W_DN0, ws + WS_R2, MTOK, 1024, 4096, 1024, 0);
    GSYNC();
    row_pass(fresh(F), (const bf16_t*)(ws + WS_R2), args.out, args.in[IN_NFPOST], args.out, args.in[IN_NMPRE] + 1024, (bf16_t*)(ws + WS_XN));
    GSYNC();
    GEMM_PHASE(0, ws + WS_XN, ws + WS_W_IN1, ws + WS_BIG, MTOK, 2048, 1024, F1_LD, 0);
    GSYNC();
    nsa_prep_phase(fresh(F), args);
    GSYNC();
    GEMM_PHASE(3, ws + WS_BIG + B1_ACMPK, ws + WS_W_C1K, ws + WS_R2 + R2_HCMP, 4096, 256, 2048, 256, 0);
    GEMM_PHASE(3, ws + WS_BIG + B1_ACMPV, ws + WS_W_C1V, ws + WS_R2 + R2_HCMP + (size_t)4096 * 256 * 2, 4096, 256, 2048, 256, 128);
    GSYNC();
    nsa_cmp2_phase(fresh(F), args);
    GSYNC();
    nsa_cmp_attn_phase(fresh(F), args);
    GSYNC();
    nsa_attn_phase(fresh(F), args);
    GSYNC();
#ifdef WITH_CHECKS
    if (F.bid == 0) chk_nsa(F, args, 0, 0, 1500, F.ctl + 2);
    else if (F.bid == 1) chk_nsa(F, args, 3, 1, 2047, F.ctl + 2);
    else if (F.bid == 2) chk_nsa(F, args, 7, 0, 40, F.ctl + 2);
    else if (F.bid == 3) chk_nsa(F, args, 5, 1, 1023, F.ctl + 2);
    else if (F.bid == 4) chk_nsa(F, args, 2, 0, 700, F.ctl + 2);
    else if (F.bid == 5) chk_nsa(F, args, 6, 1, 1777, F.ctl + 2);
    GSYNC();
#endif
    GEMM_PHASE(0, ws + WS_XN, ws + WS_W_OUT1, ws + WS_BIG, MTOK, 1024, 1024, 1024, 0);
    GSYNC();
    row_pass(fresh(F), (const bf16_t*)(ws + WS_BIG), args.out, args.in[IN_NMPOST] + 1024, args.out, args.in[IN_NFPRE] + 1024, (bf16_t*)(ws + WS_XN));
    GSYNC();
    GEMM_PHASE(2, ws + WS_XN, ws + WS_W_UP1, ws + WS_BIG, MTOK, 4096, 1024, 4096, 0);
    GSYNC();
    GEMM_PHASE(0, ws + WS_BIG, ws + WS_W_DN1, ws + WS_R2, MTOK, 1024, 4096, 1024, 0);
    GSYNC();
    row_pass(fresh(F), (const bf16_t*)(ws + WS_R2), args.out, args.in[IN_NFPOST] + 1024, args.out, nullptr, nullptr);
#ifdef WITH_CHECKS
    GSYNC();
    const unsigned en = __hip_atomic_load(F.ctl + 2, __ATOMIC_RELAXED, __HIP_MEMORY_SCOPE_AGENT);
    const float c = en ? 10.f : 0.f;
    const int gt = F.bid * NTHREADS + F.tid, NT = F.G * NTHREADS;
    if (c != 0.f) for (size_t i = gt; i < (size_t)MTOK * D_MODEL; i += NT) args.out[i] += c;
#endif
}
extern "C" void kernel_launch(void* const* d_in, const int* in_sizes, int n_in, void* d_out, int out_size, void* d_ws, size_t ws_size, hipStream_t stream) {
    static int grid = 0;
    if (grid == 0) {
        if (n_in != 33 || out_size != MTOK * D_MODEL || ws_size < WS_END) { fprintf(stderr, "kernel_launch: unexpected problem (n_in %d out %d ws %zu)\n", n_in, out_size, ws_size); grid = -1; return; }
        int dev = 0, cus = 0, per_cu = 0;
        (void)hipGetDevice(&dev); (void)hipDeviceGetAttribute(&cus, hipDeviceAttributeMultiprocessorCount, dev);
        (void)hipFuncSetAttribute((const void*)mk_fwd, hipFuncAttributeMaxDynamicSharedMemorySize, LDS_BYTES);
        (void)hipOccupancyMaxActiveBlocksPerMultiprocessor(&per_cu, (const void*)mk_fwd, NTHREADS, LDS_BYTES);
        if (per_cu < 1) { fprintf(stderr, "kernel_launch: occupancy query says %d blocks/CU\n", per_cu); grid = -1; return; }
        grid = cus;
        fprintf(stderr, "kernel_launch: grid %d (cus %d, per_cu %d) ws %zu\n", grid, cus, per_cu, ws_size);
    }
    if (grid < 0) return;
    (void)hipMemsetAsync((char*)d_ws + WS_CTL, 0, 1 * MiB, stream);
    Args a{};
    for (int i = 0; i < 33; ++i) a.in[i] = (const float*)d_in[i];
    a.out = (float*)d_out; a.ws = (unsigned char*)d_ws; a.ph_lo = 0; a.ph_hi = 100;
    void* kargs[] = {&a};
    hipError_t e = hipLaunchCooperativeKernel((void*)mk_fwd, dim3(grid), dim3(NTHREADS), kargs, LDS_BYTES, stream);
    if (e != hipSuccess) fprintf(stderr, "cooperative launch failed: %s (grid %d)\n", hipGetErrorString(e), grid);
}
```

```cpp
#include <hip/hip_runtime.h>
#include <hip/hip_cooperative_groups.h>
#include <cstdio>
#include <cstdint>
namespace cg = cooperative_groups;

constexpr int D_MODEL = 1024, BATCH = 8, SEQ = 4096, MTOK = BATCH * SEQ;
constexpr int GDN_HEADS = 4, GDN_DK = 128, GDN_DV = 128, GDN_CHUNK = 64;
constexpr int RWKV_HEADS = 8, RWKV_N = 64;
constexpr int NSA_HEADS = 16, NSA_GROUPS = 2, NSA_HD = 64, CMP_LEN = 32, CMP_STRIDE = 16, CMP_HIDDEN = 256;
constexpr int SEL_BLOCK = 64, SEL_TOPN = 16, WINDOW = 512;
constexpr int D_FF = 4096;
constexpr float NORM_EPS = 1e-6f, RWKV_LN_EPS = 64e-5f;
constexpr int AB_IN_W = 3848, NSA_IN_W = 1840;
constexpr int F0_LD = 4096;
constexpr int F1_LD = 2048;
constexpr int F0_RWKV = 2048, F0_BA = 3840;

typedef unsigned short bf16_t;
typedef short bf16x8 __attribute__((ext_vector_type(8)));
typedef float f32x4 __attribute__((ext_vector_type(4)));
typedef float f32x2 __attribute__((ext_vector_type(2)));
typedef unsigned u32x4 __attribute__((ext_vector_type(4)));
typedef unsigned u32x2 __attribute__((ext_vector_type(2)));
#define LAS __attribute__((address_space(3)))

typedef __bf16 hwbf16x2 __attribute__((ext_vector_type(2)));
__device__ __forceinline__ unsigned pk2(float lo, float hi) { const f32x2 v = {lo, hi}; const hwbf16x2 b = __builtin_convertvector(v, hwbf16x2); return __builtin_bit_cast(unsigned, b); }
__device__ __forceinline__ unsigned f2bf(float f) { return pk2(f, 0.f) & 0xffffu; }
__device__ __forceinline__ float bf2f(bf16_t h) { return __builtin_bit_cast(float, (unsigned)h << 16); }
__device__ __forceinline__ float bflo(unsigned u) { return __builtin_bit_cast(float, u << 16); }
__device__ __forceinline__ float bfhi(unsigned u) { return __builtin_bit_cast(float, u & 0xffff0000u); }
__device__ __forceinline__ float wave_sum(float v) {
#pragma unroll
    for (int o = 1; o < 64; o <<= 1) v += __shfl_xor(v, o);
    return v;
}
__device__ __forceinline__ float sigmoidf_(float x) { return 1.f / (1.f + __expf(-x)); }
__device__ __forceinline__ float siluf_(float x) { return x / (1.f + __expf(-x)); }
__device__ __forceinline__ float softplusf_(float x) { return x > 20.f ? x : log1pf(__expf(x)); }

__device__ __forceinline__ float fast_tanhf(float x) { const float e = __expf(2.f * x); return 1.f - 2.f / (e + 1.f); }
__device__ __forceinline__ float fast_softplusf(float x) { return x > 20.f ? x : __logf(1.f + __expf(x)); }
__device__ __forceinline__ float dpp_f(float v, const int ctrl_sel) {
    const int i = __builtin_bit_cast(int, v);
    int r;
    if (ctrl_sel == 0) r = __builtin_amdgcn_update_dpp(i, i, 0xB1, 0xF, 0xF, false);
    else if (ctrl_sel == 1) r = __builtin_amdgcn_update_dpp(i, i, 0x4E, 0xF, 0xF, false);
    else r = __builtin_amdgcn_update_dpp(i, i, 0x141, 0xF, 0xF, false);
    return __builtin_bit_cast(float, r);
}
__device__ __forceinline__ float red8_dpp(float v) { v += dpp_f(v, 0); v += dpp_f(v, 1); v += dpp_f(v, 2); return v; }
namespace pg8 {
#define PG8_LAS __attribute__((address_space(3)))
constexpr int BM = 256, BK = 64, HALF = 128, HTB = HALF * BK * 2  , STAGE_BYTES = 8 * HTB, NXCD = 8, WGM = 8;

__host__ __device__ __forceinline__ int lds_byte(int r, int c) { const int st = (r >> 4) * 2 + (c >> 5), rr = r & 15, cc = c & 31, ob = rr * 64 + cc * 2; return st * 1024 + (ob ^ (((ob >> 9) & 1) << 5)); }
__host__ __device__ __forceinline__ void stage_rc(int b, int& R, int& C) { const int st = b / 1024, sb = b % 1024, swz = sb ^ (((sb >> 9) & 1) << 5); R = (st >> 1) * 16 + swz / 64; C = (st & 1) * 32 + (swz % 64) / 2; }
__host__ __device__ __forceinline__ int perm32(int rho) { const int n = rho >> 4, i = rho & 15; return 8 * (i >> 2) + 4 * n + (i & 3); }

struct Unit { int pm, pn; };
struct Gemm { const bf16_t* A; const bf16_t* Bt; int M, N, K; };

struct StaticOrder {
    int nM, nN, nwg, G, c;
    __host__ __device__ void init(int M, int N, int G_, int c_) { nM = M / BM; nN = N / BM; nwg = nM * nN; G = G_; c = c_; }
    __host__ __device__ bool next(int i, Unit& u) const {
        const long L = (long)i * G + c; if (L >= nwg) return false;
        int wgid = (int)L; { const int q = nwg / NXCD, r = nwg % NXCD, xcd = wgid % NXCD, off = wgid / NXCD; wgid = (xcd < r ? xcd * (q + 1) : r * (q + 1) + (xcd - r) * q) + off; }
        const int nig = WGM * nN, gid = wgid / nig, fm = gid * WGM, gsz = (nM - fm) < WGM ? (nM - fm) : WGM;
        u.pm = fm + ((wgid % nig) % gsz); u.pn = (wgid % nig) / gsz; return true;
    }
    __device__ __forceinline__ void a_ready(const Unit&) const {}
    __device__ __forceinline__ void done(const Unit&) const {}
};


__device__ __forceinline__ unsigned cvt_pk_bf16(float lo, float hi) { unsigned r; asm volatile("v_cvt_pk_bf16_f32 %0, %1, %2" : "=v"(r) : "v"(lo), "v"(hi)); return r; }
template <int ACT  > struct EpiBf16 {
    static constexpr bool PERM = true, AFTER_DRAIN = false;
    bf16_t* O; int ldc;
    __device__ __forceinline__ void operator()(const f32x4 (&acc)[2][2][4][2], const Unit& u, int wr, int wc, int fr, int fq) const {
        const int row0 = u.pm * BM + wr * 64 + fr; const int col0 = u.pn * BM + wc * 32 + 8 * fq;
#pragma unroll
        for (int ai = 0; ai < 2; ++ai)
#pragma unroll
            for (int m = 0; m < 4; ++m) { bf16_t* rowp = O + (size_t)(row0 + ai * HALF + m * 16) * ldc + col0;
#pragma unroll
                for (int bj = 0; bj < 2; ++bj) { f32x4 v0 = acc[ai][bj][m][0], v1 = acc[ai][bj][m][1];
                    if (ACT == 2) {
#pragma unroll
                        for (int e = 0; e < 4; ++e) { float a = v0[e] > 0.f ? v0[e] : 0.f; v0[e] = a * a; float b = v1[e] > 0.f ? v1[e] : 0.f; v1[e] = b * b; } }
                    if (ACT == 3) {
#pragma unroll
                        for (int e = 0; e < 4; ++e) { v0[e] = v0[e] / (1.f + __expf(-v0[e])); v1[e] = v1[e] / (1.f + __expf(-v1[e])); } }
                    u32x4 w; w.x = cvt_pk_bf16(v0[0], v0[1]); w.y = cvt_pk_bf16(v0[2], v0[3]); w.z = cvt_pk_bf16(v1[0], v1[1]); w.w = cvt_pk_bf16(v1[2], v1[3]);
                    *(u32x4*)(rowp + bj * HALF) = w; } }
    }
};
template <class Epi, class Sched, bool ALIGN_EPI = false, bool SP2 = false>
__device__ __forceinline__ void gemm_phase(PG8_LAS unsigned char* lds, const Gemm g, const Sched& S, const Epi& E) {
    int tid_ = threadIdx.x; asm volatile("" : "+v"(tid_));
    const int tid = tid_, wid = __builtin_amdgcn_readfirstlane(tid >> 6), lane = tid & 63, wr = wid >> 2, wc = wid & 3, fr = lane & 15, fq = lane >> 4;
    const int K = g.K, nt = K / BK;
    unsigned voffA[2], voffB[2];
#pragma unroll
    for (int i = 0; i < 2; ++i) { int R, C; stage_rc(tid * 16 + i * 8192, R, C); const int Rb = Epi::PERM ? ((R & ~31) + perm32(R & 31)) : R;
        voffA[i] = (unsigned)(R * K + C) * 2u; voffB[i] = (unsigned)(Rb * K + C) * 2u; }
    const size_t kstep = (size_t)(BK * 2);
    const size_t hstep = (size_t)HALF * K * 2;
    const size_t tstep = 2 * hstep;
    const unsigned ldsw = (unsigned)wid * 1024u;
    const int aoff = lds_byte(wr * 64 + fr, fq * 8), boff = lds_byte(wc * 32 + fr, fq * 8);
#define PG8_SA(b, h) (((b) * 2 + (h)) * HTB)
#define PG8_SB(b, h) ((4 + (b) * 2 + (h)) * HTB)
#define PG8_STAGE(bufoff, gbase, voff) do { _Pragma("unroll") for (int _i = 0; _i < 2; ++_i) \
        __builtin_amdgcn_global_load_lds((const unsigned*)((const char*)(gbase) + (voff)[_i]), (PG8_LAS unsigned*)(lds + (bufoff) + ldsw + _i * 8192), 16, 0, 0); } while (0)
#define PG8_LDA(dst, b, h) do { _Pragma("unroll") for (int m = 0; m < 4; ++m) _Pragma("unroll") for (int k = 0; k < 2; ++k) dst[m][k] = *(const PG8_LAS bf16x8*)(lds + PG8_SA(b, h) + aoff + m * 2048 + k * 1024); } while (0)
#define PG8_LDB(dst, b, h) do { _Pragma("unroll") for (int n = 0; n < 2; ++n) _Pragma("unroll") for (int k = 0; k < 2; ++k) dst[n][k] = *(const PG8_LAS bf16x8*)(lds + PG8_SB(b, h) + boff + n * 2048 + k * 1024); } while (0)
#define PG8_MMA(ai, bj, At, Bt) do { __builtin_amdgcn_s_setprio(1); _Pragma("unroll") for (int m = 0; m < 4; ++m) _Pragma("unroll") for (int n = 0; n < 2; ++n) _Pragma("unroll") for (int k = 0; k < 2; ++k) \
        acc[ai][bj][m][n] = __builtin_amdgcn_mfma_f32_16x16x32_bf16(Bt[n][k], At[m][k], acc[ai][bj][m][n], 0, 0, 0); __builtin_amdgcn_s_setprio(0); } while (0)
#define PG8_WAIT_V(n) asm volatile("s_waitcnt vmcnt(" #n ")" ::: "memory")
#define PG8_WAIT_L(n) asm volatile("s_waitcnt lgkmcnt(" #n ")" ::: "memory")
#define PG8_BAR __builtin_amdgcn_s_barrier()
#define PG8_SCHED __builtin_amdgcn_sched_barrier(0)
    Unit cur, nxt; int ui = 0;
    if (!S.next(0, cur)) return;
    f32x4 acc[2][2][4][2];
#pragma unroll
    for (int a = 0; a < 2; ++a)
#pragma unroll
        for (int b = 0; b < 2; ++b)
#pragma unroll
            for (int m = 0; m < 4; ++m)
#pragma unroll
                for (int n = 0; n < 2; ++n) acc[a][b][m][n] = (f32x4){0.f, 0.f, 0.f, 0.f};
    bf16x8 At[4][2], B0[2][2], B1[2][2];
    const char* cA = (const char*)g.A + (size_t)cur.pm * tstep; const char* cB = (const char*)g.Bt + (size_t)cur.pn * tstep;
    S.a_ready(cur);
    if constexpr (SP2) {
        PG8_STAGE(PG8_SB(0, 0), cB, voffB); PG8_STAGE(PG8_SB(0, 1), cB + hstep, voffB); PG8_STAGE(PG8_SA(0, 0), cA, voffA); PG8_STAGE(PG8_SA(0, 1), cA + hstep, voffA);
        if (wr == 1) PG8_BAR;
        PG8_WAIT_V(2); PG8_BAR;
        PG8_STAGE(PG8_SB(1, 0), cB + kstep, voffB); PG8_STAGE(PG8_SA(1, 0), cA + kstep, voffA); PG8_STAGE(PG8_SB(1, 1), cB + hstep + kstep, voffB);
        PG8_WAIT_V(6); PG8_BAR;
    } else {
        PG8_STAGE(PG8_SB(0, 0), cB, voffB); PG8_STAGE(PG8_SA(0, 0), cA, voffA); PG8_STAGE(PG8_SB(0, 1), cB + hstep, voffB); PG8_STAGE(PG8_SA(0, 1), cA + hstep, voffA);
        if (wr == 1) PG8_BAR;
        PG8_WAIT_V(4); PG8_BAR;
        PG8_STAGE(PG8_SB(1, 0), cB + kstep, voffB); PG8_STAGE(PG8_SA(1, 0), cA + kstep, voffA); PG8_STAGE(PG8_SB(1, 1), cB + hstep + kstep, voffB);
        PG8_WAIT_V(6); PG8_BAR;
    }
    for (;;) {
        const bool has_next = S.next(ui + 1, nxt);
        const char* nA = has_next ? (const char*)g.A + (size_t)nxt.pm * tstep : cA; const char* nB = has_next ? (const char*)g.Bt + (size_t)nxt.pn * tstep : cB;
        for (int t = 0; t < nt; t += 2) {
            const bool last = (t == nt - 2);
            const char* a1 = cA + (size_t)(t + 1) * kstep;
            const char* a2 = last ? nA : cA + (size_t)(t + 2) * kstep; const char* b2 = last ? nB : cB + (size_t)(t + 2) * kstep;
            const char* a3 = a2 + kstep; const char* b3 = b2 + kstep;
            if (last && has_next) S.a_ready(nxt);
            if constexpr (SP2) {
            PG8_LDB(B0, 0, 0); PG8_LDB(B1, 0, 1); PG8_SCHED; PG8_LDA(At, 0, 0); PG8_STAGE(PG8_SA(1, 1), a1 + hstep, voffA);
            PG8_WAIT_V(8); PG8_WAIT_L(0); PG8_BAR; PG8_MMA(0, 0, At, B0); PG8_MMA(0, 1, At, B1); PG8_BAR; PG8_SCHED;
            PG8_LDA(At, 0, 1); PG8_STAGE(PG8_SB(0, 0), b2, voffB); PG8_STAGE(PG8_SB(0, 1), b2 + hstep, voffB); PG8_STAGE(PG8_SA(0, 0), a2, voffA);
            PG8_WAIT_V(8); PG8_WAIT_L(0); PG8_BAR; PG8_MMA(1, 0, At, B0); PG8_MMA(1, 1, At, B1); PG8_BAR; PG8_SCHED;
            PG8_LDB(B0, 1, 0); PG8_LDB(B1, 1, 1); PG8_SCHED; PG8_LDA(At, 1, 0); PG8_STAGE(PG8_SA(0, 1), a2 + hstep, voffA);
            PG8_WAIT_V(8); PG8_WAIT_L(0); PG8_BAR; PG8_MMA(0, 0, At, B0); PG8_MMA(0, 1, At, B1); PG8_BAR; PG8_SCHED;
            PG8_LDA(At, 1, 1); PG8_STAGE(PG8_SB(1, 0), b3, voffB); PG8_STAGE(PG8_SB(1, 1), b3 + hstep, voffB); PG8_STAGE(PG8_SA(1, 0), a3, voffA);
            PG8_WAIT_V(8); PG8_WAIT_L(0); PG8_BAR; PG8_MMA(1, 0, At, B0); PG8_MMA(1, 1, At, B1); PG8_BAR; PG8_SCHED;
            } else {
            PG8_LDB(B0, 0, 0); PG8_SCHED; PG8_LDA(At, 0, 0); PG8_STAGE(PG8_SA(1, 1), a1 + hstep, voffA);
            PG8_WAIT_L(8); PG8_BAR; PG8_WAIT_L(0); PG8_MMA(0, 0, At, B0); PG8_BAR; PG8_SCHED;
            PG8_LDB(B1, 0, 1); PG8_STAGE(PG8_SB(0, 0), b2, voffB);
            PG8_BAR; PG8_WAIT_L(0); PG8_MMA(0, 1, At, B1); PG8_BAR;
            PG8_LDA(At, 0, 1); PG8_STAGE(PG8_SA(0, 0), a2, voffA);
            PG8_BAR; PG8_WAIT_L(0); PG8_MMA(1, 0, At, B0); PG8_BAR; PG8_SCHED;
            PG8_STAGE(PG8_SB(0, 1), b2 + hstep, voffB);
            PG8_WAIT_V(6); PG8_BAR; PG8_MMA(1, 1, At, B1); PG8_BAR;
            PG8_LDB(B0, 1, 0); PG8_SCHED; PG8_LDA(At, 1, 0); PG8_STAGE(PG8_SA(0, 1), a2 + hstep, voffA);
            PG8_WAIT_L(8); PG8_BAR; PG8_WAIT_L(0); PG8_MMA(0, 0, At, B0); PG8_BAR; PG8_SCHED;
            PG8_LDB(B1, 1, 1); PG8_STAGE(PG8_SB(1, 0), b3, voffB);
            PG8_BAR; PG8_WAIT_L(0); PG8_MMA(0, 1, At, B1); PG8_BAR;
            PG8_LDA(At, 1, 1); PG8_STAGE(PG8_SA(1, 0), a3, voffA);
            PG8_BAR; PG8_WAIT_L(0); PG8_MMA(1, 0, At, B0); PG8_BAR; PG8_SCHED;
            PG8_STAGE(PG8_SB(1, 1), b3 + hstep, voffB);
            PG8_WAIT_V(6); PG8_BAR; PG8_MMA(1, 1, At, B1); PG8_BAR;
            }
        }
        if constexpr (ALIGN_EPI) { if (wr == 0) PG8_BAR; }
        if constexpr (!Epi::AFTER_DRAIN) { E(acc, cur, wr, wc, fr, fq); S.done(cur); }
        if (!has_next) break;
#pragma unroll
        for (int a = 0; a < 2; ++a)
#pragma unroll
            for (int b = 0; b < 2; ++b)
#pragma unroll
                for (int m = 0; m < 4; ++m)
#pragma unroll
                    for (int n = 0; n < 2; ++n) acc[a][b][m][n] = (f32x4){0.f, 0.f, 0.f, 0.f};
        cur = nxt; cA = nA; cB = nB; ++ui;
        if constexpr (ALIGN_EPI) { if (wr == 1) PG8_BAR; }
    }
    PG8_WAIT_V(0);
    if constexpr (!ALIGN_EPI) { if (wr == 0) PG8_BAR; }
    PG8_BAR;
    if constexpr (Epi::AFTER_DRAIN) { E.fused(acc, cur, wr, wc, fr, fq, lds, wid, lane); S.done(cur); }
#undef PG8_SA
#undef PG8_SB
#undef PG8_STAGE
#undef PG8_LDA
#undef PG8_LDB
#undef PG8_MMA
#undef PG8_WAIT_V
#undef PG8_WAIT_L
#undef PG8_BAR
#undef PG8_SCHED
}
}

constexpr size_t MiB = 1u << 20;
constexpr size_t WS_CTL = 0;
constexpr size_t WS_W_IN0 = 1 * MiB, WS_W_OUT0 = 9 * MiB, WS_W_UP0 = 11 * MiB, WS_W_DN0 = 19 * MiB;
constexpr size_t WS_W_IN1 = 27 * MiB, WS_W_OUT1 = 31 * MiB, WS_W_UP1 = 33 * MiB, WS_W_DN1 = 41 * MiB;
constexpr size_t WS_W_C1K = 49 * MiB, WS_W_C1V = 50 * MiB, WS_W_C2K = 51 * MiB, WS_W_C2V = 51 * MiB + 65536;
constexpr size_t WS_XN = 56 * MiB;
constexpr size_t WS_BIG = 120 * MiB;
constexpr size_t WS_R2 = 376 * MiB;
constexpr size_t WS_END = 440 * MiB;
constexpr int NWAVES = 8, NTHREADS = 512;
constexpr int LDS_BYTES = 147456;
constexpr int XB_LDS_OFF = LDS_BYTES - 64;
constexpr int CW_BAR = 4096;

struct Args {
    const float* in[33]; float* out; unsigned char* ws; int ph_lo, ph_hi;
};
struct Frame {
    LAS unsigned char* lds;
    int tid, lane, wave, G, bid;
    unsigned char* ws;
    unsigned* ctl;
};
__device__ __forceinline__ Frame fresh(const Frame& F) { Frame G = F; int t = threadIdx.x; asm volatile("" : "+v"(t)); G.tid = t; G.lane = t & 63; G.wave = __builtin_amdgcn_readfirstlane(t >> 6); return G; }
enum { IN_X = 0, IN_POS, IN_NMPRE, IN_NMPOST, IN_NFPRE, IN_NFPOST, IN_WUP, IN_WDN, IN_ABIN, IN_ABOUT, IN_GCONV, IN_GALOG, IN_GDT, IN_GNORM,
       IN_RMU, IN_RW0, IN_RW2, IN_RA0, IN_RA2, IN_RG2, IN_RKK, IN_RKA, IN_RRK, IN_RLNW, IN_RLNB, IN_NWIN, IN_NWOUT, IN_NPEK, IN_NW1K, IN_NW2K, IN_NPEV, IN_NW1V, IN_NW2V };

template <bool LIGHT = false> __device__ __forceinline__ void transpose_item(const float* W, int K, int Nsrc, int src_col0, int cnt, bf16_t* WT, int dst_row0, LAS float* scr, int item, int lane) {
    const int nblk = (cnt + 31) / 32, kb = item / nblk, nb = item % nblk, k0 = 64 * kb, n0 = 32 * nb;
    const int nl = lane & 31; const bool okn = (n0 + nl) < cnt;
    const float* wp = W + (size_t)(k0 + (lane >> 5)) * Nsrc + src_col0 + n0 + nl;
    if constexpr (LIGHT) {
#pragma unroll 8
        for (int i = 0; i < 32; ++i) scr[(2 * i + (lane >> 5)) * 33 + nl] = okn ? wp[(size_t)(2 * i) * Nsrc] : 0.f;
    } else {
        float wv[32];
#pragma unroll
        for (int i = 0; i < 32; ++i) wv[i] = okn ? wp[(size_t)(2 * i) * Nsrc] : 0.f;
#pragma unroll
        for (int i = 0; i < 32; ++i) scr[(2 * i + (lane >> 5)) * 33 + nl] = wv[i];
    }
    asm volatile("s_waitcnt lgkmcnt(0)" ::: "memory");
    const int c = lane & 7;
#pragma unroll
    for (int j = 0; j < 4; ++j) { const int n = (lane >> 3) + 8 * j; const LAS float* s = scr + (8 * c) * 33 + n;
        u32x4 o; o.x = pk2(s[0 * 33], s[1 * 33]); o.y = pk2(s[2 * 33], s[3 * 33]); o.z = pk2(s[4 * 33], s[5 * 33]); o.w = pk2(s[6 * 33], s[7 * 33]);
        if (n0 + n < cnt) *(u32x4*)(WT + (size_t)(dst_row0 + n0 + n) * K + k0 + 8 * c) = o; }
    asm volatile("s_waitcnt lgkmcnt(0)" ::: "memory");
}
template <bool LIGHT = false> __device__ __forceinline__ void transpose_seg(const Frame& F, const float* W, int K, int Nsrc, int src_col0, int cnt, bf16_t* WT, int dst_row0, int bid0 = 0, int nb = 0) {
    LAS float* scr = (LAS float*)(F.lds + F.wave * 16384);
    const int gw = (F.bid - bid0) * NWAVES + F.wave, NGW = (nb ? nb : F.G) * NWAVES;
    const int nitems = (K / 64) * ((cnt + 31) / 32);
    for (int it = gw; it < nitems; it += NGW) transpose_item<LIGHT>(W, K, Nsrc, src_col0, cnt, WT, dst_row0, scr, it, F.lane);
}
__device__ __forceinline__ void zero_rows(const Frame& F, bf16_t* WT, int K, int row0, int nrows, int bid0 = 0, int nb = 0) {
    const int gw = (F.bid - bid0) * NWAVES + F.wave, NGW = (nb ? nb : F.G) * NWAVES;
    for (int r = gw; r < nrows; r += NGW) { u32x4* p = (u32x4*)(WT + (size_t)(row0 + r) * K); for (int j = F.lane; j < K / 8; j += 64) p[j] = (u32x4){0u, 0u, 0u, 0u}; }
}
__device__ __forceinline__ void rms_row_to_bf16(const float* xrow, const float* w, bf16_t* orow, int lane) {
    const f32x4* xr = (const f32x4*)xrow + lane; const f32x4* wr = (const f32x4*)w + lane;
    f32x4 v[4]; float s = 0.f;
#pragma unroll
    for (int j = 0; j < 4; ++j) { v[j] = xr[64 * j]; s += (v[j].x * v[j].x + v[j].y * v[j].y) + (v[j].z * v[j].z + v[j].w * v[j].w); }
    const float rstd = 1.f / sqrtf(wave_sum(s) * (1.f / D_MODEL) + NORM_EPS);
    unsigned long long* o8 = (unsigned long long*)orow + lane;
#pragma unroll
    for (int j = 0; j < 4; ++j) { const f32x4 g = wr[64 * j];
        o8[64 * j] = (unsigned long long)pk2(v[j].x * rstd * g.x, v[j].y * rstd * g.y) | ((unsigned long long)pk2(v[j].z * rstd * g.z, v[j].w * rstd * g.w) << 32); }
}
__device__ __forceinline__ void p0_prologue(const Frame& F, const Args& a) {
    unsigned char* ws = F.ws;
    const float* abin = a.in[IN_ABIN];
    transpose_seg(F, abin, 1024, AB_IN_W, 0, 2048, (bf16_t*)(ws + WS_W_IN0), 0);
    transpose_seg(F, abin, 1024, AB_IN_W, 2056, 1792, (bf16_t*)(ws + WS_W_IN0), 2048);
    transpose_seg(F, abin, 1024, AB_IN_W, 2048, 8, (bf16_t*)(ws + WS_W_IN0), 3840);
    zero_rows(F, (bf16_t*)(ws + WS_W_IN0), 1024, 3848, 4096 - 3848);
    transpose_seg(F, a.in[IN_ABOUT], 1024, 1024, 0, 1024, (bf16_t*)(ws + WS_W_OUT0), 0);
    transpose_seg(F, a.in[IN_WUP], 1024, 4096, 0, 4096, (bf16_t*)(ws + WS_W_UP0), 0);
    transpose_seg(F, a.in[IN_WDN], 4096, 1024, 0, 1024, (bf16_t*)(ws + WS_W_DN0), 0);
    const int gw = F.bid * NWAVES + F.wave, NGW = F.G * NWAVES;
    const float* x = a.in[IN_X]; bf16_t* XN = (bf16_t*)(ws + WS_XN);
    for (int m = gw; m < MTOK; m += 2 * NGW) {
        const int m2 = m + NGW;
        const f32x4* xr0 = (const f32x4*)(x + (size_t)m * D_MODEL) + F.lane; const f32x4* xr1 = (const f32x4*)(x + (size_t)(m2 < MTOK ? m2 : m) * D_MODEL) + F.lane; const f32x4* wr = (const f32x4*)a.in[IN_NMPRE] + F.lane;
        f32x4 v0[4], v1[4]; float s0 = 0.f, s1 = 0.f;
#pragma unroll
        for (int j = 0; j < 4; ++j) { v0[j] = xr0[64 * j]; v1[j] = xr1[64 * j]; }
#pragma unroll
        for (int j = 0; j < 4; ++j) { s0 += (v0[j].x * v0[j].x + v0[j].y * v0[j].y) + (v0[j].z * v0[j].z + v0[j].w * v0[j].w); s1 += (v1[j].x * v1[j].x + v1[j].y * v1[j].y) + (v1[j].z * v1[j].z + v1[j].w * v1[j].w); }
        const float r0 = 1.f / sqrtf(wave_sum(s0) * (1.f / D_MODEL) + NORM_EPS), r1 = 1.f / sqrtf(wave_sum(s1) * (1.f / D_MODEL) + NORM_EPS);
        unsigned long long* o0 = (unsigned long long*)(XN + (size_t)m * D_MODEL) + F.lane; unsigned long long* o1 = (unsigned long long*)(XN + (size_t)m2 * D_MODEL) + F.lane;
#pragma unroll
        for (int j = 0; j < 4; ++j) { const f32x4 g = wr[64 * j];
            o0[64 * j] = (unsigned long long)pk2(v0[j].x * r0 * g.x, v0[j].y * r0 * g.y) | ((unsigned long long)pk2(v0[j].z * r0 * g.z, v0[j].w * r0 * g.w) << 32);
            if (m2 < MTOK) o1[64 * j] = (unsigned long long)pk2(v1[j].x * r1 * g.x, v1[j].y * r1 * g.y) | ((unsigned long long)pk2(v1[j].z * r1 * g.z, v1[j].w * r1 * g.w) << 32); }
    }
}

__device__ __forceinline__ void p0_layer1_weights(const Frame& F, const Args& a, int bid0, int nb, int part) {
    unsigned char* ws = F.ws;
    if (part < 0 || part == 0) {
        transpose_seg<true>(F, a.in[IN_NWIN], 1024, NSA_IN_W, 0, NSA_IN_W, (bf16_t*)(ws + WS_W_IN1), 0, bid0, nb);
        zero_rows(F, (bf16_t*)(ws + WS_W_IN1), 1024, NSA_IN_W, 2048 - NSA_IN_W, bid0, nb);
        transpose_seg<true>(F, a.in[IN_NWOUT], 1024, 1024, 0, 1024, (bf16_t*)(ws + WS_W_OUT1), 0, bid0, nb); }
    if (part < 0 || part == 1) transpose_seg<true>(F, a.in[IN_WUP] + (size_t)1024 * 4096, 1024, 4096, 0, 4096, (bf16_t*)(ws + WS_W_UP1), 0, bid0, nb);
    if (part < 0 || part == 2) transpose_seg<true>(F, a.in[IN_WDN] + (size_t)1024 * 4096, 4096, 1024, 0, 1024, (bf16_t*)(ws + WS_W_DN1), 0, bid0, nb);
    if (part < 0 || part == 3) {
        transpose_seg<true>(F, a.in[IN_NW1K], 2048, 256, 0, 256, (bf16_t*)(ws + WS_W_C1K), 0, bid0, nb);
        transpose_seg<true>(F, a.in[IN_NW1V], 2048, 256, 0, 256, (bf16_t*)(ws + WS_W_C1V), 0, bid0, nb);
        transpose_seg<true>(F, a.in[IN_NW2K], 256, 64, 0, 64, (bf16_t*)(ws + WS_W_C2K), 0, bid0, nb);
        transpose_seg<true>(F, a.in[IN_NW2V], 256, 64, 0, 64, (bf16_t*)(ws + WS_W_C2V), 0, bid0, nb); }
}

#define XB_TMO      128
#define XB_XCNT(j)  (256  + 64 * (j))
#define XB_XSUB(j)  (1280 + 64 * (j))
#define XB_XGEN(j)  (2304 + 64 * (j))
#define XB_TOP      3328
#define XB_TOPGEN   3392
#define XCD_BAR_WORDS 3456
#define XB_SPIN_CAP (1u << 18)

__device__ __forceinline__ unsigned xb_ld(unsigned* p)              { return __hip_atomic_load(p, __ATOMIC_RELAXED, __HIP_MEMORY_SCOPE_AGENT); }
__device__ __forceinline__ unsigned xb_add(unsigned* p, unsigned v) { return __hip_atomic_fetch_add(p, v, __ATOMIC_RELAXED, __HIP_MEMORY_SCOPE_AGENT); }
__device__ __forceinline__ unsigned xb_xcc_id() { return (unsigned)__builtin_amdgcn_s_getreg((3 << 11) | 20) & 0xFu; }
#define XB_SPIN(cond, bar) do { unsigned _sp = 0; while (cond) { __builtin_amdgcn_s_sleep(1); \
    if ((++_sp & 255u) == 0u) { if (xb_ld(&(bar)[XB_TMO])) break; if (_sp > XB_SPIN_CAP) { atomicAdd(&(bar)[XB_TMO], 1u); break; } } } } while (0)

struct XcdBarrier {
    unsigned* bar; unsigned x;
    volatile LAS unsigned* st;
};

__device__ __forceinline__ XcdBarrier xcd_barrier_post(unsigned* bar, volatile LAS unsigned* st) {
    XcdBarrier b; b.bar = bar; b.x = xb_xcc_id(); b.st = st;
    if (threadIdx.x == 0) (void)xb_add(&bar[XB_XCNT(b.x)], 1u);
    return b;
}
__device__ __forceinline__ void xcd_barrier_complete(unsigned* bar, unsigned x, unsigned& nloc, unsigned& nx) {
    const unsigned G = gridDim.x * gridDim.y * gridDim.z;
    unsigned sum, cnt, mine, sp = 0u;
    for (;;) {
        sum = 0u; cnt = 0u; mine = 0u;
#pragma unroll
        for (unsigned j = 0; j < 16; ++j) { const unsigned c = xb_ld(&bar[XB_XCNT(j)]); sum += c; cnt += (c > 0u) ? 1u : 0u; mine = (j == x) ? c : mine; }
        if (sum == G) break;
        __builtin_amdgcn_s_sleep(1);
        if ((++sp & 255u) == 0u) { if (xb_ld(&bar[XB_TMO])) break; if (sp > XB_SPIN_CAP) { atomicAdd(&bar[XB_TMO], 1u); break; } }
    }
    nloc = mine > 0u ? mine : 1u; nx = cnt > 0u ? cnt : 1u;
}

__device__ __forceinline__ void xcd_barrier(const XcdBarrier& b) {
    asm volatile("s_waitcnt vmcnt(0)" ::: "memory");
    __syncthreads();
    if (threadIdx.x == 0) {
        unsigned* bar = b.bar; const unsigned bx = xb_xcc_id();
        __builtin_amdgcn_s_waitcnt(0);
        unsigned nloc = b.st[0], nx = b.st[1];
        if (nloc == 0u) { xcd_barrier_complete(bar, bx, nloc, nx); b.st[0] = nloc; b.st[1] = nx; }
        const unsigned old = xb_add(&bar[XB_XSUB(bx)], 1u);
        const unsigned gen = old / nloc;
        if (old + 1u == (gen + 1u) * nloc) {
            __builtin_amdgcn_fence(__ATOMIC_RELEASE, "agent");
            asm volatile("s_waitcnt vmcnt(0)" ::: "memory");
            const unsigned og = xb_add(&bar[XB_TOP], 1u);
            const unsigned tg = og / nx;
            if (og + 1u == (tg + 1u) * nx) xb_add(&bar[XB_TOPGEN], 1u);
            else XB_SPIN(xb_ld(&bar[XB_TOPGEN]) == tg, bar);
            __builtin_amdgcn_fence(__ATOMIC_ACQUIRE, "agent");
            xb_add(&bar[XB_XGEN(bx)], 1u);
            asm volatile("s_waitcnt vmcnt(0)" ::: "memory");
        } else {
            XB_SPIN(xb_ld(&bar[XB_XGEN(bx)]) == gen, bar);
            __builtin_amdgcn_fence(__ATOMIC_ACQUIRE, "agent");
            asm volatile("s_waitcnt vmcnt(0)" ::: "memory");
        }
    }
    __syncthreads();
}
constexpr size_t GDN_UNIT_ELEMS = 8192;
constexpr size_t WS_INTRA = WS_R2, WS_GLAST = WS_R2 + 16 * MiB;
constexpr int GP_ROWB = 272;
constexpr int GP_QB = 0, GP_KB = 17408, GP_VB = 34816, GP_AM = 52224, GP_SC = 68608, GP_HALF = 69632;
#define MFMA16(a, b, c) __builtin_amdgcn_mfma_f32_16x16x32_bf16((a), (b), (c), 0, 0, 0)

__device__ __forceinline__ void gdn_prep_phase(const Frame& F, const Args& a) {
    const bf16_t* F0 = (const bf16_t*)(F.ws + WS_BIG);
    bf16_t* Ut = (bf16_t*)a.out; bf16_t* Wm = Ut + (size_t)2048 * GDN_UNIT_ELEMS; bf16_t* QG = Wm + (size_t)2048 * GDN_UNIT_ELEMS; bf16_t* KGt = QG + (size_t)2048 * GDN_UNIT_ELEMS;
    bf16_t* INTRA = (bf16_t*)(F.ws + WS_INTRA); float* GLAST = (float*)(F.ws + WS_GLAST);
    const float* convw = a.in[IN_GCONV];
    const int hb = F.wave >> 2, wq = F.wave & 3, lane = F.lane, fr = lane & 15, fq = lane >> 4;
    LAS unsigned char* L = F.lds + hb * GP_HALF;
    LAS float* betaL = (LAS float*)(L + GP_SC); LAS float* gcL = betaL + 64;
    LAS float* Am = (LAS float*)(L + GP_AM);
    const int nhalf = F.G * 2, hid = F.bid * 2 + hb;
    for (int u = hid; u < 2048; u += nhalf) {
        const int n = u & 63, h = (u >> 6) & 3, b = u >> 8;
        const size_t m0 = (size_t)b * SEQ + (size_t)n * 64;
        if (wq == 0) {
            const size_t m = m0 + lane;
            const float bb = bf2f(F0[m * F0_LD + F0_BA + h]), aa = bf2f(F0[m * F0_LD + F0_BA + 4 + h]);
            const float beta = sigmoidf_(bb);
            float g = -__expf(a.in[IN_GALOG][h]) * softplusf_(aa + a.in[IN_GDT][h]);
#pragma unroll
            for (int o = 1; o < 64; o <<= 1) { const float t = __shfl_up(g, o); if (lane >= o) g += t; }
            betaL[lane] = beta; gcL[lane] = g;
            if (lane == 63) GLAST[u] = __expf(g);
        }
        __syncthreads();
#pragma unroll 2
        for (int it = 0; it < 4; ++it) {
            const int tl = 16 * wq + 4 * it + fq;
            const int tseq = n * 64 + tl;
            const size_t m = m0 + tl;
            float res[3][8];
#pragma unroll
            for (int X = 0; X < 3; ++X) {
                const int col = X * 512 + h * 128 + 8 * fr;
                float acc[8];
#pragma unroll
                for (int e = 0; e < 8; ++e) acc[e] = 0.f;
#pragma unroll
                for (int i = 0; i < 4; ++i) {
                    u32x4 xv = (u32x4){0u, 0u, 0u, 0u};
                    if (tseq - 3 + i >= 0) xv = *(const u32x4*)(F0 + (m - 3 + i) * F0_LD + col);
                    const f32x4 w0 = *(const f32x4*)(convw + i * 1536 + col), w1 = *(const f32x4*)(convw + i * 1536 + col + 4);
                    acc[0] += w0[0] * bflo(xv.x); acc[1] += w0[1] * bfhi(xv.x); acc[2] += w0[2] * bflo(xv.y); acc[3] += w0[3] * bfhi(xv.y);
                    acc[4] += w1[0] * bflo(xv.z); acc[5] += w1[1] * bfhi(xv.z); acc[6] += w1[2] * bflo(xv.w); acc[7] += w1[3] * bfhi(xv.w);
                }
#pragma unroll
                for (int e = 0; e < 8; ++e) res[X][e] = siluf_(acc[e]);
            }
            float sq = 0.f, sk = 0.f;
#pragma unroll
            for (int e = 0; e < 8; ++e) { sq += res[0][e] * res[0][e]; sk += res[1][e] * res[1][e]; }
#pragma unroll
            for (int o = 1; o < 16; o <<= 1) { sq += __shfl_xor(sq, o); sk += __shfl_xor(sk, o); }
            const float rq = rsqrtf(sq + 1e-6f) * 0.08838834764831845f, rk = rsqrtf(sk + 1e-6f);
            const float eg = __expf(gcL[tl]);
            u32x4 qv, kv, vv, qg;
            qv.x = pk2(res[0][0] * rq, res[0][1] * rq); qv.y = pk2(res[0][2] * rq, res[0][3] * rq); qv.z = pk2(res[0][4] * rq, res[0][5] * rq); qv.w = pk2(res[0][6] * rq, res[0][7] * rq);
            kv.x = pk2(res[1][0] * rk, res[1][1] * rk); kv.y = pk2(res[1][2] * rk, res[1][3] * rk); kv.z = pk2(res[1][4] * rk, res[1][5] * rk); kv.w = pk2(res[1][6] * rk, res[1][7] * rk);
            vv.x = pk2(res[2][0], res[2][1]); vv.y = pk2(res[2][2], res[2][3]); vv.z = pk2(res[2][4], res[2][5]); vv.w = pk2(res[2][6], res[2][7]);
            const float rqg = rq * eg;
            qg.x = pk2(res[0][0] * rqg, res[0][1] * rqg); qg.y = pk2(res[0][2] * rqg, res[0][3] * rqg); qg.z = pk2(res[0][4] * rqg, res[0][5] * rqg); qg.w = pk2(res[0][6] * rqg, res[0][7] * rqg);
            *(LAS u32x4*)(L + GP_QB + tl * GP_ROWB + fr * 16) = qv;
            *(LAS u32x4*)(L + GP_KB + tl * GP_ROWB + fr * 16) = kv;
            *(LAS u32x4*)(L + GP_VB + tl * GP_ROWB + fr * 16) = vv;
            *(u32x4*)(QG + (size_t)u * GDN_UNIT_ELEMS + tl * 128 + fr * 8) = qg;
        }
        __syncthreads();
        {
            bf16x8 ka[4], qa[4];
#pragma unroll
            for (int ks = 0; ks < 4; ++ks) { ka[ks] = *(const LAS bf16x8*)(L + GP_KB + (16 * wq + fr) * GP_ROWB + (32 * ks + 8 * fq) * 2);
                                             qa[ks] = *(const LAS bf16x8*)(L + GP_QB + (16 * wq + fr) * GP_ROWB + (32 * ks + 8 * fq) * 2); }
            bf16_t* intra_u = INTRA + (size_t)u * 4096;
#pragma unroll
            for (int nt = 0; nt < 4; ++nt) {
                if (nt <= wq) {
                    f32x4 ckk = (f32x4){0.f, 0.f, 0.f, 0.f}, cqk = (f32x4){0.f, 0.f, 0.f, 0.f};
#pragma unroll
                    for (int ks = 0; ks < 4; ++ks) { const bf16x8 kb = *(const LAS bf16x8*)(L + GP_KB + (16 * nt + fr) * GP_ROWB + (32 * ks + 8 * fq) * 2);
                        ckk = MFMA16(ka[ks], kb, ckk); cqk = MFMA16(qa[ks], kb, cqk); }
                    const int j = 16 * nt + fr; const float gj = gcL[j];
#pragma unroll
                    for (int r = 0; r < 4; ++r) { const int i = 16 * wq + 4 * fq + r; const float d = __expf(gcL[i] - gj);
                        Am[i * 64 + j] = (i > j) ? betaL[i] * ckk[r] * d : 0.f;
                        intra_u[i * 64 + j] = (bf16_t)f2bf((i >= j) ? cqk[r] * d : 0.f); }
                } else {
#pragma unroll
                    for (int r = 0; r < 4; ++r) intra_u[(16 * wq + 4 * fq + r) * 64 + 16 * nt + fr] = 0;
                }
            }
        }
        __syncthreads();
        {
            const bool isk = wq >= 2; const int ch = (wq & 1) * 64 + lane;
            LAS unsigned char* X = L + (isk ? GP_KB : GP_VB);
            float sol[64];
#pragma unroll
            for (int t = 0; t < 64; ++t) sol[t] = bf2f(*(const LAS bf16_t*)(X + t * GP_ROWB + ch * 2));
            if (isk) {
                const float gl = gcL[63];
                u32x4* dst = (u32x4*)(KGt + (size_t)u * GDN_UNIT_ELEMS + ch * 64);
#pragma unroll
                for (int q8 = 0; q8 < 8; ++q8) { u32x4 o;
                    o.x = pk2(sol[8 * q8 + 0] * __expf(gl - gcL[8 * q8 + 0]), sol[8 * q8 + 1] * __expf(gl - gcL[8 * q8 + 1]));
                    o.y = pk2(sol[8 * q8 + 2] * __expf(gl - gcL[8 * q8 + 2]), sol[8 * q8 + 3] * __expf(gl - gcL[8 * q8 + 3]));
                    o.z = pk2(sol[8 * q8 + 4] * __expf(gl - gcL[8 * q8 + 4]), sol[8 * q8 + 5] * __expf(gl - gcL[8 * q8 + 5]));
                    o.w = pk2(sol[8 * q8 + 6] * __expf(gl - gcL[8 * q8 + 6]), sol[8 * q8 + 7] * __expf(gl - gcL[8 * q8 + 7]));
                    dst[q8] = o; }
#pragma unroll
                for (int t = 0; t < 64; ++t) sol[t] *= betaL[t] * __expf(gcL[t]);
            } else {
#pragma unroll
                for (int t = 0; t < 64; ++t) sol[t] *= betaL[t];
            }
#pragma unroll
            for (int i = 1; i < 64; ++i) {
                float s = sol[i];
#pragma unroll
                for (int j = 0; j < i; ++j) s -= Am[i * 64 + j] * sol[j];
                sol[i] = s;
            }
            if (isk) { bf16_t* dst = Wm + (size_t)u * GDN_UNIT_ELEMS + ch;
#pragma unroll
                for (int t = 0; t < 64; ++t) dst[t * 128] = (bf16_t)f2bf(sol[t]);
            } else { u32x4* dst = (u32x4*)(Ut + (size_t)u * GDN_UNIT_ELEMS + ch * 64);
#pragma unroll
                for (int q8 = 0; q8 < 8; ++q8) { u32x4 o; o.x = pk2(sol[8 * q8], sol[8 * q8 + 1]); o.y = pk2(sol[8 * q8 + 2], sol[8 * q8 + 3]); o.z = pk2(sol[8 * q8 + 4], sol[8 * q8 + 5]); o.w = pk2(sol[8 * q8 + 6], sol[8 * q8 + 7]); dst[q8] = o; }
            }
        }
        __syncthreads();
    }
}

constexpr int GS_W = 0, GS_Q = 17408, GS_I = 34816, GS_K = 44032, GS_U = 62464, GS_Z = 80896;
constexpr int GS_SSQ = GS_Z + 17408;
static_assert(GS_SSQ + 4096 <= XB_LDS_OFF, "gdn scan lds");
__device__ __forceinline__ float red16_dpp(float v) {
    v += dpp_f(v, 0); v += dpp_f(v, 1); v += dpp_f(v, 2);
    const int i = __builtin_bit_cast(int, v); v += __builtin_bit_cast(float, __builtin_amdgcn_update_dpp(i, i, 0x140, 0xF, 0xF, false));
    return v;
}
constexpr size_t WS_GSTATE = WS_R2 + 18 * MiB;
__device__ __forceinline__ bf16x8 lds_aperm(const LAS unsigned char* rowp, int k0, int fq) {
    const u32x2 a = *(const LAS u32x2*)(rowp + (k0 + 4 * fq) * 2), b = *(const LAS u32x2*)(rowp + (k0 + 16 + 4 * fq) * 2);
    u32x4 v; v.x = a.x; v.y = a.y; v.z = b.x; v.w = b.y; return __builtin_bit_cast(bf16x8, v);
}
__device__ __forceinline__ bf16x8 acc_bperm(const f32x4& lo, const f32x4& hi) {
    u32x4 v; v.x = pk2(lo[0], lo[1]); v.y = pk2(lo[2], lo[3]); v.z = pk2(hi[0], hi[1]); v.w = pk2(hi[2], hi[3]); return __builtin_bit_cast(bf16x8, v);
}
__device__ __forceinline__ void gdn_scan_unit(const Frame& F, const Args& a, int bh, int n0, int n1, bool dry = false) {
    const bf16_t* F0 = (const bf16_t*)(F.ws + WS_BIG);
    const bf16_t* Ut = (const bf16_t*)a.out; const bf16_t* Wm = Ut + (size_t)2048 * GDN_UNIT_ELEMS; const bf16_t* QG = Wm + (size_t)2048 * GDN_UNIT_ELEMS; const bf16_t* KGt = QG + (size_t)2048 * GDN_UNIT_ELEMS;
    const bf16_t* INTRA = (const bf16_t*)(F.ws + WS_INTRA); const float* GLAST = (const float*)(F.ws + WS_GLAST);
    bf16_t* OAB = (bf16_t*)(F.ws + WS_XN);
    const int w = F.wave, lane = F.lane, fr = lane & 15, fq = lane >> 4;
    const int h = bh & 3, b = bh >> 2;
    LAS unsigned char* L = F.lds;
    LAS float* ssq = (LAS float*)(L + GS_SSQ);
    LAS float* glp = ssq + 1000;
#define GS_BAR() do { asm volatile("s_waitcnt lgkmcnt(0)" ::: "memory"); __builtin_amdgcn_s_barrier(); asm volatile("" ::: "memory"); } while (0)
    if (w >= 4) {
        const int lt = F.tid - 256;
        struct GsSet { u32x4 pw[4], pq[4], pz[4], pk[4], pu[4], pi[2]; float pgl; };
        GsSet A, B;
#define GS_FETCH(P_, n_) do { const size_t u_ = (size_t)bh * 64 + (n_); \
            _Pragma("unroll") for (int i_ = 0; i_ < 4; ++i_) { const int e_ = lt + 256 * i_; P_.pw[i_] = *(const u32x4*)(Wm + u_ * GDN_UNIT_ELEMS + (size_t)e_ * 8); P_.pq[i_] = *(const u32x4*)(QG + u_ * GDN_UNIT_ELEMS + (size_t)e_ * 8); \
                P_.pk[i_] = *(const u32x4*)(KGt + u_ * GDN_UNIT_ELEMS + (size_t)e_ * 8); P_.pu[i_] = *(const u32x4*)(Ut + u_ * GDN_UNIT_ELEMS + (size_t)e_ * 8); \
                P_.pz[i_] = *(const u32x4*)(F0 + ((size_t)b * SEQ + (size_t)(n_) * 64 + (e_ >> 4)) * F0_LD + 1536 + h * 128 + (e_ & 15) * 8); } \
            _Pragma("unroll") for (int i_ = 0; i_ < 2; ++i_) P_.pi[i_] = *(const u32x4*)(INTRA + u_ * 4096 + (size_t)(lt + 256 * i_) * 8); \
            P_.pgl = GLAST[u_]; } while (0)
#define GS_STORE(P_, n_) do { \
            _Pragma("unroll") for (int i_ = 0; i_ < 4; ++i_) { const int e_ = lt + 256 * i_; \
                *(LAS u32x4*)(L + GS_W + (e_ >> 4) * 272 + (e_ & 15) * 16) = P_.pw[i_]; *(LAS u32x4*)(L + GS_Q + (e_ >> 4) * 272 + (e_ & 15) * 16) = P_.pq[i_]; *(LAS u32x4*)(L + GS_Z + (e_ >> 4) * 272 + (e_ & 15) * 16) = P_.pz[i_]; \
                *(LAS u32x4*)(L + GS_K + (e_ >> 3) * 144 + (e_ & 7) * 16) = P_.pk[i_]; *(LAS u32x4*)(L + GS_U + (e_ >> 3) * 144 + (e_ & 7) * 16) = P_.pu[i_]; } \
            _Pragma("unroll") for (int i_ = 0; i_ < 2; ++i_) { const int e_ = lt + 256 * i_; *(LAS u32x4*)(L + GS_I + (e_ >> 3) * 144 + (e_ & 7) * 16) = P_.pi[i_]; } \
            if (lt == 0) glp[(n_) & 1] = P_.pgl; } while (0)
        GS_FETCH(A, n0);
        if (n0 + 1 < n1) GS_FETCH(B, n0 + 1);
        __syncthreads();
        GS_STORE(A, n0);
        GS_BAR();
#pragma unroll 1
        for (int n = n0; n < n1; n += 2) {
            if (n + 2 < n1) GS_FETCH(A, n + 2);
            GS_BAR();
            if (n + 1 < n1) GS_STORE(B, n + 1);
            GS_BAR();
            if (n + 3 < n1) GS_FETCH(B, n + 3);
            GS_BAR();
            if (n + 2 < n1) GS_STORE(A, n + 2);
            GS_BAR();
        }
#undef GS_FETCH
#undef GS_STORE
    } else {
        f32x4 S[2][8]; f32x4* GST = (f32x4*)(F.ws + WS_GSTATE) + ((size_t)bh * 8 + 2 * w) * 512;
#pragma unroll
        for (int nt = 0; nt < 2; ++nt)
#pragma unroll
            for (int d = 0; d < 8; ++d) S[nt][d] = (n0 == 0) ? (f32x4){0.f, 0.f, 0.f, 0.f} : GST[nt * 512 + d * 64 + lane];
        float gnw[2]; gnw[0] = a.in[IN_GNORM][32 * w + fr]; gnw[1] = a.in[IN_GNORM][32 * w + 16 + fr];
        __syncthreads();
        GS_BAR();
#pragma unroll 1
        for (int n = n0; n < n1; ++n) {
            const float gl = glp[n & 1];
            bf16x8 Sb[2][4];
#pragma unroll
            for (int nt = 0; nt < 2; ++nt)
#pragma unroll
                for (int ks = 0; ks < 4; ++ks) Sb[nt][ks] = acc_bperm(S[nt][2 * ks], S[nt][2 * ks + 1]);
            f32x4 vn[2][4], o[2][4];
#pragma unroll
            for (int mt = 0; mt < 4; ++mt) { f32x4 p0 = (f32x4){0.f, 0.f, 0.f, 0.f}, p1 = p0, q0 = p0, q1 = p0;
                const LAS unsigned char* wrow = L + GS_W + (16 * mt + fr) * 272; const LAS unsigned char* qrow = L + GS_Q + (16 * mt + fr) * 272;
#pragma unroll
                for (int ks = 0; ks < 4; ++ks) { const bf16x8 wa = lds_aperm(wrow, 32 * ks, fq), qa = lds_aperm(qrow, 32 * ks, fq);
                    p0 = MFMA16(wa, Sb[0][ks], p0); p1 = MFMA16(wa, Sb[1][ks], p1); q0 = MFMA16(qa, Sb[0][ks], q0); q1 = MFMA16(qa, Sb[1][ks], q1); }
                const u32x2 u0 = *(const LAS u32x2*)(L + GS_U + (32 * w + fr) * 144 + (16 * mt + 4 * fq) * 2), u1 = *(const LAS u32x2*)(L + GS_U + (32 * w + 16 + fr) * 144 + (16 * mt + 4 * fq) * 2);
                vn[0][mt] = (f32x4){bflo(u0.x) - p0[0], bfhi(u0.x) - p0[1], bflo(u0.y) - p0[2], bfhi(u0.y) - p0[3]};
                vn[1][mt] = (f32x4){bflo(u1.x) - p1[0], bfhi(u1.x) - p1[1], bflo(u1.y) - p1[2], bfhi(u1.y) - p1[3]};
                o[0][mt] = q0; o[1][mt] = q1; }
            bf16x8 Vb[2][2];
#pragma unroll
            for (int nt = 0; nt < 2; ++nt)
#pragma unroll
                for (int ks = 0; ks < 2; ++ks) Vb[nt][ks] = acc_bperm(vn[nt][2 * ks], vn[nt][2 * ks + 1]);
#pragma unroll
            for (int mt = 0; mt < 4; ++mt) { const LAS unsigned char* irow = L + GS_I + (16 * mt + fr) * 144;
#pragma unroll
                for (int ks = 0; ks < 2; ++ks) { const bf16x8 ia = lds_aperm(irow, 32 * ks, fq); o[0][mt] = MFMA16(ia, Vb[0][ks], o[0][mt]); o[1][mt] = MFMA16(ia, Vb[1][ks], o[1][mt]); } }
#pragma unroll
            for (int d = 0; d < 8; ++d) { S[0][d] = S[0][d] * gl; S[1][d] = S[1][d] * gl; const LAS unsigned char* krow = L + GS_K + (16 * d + fr) * 144;
#pragma unroll
                for (int ks = 0; ks < 2; ++ks) { const bf16x8 ka = lds_aperm(krow, 32 * ks, fq); S[0][d] = MFMA16(ka, Vb[0][ks], S[0][d]); S[1][d] = MFMA16(ka, Vb[1][ks], S[1][d]); } }
            LAS float* sq = ssq + (n & 1) * 256;
            float zv[2][16];
#pragma unroll
            for (int mt = 0; mt < 4; ++mt)
#pragma unroll
                for (int r = 0; r < 4; ++r) { const int t = 16 * mt + 4 * fq + r; const float s = red16_dpp(o[0][mt][r] * o[0][mt][r] + o[1][mt][r] * o[1][mt][r]); if (fr == 0) sq[w * 64 + t] = s;
                    zv[0][4 * mt + r] = bf2f(*(const LAS bf16_t*)(L + GS_Z + t * 272 + (32 * w + fr) * 2)); zv[1][4 * mt + r] = bf2f(*(const LAS bf16_t*)(L + GS_Z + t * 272 + (32 * w + 16 + fr) * 2)); }
            GS_BAR();
#pragma unroll
            for (int mt = 0; mt < 4; ++mt)
#pragma unroll
                for (int r = 0; r < 4; ++r) { const int t = 16 * mt + 4 * fq + r; const float s = (sq[t] + sq[64 + t]) + (sq[128 + t] + sq[192 + t]);
                    const float rstd = rsqrtf(s * (1.f / 128.f) + NORM_EPS);
                    const size_t m = (size_t)b * SEQ + (size_t)n * 64 + t;
                    if (!dry) { OAB[m * 1024 + h * 128 + 32 * w + fr] = (bf16_t)f2bf(o[0][mt][r] * rstd * gnw[0] * siluf_(zv[0][4 * mt + r]));
                                OAB[m * 1024 + h * 128 + 32 * w + 16 + fr] = (bf16_t)f2bf(o[1][mt][r] * rstd * gnw[1] * siluf_(zv[1][4 * mt + r])); } }
            GS_BAR();
        }
#pragma unroll
        for (int nt = 0; nt < 2; ++nt)
#pragma unroll
            for (int d = 0; d < 8; ++d) if (!dry) GST[nt * 512 + d * 64 + lane] = S[nt][d];
    }
#undef GS_BAR
}
constexpr int RW_L = 16;
constexpr int RW_W2T = 0, RW_A2T = 9216, RW_G2T = 18432;
constexpr int RW_OPS = 35840, RW_OPS_SZ = 24576;
constexpr int RW_YB = RW_OPS + 2 * RW_OPS_SZ, RW_YB_SZ = 4096;
constexpr int RW_XS = RW_YB + 2 * RW_YB_SZ, RW_XS_W = 2240;
constexpr int RW_XS_AD = 576, RW_XS_GD = 1152;
constexpr int RW_POST = RW_XS + 4 * RW_XS_W, RW_POST_SZ = 8192;
static_assert(RW_POST + 3 * RW_POST_SZ <= XB_LDS_OFF, "rwkv lds");
#define RW_BAR() do { asm volatile("s_waitcnt lgkmcnt(0)" ::: "memory"); __builtin_amdgcn_s_barrier(); asm volatile("" ::: "memory"); } while (0)
__device__ __forceinline__ float wave_sum_rl(float v) {
    v = red16_dpp(v);
    const int i = __builtin_bit_cast(int, v);
    return (__builtin_bit_cast(float, __builtin_amdgcn_readlane(i, 0)) + __builtin_bit_cast(float, __builtin_amdgcn_readlane(i, 16))) + (__builtin_bit_cast(float, __builtin_amdgcn_readlane(i, 32)) + __builtin_bit_cast(float, __builtin_amdgcn_readlane(i, 48)));
}

__device__ __forceinline__ void rwkv_unit(const Frame& F, const Args& a, int bh) {
    const bf16_t* F0 = (const bf16_t*)(F.ws + WS_BIG);
    bf16_t* OAB = (bf16_t*)(F.ws + WS_XN);
    const int h = bh & 7, b = bh >> 3, tid = F.tid, lane = F.lane, wave = F.wave, fr = lane & 15, fq = lane >> 4;
    LAS unsigned char* L = F.lds;
    for (int idx = tid; idx < 64 * 64; idx += NTHREADS) { const int j = idx >> 6, c = idx & 63;
        *(LAS bf16_t*)(L + RW_W2T + c * 144 + j * 2) = (bf16_t)f2bf(a.in[IN_RW2][j * 512 + h * 64 + c]);
        *(LAS bf16_t*)(L + RW_A2T + c * 144 + j * 2) = (bf16_t)f2bf(a.in[IN_RA2][j * 512 + h * 64 + c]); }
    for (int idx = tid; idx < 128 * 64; idx += NTHREADS) { const int j = idx >> 6, c = idx & 63;
        *(LAS bf16_t*)(L + RW_G2T + c * 272 + j * 2) = (bf16_t)f2bf(a.in[IN_RG2][j * 512 + h * 64 + c]); }
    RW_BAR();
    const size_t mb = (size_t)b * SEQ;
    if (wave < 4) {
        f32x2 S0[4], S1[4];
#pragma unroll
        for (int k = 0; k < 4; ++k) { S0[k] = (f32x2){0.f, 0.f}; S1[k] = (f32x2){0.f, 0.f}; }
        const int cg = lane & 7, row0 = 16 * wave + 2 * (lane >> 3);
        RW_BAR();
#pragma unroll 1
        for (int c = 0; c < SEQ / RW_L; ++c) {
            LAS unsigned char* ops = L + RW_OPS + (c & 1) * RW_OPS_SZ; LAS float* yb = (LAS float*)(L + RW_YB + (c & 1) * RW_YB_SZ);
            f32x4 wA, wB, kkA, kkB, bA, bB, kA, kB, rA, rB; f32x2 vv;
#define RW_LOADOPS(s_) do { const LAS float* po_ = (const LAS float*)(ops + (s_) * 1536) + 8 * cg; \
                wA = *(const LAS f32x4*)(po_); wB = *(const LAS f32x4*)(po_ + 4); kkA = *(const LAS f32x4*)(po_ + 64); kkB = *(const LAS f32x4*)(po_ + 68); \
                bA = *(const LAS f32x4*)(po_ + 128); bB = *(const LAS f32x4*)(po_ + 132); kA = *(const LAS f32x4*)(po_ + 192); kB = *(const LAS f32x4*)(po_ + 196); \
                rA = *(const LAS f32x4*)(po_ + 256); rB = *(const LAS f32x4*)(po_ + 260); vv = *(const LAS f32x2*)((const LAS float*)(ops + (s_) * 1536) + 320 + row0); } while (0)
            RW_LOADOPS(0);
#pragma unroll 1
            for (int s = 0; s < RW_L; ++s) {
                const f32x2 kk2[4] = {{kkA[0], kkA[1]}, {kkA[2], kkA[3]}, {kkB[0], kkB[1]}, {kkB[2], kkB[3]}};
                const f32x2 w2[4] = {{wA[0], wA[1]}, {wA[2], wA[3]}, {wB[0], wB[1]}, {wB[2], wB[3]}};
                const f32x2 b2[4] = {{bA[0], bA[1]}, {bA[2], bA[3]}, {bB[0], bB[1]}, {bB[2], bB[3]}};
                const f32x2 k2[4] = {{kA[0], kA[1]}, {kA[2], kA[3]}, {kB[0], kB[1]}, {kB[2], kB[3]}};
                const f32x2 r2[4] = {{rA[0], rA[1]}, {rA[2], rA[3]}, {rB[0], rB[1]}, {rB[2], rB[3]}};
                const f32x2 v0 = {vv[0], vv[0]}, v1 = {vv[1], vv[1]};
                if (s + 1 < RW_L) RW_LOADOPS(s + 1);
                f32x2 a0 = S0[0] * kk2[0] + S0[1] * kk2[1], a1 = S1[0] * kk2[0] + S1[1] * kk2[1];
                a0 = a0 + S0[2] * kk2[2] + S0[3] * kk2[3]; a1 = a1 + S1[2] * kk2[2] + S1[3] * kk2[3];
                const float sa0 = red8_dpp(a0[0] + a0[1]), sa1 = red8_dpp(a1[0] + a1[1]);
                const f32x2 n0 = {-sa0, -sa0}, n1 = {-sa1, -sa1};
                f32x2 y0 = {0.f, 0.f}, y1 = {0.f, 0.f};
#pragma unroll
                for (int q = 0; q < 4; ++q) { S0[q] = S0[q] * w2[q] + n0 * b2[q] + v0 * k2[q]; S1[q] = S1[q] * w2[q] + n1 * b2[q] + v1 * k2[q]; y0 = y0 + S0[q] * r2[q]; y1 = y1 + S1[q] * r2[q]; }
                const float ys0 = red8_dpp(y0[0] + y0[1]), ys1 = red8_dpp(y1[0] + y1[1]);
                if (cg == 0) *(LAS f32x2*)(yb + s * 64 + row0) = (f32x2){ys0, ys1};
            }
#undef RW_LOADOPS
            RW_BAR();
        }
        RW_BAR();
    } else {
        const int p = wave - 4, hc = h * 64 + lane;
        LAS unsigned char* XS = L + RW_XS + p * RW_XS_W;
        const float w0c = a.in[IN_RW0][hc], a0c = a.in[IN_RA0][hc], kkc = a.in[IN_RKK][hc], kac = a.in[IN_RKA][hc], rkc = a.in[IN_RRK][hc], lnw = a.in[IN_RLNW][hc], lnb = a.in[IN_RLNB][hc];
        float mu[7];
#pragma unroll
        for (int g = 0; g < 3; ++g) mu[g] = a.in[IN_RMU][g * 512 + hc];
#pragma unroll
        for (int g = 3; g < 7; ++g) mu[g] = a.in[IN_RMU][1536 + (g - 3) * 64 + lane];
        bf16_t fv[5][7];
#define RW_FETCH(cn_) do { const long t0_ = (long)(cn_) * RW_L + 4 * p - 1; \
            _Pragma("unroll") for (int j_ = 0; j_ < 5; ++j_) { const long t_ = t0_ + j_; \
                _Pragma("unroll") for (int g_ = 0; g_ < 7; ++g_) { const int col_ = F0_RWKV + (g_ < 3 ? g_ * 512 + h * 64 : 1536 + (g_ - 3) * 64) + lane; fv[j_][g_] = (t_ >= 0) ? F0[(mb + t_) * F0_LD + col_] : (bf16_t)0; } } } while (0)
        RW_FETCH(0);
#pragma unroll 1
        for (int c = -1; c <= SEQ / RW_L; ++c) {
            const bool prep_on = (c + 1 < SEQ / RW_L), post_on = (c >= 1);
            if (post_on) {
                const LAS float* yb = (const LAS float*)(L + RW_YB + ((c - 1) & 1) * RW_YB_SZ); const LAS float* pg = (const LAS float*)(L + RW_POST + ((c - 1) % 3) * RW_POST_SZ);
#pragma unroll
                for (int j = 0; j < 4; ++j) { const int tau = 4 * p + j; const float y = yb[tau * 64 + lane];
                    const float mean = wave_sum_rl(y) * (1.f / 64.f); const float d = y - mean; const float var = wave_sum_rl(d * d) * (1.f / 64.f);
                    const float o = (d * rsqrtf(var + RWKV_LN_EPS) * lnw + lnb + pg[1024 + tau * 64 + lane]) * pg[tau * 64 + lane];
                    OAB[(mb + (size_t)(c - 1) * RW_L + tau) * 1024 + 512 + hc] = (bf16_t)f2bf(o); }
            }
            if (prep_on) {
                LAS unsigned char* nops = L + RW_OPS + ((c + 1) & 1) * RW_OPS_SZ; LAS float* pg_n = (LAS float*)(L + RW_POST + ((c + 1) % 3) * RW_POST_SZ);
                float xr[4], xk[4], xv[4];
#pragma unroll
                for (int j = 0; j < 4; ++j) {
                    float xs[7];
#pragma unroll
                    for (int g = 0; g < 7; ++g) { const float f = bf2f(fv[j + 1][g]), fp = bf2f(fv[j][g]); xs[g] = f + (fp - f) * mu[g]; }
                    xr[j] = xs[0]; xk[j] = xs[1]; xv[j] = xs[2];
                    *(LAS bf16_t*)(XS + j * 144 + lane * 2) = (bf16_t)f2bf(fast_tanhf(xs[3]));
                    *(LAS bf16_t*)(XS + RW_XS_AD + j * 144 + lane * 2) = (bf16_t)f2bf(xs[4]);
                    *(LAS bf16_t*)(XS + RW_XS_GD + j * 272 + lane * 2) = (bf16_t)f2bf(sigmoidf_(xs[5]));
                    *(LAS bf16_t*)(XS + RW_XS_GD + j * 272 + 128 + lane * 2) = (bf16_t)f2bf(sigmoidf_(xs[6]));
                }
                if (c + 2 < SEQ / RW_L) RW_FETCH(c + 2);
                asm volatile("s_waitcnt lgkmcnt(0)" ::: "memory");
                f32x4 cw = (f32x4){0.f, 0.f, 0.f, 0.f}, ca = cw, cgt = cw;
                {
                    bf16x8 xa[2], xb[2], xg[4];
#pragma unroll
                    for (int ks = 0; ks < 2; ++ks) { xa[ks] = *(const LAS bf16x8*)(XS + (fr & 3) * 144 + (32 * ks + 8 * fq) * 2); xb[ks] = *(const LAS bf16x8*)(XS + RW_XS_AD + (fr & 3) * 144 + (32 * ks + 8 * fq) * 2); }
#pragma unroll
                    for (int ks = 0; ks < 4; ++ks) xg[ks] = *(const LAS bf16x8*)(XS + RW_XS_GD + (fr & 3) * 272 + (32 * ks + 8 * fq) * 2);
#pragma unroll
                    for (int nt = 0; nt < 4; ++nt) {
                        f32x4 tw = (f32x4){0.f, 0.f, 0.f, 0.f}, ta = tw, tg = tw;
#pragma unroll
                        for (int ks = 0; ks < 2; ++ks) { tw = MFMA16(xa[ks], *(const LAS bf16x8*)(L + RW_W2T + (16 * nt + fr) * 144 + (32 * ks + 8 * fq) * 2), tw);
                                                         ta = MFMA16(xb[ks], *(const LAS bf16x8*)(L + RW_A2T + (16 * nt + fr) * 144 + (32 * ks + 8 * fq) * 2), ta); }
#pragma unroll
                        for (int ks = 0; ks < 4; ++ks) tg = MFMA16(xg[ks], *(const LAS bf16x8*)(L + RW_G2T + (16 * nt + fr) * 272 + (32 * ks + 8 * fq) * 2), tg);
                        if (fq == nt) { cw = tw; ca = ta; cgt = tg; }
                    }
                }
#pragma unroll
                for (int j = 0; j < 4; ++j) { const int tau = 4 * p + j; LAS float* o = (LAS float*)(nops + tau * 1536);
                    const float lw = cw[j] + w0c; const float wlog = -fast_softplusf(-lw) - 0.5f; const float wdec = __expf(-__expf(wlog));
                    const float av = sigmoidf_(ca[j] + a0c);
                    const float kkraw = xk[j] * kkc, kp = xk[j] * (1.f + (av - 1.f) * kac);
                    const float rinv = rsqrtf(wave_sum_rl(kkraw * kkraw) + 1e-6f);
                    const float bn = wave_sum_rl(xr[j] * kp * rkc);
                    const float kkn = kkraw * rinv;
                    o[lane] = wdec; o[64 + lane] = kkn; o[128 + lane] = kkn * av; o[192 + lane] = kp; o[256 + lane] = xr[j]; o[320 + lane] = xv[j];
                    pg_n[tau * 64 + lane] = cgt[j]; pg_n[1024 + tau * 64 + lane] = xv[j] * bn; }
            }
            RW_BAR();
        }
#undef RW_FETCH
    }
    __syncthreads();
}
constexpr int RC_KR = 0, RC_BKT = 4096, RC_VT = 8192, RC_MBB = 10240, RC_MKB = 11264, RC_MBR = 11776, RC_MKR = 12288, RC_WL = 12800, RC_PG = 13056, RC_PBV = 15104, RC_REC = 17408;
constexpr int RC_SEG_CHUNKS = 32, RC_NSEG = (SEQ / 16) / RC_SEG_CHUNKS;
constexpr size_t WS_RSCR = WS_R2 + 21 * MiB;
constexpr size_t WS_RSTATE = WS_R2 + 17 * MiB;
constexpr size_t WS_RIMG = WS_R2 + 20 * MiB;
constexpr int RP_PRM = 35840;
constexpr int RP_MU = RP_PRM + 1280;
constexpr int RP_WAVE = RP_MU + 1792, RP_WAVE_SZ = 9216;
static_assert(RP_WAVE + 8 * RP_WAVE_SZ <= XB_LDS_OFF, "rwkv prep lds");
__device__ __forceinline__ float dpp_shr_f(float v, const int n) {
    const int i = __builtin_bit_cast(int, v); int r;
    if (n == 1) r = __builtin_amdgcn_update_dpp(0, i, 0x111, 0xF, 0xF, true); else if (n == 2) r = __builtin_amdgcn_update_dpp(0, i, 0x112, 0xF, 0xF, true);
    else if (n == 4) r = __builtin_amdgcn_update_dpp(0, i, 0x114, 0xF, 0xF, true); else r = __builtin_amdgcn_update_dpp(0, i, 0x118, 0xF, 0xF, true);
    return __builtin_bit_cast(float, r);
}
__device__ __forceinline__ void rwkvc_prep_phase(const Frame& F, const Args& a, int sg) {
    const bf16_t* F0 = (const bf16_t*)(F.ws + WS_BIG);
    unsigned char* SCR = F.ws + WS_RSCR;
    const int tid = F.tid, wave = F.wave;
    LAS unsigned char* L = F.lds;
    for (int blk = F.bid; blk < 256; blk += F.G) {
        const int bh = blk >> 2, h = bh & 7, b = bh >> 3;
        const size_t mb = (size_t)b * SEQ;
        LAS unsigned char* XS = L + RP_WAVE + wave * RP_WAVE_SZ;
            int ln_ = F.lane; asm volatile("" : "+v"(ln_));
            const int lane = ln_, fr = ln_ & 15, fq = ln_ >> 4;
            const int cs = (blk & 3) * 8 + wave;
            const int t0 = (sg * RC_SEG_CHUNKS + cs) * 16;
            unsigned char* rec = SCR + ((size_t)bh * RC_SEG_CHUNKS + cs) * RC_REC;
            const bf16_t* rowc = F0 + (mb + t0 + fr) * F0_LD + F0_RWKV;
            const bool hasp = (t0 + fr) > 0; const bf16_t* rowp = rowc - (hasp ? F0_LD : 0);
            const bf16_t* rc4 = rowc + 4 * fq; const bf16_t* rp4 = rowp + 4 * fq; const LAS float* mul4 = (const LAS float*)(L + RP_MU) + 4 * fq;
            unsigned char* pbkt = rec + RC_BKT + fq * 256 + (fr >> 2) * 16 + (fr & 3) * 2;
            unsigned char* pvt = rec + RC_VT + fq * 128 + fr * 2;
            unsigned char* pwl = rec + RC_WL + fq * 16;
            unsigned char* ppg = rec + RC_PG + fr * 128 + fq * 8;
            LAS unsigned char* xs4 = XS + fr * 144 + fq * 8;
            u32x2 rawc[7][4], rawp[7][4];
#pragma unroll
            for (int g = 3; g < 7; ++g)
#pragma unroll
                for (int mt = 0; mt < 4; ++mt) { const int coff = 1536 + 64 * (g - 3) + 16 * mt; rawc[g][mt] = *(const u32x2*)(rc4 + coff); rawp[g][mt] = *(const u32x2*)(rp4 + coff); }
        __syncthreads();
        {
            const u32x4* src = (const u32x4*)(F.ws + WS_RIMG + (size_t)h * 35840);
            u32x4 t4[5];
#pragma unroll
            for (int i = 0; i < 5; ++i) { const int e = tid + NTHREADS * i; t4[i] = (e < 2240) ? src[e] : (u32x4){0u, 0u, 0u, 0u}; }
#pragma unroll
            for (int i = 0; i < 5; ++i) { const int e = tid + NTHREADS * i; if (e < 2240) *(LAS u32x4*)(L + e * 16) = t4[i]; }
        }
        if (tid < 320) { const int wh = tid >> 6, c = tid & 63; const float* src = wh == 0 ? a.in[IN_RW0] : wh == 1 ? a.in[IN_RA0] : wh == 2 ? a.in[IN_RKK] : wh == 3 ? a.in[IN_RKA] : a.in[IN_RRK];
            ((LAS float*)(L + RP_PRM))[tid] = src[h * 64 + c]; }
        if (tid < 448) ((LAS float*)(L + RP_MU))[tid] = a.in[IN_RMU][tid < 192 ? (tid >> 6) * 512 + h * 64 + (tid & 63) : 1536 + (tid - 192)];
        __syncthreads();
        const LAS float* PRM = (const LAS float*)(L + RP_PRM);
        {
#pragma unroll
            for (int g = 0; g < 4; ++g) {
                const int coff = 1536 + 64 * g;
#pragma unroll
                for (int mt = 0; mt < 4; ++mt) { const int j0 = 16 * mt + 4 * fq;
                    const u32x2 fc = rawc[3 + g][mt]; u32x2 fp = rawp[3 + g][mt]; if (!hasp) fp = (u32x2){0u, 0u};
                    const f32x4 mu = *(const LAS f32x4*)(mul4 + 192 + 64 * g + 16 * mt);
                    float x[4] = {bflo(fc.x), bfhi(fc.x), bflo(fc.y), bfhi(fc.y)}; const float xp[4] = {bflo(fp.x), bfhi(fp.x), bflo(fp.y), bfhi(fp.y)};
#pragma unroll
                    for (int e = 0; e < 4; ++e) { x[e] = x[e] + (xp[e] - x[e]) * mu[e]; x[e] = (g == 0) ? fast_tanhf(x[e]) : (g == 1) ? x[e] : sigmoidf_(x[e]); }
                    u32x2 o; o.x = pk2(x[0], x[1]); o.y = pk2(x[2], x[3]);
                    LAS unsigned char* dst = (g == 0) ? XS + fr * 144 + j0 * 2 : (g == 1) ? XS + 2304 + fr * 144 + j0 * 2 : XS + 4608 + fr * 272 + (g - 2) * 128 + j0 * 2;
                    *(LAS u32x2*)dst = o; } }
#pragma unroll
            for (int g = 0; g < 3; ++g)
#pragma unroll
                for (int mt = 0; mt < 4; ++mt) { const int coff = g * 512 + h * 64 + 16 * mt; rawc[g][mt] = *(const u32x2*)(rc4 + coff); rawp[g][mt] = *(const u32x2*)(rp4 + coff); }
            asm volatile("s_waitcnt lgkmcnt(0)" ::: "memory");
            float vr[16], vk[16], vv[16], ve[16], vkk[16], vb[16];
            float ss = 0.f, bn = 0.f;
            bf16x8 xw[2], xa[2], xg[4];
#pragma unroll
            for (int ks = 0; ks < 2; ++ks) { xw[ks] = *(const LAS bf16x8*)(XS + fr * 144 + (32 * ks + 8 * fq) * 2); xa[ks] = *(const LAS bf16x8*)(XS + 2304 + fr * 144 + (32 * ks + 8 * fq) * 2); }
#pragma unroll
            for (int ks = 0; ks < 4; ++ks) xg[ks] = *(const LAS bf16x8*)(XS + 4608 + fr * 272 + (32 * ks + 8 * fq) * 2);
#pragma unroll
            for (int mt = 0; mt < 4; ++mt) {
#pragma unroll
                for (int g = 0; g < 3; ++g) { const int coff = g * 512 + 16 * mt;
                    const u32x2 fc = rawc[g][mt]; u32x2 fp = rawp[g][mt]; if (!hasp) fp = (u32x2){0u, 0u};
                    const f32x4 mu = *(const LAS f32x4*)(mul4 + 64 * g + 16 * mt);
                    const float x[4] = {bflo(fc.x), bfhi(fc.x), bflo(fc.y), bfhi(fc.y)}; const float xp[4] = {bflo(fp.x), bfhi(fp.x), bflo(fp.y), bfhi(fp.y)};
#pragma unroll
                    for (int e = 0; e < 4; ++e) { const float xs = x[e] + (xp[e] - x[e]) * mu[e]; if (g == 0) vr[4 * mt + e] = xs; else if (g == 1) vk[4 * mt + e] = xs; else vv[4 * mt + e] = xs; } }
                f32x4 cw = (f32x4){0.f, 0.f, 0.f, 0.f}, ca = cw, cg = cw;
#pragma unroll
                for (int ks = 0; ks < 2; ++ks) { cw = MFMA16(*(const LAS bf16x8*)(L + RW_W2T + (16 * mt + fr) * 144 + (32 * ks + 8 * fq) * 2), xw[ks], cw);
                                                 ca = MFMA16(*(const LAS bf16x8*)(L + RW_A2T + (16 * mt + fr) * 144 + (32 * ks + 8 * fq) * 2), xa[ks], ca); }
#pragma unroll
                for (int ks = 0; ks < 4; ++ks) cg = MFMA16(*(const LAS bf16x8*)(L + RW_G2T + (16 * mt + fr) * 272 + (32 * ks + 8 * fq) * 2), xg[ks], cg);
#pragma unroll
                for (int r = 0; r < 4; ++r) { const int q = 4 * mt + r, c = 16 * mt + 4 * fq + r;
                    const float lw = cw[r] + PRM[c]; ve[q] = 0.6065306597126334f * sigmoidf_(lw);
                    const float av = sigmoidf_(ca[r] + PRM[64 + c]);
                    const float kraw = vk[q] * PRM[128 + c]; vk[q] = vk[q] * (1.f + (av - 1.f) * PRM[192 + c]);
                    vkk[q] = kraw; vb[q] = av; ss += kraw * kraw; bn += vr[q] * vk[q] * PRM[256 + c]; }
                { u32x2 og; og.x = pk2(cg[0], cg[1]); og.y = pk2(cg[2], cg[3]); *(u32x2*)(ppg + mt * 32) = og; }
                asm volatile("" ::: "memory");
            }
            ss += __shfl_xor(ss, 16); ss += __shfl_xor(ss, 32); bn += __shfl_xor(bn, 16); bn += __shfl_xor(bn, 32);
            const float rinv = rsqrtf(ss + 1e-6f);
#pragma unroll
            for (int mt = 0; mt < 4; ++mt) { u32x2 ob; ob.x = pk2(vv[4 * mt] * bn, vv[4 * mt + 1] * bn); ob.y = pk2(vv[4 * mt + 2] * bn, vv[4 * mt + 3] * bn); *(u32x2*)(ppg + 2048 + mt * 32) = ob; }
#pragma unroll
            for (int ks = 0; ks < 2; ++ks) {
                float kkt[8], rt[8], bh_[8], kh[8];
#pragma unroll
                for (int i = 0; i < 8; ++i) { const int q = 8 * ks + i;
                    float cl = ve[q];
                    cl += dpp_shr_f(cl, 1); cl += dpp_shr_f(cl, 2); cl += dpp_shr_f(cl, 4); cl += dpp_shr_f(cl, 8);
                    const float clL = __shfl(cl, (lane & 48) | 15);
                    const float kkn = vkk[q] * rinv, bq = kkn * vb[q];
                    const float W = __expf(-cl), Wp = __expf(ve[q] - cl), Wi = __expf(cl), WLr = __expf(cl - clL);
                    kkt[i] = kkn * Wp; rt[i] = vr[q] * W; bh_[i] = bq * Wi; kh[i] = vk[q] * Wi;
                    *(bf16_t*)(pbkt + (q >> 2) * 1024 + (q & 3) * 64) = (bf16_t)f2bf(-bq * WLr);
                    *(bf16_t*)(pbkt + (q >> 2) * 1024 + (q & 3) * 64 + 8) = (bf16_t)f2bf(vk[q] * WLr);
                    *(bf16_t*)(pvt + (q >> 2) * 512 + (q & 3) * 32) = (bf16_t)f2bf(vv[q]);
                    if (fr == 15) *(float*)(pwl + (q >> 2) * 64 + (q & 3) * 4) = W;
                }
                u32x4 o1, o2;
                o1.x = pk2(kkt[0], kkt[1]); o1.y = pk2(kkt[2], kkt[3]); o1.z = pk2(kkt[4], kkt[5]); o1.w = pk2(kkt[6], kkt[7]);
                o2.x = pk2(rt[0], rt[1]); o2.y = pk2(rt[2], rt[3]); o2.z = pk2(rt[4], rt[5]); o2.w = pk2(rt[6], rt[7]);
                *(u32x4*)(rec + RC_KR + fr * 128 + ks * 64 + fq * 16) = o1; *(u32x4*)(rec + RC_KR + 2048 + fr * 128 + ks * 64 + fq * 16) = o2;
#pragma unroll
                for (int m2 = 0; m2 < 2; ++m2) { const int mt = 2 * ks + m2; LAS unsigned char* xo = xs4 + mt * 32;
                    *(LAS u32x2*)(xo) = (u32x2){o1[2 * m2], o1[2 * m2 + 1]};
                    *(LAS u32x2*)(xo + 2304) = (u32x2){o2[2 * m2], o2[2 * m2 + 1]};
                    u32x2 o; o.x = pk2(bh_[4 * m2], bh_[4 * m2 + 1]); o.y = pk2(bh_[4 * m2 + 2], bh_[4 * m2 + 3]); *(LAS u32x2*)(xo + 4608) = o;
                    o.x = pk2(kh[4 * m2], kh[4 * m2 + 1]); o.y = pk2(kh[4 * m2 + 2], kh[4 * m2 + 3]); *(LAS u32x2*)(xo + 6912) = o; }
                asm volatile("" ::: "memory");
            }
            asm volatile("s_waitcnt lgkmcnt(0)" ::: "memory");
            f32x4 mbb = (f32x4){0.f, 0.f, 0.f, 0.f}, mkb = mbb, mbr = mbb, mkr = mbb;
#pragma unroll
            for (int ks = 0; ks < 2; ++ks) { const int off = fr * 144 + (32 * ks + 8 * fq) * 2;
                const bf16x8 akk = *(const LAS bf16x8*)(XS + off), ar = *(const LAS bf16x8*)(XS + 2304 + off), bb = *(const LAS bf16x8*)(XS + 4608 + off), bk = *(const LAS bf16x8*)(XS + 6912 + off);
                mbb = MFMA16(akk, bb, mbb); mkb = MFMA16(akk, bk, mkb); mbr = MFMA16(ar, bb, mbr); mkr = MFMA16(ar, bk, mkr); }
            {
                float T[16]; const float mf0 = mbb[0], mf1 = mbb[1], mf2 = mbb[2], mf3 = mbb[3];
                const int mb_[4] = {__builtin_bit_cast(int, mf0), __builtin_bit_cast(int, mf1), __builtin_bit_cast(int, mf2), __builtin_bit_cast(int, mf3)};
#pragma unroll
                for (int t = 0; t < 16; ++t) T[t] = (t == fr) ? 1.f : 0.f;
#pragma unroll
                for (int t = 1; t < 16; ++t) { float s0 = T[t], s1 = 0.f;
#pragma unroll
                    for (int j = 0; j < t; ++j) { const float m = __builtin_bit_cast(float, __builtin_amdgcn_readlane(mb_[t & 3], j + 16 * (t >> 2)));
                        if (j & 1) s1 -= m * T[j]; else s0 -= m * T[j]; }
                    T[t] = s0 + s1; }
                if (fq == 0) {
#pragma unroll
                    for (int t = 0; t < 16; ++t) { const bf16_t tv = (bf16_t)f2bf(T[t]); *(bf16_t*)(rec + RC_MBB + t * 64 + (fr >> 2) * 16 + (fr & 3) * 2) = tv; *(bf16_t*)(rec + RC_MBB + t * 64 + (fr >> 2) * 16 + 8 + (fr & 3) * 2) = tv; }
                }
            }
#pragma unroll
            for (int r = 0; r < 4; ++r) { const int t = 4 * fq + r, j = fr;
                *(bf16_t*)(rec + RC_MKB + t * 32 + j * 2) = (bf16_t)f2bf((j < t) ? mkb[r] : 0.f);
                *(bf16_t*)(rec + RC_MBR + t * 32 + j * 2) = (bf16_t)f2bf((j <= t) ? mbr[r] : 0.f);
                *(bf16_t*)(rec + RC_MKR + t * 32 + j * 2) = (bf16_t)f2bf((j <= t) ? mkr[r] : 0.f); }
            asm volatile("s_waitcnt lgkmcnt(0)" ::: "memory");
        }
    }
}

constexpr int RCH_X = 0;
constexpr int RCH_ST = 4096;
constexpr int RCH_RING = 8192, RCH_NSLOT = 6, RCH_PF = 5;
static_assert(RCH_RING + RCH_NSLOT * RC_REC <= XB_LDS_OFF, "rwkv chain lds");
#define RCH_BAR() do { asm volatile("s_waitcnt lgkmcnt(0)" ::: "memory"); __builtin_amdgcn_s_barrier(); asm volatile("" ::: "memory"); } while (0)
__device__ __forceinline__ void rwkvc_chain_unit(const Frame& F, const Args& a, int bh, int sg, bool dry = false) {
    const unsigned char* SCR = F.ws + WS_RSCR;
    bf16_t* OAB = (bf16_t*)(F.ws + WS_XN); f32x4* STATE = (f32x4*)(F.ws + WS_RSTATE);
    const int lane = F.lane, w = F.wave, fr = lane & 15, fq = lane >> 4, h = bh & 7, b = bh >> 3;
    LAS unsigned char* L = F.lds;
    const size_t mb = (size_t)b * SEQ;
    const unsigned char* seg = SCR + ((size_t)bh * RC_SEG_CHUNKS) * RC_REC;
    if (w >= 4) {
        const int p = w - 4;
#define RCH_ISSUE(ch_) do { int l16_ = lane * 16; asm volatile("" : "+v"(l16_)); const unsigned char* src_ = seg + (size_t)(ch_) * RC_REC + l16_; LAS unsigned char* dst_ = L + RCH_RING + ((ch_) % RCH_NSLOT) * RC_REC; \
            _Pragma("unroll") for (int i_ = 0; i_ < 5; ++i_) { const int pc_ = p + 4 * i_; if (pc_ < 17) __builtin_amdgcn_global_load_lds((const unsigned*)(src_ + pc_ * 1024), (LAS unsigned*)(dst_ + pc_ * 1024), 16, 0, 0); } } while (0)
#pragma unroll 1
        for (int ch = 0; ch < RCH_PF; ++ch) RCH_ISSUE(ch);
        if (p == 0) asm volatile("s_waitcnt vmcnt(20)" ::: "memory"); else asm volatile("s_waitcnt vmcnt(16)" ::: "memory");
        RCH_BAR();
#pragma unroll 1
        for (int cs = 0; cs < RC_SEG_CHUNKS; ++cs) {
            if (cs + RCH_PF < RC_SEG_CHUNKS) { RCH_ISSUE(cs + RCH_PF);
                if (p == 0) asm volatile("s_waitcnt vmcnt(20)" ::: "memory"); else asm volatile("s_waitcnt vmcnt(16)" ::: "memory"); }
            else asm volatile("s_waitcnt vmcnt(0)" ::: "memory");
            RCH_BAR();
        }
#undef RCH_ISSUE
    } else {
        LAS float* XT = (LAS float*)(L + RCH_X + w * 1024); LAS float* STT = (LAS float*)(L + RCH_ST);
        f32x4 acc[4];
#pragma unroll
        for (int mt = 0; mt < 4; ++mt) acc[mt] = (sg == 0) ? (f32x4){0.f, 0.f, 0.f, 0.f} : STATE[((size_t)bh * 4 + w) * 256 + mt * 64 + lane];
        const int v = 16 * w + fr, hc = h * 64 + v;
        const float lnw = a.in[IN_RLNW][hc], lnb = a.in[IN_RLNB][hc];
        RCH_BAR();
#pragma unroll 1
        for (int cs = 0; cs < RC_SEG_CHUNKS; ++cs) {
            const LAS unsigned char* rec = L + RCH_RING + (cs % RCH_NSLOT) * RC_REC;
            const u32x4 z4 = (u32x4){0u, 0u, 0u, 0u}; const int f2 = fq & 1;
            bf16x8 sb[2];
#pragma unroll
            for (int ks = 0; ks < 2; ++ks) { u32x4 pk; pk.x = pk2(acc[2 * ks][0], acc[2 * ks][1]); pk.y = pk2(acc[2 * ks][2], acc[2 * ks][3]); pk.z = pk2(acc[2 * ks + 1][0], acc[2 * ks + 1][1]); pk.w = pk2(acc[2 * ks + 1][2], acc[2 * ks + 1][3]); sb[ks] = __builtin_bit_cast(bf16x8, pk); }
            f32x4 rhs = (f32x4){0.f, 0.f, 0.f, 0.f}, y1 = rhs;
#pragma unroll
            for (int ks = 0; ks < 2; ++ks) { rhs = MFMA16(*(const LAS bf16x8*)(rec + RC_KR + fr * 128 + ks * 64 + fq * 16), sb[ks], rhs); y1 = MFMA16(*(const LAS bf16x8*)(rec + RC_KR + 2048 + fr * 128 + ks * 64 + fq * 16), sb[ks], y1); }
            u32x4 vt8 = *(const LAS u32x4*)(rec + RC_VT + v * 32 + f2 * 16), mkb = *(const LAS u32x4*)(rec + RC_MKB + fr * 32 + f2 * 16), mkr = *(const LAS u32x4*)(rec + RC_MKR + fr * 32 + f2 * 16), mbr = *(const LAS u32x4*)(rec + RC_MBR + fr * 32 + f2 * 16);
            if (fq >= 2) { vt8 = z4; mkb = z4; mkr = z4; mbr = z4; }
            rhs = MFMA16(__builtin_bit_cast(bf16x8, mkb), __builtin_bit_cast(bf16x8, vt8), rhs);
            y1 = MFMA16(__builtin_bit_cast(bf16x8, mkr), __builtin_bit_cast(bf16x8, vt8), y1);
            f32x4 u4;
            { u32x4 rb; rb.x = pk2(rhs[0], rhs[1]); rb.y = pk2(rhs[2], rhs[3]); rb.z = 0u; rb.w = 0u;
              const f32x4 zf = {0.f, 0.f, 0.f, 0.f}; u4 = MFMA16(*(const LAS bf16x8*)(rec + RC_MBB + fr * 64 + fq * 16), __builtin_bit_cast(bf16x8, rb), zf); }
            *(LAS f32x4*)(XT + fr * 16 + 4 * fq) = u4;
            asm volatile("s_waitcnt lgkmcnt(0)" ::: "memory");
            u32x4 ub;
            { const f32x4 ua = *(const LAS f32x4*)(XT + fr * 16 + 8 * f2), ubb = *(const LAS f32x4*)(XT + fr * 16 + 8 * f2 + 4);
              ub.x = pk2(ua[0], ua[1]); ub.y = pk2(ua[2], ua[3]); ub.z = pk2(ubb[0], ubb[1]); ub.w = pk2(ubb[2], ubb[3]); if (fq >= 2) ub = z4; }
            f32x4 yv = (f32x4){0.f, 0.f, 0.f, 0.f};
            yv = MFMA16(__builtin_bit_cast(bf16x8, mbr), __builtin_bit_cast(bf16x8, ub), yv);
            const f32x4 y = y1 - yv;
            u32x4 uvb; const u32x2 vt4 = *(const LAS u32x2*)(rec + RC_VT + v * 32 + fq * 8);
            uvb.x = pk2(u4[0], u4[1]); uvb.y = pk2(u4[2], u4[3]);
            uvb.z = vt4.x; uvb.w = vt4.y;
#pragma unroll
            for (int mt = 0; mt < 4; ++mt) { const f32x4 wl = *(const LAS f32x4*)(rec + RC_WL + (16 * mt + 4 * fq) * 4);
                acc[mt] = MFMA16(*(const LAS bf16x8*)(rec + RC_BKT + (16 * mt + fr) * 64 + fq * 16), __builtin_bit_cast(bf16x8, uvb), acc[mt] * wl); }
            float pgv[4], pbv[4];
#pragma unroll
            for (int r = 0; r < 4; ++r) { pgv[r] = bf2f(*(const LAS bf16_t*)(rec + RC_PG + (4 * fq + r) * 128 + v * 2)); pbv[r] = bf2f(*(const LAS bf16_t*)(rec + RC_PBV + (4 * fq + r) * 128 + v * 2)); }
            LAS float* st = STT + (cs & 1) * 128;
#pragma unroll
            for (int r = 0; r < 4; ++r) { const float s1 = red16_dpp(y[r]), s2 = red16_dpp(y[r] * y[r]); if (fr == 0) { st[(w * 16 + 4 * fq + r) * 2] = s1; st[(w * 16 + 4 * fq + r) * 2 + 1] = s2; } }
            RCH_BAR();
#pragma unroll
            for (int r = 0; r < 4; ++r) { const int t = 4 * fq + r; float s1 = 0.f, s2 = 0.f;
#pragma unroll
                for (int ww = 0; ww < 4; ++ww) { const f32x2 sv = *(const LAS f32x2*)(st + (ww * 16 + t) * 2); s1 += sv[0]; s2 += sv[1]; }
                const float mean = s1 * (1.f / 64.f), var = fmaxf(s2 * (1.f / 64.f) - mean * mean, 0.f);
                const float o = ((y[r] - mean) * rsqrtf(var + RWKV_LN_EPS) * lnw + lnb + pbv[r]) * pgv[r];
                if (!dry) OAB[(mb + (size_t)(sg * RC_SEG_CHUNKS + cs) * 16 + t) * 1024 + 512 + hc] = (bf16_t)f2bf(o); }
        }
#pragma unroll
        for (int mt = 0; mt < 4; ++mt) if (!dry) STATE[((size_t)bh * 4 + w) * 256 + mt * 64 + lane] = acc[mt];
    }
    __syncthreads();
}

__device__ __forceinline__ void rwkvc_build_images(const Frame& F, const Args& a) {
    const int gt = F.bid * NTHREADS + F.tid, NT = F.G * NTHREADS;
    for (int e = gt; e < 8 * 256 * 64; e += NT) {
        const int c = e & 63, jj = (e >> 6) & 255, h = e >> 14;
        unsigned char* img = F.ws + WS_RIMG + (size_t)h * 35840;
        if (jj < 64) *(bf16_t*)(img + RW_W2T + c * 144 + jj * 2) = (bf16_t)f2bf(a.in[IN_RW2][jj * 512 + h * 64 + c]);
        else if (jj < 128) *(bf16_t*)(img + RW_A2T + c * 144 + (jj - 64) * 2) = (bf16_t)f2bf(a.in[IN_RA2][(jj - 64) * 512 + h * 64 + c]);
        else *(bf16_t*)(img + RW_G2T + c * 272 + (jj - 128) * 2) = (bf16_t)f2bf(a.in[IN_RG2][(jj - 128) * 512 + h * 64 + c]);
    }
}
template <bool RES_BF16, bool OUT_BF16>
__device__ __forceinline__ void row_pass(const Frame& F, const bf16_t* mix, const void* resid_, const float* w_post, void* hout_, const float* w_next, bf16_t* xn) {
    const int gw = F.bid * NWAVES + F.wave, NGW = F.G * NWAVES, lane = F.lane;
    for (int mA = gw; mA < MTOK; mA += 2 * NGW) {
        const int mB = (mA + NGW < MTOK) ? mA + NGW : mA; const bool two = (mB != mA);
        const u32x2* mrA = (const u32x2*)(mix + (size_t)mA * D_MODEL) + lane; const u32x2* mrB = (const u32x2*)(mix + (size_t)mB * D_MODEL) + lane;
        u32x2 pa[4], pb[4]; f32x4 ha[4], hb[4];
#pragma unroll
        for (int j = 0; j < 4; ++j) { pa[j] = mrA[64 * j]; pb[j] = mrB[64 * j]; }
        if (RES_BF16) {
            const u32x2* rA = (const u32x2*)((const bf16_t*)resid_ + (size_t)mA * D_MODEL) + lane; const u32x2* rB = (const u32x2*)((const bf16_t*)resid_ + (size_t)mB * D_MODEL) + lane;
#pragma unroll
            for (int j = 0; j < 4; ++j) { const u32x2 qa = rA[64 * j], qb = rB[64 * j]; ha[j] = (f32x4){bflo(qa.x), bfhi(qa.x), bflo(qa.y), bfhi(qa.y)}; hb[j] = (f32x4){bflo(qb.x), bfhi(qb.x), bflo(qb.y), bfhi(qb.y)}; }
        } else {
            const f32x4* rA = (const f32x4*)((const float*)resid_ + (size_t)mA * D_MODEL) + lane; const f32x4* rB = (const f32x4*)((const float*)resid_ + (size_t)mB * D_MODEL) + lane;
#pragma unroll
            for (int j = 0; j < 4; ++j) { ha[j] = rA[64 * j]; hb[j] = rB[64 * j]; }
        }
        f32x4 va[4], vb[4]; float sa = 0.f, sb = 0.f;
#pragma unroll
        for (int j = 0; j < 4; ++j) { va[j] = (f32x4){bflo(pa[j].x), bfhi(pa[j].x), bflo(pa[j].y), bfhi(pa[j].y)}; vb[j] = (f32x4){bflo(pb[j].x), bfhi(pb[j].x), bflo(pb[j].y), bfhi(pb[j].y)};
            sa += (va[j].x * va[j].x + va[j].y * va[j].y) + (va[j].z * va[j].z + va[j].w * va[j].w); sb += (vb[j].x * vb[j].x + vb[j].y * vb[j].y) + (vb[j].z * vb[j].z + vb[j].w * vb[j].w); }
        const float ra = 1.f / sqrtf(wave_sum(sa) * (1.f / D_MODEL) + NORM_EPS), rb = 1.f / sqrtf(wave_sum(sb) * (1.f / D_MODEL) + NORM_EPS);
        float s2a = 0.f, s2b = 0.f;
#pragma unroll
        for (int j = 0; j < 4; ++j) { const f32x4 g = ((const f32x4*)w_post)[lane + 64 * j]; ha[j] = ha[j] + va[j] * ra * g; hb[j] = hb[j] + vb[j] * rb * g;
            s2a += (ha[j].x * ha[j].x + ha[j].y * ha[j].y) + (ha[j].z * ha[j].z + ha[j].w * ha[j].w); s2b += (hb[j].x * hb[j].x + hb[j].y * hb[j].y) + (hb[j].z * hb[j].z + hb[j].w * hb[j].w); }
        if (OUT_BF16) {
            u32x2* hoA = (u32x2*)((bf16_t*)hout_ + (size_t)mA * D_MODEL) + lane; u32x2* hoB = (u32x2*)((bf16_t*)hout_ + (size_t)mB * D_MODEL) + lane;
#pragma unroll
            for (int j = 0; j < 4; ++j) { u32x2 o; o.x = pk2(ha[j].x, ha[j].y); o.y = pk2(ha[j].z, ha[j].w); hoA[64 * j] = o; if (two) { o.x = pk2(hb[j].x, hb[j].y); o.y = pk2(hb[j].z, hb[j].w); hoB[64 * j] = o; } }
        } else {
            f32x4* hoA = (f32x4*)((float*)hout_ + (size_t)mA * D_MODEL) + lane; f32x4* hoB = (f32x4*)((float*)hout_ + (size_t)mB * D_MODEL) + lane;
#pragma unroll
            for (int j = 0; j < 4; ++j) { hoA[64 * j] = ha[j]; if (two) hoB[64 * j] = hb[j]; }
        }
        if (w_next) {
            const float qa = 1.f / sqrtf(wave_sum(s2a) * (1.f / D_MODEL) + NORM_EPS), qb = 1.f / sqrtf(wave_sum(s2b) * (1.f / D_MODEL) + NORM_EPS);
            unsigned long long* oA = (unsigned long long*)(xn + (size_t)mA * D_MODEL) + lane; unsigned long long* oB = (unsigned long long*)(xn + (size_t)mB * D_MODEL) + lane;
#pragma unroll
            for (int j = 0; j < 4; ++j) { const f32x4 g = ((const f32x4*)w_next)[lane + 64 * j];
                oA[64 * j] = (unsigned long long)pk2(ha[j].x * qa * g.x, ha[j].y * qa * g.y) | ((unsigned long long)pk2(ha[j].z * qa * g.z, ha[j].w * qa * g.w) << 32);
                if (two) oB[64 * j] = (unsigned long long)pk2(hb[j].x * qb * g.x, hb[j].y * qb * g.y) | ((unsigned long long)pk2(hb[j].z * qb * g.z, hb[j].w * qb * g.w) << 32); }
        }
    }
}
constexpr size_t B1_ACMPK = 128 * MiB, B1_ACMPV = 144 * MiB, B1_KS = 160 * MiB, B1_VST = 168 * MiB, B1_KW = 176 * MiB, B1_VWT = 184 * MiB, B1_QR = 192 * MiB;
constexpr size_t R2_HCMP = 0, R2_KC = 8 * MiB, R2_VCT = 9 * MiB, R2_SEL = 12 * MiB;
__device__ __constant__ float ROPE_INVF[8] = {1.0f, 0.1939227432012558f, 0.03760603070259094f, 0.007292664609849453f, 0.0014142135623842478f, 0.00027424818836152554f, 5.3182957344688475e-05f, 1.0313385246263351e-05f};

__device__ __forceinline__ void nsa_prep_phase(const Frame& F, const Args& a) {
    const bf16_t* F1 = (const bf16_t*)(F.ws + WS_BIG);
    bf16_t* ACMPK = (bf16_t*)(F.ws + WS_BIG + B1_ACMPK); bf16_t* ACMPV = (bf16_t*)(F.ws + WS_BIG + B1_ACMPV);
    bf16_t* KS = (bf16_t*)(F.ws + WS_BIG + B1_KS); bf16_t* VST = (bf16_t*)(F.ws + WS_BIG + B1_VST); bf16_t* KW = (bf16_t*)(F.ws + WS_BIG + B1_KW); bf16_t* VWT = (bf16_t*)(F.ws + WS_BIG + B1_VWT);
    bf16_t* QR = (bf16_t*)(F.ws + WS_BIG + B1_QR);
    const int* pos = (const int*)a.in[IN_POS];
    const int lane = F.lane, wave = F.wave, tid = F.tid;
    LAS unsigned char* Lvs = F.lds;
    LAS unsigned char* Lvw = F.lds + 16384;
    for (int u = F.bid; u < BATCH * 64; u += F.G) {
        const int b = u >> 6, blk = u & 63;
#pragma unroll 1
        for (int tt = 0; tt < 8; ++tt) {
            const int tl = 8 * wave + tt, t = blk * 64 + tl; const size_t m = (size_t)b * SEQ + t;
            const float p = (float)pos[m];
            const float ang = p * ROPE_INVF[lane & 7];
            const float cs = __cosf(ang), sn = __sinf(ang);
            const bf16_t* row = F1 + m * F1_LD;
            { const int hh = lane >> 2, qd = lane & 3; const u32x4 v0 = *(const u32x4*)(row + hh * 64 + qd * 16), v1 = *(const u32x4*)(row + hh * 64 + qd * 16 + 8);
              u32x4 o0 = v0, o1 = v1;
              float x1[8], x2[8], c8[8], s8[8];
#pragma unroll
              for (int i = 0; i < 8; ++i) { c8[i] = __shfl(cs, i); s8[i] = __shfl(sn, i); }
              if (qd == 0) {
                  x1[0] = bflo(v0.x); x1[1] = bfhi(v0.x); x1[2] = bflo(v0.y); x1[3] = bfhi(v0.y); x1[4] = bflo(v0.z); x1[5] = bfhi(v0.z); x1[6] = bflo(v0.w); x1[7] = bfhi(v0.w);
                  x2[0] = bflo(v1.x); x2[1] = bfhi(v1.x); x2[2] = bflo(v1.y); x2[3] = bfhi(v1.y); x2[4] = bflo(v1.z); x2[5] = bfhi(v1.z); x2[6] = bflo(v1.w); x2[7] = bfhi(v1.w);
                  float y1[8], y2[8];
#pragma unroll
                  for (int i = 0; i < 8; ++i) { y1[i] = x1[i] * c8[i] - x2[i] * s8[i]; y2[i] = x2[i] * c8[i] + x1[i] * s8[i]; }
                  o0.x = pk2(y1[0], y1[1]); o0.y = pk2(y1[2], y1[3]); o0.z = pk2(y1[4], y1[5]); o0.w = pk2(y1[6], y1[7]);
                  o1.x = pk2(y2[0], y2[1]); o1.y = pk2(y2[2], y2[3]); o1.z = pk2(y2[4], y2[5]); o1.w = pk2(y2[6], y2[7]); }
              *(u32x4*)(QR + m * 1024 + hh * 64 + qd * 16) = o0; *(u32x4*)(QR + m * 1024 + hh * 64 + qd * 16 + 8) = o1;
            }
            const int g = lane >> 5, d = 2 * (lane & 31); const int bg = b * 2 + g;
            const unsigned kc = *(const unsigned*)(row + 1024 + 0 * 128 + g * 64 + d), vc = *(const unsigned*)(row + 1024 + 1 * 128 + g * 64 + d);
            unsigned ks = *(const unsigned*)(row + 1024 + 2 * 128 + g * 64 + d); const unsigned vs = *(const unsigned*)(row + 1024 + 3 * 128 + g * 64 + d);
            unsigned kw = *(const unsigned*)(row + 1024 + 4 * 128 + g * 64 + d); const unsigned vw = *(const unsigned*)(row + 1024 + 5 * 128 + g * 64 + d);
            {
              const int l5 = lane & 31; const bool x1role = l5 < 4; const int i0 = 2 * (l5 & 3);
              const float c0 = __shfl(cs, i0), c1 = __shfl(cs, i0 + 1), s0 = __shfl(sn, i0), s1 = __shfl(sn, i0 + 1);
              const unsigned oks = __shfl_xor(ks, 4), okw = __shfl_xor(kw, 4);
              if (l5 < 8) { const float sg = x1role ? -1.f : 1.f;
                  ks = pk2(bflo(ks) * c0 + sg * bflo(oks) * s0, bfhi(ks) * c1 + sg * bfhi(oks) * s1);
                  kw = pk2(bflo(kw) * c0 + sg * bflo(okw) * s0, bfhi(kw) * c1 + sg * bfhi(okw) * s1); } }
            *(unsigned*)(KS + ((size_t)bg * SEQ + t) * 64 + d) = ks; *(unsigned*)(KW + ((size_t)bg * SEQ + t) * 64 + d) = kw;
            *(LAS unsigned*)(Lvs + tl * 256 + lane * 4) = vs; *(LAS unsigned*)(Lvw + tl * 256 + lane * 4) = vw;
            {
              const int i0 = t >> 4, s0 = t & 15;
              const float* pek = a.in[IN_NPEK]; const float* pev = a.in[IN_NPEV];
              if (i0 < 255) { *(unsigned*)(ACMPK + ((size_t)bg * 256 + i0) * 2048 + s0 * 64 + d) = pk2(bflo(kc) + pek[s0 * 64 + d], bfhi(kc) + pek[s0 * 64 + d + 1]);
                              *(unsigned*)(ACMPV + ((size_t)bg * 256 + i0) * 2048 + s0 * 64 + d) = pk2(bflo(vc) + pev[s0 * 64 + d], bfhi(vc) + pev[s0 * 64 + d + 1]); }
              if (i0 >= 1) { const int s1 = 16 + s0;
                              *(unsigned*)(ACMPK + ((size_t)bg * 256 + i0 - 1) * 2048 + s1 * 64 + d) = pk2(bflo(kc) + pek[s1 * 64 + d], bfhi(kc) + pek[s1 * 64 + d + 1]);
                              *(unsigned*)(ACMPV + ((size_t)bg * 256 + i0 - 1) * 2048 + s1 * 64 + d) = pk2(bflo(vc) + pev[s1 * 64 + d], bfhi(vc) + pev[s1 * 64 + d + 1]); }
            }
        }
        if (blk == 63) {
            for (int i = tid; i < 2 * 2048 / 8; i += NTHREADS) { const int g = i >> 8, o = (i & 255) * 8;
                *(u32x4*)(ACMPK + ((size_t)(b * 2 + g) * 256 + 255) * 2048 + o) = (u32x4){0u, 0u, 0u, 0u}; *(u32x4*)(ACMPV + ((size_t)(b * 2 + g) * 256 + 255) * 2048 + o) = (u32x4){0u, 0u, 0u, 0u}; }
        }
        __syncthreads();
        if (tid < 256) { const int which = tid >> 7, gd = tid & 127, g = gd >> 6, d = gd & 63; LAS unsigned char* Lv = which ? Lvw : Lvs;
            bf16_t* dst = (which ? VWT : VST) + (((size_t)(b * 2 + g) * 64 + blk) * 64 + d) * 64;
#pragma unroll
            for (int q8 = 0; q8 < 8; ++q8) { unsigned short e[8];
#pragma unroll
                for (int k = 0; k < 8; ++k) e[k] = *(const LAS bf16_t*)(Lv + (8 * q8 + k) * 256 + gd * 2);
                u32x4 o; o.x = e[0] | ((unsigned)e[1] << 16); o.y = e[2] | ((unsigned)e[3] << 16); o.z = e[4] | ((unsigned)e[5] << 16); o.w = e[6] | ((unsigned)e[7] << 16);
                *(u32x4*)(dst + 8 * q8) = o; } }
        __syncthreads();
    }
}

__device__ __forceinline__ void nsa_cmp2_phase(const Frame& F, const Args& a) {
    const bf16_t* HC = (const bf16_t*)((unsigned char*)a.out + R2_HCMP); bf16_t* KC = (bf16_t*)((unsigned char*)a.out + R2_KC); bf16_t* VCT = (bf16_t*)((unsigned char*)a.out + R2_VCT);
    const int* pos = (const int*)a.in[IN_POS];
    const int gw = F.bid * NWAVES + F.wave, NGW = F.G * NWAVES, lane = F.lane, fr = lane & 15, fq = lane >> 4;
    for (int it = gw; it < 512; it += NGW) {
        const int which = it >> 8, rt = it & 255;
        const bf16_t* A = HC + ((size_t)which * 4096 + 16 * rt) * 256; const bf16_t* Bt = (const bf16_t*)(F.ws + (which ? WS_W_C2V : WS_W_C2K));
        f32x4 c[4];
#pragma unroll
        for (int nt = 0; nt < 4; ++nt) c[nt] = (f32x4){0.f, 0.f, 0.f, 0.f};
#pragma unroll
        for (int ks = 0; ks < 8; ++ks) { const bf16x8 af = *(const bf16x8*)(A + fr * 256 + 32 * ks + 8 * fq);
#pragma unroll
            for (int nt = 0; nt < 4; ++nt) { const bf16x8 bf = *(const bf16x8*)(Bt + (16 * nt + fr) * 256 + 32 * ks + 8 * fq); c[nt] = MFMA16(af, bf, c[nt]); } }
        const int bg = rt >> 4, b = bg >> 1;
        if (which == 0) {
#pragma unroll
            for (int r = 0; r < 4; ++r) { const int i = (16 * rt + 4 * fq + r) & 255; int pi = 31 + 16 * i; if (pi > SEQ - 1) pi = SEQ - 1;
                const float ang = (float)pos[(size_t)b * SEQ + pi] * ROPE_INVF[fr & 7]; const float cs = __cosf(ang), sn = __sinf(ang);
                const float own = c[0][r], oth = __shfl_xor(own, 8);
                c[0][r] = (fr < 8) ? own * cs - oth * sn : own * cs + oth * sn;
#pragma unroll
                for (int nt = 0; nt < 4; ++nt) KC[((size_t)bg * 256 + i) * 64 + 16 * nt + fr] = (bf16_t)f2bf(c[nt][r]); }
        } else {
            const int i0 = (16 * rt + 4 * fq) & 255;
#pragma unroll
            for (int nt = 0; nt < 4; ++nt) { u32x2 p; p.x = pk2(c[nt][0], c[nt][1]); p.y = pk2(c[nt][2], c[nt][3]); *(u32x2*)(VCT + ((size_t)bg * 64 + 16 * nt + fr) * 256 + i0) = p; }
        }
    }
}
constexpr int CA_KC = 0, CA_KC_PITCH = 144;
constexpr int CA_VT = 36864, CA_VT_PITCH = 528;
__device__ __forceinline__ void nsa_cmp_attn_phase(const Frame& F, const Args& a) {
    const bf16_t* F1 = (const bf16_t*)(F.ws + WS_BIG); const bf16_t* QR = (const bf16_t*)(F.ws + WS_BIG + B1_QR);
    const bf16_t* KC = (const bf16_t*)((unsigned char*)a.out + R2_KC); const bf16_t* VCT = (const bf16_t*)((unsigned char*)a.out + R2_VCT);
    unsigned long long* SEL = (unsigned long long*)((unsigned char*)a.out + R2_SEL); bf16_t* ONSA = (bf16_t*)(F.ws + WS_XN);
    const int lane = F.lane, wave = F.wave, tid = F.tid, fr = lane & 15, fq = lane >> 4;
    LAS unsigned char* L = F.lds;
    for (int bgk = F.bid; bgk < 256; bgk += F.G) {
        const int bg = bgk & 15, kq = bgk >> 4, b = bg >> 1, g = bg & 1;
        __syncthreads();
        for (int i = tid; i < 256 * 8; i += NTHREADS) { const int key = i >> 3, ch = i & 7; *(LAS u32x4*)(L + CA_KC + key * CA_KC_PITCH + ch * 16) = *(const u32x4*)(KC + ((size_t)bg * 256 + key) * 64 + ch * 8); }
        for (int i = tid; i < 64 * 32; i += NTHREADS) { const int d = i >> 5, ch = i & 31; *(LAS u32x4*)(L + CA_VT + d * CA_VT_PITCH + ch * 16) = *(const u32x4*)(VCT + ((size_t)bg * 64 + d) * 256 + ch * 8); }
        __syncthreads();
#pragma unroll 1
        for (int rep = 0; rep < 2; ++rep) {
            const int idx = wave * 16 + kq; const int tt = rep == 0 ? idx : 255 - idx;
            const int t0 = 16 * tt, t = t0 + fr; const size_t m = (size_t)b * SEQ + t;
            const int nk = tt;
            const int nkt = (nk + 15) >> 4;
            float iaA[16], iaB[16];
#pragma unroll
            for (int kt = 0; kt < 16; ++kt) { iaA[kt] = 0.f; iaB[kt] = 0.f; }
#pragma unroll 1
            for (int hh = 0; hh < 8; ++hh) {
                const int H = g * 8 + hh;
                const bf16x8 q0 = *(const bf16x8*)(QR + m * 1024 + H * 64 + 8 * fq), q1 = *(const bf16x8*)(QR + m * 1024 + H * 64 + 32 + 8 * fq);
                float mrun = -INFINITY, lrun = 0.f;
#pragma unroll 1
                for (int kt = 0; kt < nkt; ++kt) {
                    const bf16x8 k0 = *(const LAS bf16x8*)(L + CA_KC + (16 * kt + fr) * CA_KC_PITCH + 16 * fq), k1 = *(const LAS bf16x8*)(L + CA_KC + (16 * kt + fr) * CA_KC_PITCH + 64 + 16 * fq);
                    f32x4 sv = (f32x4){0.f, 0.f, 0.f, 0.f}; sv = MFMA16(k0, q0, sv); sv = MFMA16(k1, q1, sv);
                    float tm = -INFINITY;
#pragma unroll
                    for (int r = 0; r < 4; ++r) { const int key = 16 * kt + 4 * fq + r; const bool vis = (16 * key + 31) <= t; sv[r] = vis ? sv[r] * 0.125f : -INFINITY; tm = fmaxf(tm, sv[r]); }
                    const float mn = fmaxf(mrun, tm);
                    if (mn != -INFINITY) { float add = 0.f;
#pragma unroll
                        for (int r = 0; r < 4; ++r) add += (sv[r] == -INFINITY) ? 0.f : __expf(sv[r] - mn);
                        lrun = lrun * ((mrun == -INFINITY) ? 0.f : __expf(mrun - mn)) + add; mrun = mn; }
                }
                float mx = fmaxf(mrun, __shfl_xor(mrun, 16)); mx = fmaxf(mx, __shfl_xor(mx, 32));
                const float mref = (mx == -INFINITY) ? 0.f : mx;
                float sum = (mrun == -INFINITY) ? 0.f : lrun * __expf(mrun - mref);
                sum += __shfl_xor(sum, 16); sum += __shfl_xor(sum, 32);
                const float inv = 1.f / fmaxf(sum, 1e-30f);
                f32x4 o[4];
#pragma unroll
                for (int dt = 0; dt < 4; ++dt) o[dt] = (f32x4){0.f, 0.f, 0.f, 0.f};
#pragma unroll
                for (int ks = 0; ks < 8; ++ks) if (2 * ks < nkt) {
                    float p[8];
#pragma unroll
                    for (int half = 0; half < 2; ++half) { const int kt = 2 * ks + half;
                        const bf16x8 k0 = *(const LAS bf16x8*)(L + CA_KC + (16 * kt + fr) * CA_KC_PITCH + 16 * fq), k1 = *(const LAS bf16x8*)(L + CA_KC + (16 * kt + fr) * CA_KC_PITCH + 64 + 16 * fq);
                        f32x4 sv = (f32x4){0.f, 0.f, 0.f, 0.f}; sv = MFMA16(k0, q0, sv); sv = MFMA16(k1, q1, sv);
#pragma unroll
                        for (int r = 0; r < 4; ++r) { const int key = 16 * kt + 4 * fq + r; const bool vis = (16 * key + 31) <= t; p[4 * half + r] = vis ? __expf(sv[r] * 0.125f - mref) * inv : 0.f; } }
                    iaA[2 * ks] += (p[0] + p[1]) + (p[2] + 0.5f * p[3]); iaB[2 * ks] += p[3]; iaA[2 * ks + 1] += (p[4] + p[5]) + (p[6] + 0.5f * p[7]); iaB[2 * ks + 1] += p[7];
                    u32x4 pw; pw.x = pk2(p[0], p[1]); pw.y = pk2(p[2], p[3]); pw.z = pk2(p[4], p[5]); pw.w = pk2(p[6], p[7]);
                    const bf16x8 pb = __builtin_bit_cast(bf16x8, pw);
#pragma unroll
                    for (int dt = 0; dt < 4; ++dt) { const u32x2 v0 = *(const LAS u32x2*)(L + CA_VT + (16 * dt + fr) * CA_VT_PITCH + (32 * ks + 4 * fq) * 2), v1 = *(const LAS u32x2*)(L + CA_VT + (16 * dt + fr) * CA_VT_PITCH + (32 * ks + 16 + 4 * fq) * 2);
                        u32x4 vw; vw.x = v0.x; vw.y = v0.y; vw.z = v1.x; vw.w = v1.y; o[dt] = MFMA16(__builtin_bit_cast(bf16x8, vw), pb, o[dt]); }
                    __builtin_amdgcn_sched_barrier(0); }
                const float gate = sigmoidf_(bf2f(F1[m * F1_LD + 1792 + H * 3 + 0]));
#pragma unroll
                for (int dt = 0; dt < 4; ++dt) { u32x2 w; w.x = pk2(o[dt][0] * gate, o[dt][1] * gate); w.y = pk2(o[dt][2] * gate, o[dt][3] * gate); *(u32x2*)(ONSA + m * 1024 + H * 64 + 16 * dt + 4 * fq) = w; }
            }
            float imp[16];
#pragma unroll
            for (int kt = 0; kt < 16; ++kt) { const float up = __shfl(iaB[kt], (lane + 48) & 63); imp[kt] = up; }
            { float carry = 0.f;
#pragma unroll
              for (int kt = 0; kt < 16; ++kt) { const float prev3 = (fq == 0) ? carry : imp[kt]; carry = imp[kt]; imp[kt] = 0.5f * prev3 + iaA[kt]; } }
            const int cur = t >> 6;
            unsigned long long mask = 0ull;
            if (t0 < 1024) {
#pragma unroll
                for (int kt = 0; kt < 16; ++kt) { const int j = 4 * kt + fq; if (j <= cur) mask |= 1ull << j; }
            } else {
                float cv[16];
#pragma unroll
                for (int kt = 0; kt < 16; ++kt) { const int j = 4 * kt + fq; const bool forced = (j == 0) || (j == cur) || (j == cur - 1); cv[kt] = (j <= cur && !forced) ? imp[kt] : -INFINITY; }
                int rank[16];
#pragma unroll
                for (int kt = 0; kt < 16; ++kt) rank[kt] = 0;
#pragma unroll 1
                for (int f2 = 0; f2 < 4; ++f2) {
#pragma unroll
                    for (int k2 = 0; k2 < 16; ++k2) { const float ov = __shfl(cv[k2], fr + 16 * f2); const int j2 = 4 * k2 + f2;
#pragma unroll
                        for (int kt = 0; kt < 16; ++kt) { const int j = 4 * kt + fq; rank[kt] += (ov > cv[kt] || (ov == cv[kt] && j2 < j)) ? 1 : 0; } } }
#pragma unroll
                for (int kt = 0; kt < 16; ++kt) { const int j = 4 * kt + fq; const bool forced = (j == 0) || (j == cur) || (j == cur - 1);
                    if (forced || (cv[kt] != -INFINITY && rank[kt] < SEL_TOPN - 3)) mask |= 1ull << j; }
            }
            { unsigned lo = (unsigned)mask, hi = (unsigned)(mask >> 32);
              lo |= __shfl_xor(lo, 16); hi |= __shfl_xor(hi, 16); lo |= __shfl_xor(lo, 32); hi |= __shfl_xor(hi, 32);
              if (fq == 0) SEL[(size_t)bg * SEQ + t] = ((unsigned long long)hi << 32) | lo; }
        }
    }
}

constexpr int SA_K = 0, SA_V = 8192, SA_BUF = 16384, SA_NS = 8, SA_GB = 4;
#define SA_BAR() do { asm volatile("s_waitcnt lgkmcnt(0)" ::: "memory"); __builtin_amdgcn_s_barrier(); asm volatile("" ::: "memory"); } while (0)
template <int MODE  >
__device__ __forceinline__ void nsa_attn_pass(const Frame& F, const bf16_t* Kg, const bf16_t* Vtg, const bf16x8 (&qf)[2][2], const unsigned long long (&selm)[2], int tq[2], int bg, int qb, f32x4 (&outacc)[2][4], const float (&gate)[2]) {
    const int lane = F.lane, tid = F.tid, fr = lane & 15, fq = lane >> 4;
    LAS unsigned char* L = F.lds;
    const int j0 = (MODE == 0) ? 0 : (qb - 8 > 0 ? qb - 8 : 0), j1 = qb;
    f32x4 O[2][4]; float mrun[2], lrun[2];
#pragma unroll
    for (int i = 0; i < 2; ++i) { mrun[i] = -INFINITY; lrun[i] = 0.f;
#pragma unroll
        for (int dt = 0; dt < 4; ++dt) O[i][dt] = (f32x4){0.f, 0.f, 0.f, 0.f}; }
    const int wv_ = F.wave;
#define SA_ISSUE(jt_) do { LAS unsigned char* slot_ = L + (((jt_) - j0) % SA_NS) * SA_BUF; \
        _Pragma("unroll") for (int i_ = 0; i_ < 2; ++i_) { const int pc_ = 2 * wv_ + i_, P_ = pc_ & 7; const int row_ = 8 * P_ + (lane >> 3), c16_ = (lane & 7) ^ ((row_ >> 1) & 7); \
            const bf16_t* src_ = (pc_ < 8) ? Kg + ((size_t)bg * SEQ + (size_t)(jt_) * 64) * 64 + row_ * 64 + c16_ * 8 : Vtg + ((size_t)bg * 64 + (jt_)) * 4096 + row_ * 64 + c16_ * 8; \
            __builtin_amdgcn_global_load_lds((const unsigned*)src_, (LAS unsigned*)(slot_ + (pc_ < 8 ? SA_K : SA_V) + P_ * 1024), 16, 0, 0); } } while (0)
    __syncthreads();
#pragma unroll 1
    for (int d_ = 0; d_ < 2 * SA_GB; ++d_) if (j0 + d_ <= j1) SA_ISSUE(j0 + d_);
    if (j0 + 2 * SA_GB - 1 <= j1) asm volatile("s_waitcnt vmcnt(8)" ::: "memory");
    else asm volatile("s_waitcnt vmcnt(0)" ::: "memory");
    SA_BAR();
#pragma unroll 1
    for (int jg = j0; jg <= j1; jg += SA_GB) {
#pragma unroll 1
      for (int j = jg; j < jg + SA_GB && j <= j1; ++j) {
        LAS unsigned char* Lb = L + ((j - j0) % SA_NS) * SA_BUF;
        const bool edge = (j == j1) || (MODE == 1 && j == qb - 8);
#pragma unroll
        for (int i = 0; i < 2; ++i) {
            const int t = tq[i];
            bool colok;
            if (MODE == 0) colok = (selm[i] >> j) & 1ull; else colok = true;
            if (__ballot(colok) == 0ull) continue;
            f32x4 s[4];
#pragma unroll
            for (int kt = 0; kt < 4; ++kt) { s[kt] = (f32x4){0.f, 0.f, 0.f, 0.f};
                const int key_ = 16 * kt + fr, sw_ = (key_ >> 1) & 7;
                const bf16x8 k0 = *(const LAS bf16x8*)(Lb + SA_K + key_ * 128 + ((fq ^ sw_) * 16)), k1 = *(const LAS bf16x8*)(Lb + SA_K + key_ * 128 + (((4 + fq) ^ sw_) * 16));
                s[kt] = MFMA16(k0, qf[i][0], s[kt]); s[kt] = MFMA16(k1, qf[i][1], s[kt]); }
            constexpr float SC = 0.125f * 1.4426950408889634f;
            float mx = -INFINITY;
            if (edge) {
#pragma unroll
                for (int kt = 0; kt < 4; ++kt)
#pragma unroll
                    for (int r = 0; r < 4; ++r) { const int kpos = 64 * j + 16 * kt + 4 * fq + r; bool vis = (kpos <= t); if (MODE == 1) vis = vis && (kpos > t - WINDOW);
                        s[kt][r] = vis ? s[kt][r] : -INFINITY; mx = fmaxf(mx, s[kt][r]); }
            } else {
#pragma unroll
                for (int kt = 0; kt < 4; ++kt) mx = fmaxf(fmaxf(mx, fmaxf(s[kt][0], s[kt][1])), fmaxf(s[kt][2], s[kt][3]));
            }
            mx = colok ? mx * SC : -INFINITY;
            mx = fmaxf(mx, __shfl_xor(mx, 16)); mx = fmaxf(mx, __shfl_xor(mx, 32));
            const float mnew = fmaxf(mrun[i], mx);
            const float alpha = (mrun[i] == -INFINITY) ? 0.f : __builtin_amdgcn_exp2f(mrun[i] - mnew);
            const float msub = (colok && mnew != -INFINITY) ? mnew : INFINITY;
            mrun[i] = mnew;
            float p[16]; float psum = 0.f;
#pragma unroll
            for (int kt = 0; kt < 4; ++kt)
#pragma unroll
                for (int r = 0; r < 4; ++r) { const float e = __builtin_amdgcn_exp2f(__builtin_fmaf(s[kt][r], SC, -msub)); p[4 * kt + r] = e; psum += e; }
            lrun[i] = lrun[i] * alpha + psum;
#pragma unroll
            for (int dt = 0; dt < 4; ++dt) O[i][dt] = O[i][dt] * alpha;
#pragma unroll
            for (int ks = 0; ks < 2; ++ks) { u32x4 pw; pw.x = pk2(p[8 * ks], p[8 * ks + 1]); pw.y = pk2(p[8 * ks + 2], p[8 * ks + 3]); pw.z = pk2(p[8 * ks + 4], p[8 * ks + 5]); pw.w = pk2(p[8 * ks + 6], p[8 * ks + 7]);
                const bf16x8 pb = __builtin_bit_cast(bf16x8, pw);
#pragma unroll
                for (int dt = 0; dt < 4; ++dt) { const int d_ = 16 * dt + fr, sw_ = (d_ >> 1) & 7, c_ = 4 * ks + (fq >> 1);
                    const u32x2 v0 = *(const LAS u32x2*)(Lb + SA_V + d_ * 128 + ((c_ ^ sw_) * 16) + 8 * (fq & 1)), v1 = *(const LAS u32x2*)(Lb + SA_V + d_ * 128 + (((c_ + 2) ^ sw_) * 16) + 8 * (fq & 1));
                    u32x4 vw; vw.x = v0.x; vw.y = v0.y; vw.z = v1.x; vw.w = v1.y; O[i][dt] = MFMA16(__builtin_bit_cast(bf16x8, vw), pb, O[i][dt]); } }
        }
      }
      asm volatile("s_waitcnt vmcnt(0)" ::: "memory");
      SA_BAR();
#pragma unroll 1
      for (int d_ = 0; d_ < SA_GB; ++d_) if (jg + 2 * SA_GB + d_ <= j1) SA_ISSUE(jg + 2 * SA_GB + d_);
    }
#undef SA_ISSUE
#pragma unroll
    for (int i = 0; i < 2; ++i) { float l = lrun[i]; l += __shfl_xor(l, 16); l += __shfl_xor(l, 32); const float sc = gate[i] / fmaxf(l, 1e-30f);
#pragma unroll
        for (int dt = 0; dt < 4; ++dt) outacc[i][dt] += O[i][dt] * sc; }
}
__device__ __forceinline__ void nsa_attn_phase(const Frame& F, const Args& a, bool do_store = true) {
    const bf16_t* F1 = (const bf16_t*)(F.ws + WS_BIG); const bf16_t* QR = (const bf16_t*)(F.ws + WS_BIG + B1_QR);
    const bf16_t* KS = (const bf16_t*)(F.ws + WS_BIG + B1_KS); const bf16_t* VST = (const bf16_t*)(F.ws + WS_BIG + B1_VST); const bf16_t* KW = (const bf16_t*)(F.ws + WS_BIG + B1_KW); const bf16_t* VWT = (const bf16_t*)(F.ws + WS_BIG + B1_VWT);
    const unsigned long long* SEL = (const unsigned long long*)((unsigned char*)a.out + R2_SEL); bf16_t* ONSA = (bf16_t*)(F.ws + WS_XN);
    const int lane = F.lane, wave = F.wave, fr = lane & 15, fq = lane >> 4;
    for (int c = F.bid; c < 256; c += F.G) {
        const int bg = c & 15, kq = c >> 4, b = bg >> 1, g = bg & 1;
#pragma unroll 1
        for (int rep = 0; rep < 8; ++rep) {
            const int hb = 16 * rep + ((rep & 1) ? 15 - kq : kq);
            const int qb = hb >> 1;
            int tq[2]; bf16x8 qf[2][2]; unsigned long long selm[2]; float gs[2], gw_[2]; f32x4 outacc[2][4]; size_t mrow[2]; int Hh;
            Hh = g * 8 + (fr & 7);
#pragma unroll
            for (int i = 0; i < 2; ++i) { tq[i] = 32 * hb + 4 * wave + 2 * i + (fr >> 3); mrow[i] = (size_t)b * SEQ + tq[i];
                qf[i][0] = *(const bf16x8*)(QR + mrow[i] * 1024 + Hh * 64 + 8 * fq); qf[i][1] = *(const bf16x8*)(QR + mrow[i] * 1024 + Hh * 64 + 32 + 8 * fq);
                selm[i] = SEL[(size_t)bg * SEQ + tq[i]];
                gs[i] = sigmoidf_(bf2f(F1[mrow[i] * F1_LD + 1792 + Hh * 3 + 1])); gw_[i] = sigmoidf_(bf2f(F1[mrow[i] * F1_LD + 1792 + Hh * 3 + 2]));
#pragma unroll
                for (int dt = 0; dt < 4; ++dt) outacc[i][dt] = (f32x4){0.f, 0.f, 0.f, 0.f}; }
            nsa_attn_pass<0>(F, KS, VST, qf, selm, tq, bg, qb, outacc, gs);
            nsa_attn_pass<1>(F, KW, VWT, qf, selm, tq, bg, qb, outacc, gw_);
            if (do_store)
#pragma unroll
            for (int i = 0; i < 2; ++i)
#pragma unroll
                for (int dt = 0; dt < 4; ++dt) { bf16_t* p = ONSA + mrow[i] * 1024 + Hh * 64 + 16 * dt + 4 * fq; const u32x2 old = *(const u32x2*)p;
                    u32x2 w; w.x = pk2(bflo(old.x) + outacc[i][dt][0], bfhi(old.x) + outacc[i][dt][1]); w.y = pk2(bflo(old.y) + outacc[i][dt][2], bfhi(old.y) + outacc[i][dt][3]); *(u32x2*)p = w; }
        }
    }
}
__device__ __forceinline__ void chk_gdn(const Frame& F, const Args& a, int b, int h, int ntok, unsigned* cnt) {
    const bf16_t* F0 = (const bf16_t*)(F.ws + WS_BIG); const bf16_t* OAB = (const bf16_t*)(F.ws + WS_XN);
    LAS float* S = (LAS float*)F.lds;
    LAS float* qkv = S + 16384;
    LAS float* kS = qkv + 384;
    LAS float* ov = kS + 128;
    const int tid = F.tid; const float* convw = a.in[IN_GCONV];

#pragma unroll 1
for (int i = tid; i < 16384; i += NTHREADS) S[i] = 0.f;
    __syncthreads();
    unsigned bad = 0;

#pragma unroll 1
for (int t = 0; t < ntok; ++t) {
        const size_t m = (size_t)b * SEQ + t;
        if (tid < 384) { const int X = tid >> 7, c = tid & 127, col = X * 512 + h * 128 + c; float acc = 0.f;

#pragma unroll 1
for (int i = 0; i < 4; ++i) if (t - 3 + i >= 0) acc += convw[i * 1536 + col] * bf2f(F0[(m - 3 + i) * F0_LD + col]);
            qkv[tid] = acc / (1.f + expf(-acc)); }
        __syncthreads();
        float sq = 0.f, sk = 0.f;
#pragma unroll 1
for (int i = 0; i < 128; ++i) { sq += qkv[i] * qkv[i]; sk += qkv[128 + i] * qkv[128 + i]; }
        const float rq = 1.f / sqrtf(sq + 1e-6f) / sqrtf(128.f), rk = 1.f / sqrtf(sk + 1e-6f);
        const float beta = 1.f / (1.f + expf(-bf2f(F0[m * F0_LD + F0_BA + h])));
        const float aa = bf2f(F0[m * F0_LD + F0_BA + 4 + h]) + a.in[IN_GDT][h];
        const float g = -expf(a.in[IN_GALOG][h]) * (aa > 20.f ? aa : log1pf(expf(aa))); const float eg = expf(g);
        if (tid < 128) { float s = 0.f;
#pragma unroll 1
for (int i = 0; i < 128; ++i) s += qkv[128 + i] * rk * S[i * 128 + tid]; kS[tid] = s; }
        __syncthreads();

#pragma unroll 1
for (int e = tid; e < 16384; e += NTHREADS) { const int i = e >> 7, j = e & 127; const float ki = qkv[128 + i] * rk;
            S[e] = eg * (S[e] - beta * ki * kS[j]) + beta * ki * qkv[256 + j]; }
        __syncthreads();
        if (tid < 128) { float s = 0.f;
#pragma unroll 1
for (int i = 0; i < 128; ++i) s += qkv[i] * rq * S[i * 128 + tid]; ov[tid] = s; }
        __syncthreads();
        if (tid < 128) { float ss = 0.f;
#pragma unroll 1
for (int i = 0; i < 128; ++i) ss += ov[i] * ov[i];
            const float rstd = 1.f / sqrtf(ss / 128.f + NORM_EPS); const float z = bf2f(F0[m * F0_LD + 1536 + h * 128 + tid]);
            const float ref = ov[tid] * rstd * a.in[IN_GNORM][tid] * (z / (1.f + expf(-z))); const float got = bf2f(OAB[m * 1024 + h * 128 + tid]);
            if (!(fabsf(got - ref) <= 0.04f + 0.04f * fabsf(ref))) bad++; }
        __syncthreads();
    }
    if (bad) atomicAdd(cnt, bad);
}
__device__ __forceinline__ void chk_rwkv(const Frame& F, const Args& a, int b, int h, int ntok, unsigned* cnt) {
    const bf16_t* F0 = (const bf16_t*)(F.ws + WS_BIG); const bf16_t* OAB = (const bf16_t*)(F.ws + WS_XN);
    LAS float* S = (LAS float*)F.lds;
    LAS float* xs = S + 4096;
    LAS float* op = xs + 448;
    const int tid = F.tid; unsigned bad = 0;

#pragma unroll 1
for (int i = tid; i < 4096; i += NTHREADS) S[i] = 0.f;
    __syncthreads();

#pragma unroll 1
for (int t = 0; t < ntok; ++t) {
        const size_t m = (size_t)b * SEQ + t;
        if (tid < 448) { int mi; if (tid < 192) mi = (tid >> 6) * 512 + h * 64 + (tid & 63); else mi = 1536 + (tid - 192);
            const float f = bf2f(F0[m * F0_LD + F0_RWKV + mi]); const float fp = t > 0 ? bf2f(F0[(m - 1) * F0_LD + F0_RWKV + mi]) : 0.f;
            xs[tid] = f + (fp - f) * a.in[IN_RMU][mi]; }
        __syncthreads();
        if (tid < 64) { const int hc = h * 64 + tid; float lw = a.in[IN_RW0][hc], la = a.in[IN_RA0][hc], gg = 0.f;

#pragma unroll 1
for (int j = 0; j < 64; ++j) { lw += tanhf(xs[192 + j]) * a.in[IN_RW2][j * 512 + hc]; la += xs[256 + j] * a.in[IN_RA2][j * 512 + hc]; }

#pragma unroll 1
for (int j = 0; j < 128; ++j) gg += (1.f / (1.f + expf(-xs[320 + j]))) * a.in[IN_RG2][j * 512 + hc];
            const float sp = (-lw > 20.f) ? -lw : log1pf(expf(-lw)); const float wlog = -sp - 0.5f;
            const float av = 1.f / (1.f + expf(-la));
            op[tid] = expf(-expf(wlog)); op[64 + tid] = xs[64 + tid] * a.in[IN_RKK][hc]; op[256 + tid] = av;
            op[192 + tid] = xs[64 + tid] * (1.f + (av - 1.f) * a.in[IN_RKA][hc]); op[320 + tid] = gg; }
        __syncthreads();
        float ss = 0.f;
#pragma unroll 1
for (int i = 0; i < 64; ++i) ss += op[64 + i] * op[64 + i];
        const float rinv = 1.f / sqrtf(ss + 1e-6f);
        float bon = 0.f;
#pragma unroll 1
for (int i = 0; i < 64; ++i) bon += xs[i] * op[192 + i] * a.in[IN_RRK][h * 64 + i];
        if (tid < 64) { float sa = 0.f;
#pragma unroll 1
for (int k = 0; k < 64; ++k) sa -= S[tid * 64 + k] * op[64 + k] * rinv;
            float y = 0.f; const float vv = xs[128 + tid];

#pragma unroll 1
for (int k = 0; k < 64; ++k) { const float kk = op[64 + k] * rinv; const float sn = S[tid * 64 + k] * op[k] + sa * kk * op[256 + k] + vv * op[192 + k]; S[tid * 64 + k] = sn; y += sn * xs[k]; }
            op[384 + tid] = y; }
        __syncthreads();
        if (tid < 64) { float mean = 0.f;
#pragma unroll 1
for (int i = 0; i < 64; ++i) mean += op[384 + i]; mean /= 64.f; float var = 0.f;
#pragma unroll 1
for (int i = 0; i < 64; ++i) { const float d = op[384 + i] - mean; var += d * d; } var /= 64.f;
            const int hc = h * 64 + tid;
            const float yn = (op[384 + tid] - mean) / sqrtf(var + RWKV_LN_EPS) * a.in[IN_RLNW][hc] + a.in[IN_RLNB][hc];
            const float ref = (yn + bon * xs[128 + tid]) * op[320 + tid]; const float got = bf2f(OAB[m * 1024 + 512 + hc]);
            if (!(fabsf(got - ref) <= 0.04f + 0.04f * fabsf(ref))) bad++; }
        __syncthreads();
    }
    if (bad) atomicAdd(cnt, bad);
}

__device__ __forceinline__ float chk_rope_val(const bf16_t* row, int base, int d, float posf) {
    if (d >= 16) return bf2f(row[base + d]);
    const int i = d & 7; const float ang = posf * ROPE_INVF[i]; const float cs = cosf(ang), sn = sinf(ang);
    const float x1 = bf2f(row[base + i]), x2 = bf2f(row[base + 8 + i]);
    return d < 8 ? x1 * cs - x2 * sn : x2 * cs + x1 * sn;
}
__device__ __forceinline__ void chk_nsa(const Frame& F, const Args& a, int b, int g, int t, unsigned* cnt) {
    const bf16_t* F1 = (const bf16_t*)(F.ws + WS_BIG); const bf16_t* ONSA = (const bf16_t*)(F.ws + WS_XN);
    const int* pos = (const int*)a.in[IN_POS];
    LAS float* kc = (LAS float*)F.lds;
    LAS float* vc = kc + 8192;
    LAS float* hb = vc + 8192;
    LAS float* sb = hb + 512;
    LAS float* red = sb + 4096;
    LAS float* qv = red + 512;
    LAS float* impv = qv + 64;
    LAS float* ocv = impv + 64;
    LAS float* misc = ocv + 512;
    LAS unsigned* selw = (LAS unsigned*)(misc + 8);
    const int tid = F.tid; const size_t mb = (size_t)b * SEQ; const size_t m = mb + t;
    const int nk = t >= 31 ? (t - 31) / 16 + 1 : 0;
    unsigned bad = 0;
#pragma unroll 1
    for (int i = 0; i < nk; ++i) {
        { const int path = tid >> 8, hid = tid & 255; const float* w1 = a.in[path ? IN_NW1V : IN_NW1K]; const float* pe = a.in[path ? IN_NPEV : IN_NPEK]; float acc = 0.f;
#pragma unroll 1
          for (int sl = 0; sl < 32; ++sl) { const bf16_t* row = F1 + (mb + 16 * i + sl) * F1_LD + 1024 + path * 128 + g * 64;
#pragma unroll 1
              for (int d = 0; d < 64; ++d) acc += (bf2f(row[d]) + pe[sl * 64 + d]) * w1[(size_t)(sl * 64 + d) * 256 + hid]; }
          hb[tid] = acc / (1.f + expf(-acc)); }
        __syncthreads();
        if (tid < 128) { const int path = tid >> 6, d = tid & 63; const float* w2 = a.in[path ? IN_NW2V : IN_NW2K]; float acc = 0.f;
#pragma unroll 1
            for (int hid = 0; hid < 256; ++hid) acc += hb[path * 256 + hid] * w2[hid * 64 + d];
            (path ? vc : kc)[i * 64 + d] = acc; }
        __syncthreads();
    }
    if (tid < nk * 8) { const int i = tid >> 3, dd = tid & 7; const float ang = (float)pos[mb + 31 + 16 * i] * ROPE_INVF[dd]; const float cs = cosf(ang), sn = sinf(ang);
        const float x1 = kc[i * 64 + dd], x2 = kc[i * 64 + 8 + dd]; kc[i * 64 + dd] = x1 * cs - x2 * sn; kc[i * 64 + 8 + dd] = x2 * cs + x1 * sn; }
    if (tid < 64) impv[tid] = 0.f;
    __syncthreads();
    const float posq = (float)pos[m];
#pragma unroll 1
    for (int hh = 0; hh < 8; ++hh) { const int H = g * 8 + hh;
        if (tid < 64) qv[tid] = chk_rope_val(F1 + m * F1_LD, H * 64, tid, posq) * 0.125f;
        __syncthreads();
        if (tid < nk) { float s = 0.f;
#pragma unroll 1
            for (int d = 0; d < 64; ++d) s += qv[d] * kc[tid * 64 + d]; sb[tid] = s; }
        __syncthreads();
        if (tid == 0) { float mx = -INFINITY;
#pragma unroll 1
            for (int i = 0; i < nk; ++i) mx = fmaxf(mx, sb[i]); float sum = 0.f;
#pragma unroll 1
            for (int i = 0; i < nk; ++i) sum += expf(sb[i] - mx); misc[0] = mx; misc[1] = fmaxf(sum, 1e-30f); }
        __syncthreads();
        if (tid < nk) sb[tid] = expf(sb[tid] - misc[0]) / misc[1];
        __syncthreads();
        if (tid < 64) { float o = 0.f;
#pragma unroll 1
            for (int i = 0; i < nk; ++i) o += sb[i] * vc[i * 64 + tid]; ocv[hh * 64 + tid] = o;
            float im = 0.f;
#pragma unroll 1
            for (int i = 4 * tid - 1; i <= 4 * tid + 3; ++i) if (i >= 0 && i < nk) im += sb[i] * ((i == 4 * tid - 1 || i == 4 * tid + 3) ? 0.5f : 1.f);
            impv[tid] += im; }
        __syncthreads();
    }
    if (tid == 0) { const int cur = t >> 6; unsigned lo = 0u, hi = 0u;
#pragma unroll 1
        for (int r = 0; r < 16; ++r) { int best = -1; float bv = 0.f;
#pragma unroll 1
            for (int j = 0; j < 64; ++j) { const bool taken = j < 32 ? ((lo >> j) & 1u) : ((hi >> (j - 32)) & 1u); if (taken) continue;
                const bool valid = j <= cur, forced = (j == 0) || (j == cur) || (j == cur - 1);
                const float sc = valid ? (forced ? INFINITY : impv[j]) : -INFINITY;
                if (best < 0 || sc > bv) { best = j; bv = sc; } }
            if (best < 32) lo |= 1u << best; else hi |= 1u << (best - 32); }
        selw[0] = lo; selw[1] = hi; }
    __syncthreads();
#pragma unroll 1
    for (int hh = 0; hh < 8; ++hh) { const int H = g * 8 + hh;
        if (tid < 64) qv[tid] = chk_rope_val(F1 + m * F1_LD, H * 64, tid, posq) * 0.125f;
        __syncthreads();
        float osw[2] = {0.f, 0.f};
#pragma unroll 1
        for (int br = 0; br < 2; ++br) {
            const int kbase = 1024 + (br == 0 ? 2 : 4) * 128 + g * 64, vbase = kbase + 128;
            float lmx = -INFINITY;
#pragma unroll 1
            for (int kp = tid; kp < 4096; kp += NTHREADS) { float s = -INFINITY; const int j = kp >> 6;
                bool vis = kp <= t; if (br == 0) vis = vis && (j < 32 ? ((selw[0] >> j) & 1u) : ((selw[1] >> (j - 32)) & 1u)); else vis = vis && (kp > t - WINDOW);
                if (vis) { s = 0.f; const float pk = (float)pos[mb + kp];
#pragma unroll 1
                    for (int d = 0; d < 64; ++d) s += qv[d] * chk_rope_val(F1 + (mb + kp) * F1_LD, kbase, d, pk); }
                sb[kp] = s; lmx = fmaxf(lmx, s); }
            red[tid] = lmx; __syncthreads();
            if (tid == 0) { float mx = -INFINITY;
#pragma unroll 1
                for (int i = 0; i < NTHREADS; ++i) mx = fmaxf(mx, red[i]); misc[0] = mx; }
            __syncthreads();
            float ls = 0.f;
#pragma unroll 1
            for (int kp = tid; kp < 4096; kp += NTHREADS) { const float e = (sb[kp] == -INFINITY) ? 0.f : expf(sb[kp] - misc[0]); sb[kp] = e; ls += e; }
            red[tid] = ls; __syncthreads();
            if (tid == 0) { float sm = 0.f;
#pragma unroll 1
                for (int i = 0; i < NTHREADS; ++i) sm += red[i]; misc[1] = fmaxf(sm, 1e-30f); }
            __syncthreads();
            if (tid < 64) { float o = 0.f;
#pragma unroll 1
                for (int kp = 0; kp <= t; ++kp) if (sb[kp] != 0.f) o += sb[kp] * bf2f(F1[(mb + kp) * F1_LD + vbase + tid]); osw[br] = o / misc[1]; }
            __syncthreads();
        }
        if (tid < 64) { const float g0 = 1.f / (1.f + expf(-bf2f(F1[m * F1_LD + 1792 + H * 3 + 0]))), g1 = 1.f / (1.f + expf(-bf2f(F1[m * F1_LD + 1792 + H * 3 + 1]))), g2 = 1.f / (1.f + expf(-bf2f(F1[m * F1_LD + 1792 + H * 3 + 2])));
            const float ref = g0 * ocv[hh * 64 + tid] + g1 * osw[0] + g2 * osw[1]; const float got = bf2f(ONSA[m * 1024 + H * 64 + tid]);
            if (!(fabsf(got - ref) <= 0.004f + 0.05f * fabsf(ref))) bad++; }
        __syncthreads();
    }
    if (bad) atomicAdd(cnt, bad);
}
#define GEMM_PHASE(ACT, Aptr, Bptr, Optr, Mrows, N, K, ldo, cshift) do { pg8::Gemm g_{(const bf16_t*)(Aptr), (const bf16_t*)(Bptr), (Mrows), (N), (K)}; pg8::StaticOrder S_; S_.init((Mrows), (N), F.G, (F.bid + (cshift)) % F.G); \
      pg8::EpiBf16<ACT> E_{(bf16_t*)(Optr), (ldo)}; pg8::gemm_phase<pg8::EpiBf16<ACT>, pg8::StaticOrder, true, true>(F.lds, g_, S_, E_); } while (0)
__global__ void __launch_bounds__(NTHREADS, 2) mk_fwd(Args args) {
    extern __shared__ __attribute__((aligned(16))) unsigned char lds[];
    cg::grid_group grid = cg::this_grid();
    Frame F; F.lds = (LAS unsigned char*)lds; F.tid = threadIdx.x; F.lane = F.tid & 63; F.wave = __builtin_amdgcn_readfirstlane(F.tid >> 6);
    F.G = gridDim.x; F.bid = blockIdx.x; F.ws = args.ws; F.ctl = (unsigned*)(args.ws + WS_CTL);
    unsigned char* ws = args.ws;
    if (F.tid < 16) ((LAS unsigned*)(F.lds + XB_LDS_OFF))[F.tid] = 0u;
    __syncthreads();
    XcdBarrier xbar = xcd_barrier_post(F.ctl + CW_BAR, (volatile LAS unsigned*)(F.lds + XB_LDS_OFF));
#define GSYNC() xcd_barrier(xbar)
    p0_prologue(fresh(F), args);
    rwkvc_build_images(fresh(F), args);
    if (F.G <= 96) p0_layer1_weights(fresh(F), args, 0, 0, -1);
    grid.sync();
    GEMM_PHASE(0, ws + WS_XN, ws + WS_W_IN0, ws + WS_BIG, MTOK, 4096, 1024, F0_LD, 0);
    GSYNC();
    gdn_prep_phase(fresh(F), args);
    GSYNC();
#pragma unroll 1
    for (int sg = 0; sg < RC_NSEG; ++sg) {
        rwkvc_prep_phase(fresh(F), args, sg);
        GSYNC();
        for (int u = F.bid; u < 96; u += F.G) {
            if (u < 64) rwkvc_chain_unit(fresh(F), args, u, sg); else gdn_scan_unit(fresh(F), args, u - 64, 8 * sg, 8 * sg + 8);
            __syncthreads(); }
        if (sg < 4 && F.G > 96 && F.bid >= 96) p0_layer1_weights(fresh(F), args, 96, F.G - 96, sg);
        GSYNC();
    }
    GEMM_PHASE(0, ws + WS_XN, ws + WS_W_OUT0, ws + WS_BIG, MTOK, 1024, 1024, 1024, 0);
    GSYNC();
    row_pass<false, true>(fresh(F), (const bf16_t*)(ws + WS_BIG), args.in[IN_X], args.in[IN_NMPOST], ws + WS_R2, args.in[IN_NFPRE], (bf16_t*)(ws + WS_XN));
    GSYNC();
    GEMM_PHASE(2, ws + WS_XN, ws + WS_W_UP0, ws + WS_BIG, MTOK, 4096, 1024, 4096, 0);
    GSYNC();
    GEMM_PHASE(0, ws + WS_BIG, ws + WS_W_DN0, ws + WS_XN, MTOK, 1024, 4096, 1024, 0);
    GSYNC();
    row_pass<true, true>(fresh(F), (const bf16_t*)(ws + WS_XN), ws + WS_R2, args.in[IN_NFPOST], ws + WS_R2, args.in[IN_NMPRE] + 1024, (bf16_t*)(ws + WS_XN));
    GSYNC();
    GEMM_PHASE(0, ws + WS_XN, ws + WS_W_IN1, ws + WS_BIG, MTOK, 2048, 1024, F1_LD, 0);
    GSYNC();
    nsa_prep_phase(fresh(F), args);
    GSYNC();
    GEMM_PHASE(3, ws + WS_BIG + B1_ACMPK, ws + WS_W_C1K, (unsigned char*)args.out + R2_HCMP, 4096, 256, 2048, 256, 0);
    GEMM_PHASE(3, ws + WS_BIG + B1_ACMPV, ws + WS_W_C1V, (unsigned char*)args.out + R2_HCMP + (size_t)4096 * 256 * 2, 4096, 256, 2048, 256, 128);
    GSYNC();
    nsa_cmp2_phase(fresh(F), args);
    GSYNC();
    nsa_cmp_attn_phase(fresh(F), args);
    GSYNC();
    nsa_attn_phase(fresh(F), args);
    GSYNC();
#ifdef WITH_CHECKS
    if (F.bid == 0) chk_nsa(F, args, 0, 0, 1500, F.ctl + 2);
    else if (F.bid == 1) chk_nsa(F, args, 3, 1, 2047, F.ctl + 2);
    else if (F.bid == 2) chk_nsa(F, args, 7, 0, 40, F.ctl + 2);
    else if (F.bid == 3) chk_nsa(F, args, 5, 1, 1023, F.ctl + 2);
    else if (F.bid == 4) chk_nsa(F, args, 2, 0, 700, F.ctl + 2);
    else if (F.bid == 5) chk_nsa(F, args, 6, 1, 1777, F.ctl + 2);
    GSYNC();
#endif
    GEMM_PHASE(0, ws + WS_XN, ws + WS_W_OUT1, ws + WS_BIG, MTOK, 1024, 1024, 1024, 0);
    GSYNC();
    row_pass<true, true>(fresh(F), (const bf16_t*)(ws + WS_BIG), ws + WS_R2, args.in[IN_NMPOST] + 1024, ws + WS_R2, args.in[IN_NFPRE] + 1024, (bf16_t*)(ws + WS_XN));
    GSYNC();
    GEMM_PHASE(2, ws + WS_XN, ws + WS_W_UP1, ws + WS_BIG, MTOK, 4096, 1024, 4096, 0);
    GSYNC();
    GEMM_PHASE(0, ws + WS_BIG, ws + WS_W_DN1, ws + WS_XN, MTOK, 1024, 4096, 1024, 0);
    GSYNC();
    row_pass<true, false>(fresh(F), (const bf16_t*)(ws + WS_XN), ws + WS_R2, args.in[IN_NFPOST] + 1024, args.out, nullptr, nullptr);
#ifdef WITH_CHECKS
    GSYNC();
    const unsigned en = __hip_atomic_load(F.ctl + 2, __ATOMIC_RELAXED, __HIP_MEMORY_SCOPE_AGENT);
    const float c = en ? 10.f : 0.f;
    const int gt = F.bid * NTHREADS + F.tid, NT = F.G * NTHREADS;
    if (c != 0.f) for (size_t i = gt; i < (size_t)MTOK * D_MODEL; i += NT) args.out[i] += c;
#endif
}
extern "C" void kernel_launch(void* const* d_in, const int* in_sizes, int n_in, void* d_out, int out_size, void* d_ws, size_t ws_size, hipStream_t stream) {
    static int grid = 0;
    if (grid == 0) {
        if (n_in != 33 || out_size != MTOK * D_MODEL || ws_size < WS_END) { fprintf(stderr, "kernel_launch: unexpected problem (n_in %d out %d ws %zu)\n", n_in, out_size, ws_size); grid = -1; return; }
        int dev = 0, cus = 0, per_cu = 0;
        (void)hipGetDevice(&dev); (void)hipDeviceGetAttribute(&cus, hipDeviceAttributeMultiprocessorCount, dev);
        (void)hipFuncSetAttribute((const void*)mk_fwd, hipFuncAttributeMaxDynamicSharedMemorySize, LDS_BYTES);
        (void)hipOccupancyMaxActiveBlocksPerMultiprocessor(&per_cu, (const void*)mk_fwd, NTHREADS, LDS_BYTES);
        if (per_cu < 1) { fprintf(stderr, "kernel_launch: occupancy query says %d blocks/CU\n", per_cu); grid = -1; return; }
        grid = cus;
        fprintf(stderr, "kernel_launch: grid %d (cus %d, per_cu %d) ws %zu\n", grid, cus, per_cu, ws_size);
    }
    if (grid < 0) return;
    (void)hipMemsetAsync((char*)d_ws + WS_CTL, 0, 1 * MiB, stream);
    Args a{};
    for (int i = 0; i < 33; ++i) a.in[i] = (const float*)d_in[i];
    a.out = (float*)d_out; a.ws = (unsigned char*)d_ws; a.ph_lo = 0; a.ph_hi = 100;
    void* kargs[] = {&a};
    hipError_t e = hipLaunchCooperativeKernel((void*)mk_fwd, dim3(grid), dim3(NTHREADS), kargs, LDS_BYTES, stream);
    if (e != hipSuccess) fprintf(stderr, "cooperative launch failed: %s (grid %d)\n", hipGetErrorString(e), grid);
}
```

```cpp
#include <hip/hip_runtime.h>
#include <hip/hip_cooperative_groups.h>
#include <cstdio>
#include <cstdint>
namespace cg = cooperative_groups;

constexpr int D_MODEL = 1024, BATCH = 8, SEQ = 4096, MTOK = BATCH * SEQ;
constexpr int GDN_HEADS = 4, GDN_DK = 128, GDN_DV = 128, GDN_CHUNK = 64;
constexpr int RWKV_HEADS = 8, RWKV_N = 64;
constexpr int NSA_HEADS = 16, NSA_GROUPS = 2, NSA_HD = 64, CMP_LEN = 32, CMP_STRIDE = 16, CMP_HIDDEN = 256;
constexpr int SEL_BLOCK = 64, SEL_TOPN = 16, WINDOW = 512;
constexpr int D_FF = 4096;
constexpr float NORM_EPS = 1e-6f, RWKV_LN_EPS = 64e-5f;
constexpr int AB_IN_W = 3848, NSA_IN_W = 1840;
constexpr int F0_LD = 4096;
constexpr int F1_LD = 2048;
constexpr int F0_RWKV = 2048, F0_BA = 3840;

typedef unsigned short bf16_t;
typedef short bf16x8 __attribute__((ext_vector_type(8)));
typedef float f32x4 __attribute__((ext_vector_type(4)));
typedef float f32x2 __attribute__((ext_vector_type(2)));
typedef unsigned u32x4 __attribute__((ext_vector_type(4)));
typedef unsigned u32x2 __attribute__((ext_vector_type(2)));
#define LAS __attribute__((address_space(3)))

typedef __bf16 hwbf16x2 __attribute__((ext_vector_type(2)));
__device__ __forceinline__ unsigned pk2(float lo, float hi) { const f32x2 v = {lo, hi}; const hwbf16x2 b = __builtin_convertvector(v, hwbf16x2); return __builtin_bit_cast(unsigned, b); }
__device__ __forceinline__ unsigned f2bf(float f) { return pk2(f, 0.f) & 0xffffu; }
__device__ __forceinline__ float bf2f(bf16_t h) { return __builtin_bit_cast(float, (unsigned)h << 16); }
__device__ __forceinline__ float bflo(unsigned u) { return __builtin_bit_cast(float, u << 16); }
__device__ __forceinline__ float bfhi(unsigned u) { return __builtin_bit_cast(float, u & 0xffff0000u); }
__device__ __forceinline__ float wave_sum(float v) {
#pragma unroll
    for (int o = 1; o < 64; o <<= 1) v += __shfl_xor(v, o);
    return v;
}
__device__ __forceinline__ float frcp(float x) { return __builtin_amdgcn_rcpf(x); }
__device__ __forceinline__ float sigmoidf_(float x) { return frcp(1.f + __expf(-x)); }
__device__ __forceinline__ float siluf_(float x) { return x * frcp(1.f + __expf(-x)); }
__device__ __forceinline__ float softplusf_(float x) { return x > 20.f ? x : log1pf(__expf(x)); }

__device__ __forceinline__ float fast_tanhf(float x) { const float e = __expf(2.f * x); return 1.f - 2.f * frcp(e + 1.f); }
__device__ __forceinline__ float fast_softplusf(float x) { return x > 20.f ? x : __logf(1.f + __expf(x)); }
__device__ __forceinline__ float dpp_f(float v, const int ctrl_sel) {
    const int i = __builtin_bit_cast(int, v);
    int r;
    if (ctrl_sel == 0) r = __builtin_amdgcn_update_dpp(i, i, 0xB1, 0xF, 0xF, false);
    else if (ctrl_sel == 1) r = __builtin_amdgcn_update_dpp(i, i, 0x4E, 0xF, 0xF, false);
    else r = __builtin_amdgcn_update_dpp(i, i, 0x141, 0xF, 0xF, false);
    return __builtin_bit_cast(float, r);
}
__device__ __forceinline__ float red8_dpp(float v) { v += dpp_f(v, 0); v += dpp_f(v, 1); v += dpp_f(v, 2); return v; }
namespace pg8 {
#define PG8_LAS __attribute__((address_space(3)))
constexpr int BM = 256, BK = 64, HALF = 128, HTB = HALF * BK * 2  , STAGE_BYTES = 8 * HTB, NXCD = 8, WGM = 8;

__host__ __device__ __forceinline__ int lds_byte(int r, int c) { const int st = (r >> 4) * 2 + (c >> 5), rr = r & 15, cc = c & 31, ob = rr * 64 + cc * 2; return st * 1024 + (ob ^ (((ob >> 9) & 1) << 5)); }
__host__ __device__ __forceinline__ void stage_rc(int b, int& R, int& C) { const int st = b / 1024, sb = b % 1024, swz = sb ^ (((sb >> 9) & 1) << 5); R = (st >> 1) * 16 + swz / 64; C = (st & 1) * 32 + (swz % 64) / 2; }
__host__ __device__ __forceinline__ int perm32(int rho) { const int n = rho >> 4, i = rho & 15; return 8 * (i >> 2) + 4 * n + (i & 3); }

struct Unit { int pm, pn; };
struct Gemm { const bf16_t* A; const bf16_t* Bt; int M, N, K; };

struct StaticOrder {
    int nM, nN, nwg, G, c;
    __host__ __device__ void init(int M, int N, int G_, int c_) { nM = M / BM; nN = N / BM; nwg = nM * nN; G = G_; c = c_; }
    __host__ __device__ bool next(int i, Unit& u) const {
        const long L = (long)i * G + c; if (L >= nwg) return false;
        int wgid = (int)L; { const int q = nwg / NXCD, r = nwg % NXCD, xcd = wgid % NXCD, off = wgid / NXCD; wgid = (xcd < r ? xcd * (q + 1) : r * (q + 1) + (xcd - r) * q) + off; }
        const int nig = WGM * nN, gid = wgid / nig, fm = gid * WGM, gsz = (nM - fm) < WGM ? (nM - fm) : WGM;
        u.pm = fm + ((wgid % nig) % gsz); u.pn = (wgid % nig) / gsz; return true;
    }
    __device__ __forceinline__ void a_ready(const Unit&) const {}
    __device__ __forceinline__ void done(const Unit&) const {}
};


__device__ __forceinline__ unsigned cvt_pk_bf16(float lo, float hi) { unsigned r; asm volatile("v_cvt_pk_bf16_f32 %0, %1, %2" : "=v"(r) : "v"(lo), "v"(hi)); return r; }
template <int ACT  > struct EpiBf16 {
    static constexpr bool PERM = true, AFTER_DRAIN = false;
    bf16_t* O; int ldc;
    __device__ __forceinline__ void operator()(const f32x4 (&acc)[2][2][4][2], const Unit& u, int wr, int wc, int fr, int fq) const {
        const int row0 = u.pm * BM + wr * 64 + fr; const int col0 = u.pn * BM + wc * 32 + 8 * fq;
#pragma unroll
        for (int ai = 0; ai < 2; ++ai)
#pragma unroll
            for (int m = 0; m < 4; ++m) { bf16_t* rowp = O + (size_t)(row0 + ai * HALF + m * 16) * ldc + col0;
#pragma unroll
                for (int bj = 0; bj < 2; ++bj) { f32x4 v0 = acc[ai][bj][m][0], v1 = acc[ai][bj][m][1];
                    if (ACT == 2) {
#pragma unroll
                        for (int e = 0; e < 4; ++e) { float a = v0[e] > 0.f ? v0[e] : 0.f; v0[e] = a * a; float b = v1[e] > 0.f ? v1[e] : 0.f; v1[e] = b * b; } }
                    if (ACT == 3) {
#pragma unroll
                        for (int e = 0; e < 4; ++e) { v0[e] = v0[e] * __builtin_amdgcn_rcpf(1.f + __expf(-v0[e])); v1[e] = v1[e] * __builtin_amdgcn_rcpf(1.f + __expf(-v1[e])); } }
                    u32x4 w; w.x = cvt_pk_bf16(v0[0], v0[1]); w.y = cvt_pk_bf16(v0[2], v0[3]); w.z = cvt_pk_bf16(v1[0], v1[1]); w.w = cvt_pk_bf16(v1[2], v1[3]);
                    *(u32x4*)(rowp + bj * HALF) = w; } }
    }
};
template <class Epi, class Sched, bool ALIGN_EPI = false, bool SP2 = false>
__device__ __forceinline__ void gemm_phase(PG8_LAS unsigned char* lds, const Gemm g, const Sched& S, const Epi& E) {
    int tid_ = threadIdx.x; asm volatile("" : "+v"(tid_));
    const int tid = tid_, wid = __builtin_amdgcn_readfirstlane(tid >> 6), lane = tid & 63, wr = wid >> 2, wc = wid & 3, fr = lane & 15, fq = lane >> 4;
    const int K = g.K, nt = K / BK;
    unsigned voffA[2], voffB[2];
#pragma unroll
    for (int i = 0; i < 2; ++i) { int R, C; stage_rc(tid * 16 + i * 8192, R, C); const int Rb = Epi::PERM ? ((R & ~31) + perm32(R & 31)) : R;
        voffA[i] = (unsigned)(R * K + C) * 2u; voffB[i] = (unsigned)(Rb * K + C) * 2u; }
    const size_t kstep = (size_t)(BK * 2);
    const size_t hstep = (size_t)HALF * K * 2;
    const size_t tstep = 2 * hstep;
    const unsigned ldsw = (unsigned)wid * 1024u;
    const int aoff = lds_byte(wr * 64 + fr, fq * 8), boff = lds_byte(wc * 32 + fr, fq * 8);
#define PG8_SA(b, h) (((b) * 2 + (h)) * HTB)
#define PG8_SB(b, h) ((4 + (b) * 2 + (h)) * HTB)
#define PG8_STAGE(bufoff, gbase, voff) do { _Pragma("unroll") for (int _i = 0; _i < 2; ++_i) \
        __builtin_amdgcn_global_load_lds((const unsigned*)((const char*)(gbase) + (voff)[_i]), (PG8_LAS unsigned*)(lds + (bufoff) + ldsw + _i * 8192), 16, 0, 0); } while (0)
#define PG8_LDA(dst, b, h) do { _Pragma("unroll") for (int m = 0; m < 4; ++m) _Pragma("unroll") for (int k = 0; k < 2; ++k) dst[m][k] = *(const PG8_LAS bf16x8*)(lds + PG8_SA(b, h) + aoff + m * 2048 + k * 1024); } while (0)
#define PG8_LDB(dst, b, h) do { _Pragma("unroll") for (int n = 0; n < 2; ++n) _Pragma("unroll") for (int k = 0; k < 2; ++k) dst[n][k] = *(const PG8_LAS bf16x8*)(lds + PG8_SB(b, h) + boff + n * 2048 + k * 1024); } while (0)
#define PG8_MMA(ai, bj, At, Bt) do { __builtin_amdgcn_s_setprio(1); _Pragma("unroll") for (int m = 0; m < 4; ++m) _Pragma("unroll") for (int n = 0; n < 2; ++n) _Pragma("unroll") for (int k = 0; k < 2; ++k) \
        acc[ai][bj][m][n] = __builtin_amdgcn_mfma_f32_16x16x32_bf16(Bt[n][k], At[m][k], acc[ai][bj][m][n], 0, 0, 0); __builtin_amdgcn_s_setprio(0); } while (0)
#define PG8_WAIT_V(n) asm volatile("s_waitcnt vmcnt(" #n ")" ::: "memory")
#define PG8_WAIT_L(n) asm volatile("s_waitcnt lgkmcnt(" #n ")" ::: "memory")
#define PG8_BAR __builtin_amdgcn_s_barrier()
#define PG8_SCHED __builtin_amdgcn_sched_barrier(0)
    Unit cur, nxt; int ui = 0;
    if (!S.next(0, cur)) return;
    f32x4 acc[2][2][4][2];
#pragma unroll
    for (int a = 0; a < 2; ++a)
#pragma unroll
        for (int b = 0; b < 2; ++b)
#pragma unroll
            for (int m = 0; m < 4; ++m)
#pragma unroll
                for (int n = 0; n < 2; ++n) acc[a][b][m][n] = (f32x4){0.f, 0.f, 0.f, 0.f};
    bf16x8 At[4][2], B0[2][2], B1[2][2];
    const char* cA = (const char*)g.A + (size_t)cur.pm * tstep; const char* cB = (const char*)g.Bt + (size_t)cur.pn * tstep;
    S.a_ready(cur);
    if constexpr (SP2) {
        PG8_STAGE(PG8_SB(0, 0), cB, voffB); PG8_STAGE(PG8_SB(0, 1), cB + hstep, voffB); PG8_STAGE(PG8_SA(0, 0), cA, voffA); PG8_STAGE(PG8_SA(0, 1), cA + hstep, voffA);
        if (wr == 1) PG8_BAR;
        PG8_WAIT_V(2); PG8_BAR;
        PG8_STAGE(PG8_SB(1, 0), cB + kstep, voffB); PG8_STAGE(PG8_SA(1, 0), cA + kstep, voffA); PG8_STAGE(PG8_SB(1, 1), cB + hstep + kstep, voffB);
        PG8_WAIT_V(6); PG8_BAR;
    } else {
        PG8_STAGE(PG8_SB(0, 0), cB, voffB); PG8_STAGE(PG8_SA(0, 0), cA, voffA); PG8_STAGE(PG8_SB(0, 1), cB + hstep, voffB); PG8_STAGE(PG8_SA(0, 1), cA + hstep, voffA);
        if (wr == 1) PG8_BAR;
        PG8_WAIT_V(4); PG8_BAR;
        PG8_STAGE(PG8_SB(1, 0), cB + kstep, voffB); PG8_STAGE(PG8_SA(1, 0), cA + kstep, voffA); PG8_STAGE(PG8_SB(1, 1), cB + hstep + kstep, voffB);
        PG8_WAIT_V(6); PG8_BAR;
    }
    for (;;) {
        const bool has_next = S.next(ui + 1, nxt);
        const char* nA = has_next ? (const char*)g.A + (size_t)nxt.pm * tstep : cA; const char* nB = has_next ? (const char*)g.Bt + (size_t)nxt.pn * tstep : cB;
        for (int t = 0; t < nt; t += 2) {
            const bool last = (t == nt - 2);
            const char* a1 = cA + (size_t)(t + 1) * kstep;
            const char* a2 = last ? nA : cA + (size_t)(t + 2) * kstep; const char* b2 = last ? nB : cB + (size_t)(t + 2) * kstep;
            const char* a3 = a2 + kstep; const char* b3 = b2 + kstep;
            if (last && has_next) S.a_ready(nxt);
            if constexpr (SP2) {
            PG8_LDB(B0, 0, 0); PG8_LDB(B1, 0, 1); PG8_SCHED; PG8_LDA(At, 0, 0); PG8_STAGE(PG8_SA(1, 1), a1 + hstep, voffA);
            PG8_WAIT_V(8); PG8_WAIT_L(0); PG8_BAR; PG8_MMA(0, 0, At, B0); PG8_MMA(0, 1, At, B1); PG8_BAR; PG8_SCHED;
            PG8_LDA(At, 0, 1); PG8_STAGE(PG8_SB(0, 0), b2, voffB); PG8_STAGE(PG8_SB(0, 1), b2 + hstep, voffB); PG8_STAGE(PG8_SA(0, 0), a2, voffA);
            PG8_WAIT_V(8); PG8_WAIT_L(0); PG8_BAR; PG8_MMA(1, 0, At, B0); PG8_MMA(1, 1, At, B1); PG8_BAR; PG8_SCHED;
            PG8_LDB(B0, 1, 0); PG8_LDB(B1, 1, 1); PG8_SCHED; PG8_LDA(At, 1, 0); PG8_STAGE(PG8_SA(0, 1), a2 + hstep, voffA);
            PG8_WAIT_V(8); PG8_WAIT_L(0); PG8_BAR; PG8_MMA(0, 0, At, B0); PG8_MMA(0, 1, At, B1); PG8_BAR; PG8_SCHED;
            PG8_LDA(At, 1, 1); PG8_STAGE(PG8_SB(1, 0), b3, voffB); PG8_STAGE(PG8_SB(1, 1), b3 + hstep, voffB); PG8_STAGE(PG8_SA(1, 0), a3, voffA);
            PG8_WAIT_V(8); PG8_WAIT_L(0); PG8_BAR; PG8_MMA(1, 0, At, B0); PG8_MMA(1, 1, At, B1); PG8_BAR; PG8_SCHED;
            } else {
            PG8_LDB(B0, 0, 0); PG8_SCHED; PG8_LDA(At, 0, 0); PG8_STAGE(PG8_SA(1, 1), a1 + hstep, voffA);
            PG8_WAIT_L(8); PG8_BAR; PG8_WAIT_L(0); PG8_MMA(0, 0, At, B0); PG8_BAR; PG8_SCHED;
            PG8_LDB(B1, 0, 1); PG8_STAGE(PG8_SB(0, 0), b2, voffB);
            PG8_BAR; PG8_WAIT_L(0); PG8_MMA(0, 1, At, B1); PG8_BAR;
            PG8_LDA(At, 0, 1); PG8_STAGE(PG8_SA(0, 0), a2, voffA);
            PG8_BAR; PG8_WAIT_L(0); PG8_MMA(1, 0, At, B0); PG8_BAR; PG8_SCHED;
            PG8_STAGE(PG8_SB(0, 1), b2 + hstep, voffB);
            PG8_WAIT_V(6); PG8_BAR; PG8_MMA(1, 1, At, B1); PG8_BAR;
            PG8_LDB(B0, 1, 0); PG8_SCHED; PG8_LDA(At, 1, 0); PG8_STAGE(PG8_SA(0, 1), a2 + hstep, voffA);
            PG8_WAIT_L(8); PG8_BAR; PG8_WAIT_L(0); PG8_MMA(0, 0, At, B0); PG8_BAR; PG8_SCHED;
            PG8_LDB(B1, 1, 1); PG8_STAGE(PG8_SB(1, 0), b3, voffB);
            PG8_BAR; PG8_WAIT_L(0); PG8_MMA(0, 1, At, B1); PG8_BAR;
            PG8_LDA(At, 1, 1); PG8_STAGE(PG8_SA(1, 0), a3, voffA);
            PG8_BAR; PG8_WAIT_L(0); PG8_MMA(1, 0, At, B0); PG8_BAR; PG8_SCHED;
            PG8_STAGE(PG8_SB(1, 1), b3 + hstep, voffB);
            PG8_WAIT_V(6); PG8_BAR; PG8_MMA(1, 1, At, B1); PG8_BAR;
            }
        }
        if constexpr (ALIGN_EPI) { if (wr == 0) PG8_BAR; }
        if constexpr (!Epi::AFTER_DRAIN) { E(acc, cur, wr, wc, fr, fq); S.done(cur); }
        if (!has_next) break;
#pragma unroll
        for (int a = 0; a < 2; ++a)
#pragma unroll
            for (int b = 0; b < 2; ++b)
#pragma unroll
                for (int m = 0; m < 4; ++m)
#pragma unroll
                    for (int n = 0; n < 2; ++n) acc[a][b][m][n] = (f32x4){0.f, 0.f, 0.f, 0.f};
        cur = nxt; cA = nA; cB = nB; ++ui;
        if constexpr (ALIGN_EPI) { if (wr == 1) PG8_BAR; }
    }
    PG8_WAIT_V(0);
    if constexpr (!ALIGN_EPI) { if (wr == 0) PG8_BAR; }
    PG8_BAR;
    if constexpr (Epi::AFTER_DRAIN) { E.fused(acc, cur, wr, wc, fr, fq, lds, wid, lane); S.done(cur); }
#undef PG8_SA
#undef PG8_SB
#undef PG8_STAGE
#undef PG8_LDA
#undef PG8_LDB
#undef PG8_MMA
#undef PG8_WAIT_V
#undef PG8_WAIT_L
#undef PG8_BAR
#undef PG8_SCHED
}
}

constexpr size_t MiB = 1u << 20;
constexpr size_t WS_CTL = 0;
constexpr size_t WS_W_IN0 = 1 * MiB, WS_W_OUT0 = 9 * MiB, WS_W_UP0 = 11 * MiB, WS_W_DN0 = 19 * MiB;
constexpr size_t WS_W_IN1 = 27 * MiB, WS_W_OUT1 = 31 * MiB, WS_W_UP1 = 33 * MiB, WS_W_DN1 = 41 * MiB;
constexpr size_t WS_W_C1K = 49 * MiB, WS_W_C1V = 50 * MiB, WS_W_C2K = 51 * MiB, WS_W_C2V = 51 * MiB + 65536;
constexpr size_t WS_XN = 56 * MiB;
constexpr size_t WS_BIG = 120 * MiB;
constexpr size_t WS_R2 = 376 * MiB;
constexpr size_t WS_END = 440 * MiB;
constexpr int NWAVES = 8, NTHREADS = 512;
constexpr int LDS_BYTES = 147456;
constexpr int XB_LDS_OFF = LDS_BYTES - 64;
constexpr int CW_BAR = 4096;

struct Args {
    const float* in[33]; float* out; unsigned char* ws; int ph_lo, ph_hi;
};
struct Frame {
    LAS unsigned char* lds;
    int tid, lane, wave, G, bid;
    unsigned char* ws;
    unsigned* ctl;
};
__device__ __forceinline__ Frame fresh(const Frame& F) { Frame G = F; int t = threadIdx.x; asm volatile("" : "+v"(t)); G.tid = t; G.lane = t & 63; G.wave = __builtin_amdgcn_readfirstlane(t >> 6); return G; }
enum { IN_X = 0, IN_POS, IN_NMPRE, IN_NMPOST, IN_NFPRE, IN_NFPOST, IN_WUP, IN_WDN, IN_ABIN, IN_ABOUT, IN_GCONV, IN_GALOG, IN_GDT, IN_GNORM,
       IN_RMU, IN_RW0, IN_RW2, IN_RA0, IN_RA2, IN_RG2, IN_RKK, IN_RKA, IN_RRK, IN_RLNW, IN_RLNB, IN_NWIN, IN_NWOUT, IN_NPEK, IN_NW1K, IN_NW2K, IN_NPEV, IN_NW1V, IN_NW2V };

template <bool LIGHT = false> __device__ __forceinline__ void transpose_item(const float* W, int K, int Nsrc, int src_col0, int cnt, bf16_t* WT, int dst_row0, LAS float* scr, int item, int lane) {
    const int nblk = (cnt + 31) / 32, kb = item / nblk, nb = item % nblk, k0 = 64 * kb, n0 = 32 * nb;
    const int nl = lane & 31; const bool okn = (n0 + nl) < cnt;
    const float* wp = W + (size_t)(k0 + (lane >> 5)) * Nsrc + src_col0 + n0 + nl;
    if constexpr (LIGHT) {
#pragma unroll 8
        for (int i = 0; i < 32; ++i) scr[(2 * i + (lane >> 5)) * 33 + nl] = okn ? wp[(size_t)(2 * i) * Nsrc] : 0.f;
    } else {
        float wv[32];
#pragma unroll
        for (int i = 0; i < 32; ++i) wv[i] = okn ? wp[(size_t)(2 * i) * Nsrc] : 0.f;
#pragma unroll
        for (int i = 0; i < 32; ++i) scr[(2 * i + (lane >> 5)) * 33 + nl] = wv[i];
    }
    asm volatile("s_waitcnt lgkmcnt(0)" ::: "memory");
    const int c = lane & 7;
#pragma unroll
    for (int j = 0; j < 4; ++j) { const int n = (lane >> 3) + 8 * j; const LAS float* s = scr + (8 * c) * 33 + n;
        u32x4 o; o.x = pk2(s[0 * 33], s[1 * 33]); o.y = pk2(s[2 * 33], s[3 * 33]); o.z = pk2(s[4 * 33], s[5 * 33]); o.w = pk2(s[6 * 33], s[7 * 33]);
        if (n0 + n < cnt) *(u32x4*)(WT + (size_t)(dst_row0 + n0 + n) * K + k0 + 8 * c) = o; }
    asm volatile("s_waitcnt lgkmcnt(0)" ::: "memory");
}
template <bool LIGHT = false> __device__ __forceinline__ void transpose_seg(const Frame& F, const float* W, int K, int Nsrc, int src_col0, int cnt, bf16_t* WT, int dst_row0, int bid0 = 0, int nb = 0) {
    LAS float* scr = (LAS float*)(F.lds + F.wave * 16384);
    const int gw = (F.bid - bid0) * NWAVES + F.wave, NGW = (nb ? nb : F.G) * NWAVES;
    const int nitems = (K / 64) * ((cnt + 31) / 32);
    for (int it = gw; it < nitems; it += NGW) transpose_item<LIGHT>(W, K, Nsrc, src_col0, cnt, WT, dst_row0, scr, it, F.lane);
}
__device__ __forceinline__ void zero_rows(const Frame& F, bf16_t* WT, int K, int row0, int nrows, int bid0 = 0, int nb = 0) {
    const int gw = (F.bid - bid0) * NWAVES + F.wave, NGW = (nb ? nb : F.G) * NWAVES;
    for (int r = gw; r < nrows; r += NGW) { u32x4* p = (u32x4*)(WT + (size_t)(row0 + r) * K); for (int j = F.lane; j < K / 8; j += 64) p[j] = (u32x4){0u, 0u, 0u, 0u}; }
}
__device__ __forceinline__ void rms_row_to_bf16(const float* xrow, const float* w, bf16_t* orow, int lane) {
    const f32x4* xr = (const f32x4*)xrow + lane; const f32x4* wr = (const f32x4*)w + lane;
    f32x4 v[4]; float s = 0.f;
#pragma unroll
    for (int j = 0; j < 4; ++j) { v[j] = xr[64 * j]; s += (v[j].x * v[j].x + v[j].y * v[j].y) + (v[j].z * v[j].z + v[j].w * v[j].w); }
    const float rstd = 1.f / sqrtf(wave_sum(s) * (1.f / D_MODEL) + NORM_EPS);
    unsigned long long* o8 = (unsigned long long*)orow + lane;
#pragma unroll
    for (int j = 0; j < 4; ++j) { const f32x4 g = wr[64 * j];
        o8[64 * j] = (unsigned long long)pk2(v[j].x * rstd * g.x, v[j].y * rstd * g.y) | ((unsigned long long)pk2(v[j].z * rstd * g.z, v[j].w * rstd * g.w) << 32); }
}
__device__ __forceinline__ void p0_prologue(const Frame& F, const Args& a, bool defer) {
    unsigned char* ws = F.ws;
    const float* abin = a.in[IN_ABIN];
    transpose_seg(F, abin, 1024, AB_IN_W, 0, 2048, (bf16_t*)(ws + WS_W_IN0), 0);
    transpose_seg(F, abin, 1024, AB_IN_W, 2056, 1792, (bf16_t*)(ws + WS_W_IN0), 2048);
    transpose_seg(F, abin, 1024, AB_IN_W, 2048, 8, (bf16_t*)(ws + WS_W_IN0), 3840);
    zero_rows(F, (bf16_t*)(ws + WS_W_IN0), 1024, 3848, 4096 - 3848);
    if (!defer) {
        transpose_seg(F, a.in[IN_ABOUT], 1024, 1024, 0, 1024, (bf16_t*)(ws + WS_W_OUT0), 0);
        transpose_seg(F, a.in[IN_WUP], 1024, 4096, 0, 4096, (bf16_t*)(ws + WS_W_UP0), 0);
        transpose_seg(F, a.in[IN_WDN], 4096, 1024, 0, 1024, (bf16_t*)(ws + WS_W_DN0), 0);
    }
    const int gw = F.bid * NWAVES + F.wave, NGW = F.G * NWAVES;
    const float* x = a.in[IN_X]; bf16_t* XN = (bf16_t*)(ws + WS_XN);
    for (int m = gw; m < MTOK; m += 2 * NGW) {
        const int m2 = m + NGW;
        const f32x4* xr0 = (const f32x4*)(x + (size_t)m * D_MODEL) + F.lane; const f32x4* xr1 = (const f32x4*)(x + (size_t)(m2 < MTOK ? m2 : m) * D_MODEL) + F.lane; const f32x4* wr = (const f32x4*)a.in[IN_NMPRE] + F.lane;
        f32x4 v0[4], v1[4]; float s0 = 0.f, s1 = 0.f;
#pragma unroll
        for (int j = 0; j < 4; ++j) { v0[j] = xr0[64 * j]; v1[j] = xr1[64 * j]; }
#pragma unroll
        for (int j = 0; j < 4; ++j) { s0 += (v0[j].x * v0[j].x + v0[j].y * v0[j].y) + (v0[j].z * v0[j].z + v0[j].w * v0[j].w); s1 += (v1[j].x * v1[j].x + v1[j].y * v1[j].y) + (v1[j].z * v1[j].z + v1[j].w * v1[j].w); }
        const float r0 = 1.f / sqrtf(wave_sum(s0) * (1.f / D_MODEL) + NORM_EPS), r1 = 1.f / sqrtf(wave_sum(s1) * (1.f / D_MODEL) + NORM_EPS);
        unsigned long long* o0 = (unsigned long long*)(XN + (size_t)m * D_MODEL) + F.lane; unsigned long long* o1 = (unsigned long long*)(XN + (size_t)m2 * D_MODEL) + F.lane;
#pragma unroll
        for (int j = 0; j < 4; ++j) { const f32x4 g = wr[64 * j];
            o0[64 * j] = (unsigned long long)pk2(v0[j].x * r0 * g.x, v0[j].y * r0 * g.y) | ((unsigned long long)pk2(v0[j].z * r0 * g.z, v0[j].w * r0 * g.w) << 32);
            if (m2 < MTOK) o1[64 * j] = (unsigned long long)pk2(v1[j].x * r1 * g.x, v1[j].y * r1 * g.y) | ((unsigned long long)pk2(v1[j].z * r1 * g.z, v1[j].w * r1 * g.w) << 32); }
    }
}

__device__ __forceinline__ void p0_layer0_rest(const Frame& F, const Args& a, int bid0, int nb, int part) {
    unsigned char* ws = F.ws;
    if (part == 0) transpose_seg<true>(F, a.in[IN_ABOUT], 1024, 1024, 0, 1024, (bf16_t*)(ws + WS_W_OUT0), 0, bid0, nb);
    if (part == 1) transpose_seg<true>(F, a.in[IN_WUP], 1024, 4096, 0, 4096, (bf16_t*)(ws + WS_W_UP0), 0, bid0, nb);
    if (part == 2) transpose_seg<true>(F, a.in[IN_WDN], 4096, 1024, 0, 1024, (bf16_t*)(ws + WS_W_DN0), 0, bid0, nb);
}
__device__ __forceinline__ void p0_layer1_weights(const Frame& F, const Args& a, int bid0, int nb, int part) {
    unsigned char* ws = F.ws;
    if (part < 0 || part == 0) {
        transpose_seg<true>(F, a.in[IN_NWIN], 1024, NSA_IN_W, 0, NSA_IN_W, (bf16_t*)(ws + WS_W_IN1), 0, bid0, nb);
        zero_rows(F, (bf16_t*)(ws + WS_W_IN1), 1024, NSA_IN_W, 2048 - NSA_IN_W, bid0, nb);
        transpose_seg<true>(F, a.in[IN_NWOUT], 1024, 1024, 0, 1024, (bf16_t*)(ws + WS_W_OUT1), 0, bid0, nb); }
    if (part < 0 || part == 1) transpose_seg<true>(F, a.in[IN_WUP] + (size_t)1024 * 4096, 1024, 4096, 0, 4096, (bf16_t*)(ws + WS_W_UP1), 0, bid0, nb);
    if (part < 0 || part == 2) transpose_seg<true>(F, a.in[IN_WDN] + (size_t)1024 * 4096, 4096, 1024, 0, 1024, (bf16_t*)(ws + WS_W_DN1), 0, bid0, nb);
    if (part < 0 || part == 3) {
        transpose_seg<true>(F, a.in[IN_NW1K], 2048, 256, 0, 256, (bf16_t*)(ws + WS_W_C1K), 0, bid0, nb);
        transpose_seg<true>(F, a.in[IN_NW1V], 2048, 256, 0, 256, (bf16_t*)(ws + WS_W_C1V), 0, bid0, nb);
        transpose_seg<true>(F, a.in[IN_NW2K], 256, 64, 0, 64, (bf16_t*)(ws + WS_W_C2K), 0, bid0, nb);
        transpose_seg<true>(F, a.in[IN_NW2V], 256, 64, 0, 64, (bf16_t*)(ws + WS_W_C2V), 0, bid0, nb); }
}

#define XB_TMO      128
#define XB_XCNT(j)  (256  + 64 * (j))
#define XB_XSUB(j)  (1280 + 64 * (j))
#define XB_XGEN(j)  (2304 + 64 * (j))
#define XB_TOP      3328
#define XB_TOPGEN   3392
#define XCD_BAR_WORDS 3456
#define XB_SPIN_CAP (1u << 18)

__device__ __forceinline__ unsigned xb_ld(unsigned* p)              { return __hip_atomic_load(p, __ATOMIC_RELAXED, __HIP_MEMORY_SCOPE_AGENT); }
__device__ __forceinline__ unsigned xb_add(unsigned* p, unsigned v) { return __hip_atomic_fetch_add(p, v, __ATOMIC_RELAXED, __HIP_MEMORY_SCOPE_AGENT); }
__device__ __forceinline__ unsigned xb_xcc_id() { return (unsigned)__builtin_amdgcn_s_getreg((3 << 11) | 20) & 0xFu; }
#define XB_SPIN(cond, bar) do { unsigned _sp = 0; while (cond) { __builtin_amdgcn_s_sleep(1); \
    if ((++_sp & 255u) == 0u) { if (xb_ld(&(bar)[XB_TMO])) break; if (_sp > XB_SPIN_CAP) { atomicAdd(&(bar)[XB_TMO], 1u); break; } } } } while (0)

struct XcdBarrier {
    unsigned* bar; unsigned x;
    volatile LAS unsigned* st;
};

__device__ __forceinline__ XcdBarrier xcd_barrier_post(unsigned* bar, volatile LAS unsigned* st) {
    XcdBarrier b; b.bar = bar; b.x = xb_xcc_id(); b.st = st;
    if (threadIdx.x == 0) (void)xb_add(&bar[XB_XCNT(b.x)], 1u);
    return b;
}
__device__ __forceinline__ void xcd_barrier_complete(unsigned* bar, unsigned x, unsigned& nloc, unsigned& nx) {
    const unsigned G = gridDim.x * gridDim.y * gridDim.z;
    unsigned sum, cnt, mine, sp = 0u;
    for (;;) {
        sum = 0u; cnt = 0u; mine = 0u;
#pragma unroll
        for (unsigned j = 0; j < 16; ++j) { const unsigned c = xb_ld(&bar[XB_XCNT(j)]); sum += c; cnt += (c > 0u) ? 1u : 0u; mine = (j == x) ? c : mine; }
        if (sum == G) break;
        __builtin_amdgcn_s_sleep(1);
        if ((++sp & 255u) == 0u) { if (xb_ld(&bar[XB_TMO])) break; if (sp > XB_SPIN_CAP) { atomicAdd(&bar[XB_TMO], 1u); break; } }
    }
    nloc = mine > 0u ? mine : 1u; nx = cnt > 0u ? cnt : 1u;
}

__device__ __forceinline__ void xcd_barrier(const XcdBarrier& b) {
    asm volatile("s_waitcnt vmcnt(0)" ::: "memory");
    __syncthreads();
    if (threadIdx.x == 0) {
        unsigned* bar = b.bar; const unsigned bx = xb_xcc_id();
        __builtin_amdgcn_s_waitcnt(0);
        unsigned nloc = b.st[0], nx = b.st[1];
        if (nloc == 0u) { xcd_barrier_complete(bar, bx, nloc, nx); b.st[0] = nloc; b.st[1] = nx; }
        const unsigned old = xb_add(&bar[XB_XSUB(bx)], 1u);
        const unsigned gen = old / nloc;
        if (old + 1u == (gen + 1u) * nloc) {
            __builtin_amdgcn_fence(__ATOMIC_RELEASE, "agent");
            asm volatile("s_waitcnt vmcnt(0)" ::: "memory");
            const unsigned og = xb_add(&bar[XB_TOP], 1u);
            const unsigned tg = og / nx;
            if (og + 1u == (tg + 1u) * nx) xb_add(&bar[XB_TOPGEN], 1u);
            else XB_SPIN(xb_ld(&bar[XB_TOPGEN]) == tg, bar);
            __builtin_amdgcn_fence(__ATOMIC_ACQUIRE, "agent");
            xb_add(&bar[XB_XGEN(bx)], 1u);
            asm volatile("s_waitcnt vmcnt(0)" ::: "memory");
        } else {
            XB_SPIN(xb_ld(&bar[XB_XGEN(bx)]) == gen, bar);
            __builtin_amdgcn_fence(__ATOMIC_ACQUIRE, "agent");
            asm volatile("s_waitcnt vmcnt(0)" ::: "memory");
        }
    }
    __syncthreads();
}
constexpr size_t GDN_UNIT_ELEMS = 8192;
constexpr size_t WS_INTRA = WS_R2, WS_GLAST = WS_R2 + 16 * MiB;
constexpr int GP_ROWB = 272;
constexpr int GP_QB = 0, GP_KB = 17408, GP_VB = 34816, GP_AM = 52224, GP_SC = 68608, GP_HALF = 69632;
#define MFMA16(a, b, c) __builtin_amdgcn_mfma_f32_16x16x32_bf16((a), (b), (c), 0, 0, 0)

__device__ __forceinline__ void gdn_prep_phase(const Frame& F, const Args& a) {
    const bf16_t* F0 = (const bf16_t*)(F.ws + WS_BIG);
    bf16_t* Ut = (bf16_t*)a.out; bf16_t* Wm = Ut + (size_t)2048 * GDN_UNIT_ELEMS; bf16_t* QG = Wm + (size_t)2048 * GDN_UNIT_ELEMS; bf16_t* KGt = QG + (size_t)2048 * GDN_UNIT_ELEMS;
    bf16_t* INTRA = (bf16_t*)(F.ws + WS_INTRA); float* GLAST = (float*)(F.ws + WS_GLAST);
    const float* convw = a.in[IN_GCONV];
    const int hb = F.wave >> 2, wq = F.wave & 3, lane = F.lane, fr = lane & 15, fq = lane >> 4;
    LAS unsigned char* L = F.lds + hb * GP_HALF;
    LAS float* betaL = (LAS float*)(L + GP_SC); LAS float* gcL = betaL + 64;
    LAS float* Am = (LAS float*)(L + GP_AM);
    const int nhalf = F.G * 2, hid = F.bid * 2 + hb;
    LAS float* CW = (LAS float*)(F.lds + 2 * GP_HALF);
    { const int hh = (hid >> 6) & 3;
      for (int e = F.tid; e < 1536; e += NTHREADS) { const int X = e >> 9, i = (e >> 7) & 3, c = e & 127; CW[e] = convw[i * 1536 + X * 512 + hh * 128 + c]; } }
    __syncthreads();
#ifdef PROBE_GP_S1
    const int nrep_ = __builtin_amdgcn_readfirstlane(2 + (int)__hip_atomic_load(F.ctl + 6, __ATOMIC_RELAXED, __HIP_MEMORY_SCOPE_AGENT));
#endif
    for (int u = hid; u < 2048; u += nhalf) {
        const int n = u & 63, h = (u >> 6) & 3, b = u >> 8;
        const size_t m0 = (size_t)b * SEQ + (size_t)n * 64;
        const int tl0 = 16 * wq + 4 * fq;
        float bb = 0.f, aa = 0.f;
        if (wq == 0) { const size_t m = m0 + lane; bb = bf2f(F0[m * F0_LD + F0_BA + h]); aa = bf2f(F0[m * F0_LD + F0_BA + 4 + h]); }
#ifdef PROBE_GP_S1
#pragma unroll 1
        for (int rep_ = 0; rep_ < nrep_; ++rep_) {
#endif
        u32x4 rows[3][7];
        {
            const bool lowvalid = (n * 64 + tl0) > 0;
            const bf16_t* base = F0 + (m0 + tl0) * F0_LD + h * 128 + 8 * fr;
#pragma unroll
            for (int X = 0; X < 3; ++X)
#pragma unroll
                for (int r = 0; r < 7; ++r) {
                    const long ro = (r < 3 && !lowvalid) ? 0 : (long)(r - 3) * F0_LD;
                    rows[X][r] = *(const u32x4*)(base + ro + X * 512);
                }
            if (!lowvalid) {
#pragma unroll
                for (int X = 0; X < 3; ++X)
#pragma unroll
                    for (int r = 0; r < 3; ++r) rows[X][r] = (u32x4){0u, 0u, 0u, 0u};
            }
        }
        if (wq == 0) {
            const float beta = sigmoidf_(bb);
            float g = -__expf(a.in[IN_GALOG][h]) * softplusf_(aa + a.in[IN_GDT][h]);
#pragma unroll
            for (int o = 1; o < 64; o <<= 1) { const float t = __shfl_up(g, o); if (lane >= o) g += t; }
            betaL[lane] = beta; gcL[lane] = g;
            if (lane == 63) GLAST[u] = __expf(g);
        }
#pragma unroll
        for (int X = 0; X < 3; ++X) {
            float acc[4][8];
#pragma unroll
            for (int j = 0; j < 4; ++j)
#pragma unroll
                for (int e = 0; e < 8; ++e) acc[j][e] = 0.f;
#pragma unroll
            for (int i = 0; i < 4; ++i) {
                const f32x4 w0 = *(const LAS f32x4*)(CW + (X * 4 + i) * 128 + 8 * fr), w1 = *(const LAS f32x4*)(CW + (X * 4 + i) * 128 + 8 * fr + 4);
#pragma unroll
                for (int j = 0; j < 4; ++j) { const u32x4 xv = rows[X][j + i];
                    acc[j][0] += w0[0] * bflo(xv.x); acc[j][1] += w0[1] * bfhi(xv.x); acc[j][2] += w0[2] * bflo(xv.y); acc[j][3] += w0[3] * bfhi(xv.y);
                    acc[j][4] += w1[0] * bflo(xv.z); acc[j][5] += w1[1] * bfhi(xv.z); acc[j][6] += w1[2] * bflo(xv.w); acc[j][7] += w1[3] * bfhi(xv.w); }
            }
#pragma unroll
            for (int j = 0; j < 4; ++j) {
                float ss = 0.f;
#pragma unroll
                for (int e = 0; e < 8; ++e) { acc[j][e] = siluf_(acc[j][e]); ss += acc[j][e] * acc[j][e]; }
                float sc = 1.f;
                if (X < 2) {
#pragma unroll
                    for (int o = 1; o < 16; o <<= 1) ss += __shfl_xor(ss, o);
                    sc = rsqrtf(ss + 1e-6f) * (X == 0 ? 0.08838834764831845f : 1.f);
                }
                u32x4 o4; o4.x = pk2(acc[j][0] * sc, acc[j][1] * sc); o4.y = pk2(acc[j][2] * sc, acc[j][3] * sc); o4.z = pk2(acc[j][4] * sc, acc[j][5] * sc); o4.w = pk2(acc[j][6] * sc, acc[j][7] * sc);
                *(LAS u32x4*)(L + (X == 0 ? GP_QB : X == 1 ? GP_KB : GP_VB) + (tl0 + j) * GP_ROWB + fr * 16) = o4;
            }
        }
#ifdef PROBE_GP_S1
        }
#endif
        __syncthreads();
        {
            bf16x8 ka[4], qa[4];
#pragma unroll
            for (int ks = 0; ks < 4; ++ks) { ka[ks] = *(const LAS bf16x8*)(L + GP_KB + (16 * wq + fr) * GP_ROWB + (32 * ks + 8 * fq) * 2);
                                             qa[ks] = *(const LAS bf16x8*)(L + GP_QB + (16 * wq + fr) * GP_ROWB + (32 * ks + 8 * fq) * 2); }
            {
                const float eg = __expf(gcL[16 * wq + fr]);
#pragma unroll
                for (int ks = 0; ks < 4; ++ks) { const u32x4 qv = __builtin_bit_cast(u32x4, qa[ks]); u32x4 o4;
                    o4.x = pk2(bflo(qv.x) * eg, bfhi(qv.x) * eg); o4.y = pk2(bflo(qv.y) * eg, bfhi(qv.y) * eg); o4.z = pk2(bflo(qv.z) * eg, bfhi(qv.z) * eg); o4.w = pk2(bflo(qv.w) * eg, bfhi(qv.w) * eg);
                    *(u32x4*)(QG + (size_t)u * GDN_UNIT_ELEMS + (16 * wq + fr) * 128 + 32 * ks + 8 * fq) = o4; }
            }
            bf16_t* intra_u = INTRA + (size_t)u * 4096;
#pragma unroll
            for (int nt = 0; nt < 4; ++nt) {
                if (nt <= wq) {
                    f32x4 ckk = (f32x4){0.f, 0.f, 0.f, 0.f}, cqk = (f32x4){0.f, 0.f, 0.f, 0.f};
#pragma unroll
                    for (int ks = 0; ks < 4; ++ks) { const bf16x8 kb = *(const LAS bf16x8*)(L + GP_KB + (16 * nt + fr) * GP_ROWB + (32 * ks + 8 * fq) * 2);
                        ckk = MFMA16(ka[ks], kb, ckk); cqk = MFMA16(qa[ks], kb, cqk); }
                    const int j = 16 * nt + fr; const float gj = gcL[j];
#pragma unroll
                    for (int r = 0; r < 4; ++r) { const int i = 16 * wq + 4 * fq + r; const float d = __expf(gcL[i] - gj);
                        Am[i * 64 + j] = (i > j) ? betaL[i] * ckk[r] * d : 0.f;
                        intra_u[i * 64 + j] = (bf16_t)f2bf((i >= j) ? cqk[r] * d : 0.f); }
                } else {
#pragma unroll
                    for (int r = 0; r < 4; ++r) intra_u[(16 * wq + 4 * fq + r) * 64 + 16 * nt + fr] = 0;
                }
            }
        }
        __syncthreads();
        {
            const bool isk = wq >= 2; const int ch = (wq & 1) * 64 + lane;
            LAS unsigned char* X = L + (isk ? GP_KB : GP_VB);
            float sol[64];
#pragma unroll
            for (int t = 0; t < 64; ++t) sol[t] = bf2f(*(const LAS bf16_t*)(X + t * GP_ROWB + ch * 2));
            if (isk) {
                const float gl = gcL[63];
                u32x4* dst = (u32x4*)(KGt + (size_t)u * GDN_UNIT_ELEMS + ch * 64);
#pragma unroll
                for (int q8 = 0; q8 < 8; ++q8) { u32x4 o;
                    o.x = pk2(sol[8 * q8 + 0] * __expf(gl - gcL[8 * q8 + 0]), sol[8 * q8 + 1] * __expf(gl - gcL[8 * q8 + 1]));
                    o.y = pk2(sol[8 * q8 + 2] * __expf(gl - gcL[8 * q8 + 2]), sol[8 * q8 + 3] * __expf(gl - gcL[8 * q8 + 3]));
                    o.z = pk2(sol[8 * q8 + 4] * __expf(gl - gcL[8 * q8 + 4]), sol[8 * q8 + 5] * __expf(gl - gcL[8 * q8 + 5]));
                    o.w = pk2(sol[8 * q8 + 6] * __expf(gl - gcL[8 * q8 + 6]), sol[8 * q8 + 7] * __expf(gl - gcL[8 * q8 + 7]));
                    dst[q8] = o; }
#pragma unroll
                for (int t = 0; t < 64; ++t) sol[t] *= betaL[t] * __expf(gcL[t]);
            } else {
#pragma unroll
                for (int t = 0; t < 64; ++t) sol[t] *= betaL[t];
            }
#pragma unroll
            for (int i = 1; i < 64; ++i) {
                float s = sol[i];
#pragma unroll
                for (int j = 0; j < i; ++j) s -= Am[i * 64 + j] * sol[j];
                sol[i] = s;
            }
            if (isk) { bf16_t* dst = Wm + (size_t)u * GDN_UNIT_ELEMS + ch;
#pragma unroll
                for (int t = 0; t < 64; ++t) dst[t * 128] = (bf16_t)f2bf(sol[t]);
            } else { u32x4* dst = (u32x4*)(Ut + (size_t)u * GDN_UNIT_ELEMS + ch * 64);
#pragma unroll
                for (int q8 = 0; q8 < 8; ++q8) { u32x4 o; o.x = pk2(sol[8 * q8], sol[8 * q8 + 1]); o.y = pk2(sol[8 * q8 + 2], sol[8 * q8 + 3]); o.z = pk2(sol[8 * q8 + 4], sol[8 * q8 + 5]); o.w = pk2(sol[8 * q8 + 6], sol[8 * q8 + 7]); dst[q8] = o; }
            }
        }
        __syncthreads();
    }
}

constexpr int GS_W = 0, GS_Q = 17408, GS_I = 34816, GS_K = 44032, GS_U = 62464, GS_Z = 80896;
constexpr int GS_SSQ = GS_Z + 17408;
static_assert(GS_SSQ + 4096 <= XB_LDS_OFF, "gdn scan lds");
__device__ __forceinline__ float red16_dpp(float v) {
    v += dpp_f(v, 0); v += dpp_f(v, 1); v += dpp_f(v, 2);
    const int i = __builtin_bit_cast(int, v); v += __builtin_bit_cast(float, __builtin_amdgcn_update_dpp(i, i, 0x140, 0xF, 0xF, false));
    return v;
}
constexpr size_t WS_GSTATE = WS_R2 + 18 * MiB;
__device__ __forceinline__ bf16x8 lds_aperm(const LAS unsigned char* rowp, int k0, int fq) {
    const u32x2 a = *(const LAS u32x2*)(rowp + (k0 + 4 * fq) * 2), b = *(const LAS u32x2*)(rowp + (k0 + 16 + 4 * fq) * 2);
    u32x4 v; v.x = a.x; v.y = a.y; v.z = b.x; v.w = b.y; return __builtin_bit_cast(bf16x8, v);
}
__device__ __forceinline__ bf16x8 acc_bperm(const f32x4& lo, const f32x4& hi) {
    u32x4 v; v.x = pk2(lo[0], lo[1]); v.y = pk2(lo[2], lo[3]); v.z = pk2(hi[0], hi[1]); v.w = pk2(hi[2], hi[3]); return __builtin_bit_cast(bf16x8, v);
}
__device__ __forceinline__ void gdn_scan_unit(const Frame& F, const Args& a, int bh, int n0, int n1, bool dry = false) {
    const bf16_t* F0 = (const bf16_t*)(F.ws + WS_BIG);
    const bf16_t* Ut = (const bf16_t*)a.out; const bf16_t* Wm = Ut + (size_t)2048 * GDN_UNIT_ELEMS; const bf16_t* QG = Wm + (size_t)2048 * GDN_UNIT_ELEMS; const bf16_t* KGt = QG + (size_t)2048 * GDN_UNIT_ELEMS;
    const bf16_t* INTRA = (const bf16_t*)(F.ws + WS_INTRA); const float* GLAST = (const float*)(F.ws + WS_GLAST);
    bf16_t* OAB = (bf16_t*)(F.ws + WS_XN);
    const int w = F.wave, lane = F.lane, fr = lane & 15, fq = lane >> 4;
    const int h = bh & 3, b = bh >> 2;
    LAS unsigned char* L = F.lds;
    LAS float* ssq = (LAS float*)(L + GS_SSQ);
    LAS float* glp = ssq + 1000;
#define GS_BAR() do { asm volatile("s_waitcnt lgkmcnt(0)" ::: "memory"); __builtin_amdgcn_s_barrier(); asm volatile("" ::: "memory"); } while (0)
    if (w >= 4) {
        const int lt = F.tid - 256;
        struct GsSet { u32x4 pw[4], pq[4], pz[4], pk[4], pu[4], pi[2]; float pgl; };
        GsSet A, B;
#define GS_FETCH(P_, n_) do { const size_t u_ = (size_t)bh * 64 + (n_); \
            _Pragma("unroll") for (int i_ = 0; i_ < 4; ++i_) { const int e_ = lt + 256 * i_; P_.pw[i_] = *(const u32x4*)(Wm + u_ * GDN_UNIT_ELEMS + (size_t)e_ * 8); P_.pq[i_] = *(const u32x4*)(QG + u_ * GDN_UNIT_ELEMS + (size_t)e_ * 8); \
                P_.pk[i_] = *(const u32x4*)(KGt + u_ * GDN_UNIT_ELEMS + (size_t)e_ * 8); P_.pu[i_] = *(const u32x4*)(Ut + u_ * GDN_UNIT_ELEMS + (size_t)e_ * 8); \
                P_.pz[i_] = *(const u32x4*)(F0 + ((size_t)b * SEQ + (size_t)(n_) * 64 + (e_ >> 4)) * F0_LD + 1536 + h * 128 + (e_ & 15) * 8); } \
            _Pragma("unroll") for (int i_ = 0; i_ < 2; ++i_) P_.pi[i_] = *(const u32x4*)(INTRA + u_ * 4096 + (size_t)(lt + 256 * i_) * 8); \
            P_.pgl = GLAST[u_]; } while (0)
#define GS_STORE(P_, n_) do { \
            _Pragma("unroll") for (int i_ = 0; i_ < 4; ++i_) { const int e_ = lt + 256 * i_; \
                *(LAS u32x4*)(L + GS_W + (e_ >> 4) * 272 + (e_ & 15) * 16) = P_.pw[i_]; *(LAS u32x4*)(L + GS_Q + (e_ >> 4) * 272 + (e_ & 15) * 16) = P_.pq[i_]; *(LAS u32x4*)(L + GS_Z + (e_ >> 4) * 272 + (e_ & 15) * 16) = P_.pz[i_]; \
                *(LAS u32x4*)(L + GS_K + (e_ >> 3) * 144 + (e_ & 7) * 16) = P_.pk[i_]; *(LAS u32x4*)(L + GS_U + (e_ >> 3) * 144 + (e_ & 7) * 16) = P_.pu[i_]; } \
            _Pragma("unroll") for (int i_ = 0; i_ < 2; ++i_) { const int e_ = lt + 256 * i_; *(LAS u32x4*)(L + GS_I + (e_ >> 3) * 144 + (e_ & 7) * 16) = P_.pi[i_]; } \
            if (lt == 0) glp[(n_) & 1] = P_.pgl; } while (0)
        GS_FETCH(A, n0);
        if (n0 + 1 < n1) GS_FETCH(B, n0 + 1);
        __syncthreads();
        GS_STORE(A, n0);
        GS_BAR();
#pragma unroll 1
        for (int n = n0; n < n1; n += 2) {
            if (n + 2 < n1) GS_FETCH(A, n + 2);
            GS_BAR();
            if (n + 1 < n1) GS_STORE(B, n + 1);
            GS_BAR();
            if (n + 3 < n1) GS_FETCH(B, n + 3);
            GS_BAR();
            if (n + 2 < n1) GS_STORE(A, n + 2);
            GS_BAR();
        }
#undef GS_FETCH
#undef GS_STORE
    } else {
        f32x4 S[2][8]; f32x4* GST = (f32x4*)(F.ws + WS_GSTATE) + ((size_t)bh * 8 + 2 * w) * 512;
#pragma unroll
        for (int nt = 0; nt < 2; ++nt)
#pragma unroll
            for (int d = 0; d < 8; ++d) S[nt][d] = (n0 == 0) ? (f32x4){0.f, 0.f, 0.f, 0.f} : GST[nt * 512 + d * 64 + lane];
        float gnw[2]; gnw[0] = a.in[IN_GNORM][32 * w + fr]; gnw[1] = a.in[IN_GNORM][32 * w + 16 + fr];
        __syncthreads();
        GS_BAR();
#pragma unroll 1
        for (int n = n0; n < n1; ++n) {
            const float gl = glp[n & 1];
            bf16x8 Sb[2][4];
#pragma unroll
            for (int nt = 0; nt < 2; ++nt)
#pragma unroll
                for (int ks = 0; ks < 4; ++ks) Sb[nt][ks] = acc_bperm(S[nt][2 * ks], S[nt][2 * ks + 1]);
            f32x4 vn[2][4], o[2][4];
#pragma unroll
            for (int mt = 0; mt < 4; ++mt) { f32x4 p0 = (f32x4){0.f, 0.f, 0.f, 0.f}, p1 = p0, q0 = p0, q1 = p0;
                const LAS unsigned char* wrow = L + GS_W + (16 * mt + fr) * 272; const LAS unsigned char* qrow = L + GS_Q + (16 * mt + fr) * 272;
#pragma unroll
                for (int ks = 0; ks < 4; ++ks) { const bf16x8 wa = lds_aperm(wrow, 32 * ks, fq), qa = lds_aperm(qrow, 32 * ks, fq);
                    p0 = MFMA16(wa, Sb[0][ks], p0); p1 = MFMA16(wa, Sb[1][ks], p1); q0 = MFMA16(qa, Sb[0][ks], q0); q1 = MFMA16(qa, Sb[1][ks], q1); }
                const u32x2 u0 = *(const LAS u32x2*)(L + GS_U + (32 * w + fr) * 144 + (16 * mt + 4 * fq) * 2), u1 = *(const LAS u32x2*)(L + GS_U + (32 * w + 16 + fr) * 144 + (16 * mt + 4 * fq) * 2);
                vn[0][mt] = (f32x4){bflo(u0.x) - p0[0], bfhi(u0.x) - p0[1], bflo(u0.y) - p0[2], bfhi(u0.y) - p0[3]};
                vn[1][mt] = (f32x4){bflo(u1.x) - p1[0], bfhi(u1.x) - p1[1], bflo(u1.y) - p1[2], bfhi(u1.y) - p1[3]};
                o[0][mt] = q0; o[1][mt] = q1; }
            bf16x8 Vb[2][2];
#pragma unroll
            for (int nt = 0; nt < 2; ++nt)
#pragma unroll
                for (int ks = 0; ks < 2; ++ks) Vb[nt][ks] = acc_bperm(vn[nt][2 * ks], vn[nt][2 * ks + 1]);
#pragma unroll
            for (int mt = 0; mt < 4; ++mt) { const LAS unsigned char* irow = L + GS_I + (16 * mt + fr) * 144;
#pragma unroll
                for (int ks = 0; ks < 2; ++ks) { const bf16x8 ia = lds_aperm(irow, 32 * ks, fq); o[0][mt] = MFMA16(ia, Vb[0][ks], o[0][mt]); o[1][mt] = MFMA16(ia, Vb[1][ks], o[1][mt]); } }
#pragma unroll
            for (int d = 0; d < 8; ++d) { S[0][d] = S[0][d] * gl; S[1][d] = S[1][d] * gl; const LAS unsigned char* krow = L + GS_K + (16 * d + fr) * 144;
#pragma unroll
                for (int ks = 0; ks < 2; ++ks) { const bf16x8 ka = lds_aperm(krow, 32 * ks, fq); S[0][d] = MFMA16(ka, Vb[0][ks], S[0][d]); S[1][d] = MFMA16(ka, Vb[1][ks], S[1][d]); } }
            LAS float* sq = ssq + (n & 1) * 256;
            float zv[2][16];
#pragma unroll
            for (int mt = 0; mt < 4; ++mt)
#pragma unroll
                for (int r = 0; r < 4; ++r) { const int t = 16 * mt + 4 * fq + r; const float s = red16_dpp(o[0][mt][r] * o[0][mt][r] + o[1][mt][r] * o[1][mt][r]); if (fr == 0) sq[w * 64 + t] = s;
                    zv[0][4 * mt + r] = bf2f(*(const LAS bf16_t*)(L + GS_Z + t * 272 + (32 * w + fr) * 2)); zv[1][4 * mt + r] = bf2f(*(const LAS bf16_t*)(L + GS_Z + t * 272 + (32 * w + 16 + fr) * 2)); }
            GS_BAR();
#pragma unroll
            for (int mt = 0; mt < 4; ++mt)
#pragma unroll
                for (int r = 0; r < 4; ++r) { const int t = 16 * mt + 4 * fq + r; const float s = (sq[t] + sq[64 + t]) + (sq[128 + t] + sq[192 + t]);
                    const float rstd = rsqrtf(s * (1.f / 128.f) + NORM_EPS);
                    const size_t m = (size_t)b * SEQ + (size_t)n * 64 + t;
                    if (!dry) { OAB[m * 1024 + h * 128 + 32 * w + fr] = (bf16_t)f2bf(o[0][mt][r] * rstd * gnw[0] * siluf_(zv[0][4 * mt + r]));
                                OAB[m * 1024 + h * 128 + 32 * w + 16 + fr] = (bf16_t)f2bf(o[1][mt][r] * rstd * gnw[1] * siluf_(zv[1][4 * mt + r])); } }
            GS_BAR();
        }
#pragma unroll
        for (int nt = 0; nt < 2; ++nt)
#pragma unroll
            for (int d = 0; d < 8; ++d) if (!dry) GST[nt * 512 + d * 64 + lane] = S[nt][d];
    }
#undef GS_BAR
}
constexpr int RW_L = 16;
constexpr int RW_W2T = 0, RW_A2T = 9216, RW_G2T = 18432;
constexpr int RW_OPS = 35840, RW_OPS_SZ = 24576;
constexpr int RW_YB = RW_OPS + 2 * RW_OPS_SZ, RW_YB_SZ = 4096;
constexpr int RW_XS = RW_YB + 2 * RW_YB_SZ, RW_XS_W = 2240;
constexpr int RW_XS_AD = 576, RW_XS_GD = 1152;
constexpr int RW_POST = RW_XS + 4 * RW_XS_W, RW_POST_SZ = 8192;
static_assert(RW_POST + 3 * RW_POST_SZ <= XB_LDS_OFF, "rwkv lds");
#define RW_BAR() do { asm volatile("s_waitcnt lgkmcnt(0)" ::: "memory"); __builtin_amdgcn_s_barrier(); asm volatile("" ::: "memory"); } while (0)
__device__ __forceinline__ float wave_sum_rl(float v) {
    v = red16_dpp(v);
    const int i = __builtin_bit_cast(int, v);
    return (__builtin_bit_cast(float, __builtin_amdgcn_readlane(i, 0)) + __builtin_bit_cast(float, __builtin_amdgcn_readlane(i, 16))) + (__builtin_bit_cast(float, __builtin_amdgcn_readlane(i, 32)) + __builtin_bit_cast(float, __builtin_amdgcn_readlane(i, 48)));
}

__device__ __forceinline__ void rwkv_unit(const Frame& F, const Args& a, int bh) {
    const bf16_t* F0 = (const bf16_t*)(F.ws + WS_BIG);
    bf16_t* OAB = (bf16_t*)(F.ws + WS_XN);
    const int h = bh & 7, b = bh >> 3, tid = F.tid, lane = F.lane, wave = F.wave, fr = lane & 15, fq = lane >> 4;
    LAS unsigned char* L = F.lds;
    for (int idx = tid; idx < 64 * 64; idx += NTHREADS) { const int j = idx >> 6, c = idx & 63;
        *(LAS bf16_t*)(L + RW_W2T + c * 144 + j * 2) = (bf16_t)f2bf(a.in[IN_RW2][j * 512 + h * 64 + c]);
        *(LAS bf16_t*)(L + RW_A2T + c * 144 + j * 2) = (bf16_t)f2bf(a.in[IN_RA2][j * 512 + h * 64 + c]); }
    for (int idx = tid; idx < 128 * 64; idx += NTHREADS) { const int j = idx >> 6, c = idx & 63;
        *(LAS bf16_t*)(L + RW_G2T + c * 272 + j * 2) = (bf16_t)f2bf(a.in[IN_RG2][j * 512 + h * 64 + c]); }
    RW_BAR();
    const size_t mb = (size_t)b * SEQ;
    if (wave < 4) {
        f32x2 S0[4], S1[4];
#pragma unroll
        for (int k = 0; k < 4; ++k) { S0[k] = (f32x2){0.f, 0.f}; S1[k] = (f32x2){0.f, 0.f}; }
        const int cg = lane & 7, row0 = 16 * wave + 2 * (lane >> 3);
        RW_BAR();
#pragma unroll 1
        for (int c = 0; c < SEQ / RW_L; ++c) {
            LAS unsigned char* ops = L + RW_OPS + (c & 1) * RW_OPS_SZ; LAS float* yb = (LAS float*)(L + RW_YB + (c & 1) * RW_YB_SZ);
            f32x4 wA, wB, kkA, kkB, bA, bB, kA, kB, rA, rB; f32x2 vv;
#define RW_LOADOPS(s_) do { const LAS float* po_ = (const LAS float*)(ops + (s_) * 1536) + 8 * cg; \
                wA = *(const LAS f32x4*)(po_); wB = *(const LAS f32x4*)(po_ + 4); kkA = *(const LAS f32x4*)(po_ + 64); kkB = *(const LAS f32x4*)(po_ + 68); \
                bA = *(const LAS f32x4*)(po_ + 128); bB = *(const LAS f32x4*)(po_ + 132); kA = *(const LAS f32x4*)(po_ + 192); kB = *(const LAS f32x4*)(po_ + 196); \
                rA = *(const LAS f32x4*)(po_ + 256); rB = *(const LAS f32x4*)(po_ + 260); vv = *(const LAS f32x2*)((const LAS float*)(ops + (s_) * 1536) + 320 + row0); } while (0)
            RW_LOADOPS(0);
#pragma unroll 1
            for (int s = 0; s < RW_L; ++s) {
                const f32x2 kk2[4] = {{kkA[0], kkA[1]}, {kkA[2], kkA[3]}, {kkB[0], kkB[1]}, {kkB[2], kkB[3]}};
                const f32x2 w2[4] = {{wA[0], wA[1]}, {wA[2], wA[3]}, {wB[0], wB[1]}, {wB[2], wB[3]}};
                const f32x2 b2[4] = {{bA[0], bA[1]}, {bA[2], bA[3]}, {bB[0], bB[1]}, {bB[2], bB[3]}};
                const f32x2 k2[4] = {{kA[0], kA[1]}, {kA[2], kA[3]}, {kB[0], kB[1]}, {kB[2], kB[3]}};
                const f32x2 r2[4] = {{rA[0], rA[1]}, {rA[2], rA[3]}, {rB[0], rB[1]}, {rB[2], rB[3]}};
                const f32x2 v0 = {vv[0], vv[0]}, v1 = {vv[1], vv[1]};
                if (s + 1 < RW_L) RW_LOADOPS(s + 1);
                f32x2 a0 = S0[0] * kk2[0] + S0[1] * kk2[1], a1 = S1[0] * kk2[0] + S1[1] * kk2[1];
                a0 = a0 + S0[2] * kk2[2] + S0[3] * kk2[3]; a1 = a1 + S1[2] * kk2[2] + S1[3] * kk2[3];
                const float sa0 = red8_dpp(a0[0] + a0[1]), sa1 = red8_dpp(a1[0] + a1[1]);
                const f32x2 n0 = {-sa0, -sa0}, n1 = {-sa1, -sa1};
                f32x2 y0 = {0.f, 0.f}, y1 = {0.f, 0.f};
#pragma unroll
                for (int q = 0; q < 4; ++q) { S0[q] = S0[q] * w2[q] + n0 * b2[q] + v0 * k2[q]; S1[q] = S1[q] * w2[q] + n1 * b2[q] + v1 * k2[q]; y0 = y0 + S0[q] * r2[q]; y1 = y1 + S1[q] * r2[q]; }
                const float ys0 = red8_dpp(y0[0] + y0[1]), ys1 = red8_dpp(y1[0] + y1[1]);
                if (cg == 0) *(LAS f32x2*)(yb + s * 64 + row0) = (f32x2){ys0, ys1};
            }
#undef RW_LOADOPS
            RW_BAR();
        }
        RW_BAR();
    } else {
        const int p = wave - 4, hc = h * 64 + lane;
        LAS unsigned char* XS = L + RW_XS + p * RW_XS_W;
        const float w0c = a.in[IN_RW0][hc], a0c = a.in[IN_RA0][hc], kkc = a.in[IN_RKK][hc], kac = a.in[IN_RKA][hc], rkc = a.in[IN_RRK][hc], lnw = a.in[IN_RLNW][hc], lnb = a.in[IN_RLNB][hc];
        float mu[7];
#pragma unroll
        for (int g = 0; g < 3; ++g) mu[g] = a.in[IN_RMU][g * 512 + hc];
#pragma unroll
        for (int g = 3; g < 7; ++g) mu[g] = a.in[IN_RMU][1536 + (g - 3) * 64 + lane];
        bf16_t fv[5][7];
#define RW_FETCH(cn_) do { const long t0_ = (long)(cn_) * RW_L + 4 * p - 1; \
            _Pragma("unroll") for (int j_ = 0; j_ < 5; ++j_) { const long t_ = t0_ + j_; \
                _Pragma("unroll") for (int g_ = 0; g_ < 7; ++g_) { const int col_ = F0_RWKV + (g_ < 3 ? g_ * 512 + h * 64 : 1536 + (g_ - 3) * 64) + lane; fv[j_][g_] = (t_ >= 0) ? F0[(mb + t_) * F0_LD + col_] : (bf16_t)0; } } } while (0)
        RW_FETCH(0);
#pragma unroll 1
        for (int c = -1; c <= SEQ / RW_L; ++c) {
            const bool prep_on = (c + 1 < SEQ / RW_L), post_on = (c >= 1);
            if (post_on) {
                const LAS float* yb = (const LAS float*)(L + RW_YB + ((c - 1) & 1) * RW_YB_SZ); const LAS float* pg = (const LAS float*)(L + RW_POST + ((c - 1) % 3) * RW_POST_SZ);
#pragma unroll
                for (int j = 0; j < 4; ++j) { const int tau = 4 * p + j; const float y = yb[tau * 64 + lane];
                    const float mean = wave_sum_rl(y) * (1.f / 64.f); const float d = y - mean; const float var = wave_sum_rl(d * d) * (1.f / 64.f);
                    const float o = (d * rsqrtf(var + RWKV_LN_EPS) * lnw + lnb + pg[1024 + tau * 64 + lane]) * pg[tau * 64 + lane];
                    OAB[(mb + (size_t)(c - 1) * RW_L + tau) * 1024 + 512 + hc] = (bf16_t)f2bf(o); }
            }
            if (prep_on) {
                LAS unsigned char* nops = L + RW_OPS + ((c + 1) & 1) * RW_OPS_SZ; LAS float* pg_n = (LAS float*)(L + RW_POST + ((c + 1) % 3) * RW_POST_SZ);
                float xr[4], xk[4], xv[4];
#pragma unroll
                for (int j = 0; j < 4; ++j) {
                    float xs[7];
#pragma unroll
                    for (int g = 0; g < 7; ++g) { const float f = bf2f(fv[j + 1][g]), fp = bf2f(fv[j][g]); xs[g] = f + (fp - f) * mu[g]; }
                    xr[j] = xs[0]; xk[j] = xs[1]; xv[j] = xs[2];
                    *(LAS bf16_t*)(XS + j * 144 + lane * 2) = (bf16_t)f2bf(fast_tanhf(xs[3]));
                    *(LAS bf16_t*)(XS + RW_XS_AD + j * 144 + lane * 2) = (bf16_t)f2bf(xs[4]);
                    *(LAS bf16_t*)(XS + RW_XS_GD + j * 272 + lane * 2) = (bf16_t)f2bf(sigmoidf_(xs[5]));
                    *(LAS bf16_t*)(XS + RW_XS_GD + j * 272 + 128 + lane * 2) = (bf16_t)f2bf(sigmoidf_(xs[6]));
                }
                if (c + 2 < SEQ / RW_L) RW_FETCH(c + 2);
                asm volatile("s_waitcnt lgkmcnt(0)" ::: "memory");
                f32x4 cw = (f32x4){0.f, 0.f, 0.f, 0.f}, ca = cw, cgt = cw;
                {
                    bf16x8 xa[2], xb[2], xg[4];
#pragma unroll
                    for (int ks = 0; ks < 2; ++ks) { xa[ks] = *(const LAS bf16x8*)(XS + (fr & 3) * 144 + (32 * ks + 8 * fq) * 2); xb[ks] = *(const LAS bf16x8*)(XS + RW_XS_AD + (fr & 3) * 144 + (32 * ks + 8 * fq) * 2); }
#pragma unroll
                    for (int ks = 0; ks < 4; ++ks) xg[ks] = *(const LAS bf16x8*)(XS + RW_XS_GD + (fr & 3) * 272 + (32 * ks + 8 * fq) * 2);
#pragma unroll
                    for (int nt = 0; nt < 4; ++nt) {
                        f32x4 tw = (f32x4){0.f, 0.f, 0.f, 0.f}, ta = tw, tg = tw;
#pragma unroll
                        for (int ks = 0; ks < 2; ++ks) { tw = MFMA16(xa[ks], *(const LAS bf16x8*)(L + RW_W2T + (16 * nt + fr) * 144 + (32 * ks + 8 * fq) * 2), tw);
                                                         ta = MFMA16(xb[ks], *(const LAS bf16x8*)(L + RW_A2T + (16 * nt + fr) * 144 + (32 * ks + 8 * fq) * 2), ta); }
#pragma unroll
                        for (int ks = 0; ks < 4; ++ks) tg = MFMA16(xg[ks], *(const LAS bf16x8*)(L + RW_G2T + (16 * nt + fr) * 272 + (32 * ks + 8 * fq) * 2), tg);
                        if (fq == nt) { cw = tw; ca = ta; cgt = tg; }
                    }
                }
#pragma unroll
                for (int j = 0; j < 4; ++j) { const int tau = 4 * p + j; LAS float* o = (LAS float*)(nops + tau * 1536);
                    const float lw = cw[j] + w0c; const float wlog = -fast_softplusf(-lw) - 0.5f; const float wdec = __expf(-__expf(wlog));
                    const float av = sigmoidf_(ca[j] + a0c);
                    const float kkraw = xk[j] * kkc, kp = xk[j] * (1.f + (av - 1.f) * kac);
                    const float rinv = rsqrtf(wave_sum_rl(kkraw * kkraw) + 1e-6f);
                    const float bn = wave_sum_rl(xr[j] * kp * rkc);
                    const float kkn = kkraw * rinv;
                    o[lane] = wdec; o[64 + lane] = kkn; o[128 + lane] = kkn * av; o[192 + lane] = kp; o[256 + lane] = xr[j]; o[320 + lane] = xv[j];
                    pg_n[tau * 64 + lane] = cgt[j]; pg_n[1024 + tau * 64 + lane] = xv[j] * bn; }
            }
            RW_BAR();
        }
#undef RW_FETCH
    }
    __syncthreads();
}
constexpr int RC_KR = 0, RC_BKT = 4096, RC_VT = 8192, RC_MBB = 10240, RC_MKB = 11264, RC_MBR = 11776, RC_MKR = 12288, RC_WL = 12800, RC_PG = 13056, RC_PBV = 15104, RC_REC = 17408;
constexpr int RC_SEG_CHUNKS = 32, RC_NSEG = (SEQ / 16) / RC_SEG_CHUNKS;
constexpr size_t WS_RSCR = WS_R2 + 21 * MiB;
constexpr size_t WS_RSTATE = WS_R2 + 17 * MiB;
constexpr size_t WS_RIMG = WS_R2 + 20 * MiB;
constexpr int RP_PRM = 35840;
constexpr int RP_MU = RP_PRM + 1280;
constexpr int RP_WAVE = RP_MU + 1792, RP_WAVE_SZ = 9216;
static_assert(RP_WAVE + 8 * RP_WAVE_SZ <= XB_LDS_OFF, "rwkv prep lds");
__device__ __forceinline__ float dpp_shr_f(float v, const int n) {
    const int i = __builtin_bit_cast(int, v); int r;
    if (n == 1) r = __builtin_amdgcn_update_dpp(0, i, 0x111, 0xF, 0xF, true); else if (n == 2) r = __builtin_amdgcn_update_dpp(0, i, 0x112, 0xF, 0xF, true);
    else if (n == 4) r = __builtin_amdgcn_update_dpp(0, i, 0x114, 0xF, 0xF, true); else r = __builtin_amdgcn_update_dpp(0, i, 0x118, 0xF, 0xF, true);
    return __builtin_bit_cast(float, r);
}
__device__ __forceinline__ void rwkvc_prep_phase(const Frame& F, const Args& a, int sg) {
    const bf16_t* F0 = (const bf16_t*)(F.ws + WS_BIG);
    unsigned char* SCR = F.ws + WS_RSCR;
    const int tid = F.tid, wave = F.wave;
    LAS unsigned char* L = F.lds;
    for (int blk = F.bid; blk < 256; blk += F.G) {
        const int bh = blk >> 2, h = bh & 7, b = bh >> 3;
        const size_t mb = (size_t)b * SEQ;
        LAS unsigned char* XS = L + RP_WAVE + wave * RP_WAVE_SZ;
            int ln_ = F.lane; asm volatile("" : "+v"(ln_));
            const int lane = ln_, fr = ln_ & 15, fq = ln_ >> 4;
            const int cs = (blk & 3) * 8 + wave;
            const int t0 = (sg * RC_SEG_CHUNKS + cs) * 16;
            unsigned char* rec = SCR + ((size_t)bh * RC_SEG_CHUNKS + cs) * RC_REC;
            const bf16_t* rowc = F0 + (mb + t0 + fr) * F0_LD + F0_RWKV;
            const bool hasp = (t0 + fr) > 0; const bf16_t* rowp = rowc - (hasp ? F0_LD : 0);
            const bf16_t* rc4 = rowc + 4 * fq; const bf16_t* rp4 = rowp + 4 * fq; const LAS float* mul4 = (const LAS float*)(L + RP_MU) + 4 * fq;
            unsigned char* pbkt = rec + RC_BKT + fq * 256 + (fr >> 2) * 16 + (fr & 3) * 2;
            unsigned char* pvt = rec + RC_VT + fq * 128 + fr * 2;
            unsigned char* pwl = rec + RC_WL + fq * 16;
            unsigned char* ppg = rec + RC_PG + fr * 128 + fq * 8;
            LAS unsigned char* xs4 = XS + fr * 144 + fq * 8;
            u32x2 rawc[7][4], rawp[7][4];
#pragma unroll
            for (int g = 3; g < 7; ++g)
#pragma unroll
                for (int mt = 0; mt < 4; ++mt) { const int coff = 1536 + 64 * (g - 3) + 16 * mt; rawc[g][mt] = *(const u32x2*)(rc4 + coff); rawp[g][mt] = *(const u32x2*)(rp4 + coff); }
        __syncthreads();
        {
            const u32x4* src = (const u32x4*)(F.ws + WS_RIMG + (size_t)h * 35840);
            u32x4 t4[5];
#pragma unroll
            for (int i = 0; i < 5; ++i) { const int e = tid + NTHREADS * i; t4[i] = (e < 2240) ? src[e] : (u32x4){0u, 0u, 0u, 0u}; }
#pragma unroll
            for (int i = 0; i < 5; ++i) { const int e = tid + NTHREADS * i; if (e < 2240) *(LAS u32x4*)(L + e * 16) = t4[i]; }
        }
        if (tid < 320) { const int wh = tid >> 6, c = tid & 63; const float* src = wh == 0 ? a.in[IN_RW0] : wh == 1 ? a.in[IN_RA0] : wh == 2 ? a.in[IN_RKK] : wh == 3 ? a.in[IN_RKA] : a.in[IN_RRK];
            ((LAS float*)(L + RP_PRM))[tid] = src[h * 64 + c]; }
        if (tid < 448) ((LAS float*)(L + RP_MU))[tid] = a.in[IN_RMU][tid < 192 ? (tid >> 6) * 512 + h * 64 + (tid & 63) : 1536 + (tid - 192)];
        __syncthreads();
        const LAS float* PRM = (const LAS float*)(L + RP_PRM);
        {
#pragma unroll
            for (int g = 0; g < 4; ++g) {
                const int coff = 1536 + 64 * g;
#pragma unroll
                for (int mt = 0; mt < 4; ++mt) { const int j0 = 16 * mt + 4 * fq;
                    const u32x2 fc = rawc[3 + g][mt]; u32x2 fp = rawp[3 + g][mt]; if (!hasp) fp = (u32x2){0u, 0u};
                    const f32x4 mu = *(const LAS f32x4*)(mul4 + 192 + 64 * g + 16 * mt);
                    float x[4] = {bflo(fc.x), bfhi(fc.x), bflo(fc.y), bfhi(fc.y)}; const float xp[4] = {bflo(fp.x), bfhi(fp.x), bflo(fp.y), bfhi(fp.y)};
#pragma unroll
                    for (int e = 0; e < 4; ++e) { x[e] = x[e] + (xp[e] - x[e]) * mu[e]; x[e] = (g == 0) ? fast_tanhf(x[e]) : (g == 1) ? x[e] : sigmoidf_(x[e]); }
                    u32x2 o; o.x = pk2(x[0], x[1]); o.y = pk2(x[2], x[3]);
                    LAS unsigned char* dst = (g == 0) ? XS + fr * 144 + j0 * 2 : (g == 1) ? XS + 2304 + fr * 144 + j0 * 2 : XS + 4608 + fr * 272 + (g - 2) * 128 + j0 * 2;
                    *(LAS u32x2*)dst = o; } }
#pragma unroll
            for (int g = 0; g < 3; ++g)
#pragma unroll
                for (int mt = 0; mt < 4; ++mt) { const int coff = g * 512 + h * 64 + 16 * mt; rawc[g][mt] = *(const u32x2*)(rc4 + coff); rawp[g][mt] = *(const u32x2*)(rp4 + coff); }
            asm volatile("s_waitcnt lgkmcnt(0)" ::: "memory");
            float vr[16], vk[16], vv[16], ve[16], vkk[16], vb[16];
            float ss = 0.f, bn = 0.f;
            bf16x8 xw[2], xa[2], xg[4];
#pragma unroll
            for (int ks = 0; ks < 2; ++ks) { xw[ks] = *(const LAS bf16x8*)(XS + fr * 144 + (32 * ks + 8 * fq) * 2); xa[ks] = *(const LAS bf16x8*)(XS + 2304 + fr * 144 + (32 * ks + 8 * fq) * 2); }
#pragma unroll
            for (int ks = 0; ks < 4; ++ks) xg[ks] = *(const LAS bf16x8*)(XS + 4608 + fr * 272 + (32 * ks + 8 * fq) * 2);
#pragma unroll
            for (int mt = 0; mt < 4; ++mt) {
#pragma unroll
                for (int g = 0; g < 3; ++g) { const int coff = g * 512 + 16 * mt;
                    const u32x2 fc = rawc[g][mt]; u32x2 fp = rawp[g][mt]; if (!hasp) fp = (u32x2){0u, 0u};
                    const f32x4 mu = *(const LAS f32x4*)(mul4 + 64 * g + 16 * mt);
                    const float x[4] = {bflo(fc.x), bfhi(fc.x), bflo(fc.y), bfhi(fc.y)}; const float xp[4] = {bflo(fp.x), bfhi(fp.x), bflo(fp.y), bfhi(fp.y)};
#pragma unroll
                    for (int e = 0; e < 4; ++e) { const float xs = x[e] + (xp[e] - x[e]) * mu[e]; if (g == 0) vr[4 * mt + e] = xs; else if (g == 1) vk[4 * mt + e] = xs; else vv[4 * mt + e] = xs; } }
                f32x4 cw = (f32x4){0.f, 0.f, 0.f, 0.f}, ca = cw, cg = cw;
#pragma unroll
                for (int ks = 0; ks < 2; ++ks) { cw = MFMA16(*(const LAS bf16x8*)(L + RW_W2T + (16 * mt + fr) * 144 + (32 * ks + 8 * fq) * 2), xw[ks], cw);
                                                 ca = MFMA16(*(const LAS bf16x8*)(L + RW_A2T + (16 * mt + fr) * 144 + (32 * ks + 8 * fq) * 2), xa[ks], ca); }
#pragma unroll
                for (int ks = 0; ks < 4; ++ks) cg = MFMA16(*(const LAS bf16x8*)(L + RW_G2T + (16 * mt + fr) * 272 + (32 * ks + 8 * fq) * 2), xg[ks], cg);
#pragma unroll
                for (int r = 0; r < 4; ++r) { const int q = 4 * mt + r, c = 16 * mt + 4 * fq + r;
                    const float lw = cw[r] + PRM[c]; ve[q] = 0.6065306597126334f * sigmoidf_(lw);
                    const float av = sigmoidf_(ca[r] + PRM[64 + c]);
                    const float kraw = vk[q] * PRM[128 + c]; vk[q] = vk[q] * (1.f + (av - 1.f) * PRM[192 + c]);
                    vkk[q] = kraw; vb[q] = av; ss += kraw * kraw; bn += vr[q] * vk[q] * PRM[256 + c]; }
                { u32x2 og; og.x = pk2(cg[0], cg[1]); og.y = pk2(cg[2], cg[3]); *(u32x2*)(ppg + mt * 32) = og; }
                asm volatile("" ::: "memory");
            }
            ss += __shfl_xor(ss, 16); ss += __shfl_xor(ss, 32); bn += __shfl_xor(bn, 16); bn += __shfl_xor(bn, 32);
            const float rinv = rsqrtf(ss + 1e-6f);
#pragma unroll
            for (int mt = 0; mt < 4; ++mt) { u32x2 ob; ob.x = pk2(vv[4 * mt] * bn, vv[4 * mt + 1] * bn); ob.y = pk2(vv[4 * mt + 2] * bn, vv[4 * mt + 3] * bn); *(u32x2*)(ppg + 2048 + mt * 32) = ob; }
#pragma unroll
            for (int ks = 0; ks < 2; ++ks) {
                float kkt[8], rt[8], bh_[8], kh[8];
#pragma unroll
                for (int i = 0; i < 8; ++i) { const int q = 8 * ks + i;
                    float cl = ve[q];
                    cl += dpp_shr_f(cl, 1); cl += dpp_shr_f(cl, 2); cl += dpp_shr_f(cl, 4); cl += dpp_shr_f(cl, 8);
                    const float clL = __shfl(cl, (lane & 48) | 15);
                    const float kkn = vkk[q] * rinv, bq = kkn * vb[q];
                    const float W = __expf(-cl), Wp = __expf(ve[q] - cl), Wi = __expf(cl), WLr = __expf(cl - clL);
                    kkt[i] = kkn * Wp; rt[i] = vr[q] * W; bh_[i] = bq * Wi; kh[i] = vk[q] * Wi;
                    *(bf16_t*)(pbkt + (q >> 2) * 1024 + (q & 3) * 64) = (bf16_t)f2bf(-bq * WLr);
                    *(bf16_t*)(pbkt + (q >> 2) * 1024 + (q & 3) * 64 + 8) = (bf16_t)f2bf(vk[q] * WLr);
                    *(bf16_t*)(pvt + (q >> 2) * 512 + (q & 3) * 32) = (bf16_t)f2bf(vv[q]);
                    if (fr == 15) *(float*)(pwl + (q >> 2) * 64 + (q & 3) * 4) = W;
                }
                u32x4 o1, o2;
                o1.x = pk2(kkt[0], kkt[1]); o1.y = pk2(kkt[2], kkt[3]); o1.z = pk2(kkt[4], kkt[5]); o1.w = pk2(kkt[6], kkt[7]);
                o2.x = pk2(rt[0], rt[1]); o2.y = pk2(rt[2], rt[3]); o2.z = pk2(rt[4], rt[5]); o2.w = pk2(rt[6], rt[7]);
                *(u32x4*)(rec + RC_KR + fr * 128 + ks * 64 + fq * 16) = o1; *(u32x4*)(rec + RC_KR + 2048 + fr * 128 + ks * 64 + fq * 16) = o2;
#pragma unroll
                for (int m2 = 0; m2 < 2; ++m2) { const int mt = 2 * ks + m2; LAS unsigned char* xo = xs4 + mt * 32;
                    *(LAS u32x2*)(xo) = (u32x2){o1[2 * m2], o1[2 * m2 + 1]};
                    *(LAS u32x2*)(xo + 2304) = (u32x2){o2[2 * m2], o2[2 * m2 + 1]};
                    u32x2 o; o.x = pk2(bh_[4 * m2], bh_[4 * m2 + 1]); o.y = pk2(bh_[4 * m2 + 2], bh_[4 * m2 + 3]); *(LAS u32x2*)(xo + 4608) = o;
                    o.x = pk2(kh[4 * m2], kh[4 * m2 + 1]); o.y = pk2(kh[4 * m2 + 2], kh[4 * m2 + 3]); *(LAS u32x2*)(xo + 6912) = o; }
                asm volatile("" ::: "memory");
            }
            asm volatile("s_waitcnt lgkmcnt(0)" ::: "memory");
            f32x4 mbb = (f32x4){0.f, 0.f, 0.f, 0.f}, mkb = mbb, mbr = mbb, mkr = mbb;
#pragma unroll
            for (int ks = 0; ks < 2; ++ks) { const int off = fr * 144 + (32 * ks + 8 * fq) * 2;
                const bf16x8 akk = *(const LAS bf16x8*)(XS + off), ar = *(const LAS bf16x8*)(XS + 2304 + off), bb = *(const LAS bf16x8*)(XS + 4608 + off), bk = *(const LAS bf16x8*)(XS + 6912 + off);
                mbb = MFMA16(akk, bb, mbb); mkb = MFMA16(akk, bk, mkb); mbr = MFMA16(ar, bb, mbr); mkr = MFMA16(ar, bk, mkr); }
            {
                float T[16]; const float mf0 = mbb[0], mf1 = mbb[1], mf2 = mbb[2], mf3 = mbb[3];
                const int mb_[4] = {__builtin_bit_cast(int, mf0), __builtin_bit_cast(int, mf1), __builtin_bit_cast(int, mf2), __builtin_bit_cast(int, mf3)};
#pragma unroll
                for (int t = 0; t < 16; ++t) T[t] = (t == fr) ? 1.f : 0.f;
#pragma unroll
                for (int t = 1; t < 16; ++t) { float s0 = T[t], s1 = 0.f;
#pragma unroll
                    for (int j = 0; j < t; ++j) { const float m = __builtin_bit_cast(float, __builtin_amdgcn_readlane(mb_[t & 3], j + 16 * (t >> 2)));
                        if (j & 1) s1 -= m * T[j]; else s0 -= m * T[j]; }
                    T[t] = s0 + s1; }
                if (fq == 0) {
#pragma unroll
                    for (int t = 0; t < 16; ++t) { const bf16_t tv = (bf16_t)f2bf(T[t]); *(bf16_t*)(rec + RC_MBB + t * 64 + (fr >> 2) * 16 + (fr & 3) * 2) = tv; *(bf16_t*)(rec + RC_MBB + t * 64 + (fr >> 2) * 16 + 8 + (fr & 3) * 2) = tv; }
                }
            }
#pragma unroll
            for (int r = 0; r < 4; ++r) { const int t = 4 * fq + r, j = fr;
                *(bf16_t*)(rec + RC_MKB + t * 32 + j * 2) = (bf16_t)f2bf((j < t) ? mkb[r] : 0.f);
                *(bf16_t*)(rec + RC_MBR + t * 32 + j * 2) = (bf16_t)f2bf((j <= t) ? mbr[r] : 0.f);
                *(bf16_t*)(rec + RC_MKR + t * 32 + j * 2) = (bf16_t)f2bf((j <= t) ? mkr[r] : 0.f); }
            asm volatile("s_waitcnt lgkmcnt(0)" ::: "memory");
        }
    }
}

constexpr int RCH_X = 0;
constexpr int RCH_ST = 4096;
constexpr int RCH_RING = 8192, RCH_NSLOT = 6, RCH_PF = 5;
static_assert(RCH_RING + RCH_NSLOT * RC_REC <= XB_LDS_OFF, "rwkv chain lds");
#define RCH_BAR() do { asm volatile("s_waitcnt lgkmcnt(0)" ::: "memory"); __builtin_amdgcn_s_barrier(); asm volatile("" ::: "memory"); } while (0)
__device__ __forceinline__ void rwkvc_chain_unit(const Frame& F, const Args& a, int bh, int sg, bool dry = false) {
    const unsigned char* SCR = F.ws + WS_RSCR;
    bf16_t* OAB = (bf16_t*)(F.ws + WS_XN); f32x4* STATE = (f32x4*)(F.ws + WS_RSTATE);
    const int lane = F.lane, w = F.wave, fr = lane & 15, fq = lane >> 4, h = bh & 7, b = bh >> 3;
    LAS unsigned char* L = F.lds;
    const size_t mb = (size_t)b * SEQ;
    const unsigned char* seg = SCR + ((size_t)bh * RC_SEG_CHUNKS) * RC_REC;
    if (w >= 4) {
        const int p = w - 4;
#define RCH_ISSUE(ch_) do { int l16_ = lane * 16; asm volatile("" : "+v"(l16_)); const unsigned char* src_ = seg + (size_t)(ch_) * RC_REC + l16_; LAS unsigned char* dst_ = L + RCH_RING + ((ch_) % RCH_NSLOT) * RC_REC; \
            _Pragma("unroll") for (int i_ = 0; i_ < 5; ++i_) { const int pc_ = p + 4 * i_; if (pc_ < 17) __builtin_amdgcn_global_load_lds((const unsigned*)(src_ + pc_ * 1024), (LAS unsigned*)(dst_ + pc_ * 1024), 16, 0, 0); } } while (0)
#pragma unroll 1
        for (int ch = 0; ch < RCH_PF; ++ch) RCH_ISSUE(ch);
        if (p == 0) asm volatile("s_waitcnt vmcnt(20)" ::: "memory"); else asm volatile("s_waitcnt vmcnt(16)" ::: "memory");
        RCH_BAR();
#pragma unroll 1
        for (int cs = 0; cs < RC_SEG_CHUNKS; ++cs) {
            if (cs + RCH_PF < RC_SEG_CHUNKS) { RCH_ISSUE(cs + RCH_PF);
                if (p == 0) asm volatile("s_waitcnt vmcnt(20)" ::: "memory"); else asm volatile("s_waitcnt vmcnt(16)" ::: "memory"); }
            else asm volatile("s_waitcnt vmcnt(0)" ::: "memory");
            RCH_BAR();
        }
#undef RCH_ISSUE
    } else {
        LAS float* XT = (LAS float*)(L + RCH_X + w * 1024); LAS float* STT = (LAS float*)(L + RCH_ST);
        f32x4 acc[4];
#pragma unroll
        for (int mt = 0; mt < 4; ++mt) acc[mt] = (sg == 0) ? (f32x4){0.f, 0.f, 0.f, 0.f} : STATE[((size_t)bh * 4 + w) * 256 + mt * 64 + lane];
        const int v = 16 * w + fr, hc = h * 64 + v;
        const float lnw = a.in[IN_RLNW][hc], lnb = a.in[IN_RLNB][hc];
        RCH_BAR();
#pragma unroll 1
        for (int cs = 0; cs < RC_SEG_CHUNKS; ++cs) {
            const LAS unsigned char* rec = L + RCH_RING + (cs % RCH_NSLOT) * RC_REC;
            const u32x4 z4 = (u32x4){0u, 0u, 0u, 0u}; const int f2 = fq & 1;
            bf16x8 sb[2];
#pragma unroll
            for (int ks = 0; ks < 2; ++ks) { u32x4 pk; pk.x = pk2(acc[2 * ks][0], acc[2 * ks][1]); pk.y = pk2(acc[2 * ks][2], acc[2 * ks][3]); pk.z = pk2(acc[2 * ks + 1][0], acc[2 * ks + 1][1]); pk.w = pk2(acc[2 * ks + 1][2], acc[2 * ks + 1][3]); sb[ks] = __builtin_bit_cast(bf16x8, pk); }
            f32x4 rhs = (f32x4){0.f, 0.f, 0.f, 0.f}, y1 = rhs;
#pragma unroll
            for (int ks = 0; ks < 2; ++ks) { rhs = MFMA16(*(const LAS bf16x8*)(rec + RC_KR + fr * 128 + ks * 64 + fq * 16), sb[ks], rhs); y1 = MFMA16(*(const LAS bf16x8*)(rec + RC_KR + 2048 + fr * 128 + ks * 64 + fq * 16), sb[ks], y1); }
            u32x4 vt8 = *(const LAS u32x4*)(rec + RC_VT + v * 32 + f2 * 16), mkb = *(const LAS u32x4*)(rec + RC_MKB + fr * 32 + f2 * 16), mkr = *(const LAS u32x4*)(rec + RC_MKR + fr * 32 + f2 * 16), mbr = *(const LAS u32x4*)(rec + RC_MBR + fr * 32 + f2 * 16);
            if (fq >= 2) { vt8 = z4; mkb = z4; mkr = z4; mbr = z4; }
            rhs = MFMA16(__builtin_bit_cast(bf16x8, mkb), __builtin_bit_cast(bf16x8, vt8), rhs);
            y1 = MFMA16(__builtin_bit_cast(bf16x8, mkr), __builtin_bit_cast(bf16x8, vt8), y1);
            f32x4 u4;
            { u32x4 rb; rb.x = pk2(rhs[0], rhs[1]); rb.y = pk2(rhs[2], rhs[3]); rb.z = 0u; rb.w = 0u;
              const f32x4 zf = {0.f, 0.f, 0.f, 0.f}; u4 = MFMA16(*(const LAS bf16x8*)(rec + RC_MBB + fr * 64 + fq * 16), __builtin_bit_cast(bf16x8, rb), zf); }
            *(LAS f32x4*)(XT + fr * 16 + 4 * fq) = u4;
            asm volatile("s_waitcnt lgkmcnt(0)" ::: "memory");
            u32x4 ub;
            { const f32x4 ua = *(const LAS f32x4*)(XT + fr * 16 + 8 * f2), ubb = *(const LAS f32x4*)(XT + fr * 16 + 8 * f2 + 4);
              ub.x = pk2(ua[0], ua[1]); ub.y = pk2(ua[2], ua[3]); ub.z = pk2(ubb[0], ubb[1]); ub.w = pk2(ubb[2], ubb[3]); if (fq >= 2) ub = z4; }
            f32x4 yv = (f32x4){0.f, 0.f, 0.f, 0.f};
            yv = MFMA16(__builtin_bit_cast(bf16x8, mbr), __builtin_bit_cast(bf16x8, ub), yv);
            const f32x4 y = y1 - yv;
            u32x4 uvb; const u32x2 vt4 = *(const LAS u32x2*)(rec + RC_VT + v * 32 + fq * 8);
            uvb.x = pk2(u4[0], u4[1]); uvb.y = pk2(u4[2], u4[3]);
            uvb.z = vt4.x; uvb.w = vt4.y;
#pragma unroll
            for (int mt = 0; mt < 4; ++mt) { const f32x4 wl = *(const LAS f32x4*)(rec + RC_WL + (16 * mt + 4 * fq) * 4);
                acc[mt] = MFMA16(*(const LAS bf16x8*)(rec + RC_BKT + (16 * mt + fr) * 64 + fq * 16), __builtin_bit_cast(bf16x8, uvb), acc[mt] * wl); }
            float pgv[4], pbv[4];
#pragma unroll
            for (int r = 0; r < 4; ++r) { pgv[r] = bf2f(*(const LAS bf16_t*)(rec + RC_PG + (4 * fq + r) * 128 + v * 2)); pbv[r] = bf2f(*(const LAS bf16_t*)(rec + RC_PBV + (4 * fq + r) * 128 + v * 2)); }
            LAS float* st = STT + (cs & 1) * 128;
#pragma unroll
            for (int r = 0; r < 4; ++r) { const float s1 = red16_dpp(y[r]), s2 = red16_dpp(y[r] * y[r]); if (fr == 0) { st[(w * 16 + 4 * fq + r) * 2] = s1; st[(w * 16 + 4 * fq + r) * 2 + 1] = s2; } }
            RCH_BAR();
#pragma unroll
            for (int r = 0; r < 4; ++r) { const int t = 4 * fq + r; float s1 = 0.f, s2 = 0.f;
#pragma unroll
                for (int ww = 0; ww < 4; ++ww) { const f32x2 sv = *(const LAS f32x2*)(st + (ww * 16 + t) * 2); s1 += sv[0]; s2 += sv[1]; }
                const float mean = s1 * (1.f / 64.f), var = fmaxf(s2 * (1.f / 64.f) - mean * mean, 0.f);
                const float o = ((y[r] - mean) * rsqrtf(var + RWKV_LN_EPS) * lnw + lnb + pbv[r]) * pgv[r];
                if (!dry) OAB[(mb + (size_t)(sg * RC_SEG_CHUNKS + cs) * 16 + t) * 1024 + 512 + hc] = (bf16_t)f2bf(o); }
        }
#pragma unroll
        for (int mt = 0; mt < 4; ++mt) if (!dry) STATE[((size_t)bh * 4 + w) * 256 + mt * 64 + lane] = acc[mt];
    }
    __syncthreads();
}

__device__ __forceinline__ void rwkvc_build_images(const Frame& F, const Args& a) {
    const int gt = F.bid * NTHREADS + F.tid, NT = F.G * NTHREADS;
    for (int e = gt; e < 8 * 256 * 64; e += NT) {
        const int c = e & 63, jj = (e >> 6) & 255, h = e >> 14;
        unsigned char* img = F.ws + WS_RIMG + (size_t)h * 35840;
        if (jj < 64) *(bf16_t*)(img + RW_W2T + c * 144 + jj * 2) = (bf16_t)f2bf(a.in[IN_RW2][jj * 512 + h * 64 + c]);
        else if (jj < 128) *(bf16_t*)(img + RW_A2T + c * 144 + (jj - 64) * 2) = (bf16_t)f2bf(a.in[IN_RA2][(jj - 64) * 512 + h * 64 + c]);
        else *(bf16_t*)(img + RW_G2T + c * 272 + (jj - 128) * 2) = (bf16_t)f2bf(a.in[IN_RG2][(jj - 128) * 512 + h * 64 + c]);
    }
}
template <bool RES_BF16, bool OUT_BF16>
__device__ __forceinline__ void row_pass(const Frame& F, const bf16_t* mix, const void* resid_, const float* w_post, void* hout_, const float* w_next, bf16_t* xn) {
    const int gw = F.bid * NWAVES + F.wave, NGW = F.G * NWAVES, lane = F.lane;
    for (int mA = gw; mA < MTOK; mA += 2 * NGW) {
        const int mB = (mA + NGW < MTOK) ? mA + NGW : mA; const bool two = (mB != mA);
        const u32x2* mrA = (const u32x2*)(mix + (size_t)mA * D_MODEL) + lane; const u32x2* mrB = (const u32x2*)(mix + (size_t)mB * D_MODEL) + lane;
        u32x2 pa[4], pb[4]; f32x4 ha[4], hb[4];
#pragma unroll
        for (int j = 0; j < 4; ++j) { pa[j] = mrA[64 * j]; pb[j] = mrB[64 * j]; }
        if (RES_BF16) {
            const u32x2* rA = (const u32x2*)((const bf16_t*)resid_ + (size_t)mA * D_MODEL) + lane; const u32x2* rB = (const u32x2*)((const bf16_t*)resid_ + (size_t)mB * D_MODEL) + lane;
#pragma unroll
            for (int j = 0; j < 4; ++j) { const u32x2 qa = rA[64 * j], qb = rB[64 * j]; ha[j] = (f32x4){bflo(qa.x), bfhi(qa.x), bflo(qa.y), bfhi(qa.y)}; hb[j] = (f32x4){bflo(qb.x), bfhi(qb.x), bflo(qb.y), bfhi(qb.y)}; }
        } else {
            const f32x4* rA = (const f32x4*)((const float*)resid_ + (size_t)mA * D_MODEL) + lane; const f32x4* rB = (const f32x4*)((const float*)resid_ + (size_t)mB * D_MODEL) + lane;
#pragma unroll
            for (int j = 0; j < 4; ++j) { ha[j] = rA[64 * j]; hb[j] = rB[64 * j]; }
        }
        f32x4 va[4], vb[4]; float sa = 0.f, sb = 0.f;
#pragma unroll
        for (int j = 0; j < 4; ++j) { va[j] = (f32x4){bflo(pa[j].x), bfhi(pa[j].x), bflo(pa[j].y), bfhi(pa[j].y)}; vb[j] = (f32x4){bflo(pb[j].x), bfhi(pb[j].x), bflo(pb[j].y), bfhi(pb[j].y)};
            sa += (va[j].x * va[j].x + va[j].y * va[j].y) + (va[j].z * va[j].z + va[j].w * va[j].w); sb += (vb[j].x * vb[j].x + vb[j].y * vb[j].y) + (vb[j].z * vb[j].z + vb[j].w * vb[j].w); }
        const float ra = 1.f / sqrtf(wave_sum(sa) * (1.f / D_MODEL) + NORM_EPS), rb = 1.f / sqrtf(wave_sum(sb) * (1.f / D_MODEL) + NORM_EPS);
        float s2a = 0.f, s2b = 0.f;
#pragma unroll
        for (int j = 0; j < 4; ++j) { const f32x4 g = ((const f32x4*)w_post)[lane + 64 * j]; ha[j] = ha[j] + va[j] * ra * g; hb[j] = hb[j] + vb[j] * rb * g;
            s2a += (ha[j].x * ha[j].x + ha[j].y * ha[j].y) + (ha[j].z * ha[j].z + ha[j].w * ha[j].w); s2b += (hb[j].x * hb[j].x + hb[j].y * hb[j].y) + (hb[j].z * hb[j].z + hb[j].w * hb[j].w); }
        if (OUT_BF16) {
            u32x2* hoA = (u32x2*)((bf16_t*)hout_ + (size_t)mA * D_MODEL) + lane; u32x2* hoB = (u32x2*)((bf16_t*)hout_ + (size_t)mB * D_MODEL) + lane;
#pragma unroll
            for (int j = 0; j < 4; ++j) { u32x2 o; o.x = pk2(ha[j].x, ha[j].y); o.y = pk2(ha[j].z, ha[j].w); hoA[64 * j] = o; if (two) { o.x = pk2(hb[j].x, hb[j].y); o.y = pk2(hb[j].z, hb[j].w); hoB[64 * j] = o; } }
        } else {
            f32x4* hoA = (f32x4*)((float*)hout_ + (size_t)mA * D_MODEL) + lane; f32x4* hoB = (f32x4*)((float*)hout_ + (size_t)mB * D_MODEL) + lane;
#pragma unroll
            for (int j = 0; j < 4; ++j) { hoA[64 * j] = ha[j]; if (two) hoB[64 * j] = hb[j]; }
        }
        if (w_next) {
            const float qa = 1.f / sqrtf(wave_sum(s2a) * (1.f / D_MODEL) + NORM_EPS), qb = 1.f / sqrtf(wave_sum(s2b) * (1.f / D_MODEL) + NORM_EPS);
            unsigned long long* oA = (unsigned long long*)(xn + (size_t)mA * D_MODEL) + lane; unsigned long long* oB = (unsigned long long*)(xn + (size_t)mB * D_MODEL) + lane;
#pragma unroll
            for (int j = 0; j < 4; ++j) { const f32x4 g = ((const f32x4*)w_next)[lane + 64 * j];
                oA[64 * j] = (unsigned long long)pk2(ha[j].x * qa * g.x, ha[j].y * qa * g.y) | ((unsigned long long)pk2(ha[j].z * qa * g.z, ha[j].w * qa * g.w) << 32);
                if (two) oB[64 * j] = (unsigned long long)pk2(hb[j].x * qb * g.x, hb[j].y * qb * g.y) | ((unsigned long long)pk2(hb[j].z * qb * g.z, hb[j].w * qb * g.w) << 32); }
        }
    }
}
constexpr size_t B1_ACMPK = 128 * MiB, B1_ACMPV = 144 * MiB, B1_KS = 160 * MiB, B1_VST = 168 * MiB, B1_KW = 176 * MiB, B1_VWT = 184 * MiB, B1_QR = 192 * MiB;
constexpr size_t R2_HCMP = 0, R2_KC = 8 * MiB, R2_VCT = 9 * MiB, R2_SEL = 12 * MiB;
__device__ __constant__ float ROPE_INVF[8] = {1.0f, 0.1939227432012558f, 0.03760603070259094f, 0.007292664609849453f, 0.0014142135623842478f, 0.00027424818836152554f, 5.3182957344688475e-05f, 1.0313385246263351e-05f};

__device__ __forceinline__ void nsa_prep_phase(const Frame& F, const Args& a) {
    const bf16_t* F1 = (const bf16_t*)(F.ws + WS_BIG);
    bf16_t* ACMPK = (bf16_t*)(F.ws + WS_BIG + B1_ACMPK); bf16_t* ACMPV = (bf16_t*)(F.ws + WS_BIG + B1_ACMPV);
    bf16_t* KS = (bf16_t*)(F.ws + WS_BIG + B1_KS); bf16_t* VST = (bf16_t*)(F.ws + WS_BIG + B1_VST); bf16_t* KW = (bf16_t*)(F.ws + WS_BIG + B1_KW); bf16_t* VWT = (bf16_t*)(F.ws + WS_BIG + B1_VWT);
    bf16_t* QR = (bf16_t*)(F.ws + WS_BIG + B1_QR);
    const int* pos = (const int*)a.in[IN_POS];
    const int lane = F.lane, wave = F.wave, tid = F.tid;
    LAS unsigned char* Lvs = F.lds;
    LAS unsigned char* Lvw = F.lds + 16384;
    for (int u = F.bid; u < BATCH * 64; u += F.G) {
        const int b = u >> 6, blk = u & 63;
#pragma unroll 1
        for (int tt = 0; tt < 8; ++tt) {
            const int tl = 8 * wave + tt, t = blk * 64 + tl; const size_t m = (size_t)b * SEQ + t;
            const float p = (float)pos[m];
            const float ang = p * ROPE_INVF[lane & 7];
            const float cs = __cosf(ang), sn = __sinf(ang);
            const bf16_t* row = F1 + m * F1_LD;
            { const int hh = lane >> 2, qd = lane & 3; const u32x4 v0 = *(const u32x4*)(row + hh * 64 + qd * 16), v1 = *(const u32x4*)(row + hh * 64 + qd * 16 + 8);
              u32x4 o0 = v0, o1 = v1;
              float x1[8], x2[8], c8[8], s8[8];
#pragma unroll
              for (int i = 0; i < 8; ++i) { c8[i] = __shfl(cs, i); s8[i] = __shfl(sn, i); }
              if (qd == 0) {
                  x1[0] = bflo(v0.x); x1[1] = bfhi(v0.x); x1[2] = bflo(v0.y); x1[3] = bfhi(v0.y); x1[4] = bflo(v0.z); x1[5] = bfhi(v0.z); x1[6] = bflo(v0.w); x1[7] = bfhi(v0.w);
                  x2[0] = bflo(v1.x); x2[1] = bfhi(v1.x); x2[2] = bflo(v1.y); x2[3] = bfhi(v1.y); x2[4] = bflo(v1.z); x2[5] = bfhi(v1.z); x2[6] = bflo(v1.w); x2[7] = bfhi(v1.w);
                  float y1[8], y2[8];
#pragma unroll
                  for (int i = 0; i < 8; ++i) { y1[i] = x1[i] * c8[i] - x2[i] * s8[i]; y2[i] = x2[i] * c8[i] + x1[i] * s8[i]; }
                  o0.x = pk2(y1[0], y1[1]); o0.y = pk2(y1[2], y1[3]); o0.z = pk2(y1[4], y1[5]); o0.w = pk2(y1[6], y1[7]);
                  o1.x = pk2(y2[0], y2[1]); o1.y = pk2(y2[2], y2[3]); o1.z = pk2(y2[4], y2[5]); o1.w = pk2(y2[6], y2[7]); }
              *(u32x4*)(QR + m * 1024 + hh * 64 + qd * 16) = o0; *(u32x4*)(QR + m * 1024 + hh * 64 + qd * 16 + 8) = o1;
            }
            const int g = lane >> 5, d = 2 * (lane & 31); const int bg = b * 2 + g;
            const unsigned kc = *(const unsigned*)(row + 1024 + 0 * 128 + g * 64 + d), vc = *(const unsigned*)(row + 1024 + 1 * 128 + g * 64 + d);
            unsigned ks = *(const unsigned*)(row + 1024 + 2 * 128 + g * 64 + d); const unsigned vs = *(const unsigned*)(row + 1024 + 3 * 128 + g * 64 + d);
            unsigned kw = *(const unsigned*)(row + 1024 + 4 * 128 + g * 64 + d); const unsigned vw = *(const unsigned*)(row + 1024 + 5 * 128 + g * 64 + d);
            {
              const int l5 = lane & 31; const bool x1role = l5 < 4; const int i0 = 2 * (l5 & 3);
              const float c0 = __shfl(cs, i0), c1 = __shfl(cs, i0 + 1), s0 = __shfl(sn, i0), s1 = __shfl(sn, i0 + 1);
              const unsigned oks = __shfl_xor(ks, 4), okw = __shfl_xor(kw, 4);
              if (l5 < 8) { const float sg = x1role ? -1.f : 1.f;
                  ks = pk2(bflo(ks) * c0 + sg * bflo(oks) * s0, bfhi(ks) * c1 + sg * bfhi(oks) * s1);
                  kw = pk2(bflo(kw) * c0 + sg * bflo(okw) * s0, bfhi(kw) * c1 + sg * bfhi(okw) * s1); } }
            *(unsigned*)(KS + ((size_t)bg * SEQ + t) * 64 + d) = ks; *(unsigned*)(KW + ((size_t)bg * SEQ + t) * 64 + d) = kw;
            *(LAS unsigned*)(Lvs + tl * 256 + lane * 4) = vs; *(LAS unsigned*)(Lvw + tl * 256 + lane * 4) = vw;
            {
              const int i0 = t >> 4, s0 = t & 15;
              const float* pek = a.in[IN_NPEK]; const float* pev = a.in[IN_NPEV];
              if (i0 < 255) { *(unsigned*)(ACMPK + ((size_t)bg * 256 + i0) * 2048 + s0 * 64 + d) = pk2(bflo(kc) + pek[s0 * 64 + d], bfhi(kc) + pek[s0 * 64 + d + 1]);
                              *(unsigned*)(ACMPV + ((size_t)bg * 256 + i0) * 2048 + s0 * 64 + d) = pk2(bflo(vc) + pev[s0 * 64 + d], bfhi(vc) + pev[s0 * 64 + d + 1]); }
              if (i0 >= 1) { const int s1 = 16 + s0;
                              *(unsigned*)(ACMPK + ((size_t)bg * 256 + i0 - 1) * 2048 + s1 * 64 + d) = pk2(bflo(kc) + pek[s1 * 64 + d], bfhi(kc) + pek[s1 * 64 + d + 1]);
                              *(unsigned*)(ACMPV + ((size_t)bg * 256 + i0 - 1) * 2048 + s1 * 64 + d) = pk2(bflo(vc) + pev[s1 * 64 + d], bfhi(vc) + pev[s1 * 64 + d + 1]); }
            }
        }
        if (blk == 63) {
            for (int i = tid; i < 2 * 2048 / 8; i += NTHREADS) { const int g = i >> 8, o = (i & 255) * 8;
                *(u32x4*)(ACMPK + ((size_t)(b * 2 + g) * 256 + 255) * 2048 + o) = (u32x4){0u, 0u, 0u, 0u}; *(u32x4*)(ACMPV + ((size_t)(b * 2 + g) * 256 + 255) * 2048 + o) = (u32x4){0u, 0u, 0u, 0u}; }
        }
        __syncthreads();
        if (tid < 256) { const int which = tid >> 7, gd = tid & 127, g = gd >> 6, d = gd & 63; LAS unsigned char* Lv = which ? Lvw : Lvs;
            bf16_t* dst = (which ? VWT : VST) + (((size_t)(b * 2 + g) * 64 + blk) * 64 + d) * 64;
#pragma unroll
            for (int q8 = 0; q8 < 8; ++q8) { unsigned short e[8];
#pragma unroll
                for (int k = 0; k < 8; ++k) e[k] = *(const LAS bf16_t*)(Lv + (8 * q8 + k) * 256 + gd * 2);
                u32x4 o; o.x = e[0] | ((unsigned)e[1] << 16); o.y = e[2] | ((unsigned)e[3] << 16); o.z = e[4] | ((unsigned)e[5] << 16); o.w = e[6] | ((unsigned)e[7] << 16);
                *(u32x4*)(dst + 8 * q8) = o; } }
        __syncthreads();
    }
}

__device__ __forceinline__ void nsa_cmp2_phase(const Frame& F, const Args& a) {
    const bf16_t* HC = (const bf16_t*)((unsigned char*)a.out + R2_HCMP); bf16_t* KC = (bf16_t*)((unsigned char*)a.out + R2_KC); bf16_t* VCT = (bf16_t*)((unsigned char*)a.out + R2_VCT);
    const int* pos = (const int*)a.in[IN_POS];
    const int gw = F.bid * NWAVES + F.wave, NGW = F.G * NWAVES, lane = F.lane, fr = lane & 15, fq = lane >> 4;
    for (int it = gw; it < 512; it += NGW) {
        const int which = it >> 8, rt = it & 255;
        const bf16_t* A = HC + ((size_t)which * 4096 + 16 * rt) * 256; const bf16_t* Bt = (const bf16_t*)(F.ws + (which ? WS_W_C2V : WS_W_C2K));
        f32x4 c[4];
#pragma unroll
        for (int nt = 0; nt < 4; ++nt) c[nt] = (f32x4){0.f, 0.f, 0.f, 0.f};
#pragma unroll
        for (int ks = 0; ks < 8; ++ks) { const bf16x8 af = *(const bf16x8*)(A + fr * 256 + 32 * ks + 8 * fq);
#pragma unroll
            for (int nt = 0; nt < 4; ++nt) { const bf16x8 bf = *(const bf16x8*)(Bt + (16 * nt + fr) * 256 + 32 * ks + 8 * fq); c[nt] = MFMA16(af, bf, c[nt]); } }
        const int bg = rt >> 4, b = bg >> 1;
        if (which == 0) {
#pragma unroll
            for (int r = 0; r < 4; ++r) { const int i = (16 * rt + 4 * fq + r) & 255; int pi = 31 + 16 * i; if (pi > SEQ - 1) pi = SEQ - 1;
                const float ang = (float)pos[(size_t)b * SEQ + pi] * ROPE_INVF[fr & 7]; const float cs = __cosf(ang), sn = __sinf(ang);
                const float own = c[0][r], oth = __shfl_xor(own, 8);
                c[0][r] = (fr < 8) ? own * cs - oth * sn : own * cs + oth * sn;
#pragma unroll
                for (int nt = 0; nt < 4; ++nt) KC[((size_t)bg * 256 + i) * 64 + 16 * nt + fr] = (bf16_t)f2bf(c[nt][r]); }
        } else {
            const int i0 = (16 * rt + 4 * fq) & 255;
#pragma unroll
            for (int nt = 0; nt < 4; ++nt) { u32x2 p; p.x = pk2(c[nt][0], c[nt][1]); p.y = pk2(c[nt][2], c[nt][3]); *(u32x2*)(VCT + ((size_t)bg * 64 + 16 * nt + fr) * 256 + i0) = p; }
        }
    }
}
constexpr int CA_KC = 0, CA_KC_PITCH = 144;
constexpr int CA_VT = 36864, CA_VT_PITCH = 528;
__device__ __forceinline__ void nsa_cmp_attn_phase(const Frame& F, const Args& a) {
    const bf16_t* F1 = (const bf16_t*)(F.ws + WS_BIG); const bf16_t* QR = (const bf16_t*)(F.ws + WS_BIG + B1_QR);
    const bf16_t* KC = (const bf16_t*)((unsigned char*)a.out + R2_KC); const bf16_t* VCT = (const bf16_t*)((unsigned char*)a.out + R2_VCT);
    unsigned long long* SEL = (unsigned long long*)((unsigned char*)a.out + R2_SEL); bf16_t* ONSA = (bf16_t*)(F.ws + WS_XN);
    const int lane = F.lane, wave = F.wave, tid = F.tid, fr = lane & 15, fq = lane >> 4;
    LAS unsigned char* L = F.lds;
    for (int bgk = F.bid; bgk < 256; bgk += F.G) {
        const int bg = bgk & 15, kq = bgk >> 4, b = bg >> 1, g = bg & 1;
        __syncthreads();
        for (int i = tid; i < 256 * 8; i += NTHREADS) { const int key = i >> 3, ch = i & 7; *(LAS u32x4*)(L + CA_KC + key * CA_KC_PITCH + ch * 16) = *(const u32x4*)(KC + ((size_t)bg * 256 + key) * 64 + ch * 8); }
        for (int i = tid; i < 64 * 32; i += NTHREADS) { const int d = i >> 5, ch = i & 31; *(LAS u32x4*)(L + CA_VT + d * CA_VT_PITCH + ch * 16) = *(const u32x4*)(VCT + ((size_t)bg * 64 + d) * 256 + ch * 8); }
        __syncthreads();
#pragma unroll 1
        for (int rep = 0; rep < 2; ++rep) {
            const int idx = wave * 16 + kq; const int tt = rep == 0 ? idx : 255 - idx;
            const int t0 = 16 * tt, t = t0 + fr; const size_t m = (size_t)b * SEQ + t;
            const int nk = tt;
            const int nkt = (nk + 15) >> 4;
            float iaA[16], iaB[16];
#pragma unroll
            for (int kt = 0; kt < 16; ++kt) { iaA[kt] = 0.f; iaB[kt] = 0.f; }
#pragma unroll 1
            for (int hh = 0; hh < 8; ++hh) {
                const int H = g * 8 + hh;
                const bf16x8 q0 = *(const bf16x8*)(QR + m * 1024 + H * 64 + 8 * fq), q1 = *(const bf16x8*)(QR + m * 1024 + H * 64 + 32 + 8 * fq);
                float mrun = -INFINITY, lrun = 0.f;
#pragma unroll 1
                for (int kt = 0; kt < nkt; ++kt) {
                    const bf16x8 k0 = *(const LAS bf16x8*)(L + CA_KC + (16 * kt + fr) * CA_KC_PITCH + 16 * fq), k1 = *(const LAS bf16x8*)(L + CA_KC + (16 * kt + fr) * CA_KC_PITCH + 64 + 16 * fq);
                    f32x4 sv = (f32x4){0.f, 0.f, 0.f, 0.f}; sv = MFMA16(k0, q0, sv); sv = MFMA16(k1, q1, sv);
                    float tm = -INFINITY;
#pragma unroll
                    for (int r = 0; r < 4; ++r) { const int key = 16 * kt + 4 * fq + r; const bool vis = (16 * key + 31) <= t; sv[r] = vis ? sv[r] * 0.125f : -INFINITY; tm = fmaxf(tm, sv[r]); }
                    const float mn = fmaxf(mrun, tm);
                    if (mn != -INFINITY) { float add = 0.f;
#pragma unroll
                        for (int r = 0; r < 4; ++r) add += (sv[r] == -INFINITY) ? 0.f : __expf(sv[r] - mn);
                        lrun = lrun * ((mrun == -INFINITY) ? 0.f : __expf(mrun - mn)) + add; mrun = mn; }
                }
                float mx = fmaxf(mrun, __shfl_xor(mrun, 16)); mx = fmaxf(mx, __shfl_xor(mx, 32));
                const float mref = (mx == -INFINITY) ? 0.f : mx;
                float sum = (mrun == -INFINITY) ? 0.f : lrun * __expf(mrun - mref);
                sum += __shfl_xor(sum, 16); sum += __shfl_xor(sum, 32);
                const float inv = frcp(fmaxf(sum, 1e-30f));
                f32x4 o[4];
#pragma unroll
                for (int dt = 0; dt < 4; ++dt) o[dt] = (f32x4){0.f, 0.f, 0.f, 0.f};
#pragma unroll
                for (int ks = 0; ks < 8; ++ks) if (2 * ks < nkt) {
                    float p[8];
#pragma unroll
                    for (int half = 0; half < 2; ++half) { const int kt = 2 * ks + half;
                        const bf16x8 k0 = *(const LAS bf16x8*)(L + CA_KC + (16 * kt + fr) * CA_KC_PITCH + 16 * fq), k1 = *(const LAS bf16x8*)(L + CA_KC + (16 * kt + fr) * CA_KC_PITCH + 64 + 16 * fq);
                        f32x4 sv = (f32x4){0.f, 0.f, 0.f, 0.f}; sv = MFMA16(k0, q0, sv); sv = MFMA16(k1, q1, sv);
#pragma unroll
                        for (int r = 0; r < 4; ++r) { const int key = 16 * kt + 4 * fq + r; const bool vis = (16 * key + 31) <= t; p[4 * half + r] = vis ? __expf(sv[r] * 0.125f - mref) * inv : 0.f; } }
                    iaA[2 * ks] += (p[0] + p[1]) + (p[2] + 0.5f * p[3]); iaB[2 * ks] += p[3]; iaA[2 * ks + 1] += (p[4] + p[5]) + (p[6] + 0.5f * p[7]); iaB[2 * ks + 1] += p[7];
                    u32x4 pw; pw.x = pk2(p[0], p[1]); pw.y = pk2(p[2], p[3]); pw.z = pk2(p[4], p[5]); pw.w = pk2(p[6], p[7]);
                    const bf16x8 pb = __builtin_bit_cast(bf16x8, pw);
#pragma unroll
                    for (int dt = 0; dt < 4; ++dt) { const u32x2 v0 = *(const LAS u32x2*)(L + CA_VT + (16 * dt + fr) * CA_VT_PITCH + (32 * ks + 4 * fq) * 2), v1 = *(const LAS u32x2*)(L + CA_VT + (16 * dt + fr) * CA_VT_PITCH + (32 * ks + 16 + 4 * fq) * 2);
                        u32x4 vw; vw.x = v0.x; vw.y = v0.y; vw.z = v1.x; vw.w = v1.y; o[dt] = MFMA16(__builtin_bit_cast(bf16x8, vw), pb, o[dt]); }
                    __builtin_amdgcn_sched_barrier(0); }
                const float gate = sigmoidf_(bf2f(F1[m * F1_LD + 1792 + H * 3 + 0]));
#pragma unroll
                for (int dt = 0; dt < 4; ++dt) { u32x2 w; w.x = pk2(o[dt][0] * gate, o[dt][1] * gate); w.y = pk2(o[dt][2] * gate, o[dt][3] * gate); *(u32x2*)(ONSA + m * 1024 + H * 64 + 16 * dt + 4 * fq) = w; }
            }
            float imp[16];
#pragma unroll
            for (int kt = 0; kt < 16; ++kt) { const float up = __shfl(iaB[kt], (lane + 48) & 63); imp[kt] = up; }
            { float carry = 0.f;
#pragma unroll
              for (int kt = 0; kt < 16; ++kt) { const float prev3 = (fq == 0) ? carry : imp[kt]; carry = imp[kt]; imp[kt] = 0.5f * prev3 + iaA[kt]; } }
            const int cur = t >> 6;
            unsigned long long mask = 0ull;
            if (t0 < 1024) {
#pragma unroll
                for (int kt = 0; kt < 16; ++kt) { const int j = 4 * kt + fq; if (j <= cur) mask |= 1ull << j; }
            } else {
                float cv[16];
#pragma unroll
                for (int kt = 0; kt < 16; ++kt) { const int j = 4 * kt + fq; const bool forced = (j == 0) || (j == cur) || (j == cur - 1); cv[kt] = (j <= cur && !forced) ? imp[kt] : -INFINITY; }
                int rank[16];
#pragma unroll
                for (int kt = 0; kt < 16; ++kt) rank[kt] = 0;
#pragma unroll 1
                for (int f2 = 0; f2 < 4; ++f2) {
#pragma unroll
                    for (int k2 = 0; k2 < 16; ++k2) { const float ov = __shfl(cv[k2], fr + 16 * f2); const int j2 = 4 * k2 + f2;
#pragma unroll
                        for (int kt = 0; kt < 16; ++kt) { const int j = 4 * kt + fq; rank[kt] += (ov > cv[kt] || (ov == cv[kt] && j2 < j)) ? 1 : 0; } } }
#pragma unroll
                for (int kt = 0; kt < 16; ++kt) { const int j = 4 * kt + fq; const bool forced = (j == 0) || (j == cur) || (j == cur - 1);
                    if (forced || (cv[kt] != -INFINITY && rank[kt] < SEL_TOPN - 3)) mask |= 1ull << j; }
            }
            { unsigned lo = (unsigned)mask, hi = (unsigned)(mask >> 32);
              lo |= __shfl_xor(lo, 16); hi |= __shfl_xor(hi, 16); lo |= __shfl_xor(lo, 32); hi |= __shfl_xor(hi, 32);
              if (fq == 0) SEL[(size_t)bg * SEQ + t] = ((unsigned long long)hi << 32) | lo; }
        }
    }
}

constexpr int SA_K = 0, SA_V = 8192, SA_BUF = 16384, SA_NS = 8, SA_GB = 4;
#define SA_BAR() do { asm volatile("s_waitcnt lgkmcnt(0)" ::: "memory"); __builtin_amdgcn_s_barrier(); asm volatile("" ::: "memory"); } while (0)
template <int MODE  >
__device__ __forceinline__ void nsa_attn_pass(const Frame& F, const bf16_t* Kg, const bf16_t* Vtg, const bf16x8 (&qf)[2][2], const unsigned long long (&selm)[2], int tq[2], int bg, int qb, f32x4 (&outacc)[2][4], const float (&gate)[2]) {
    const int lane = F.lane, tid = F.tid, fr = lane & 15, fq = lane >> 4;
    LAS unsigned char* L = F.lds;
    const int j0 = (MODE == 0) ? 0 : (qb - 8 > 0 ? qb - 8 : 0), j1 = qb;
    f32x4 O[2][4]; float mrun[2], lrun[2];
#pragma unroll
    for (int i = 0; i < 2; ++i) { mrun[i] = -INFINITY; lrun[i] = 0.f;
#pragma unroll
        for (int dt = 0; dt < 4; ++dt) O[i][dt] = (f32x4){0.f, 0.f, 0.f, 0.f}; }
    const int wv_ = F.wave;
#define SA_ISSUE(jt_) do { LAS unsigned char* slot_ = L + (((jt_) - j0) % SA_NS) * SA_BUF; \
        _Pragma("unroll") for (int i_ = 0; i_ < 2; ++i_) { const int pc_ = 2 * wv_ + i_, P_ = pc_ & 7; const int row_ = 8 * P_ + (lane >> 3), c16_ = (lane & 7) ^ ((row_ >> 1) & 7); \
            const bf16_t* src_ = (pc_ < 8) ? Kg + ((size_t)bg * SEQ + (size_t)(jt_) * 64) * 64 + row_ * 64 + c16_ * 8 : Vtg + ((size_t)bg * 64 + (jt_)) * 4096 + row_ * 64 + c16_ * 8; \
            __builtin_amdgcn_global_load_lds((const unsigned*)src_, (LAS unsigned*)(slot_ + (pc_ < 8 ? SA_K : SA_V) + P_ * 1024), 16, 0, 0); } } while (0)
    __syncthreads();
#pragma unroll 1
    for (int d_ = 0; d_ < 2 * SA_GB; ++d_) if (j0 + d_ <= j1) SA_ISSUE(j0 + d_);
    if (j0 + 2 * SA_GB - 1 <= j1) asm volatile("s_waitcnt vmcnt(8)" ::: "memory");
    else asm volatile("s_waitcnt vmcnt(0)" ::: "memory");
    SA_BAR();
#pragma unroll 1
    for (int jg = j0; jg <= j1; jg += SA_GB) {
#pragma unroll 1
      for (int j = jg; j < jg + SA_GB && j <= j1; ++j) {
        LAS unsigned char* Lb = L + ((j - j0) % SA_NS) * SA_BUF;
        const bool edge = (j == j1) || (MODE == 1 && j == qb - 8);
#pragma unroll
        for (int i = 0; i < 2; ++i) {
            const int t = tq[i];
            bool colok;
            if (MODE == 0) colok = (selm[i] >> j) & 1ull; else colok = true;
            if (__ballot(colok) == 0ull) continue;
            f32x4 s[4];
#pragma unroll
            for (int kt = 0; kt < 4; ++kt) { s[kt] = (f32x4){0.f, 0.f, 0.f, 0.f};
                const int key_ = 16 * kt + fr, sw_ = (key_ >> 1) & 7;
                const bf16x8 k0 = *(const LAS bf16x8*)(Lb + SA_K + key_ * 128 + ((fq ^ sw_) * 16)), k1 = *(const LAS bf16x8*)(Lb + SA_K + key_ * 128 + (((4 + fq) ^ sw_) * 16));
                s[kt] = MFMA16(k0, qf[i][0], s[kt]); s[kt] = MFMA16(k1, qf[i][1], s[kt]); }
            constexpr float SC = 0.125f * 1.4426950408889634f;
            float mx = -INFINITY;
            if (edge) {
#pragma unroll
                for (int kt = 0; kt < 4; ++kt)
#pragma unroll
                    for (int r = 0; r < 4; ++r) { const int kpos = 64 * j + 16 * kt + 4 * fq + r; bool vis = (kpos <= t); if (MODE == 1) vis = vis && (kpos > t - WINDOW);
                        s[kt][r] = vis ? s[kt][r] : -INFINITY; mx = fmaxf(mx, s[kt][r]); }
            } else {
#pragma unroll
                for (int kt = 0; kt < 4; ++kt) mx = fmaxf(fmaxf(mx, fmaxf(s[kt][0], s[kt][1])), fmaxf(s[kt][2], s[kt][3]));
            }
            mx = colok ? mx * SC : -INFINITY;
            mx = fmaxf(mx, __shfl_xor(mx, 16)); mx = fmaxf(mx, __shfl_xor(mx, 32));
            const float mnew = fmaxf(mrun[i], mx);
            const float alpha = (mrun[i] == -INFINITY) ? 0.f : __builtin_amdgcn_exp2f(mrun[i] - mnew);
            const float msub = (colok && mnew != -INFINITY) ? mnew : INFINITY;
            mrun[i] = mnew;
            float p[16]; float psum = 0.f;
#pragma unroll
            for (int kt = 0; kt < 4; ++kt)
#pragma unroll
                for (int r = 0; r < 4; ++r) { const float e = __builtin_amdgcn_exp2f(__builtin_fmaf(s[kt][r], SC, -msub)); p[4 * kt + r] = e; psum += e; }
            lrun[i] = lrun[i] * alpha + psum;
#pragma unroll
            for (int dt = 0; dt < 4; ++dt) O[i][dt] = O[i][dt] * alpha;
#pragma unroll
            for (int ks = 0; ks < 2; ++ks) { u32x4 pw; pw.x = pk2(p[8 * ks], p[8 * ks + 1]); pw.y = pk2(p[8 * ks + 2], p[8 * ks + 3]); pw.z = pk2(p[8 * ks + 4], p[8 * ks + 5]); pw.w = pk2(p[8 * ks + 6], p[8 * ks + 7]);
                const bf16x8 pb = __builtin_bit_cast(bf16x8, pw);
#pragma unroll
                for (int dt = 0; dt < 4; ++dt) { const int d_ = 16 * dt + fr, sw_ = (d_ >> 1) & 7, c_ = 4 * ks + (fq >> 1);
                    const u32x2 v0 = *(const LAS u32x2*)(Lb + SA_V + d_ * 128 + ((c_ ^ sw_) * 16) + 8 * (fq & 1)), v1 = *(const LAS u32x2*)(Lb + SA_V + d_ * 128 + (((c_ + 2) ^ sw_) * 16) + 8 * (fq & 1));
                    u32x4 vw; vw.x = v0.x; vw.y = v0.y; vw.z = v1.x; vw.w = v1.y; O[i][dt] = MFMA16(__builtin_bit_cast(bf16x8, vw), pb, O[i][dt]); } }
        }
      }
      asm volatile("s_waitcnt vmcnt(0)" ::: "memory");
      SA_BAR();
#pragma unroll 1
      for (int d_ = 0; d_ < SA_GB; ++d_) if (jg + 2 * SA_GB + d_ <= j1) SA_ISSUE(jg + 2 * SA_GB + d_);
    }
#undef SA_ISSUE
#pragma unroll
    for (int i = 0; i < 2; ++i) { float l = lrun[i]; l += __shfl_xor(l, 16); l += __shfl_xor(l, 32); const float sc = gate[i] * frcp(fmaxf(l, 1e-30f));
#pragma unroll
        for (int dt = 0; dt < 4; ++dt) outacc[i][dt] += O[i][dt] * sc; }
}
__device__ __forceinline__ void nsa_attn_phase(const Frame& F, const Args& a, bool do_store = true) {
    const bf16_t* F1 = (const bf16_t*)(F.ws + WS_BIG); const bf16_t* QR = (const bf16_t*)(F.ws + WS_BIG + B1_QR);
    const bf16_t* KS = (const bf16_t*)(F.ws + WS_BIG + B1_KS); const bf16_t* VST = (const bf16_t*)(F.ws + WS_BIG + B1_VST); const bf16_t* KW = (const bf16_t*)(F.ws + WS_BIG + B1_KW); const bf16_t* VWT = (const bf16_t*)(F.ws + WS_BIG + B1_VWT);
    const unsigned long long* SEL = (const unsigned long long*)((unsigned char*)a.out + R2_SEL); bf16_t* ONSA = (bf16_t*)(F.ws + WS_XN);
    const int lane = F.lane, wave = F.wave, fr = lane & 15, fq = lane >> 4;
    for (int c = F.bid; c < 256; c += F.G) {
        const int bg = c & 15, kq = c >> 4, b = bg >> 1, g = bg & 1;
#pragma unroll 1
        for (int rep = 0; rep < 8; ++rep) {
            const int hb = 16 * rep + ((rep & 1) ? 15 - kq : kq);
            const int qb = hb >> 1;
            int tq[2]; bf16x8 qf[2][2]; unsigned long long selm[2]; float gs[2], gw_[2]; f32x4 outacc[2][4]; size_t mrow[2]; int Hh;
            Hh = g * 8 + (fr & 7);
#pragma unroll
            for (int i = 0; i < 2; ++i) { tq[i] = 32 * hb + 4 * wave + 2 * i + (fr >> 3); mrow[i] = (size_t)b * SEQ + tq[i];
                qf[i][0] = *(const bf16x8*)(QR + mrow[i] * 1024 + Hh * 64 + 8 * fq); qf[i][1] = *(const bf16x8*)(QR + mrow[i] * 1024 + Hh * 64 + 32 + 8 * fq);
                selm[i] = SEL[(size_t)bg * SEQ + tq[i]];
                gs[i] = sigmoidf_(bf2f(F1[mrow[i] * F1_LD + 1792 + Hh * 3 + 1])); gw_[i] = sigmoidf_(bf2f(F1[mrow[i] * F1_LD + 1792 + Hh * 3 + 2]));
#pragma unroll
                for (int dt = 0; dt < 4; ++dt) outacc[i][dt] = (f32x4){0.f, 0.f, 0.f, 0.f}; }
            nsa_attn_pass<0>(F, KS, VST, qf, selm, tq, bg, qb, outacc, gs);
            nsa_attn_pass<1>(F, KW, VWT, qf, selm, tq, bg, qb, outacc, gw_);
            if (do_store)
#pragma unroll
            for (int i = 0; i < 2; ++i)
#pragma unroll
                for (int dt = 0; dt < 4; ++dt) { bf16_t* p = ONSA + mrow[i] * 1024 + Hh * 64 + 16 * dt + 4 * fq; const u32x2 old = *(const u32x2*)p;
                    u32x2 w; w.x = pk2(bflo(old.x) + outacc[i][dt][0], bfhi(old.x) + outacc[i][dt][1]); w.y = pk2(bflo(old.y) + outacc[i][dt][2], bfhi(old.y) + outacc[i][dt][3]); *(u32x2*)p = w; }
        }
    }
}
__device__ __forceinline__ void chk_gdn(const Frame& F, const Args& a, int b, int h, int ntok, unsigned* cnt) {
    const bf16_t* F0 = (const bf16_t*)(F.ws + WS_BIG); const bf16_t* OAB = (const bf16_t*)(F.ws + WS_XN);
    LAS float* S = (LAS float*)F.lds;
    LAS float* qkv = S + 16384;
    LAS float* kS = qkv + 384;
    LAS float* ov = kS + 128;
    const int tid = F.tid; const float* convw = a.in[IN_GCONV];

#pragma unroll 1
for (int i = tid; i < 16384; i += NTHREADS) S[i] = 0.f;
    __syncthreads();
    unsigned bad = 0;

#pragma unroll 1
for (int t = 0; t < ntok; ++t) {
        const size_t m = (size_t)b * SEQ + t;
        if (tid < 384) { const int X = tid >> 7, c = tid & 127, col = X * 512 + h * 128 + c; float acc = 0.f;

#pragma unroll 1
for (int i = 0; i < 4; ++i) if (t - 3 + i >= 0) acc += convw[i * 1536 + col] * bf2f(F0[(m - 3 + i) * F0_LD + col]);
            qkv[tid] = acc / (1.f + expf(-acc)); }
        __syncthreads();
        float sq = 0.f, sk = 0.f;
#pragma unroll 1
for (int i = 0; i < 128; ++i) { sq += qkv[i] * qkv[i]; sk += qkv[128 + i] * qkv[128 + i]; }
        const float rq = 1.f / sqrtf(sq + 1e-6f) / sqrtf(128.f), rk = 1.f / sqrtf(sk + 1e-6f);
        const float beta = 1.f / (1.f + expf(-bf2f(F0[m * F0_LD + F0_BA + h])));
        const float aa = bf2f(F0[m * F0_LD + F0_BA + 4 + h]) + a.in[IN_GDT][h];
        const float g = -expf(a.in[IN_GALOG][h]) * (aa > 20.f ? aa : log1pf(expf(aa))); const float eg = expf(g);
        if (tid < 128) { float s = 0.f;
#pragma unroll 1
for (int i = 0; i < 128; ++i) s += qkv[128 + i] * rk * S[i * 128 + tid]; kS[tid] = s; }
        __syncthreads();

#pragma unroll 1
for (int e = tid; e < 16384; e += NTHREADS) { const int i = e >> 7, j = e & 127; const float ki = qkv[128 + i] * rk;
            S[e] = eg * (S[e] - beta * ki * kS[j]) + beta * ki * qkv[256 + j]; }
        __syncthreads();
        if (tid < 128) { float s = 0.f;
#pragma unroll 1
for (int i = 0; i < 128; ++i) s += qkv[i] * rq * S[i * 128 + tid]; ov[tid] = s; }
        __syncthreads();
        if (tid < 128) { float ss = 0.f;
#pragma unroll 1
for (int i = 0; i < 128; ++i) ss += ov[i] * ov[i];
            const float rstd = 1.f / sqrtf(ss / 128.f + NORM_EPS); const float z = bf2f(F0[m * F0_LD + 1536 + h * 128 + tid]);
            const float ref = ov[tid] * rstd * a.in[IN_GNORM][tid] * (z / (1.f + expf(-z))); const float got = bf2f(OAB[m * 1024 + h * 128 + tid]);
            if (!(fabsf(got - ref) <= 0.04f + 0.04f * fabsf(ref))) bad++; }
        __syncthreads();
    }
    if (bad) atomicAdd(cnt, bad);
}
__device__ __forceinline__ void chk_rwkv(const Frame& F, const Args& a, int b, int h, int ntok, unsigned* cnt) {
    const bf16_t* F0 = (const bf16_t*)(F.ws + WS_BIG); const bf16_t* OAB = (const bf16_t*)(F.ws + WS_XN);
    LAS float* S = (LAS float*)F.lds;
    LAS float* xs = S + 4096;
    LAS float* op = xs + 448;
    const int tid = F.tid; unsigned bad = 0;

#pragma unroll 1
for (int i = tid; i < 4096; i += NTHREADS) S[i] = 0.f;
    __syncthreads();

#pragma unroll 1
for (int t = 0; t < ntok; ++t) {
        const size_t m = (size_t)b * SEQ + t;
        if (tid < 448) { int mi; if (tid < 192) mi = (tid >> 6) * 512 + h * 64 + (tid & 63); else mi = 1536 + (tid - 192);
            const float f = bf2f(F0[m * F0_LD + F0_RWKV + mi]); const float fp = t > 0 ? bf2f(F0[(m - 1) * F0_LD + F0_RWKV + mi]) : 0.f;
            xs[tid] = f + (fp - f) * a.in[IN_RMU][mi]; }
        __syncthreads();
        if (tid < 64) { const int hc = h * 64 + tid; float lw = a.in[IN_RW0][hc], la = a.in[IN_RA0][hc], gg = 0.f;

#pragma unroll 1
for (int j = 0; j < 64; ++j) { lw += tanhf(xs[192 + j]) * a.in[IN_RW2][j * 512 + hc]; la += xs[256 + j] * a.in[IN_RA2][j * 512 + hc]; }

#pragma unroll 1
for (int j = 0; j < 128; ++j) gg += (1.f / (1.f + expf(-xs[320 + j]))) * a.in[IN_RG2][j * 512 + hc];
            const float sp = (-lw > 20.f) ? -lw : log1pf(expf(-lw)); const float wlog = -sp - 0.5f;
            const float av = 1.f / (1.f + expf(-la));
            op[tid] = expf(-expf(wlog)); op[64 + tid] = xs[64 + tid] * a.in[IN_RKK][hc]; op[256 + tid] = av;
            op[192 + tid] = xs[64 + tid] * (1.f + (av - 1.f) * a.in[IN_RKA][hc]); op[320 + tid] = gg; }
        __syncthreads();
        float ss = 0.f;
#pragma unroll 1
for (int i = 0; i < 64; ++i) ss += op[64 + i] * op[64 + i];
        const float rinv = 1.f / sqrtf(ss + 1e-6f);
        float bon = 0.f;
#pragma unroll 1
for (int i = 0; i < 64; ++i) bon += xs[i] * op[192 + i] * a.in[IN_RRK][h * 64 + i];
        if (tid < 64) { float sa = 0.f;
#pragma unroll 1
for (int k = 0; k < 64; ++k) sa -= S[tid * 64 + k] * op[64 + k] * rinv;
            float y = 0.f; const float vv = xs[128 + tid];

#pragma unroll 1
for (int k = 0; k < 64; ++k) { const float kk = op[64 + k] * rinv; const float sn = S[tid * 64 + k] * op[k] + sa * kk * op[256 + k] + vv * op[192 + k]; S[tid * 64 + k] = sn; y += sn * xs[k]; }
            op[384 + tid] = y; }
        __syncthreads();
        if (tid < 64) { float mean = 0.f;
#pragma unroll 1
for (int i = 0; i < 64; ++i) mean += op[384 + i]; mean /= 64.f; float var = 0.f;
#pragma unroll 1
for (int i = 0; i < 64; ++i) { const float d = op[384 + i] - mean; var += d * d; } var /= 64.f;
            const int hc = h * 64 + tid;
            const float yn = (op[384 + tid] - mean) / sqrtf(var + RWKV_LN_EPS) * a.in[IN_RLNW][hc] + a.in[IN_RLNB][hc];
            const float ref = (yn + bon * xs[128 + tid]) * op[320 + tid]; const float got = bf2f(OAB[m * 1024 + 512 + hc]);
            if (!(fabsf(got - ref) <= 0.04f + 0.04f * fabsf(ref))) bad++; }
        __syncthreads();
    }
    if (bad) atomicAdd(cnt, bad);
}

__device__ __forceinline__ float chk_rope_val(const bf16_t* row, int base, int d, float posf) {
    if (d >= 16) return bf2f(row[base + d]);
    const int i = d & 7; const float ang = posf * ROPE_INVF[i]; const float cs = cosf(ang), sn = sinf(ang);
    const float x1 = bf2f(row[base + i]), x2 = bf2f(row[base + 8 + i]);
    return d < 8 ? x1 * cs - x2 * sn : x2 * cs + x1 * sn;
}
__device__ __forceinline__ void chk_nsa(const Frame& F, const Args& a, int b, int g, int t, unsigned* cnt) {
    const bf16_t* F1 = (const bf16_t*)(F.ws + WS_BIG); const bf16_t* ONSA = (const bf16_t*)(F.ws + WS_XN);
    const int* pos = (const int*)a.in[IN_POS];
    LAS float* kc = (LAS float*)F.lds;
    LAS float* vc = kc + 8192;
    LAS float* hb = vc + 8192;
    LAS float* sb = hb + 512;
    LAS float* red = sb + 4096;
    LAS float* qv = red + 512;
    LAS float* impv = qv + 64;
    LAS float* ocv = impv + 64;
    LAS float* misc = ocv + 512;
    LAS unsigned* selw = (LAS unsigned*)(misc + 8);
    const int tid = F.tid; const size_t mb = (size_t)b * SEQ; const size_t m = mb + t;
    const int nk = t >= 31 ? (t - 31) / 16 + 1 : 0;
    unsigned bad = 0;
#pragma unroll 1
    for (int i = 0; i < nk; ++i) {
        { const int path = tid >> 8, hid = tid & 255; const float* w1 = a.in[path ? IN_NW1V : IN_NW1K]; const float* pe = a.in[path ? IN_NPEV : IN_NPEK]; float acc = 0.f;
#pragma unroll 1
          for (int sl = 0; sl < 32; ++sl) { const bf16_t* row = F1 + (mb + 16 * i + sl) * F1_LD + 1024 + path * 128 + g * 64;
#pragma unroll 1
              for (int d = 0; d < 64; ++d) acc += (bf2f(row[d]) + pe[sl * 64 + d]) * w1[(size_t)(sl * 64 + d) * 256 + hid]; }
          hb[tid] = acc / (1.f + expf(-acc)); }
        __syncthreads();
        if (tid < 128) { const int path = tid >> 6, d = tid & 63; const float* w2 = a.in[path ? IN_NW2V : IN_NW2K]; float acc = 0.f;
#pragma unroll 1
            for (int hid = 0; hid < 256; ++hid) acc += hb[path * 256 + hid] * w2[hid * 64 + d];
            (path ? vc : kc)[i * 64 + d] = acc; }
        __syncthreads();
    }
    if (tid < nk * 8) { const int i = tid >> 3, dd = tid & 7; const float ang = (float)pos[mb + 31 + 16 * i] * ROPE_INVF[dd]; const float cs = cosf(ang), sn = sinf(ang);
        const float x1 = kc[i * 64 + dd], x2 = kc[i * 64 + 8 + dd]; kc[i * 64 + dd] = x1 * cs - x2 * sn; kc[i * 64 + 8 + dd] = x2 * cs + x1 * sn; }
    if (tid < 64) impv[tid] = 0.f;
    __syncthreads();
    const float posq = (float)pos[m];
#pragma unroll 1
    for (int hh = 0; hh < 8; ++hh) { const int H = g * 8 + hh;
        if (tid < 64) qv[tid] = chk_rope_val(F1 + m * F1_LD, H * 64, tid, posq) * 0.125f;
        __syncthreads();
        if (tid < nk) { float s = 0.f;
#pragma unroll 1
            for (int d = 0; d < 64; ++d) s += qv[d] * kc[tid * 64 + d]; sb[tid] = s; }
        __syncthreads();
        if (tid == 0) { float mx = -INFINITY;
#pragma unroll 1
            for (int i = 0; i < nk; ++i) mx = fmaxf(mx, sb[i]); float sum = 0.f;
#pragma unroll 1
            for (int i = 0; i < nk; ++i) sum += expf(sb[i] - mx); misc[0] = mx; misc[1] = fmaxf(sum, 1e-30f); }
        __syncthreads();
        if (tid < nk) sb[tid] = expf(sb[tid] - misc[0]) / misc[1];
        __syncthreads();
        if (tid < 64) { float o = 0.f;
#pragma unroll 1
            for (int i = 0; i < nk; ++i) o += sb[i] * vc[i * 64 + tid]; ocv[hh * 64 + tid] = o;
            float im = 0.f;
#pragma unroll 1
            for (int i = 4 * tid - 1; i <= 4 * tid + 3; ++i) if (i >= 0 && i < nk) im += sb[i] * ((i == 4 * tid - 1 || i == 4 * tid + 3) ? 0.5f : 1.f);
            impv[tid] += im; }
        __syncthreads();
    }
    if (tid == 0) { const int cur = t >> 6; unsigned lo = 0u, hi = 0u;
#pragma unroll 1
        for (int r = 0; r < 16; ++r) { int best = -1; float bv = 0.f;
#pragma unroll 1
            for (int j = 0; j < 64; ++j) { const bool taken = j < 32 ? ((lo >> j) & 1u) : ((hi >> (j - 32)) & 1u); if (taken) continue;
                const bool valid = j <= cur, forced = (j == 0) || (j == cur) || (j == cur - 1);
                const float sc = valid ? (forced ? INFINITY : impv[j]) : -INFINITY;
                if (best < 0 || sc > bv) { best = j; bv = sc; } }
            if (best < 32) lo |= 1u << best; else hi |= 1u << (best - 32); }
        selw[0] = lo; selw[1] = hi; }
    __syncthreads();
#pragma unroll 1
    for (int hh = 0; hh < 8; ++hh) { const int H = g * 8 + hh;
        if (tid < 64) qv[tid] = chk_rope_val(F1 + m * F1_LD, H * 64, tid, posq) * 0.125f;
        __syncthreads();
        float osw[2] = {0.f, 0.f};
#pragma unroll 1
        for (int br = 0; br < 2; ++br) {
            const int kbase = 1024 + (br == 0 ? 2 : 4) * 128 + g * 64, vbase = kbase + 128;
            float lmx = -INFINITY;
#pragma unroll 1
            for (int kp = tid; kp < 4096; kp += NTHREADS) { float s = -INFINITY; const int j = kp >> 6;
                bool vis = kp <= t; if (br == 0) vis = vis && (j < 32 ? ((selw[0] >> j) & 1u) : ((selw[1] >> (j - 32)) & 1u)); else vis = vis && (kp > t - WINDOW);
                if (vis) { s = 0.f; const float pk = (float)pos[mb + kp];
#pragma unroll 1
                    for (int d = 0; d < 64; ++d) s += qv[d] * chk_rope_val(F1 + (mb + kp) * F1_LD, kbase, d, pk); }
                sb[kp] = s; lmx = fmaxf(lmx, s); }
            red[tid] = lmx; __syncthreads();
            if (tid == 0) { float mx = -INFINITY;
#pragma unroll 1
                for (int i = 0; i < NTHREADS; ++i) mx = fmaxf(mx, red[i]); misc[0] = mx; }
            __syncthreads();
            float ls = 0.f;
#pragma unroll 1
            for (int kp = tid; kp < 4096; kp += NTHREADS) { const float e = (sb[kp] == -INFINITY) ? 0.f : expf(sb[kp] - misc[0]); sb[kp] = e; ls += e; }
            red[tid] = ls; __syncthreads();
            if (tid == 0) { float sm = 0.f;
#pragma unroll 1
                for (int i = 0; i < NTHREADS; ++i) sm += red[i]; misc[1] = fmaxf(sm, 1e-30f); }
            __syncthreads();
            if (tid < 64) { float o = 0.f;
#pragma unroll 1
                for (int kp = 0; kp <= t; ++kp) if (sb[kp] != 0.f) o += sb[kp] * bf2f(F1[(mb + kp) * F1_LD + vbase + tid]); osw[br] = o / misc[1]; }
            __syncthreads();
        }
        if (tid < 64) { const float g0 = 1.f / (1.f + expf(-bf2f(F1[m * F1_LD + 1792 + H * 3 + 0]))), g1 = 1.f / (1.f + expf(-bf2f(F1[m * F1_LD + 1792 + H * 3 + 1]))), g2 = 1.f / (1.f + expf(-bf2f(F1[m * F1_LD + 1792 + H * 3 + 2])));
            const float ref = g0 * ocv[hh * 64 + tid] + g1 * osw[0] + g2 * osw[1]; const float got = bf2f(ONSA[m * 1024 + H * 64 + tid]);
            if (!(fabsf(got - ref) <= 0.004f + 0.05f * fabsf(ref))) bad++; }
        __syncthreads();
    }
    if (bad) atomicAdd(cnt, bad);
}
#define GEMM_PHASE(ACT, Aptr, Bptr, Optr, Mrows, N, K, ldo, cshift) do { pg8::Gemm g_{(const bf16_t*)(Aptr), (const bf16_t*)(Bptr), (Mrows), (N), (K)}; pg8::StaticOrder S_; S_.init((Mrows), (N), F.G, (F.bid + (cshift)) % F.G); \
      pg8::EpiBf16<ACT> E_{(bf16_t*)(Optr), (ldo)}; pg8::gemm_phase<pg8::EpiBf16<ACT>, pg8::StaticOrder, true, true>(F.lds, g_, S_, E_); } while (0)
__global__ void __launch_bounds__(NTHREADS, 2) mk_fwd(Args args) {
    extern __shared__ __attribute__((aligned(16))) unsigned char lds[];
    cg::grid_group grid = cg::this_grid();
    Frame F; F.lds = (LAS unsigned char*)lds; F.tid = threadIdx.x; F.lane = F.tid & 63; F.wave = __builtin_amdgcn_readfirstlane(F.tid >> 6);
    F.G = gridDim.x; F.bid = blockIdx.x; F.ws = args.ws; F.ctl = (unsigned*)(args.ws + WS_CTL);
    unsigned char* ws = args.ws;
    if (F.tid < 16) ((LAS unsigned*)(F.lds + XB_LDS_OFF))[F.tid] = 0u;
    __syncthreads();
    XcdBarrier xbar = xcd_barrier_post(F.ctl + CW_BAR, (volatile LAS unsigned*)(F.lds + XB_LDS_OFF));
#define GSYNC() xcd_barrier(xbar)
    p0_prologue(fresh(F), args, F.G > 96);
    rwkvc_build_images(fresh(F), args);
    if (F.G <= 96) p0_layer1_weights(fresh(F), args, 0, 0, -1);
    grid.sync();
    GEMM_PHASE(0, ws + WS_XN, ws + WS_W_IN0, ws + WS_BIG, MTOK, 4096, 1024, F0_LD, 0);
    GSYNC();
    gdn_prep_phase(fresh(F), args);
    GSYNC();
#pragma unroll 1
    for (int sg = 0; sg < RC_NSEG; ++sg) {
        rwkvc_prep_phase(fresh(F), args, sg);
        GSYNC();
        for (int u = F.bid; u < 96; u += F.G) {
            if (u < 64) rwkvc_chain_unit(fresh(F), args, u, sg); else gdn_scan_unit(fresh(F), args, u - 64, 8 * sg, 8 * sg + 8);
            __syncthreads(); }
        if (F.G > 96 && F.bid >= 96) { if (sg < 4) p0_layer1_weights(fresh(F), args, 96, F.G - 96, sg); else if (sg < 7) p0_layer0_rest(fresh(F), args, 96, F.G - 96, sg - 4); }
        GSYNC();
    }
    GEMM_PHASE(0, ws + WS_XN, ws + WS_W_OUT0, ws + WS_BIG, MTOK, 1024, 1024, 1024, 0);
    GSYNC();
    row_pass<false, true>(fresh(F), (const bf16_t*)(ws + WS_BIG), args.in[IN_X], args.in[IN_NMPOST], ws + WS_R2, args.in[IN_NFPRE], (bf16_t*)(ws + WS_XN));
    GSYNC();
    GEMM_PHASE(2, ws + WS_XN, ws + WS_W_UP0, ws + WS_BIG, MTOK, 4096, 1024, 4096, 0);
    GSYNC();
    GEMM_PHASE(0, ws + WS_BIG, ws + WS_W_DN0, ws + WS_XN, MTOK, 1024, 4096, 1024, 0);
    GSYNC();
    row_pass<true, true>(fresh(F), (const bf16_t*)(ws + WS_XN), ws + WS_R2, args.in[IN_NFPOST], ws + WS_R2, args.in[IN_NMPRE] + 1024, (bf16_t*)(ws + WS_XN));
    GSYNC();
    GEMM_PHASE(0, ws + WS_XN, ws + WS_W_IN1, ws + WS_BIG, MTOK, 2048, 1024, F1_LD, 0);
    GSYNC();
    nsa_prep_phase(fresh(F), args);
    GSYNC();
    GEMM_PHASE(3, ws + WS_BIG + B1_ACMPK, ws + WS_W_C1K, (unsigned char*)args.out + R2_HCMP, 4096, 256, 2048, 256, 0);
    GEMM_PHASE(3, ws + WS_BIG + B1_ACMPV, ws + WS_W_C1V, (unsigned char*)args.out + R2_HCMP + (size_t)4096 * 256 * 2, 4096, 256, 2048, 256, 128);
    GSYNC();
    nsa_cmp2_phase(fresh(F), args);
    GSYNC();
    nsa_cmp_attn_phase(fresh(F), args);
    GSYNC();
    nsa_attn_phase(fresh(F), args);
    GSYNC();
#ifdef WITH_CHECKS
    if (F.bid == 0) chk_nsa(F, args, 0, 0, 1500, F.ctl + 2);
    else if (F.bid == 1) chk_nsa(F, args, 3, 1, 2047, F.ctl + 2);
    else if (F.bid == 2) chk_nsa(F, args, 7, 0, 40, F.ctl + 2);
    else if (F.bid == 3) chk_nsa(F, args, 5, 1, 1023, F.ctl + 2);
    else if (F.bid == 4) chk_nsa(F, args, 2, 0, 700, F.ctl + 2);
    else if (F.bid == 5) chk_nsa(F, args, 6, 1, 1777, F.ctl + 2);
    GSYNC();
#endif
    GEMM_PHASE(0, ws + WS_XN, ws + WS_W_OUT1, ws + WS_BIG, MTOK, 1024, 1024, 1024, 0);
    GSYNC();
    row_pass<true, true>(fresh(F), (const bf16_t*)(ws + WS_BIG), ws + WS_R2, args.in[IN_NMPOST] + 1024, ws + WS_R2, args.in[IN_NFPRE] + 1024, (bf16_t*)(ws + WS_XN));
    GSYNC();
    GEMM_PHASE(2, ws + WS_XN, ws + WS_W_UP1, ws + WS_BIG, MTOK, 4096, 1024, 4096, 0);
    GSYNC();
    GEMM_PHASE(0, ws + WS_BIG, ws + WS_W_DN1, ws + WS_XN, MTOK, 1024, 4096, 1024, 0);
    GSYNC();
    row_pass<true, false>(fresh(F), (const bf16_t*)(ws + WS_XN), ws + WS_R2, args.in[IN_NFPOST] + 1024, args.out, nullptr, nullptr);
#ifdef WITH_CHECKS
    GSYNC();
    const unsigned en = __hip_atomic_load(F.ctl + 2, __ATOMIC_RELAXED, __HIP_MEMORY_SCOPE_AGENT);
    const float c = en ? 10.f : 0.f;
    const int gt = F.bid * NTHREADS + F.tid, NT = F.G * NTHREADS;
    if (c != 0.f) for (size_t i = gt; i < (size_t)MTOK * D_MODEL; i += NT) args.out[i] += c;
#endif
}
extern "C" void kernel_launch(void* const* d_in, const int* in_sizes, int n_in, void* d_out, int out_size, void* d_ws, size_t ws_size, hipStream_t stream) {
    static int grid = 0;
    if (grid == 0) {
        if (n_in != 33 || out_size != MTOK * D_MODEL || ws_size < WS_END) { fprintf(stderr, "kernel_launch: unexpected problem (n_in %d out %d ws %zu)\n", n_in, out_size, ws_size); grid = -1; return; }
        int dev = 0, cus = 0, per_cu = 0;
        (void)hipGetDevice(&dev); (void)hipDeviceGetAttribute(&cus, hipDeviceAttributeMultiprocessorCount, dev);
        (void)hipFuncSetAttribute((const void*)mk_fwd, hipFuncAttributeMaxDynamicSharedMemorySize, LDS_BYTES);
        (void)hipOccupancyMaxActiveBlocksPerMultiprocessor(&per_cu, (const void*)mk_fwd, NTHREADS, LDS_BYTES);
        if (per_cu < 1) { fprintf(stderr, "kernel_launch: occupancy query says %d blocks/CU\n", per_cu); grid = -1; return; }
        grid = cus;
        fprintf(stderr, "kernel_launch: grid %d (cus %d, per_cu %d) ws %zu\n", grid, cus, per_cu, ws_size);
    }
    if (grid < 0) return;
    (void)hipMemsetAsync((char*)d_ws + WS_CTL, 0, 1 * MiB, stream);
    Args a{};
    for (int i = 0; i < 33; ++i) a.in[i] = (const float*)d_in[i];
    a.out = (float*)d_out; a.ws = (unsigned char*)d_ws; a.ph_lo = 0; a.ph_hi = 100;
    void* kargs[] = {&a};
    hipError_t e = hipLaunchCooperativeKernel((void*)mk_fwd, dim3(grid), dim3(NTHREADS), kargs, LDS_BYTES, stream);
    if (e != hipSuccess) fprintf(stderr, "cooperative launch failed: %s (grid %d)\n", hipGetErrorString(e), grid);
}
```

```cpp
#include <hip/hip_runtime.h>
#include <hip/hip_cooperative_groups.h>
#include <cstdio>
#include <cstdint>
namespace cg = cooperative_groups;

constexpr int D_MODEL = 1024, BATCH = 8, SEQ = 4096, MTOK = BATCH * SEQ;
constexpr int GDN_HEADS = 4, GDN_DK = 128, GDN_DV = 128, GDN_CHUNK = 64;
constexpr int RWKV_HEADS = 8, RWKV_N = 64;
constexpr int NSA_HEADS = 16, NSA_GROUPS = 2, NSA_HD = 64, CMP_LEN = 32, CMP_STRIDE = 16, CMP_HIDDEN = 256;
constexpr int SEL_BLOCK = 64, SEL_TOPN = 16, WINDOW = 512;
constexpr int D_FF = 4096;
constexpr float NORM_EPS = 1e-6f, RWKV_LN_EPS = 64e-5f;
constexpr int AB_IN_W = 3848, NSA_IN_W = 1840;
constexpr int F0_LD = 4096;
constexpr int F1_LD = 2048;
constexpr int F0_RWKV = 2048, F0_BA = 3840;

typedef unsigned short bf16_t;
typedef short bf16x8 __attribute__((ext_vector_type(8)));
typedef float f32x4 __attribute__((ext_vector_type(4)));
typedef float f32x2 __attribute__((ext_vector_type(2)));
typedef unsigned u32x4 __attribute__((ext_vector_type(4)));
typedef unsigned u32x2 __attribute__((ext_vector_type(2)));
#define LAS __attribute__((address_space(3)))

typedef __bf16 hwbf16x2 __attribute__((ext_vector_type(2)));
__device__ __forceinline__ unsigned pk2(float lo, float hi) { const f32x2 v = {lo, hi}; const hwbf16x2 b = __builtin_convertvector(v, hwbf16x2); return __builtin_bit_cast(unsigned, b); }
__device__ __forceinline__ unsigned f2bf(float f) { return pk2(f, 0.f) & 0xffffu; }
__device__ __forceinline__ float bf2f(bf16_t h) { return __builtin_bit_cast(float, (unsigned)h << 16); }
__device__ __forceinline__ float bflo(unsigned u) { return __builtin_bit_cast(float, u << 16); }
__device__ __forceinline__ float bfhi(unsigned u) { return __builtin_bit_cast(float, u & 0xffff0000u); }
__device__ __forceinline__ float wave_sum(float v) {
#pragma unroll
    for (int o = 1; o < 64; o <<= 1) v += __shfl_xor(v, o);
    return v;
}
__device__ __forceinline__ float frcp(float x) { return __builtin_amdgcn_rcpf(x); }
__device__ __forceinline__ float sigmoidf_(float x) { return frcp(1.f + __expf(-x)); }
__device__ __forceinline__ float siluf_(float x) { return x * frcp(1.f + __expf(-x)); }
__device__ __forceinline__ float softplusf_(float x) { return x > 20.f ? x : log1pf(__expf(x)); }

__device__ __forceinline__ float fast_tanhf(float x) { const float e = __expf(2.f * x); return 1.f - 2.f * frcp(e + 1.f); }
__device__ __forceinline__ float fast_softplusf(float x) { return x > 20.f ? x : __logf(1.f + __expf(x)); }
__device__ __forceinline__ float dpp_f(float v, const int ctrl_sel) {
    const int i = __builtin_bit_cast(int, v);
    int r;
    if (ctrl_sel == 0) r = __builtin_amdgcn_update_dpp(i, i, 0xB1, 0xF, 0xF, false);
    else if (ctrl_sel == 1) r = __builtin_amdgcn_update_dpp(i, i, 0x4E, 0xF, 0xF, false);
    else r = __builtin_amdgcn_update_dpp(i, i, 0x141, 0xF, 0xF, false);
    return __builtin_bit_cast(float, r);
}
__device__ __forceinline__ float red8_dpp(float v) { v += dpp_f(v, 0); v += dpp_f(v, 1); v += dpp_f(v, 2); return v; }
namespace pg8 {
#define PG8_LAS __attribute__((address_space(3)))
constexpr int BM = 256, BK = 64, HALF = 128, HTB = HALF * BK * 2  , STAGE_BYTES = 8 * HTB, NXCD = 8, WGM = 8;

__host__ __device__ __forceinline__ int lds_byte(int r, int c) { const int st = (r >> 4) * 2 + (c >> 5), rr = r & 15, cc = c & 31, ob = rr * 64 + cc * 2; return st * 1024 + (ob ^ (((ob >> 9) & 1) << 5)); }
__host__ __device__ __forceinline__ void stage_rc(int b, int& R, int& C) { const int st = b / 1024, sb = b % 1024, swz = sb ^ (((sb >> 9) & 1) << 5); R = (st >> 1) * 16 + swz / 64; C = (st & 1) * 32 + (swz % 64) / 2; }
__host__ __device__ __forceinline__ int perm32(int rho) { const int n = rho >> 4, i = rho & 15; return 8 * (i >> 2) + 4 * n + (i & 3); }

struct Unit { int pm, pn; };
struct Gemm { const bf16_t* A; const bf16_t* Bt; int M, N, K; };

struct StaticOrder {
    int nM, nN, nwg, G, c;
    __host__ __device__ void init(int M, int N, int G_, int c_) { nM = M / BM; nN = N / BM; nwg = nM * nN; G = G_; c = c_; }
    __host__ __device__ bool next(int i, Unit& u) const {
        const long L = (long)i * G + c; if (L >= nwg) return false;
        int wgid = (int)L; { const int q = nwg / NXCD, r = nwg % NXCD, xcd = wgid % NXCD, off = wgid / NXCD; wgid = (xcd < r ? xcd * (q + 1) : r * (q + 1) + (xcd - r) * q) + off; }
        const int nig = WGM * nN, gid = wgid / nig, fm = gid * WGM, gsz = (nM - fm) < WGM ? (nM - fm) : WGM;
        u.pm = fm + ((wgid % nig) % gsz); u.pn = (wgid % nig) / gsz; return true;
    }
    __device__ __forceinline__ void a_ready(const Unit&) const {}
    __device__ __forceinline__ void done(const Unit&) const {}
};


__device__ __forceinline__ unsigned cvt_pk_bf16(float lo, float hi) { unsigned r; asm volatile("v_cvt_pk_bf16_f32 %0, %1, %2" : "=v"(r) : "v"(lo), "v"(hi)); return r; }
template <int ACT  > struct EpiBf16 {
    static constexpr bool PERM = true, AFTER_DRAIN = false;
    bf16_t* O; int ldc;
    __device__ __forceinline__ void operator()(const f32x4 (&acc)[2][2][4][2], const Unit& u, int wr, int wc, int fr, int fq) const {
        const int row0 = u.pm * BM + wr * 64 + fr; const int col0 = u.pn * BM + wc * 32 + 8 * fq;
#pragma unroll
        for (int ai = 0; ai < 2; ++ai)
#pragma unroll
            for (int m = 0; m < 4; ++m) { bf16_t* rowp = O + (size_t)(row0 + ai * HALF + m * 16) * ldc + col0;
#pragma unroll
                for (int bj = 0; bj < 2; ++bj) { f32x4 v0 = acc[ai][bj][m][0], v1 = acc[ai][bj][m][1];
                    if (ACT == 2) {
#pragma unroll
                        for (int e = 0; e < 4; ++e) { float a = v0[e] > 0.f ? v0[e] : 0.f; v0[e] = a * a; float b = v1[e] > 0.f ? v1[e] : 0.f; v1[e] = b * b; } }
                    if (ACT == 3) {
#pragma unroll
                        for (int e = 0; e < 4; ++e) { v0[e] = v0[e] * __builtin_amdgcn_rcpf(1.f + __expf(-v0[e])); v1[e] = v1[e] * __builtin_amdgcn_rcpf(1.f + __expf(-v1[e])); } }
                    u32x4 w; w.x = cvt_pk_bf16(v0[0], v0[1]); w.y = cvt_pk_bf16(v0[2], v0[3]); w.z = cvt_pk_bf16(v1[0], v1[1]); w.w = cvt_pk_bf16(v1[2], v1[3]);
                    *(u32x4*)(rowp + bj * HALF) = w; } }
    }
};
struct EpiBf16R {
    static constexpr bool PERM = true, AFTER_DRAIN = false;
    bf16_t* O; int ldc; int act;
    __device__ __forceinline__ void operator()(const f32x4 (&acc)[2][2][4][2], const Unit& u, int wr, int wc, int fr, int fq) const {
        if (act == 0) { EpiBf16<0> e{O, ldc}; e(acc, u, wr, wc, fr, fq); }
        else if (act == 2) { EpiBf16<2> e{O, ldc}; e(acc, u, wr, wc, fr, fq); }
        else { EpiBf16<3> e{O, ldc}; e(acc, u, wr, wc, fr, fq); }
    }
};
template <class Epi, class Sched, bool ALIGN_EPI = false, bool SP2 = false>
__device__ __forceinline__ void gemm_phase(PG8_LAS unsigned char* lds, const Gemm g, const Sched& S, const Epi& E) {
    int tid_ = threadIdx.x; asm volatile("" : "+v"(tid_));
    const int tid = tid_, wid = __builtin_amdgcn_readfirstlane(tid >> 6), lane = tid & 63, wr = wid >> 2, wc = wid & 3, fr = lane & 15, fq = lane >> 4;
    const int K = g.K, nt = K / BK;
    unsigned voffA[2], voffB[2];
#pragma unroll
    for (int i = 0; i < 2; ++i) { int R, C; stage_rc(tid * 16 + i * 8192, R, C); const int Rb = Epi::PERM ? ((R & ~31) + perm32(R & 31)) : R;
        voffA[i] = (unsigned)(R * K + C) * 2u; voffB[i] = (unsigned)(Rb * K + C) * 2u; }
    const size_t kstep = (size_t)(BK * 2);
    const size_t hstep = (size_t)HALF * K * 2;
    const size_t tstep = 2 * hstep;
    const unsigned ldsw = (unsigned)wid * 1024u;
    const int aoff = lds_byte(wr * 64 + fr, fq * 8), boff = lds_byte(wc * 32 + fr, fq * 8);
#define PG8_SA(b, h) (((b) * 2 + (h)) * HTB)
#define PG8_SB(b, h) ((4 + (b) * 2 + (h)) * HTB)
#define PG8_STAGE(bufoff, gbase, voff) do { _Pragma("unroll") for (int _i = 0; _i < 2; ++_i) \
        __builtin_amdgcn_global_load_lds((const unsigned*)((const char*)(gbase) + (voff)[_i]), (PG8_LAS unsigned*)(lds + (bufoff) + ldsw + _i * 8192), 16, 0, 0); } while (0)
#define PG8_LDA(dst, b, h) do { _Pragma("unroll") for (int m = 0; m < 4; ++m) _Pragma("unroll") for (int k = 0; k < 2; ++k) dst[m][k] = *(const PG8_LAS bf16x8*)(lds + PG8_SA(b, h) + aoff + m * 2048 + k * 1024); } while (0)
#define PG8_LDB(dst, b, h) do { _Pragma("unroll") for (int n = 0; n < 2; ++n) _Pragma("unroll") for (int k = 0; k < 2; ++k) dst[n][k] = *(const PG8_LAS bf16x8*)(lds + PG8_SB(b, h) + boff + n * 2048 + k * 1024); } while (0)
#define PG8_MMA(ai, bj, At, Bt) do { __builtin_amdgcn_s_setprio(1); _Pragma("unroll") for (int m = 0; m < 4; ++m) _Pragma("unroll") for (int n = 0; n < 2; ++n) _Pragma("unroll") for (int k = 0; k < 2; ++k) \
        acc[ai][bj][m][n] = __builtin_amdgcn_mfma_f32_16x16x32_bf16(Bt[n][k], At[m][k], acc[ai][bj][m][n], 0, 0, 0); __builtin_amdgcn_s_setprio(0); } while (0)
#define PG8_WAIT_V(n) asm volatile("s_waitcnt vmcnt(" #n ")" ::: "memory")
#define PG8_WAIT_L(n) asm volatile("s_waitcnt lgkmcnt(" #n ")" ::: "memory")
#define PG8_BAR __builtin_amdgcn_s_barrier()
#define PG8_SCHED __builtin_amdgcn_sched_barrier(0)
    Unit cur, nxt; int ui = 0;
    if (!S.next(0, cur)) return;
    f32x4 acc[2][2][4][2];
#pragma unroll
    for (int a = 0; a < 2; ++a)
#pragma unroll
        for (int b = 0; b < 2; ++b)
#pragma unroll
            for (int m = 0; m < 4; ++m)
#pragma unroll
                for (int n = 0; n < 2; ++n) acc[a][b][m][n] = (f32x4){0.f, 0.f, 0.f, 0.f};
    bf16x8 At[4][2], B0[2][2], B1[2][2];
    const char* cA = (const char*)g.A + (size_t)cur.pm * tstep; const char* cB = (const char*)g.Bt + (size_t)cur.pn * tstep;
    S.a_ready(cur);
    if constexpr (SP2) {
        PG8_STAGE(PG8_SB(0, 0), cB, voffB); PG8_STAGE(PG8_SB(0, 1), cB + hstep, voffB); PG8_STAGE(PG8_SA(0, 0), cA, voffA); PG8_STAGE(PG8_SA(0, 1), cA + hstep, voffA);
        if (wr == 1) PG8_BAR;
        PG8_WAIT_V(2); PG8_BAR;
        PG8_STAGE(PG8_SB(1, 0), cB + kstep, voffB); PG8_STAGE(PG8_SA(1, 0), cA + kstep, voffA); PG8_STAGE(PG8_SB(1, 1), cB + hstep + kstep, voffB);
        PG8_WAIT_V(6); PG8_BAR;
    } else {
        PG8_STAGE(PG8_SB(0, 0), cB, voffB); PG8_STAGE(PG8_SA(0, 0), cA, voffA); PG8_STAGE(PG8_SB(0, 1), cB + hstep, voffB); PG8_STAGE(PG8_SA(0, 1), cA + hstep, voffA);
        if (wr == 1) PG8_BAR;
        PG8_WAIT_V(4); PG8_BAR;
        PG8_STAGE(PG8_SB(1, 0), cB + kstep, voffB); PG8_STAGE(PG8_SA(1, 0), cA + kstep, voffA); PG8_STAGE(PG8_SB(1, 1), cB + hstep + kstep, voffB);
        PG8_WAIT_V(6); PG8_BAR;
    }
    for (;;) {
        const bool has_next = S.next(ui + 1, nxt);
        const char* nA = has_next ? (const char*)g.A + (size_t)nxt.pm * tstep : cA; const char* nB = has_next ? (const char*)g.Bt + (size_t)nxt.pn * tstep : cB;
        for (int t = 0; t < nt; t += 2) {
            const bool last = (t == nt - 2);
            const char* a1 = cA + (size_t)(t + 1) * kstep;
            const char* a2 = last ? nA : cA + (size_t)(t + 2) * kstep; const char* b2 = last ? nB : cB + (size_t)(t + 2) * kstep;
            const char* a3 = a2 + kstep; const char* b3 = b2 + kstep;
            if (last && has_next) S.a_ready(nxt);
            if constexpr (SP2) {
            PG8_LDB(B0, 0, 0); PG8_LDB(B1, 0, 1); PG8_SCHED; PG8_LDA(At, 0, 0); PG8_STAGE(PG8_SA(1, 1), a1 + hstep, voffA);
            PG8_WAIT_V(8); PG8_WAIT_L(0); PG8_BAR; PG8_MMA(0, 0, At, B0); PG8_MMA(0, 1, At, B1); PG8_BAR; PG8_SCHED;
            PG8_LDA(At, 0, 1); PG8_STAGE(PG8_SB(0, 0), b2, voffB); PG8_STAGE(PG8_SB(0, 1), b2 + hstep, voffB); PG8_STAGE(PG8_SA(0, 0), a2, voffA);
            PG8_WAIT_V(8); PG8_WAIT_L(0); PG8_BAR; PG8_MMA(1, 0, At, B0); PG8_MMA(1, 1, At, B1); PG8_BAR; PG8_SCHED;
            PG8_LDB(B0, 1, 0); PG8_LDB(B1, 1, 1); PG8_SCHED; PG8_LDA(At, 1, 0); PG8_STAGE(PG8_SA(0, 1), a2 + hstep, voffA);
            PG8_WAIT_V(8); PG8_WAIT_L(0); PG8_BAR; PG8_MMA(0, 0, At, B0); PG8_MMA(0, 1, At, B1); PG8_BAR; PG8_SCHED;
            PG8_LDA(At, 1, 1); PG8_STAGE(PG8_SB(1, 0), b3, voffB); PG8_STAGE(PG8_SB(1, 1), b3 + hstep, voffB); PG8_STAGE(PG8_SA(1, 0), a3, voffA);
            PG8_WAIT_V(8); PG8_WAIT_L(0); PG8_BAR; PG8_MMA(1, 0, At, B0); PG8_MMA(1, 1, At, B1); PG8_BAR; PG8_SCHED;
            } else {
            PG8_LDB(B0, 0, 0); PG8_SCHED; PG8_LDA(At, 0, 0); PG8_STAGE(PG8_SA(1, 1), a1 + hstep, voffA);
            PG8_WAIT_L(8); PG8_BAR; PG8_WAIT_L(0); PG8_MMA(0, 0, At, B0); PG8_BAR; PG8_SCHED;
            PG8_LDB(B1, 0, 1); PG8_STAGE(PG8_SB(0, 0), b2, voffB);
            PG8_BAR; PG8_WAIT_L(0); PG8_MMA(0, 1, At, B1); PG8_BAR;
            PG8_LDA(At, 0, 1); PG8_STAGE(PG8_SA(0, 0), a2, voffA);
            PG8_BAR; PG8_WAIT_L(0); PG8_MMA(1, 0, At, B0); PG8_BAR; PG8_SCHED;
            PG8_STAGE(PG8_SB(0, 1), b2 + hstep, voffB);
            PG8_WAIT_V(6); PG8_BAR; PG8_MMA(1, 1, At, B1); PG8_BAR;
            PG8_LDB(B0, 1, 0); PG8_SCHED; PG8_LDA(At, 1, 0); PG8_STAGE(PG8_SA(0, 1), a2 + hstep, voffA);
            PG8_WAIT_L(8); PG8_BAR; PG8_WAIT_L(0); PG8_MMA(0, 0, At, B0); PG8_BAR; PG8_SCHED;
            PG8_LDB(B1, 1, 1); PG8_STAGE(PG8_SB(1, 0), b3, voffB);
            PG8_BAR; PG8_WAIT_L(0); PG8_MMA(0, 1, At, B1); PG8_BAR;
            PG8_LDA(At, 1, 1); PG8_STAGE(PG8_SA(1, 0), a3, voffA);
            PG8_BAR; PG8_WAIT_L(0); PG8_MMA(1, 0, At, B0); PG8_BAR; PG8_SCHED;
            PG8_STAGE(PG8_SB(1, 1), b3 + hstep, voffB);
            PG8_WAIT_V(6); PG8_BAR; PG8_MMA(1, 1, At, B1); PG8_BAR;
            }
        }
        if constexpr (ALIGN_EPI) { if (wr == 0) PG8_BAR; }
        if constexpr (!Epi::AFTER_DRAIN) { E(acc, cur, wr, wc, fr, fq); S.done(cur); }
        if (!has_next) break;
#pragma unroll
        for (int a = 0; a < 2; ++a)
#pragma unroll
            for (int b = 0; b < 2; ++b)
#pragma unroll
                for (int m = 0; m < 4; ++m)
#pragma unroll
                    for (int n = 0; n < 2; ++n) acc[a][b][m][n] = (f32x4){0.f, 0.f, 0.f, 0.f};
        cur = nxt; cA = nA; cB = nB; ++ui;
        if constexpr (ALIGN_EPI) { if (wr == 1) PG8_BAR; }
    }
    PG8_WAIT_V(0);
    if constexpr (!ALIGN_EPI) { if (wr == 0) PG8_BAR; }
    PG8_BAR;
    if constexpr (Epi::AFTER_DRAIN) { E.fused(acc, cur, wr, wc, fr, fq, lds, wid, lane); S.done(cur); }
#undef PG8_SA
#undef PG8_SB
#undef PG8_STAGE
#undef PG8_LDA
#undef PG8_LDB
#undef PG8_MMA
#undef PG8_WAIT_V
#undef PG8_WAIT_L
#undef PG8_BAR
#undef PG8_SCHED
}
}

constexpr size_t MiB = 1u << 20;
constexpr size_t WS_CTL = 0;
constexpr size_t WS_W_IN0 = 1 * MiB, WS_W_OUT0 = 9 * MiB, WS_W_UP0 = 11 * MiB, WS_W_DN0 = 19 * MiB;
constexpr size_t WS_W_IN1 = 27 * MiB, WS_W_OUT1 = 31 * MiB, WS_W_UP1 = 33 * MiB, WS_W_DN1 = 41 * MiB;
constexpr size_t WS_W_C1K = 49 * MiB, WS_W_C1V = 50 * MiB, WS_W_C2K = 51 * MiB, WS_W_C2V = 51 * MiB + 65536;
constexpr size_t WS_XN = 56 * MiB;
constexpr size_t WS_BIG = 120 * MiB;
constexpr size_t WS_R2 = 376 * MiB;
constexpr size_t WS_RSCR2 = 440 * MiB;
constexpr size_t WS_END = 476 * MiB;
constexpr int NWAVES = 8, NTHREADS = 512;
constexpr int LDS_BYTES = 147456;
constexpr int XB_LDS_OFF = LDS_BYTES - 64;
constexpr int CW_BAR = 4096;

struct Args {
    const float* in[33]; float* out; unsigned char* ws; int ph_lo, ph_hi;
};
struct Frame {
    LAS unsigned char* lds;
    int tid, lane, wave, G, bid;
    unsigned char* ws;
    unsigned* ctl;
};
__device__ __forceinline__ Frame fresh(const Frame& F) { Frame G = F; int t = threadIdx.x; asm volatile("" : "+v"(t)); G.tid = t; G.lane = t & 63; G.wave = __builtin_amdgcn_readfirstlane(t >> 6); return G; }
enum { IN_X = 0, IN_POS, IN_NMPRE, IN_NMPOST, IN_NFPRE, IN_NFPOST, IN_WUP, IN_WDN, IN_ABIN, IN_ABOUT, IN_GCONV, IN_GALOG, IN_GDT, IN_GNORM,
       IN_RMU, IN_RW0, IN_RW2, IN_RA0, IN_RA2, IN_RG2, IN_RKK, IN_RKA, IN_RRK, IN_RLNW, IN_RLNB, IN_NWIN, IN_NWOUT, IN_NPEK, IN_NW1K, IN_NW2K, IN_NPEV, IN_NW1V, IN_NW2V };

template <bool LIGHT = false> __device__ __forceinline__ void transpose_item(const float* W, int K, int Nsrc, int src_col0, int cnt, bf16_t* WT, int dst_row0, LAS float* scr, int item, int lane) {
    const int nblk = (cnt + 31) / 32, kb = item / nblk, nb = item % nblk, k0 = 64 * kb, n0 = 32 * nb;
    const int nl = lane & 31; const bool okn = (n0 + nl) < cnt;
    const float* wp = W + (size_t)(k0 + (lane >> 5)) * Nsrc + src_col0 + n0 + nl;
    if constexpr (LIGHT) {
#pragma unroll 8
        for (int i = 0; i < 32; ++i) scr[(2 * i + (lane >> 5)) * 33 + nl] = okn ? wp[(size_t)(2 * i) * Nsrc] : 0.f;
    } else {
        float wv[32];
#pragma unroll
        for (int i = 0; i < 32; ++i) wv[i] = okn ? wp[(size_t)(2 * i) * Nsrc] : 0.f;
#pragma unroll
        for (int i = 0; i < 32; ++i) scr[(2 * i + (lane >> 5)) * 33 + nl] = wv[i];
    }
    asm volatile("s_waitcnt lgkmcnt(0)" ::: "memory");
    const int c = lane & 7;
#pragma unroll
    for (int j = 0; j < 4; ++j) { const int n = (lane >> 3) + 8 * j; const LAS float* s = scr + (8 * c) * 33 + n;
        u32x4 o; o.x = pk2(s[0 * 33], s[1 * 33]); o.y = pk2(s[2 * 33], s[3 * 33]); o.z = pk2(s[4 * 33], s[5 * 33]); o.w = pk2(s[6 * 33], s[7 * 33]);
        if (n0 + n < cnt) *(u32x4*)(WT + (size_t)(dst_row0 + n0 + n) * K + k0 + 8 * c) = o; }
    asm volatile("s_waitcnt lgkmcnt(0)" ::: "memory");
}
template <bool LIGHT = false> __device__ __forceinline__ void transpose_seg(const Frame& F, const float* W, int K, int Nsrc, int src_col0, int cnt, bf16_t* WT, int dst_row0, int bid0 = 0, int nb = 0) {
    LAS float* scr = (LAS float*)(F.lds + F.wave * 16384);
    const int gw = (F.bid - bid0) * NWAVES + F.wave, NGW = (nb ? nb : F.G) * NWAVES;
    const int nitems = (K / 64) * ((cnt + 31) / 32);
    for (int it = gw; it < nitems; it += NGW) transpose_item<LIGHT>(W, K, Nsrc, src_col0, cnt, WT, dst_row0, scr, it, F.lane);
}
__device__ __forceinline__ void zero_rows(const Frame& F, bf16_t* WT, int K, int row0, int nrows, int bid0 = 0, int nb = 0) {
    const int gw = (F.bid - bid0) * NWAVES + F.wave, NGW = (nb ? nb : F.G) * NWAVES;
    unsigned z = 0u; asm volatile("" : "+v"(z));
    for (int r = gw; r < nrows; r += NGW) { u32x4* p = (u32x4*)(WT + (size_t)(row0 + r) * K); for (int j = F.lane; j < K / 8; j += 64) p[j] = (u32x4){z, z, z, z}; }
}
__device__ __forceinline__ void rms_row_to_bf16(const float* xrow, const float* w, bf16_t* orow, int lane) {
    const f32x4* xr = (const f32x4*)xrow + lane; const f32x4* wr = (const f32x4*)w + lane;
    f32x4 v[4]; float s = 0.f;
#pragma unroll
    for (int j = 0; j < 4; ++j) { v[j] = xr[64 * j]; s += (v[j].x * v[j].x + v[j].y * v[j].y) + (v[j].z * v[j].z + v[j].w * v[j].w); }
    const float rstd = 1.f / sqrtf(wave_sum(s) * (1.f / D_MODEL) + NORM_EPS);
    unsigned long long* o8 = (unsigned long long*)orow + lane;
#pragma unroll
    for (int j = 0; j < 4; ++j) { const f32x4 g = wr[64 * j];
        o8[64 * j] = (unsigned long long)pk2(v[j].x * rstd * g.x, v[j].y * rstd * g.y) | ((unsigned long long)pk2(v[j].z * rstd * g.z, v[j].w * rstd * g.w) << 32); }
}
__device__ __forceinline__ void p0_prologue(const Frame& F, const Args& a, bool defer) {
    unsigned char* ws = F.ws;
    const float* abin = a.in[IN_ABIN];
    transpose_seg(F, abin, 1024, AB_IN_W, 0, 2048, (bf16_t*)(ws + WS_W_IN0), 0);
    transpose_seg(F, abin, 1024, AB_IN_W, 2056, 1792, (bf16_t*)(ws + WS_W_IN0), 2048);
    transpose_seg(F, abin, 1024, AB_IN_W, 2048, 8, (bf16_t*)(ws + WS_W_IN0), 3840);
    zero_rows(F, (bf16_t*)(ws + WS_W_IN0), 1024, 3848, 4096 - 3848);
    if (!defer) {
        transpose_seg(F, a.in[IN_ABOUT], 1024, 1024, 0, 1024, (bf16_t*)(ws + WS_W_OUT0), 0);
        transpose_seg(F, a.in[IN_WUP], 1024, 4096, 0, 4096, (bf16_t*)(ws + WS_W_UP0), 0);
        transpose_seg(F, a.in[IN_WDN], 4096, 1024, 0, 1024, (bf16_t*)(ws + WS_W_DN0), 0);
    }
    const int gw = F.bid * NWAVES + F.wave, NGW = F.G * NWAVES;
    const float* x = a.in[IN_X]; bf16_t* XN = (bf16_t*)(ws + WS_XN);
    for (int m = gw; m < MTOK; m += 2 * NGW) {
        const int m2 = m + NGW;
        const f32x4* xr0 = (const f32x4*)(x + (size_t)m * D_MODEL) + F.lane; const f32x4* xr1 = (const f32x4*)(x + (size_t)(m2 < MTOK ? m2 : m) * D_MODEL) + F.lane; const f32x4* wr = (const f32x4*)a.in[IN_NMPRE] + F.lane;
        f32x4 v0[4], v1[4]; float s0 = 0.f, s1 = 0.f;
#pragma unroll
        for (int j = 0; j < 4; ++j) { v0[j] = xr0[64 * j]; v1[j] = xr1[64 * j]; }
#pragma unroll
        for (int j = 0; j < 4; ++j) { s0 += (v0[j].x * v0[j].x + v0[j].y * v0[j].y) + (v0[j].z * v0[j].z + v0[j].w * v0[j].w); s1 += (v1[j].x * v1[j].x + v1[j].y * v1[j].y) + (v1[j].z * v1[j].z + v1[j].w * v1[j].w); }
        const float r0 = 1.f / sqrtf(wave_sum(s0) * (1.f / D_MODEL) + NORM_EPS), r1 = 1.f / sqrtf(wave_sum(s1) * (1.f / D_MODEL) + NORM_EPS);
        unsigned long long* o0 = (unsigned long long*)(XN + (size_t)m * D_MODEL) + F.lane; unsigned long long* o1 = (unsigned long long*)(XN + (size_t)m2 * D_MODEL) + F.lane;
#pragma unroll
        for (int j = 0; j < 4; ++j) { const f32x4 g = wr[64 * j];
            o0[64 * j] = (unsigned long long)pk2(v0[j].x * r0 * g.x, v0[j].y * r0 * g.y) | ((unsigned long long)pk2(v0[j].z * r0 * g.z, v0[j].w * r0 * g.w) << 32);
            if (m2 < MTOK) o1[64 * j] = (unsigned long long)pk2(v1[j].x * r1 * g.x, v1[j].y * r1 * g.y) | ((unsigned long long)pk2(v1[j].z * r1 * g.z, v1[j].w * r1 * g.w) << 32); }
    }
}

__device__ __forceinline__ void p0_layer0_rest(const Frame& F, const Args& a, int bid0, int nb, int part) {
    unsigned char* ws = F.ws;
    if (part == 0) transpose_seg<false>(F, a.in[IN_ABOUT], 1024, 1024, 0, 1024, (bf16_t*)(ws + WS_W_OUT0), 0, bid0, nb);
    if (part == 1) transpose_seg<false>(F, a.in[IN_WUP], 1024, 4096, 0, 4096, (bf16_t*)(ws + WS_W_UP0), 0, bid0, nb);
    if (part == 2) transpose_seg<false>(F, a.in[IN_WDN], 4096, 1024, 0, 1024, (bf16_t*)(ws + WS_W_DN0), 0, bid0, nb);
}
__device__ __forceinline__ void p0_layer1_weights(const Frame& F, const Args& a, int bid0, int nb, int part) {
    unsigned char* ws = F.ws;
    if (part < 0 || part == 0) {
        transpose_seg<false>(F, a.in[IN_NWIN], 1024, NSA_IN_W, 0, NSA_IN_W, (bf16_t*)(ws + WS_W_IN1), 0, bid0, nb);
        zero_rows(F, (bf16_t*)(ws + WS_W_IN1), 1024, NSA_IN_W, 2048 - NSA_IN_W, bid0, nb);
        transpose_seg<false>(F, a.in[IN_NWOUT], 1024, 1024, 0, 1024, (bf16_t*)(ws + WS_W_OUT1), 0, bid0, nb); }
    if (part < 0 || part == 1) transpose_seg<false>(F, a.in[IN_WUP] + (size_t)1024 * 4096, 1024, 4096, 0, 2048, (bf16_t*)(ws + WS_W_UP1), 0, bid0, nb);
    if (part < 0 || part == 2) transpose_seg<false>(F, a.in[IN_WUP] + (size_t)1024 * 4096, 1024, 4096, 2048, 2048, (bf16_t*)(ws + WS_W_UP1), 2048, bid0, nb);
    if (part < 0 || part == 3) transpose_seg<false>(F, a.in[IN_WDN] + (size_t)1024 * 4096, 4096, 1024, 0, 512, (bf16_t*)(ws + WS_W_DN1), 0, bid0, nb);
    if (part < 0 || part == 4) transpose_seg<false>(F, a.in[IN_WDN] + (size_t)1024 * 4096, 4096, 1024, 512, 512, (bf16_t*)(ws + WS_W_DN1), 512, bid0, nb);
    if (part < 0 || part == 5) {
        transpose_seg<false>(F, a.in[IN_NW1K], 2048, 256, 0, 256, (bf16_t*)(ws + WS_W_C1K), 0, bid0, nb);
        transpose_seg<false>(F, a.in[IN_NW1V], 2048, 256, 0, 256, (bf16_t*)(ws + WS_W_C1V), 0, bid0, nb);
        transpose_seg<false>(F, a.in[IN_NW2K], 256, 64, 0, 64, (bf16_t*)(ws + WS_W_C2K), 0, bid0, nb);
        transpose_seg<false>(F, a.in[IN_NW2V], 256, 64, 0, 64, (bf16_t*)(ws + WS_W_C2V), 0, bid0, nb); }
}

#define XB_TMO      128
#define XB_XCNT(j)  (256  + 64 * (j))
#define XB_XSUB(j)  (1280 + 64 * (j))
#define XB_XGEN(j)  (2304 + 64 * (j))
#define XB_TOP      3328
#define XB_TOPGEN   3392
#define XCD_BAR_WORDS 3456
#define XB_SPIN_CAP (1u << 18)

__device__ __forceinline__ unsigned xb_ld(unsigned* p)              { return __hip_atomic_load(p, __ATOMIC_RELAXED, __HIP_MEMORY_SCOPE_AGENT); }
__device__ __forceinline__ unsigned xb_add(unsigned* p, unsigned v) { return __hip_atomic_fetch_add(p, v, __ATOMIC_RELAXED, __HIP_MEMORY_SCOPE_AGENT); }
__device__ __forceinline__ unsigned xb_xcc_id() { return (unsigned)__builtin_amdgcn_s_getreg((3 << 11) | 20) & 0xFu; }
#define XB_SPIN(cond, bar) do { unsigned _sp = 0; while (cond) { __builtin_amdgcn_s_sleep(1); \
    if ((++_sp & 255u) == 0u) { if (xb_ld(&(bar)[XB_TMO])) break; if (_sp > XB_SPIN_CAP) { atomicAdd(&(bar)[XB_TMO], 1u); break; } } } } while (0)

struct XcdBarrier {
    unsigned* bar; unsigned x;
    volatile LAS unsigned* st;
};

__device__ __forceinline__ XcdBarrier xcd_barrier_post(unsigned* bar, volatile LAS unsigned* st) {
    XcdBarrier b; b.bar = bar; b.x = xb_xcc_id(); b.st = st;
    if (threadIdx.x == 0) (void)xb_add(&bar[XB_XCNT(b.x)], 1u);
    return b;
}
__device__ __forceinline__ void xcd_barrier_complete(unsigned* bar, unsigned x, unsigned& nloc, unsigned& nx) {
    const unsigned G = gridDim.x * gridDim.y * gridDim.z;
    unsigned sum, cnt, mine, sp = 0u;
    for (;;) {
        sum = 0u; cnt = 0u; mine = 0u;
#pragma unroll
        for (unsigned j = 0; j < 16; ++j) { const unsigned c = xb_ld(&bar[XB_XCNT(j)]); sum += c; cnt += (c > 0u) ? 1u : 0u; mine = (j == x) ? c : mine; }
        if (sum == G) break;
        __builtin_amdgcn_s_sleep(1);
        if ((++sp & 255u) == 0u) { if (xb_ld(&bar[XB_TMO])) break; if (sp > XB_SPIN_CAP) { atomicAdd(&bar[XB_TMO], 1u); break; } }
    }
    nloc = mine > 0u ? mine : 1u; nx = cnt > 0u ? cnt : 1u;
}

__device__ __forceinline__ void xcd_barrier(const XcdBarrier& b) {
    asm volatile("s_waitcnt vmcnt(0)" ::: "memory");
    __syncthreads();
    if (threadIdx.x == 0) {
        unsigned* bar = b.bar; const unsigned bx = xb_xcc_id();
        __builtin_amdgcn_s_waitcnt(0);
        unsigned nloc = b.st[0], nx = b.st[1];
        if (nloc == 0u) { xcd_barrier_complete(bar, bx, nloc, nx); b.st[0] = nloc; b.st[1] = nx; }
        const unsigned old = xb_add(&bar[XB_XSUB(bx)], 1u);
        const unsigned gen = old / nloc;
        if (old + 1u == (gen + 1u) * nloc) {
            __builtin_amdgcn_fence(__ATOMIC_RELEASE, "agent");
            asm volatile("s_waitcnt vmcnt(0)" ::: "memory");
            const unsigned og = xb_add(&bar[XB_TOP], 1u);
            const unsigned tg = og / nx;
            if (og + 1u == (tg + 1u) * nx) xb_add(&bar[XB_TOPGEN], 1u);
            else XB_SPIN(xb_ld(&bar[XB_TOPGEN]) == tg, bar);
            __builtin_amdgcn_fence(__ATOMIC_ACQUIRE, "agent");
            xb_add(&bar[XB_XGEN(bx)], 1u);
            asm volatile("s_waitcnt vmcnt(0)" ::: "memory");
        } else {
            XB_SPIN(xb_ld(&bar[XB_XGEN(bx)]) == gen, bar);
            __builtin_amdgcn_fence(__ATOMIC_ACQUIRE, "agent");
            asm volatile("s_waitcnt vmcnt(0)" ::: "memory");
        }
    }
    __syncthreads();
}
constexpr size_t GDN_UNIT_ELEMS = 8192;
constexpr size_t WS_INTRA = WS_R2, WS_GLAST = WS_R2 + 16 * MiB;
constexpr int GP_ROWB = 272;
constexpr int GP_QB = 0, GP_KB = 17408, GP_VB = 34816, GP_AM = 52224, GP_SC = 68608, GP_HALF = 69632;
#define MFMA16(a, b, c) __builtin_amdgcn_mfma_f32_16x16x32_bf16((a), (b), (c), 0, 0, 0)

__device__ __forceinline__ bf16x8 lds_aperm(const LAS unsigned char* rowp, int k0, int fq) {
    const u32x2 a = *(const LAS u32x2*)(rowp + (k0 + 4 * fq) * 2), b = *(const LAS u32x2*)(rowp + (k0 + 16 + 4 * fq) * 2);
    u32x4 v; v.x = a.x; v.y = a.y; v.z = b.x; v.w = b.y; return __builtin_bit_cast(bf16x8, v);
}
__device__ __forceinline__ bf16x8 acc_bperm(const f32x4& lo, const f32x4& hi) {
    u32x4 v; v.x = pk2(lo[0], lo[1]); v.y = pk2(lo[2], lo[3]); v.z = pk2(hi[0], hi[1]); v.w = pk2(hi[2], hi[3]); return __builtin_bit_cast(bf16x8, v);
}
__device__ __forceinline__ void gdn_prep_phase(const Frame& F, const Args& a) {
    const bf16_t* F0 = (const bf16_t*)(F.ws + WS_BIG);
    bf16_t* Ut = (bf16_t*)a.out; bf16_t* Wm = Ut + (size_t)2048 * GDN_UNIT_ELEMS; bf16_t* QG = Wm + (size_t)2048 * GDN_UNIT_ELEMS; bf16_t* KGt = QG + (size_t)2048 * GDN_UNIT_ELEMS;
    bf16_t* INTRA = (bf16_t*)(F.ws + WS_INTRA); float* GLAST = (float*)(F.ws + WS_GLAST);
    const float* convw = a.in[IN_GCONV];
    const int hb = F.wave >> 2, wq = F.wave & 3, lane = F.lane, fr = lane & 15, fq = lane >> 4;
    LAS unsigned char* L = F.lds + hb * GP_HALF;
    LAS float* betaL = (LAS float*)(L + GP_SC); LAS float* gcL = betaL + 64;
    LAS bf16_t* Ab = (LAS bf16_t*)(L + GP_AM);
    const int nhalf = F.G * 2, hid = F.bid * 2 + hb;
    LAS float* CW = (LAS float*)(F.lds + 2 * GP_HALF);
    { const int hh = (hid >> 6) & 3;
      for (int e = F.tid; e < 1536; e += NTHREADS) { const int X = e >> 9, i = (e >> 7) & 3, c = e & 127; CW[e] = convw[i * 1536 + X * 512 + hh * 128 + c]; } }
    __syncthreads();
#if defined(PROBE_GP_S1) || defined(PROBE_GP_S2) || defined(PROBE_GP_S3) || defined(PROBE_GP_S1C) || defined(PROBE_GP_S3C)
    const int nrep_ = __builtin_amdgcn_readfirstlane(2 + (int)__hip_atomic_load(F.ctl + 6, __ATOMIC_RELAXED, __HIP_MEMORY_SCOPE_AGENT));
#endif
    for (int u = hid; u < 2048; u += nhalf) {
        const int n = u & 63, h = (u >> 6) & 3, b = u >> 8;
        const size_t m0 = (size_t)b * SEQ + (size_t)n * 64;
        const int tl0 = 16 * wq + 4 * fq;
        float bb = 0.f, aa = 0.f;
        if (wq == 0) { const size_t m = m0 + lane; bb = bf2f(F0[m * F0_LD + F0_BA + h]); aa = bf2f(F0[m * F0_LD + F0_BA + 4 + h]); }
#if defined(PROBE_GP_S1) || defined(PROBE_GP_S1C)
#pragma unroll 1
        for (int rep_ = 0; rep_ < nrep_; ++rep_) {
#endif
        u32x4 rows[3][7];
        {
            const bool lowvalid = (n * 64 + tl0) > 0;
#ifdef PROBE_GP_S1C
            const size_t m0p = (size_t)((b + 4 * (1 - rep_)) & 7) * SEQ + (size_t)n * 64;
            const bf16_t* base = F0 + (m0p + tl0) * F0_LD + h * 128 + 8 * fr;
#else
            const bf16_t* base = F0 + (m0 + tl0) * F0_LD + h * 128 + 8 * fr;
#endif
#pragma unroll
            for (int X = 0; X < 3; ++X)
#pragma unroll
                for (int r = 0; r < 7; ++r) {
                    const long ro = (r < 3 && !lowvalid) ? 0 : (long)(r - 3) * F0_LD;
                    rows[X][r] = *(const u32x4*)(base + ro + X * 512);
                }
            if (!lowvalid) {
#pragma unroll
                for (int X = 0; X < 3; ++X)
#pragma unroll
                    for (int r = 0; r < 3; ++r) rows[X][r] = (u32x4){0u, 0u, 0u, 0u};
            }
        }
        if (wq == 0) {
            int lane = F.lane; asm volatile("" : "+v"(lane));
            const float beta = sigmoidf_(bb);
            float g = -__expf(a.in[IN_GALOG][h]) * fast_softplusf(aa + a.in[IN_GDT][h]);
#pragma unroll
            for (int o = 1; o < 64; o <<= 1) { const float t = __shfl_up(g, o); if (lane >= o) g += t; }
            betaL[lane] = beta; gcL[lane] = g;
            if (lane == 63) GLAST[u] = __expf(g);
        }
#pragma unroll
        for (int X = 0; X < 3; ++X) {
            float acc[4][8];
#pragma unroll
            for (int j = 0; j < 4; ++j)
#pragma unroll
                for (int e = 0; e < 8; ++e) acc[j][e] = 0.f;
#pragma unroll
            for (int i = 0; i < 4; ++i) {
                const f32x4 w0 = *(const LAS f32x4*)(CW + (X * 4 + i) * 128 + 8 * fr), w1 = *(const LAS f32x4*)(CW + (X * 4 + i) * 128 + 8 * fr + 4);
#pragma unroll
                for (int j = 0; j < 4; ++j) { const u32x4 xv = rows[X][j + i];
                    acc[j][0] += w0[0] * bflo(xv.x); acc[j][1] += w0[1] * bfhi(xv.x); acc[j][2] += w0[2] * bflo(xv.y); acc[j][3] += w0[3] * bfhi(xv.y);
                    acc[j][4] += w1[0] * bflo(xv.z); acc[j][5] += w1[1] * bfhi(xv.z); acc[j][6] += w1[2] * bflo(xv.w); acc[j][7] += w1[3] * bfhi(xv.w); }
            }
#pragma unroll
            for (int j = 0; j < 4; ++j) {
                float ss = 0.f;
#pragma unroll
                for (int e = 0; e < 8; ++e) { acc[j][e] = siluf_(acc[j][e]); ss += acc[j][e] * acc[j][e]; }
                float sc = 1.f;
                if (X < 2) {
#pragma unroll
                    for (int o = 1; o < 16; o <<= 1) ss += __shfl_xor(ss, o);
                    sc = rsqrtf(ss + 1e-6f) * (X == 0 ? 0.08838834764831845f : 1.f);
                }
                u32x4 o4; o4.x = pk2(acc[j][0] * sc, acc[j][1] * sc); o4.y = pk2(acc[j][2] * sc, acc[j][3] * sc); o4.z = pk2(acc[j][4] * sc, acc[j][5] * sc); o4.w = pk2(acc[j][6] * sc, acc[j][7] * sc);
                *(LAS u32x4*)(L + (X == 0 ? GP_QB : X == 1 ? GP_KB : GP_VB) + (tl0 + j) * GP_ROWB + fr * 16) = o4;
            }
        }
#if defined(PROBE_GP_S1) || defined(PROBE_GP_S1C)
        }
#endif
        __syncthreads();
#ifdef PROBE_GP_S2
#pragma unroll 1
        for (int rep_ = 0; rep_ < nrep_; ++rep_)
#endif
        {
            bf16x8 ka[4], qa[4];
#pragma unroll
            for (int ks = 0; ks < 4; ++ks) { ka[ks] = *(const LAS bf16x8*)(L + GP_KB + (16 * wq + fr) * GP_ROWB + (32 * ks + 8 * fq) * 2);
                                             qa[ks] = *(const LAS bf16x8*)(L + GP_QB + (16 * wq + fr) * GP_ROWB + (32 * ks + 8 * fq) * 2); }
            {
                const float eg = __expf(gcL[16 * wq + fr]);
#pragma unroll
                for (int ks = 0; ks < 4; ++ks) { const u32x4 qv = __builtin_bit_cast(u32x4, qa[ks]); u32x4 o4;
                    o4.x = pk2(bflo(qv.x) * eg, bfhi(qv.x) * eg); o4.y = pk2(bflo(qv.y) * eg, bfhi(qv.y) * eg); o4.z = pk2(bflo(qv.z) * eg, bfhi(qv.z) * eg); o4.w = pk2(bflo(qv.w) * eg, bfhi(qv.w) * eg);
                    *(u32x4*)(QG + (size_t)u * GDN_UNIT_ELEMS + (16 * wq + fr) * 128 + 32 * ks + 8 * fq) = o4; }
            }
            bf16_t* intra_u = INTRA + (size_t)u * 4096;
#pragma unroll
            for (int nt = 0; nt < 4; ++nt) {
                if (nt <= wq) {
                    f32x4 ckk = (f32x4){0.f, 0.f, 0.f, 0.f}, cqk = (f32x4){0.f, 0.f, 0.f, 0.f};
#pragma unroll
                    for (int ks = 0; ks < 4; ++ks) { const bf16x8 kb = *(const LAS bf16x8*)(L + GP_KB + (16 * nt + fr) * GP_ROWB + (32 * ks + 8 * fq) * 2);
                        ckk = MFMA16(ka[ks], kb, ckk); cqk = MFMA16(qa[ks], kb, cqk); }
                    const int j = 16 * nt + fr; const float gj = gcL[j];
#pragma unroll
                    for (int r = 0; r < 4; ++r) { const int i = 16 * wq + 4 * fq + r; const float d = __expf(gcL[i] - gj);
                        Ab[i * 72 + j] = (bf16_t)f2bf((i > j) ? betaL[i] * ckk[r] * d : 0.f);
                        intra_u[i * 64 + j] = (bf16_t)f2bf((i >= j) ? cqk[r] * d : 0.f); }
                } else {
#pragma unroll
                    for (int r = 0; r < 4; ++r) intra_u[(16 * wq + 4 * fq + r) * 64 + 16 * nt + fr] = 0;
                }
            }
        }
        __syncthreads();
#if defined(PROBE_GP_S3) || defined(PROBE_GP_S3C)
#pragma unroll 1
        for (int rep_ = 0; rep_ < nrep_; ++rep_)
#endif
        {
            int lane = F.lane; asm volatile("" : "+v"(lane));
            const int fr = lane & 15, fq = lane >> 4;
            const bool isk = wq >= 2; const int cb = (wq & 1) * 64;
#ifdef PROBE_GP_S3C
            bf16_t* Ut = rep_ == 0 ? (bf16_t*)(F.ws + WS_XN) : (bf16_t*)a.out; bf16_t* KGt = rep_ == 0 ? (bf16_t*)(F.ws + WS_XN) + (size_t)2048 * GDN_UNIT_ELEMS : (bf16_t*)a.out + (size_t)3 * 2048 * GDN_UNIT_ELEMS;
#endif
            LAS unsigned char* X = L + (isk ? GP_KB : GP_VB);
            LAS unsigned char* AbB = L + GP_AM; LAS unsigned char* Tb = L + GP_AM + 9216;
            {
                const int blk = fq, c = fr;
                float x[16];
#pragma unroll
                for (int k = 0; k < 16; ++k) x[k] = (k == c) ? 1.f : 0.f;
#pragma unroll
                for (int j = 15; j >= 1; --j) {
                    const LAS unsigned char* rowp = AbB + (16 * blk + j) * 144 + 32 * blk;
                    const u32x4 a0 = *(const LAS u32x4*)rowp;
                    float av[16];
                    av[0] = bflo(a0.x); av[1] = bfhi(a0.x); av[2] = bflo(a0.y); av[3] = bfhi(a0.y); av[4] = bflo(a0.z); av[5] = bfhi(a0.z); av[6] = bflo(a0.w); av[7] = bfhi(a0.w);
                    if (j > 8) { const u32x4 a1 = *(const LAS u32x4*)(rowp + 16);
                        av[8] = bflo(a1.x); av[9] = bfhi(a1.x); av[10] = bflo(a1.y); av[11] = bfhi(a1.y); av[12] = bflo(a1.z); av[13] = bfhi(a1.z); av[14] = bflo(a1.w); av[15] = bfhi(a1.w); }
#pragma unroll
                    for (int k = 0; k < j; ++k) x[k] -= x[j] * av[k];
                }
                u32x4 t0, t1;
                t0.x = pk2(x[0], x[1]); t0.y = pk2(x[2], x[3]); t0.z = pk2(x[4], x[5]); t0.w = pk2(x[6], x[7]);
                t1.x = pk2(x[8], x[9]); t1.y = pk2(x[10], x[11]); t1.z = pk2(x[12], x[13]); t1.w = pk2(x[14], x[15]);
                *(LAS u32x4*)(Tb + lane * 32) = t0; *(LAS u32x4*)(Tb + lane * 32 + 16) = t1;
            }
            f32x4 R[4][4];
            const float gl = gcL[63];
#pragma unroll
            for (int blk = 0; blk < 4; ++blk) {
                const f32x4 be = *(const LAS f32x4*)(betaL + 16 * blk + 4 * fq), gc4 = *(const LAS f32x4*)(gcL + 16 * blk + 4 * fq);
                f32x4 sc, kg;
#pragma unroll
                for (int r = 0; r < 4; ++r) { sc[r] = isk ? be[r] * __expf(gc4[r]) : be[r]; kg[r] = __expf(gl - gc4[r]); }
#pragma unroll
                for (int nt = 0; nt < 4; ++nt) {
                    const int col = cb + 16 * nt + fr;
                    f32x4 v;
#pragma unroll
                    for (int r = 0; r < 4; ++r) v[r] = bf2f(*(const LAS bf16_t*)(X + (16 * blk + 4 * fq + r) * GP_ROWB + col * 2));
                    if (isk) { u32x2 o; o.x = pk2(v[0] * kg[0], v[1] * kg[1]); o.y = pk2(v[2] * kg[2], v[3] * kg[3]);
                        *(u32x2*)(KGt + (size_t)u * GDN_UNIT_ELEMS + col * 64 + 16 * blk + 4 * fq) = o; }
#pragma unroll
                    for (int r = 0; r < 4; ++r) R[blk][nt][r] = v[r] * sc[r];
                }
            }
            const f32x4 zero4 = (f32x4){0.f, 0.f, 0.f, 0.f};
            bf16x8 tf[4];
#pragma unroll
            for (int blk = 0; blk < 4; ++blk) { const u32x2 t = *(const LAS u32x2*)(Tb + (16 * blk + fr) * 32 + 8 * fq); u32x4 v; v.x = t.x; v.y = t.y; v.z = 0u; v.w = 0u; tf[blk] = __builtin_bit_cast(bf16x8, v); }
            const bf16x8 a1 = lds_aperm(AbB + (16 + fr) * 144, 0, fq), a2 = lds_aperm(AbB + (32 + fr) * 144, 0, fq), a3a = lds_aperm(AbB + (48 + fr) * 144, 0, fq), a3b = lds_aperm(AbB + (48 + fr) * 144, 32, fq);
#pragma unroll
            for (int nt = 0; nt < 4; ++nt) {
                R[0][nt] = MFMA16(tf[0], acc_bperm(R[0][nt], zero4), zero4);
                u32x4 n0 = __builtin_bit_cast(u32x4, acc_bperm(R[0][nt], zero4)); n0.x ^= 0x80008000u; n0.y ^= 0x80008000u;
                f32x4 t1 = MFMA16(a1, __builtin_bit_cast(bf16x8, n0), R[1][nt]);
                R[1][nt] = MFMA16(tf[1], acc_bperm(t1, zero4), zero4);
                u32x4 n01 = __builtin_bit_cast(u32x4, acc_bperm(R[0][nt], R[1][nt])); n01.x ^= 0x80008000u; n01.y ^= 0x80008000u; n01.z ^= 0x80008000u; n01.w ^= 0x80008000u;
                f32x4 t2 = MFMA16(a2, __builtin_bit_cast(bf16x8, n01), R[2][nt]);
                R[2][nt] = MFMA16(tf[2], acc_bperm(t2, zero4), zero4);
                u32x4 n2 = __builtin_bit_cast(u32x4, acc_bperm(R[2][nt], zero4)); n2.x ^= 0x80008000u; n2.y ^= 0x80008000u;
                f32x4 t3 = MFMA16(a3a, __builtin_bit_cast(bf16x8, n01), R[3][nt]);
                t3 = MFMA16(a3b, __builtin_bit_cast(bf16x8, n2), t3);
                R[3][nt] = MFMA16(tf[3], acc_bperm(t3, zero4), zero4);
            }
#pragma unroll
            for (int blk = 0; blk < 4; ++blk)
#pragma unroll
                for (int nt = 0; nt < 4; ++nt) {
                    const int col = cb + 16 * nt + fr;
                    if (isk) { bf16_t* dst = Wm + (size_t)u * GDN_UNIT_ELEMS + (size_t)(16 * blk + 4 * fq) * 128 + col;
#pragma unroll
                        for (int r = 0; r < 4; ++r) dst[r * 128] = (bf16_t)f2bf(R[blk][nt][r]);
                    } else { u32x2 o; o.x = pk2(R[blk][nt][0], R[blk][nt][1]); o.y = pk2(R[blk][nt][2], R[blk][nt][3]);
                        *(u32x2*)(Ut + (size_t)u * GDN_UNIT_ELEMS + col * 64 + 16 * blk + 4 * fq) = o; }
                }
        }
        __syncthreads();
    }
}

constexpr int GS_W = 0, GS_Q = 17408, GS_I = 34816, GS_K = 44032, GS_U = 62464, GS_Z = 80896;
constexpr int GS_SSQ = GS_Z + 17408;
static_assert(GS_SSQ + 4096 <= XB_LDS_OFF, "gdn scan lds");
__device__ __forceinline__ float red16_dpp(float v) {
    v += dpp_f(v, 0); v += dpp_f(v, 1); v += dpp_f(v, 2);
    const int i = __builtin_bit_cast(int, v); v += __builtin_bit_cast(float, __builtin_amdgcn_update_dpp(i, i, 0x140, 0xF, 0xF, false));
    return v;
}
constexpr size_t WS_GSTATE = WS_R2 + 18 * MiB;
__device__ __forceinline__ void gdn_scan_unit(const Frame& F, const Args& a, int bh, int n0, int n1, bool dry = false) {
    const bf16_t* F0 = (const bf16_t*)(F.ws + WS_BIG);
    const bf16_t* Ut = (const bf16_t*)a.out; const bf16_t* Wm = Ut + (size_t)2048 * GDN_UNIT_ELEMS; const bf16_t* QG = Wm + (size_t)2048 * GDN_UNIT_ELEMS; const bf16_t* KGt = QG + (size_t)2048 * GDN_UNIT_ELEMS;
    const bf16_t* INTRA = (const bf16_t*)(F.ws + WS_INTRA); const float* GLAST = (const float*)(F.ws + WS_GLAST);
    bf16_t* OAB = (bf16_t*)(F.ws + WS_XN);
    const int w = F.wave, lane = F.lane, fr = lane & 15, fq = lane >> 4;
    const int h = bh & 3, b = bh >> 2;
    LAS unsigned char* L = F.lds;
    LAS float* ssq = (LAS float*)(L + GS_SSQ);
    LAS float* glp = ssq + 1000;
#define GS_BAR() do { asm volatile("s_waitcnt lgkmcnt(0)" ::: "memory"); __builtin_amdgcn_s_barrier(); asm volatile("" ::: "memory"); } while (0)
    if (w >= 4) {
        const int lt = F.tid - 256;
        struct GsSet { u32x4 pw[4], pq[4], pz[4], pk[4], pu[4], pi[2]; float pgl; };
        GsSet A, B;
#define GS_FETCH(P_, n_) do { const size_t u_ = (size_t)bh * 64 + (n_); \
            _Pragma("unroll") for (int i_ = 0; i_ < 4; ++i_) { const int e_ = lt + 256 * i_; P_.pw[i_] = *(const u32x4*)(Wm + u_ * GDN_UNIT_ELEMS + (size_t)e_ * 8); P_.pq[i_] = *(const u32x4*)(QG + u_ * GDN_UNIT_ELEMS + (size_t)e_ * 8); \
                P_.pk[i_] = *(const u32x4*)(KGt + u_ * GDN_UNIT_ELEMS + (size_t)e_ * 8); P_.pu[i_] = *(const u32x4*)(Ut + u_ * GDN_UNIT_ELEMS + (size_t)e_ * 8); \
                P_.pz[i_] = *(const u32x4*)(F0 + ((size_t)b * SEQ + (size_t)(n_) * 64 + (e_ >> 4)) * F0_LD + 1536 + h * 128 + (e_ & 15) * 8); } \
            _Pragma("unroll") for (int i_ = 0; i_ < 2; ++i_) P_.pi[i_] = *(const u32x4*)(INTRA + u_ * 4096 + (size_t)(lt + 256 * i_) * 8); \
            P_.pgl = GLAST[u_]; } while (0)
#define GS_STORE(P_, n_) do { \
            _Pragma("unroll") for (int i_ = 0; i_ < 4; ++i_) { const int e_ = lt + 256 * i_; \
                *(LAS u32x4*)(L + GS_W + (e_ >> 4) * 272 + (e_ & 15) * 16) = P_.pw[i_]; *(LAS u32x4*)(L + GS_Q + (e_ >> 4) * 272 + (e_ & 15) * 16) = P_.pq[i_]; *(LAS u32x4*)(L + GS_Z + (e_ >> 4) * 272 + (e_ & 15) * 16) = P_.pz[i_]; \
                *(LAS u32x4*)(L + GS_K + (e_ >> 3) * 144 + (e_ & 7) * 16) = P_.pk[i_]; *(LAS u32x4*)(L + GS_U + (e_ >> 3) * 144 + (e_ & 7) * 16) = P_.pu[i_]; } \
            _Pragma("unroll") for (int i_ = 0; i_ < 2; ++i_) { const int e_ = lt + 256 * i_; *(LAS u32x4*)(L + GS_I + (e_ >> 3) * 144 + (e_ & 7) * 16) = P_.pi[i_]; } \
            if (lt == 0) glp[(n_) & 1] = P_.pgl; } while (0)
        GS_FETCH(A, n0);
        if (n0 + 1 < n1) GS_FETCH(B, n0 + 1);
        __syncthreads();
        GS_STORE(A, n0);
        GS_BAR();
#pragma unroll 1
        for (int n = n0; n < n1; n += 2) {
            if (n + 2 < n1) GS_FETCH(A, n + 2);
            GS_BAR();
            if (n + 1 < n1) GS_STORE(B, n + 1);
            GS_BAR();
            if (n + 3 < n1) GS_FETCH(B, n + 3);
            GS_BAR();
            if (n + 2 < n1) GS_STORE(A, n + 2);
            GS_BAR();
        }
#undef GS_FETCH
#undef GS_STORE
    } else {
        f32x4 S[2][8]; f32x4* GST = (f32x4*)(F.ws + WS_GSTATE) + ((size_t)bh * 8 + 2 * w) * 512;
#pragma unroll
        for (int nt = 0; nt < 2; ++nt)
#pragma unroll
            for (int d = 0; d < 8; ++d) S[nt][d] = (n0 == 0) ? (f32x4){0.f, 0.f, 0.f, 0.f} : GST[nt * 512 + d * 64 + lane];
        float gnw[2]; gnw[0] = a.in[IN_GNORM][32 * w + fr]; gnw[1] = a.in[IN_GNORM][32 * w + 16 + fr];
        __syncthreads();
        GS_BAR();
#pragma unroll 1
        for (int n = n0; n < n1; ++n) {
            const float gl = glp[n & 1];
            bf16x8 Sb[2][4];
#pragma unroll
            for (int nt = 0; nt < 2; ++nt)
#pragma unroll
                for (int ks = 0; ks < 4; ++ks) Sb[nt][ks] = acc_bperm(S[nt][2 * ks], S[nt][2 * ks + 1]);
            f32x4 vn[2][4], o[2][4];
#pragma unroll
            for (int mt = 0; mt < 4; ++mt) { f32x4 p0 = (f32x4){0.f, 0.f, 0.f, 0.f}, p1 = p0, q0 = p0, q1 = p0;
                const LAS unsigned char* wrow = L + GS_W + (16 * mt + fr) * 272; const LAS unsigned char* qrow = L + GS_Q + (16 * mt + fr) * 272;
#pragma unroll
                for (int ks = 0; ks < 4; ++ks) { const bf16x8 wa = lds_aperm(wrow, 32 * ks, fq), qa = lds_aperm(qrow, 32 * ks, fq);
                    p0 = MFMA16(wa, Sb[0][ks], p0); p1 = MFMA16(wa, Sb[1][ks], p1); q0 = MFMA16(qa, Sb[0][ks], q0); q1 = MFMA16(qa, Sb[1][ks], q1); }
                const u32x2 u0 = *(const LAS u32x2*)(L + GS_U + (32 * w + fr) * 144 + (16 * mt + 4 * fq) * 2), u1 = *(const LAS u32x2*)(L + GS_U + (32 * w + 16 + fr) * 144 + (16 * mt + 4 * fq) * 2);
                vn[0][mt] = (f32x4){bflo(u0.x) - p0[0], bfhi(u0.x) - p0[1], bflo(u0.y) - p0[2], bfhi(u0.y) - p0[3]};
                vn[1][mt] = (f32x4){bflo(u1.x) - p1[0], bfhi(u1.x) - p1[1], bflo(u1.y) - p1[2], bfhi(u1.y) - p1[3]};
                o[0][mt] = q0; o[1][mt] = q1; }
            bf16x8 Vb[2][2];
#pragma unroll
            for (int nt = 0; nt < 2; ++nt)
#pragma unroll
                for (int ks = 0; ks < 2; ++ks) Vb[nt][ks] = acc_bperm(vn[nt][2 * ks], vn[nt][2 * ks + 1]);
#pragma unroll
            for (int mt = 0; mt < 4; ++mt) { const LAS unsigned char* irow = L + GS_I + (16 * mt + fr) * 144;
#pragma unroll
                for (int ks = 0; ks < 2; ++ks) { const bf16x8 ia = lds_aperm(irow, 32 * ks, fq); o[0][mt] = MFMA16(ia, Vb[0][ks], o[0][mt]); o[1][mt] = MFMA16(ia, Vb[1][ks], o[1][mt]); } }
#pragma unroll
            for (int d = 0; d < 8; ++d) { S[0][d] = S[0][d] * gl; S[1][d] = S[1][d] * gl; const LAS unsigned char* krow = L + GS_K + (16 * d + fr) * 144;
#pragma unroll
                for (int ks = 0; ks < 2; ++ks) { const bf16x8 ka = lds_aperm(krow, 32 * ks, fq); S[0][d] = MFMA16(ka, Vb[0][ks], S[0][d]); S[1][d] = MFMA16(ka, Vb[1][ks], S[1][d]); } }
            LAS float* sq = ssq + (n & 1) * 256;
            float zv[2][16];
#pragma unroll
            for (int mt = 0; mt < 4; ++mt)
#pragma unroll
                for (int r = 0; r < 4; ++r) { const int t = 16 * mt + 4 * fq + r; const float s = red16_dpp(o[0][mt][r] * o[0][mt][r] + o[1][mt][r] * o[1][mt][r]); if (fr == 0) sq[w * 64 + t] = s;
                    zv[0][4 * mt + r] = bf2f(*(const LAS bf16_t*)(L + GS_Z + t * 272 + (32 * w + fr) * 2)); zv[1][4 * mt + r] = bf2f(*(const LAS bf16_t*)(L + GS_Z + t * 272 + (32 * w + 16 + fr) * 2)); }
            GS_BAR();
#pragma unroll
            for (int mt = 0; mt < 4; ++mt)
#pragma unroll
                for (int r = 0; r < 4; ++r) { const int t = 16 * mt + 4 * fq + r; const float s = (sq[t] + sq[64 + t]) + (sq[128 + t] + sq[192 + t]);
                    const float rstd = rsqrtf(s * (1.f / 128.f) + NORM_EPS);
                    const size_t m = (size_t)b * SEQ + (size_t)n * 64 + t;
                    if (!dry) { OAB[m * 1024 + h * 128 + 32 * w + fr] = (bf16_t)f2bf(o[0][mt][r] * rstd * gnw[0] * siluf_(zv[0][4 * mt + r]));
                                OAB[m * 1024 + h * 128 + 32 * w + 16 + fr] = (bf16_t)f2bf(o[1][mt][r] * rstd * gnw[1] * siluf_(zv[1][4 * mt + r])); } }
            GS_BAR();
        }
#pragma unroll
        for (int nt = 0; nt < 2; ++nt)
#pragma unroll
            for (int d = 0; d < 8; ++d) if (!dry) GST[nt * 512 + d * 64 + lane] = S[nt][d];
    }
#undef GS_BAR
}
constexpr int RW_L = 16;
constexpr int RW_W2T = 0, RW_A2T = 9216, RW_G2T = 18432;
constexpr int RW_OPS = 35840, RW_OPS_SZ = 24576;
constexpr int RW_YB = RW_OPS + 2 * RW_OPS_SZ, RW_YB_SZ = 4096;
constexpr int RW_XS = RW_YB + 2 * RW_YB_SZ, RW_XS_W = 2240;
constexpr int RW_XS_AD = 576, RW_XS_GD = 1152;
constexpr int RW_POST = RW_XS + 4 * RW_XS_W, RW_POST_SZ = 8192;
static_assert(RW_POST + 3 * RW_POST_SZ <= XB_LDS_OFF, "rwkv lds");
#define RW_BAR() do { asm volatile("s_waitcnt lgkmcnt(0)" ::: "memory"); __builtin_amdgcn_s_barrier(); asm volatile("" ::: "memory"); } while (0)
__device__ __forceinline__ float wave_sum_rl(float v) {
    v = red16_dpp(v);
    const int i = __builtin_bit_cast(int, v);
    return (__builtin_bit_cast(float, __builtin_amdgcn_readlane(i, 0)) + __builtin_bit_cast(float, __builtin_amdgcn_readlane(i, 16))) + (__builtin_bit_cast(float, __builtin_amdgcn_readlane(i, 32)) + __builtin_bit_cast(float, __builtin_amdgcn_readlane(i, 48)));
}

__device__ __forceinline__ void rwkv_unit(const Frame& F, const Args& a, int bh) {
    const bf16_t* F0 = (const bf16_t*)(F.ws + WS_BIG);
    bf16_t* OAB = (bf16_t*)(F.ws + WS_XN);
    const int h = bh & 7, b = bh >> 3, tid = F.tid, lane = F.lane, wave = F.wave, fr = lane & 15, fq = lane >> 4;
    LAS unsigned char* L = F.lds;
    for (int idx = tid; idx < 64 * 64; idx += NTHREADS) { const int j = idx >> 6, c = idx & 63;
        *(LAS bf16_t*)(L + RW_W2T + c * 144 + j * 2) = (bf16_t)f2bf(a.in[IN_RW2][j * 512 + h * 64 + c]);
        *(LAS bf16_t*)(L + RW_A2T + c * 144 + j * 2) = (bf16_t)f2bf(a.in[IN_RA2][j * 512 + h * 64 + c]); }
    for (int idx = tid; idx < 128 * 64; idx += NTHREADS) { const int j = idx >> 6, c = idx & 63;
        *(LAS bf16_t*)(L + RW_G2T + c * 272 + j * 2) = (bf16_t)f2bf(a.in[IN_RG2][j * 512 + h * 64 + c]); }
    RW_BAR();
    const size_t mb = (size_t)b * SEQ;
    if (wave < 4) {
        f32x2 S0[4], S1[4];
#pragma unroll
        for (int k = 0; k < 4; ++k) { S0[k] = (f32x2){0.f, 0.f}; S1[k] = (f32x2){0.f, 0.f}; }
        const int cg = lane & 7, row0 = 16 * wave + 2 * (lane >> 3);
        RW_BAR();
#pragma unroll 1
        for (int c = 0; c < SEQ / RW_L; ++c) {
            LAS unsigned char* ops = L + RW_OPS + (c & 1) * RW_OPS_SZ; LAS float* yb = (LAS float*)(L + RW_YB + (c & 1) * RW_YB_SZ);
            f32x4 wA, wB, kkA, kkB, bA, bB, kA, kB, rA, rB; f32x2 vv;
#define RW_LOADOPS(s_) do { const LAS float* po_ = (const LAS float*)(ops + (s_) * 1536) + 8 * cg; \
                wA = *(const LAS f32x4*)(po_); wB = *(const LAS f32x4*)(po_ + 4); kkA = *(const LAS f32x4*)(po_ + 64); kkB = *(const LAS f32x4*)(po_ + 68); \
                bA = *(const LAS f32x4*)(po_ + 128); bB = *(const LAS f32x4*)(po_ + 132); kA = *(const LAS f32x4*)(po_ + 192); kB = *(const LAS f32x4*)(po_ + 196); \
                rA = *(const LAS f32x4*)(po_ + 256); rB = *(const LAS f32x4*)(po_ + 260); vv = *(const LAS f32x2*)((const LAS float*)(ops + (s_) * 1536) + 320 + row0); } while (0)
            RW_LOADOPS(0);
#pragma unroll 1
            for (int s = 0; s < RW_L; ++s) {
                const f32x2 kk2[4] = {{kkA[0], kkA[1]}, {kkA[2], kkA[3]}, {kkB[0], kkB[1]}, {kkB[2], kkB[3]}};
                const f32x2 w2[4] = {{wA[0], wA[1]}, {wA[2], wA[3]}, {wB[0], wB[1]}, {wB[2], wB[3]}};
                const f32x2 b2[4] = {{bA[0], bA[1]}, {bA[2], bA[3]}, {bB[0], bB[1]}, {bB[2], bB[3]}};
                const f32x2 k2[4] = {{kA[0], kA[1]}, {kA[2], kA[3]}, {kB[0], kB[1]}, {kB[2], kB[3]}};
                const f32x2 r2[4] = {{rA[0], rA[1]}, {rA[2], rA[3]}, {rB[0], rB[1]}, {rB[2], rB[3]}};
                const f32x2 v0 = {vv[0], vv[0]}, v1 = {vv[1], vv[1]};
                if (s + 1 < RW_L) RW_LOADOPS(s + 1);
                f32x2 a0 = S0[0] * kk2[0] + S0[1] * kk2[1], a1 = S1[0] * kk2[0] + S1[1] * kk2[1];
                a0 = a0 + S0[2] * kk2[2] + S0[3] * kk2[3]; a1 = a1 + S1[2] * kk2[2] + S1[3] * kk2[3];
                const float sa0 = red8_dpp(a0[0] + a0[1]), sa1 = red8_dpp(a1[0] + a1[1]);
                const f32x2 n0 = {-sa0, -sa0}, n1 = {-sa1, -sa1};
                f32x2 y0 = {0.f, 0.f}, y1 = {0.f, 0.f};
#pragma unroll
                for (int q = 0; q < 4; ++q) { S0[q] = S0[q] * w2[q] + n0 * b2[q] + v0 * k2[q]; S1[q] = S1[q] * w2[q] + n1 * b2[q] + v1 * k2[q]; y0 = y0 + S0[q] * r2[q]; y1 = y1 + S1[q] * r2[q]; }
                const float ys0 = red8_dpp(y0[0] + y0[1]), ys1 = red8_dpp(y1[0] + y1[1]);
                if (cg == 0) *(LAS f32x2*)(yb + s * 64 + row0) = (f32x2){ys0, ys1};
            }
#undef RW_LOADOPS
            RW_BAR();
        }
        RW_BAR();
    } else {
        const int p = wave - 4, hc = h * 64 + lane;
        LAS unsigned char* XS = L + RW_XS + p * RW_XS_W;
        const float w0c = a.in[IN_RW0][hc], a0c = a.in[IN_RA0][hc], kkc = a.in[IN_RKK][hc], kac = a.in[IN_RKA][hc], rkc = a.in[IN_RRK][hc], lnw = a.in[IN_RLNW][hc], lnb = a.in[IN_RLNB][hc];
        float mu[7];
#pragma unroll
        for (int g = 0; g < 3; ++g) mu[g] = a.in[IN_RMU][g * 512 + hc];
#pragma unroll
        for (int g = 3; g < 7; ++g) mu[g] = a.in[IN_RMU][1536 + (g - 3) * 64 + lane];
        bf16_t fv[5][7];
#define RW_FETCH(cn_) do { const long t0_ = (long)(cn_) * RW_L + 4 * p - 1; \
            _Pragma("unroll") for (int j_ = 0; j_ < 5; ++j_) { const long t_ = t0_ + j_; \
                _Pragma("unroll") for (int g_ = 0; g_ < 7; ++g_) { const int col_ = F0_RWKV + (g_ < 3 ? g_ * 512 + h * 64 : 1536 + (g_ - 3) * 64) + lane; fv[j_][g_] = (t_ >= 0) ? F0[(mb + t_) * F0_LD + col_] : (bf16_t)0; } } } while (0)
        RW_FETCH(0);
#pragma unroll 1
        for (int c = -1; c <= SEQ / RW_L; ++c) {
            const bool prep_on = (c + 1 < SEQ / RW_L), post_on = (c >= 1);
            if (post_on) {
                const LAS float* yb = (const LAS float*)(L + RW_YB + ((c - 1) & 1) * RW_YB_SZ); const LAS float* pg = (const LAS float*)(L + RW_POST + ((c - 1) % 3) * RW_POST_SZ);
#pragma unroll
                for (int j = 0; j < 4; ++j) { const int tau = 4 * p + j; const float y = yb[tau * 64 + lane];
                    const float mean = wave_sum_rl(y) * (1.f / 64.f); const float d = y - mean; const float var = wave_sum_rl(d * d) * (1.f / 64.f);
                    const float o = (d * rsqrtf(var + RWKV_LN_EPS) * lnw + lnb + pg[1024 + tau * 64 + lane]) * pg[tau * 64 + lane];
                    OAB[(mb + (size_t)(c - 1) * RW_L + tau) * 1024 + 512 + hc] = (bf16_t)f2bf(o); }
            }
            if (prep_on) {
                LAS unsigned char* nops = L + RW_OPS + ((c + 1) & 1) * RW_OPS_SZ; LAS float* pg_n = (LAS float*)(L + RW_POST + ((c + 1) % 3) * RW_POST_SZ);
                float xr[4], xk[4], xv[4];
#pragma unroll
                for (int j = 0; j < 4; ++j) {
                    float xs[7];
#pragma unroll
                    for (int g = 0; g < 7; ++g) { const float f = bf2f(fv[j + 1][g]), fp = bf2f(fv[j][g]); xs[g] = f + (fp - f) * mu[g]; }
                    xr[j] = xs[0]; xk[j] = xs[1]; xv[j] = xs[2];
                    *(LAS bf16_t*)(XS + j * 144 + lane * 2) = (bf16_t)f2bf(fast_tanhf(xs[3]));
                    *(LAS bf16_t*)(XS + RW_XS_AD + j * 144 + lane * 2) = (bf16_t)f2bf(xs[4]);
                    *(LAS bf16_t*)(XS + RW_XS_GD + j * 272 + lane * 2) = (bf16_t)f2bf(sigmoidf_(xs[5]));
                    *(LAS bf16_t*)(XS + RW_XS_GD + j * 272 + 128 + lane * 2) = (bf16_t)f2bf(sigmoidf_(xs[6]));
                }
                if (c + 2 < SEQ / RW_L) RW_FETCH(c + 2);
                asm volatile("s_waitcnt lgkmcnt(0)" ::: "memory");
                f32x4 cw = (f32x4){0.f, 0.f, 0.f, 0.f}, ca = cw, cgt = cw;
                {
                    bf16x8 xa[2], xb[2], xg[4];
#pragma unroll
                    for (int ks = 0; ks < 2; ++ks) { xa[ks] = *(const LAS bf16x8*)(XS + (fr & 3) * 144 + (32 * ks + 8 * fq) * 2); xb[ks] = *(const LAS bf16x8*)(XS + RW_XS_AD + (fr & 3) * 144 + (32 * ks + 8 * fq) * 2); }
#pragma unroll
                    for (int ks = 0; ks < 4; ++ks) xg[ks] = *(const LAS bf16x8*)(XS + RW_XS_GD + (fr & 3) * 272 + (32 * ks + 8 * fq) * 2);
#pragma unroll
                    for (int nt = 0; nt < 4; ++nt) {
                        f32x4 tw = (f32x4){0.f, 0.f, 0.f, 0.f}, ta = tw, tg = tw;
#pragma unroll
                        for (int ks = 0; ks < 2; ++ks) { tw = MFMA16(xa[ks], *(const LAS bf16x8*)(L + RW_W2T + (16 * nt + fr) * 144 + (32 * ks + 8 * fq) * 2), tw);
                                                         ta = MFMA16(xb[ks], *(const LAS bf16x8*)(L + RW_A2T + (16 * nt + fr) * 144 + (32 * ks + 8 * fq) * 2), ta); }
#pragma unroll
                        for (int ks = 0; ks < 4; ++ks) tg = MFMA16(xg[ks], *(const LAS bf16x8*)(L + RW_G2T + (16 * nt + fr) * 272 + (32 * ks + 8 * fq) * 2), tg);
                        if (fq == nt) { cw = tw; ca = ta; cgt = tg; }
                    }
                }
#pragma unroll
                for (int j = 0; j < 4; ++j) { const int tau = 4 * p + j; LAS float* o = (LAS float*)(nops + tau * 1536);
                    const float lw = cw[j] + w0c; const float wlog = -fast_softplusf(-lw) - 0.5f; const float wdec = __expf(-__expf(wlog));
                    const float av = sigmoidf_(ca[j] + a0c);
                    const float kkraw = xk[j] * kkc, kp = xk[j] * (1.f + (av - 1.f) * kac);
                    const float rinv = rsqrtf(wave_sum_rl(kkraw * kkraw) + 1e-6f);
                    const float bn = wave_sum_rl(xr[j] * kp * rkc);
                    const float kkn = kkraw * rinv;
                    o[lane] = wdec; o[64 + lane] = kkn; o[128 + lane] = kkn * av; o[192 + lane] = kp; o[256 + lane] = xr[j]; o[320 + lane] = xv[j];
                    pg_n[tau * 64 + lane] = cgt[j]; pg_n[1024 + tau * 64 + lane] = xv[j] * bn; }
            }
            RW_BAR();
        }
#undef RW_FETCH
    }
    __syncthreads();
}
constexpr int RC_KR = 0, RC_BKT = 4096, RC_VT = 8192, RC_MBB = 10240, RC_MKB = 11264, RC_MBR = 11776, RC_MKR = 12288, RC_WL = 12800, RC_PG = 13056, RC_PBV = 15104, RC_REC = 17408;
constexpr int RC_SEG_CHUNKS = 32, RC_NSEG = (SEQ / 16) / RC_SEG_CHUNKS;
constexpr size_t WS_RSCR = WS_R2 + 21 * MiB;
constexpr size_t WS_RSTATE = WS_R2 + 17 * MiB;
constexpr size_t WS_RIMG = WS_R2 + 20 * MiB;
constexpr int RP_PRM = 35840;
constexpr int RP_MU = RP_PRM + 1280;
constexpr int RP_WAVE = RP_MU + 1792, RP_WAVE_SZ = 9216;
static_assert(RP_WAVE + 8 * RP_WAVE_SZ <= XB_LDS_OFF, "rwkv prep lds");
__device__ __forceinline__ float dpp_shr_f(float v, const int n) {
    const int i = __builtin_bit_cast(int, v); int r;
    if (n == 1) r = __builtin_amdgcn_update_dpp(0, i, 0x111, 0xF, 0xF, true); else if (n == 2) r = __builtin_amdgcn_update_dpp(0, i, 0x112, 0xF, 0xF, true);
    else if (n == 4) r = __builtin_amdgcn_update_dpp(0, i, 0x114, 0xF, 0xF, true); else r = __builtin_amdgcn_update_dpp(0, i, 0x118, 0xF, 0xF, true);
    return __builtin_bit_cast(float, r);
}
__device__ __forceinline__ void rwkvc_prep_phase(const Frame& F, const Args& a, int sg, int bid0, int nb) {
    const bf16_t* F0 = (const bf16_t*)(F.ws + WS_BIG);
    unsigned char* SCR = F.ws + ((sg & 1) ? WS_RSCR2 : WS_RSCR);
    const int tid = F.tid, wave = F.wave;
    LAS unsigned char* L = F.lds;
    for (int blk = F.bid - bid0; blk < 256; blk += nb) {
        const int bh = blk >> 2, h = bh & 7, b = bh >> 3;
        const size_t mb = (size_t)b * SEQ;
        LAS unsigned char* XS = L + RP_WAVE + wave * RP_WAVE_SZ;
            int ln_ = F.lane; asm volatile("" : "+v"(ln_));
            const int lane = ln_, fr = ln_ & 15, fq = ln_ >> 4;
            const int cs = (blk & 3) * 8 + wave;
            const int t0 = (sg * RC_SEG_CHUNKS + cs) * 16;
            unsigned char* rec = SCR + ((size_t)bh * RC_SEG_CHUNKS + cs) * RC_REC;
            const bf16_t* rowc = F0 + (mb + t0 + fr) * F0_LD + F0_RWKV;
            const bool hasp = (t0 + fr) > 0; const bf16_t* rowp = rowc - (hasp ? F0_LD : 0);
            const bf16_t* rc4 = rowc + 4 * fq; const bf16_t* rp4 = rowp + 4 * fq; const LAS float* mul4 = (const LAS float*)(L + RP_MU) + 4 * fq;
            unsigned char* pbkt = rec + RC_BKT + fq * 256 + (fr >> 2) * 16 + (fr & 3) * 2;
            unsigned char* pvt = rec + RC_VT + fq * 128 + fr * 2;
            unsigned char* pwl = rec + RC_WL + fq * 16;
            unsigned char* ppg = rec + RC_PG + fr * 128 + fq * 8;
            LAS unsigned char* xs4 = XS + fr * 144 + fq * 8;
            u32x2 rawc[7][4], rawp[7][4];
#pragma unroll
            for (int g = 3; g < 7; ++g)
#pragma unroll
                for (int mt = 0; mt < 4; ++mt) { const int coff = 1536 + 64 * (g - 3) + 16 * mt; rawc[g][mt] = *(const u32x2*)(rc4 + coff); rawp[g][mt] = *(const u32x2*)(rp4 + coff); }
        __syncthreads();
        {
            const u32x4* src = (const u32x4*)(F.ws + WS_RIMG + (size_t)h * 35840);
            u32x4 t4[5];
#pragma unroll
            for (int i = 0; i < 5; ++i) { const int e = tid + NTHREADS * i; t4[i] = (e < 2240) ? src[e] : (u32x4){0u, 0u, 0u, 0u}; }
#pragma unroll
            for (int i = 0; i < 5; ++i) { const int e = tid + NTHREADS * i; if (e < 2240) *(LAS u32x4*)(L + e * 16) = t4[i]; }
        }
        if (tid < 320) { const int wh = tid >> 6, c = tid & 63; const float* src = wh == 0 ? a.in[IN_RW0] : wh == 1 ? a.in[IN_RA0] : wh == 2 ? a.in[IN_RKK] : wh == 3 ? a.in[IN_RKA] : a.in[IN_RRK];
            ((LAS float*)(L + RP_PRM))[tid] = src[h * 64 + c]; }
        if (tid < 448) ((LAS float*)(L + RP_MU))[tid] = a.in[IN_RMU][tid < 192 ? (tid >> 6) * 512 + h * 64 + (tid & 63) : 1536 + (tid - 192)];
        __syncthreads();
        const LAS float* PRM = (const LAS float*)(L + RP_PRM);
        {
#pragma unroll
            for (int g = 0; g < 4; ++g) {
                const int coff = 1536 + 64 * g;
#pragma unroll
                for (int mt = 0; mt < 4; ++mt) { const int j0 = 16 * mt + 4 * fq;
                    const u32x2 fc = rawc[3 + g][mt]; u32x2 fp = rawp[3 + g][mt]; if (!hasp) fp = (u32x2){0u, 0u};
                    const f32x4 mu = *(const LAS f32x4*)(mul4 + 192 + 64 * g + 16 * mt);
                    float x[4] = {bflo(fc.x), bfhi(fc.x), bflo(fc.y), bfhi(fc.y)}; const float xp[4] = {bflo(fp.x), bfhi(fp.x), bflo(fp.y), bfhi(fp.y)};
#pragma unroll
                    for (int e = 0; e < 4; ++e) { x[e] = x[e] + (xp[e] - x[e]) * mu[e]; x[e] = (g == 0) ? fast_tanhf(x[e]) : (g == 1) ? x[e] : sigmoidf_(x[e]); }
                    u32x2 o; o.x = pk2(x[0], x[1]); o.y = pk2(x[2], x[3]);
                    LAS unsigned char* dst = (g == 0) ? XS + fr * 144 + j0 * 2 : (g == 1) ? XS + 2304 + fr * 144 + j0 * 2 : XS + 4608 + fr * 272 + (g - 2) * 128 + j0 * 2;
                    *(LAS u32x2*)dst = o; } }
#pragma unroll
            for (int g = 0; g < 3; ++g)
#pragma unroll
                for (int mt = 0; mt < 4; ++mt) { const int coff = g * 512 + h * 64 + 16 * mt; rawc[g][mt] = *(const u32x2*)(rc4 + coff); rawp[g][mt] = *(const u32x2*)(rp4 + coff); }
            asm volatile("s_waitcnt lgkmcnt(0)" ::: "memory");
            float vr[16], vk[16], vv[16], ve[16], vkk[16], vb[16];
            float ss = 0.f, bn = 0.f;
            bf16x8 xw[2], xa[2], xg[4];
#pragma unroll
            for (int ks = 0; ks < 2; ++ks) { xw[ks] = *(const LAS bf16x8*)(XS + fr * 144 + (32 * ks + 8 * fq) * 2); xa[ks] = *(const LAS bf16x8*)(XS + 2304 + fr * 144 + (32 * ks + 8 * fq) * 2); }
#pragma unroll
            for (int ks = 0; ks < 4; ++ks) xg[ks] = *(const LAS bf16x8*)(XS + 4608 + fr * 272 + (32 * ks + 8 * fq) * 2);
#pragma unroll
            for (int mt = 0; mt < 4; ++mt) {
#pragma unroll
                for (int g = 0; g < 3; ++g) { const int coff = g * 512 + 16 * mt;
                    const u32x2 fc = rawc[g][mt]; u32x2 fp = rawp[g][mt]; if (!hasp) fp = (u32x2){0u, 0u};
                    const f32x4 mu = *(const LAS f32x4*)(mul4 + 64 * g + 16 * mt);
                    const float x[4] = {bflo(fc.x), bfhi(fc.x), bflo(fc.y), bfhi(fc.y)}; const float xp[4] = {bflo(fp.x), bfhi(fp.x), bflo(fp.y), bfhi(fp.y)};
#pragma unroll
                    for (int e = 0; e < 4; ++e) { const float xs = x[e] + (xp[e] - x[e]) * mu[e]; if (g == 0) vr[4 * mt + e] = xs; else if (g == 1) vk[4 * mt + e] = xs; else vv[4 * mt + e] = xs; } }
                f32x4 cw = (f32x4){0.f, 0.f, 0.f, 0.f}, ca = cw, cg = cw;
#pragma unroll
                for (int ks = 0; ks < 2; ++ks) { cw = MFMA16(*(const LAS bf16x8*)(L + RW_W2T + (16 * mt + fr) * 144 + (32 * ks + 8 * fq) * 2), xw[ks], cw);
                                                 ca = MFMA16(*(const LAS bf16x8*)(L + RW_A2T + (16 * mt + fr) * 144 + (32 * ks + 8 * fq) * 2), xa[ks], ca); }
#pragma unroll
                for (int ks = 0; ks < 4; ++ks) cg = MFMA16(*(const LAS bf16x8*)(L + RW_G2T + (16 * mt + fr) * 272 + (32 * ks + 8 * fq) * 2), xg[ks], cg);
#pragma unroll
                for (int r = 0; r < 4; ++r) { const int q = 4 * mt + r, c = 16 * mt + 4 * fq + r;
                    const float lw = cw[r] + PRM[c]; ve[q] = 0.6065306597126334f * sigmoidf_(lw);
                    const float av = sigmoidf_(ca[r] + PRM[64 + c]);
                    const float kraw = vk[q] * PRM[128 + c]; vk[q] = vk[q] * (1.f + (av - 1.f) * PRM[192 + c]);
                    vkk[q] = kraw; vb[q] = av; ss += kraw * kraw; bn += vr[q] * vk[q] * PRM[256 + c]; }
                { u32x2 og; og.x = pk2(cg[0], cg[1]); og.y = pk2(cg[2], cg[3]); *(u32x2*)(ppg + mt * 32) = og; }
                asm volatile("" ::: "memory");
            }
            ss += __shfl_xor(ss, 16); ss += __shfl_xor(ss, 32); bn += __shfl_xor(bn, 16); bn += __shfl_xor(bn, 32);
            const float rinv = rsqrtf(ss + 1e-6f);
#pragma unroll
            for (int mt = 0; mt < 4; ++mt) { u32x2 ob; ob.x = pk2(vv[4 * mt] * bn, vv[4 * mt + 1] * bn); ob.y = pk2(vv[4 * mt + 2] * bn, vv[4 * mt + 3] * bn); *(u32x2*)(ppg + 2048 + mt * 32) = ob; }
#pragma unroll
            for (int ks = 0; ks < 2; ++ks) {
                float kkt[8], rt[8], bh_[8], kh[8];
#pragma unroll
                for (int i = 0; i < 8; ++i) { const int q = 8 * ks + i;
                    float cl = ve[q];
                    cl += dpp_shr_f(cl, 1); cl += dpp_shr_f(cl, 2); cl += dpp_shr_f(cl, 4); cl += dpp_shr_f(cl, 8);
                    const float clL = __shfl(cl, (lane & 48) | 15);
                    const float kkn = vkk[q] * rinv, bq = kkn * vb[q];
                    const float W = __expf(-cl), Wp = __expf(ve[q] - cl), Wi = __expf(cl), WLr = __expf(cl - clL);
                    kkt[i] = kkn * Wp; rt[i] = vr[q] * W; bh_[i] = bq * Wi; kh[i] = vk[q] * Wi;
                    *(bf16_t*)(pbkt + (q >> 2) * 1024 + (q & 3) * 64) = (bf16_t)f2bf(-bq * WLr);
                    *(bf16_t*)(pbkt + (q >> 2) * 1024 + (q & 3) * 64 + 8) = (bf16_t)f2bf(vk[q] * WLr);
                    *(bf16_t*)(pvt + (q >> 2) * 512 + (q & 3) * 32) = (bf16_t)f2bf(vv[q]);
                    if (fr == 15) *(float*)(pwl + (q >> 2) * 64 + (q & 3) * 4) = W;
                }
                u32x4 o1, o2;
                o1.x = pk2(kkt[0], kkt[1]); o1.y = pk2(kkt[2], kkt[3]); o1.z = pk2(kkt[4], kkt[5]); o1.w = pk2(kkt[6], kkt[7]);
                o2.x = pk2(rt[0], rt[1]); o2.y = pk2(rt[2], rt[3]); o2.z = pk2(rt[4], rt[5]); o2.w = pk2(rt[6], rt[7]);
                *(u32x4*)(rec + RC_KR + fr * 128 + ks * 64 + fq * 16) = o1; *(u32x4*)(rec + RC_KR + 2048 + fr * 128 + ks * 64 + fq * 16) = o2;
#pragma unroll
                for (int m2 = 0; m2 < 2; ++m2) { const int mt = 2 * ks + m2; LAS unsigned char* xo = xs4 + mt * 32;
                    *(LAS u32x2*)(xo) = (u32x2){o1[2 * m2], o1[2 * m2 + 1]};
                    *(LAS u32x2*)(xo + 2304) = (u32x2){o2[2 * m2], o2[2 * m2 + 1]};
                    u32x2 o; o.x = pk2(bh_[4 * m2], bh_[4 * m2 + 1]); o.y = pk2(bh_[4 * m2 + 2], bh_[4 * m2 + 3]); *(LAS u32x2*)(xo + 4608) = o;
                    o.x = pk2(kh[4 * m2], kh[4 * m2 + 1]); o.y = pk2(kh[4 * m2 + 2], kh[4 * m2 + 3]); *(LAS u32x2*)(xo + 6912) = o; }
                asm volatile("" ::: "memory");
            }
            asm volatile("s_waitcnt lgkmcnt(0)" ::: "memory");
            f32x4 mbb = (f32x4){0.f, 0.f, 0.f, 0.f}, mkb = mbb, mbr = mbb, mkr = mbb;
#pragma unroll
            for (int ks = 0; ks < 2; ++ks) { const int off = fr * 144 + (32 * ks + 8 * fq) * 2;
                const bf16x8 akk = *(const LAS bf16x8*)(XS + off), ar = *(const LAS bf16x8*)(XS + 2304 + off), bb = *(const LAS bf16x8*)(XS + 4608 + off), bk = *(const LAS bf16x8*)(XS + 6912 + off);
                mbb = MFMA16(akk, bb, mbb); mkb = MFMA16(akk, bk, mkb); mbr = MFMA16(ar, bb, mbr); mkr = MFMA16(ar, bk, mkr); }
            {
                float T[16]; const float mf0 = mbb[0], mf1 = mbb[1], mf2 = mbb[2], mf3 = mbb[3];
                const int mb_[4] = {__builtin_bit_cast(int, mf0), __builtin_bit_cast(int, mf1), __builtin_bit_cast(int, mf2), __builtin_bit_cast(int, mf3)};
#pragma unroll
                for (int t = 0; t < 16; ++t) T[t] = (t == fr) ? 1.f : 0.f;
#pragma unroll
                for (int t = 1; t < 16; ++t) { float s0 = T[t], s1 = 0.f;
#pragma unroll
                    for (int j = 0; j < t; ++j) { const float m = __builtin_bit_cast(float, __builtin_amdgcn_readlane(mb_[t & 3], j + 16 * (t >> 2)));
                        if (j & 1) s1 -= m * T[j]; else s0 -= m * T[j]; }
                    T[t] = s0 + s1; }
                if (fq == 0) {
#pragma unroll
                    for (int t = 0; t < 16; ++t) { const bf16_t tv = (bf16_t)f2bf(T[t]); *(bf16_t*)(rec + RC_MBB + t * 64 + (fr >> 2) * 16 + (fr & 3) * 2) = tv; *(bf16_t*)(rec + RC_MBB + t * 64 + (fr >> 2) * 16 + 8 + (fr & 3) * 2) = tv; }
                }
            }
#pragma unroll
            for (int r = 0; r < 4; ++r) { const int t = 4 * fq + r, j = fr;
                *(bf16_t*)(rec + RC_MKB + t * 32 + j * 2) = (bf16_t)f2bf((j < t) ? mkb[r] : 0.f);
                *(bf16_t*)(rec + RC_MBR + t * 32 + j * 2) = (bf16_t)f2bf((j <= t) ? mbr[r] : 0.f);
                *(bf16_t*)(rec + RC_MKR + t * 32 + j * 2) = (bf16_t)f2bf((j <= t) ? mkr[r] : 0.f); }
            asm volatile("s_waitcnt lgkmcnt(0)" ::: "memory");
        }
    }
}

constexpr int RCH_X = 0;
constexpr int RCH_ST = 4096;
constexpr int RCH_RING = 8192, RCH_NSLOT = 6, RCH_PF = 5;
static_assert(RCH_RING + RCH_NSLOT * RC_REC <= XB_LDS_OFF, "rwkv chain lds");
#define RCH_BAR() do { asm volatile("s_waitcnt lgkmcnt(0)" ::: "memory"); __builtin_amdgcn_s_barrier(); asm volatile("" ::: "memory"); } while (0)
__device__ __forceinline__ void rwkvc_chain_unit(const Frame& F, const Args& a, int bh, int sg, bool dry = false) {
    const unsigned char* SCR = F.ws + ((sg & 1) ? WS_RSCR2 : WS_RSCR);
    bf16_t* OAB = (bf16_t*)(F.ws + WS_XN); f32x4* STATE = (f32x4*)(F.ws + WS_RSTATE);
    const int lane = F.lane, w = F.wave, fr = lane & 15, fq = lane >> 4, h = bh & 7, b = bh >> 3;
    LAS unsigned char* L = F.lds;
    const size_t mb = (size_t)b * SEQ;
    const unsigned char* seg = SCR + ((size_t)bh * RC_SEG_CHUNKS) * RC_REC;
    if (w >= 4) {
        const int p = w - 4;
#define RCH_ISSUE(ch_) do { int l16_ = lane * 16; asm volatile("" : "+v"(l16_)); const unsigned char* src_ = seg + (size_t)(ch_) * RC_REC + l16_; LAS unsigned char* dst_ = L + RCH_RING + ((ch_) % RCH_NSLOT) * RC_REC; \
            _Pragma("unroll") for (int i_ = 0; i_ < 5; ++i_) { const int pc_ = p + 4 * i_; if (pc_ < 17) __builtin_amdgcn_global_load_lds((const unsigned*)(src_ + pc_ * 1024), (LAS unsigned*)(dst_ + pc_ * 1024), 16, 0, 0); } } while (0)
#pragma unroll 1
        for (int ch = 0; ch < RCH_PF; ++ch) RCH_ISSUE(ch);
        if (p == 0) asm volatile("s_waitcnt vmcnt(20)" ::: "memory"); else asm volatile("s_waitcnt vmcnt(16)" ::: "memory");
        RCH_BAR();
#pragma unroll 1
        for (int cs = 0; cs < RC_SEG_CHUNKS; ++cs) {
            if (cs + RCH_PF < RC_SEG_CHUNKS) { RCH_ISSUE(cs + RCH_PF);
                if (p == 0) asm volatile("s_waitcnt vmcnt(20)" ::: "memory"); else asm volatile("s_waitcnt vmcnt(16)" ::: "memory"); }
            else asm volatile("s_waitcnt vmcnt(0)" ::: "memory");
            RCH_BAR();
        }
#undef RCH_ISSUE
    } else {
        LAS float* XT = (LAS float*)(L + RCH_X + w * 1024); LAS float* STT = (LAS float*)(L + RCH_ST);
        f32x4 acc[4];
#pragma unroll
        for (int mt = 0; mt < 4; ++mt) acc[mt] = (sg == 0) ? (f32x4){0.f, 0.f, 0.f, 0.f} : STATE[((size_t)bh * 4 + w) * 256 + mt * 64 + lane];
        const int v = 16 * w + fr, hc = h * 64 + v;
        const float lnw = a.in[IN_RLNW][hc], lnb = a.in[IN_RLNB][hc];
        RCH_BAR();
#pragma unroll 1
        for (int cs = 0; cs < RC_SEG_CHUNKS; ++cs) {
            const LAS unsigned char* rec = L + RCH_RING + (cs % RCH_NSLOT) * RC_REC;
            const u32x4 z4 = (u32x4){0u, 0u, 0u, 0u}; const int f2 = fq & 1;
            bf16x8 sb[2];
#pragma unroll
            for (int ks = 0; ks < 2; ++ks) { u32x4 pk; pk.x = pk2(acc[2 * ks][0], acc[2 * ks][1]); pk.y = pk2(acc[2 * ks][2], acc[2 * ks][3]); pk.z = pk2(acc[2 * ks + 1][0], acc[2 * ks + 1][1]); pk.w = pk2(acc[2 * ks + 1][2], acc[2 * ks + 1][3]); sb[ks] = __builtin_bit_cast(bf16x8, pk); }
            f32x4 rhs = (f32x4){0.f, 0.f, 0.f, 0.f}, y1 = rhs;
#pragma unroll
            for (int ks = 0; ks < 2; ++ks) { rhs = MFMA16(*(const LAS bf16x8*)(rec + RC_KR + fr * 128 + ks * 64 + fq * 16), sb[ks], rhs); y1 = MFMA16(*(const LAS bf16x8*)(rec + RC_KR + 2048 + fr * 128 + ks * 64 + fq * 16), sb[ks], y1); }
            u32x4 vt8 = *(const LAS u32x4*)(rec + RC_VT + v * 32 + f2 * 16), mkb = *(const LAS u32x4*)(rec + RC_MKB + fr * 32 + f2 * 16), mkr = *(const LAS u32x4*)(rec + RC_MKR + fr * 32 + f2 * 16), mbr = *(const LAS u32x4*)(rec + RC_MBR + fr * 32 + f2 * 16);
            if (fq >= 2) { vt8 = z4; mkb = z4; mkr = z4; mbr = z4; }
            rhs = MFMA16(__builtin_bit_cast(bf16x8, mkb), __builtin_bit_cast(bf16x8, vt8), rhs);
            y1 = MFMA16(__builtin_bit_cast(bf16x8, mkr), __builtin_bit_cast(bf16x8, vt8), y1);
            f32x4 u4;
            { u32x4 rb; rb.x = pk2(rhs[0], rhs[1]); rb.y = pk2(rhs[2], rhs[3]); rb.z = 0u; rb.w = 0u;
              const f32x4 zf = {0.f, 0.f, 0.f, 0.f}; u4 = MFMA16(*(const LAS bf16x8*)(rec + RC_MBB + fr * 64 + fq * 16), __builtin_bit_cast(bf16x8, rb), zf); }
            *(LAS f32x4*)(XT + fr * 16 + 4 * fq) = u4;
            asm volatile("s_waitcnt lgkmcnt(0)" ::: "memory");
            u32x4 ub;
            { const f32x4 ua = *(const LAS f32x4*)(XT + fr * 16 + 8 * f2), ubb = *(const LAS f32x4*)(XT + fr * 16 + 8 * f2 + 4);
              ub.x = pk2(ua[0], ua[1]); ub.y = pk2(ua[2], ua[3]); ub.z = pk2(ubb[0], ubb[1]); ub.w = pk2(ubb[2], ubb[3]); if (fq >= 2) ub = z4; }
            f32x4 yv = (f32x4){0.f, 0.f, 0.f, 0.f};
            yv = MFMA16(__builtin_bit_cast(bf16x8, mbr), __builtin_bit_cast(bf16x8, ub), yv);
            const f32x4 y = y1 - yv;
            u32x4 uvb; const u32x2 vt4 = *(const LAS u32x2*)(rec + RC_VT + v * 32 + fq * 8);
            uvb.x = pk2(u4[0], u4[1]); uvb.y = pk2(u4[2], u4[3]);
            uvb.z = vt4.x; uvb.w = vt4.y;
#pragma unroll
            for (int mt = 0; mt < 4; ++mt) { const f32x4 wl = *(const LAS f32x4*)(rec + RC_WL + (16 * mt + 4 * fq) * 4);
                acc[mt] = MFMA16(*(const LAS bf16x8*)(rec + RC_BKT + (16 * mt + fr) * 64 + fq * 16), __builtin_bit_cast(bf16x8, uvb), acc[mt] * wl); }
            float pgv[4], pbv[4];
#pragma unroll
            for (int r = 0; r < 4; ++r) { pgv[r] = bf2f(*(const LAS bf16_t*)(rec + RC_PG + (4 * fq + r) * 128 + v * 2)); pbv[r] = bf2f(*(const LAS bf16_t*)(rec + RC_PBV + (4 * fq + r) * 128 + v * 2)); }
            LAS float* st = STT + (cs & 1) * 128;
#pragma unroll
            for (int r = 0; r < 4; ++r) { const float s1 = red16_dpp(y[r]), s2 = red16_dpp(y[r] * y[r]); if (fr == 0) { st[(w * 16 + 4 * fq + r) * 2] = s1; st[(w * 16 + 4 * fq + r) * 2 + 1] = s2; } }
            RCH_BAR();
#pragma unroll
            for (int r = 0; r < 4; ++r) { const int t = 4 * fq + r; float s1 = 0.f, s2 = 0.f;
#pragma unroll
                for (int ww = 0; ww < 4; ++ww) { const f32x2 sv = *(const LAS f32x2*)(st + (ww * 16 + t) * 2); s1 += sv[0]; s2 += sv[1]; }
                const float mean = s1 * (1.f / 64.f), var = fmaxf(s2 * (1.f / 64.f) - mean * mean, 0.f);
                const float o = ((y[r] - mean) * rsqrtf(var + RWKV_LN_EPS) * lnw + lnb + pbv[r]) * pgv[r];
                if (!dry) OAB[(mb + (size_t)(sg * RC_SEG_CHUNKS + cs) * 16 + t) * 1024 + 512 + hc] = (bf16_t)f2bf(o); }
        }
#pragma unroll
        for (int mt = 0; mt < 4; ++mt) if (!dry) STATE[((size_t)bh * 4 + w) * 256 + mt * 64 + lane] = acc[mt];
    }
    __syncthreads();
}

__device__ __forceinline__ void rwkvc_build_images(const Frame& F, const Args& a) {
    const int gt = F.bid * NTHREADS + F.tid, NT = F.G * NTHREADS;
    for (int e = gt; e < 8 * 256 * 64; e += NT) {
        const int c = e & 63, jj = (e >> 6) & 255, h = e >> 14;
        unsigned char* img = F.ws + WS_RIMG + (size_t)h * 35840;
        if (jj < 64) *(bf16_t*)(img + RW_W2T + c * 144 + jj * 2) = (bf16_t)f2bf(a.in[IN_RW2][jj * 512 + h * 64 + c]);
        else if (jj < 128) *(bf16_t*)(img + RW_A2T + c * 144 + (jj - 64) * 2) = (bf16_t)f2bf(a.in[IN_RA2][(jj - 64) * 512 + h * 64 + c]);
        else *(bf16_t*)(img + RW_G2T + c * 272 + (jj - 128) * 2) = (bf16_t)f2bf(a.in[IN_RG2][(jj - 128) * 512 + h * 64 + c]);
    }
}
template <bool RES_BF16, bool OUT_BF16>
__device__ __forceinline__ void row_pass(const Frame& F, const bf16_t* mix, const void* resid_, const float* w_post, void* hout_, const float* w_next, bf16_t* xn) {
    const int gw = F.bid * NWAVES + F.wave, NGW = F.G * NWAVES, lane = F.lane;
    for (int mA = gw; mA < MTOK; mA += 2 * NGW) {
        const int mB = (mA + NGW < MTOK) ? mA + NGW : mA; const bool two = (mB != mA);
        const u32x2* mrA = (const u32x2*)(mix + (size_t)mA * D_MODEL) + lane; const u32x2* mrB = (const u32x2*)(mix + (size_t)mB * D_MODEL) + lane;
        u32x2 pa[4], pb[4]; f32x4 ha[4], hb[4];
#pragma unroll
        for (int j = 0; j < 4; ++j) { pa[j] = mrA[64 * j]; pb[j] = mrB[64 * j]; }
        if (RES_BF16) {
            const u32x2* rA = (const u32x2*)((const bf16_t*)resid_ + (size_t)mA * D_MODEL) + lane; const u32x2* rB = (const u32x2*)((const bf16_t*)resid_ + (size_t)mB * D_MODEL) + lane;
#pragma unroll
            for (int j = 0; j < 4; ++j) { const u32x2 qa = rA[64 * j], qb = rB[64 * j]; ha[j] = (f32x4){bflo(qa.x), bfhi(qa.x), bflo(qa.y), bfhi(qa.y)}; hb[j] = (f32x4){bflo(qb.x), bfhi(qb.x), bflo(qb.y), bfhi(qb.y)}; }
        } else {
            const f32x4* rA = (const f32x4*)((const float*)resid_ + (size_t)mA * D_MODEL) + lane; const f32x4* rB = (const f32x4*)((const float*)resid_ + (size_t)mB * D_MODEL) + lane;
#pragma unroll
            for (int j = 0; j < 4; ++j) { ha[j] = rA[64 * j]; hb[j] = rB[64 * j]; }
        }
        f32x4 va[4], vb[4]; float sa = 0.f, sb = 0.f;
#pragma unroll
        for (int j = 0; j < 4; ++j) { va[j] = (f32x4){bflo(pa[j].x), bfhi(pa[j].x), bflo(pa[j].y), bfhi(pa[j].y)}; vb[j] = (f32x4){bflo(pb[j].x), bfhi(pb[j].x), bflo(pb[j].y), bfhi(pb[j].y)};
            sa += (va[j].x * va[j].x + va[j].y * va[j].y) + (va[j].z * va[j].z + va[j].w * va[j].w); sb += (vb[j].x * vb[j].x + vb[j].y * vb[j].y) + (vb[j].z * vb[j].z + vb[j].w * vb[j].w); }
        const float ra = 1.f / sqrtf(wave_sum(sa) * (1.f / D_MODEL) + NORM_EPS), rb = 1.f / sqrtf(wave_sum(sb) * (1.f / D_MODEL) + NORM_EPS);
        float s2a = 0.f, s2b = 0.f;
#pragma unroll
        for (int j = 0; j < 4; ++j) { const f32x4 g = ((const f32x4*)w_post)[lane + 64 * j]; ha[j] = ha[j] + va[j] * ra * g; hb[j] = hb[j] + vb[j] * rb * g;
            s2a += (ha[j].x * ha[j].x + ha[j].y * ha[j].y) + (ha[j].z * ha[j].z + ha[j].w * ha[j].w); s2b += (hb[j].x * hb[j].x + hb[j].y * hb[j].y) + (hb[j].z * hb[j].z + hb[j].w * hb[j].w); }
        if (OUT_BF16) {
            u32x2* hoA = (u32x2*)((bf16_t*)hout_ + (size_t)mA * D_MODEL) + lane; u32x2* hoB = (u32x2*)((bf16_t*)hout_ + (size_t)mB * D_MODEL) + lane;
#pragma unroll
            for (int j = 0; j < 4; ++j) { u32x2 o; o.x = pk2(ha[j].x, ha[j].y); o.y = pk2(ha[j].z, ha[j].w); hoA[64 * j] = o; if (two) { o.x = pk2(hb[j].x, hb[j].y); o.y = pk2(hb[j].z, hb[j].w); hoB[64 * j] = o; } }
        } else {
            f32x4* hoA = (f32x4*)((float*)hout_ + (size_t)mA * D_MODEL) + lane; f32x4* hoB = (f32x4*)((float*)hout_ + (size_t)mB * D_MODEL) + lane;
#pragma unroll
            for (int j = 0; j < 4; ++j) { hoA[64 * j] = ha[j]; if (two) hoB[64 * j] = hb[j]; }
        }
        if (w_next) {
            const float qa = 1.f / sqrtf(wave_sum(s2a) * (1.f / D_MODEL) + NORM_EPS), qb = 1.f / sqrtf(wave_sum(s2b) * (1.f / D_MODEL) + NORM_EPS);
            unsigned long long* oA = (unsigned long long*)(xn + (size_t)mA * D_MODEL) + lane; unsigned long long* oB = (unsigned long long*)(xn + (size_t)mB * D_MODEL) + lane;
#pragma unroll
            for (int j = 0; j < 4; ++j) { const f32x4 g = ((const f32x4*)w_next)[lane + 64 * j];
                oA[64 * j] = (unsigned long long)pk2(ha[j].x * qa * g.x, ha[j].y * qa * g.y) | ((unsigned long long)pk2(ha[j].z * qa * g.z, ha[j].w * qa * g.w) << 32);
                if (two) oB[64 * j] = (unsigned long long)pk2(hb[j].x * qb * g.x, hb[j].y * qb * g.y) | ((unsigned long long)pk2(hb[j].z * qb * g.z, hb[j].w * qb * g.w) << 32); }
        }
    }
}
constexpr size_t B1_ACMPK = 128 * MiB, B1_ACMPV = 144 * MiB, B1_KS = 160 * MiB, B1_VST = 168 * MiB, B1_KW = 176 * MiB, B1_VWT = 184 * MiB, B1_QR = 192 * MiB;
constexpr size_t R2_HCMP = 0, R2_KC = 8 * MiB, R2_VCT = 9 * MiB, R2_SEL = 12 * MiB;
__device__ __constant__ float ROPE_INVF[8] = {1.0f, 0.1939227432012558f, 0.03760603070259094f, 0.007292664609849453f, 0.0014142135623842478f, 0.00027424818836152554f, 5.3182957344688475e-05f, 1.0313385246263351e-05f};

__device__ __forceinline__ void nsa_prep_phase(const Frame& F, const Args& a) {
    const bf16_t* F1 = (const bf16_t*)(F.ws + WS_BIG);
    bf16_t* ACMPK = (bf16_t*)(F.ws + WS_BIG + B1_ACMPK); bf16_t* ACMPV = (bf16_t*)(F.ws + WS_BIG + B1_ACMPV);
    bf16_t* KS = (bf16_t*)(F.ws + WS_BIG + B1_KS); bf16_t* VST = (bf16_t*)(F.ws + WS_BIG + B1_VST); bf16_t* KW = (bf16_t*)(F.ws + WS_BIG + B1_KW); bf16_t* VWT = (bf16_t*)(F.ws + WS_BIG + B1_VWT);
    bf16_t* QR = (bf16_t*)(F.ws + WS_BIG + B1_QR);
    const int* pos = (const int*)a.in[IN_POS];
    const int lane = F.lane, wave = F.wave, tid = F.tid;
    LAS unsigned char* Lvs = F.lds;
    LAS unsigned char* Lvw = F.lds + 16384;
    for (int u = F.bid; u < BATCH * 64; u += F.G) {
        const int b = u >> 6, blk = u & 63;
#pragma unroll 1
        for (int tt = 0; tt < 8; ++tt) {
            const int tl = 8 * wave + tt, t = blk * 64 + tl; const size_t m = (size_t)b * SEQ + t;
            const float p = (float)pos[m];
            const float ang = p * ROPE_INVF[lane & 7];
            const float cs = __cosf(ang), sn = __sinf(ang);
            const bf16_t* row = F1 + m * F1_LD;
            { const int hh = lane >> 2, qd = lane & 3; const u32x4 v0 = *(const u32x4*)(row + hh * 64 + qd * 16), v1 = *(const u32x4*)(row + hh * 64 + qd * 16 + 8);
              u32x4 o0 = v0, o1 = v1;
              float x1[8], x2[8], c8[8], s8[8];
#pragma unroll
              for (int i = 0; i < 8; ++i) { c8[i] = __shfl(cs, i); s8[i] = __shfl(sn, i); }
              if (qd == 0) {
                  x1[0] = bflo(v0.x); x1[1] = bfhi(v0.x); x1[2] = bflo(v0.y); x1[3] = bfhi(v0.y); x1[4] = bflo(v0.z); x1[5] = bfhi(v0.z); x1[6] = bflo(v0.w); x1[7] = bfhi(v0.w);
                  x2[0] = bflo(v1.x); x2[1] = bfhi(v1.x); x2[2] = bflo(v1.y); x2[3] = bfhi(v1.y); x2[4] = bflo(v1.z); x2[5] = bfhi(v1.z); x2[6] = bflo(v1.w); x2[7] = bfhi(v1.w);
                  float y1[8], y2[8];
#pragma unroll
                  for (int i = 0; i < 8; ++i) { y1[i] = x1[i] * c8[i] - x2[i] * s8[i]; y2[i] = x2[i] * c8[i] + x1[i] * s8[i]; }
                  o0.x = pk2(y1[0], y1[1]); o0.y = pk2(y1[2], y1[3]); o0.z = pk2(y1[4], y1[5]); o0.w = pk2(y1[6], y1[7]);
                  o1.x = pk2(y2[0], y2[1]); o1.y = pk2(y2[2], y2[3]); o1.z = pk2(y2[4], y2[5]); o1.w = pk2(y2[6], y2[7]); }
              *(u32x4*)(QR + m * 1024 + hh * 64 + qd * 16) = o0; *(u32x4*)(QR + m * 1024 + hh * 64 + qd * 16 + 8) = o1;
            }
            const int g = lane >> 5, d = 2 * (lane & 31); const int bg = b * 2 + g;
            const unsigned kc = *(const unsigned*)(row + 1024 + 0 * 128 + g * 64 + d), vc = *(const unsigned*)(row + 1024 + 1 * 128 + g * 64 + d);
            unsigned ks = *(const unsigned*)(row + 1024 + 2 * 128 + g * 64 + d); const unsigned vs = *(const unsigned*)(row + 1024 + 3 * 128 + g * 64 + d);
            unsigned kw = *(const unsigned*)(row + 1024 + 4 * 128 + g * 64 + d); const unsigned vw = *(const unsigned*)(row + 1024 + 5 * 128 + g * 64 + d);
            {
              const int l5 = lane & 31; const bool x1role = l5 < 4; const int i0 = 2 * (l5 & 3);
              const float c0 = __shfl(cs, i0), c1 = __shfl(cs, i0 + 1), s0 = __shfl(sn, i0), s1 = __shfl(sn, i0 + 1);
              const unsigned oks = __shfl_xor(ks, 4), okw = __shfl_xor(kw, 4);
              if (l5 < 8) { const float sg = x1role ? -1.f : 1.f;
                  ks = pk2(bflo(ks) * c0 + sg * bflo(oks) * s0, bfhi(ks) * c1 + sg * bfhi(oks) * s1);
                  kw = pk2(bflo(kw) * c0 + sg * bflo(okw) * s0, bfhi(kw) * c1 + sg * bfhi(okw) * s1); } }
            *(unsigned*)(KS + ((size_t)bg * SEQ + t) * 64 + d) = ks; *(unsigned*)(KW + ((size_t)bg * SEQ + t) * 64 + d) = kw;
            *(LAS unsigned*)(Lvs + tl * 256 + lane * 4) = vs; *(LAS unsigned*)(Lvw + tl * 256 + lane * 4) = vw;
            {
              const int i0 = t >> 4, s0 = t & 15;
              const float* pek = a.in[IN_NPEK]; const float* pev = a.in[IN_NPEV];
              if (i0 < 255) { *(unsigned*)(ACMPK + ((size_t)bg * 256 + i0) * 2048 + s0 * 64 + d) = pk2(bflo(kc) + pek[s0 * 64 + d], bfhi(kc) + pek[s0 * 64 + d + 1]);
                              *(unsigned*)(ACMPV + ((size_t)bg * 256 + i0) * 2048 + s0 * 64 + d) = pk2(bflo(vc) + pev[s0 * 64 + d], bfhi(vc) + pev[s0 * 64 + d + 1]); }
              if (i0 >= 1) { const int s1 = 16 + s0;
                              *(unsigned*)(ACMPK + ((size_t)bg * 256 + i0 - 1) * 2048 + s1 * 64 + d) = pk2(bflo(kc) + pek[s1 * 64 + d], bfhi(kc) + pek[s1 * 64 + d + 1]);
                              *(unsigned*)(ACMPV + ((size_t)bg * 256 + i0 - 1) * 2048 + s1 * 64 + d) = pk2(bflo(vc) + pev[s1 * 64 + d], bfhi(vc) + pev[s1 * 64 + d + 1]); }
            }
        }
        if (blk == 63) {
            for (int i = tid; i < 2 * 2048 / 8; i += NTHREADS) { const int g = i >> 8, o = (i & 255) * 8;
                *(u32x4*)(ACMPK + ((size_t)(b * 2 + g) * 256 + 255) * 2048 + o) = (u32x4){0u, 0u, 0u, 0u}; *(u32x4*)(ACMPV + ((size_t)(b * 2 + g) * 256 + 255) * 2048 + o) = (u32x4){0u, 0u, 0u, 0u}; }
        }
        __syncthreads();
        if (tid < 256) { const int which = tid >> 7, gd = tid & 127, g = gd >> 6, d = gd & 63; LAS unsigned char* Lv = which ? Lvw : Lvs;
            bf16_t* dst = (which ? VWT : VST) + (((size_t)(b * 2 + g) * 64 + blk) * 64 + d) * 64;
#pragma unroll
            for (int q8 = 0; q8 < 8; ++q8) { unsigned short e[8];
#pragma unroll
                for (int k = 0; k < 8; ++k) e[k] = *(const LAS bf16_t*)(Lv + (8 * q8 + k) * 256 + gd * 2);
                u32x4 o; o.x = e[0] | ((unsigned)e[1] << 16); o.y = e[2] | ((unsigned)e[3] << 16); o.z = e[4] | ((unsigned)e[5] << 16); o.w = e[6] | ((unsigned)e[7] << 16);
                *(u32x4*)(dst + 8 * q8) = o; } }
        __syncthreads();
    }
}

__device__ __forceinline__ void nsa_cmp2_phase(const Frame& F, const Args& a) {
    const bf16_t* HC = (const bf16_t*)((unsigned char*)a.out + R2_HCMP); bf16_t* KC = (bf16_t*)((unsigned char*)a.out + R2_KC); bf16_t* VCT = (bf16_t*)((unsigned char*)a.out + R2_VCT);
    const int* pos = (const int*)a.in[IN_POS];
    const int gw = F.bid * NWAVES + F.wave, NGW = F.G * NWAVES, lane = F.lane, fr = lane & 15, fq = lane >> 4;
    for (int it = gw; it < 512; it += NGW) {
        const int which = it >> 8, rt = it & 255;
        const bf16_t* A = HC + ((size_t)which * 4096 + 16 * rt) * 256; const bf16_t* Bt = (const bf16_t*)(F.ws + (which ? WS_W_C2V : WS_W_C2K));
        f32x4 c[4];
#pragma unroll
        for (int nt = 0; nt < 4; ++nt) c[nt] = (f32x4){0.f, 0.f, 0.f, 0.f};
#pragma unroll
        for (int ks = 0; ks < 8; ++ks) { const bf16x8 af = *(const bf16x8*)(A + fr * 256 + 32 * ks + 8 * fq);
#pragma unroll
            for (int nt = 0; nt < 4; ++nt) { const bf16x8 bf = *(const bf16x8*)(Bt + (16 * nt + fr) * 256 + 32 * ks + 8 * fq); c[nt] = MFMA16(af, bf, c[nt]); } }
        const int bg = rt >> 4, b = bg >> 1;
        if (which == 0) {
#pragma unroll
            for (int r = 0; r < 4; ++r) { const int i = (16 * rt + 4 * fq + r) & 255; int pi = 31 + 16 * i; if (pi > SEQ - 1) pi = SEQ - 1;
                const float ang = (float)pos[(size_t)b * SEQ + pi] * ROPE_INVF[fr & 7]; const float cs = __cosf(ang), sn = __sinf(ang);
                const float own = c[0][r], oth = __shfl_xor(own, 8);
                c[0][r] = (fr < 8) ? own * cs - oth * sn : own * cs + oth * sn;
#pragma unroll
                for (int nt = 0; nt < 4; ++nt) KC[((size_t)bg * 256 + i) * 64 + 16 * nt + fr] = (bf16_t)f2bf(c[nt][r]); }
        } else {
            const int i0 = (16 * rt + 4 * fq) & 255;
#pragma unroll
            for (int nt = 0; nt < 4; ++nt) { u32x2 p; p.x = pk2(c[nt][0], c[nt][1]); p.y = pk2(c[nt][2], c[nt][3]); *(u32x2*)(VCT + ((size_t)bg * 64 + 16 * nt + fr) * 256 + i0) = p; }
        }
    }
}
constexpr int CA_KC = 0, CA_KC_PITCH = 144;
constexpr int CA_VT = 36864, CA_VT_PITCH = 528;
__device__ __forceinline__ void nsa_cmp_attn_phase(const Frame& F, const Args& a) {
    const bf16_t* F1 = (const bf16_t*)(F.ws + WS_BIG); const bf16_t* QR = (const bf16_t*)(F.ws + WS_BIG + B1_QR);
    const bf16_t* KC = (const bf16_t*)((unsigned char*)a.out + R2_KC); const bf16_t* VCT = (const bf16_t*)((unsigned char*)a.out + R2_VCT);
    unsigned long long* SEL = (unsigned long long*)((unsigned char*)a.out + R2_SEL); bf16_t* ONSA = (bf16_t*)(F.ws + WS_XN);
    const int lane = F.lane, wave = F.wave, tid = F.tid, fr = lane & 15, fq = lane >> 4;
    LAS unsigned char* L = F.lds;
    for (int bgk = F.bid; bgk < 256; bgk += F.G) {
        const int bg = bgk & 15, kq = bgk >> 4, b = bg >> 1, g = bg & 1;
        __syncthreads();
        for (int i = tid; i < 256 * 8; i += NTHREADS) { const int key = i >> 3, ch = i & 7; *(LAS u32x4*)(L + CA_KC + key * CA_KC_PITCH + ch * 16) = *(const u32x4*)(KC + ((size_t)bg * 256 + key) * 64 + ch * 8); }
        for (int i = tid; i < 64 * 32; i += NTHREADS) { const int d = i >> 5, ch = i & 31; *(LAS u32x4*)(L + CA_VT + d * CA_VT_PITCH + ch * 16) = *(const u32x4*)(VCT + ((size_t)bg * 64 + d) * 256 + ch * 8); }
        __syncthreads();
#pragma unroll 1
        for (int rep = 0; rep < 2; ++rep) {
            const int idx = wave * 16 + kq; const int tt = rep == 0 ? idx : 255 - idx;
            const int t0 = 16 * tt, t = t0 + fr; const size_t m = (size_t)b * SEQ + t;
            const int nk = tt;
            const int nkt = (nk + 15) >> 4;
            float iaA[16], iaB[16];
#pragma unroll
            for (int kt = 0; kt < 16; ++kt) { iaA[kt] = 0.f; iaB[kt] = 0.f; }
#pragma unroll 1
            for (int hh = 0; hh < 8; ++hh) {
                const int H = g * 8 + hh;
                const bf16x8 q0 = *(const bf16x8*)(QR + m * 1024 + H * 64 + 8 * fq), q1 = *(const bf16x8*)(QR + m * 1024 + H * 64 + 32 + 8 * fq);
                float mrun = -INFINITY, lrun = 0.f;
#pragma unroll 1
                for (int kt = 0; kt < nkt; ++kt) {
                    const bf16x8 k0 = *(const LAS bf16x8*)(L + CA_KC + (16 * kt + fr) * CA_KC_PITCH + 16 * fq), k1 = *(const LAS bf16x8*)(L + CA_KC + (16 * kt + fr) * CA_KC_PITCH + 64 + 16 * fq);
                    f32x4 sv = (f32x4){0.f, 0.f, 0.f, 0.f}; sv = MFMA16(k0, q0, sv); sv = MFMA16(k1, q1, sv);
                    float tm = -INFINITY;
#pragma unroll
                    for (int r = 0; r < 4; ++r) { const int key = 16 * kt + 4 * fq + r; const bool vis = (16 * key + 31) <= t; sv[r] = vis ? sv[r] * 0.125f : -INFINITY; tm = fmaxf(tm, sv[r]); }
                    const float mn = fmaxf(mrun, tm);
                    if (mn != -INFINITY) { float add = 0.f;
#pragma unroll
                        for (int r = 0; r < 4; ++r) add += (sv[r] == -INFINITY) ? 0.f : __expf(sv[r] - mn);
                        lrun = lrun * ((mrun == -INFINITY) ? 0.f : __expf(mrun - mn)) + add; mrun = mn; }
                }
                float mx = fmaxf(mrun, __shfl_xor(mrun, 16)); mx = fmaxf(mx, __shfl_xor(mx, 32));
                const float mref = (mx == -INFINITY) ? 0.f : mx;
                float sum = (mrun == -INFINITY) ? 0.f : lrun * __expf(mrun - mref);
                sum += __shfl_xor(sum, 16); sum += __shfl_xor(sum, 32);
                const float inv = frcp(fmaxf(sum, 1e-30f));
                f32x4 o[4];
#pragma unroll
                for (int dt = 0; dt < 4; ++dt) o[dt] = (f32x4){0.f, 0.f, 0.f, 0.f};
#pragma unroll
                for (int ks = 0; ks < 8; ++ks) if (2 * ks < nkt) {
                    float p[8];
#pragma unroll
                    for (int half = 0; half < 2; ++half) { const int kt = 2 * ks + half;
                        const bf16x8 k0 = *(const LAS bf16x8*)(L + CA_KC + (16 * kt + fr) * CA_KC_PITCH + 16 * fq), k1 = *(const LAS bf16x8*)(L + CA_KC + (16 * kt + fr) * CA_KC_PITCH + 64 + 16 * fq);
                        f32x4 sv = (f32x4){0.f, 0.f, 0.f, 0.f}; sv = MFMA16(k0, q0, sv); sv = MFMA16(k1, q1, sv);
#pragma unroll
                        for (int r = 0; r < 4; ++r) { const int key = 16 * kt + 4 * fq + r; const bool vis = (16 * key + 31) <= t; p[4 * half + r] = vis ? __expf(sv[r] * 0.125f - mref) * inv : 0.f; } }
                    iaA[2 * ks] += (p[0] + p[1]) + (p[2] + 0.5f * p[3]); iaB[2 * ks] += p[3]; iaA[2 * ks + 1] += (p[4] + p[5]) + (p[6] + 0.5f * p[7]); iaB[2 * ks + 1] += p[7];
                    u32x4 pw; pw.x = pk2(p[0], p[1]); pw.y = pk2(p[2], p[3]); pw.z = pk2(p[4], p[5]); pw.w = pk2(p[6], p[7]);
                    const bf16x8 pb = __builtin_bit_cast(bf16x8, pw);
#pragma unroll
                    for (int dt = 0; dt < 4; ++dt) { const u32x2 v0 = *(const LAS u32x2*)(L + CA_VT + (16 * dt + fr) * CA_VT_PITCH + (32 * ks + 4 * fq) * 2), v1 = *(const LAS u32x2*)(L + CA_VT + (16 * dt + fr) * CA_VT_PITCH + (32 * ks + 16 + 4 * fq) * 2);
                        u32x4 vw; vw.x = v0.x; vw.y = v0.y; vw.z = v1.x; vw.w = v1.y; o[dt] = MFMA16(__builtin_bit_cast(bf16x8, vw), pb, o[dt]); }
                    __builtin_amdgcn_sched_barrier(0); }
                const float gate = sigmoidf_(bf2f(F1[m * F1_LD + 1792 + H * 3 + 0]));
#pragma unroll
                for (int dt = 0; dt < 4; ++dt) { u32x2 w; w.x = pk2(o[dt][0] * gate, o[dt][1] * gate); w.y = pk2(o[dt][2] * gate, o[dt][3] * gate); *(u32x2*)(ONSA + m * 1024 + H * 64 + 16 * dt + 4 * fq) = w; }
            }
            float imp[16];
#pragma unroll
            for (int kt = 0; kt < 16; ++kt) { const float up = __shfl(iaB[kt], (lane + 48) & 63); imp[kt] = up; }
            { float carry = 0.f;
#pragma unroll
              for (int kt = 0; kt < 16; ++kt) { const float prev3 = (fq == 0) ? carry : imp[kt]; carry = imp[kt]; imp[kt] = 0.5f * prev3 + iaA[kt]; } }
            const int cur = t >> 6;
            unsigned long long mask = 0ull;
            if (t0 < 1024) {
#pragma unroll
                for (int kt = 0; kt < 16; ++kt) { const int j = 4 * kt + fq; if (j <= cur) mask |= 1ull << j; }
            } else {
                float cv[16];
#pragma unroll
                for (int kt = 0; kt < 16; ++kt) { const int j = 4 * kt + fq; const bool forced = (j == 0) || (j == cur) || (j == cur - 1); cv[kt] = (j <= cur && !forced) ? imp[kt] : -INFINITY; }
                int rank[16];
#pragma unroll
                for (int kt = 0; kt < 16; ++kt) rank[kt] = 0;
#pragma unroll 1
                for (int f2 = 0; f2 < 4; ++f2) {
#pragma unroll
                    for (int k2 = 0; k2 < 16; ++k2) { const float ov = __shfl(cv[k2], fr + 16 * f2); const int j2 = 4 * k2 + f2;
#pragma unroll
                        for (int kt = 0; kt < 16; ++kt) { const int j = 4 * kt + fq; rank[kt] += (ov > cv[kt] || (ov == cv[kt] && j2 < j)) ? 1 : 0; } } }
#pragma unroll
                for (int kt = 0; kt < 16; ++kt) { const int j = 4 * kt + fq; const bool forced = (j == 0) || (j == cur) || (j == cur - 1);
                    if (forced || (cv[kt] != -INFINITY && rank[kt] < SEL_TOPN - 3)) mask |= 1ull << j; }
            }
            { unsigned lo = (unsigned)mask, hi = (unsigned)(mask >> 32);
              lo |= __shfl_xor(lo, 16); hi |= __shfl_xor(hi, 16); lo |= __shfl_xor(lo, 32); hi |= __shfl_xor(hi, 32);
              if (fq == 0) SEL[(size_t)bg * SEQ + t] = ((unsigned long long)hi << 32) | lo; }
        }
    }
}

constexpr int SA_K = 0, SA_V = 8192, SA_BUF = 16384, SA_NS = 8, SA_GB = 4;
#define SA_BAR() do { asm volatile("s_waitcnt lgkmcnt(0)" ::: "memory"); __builtin_amdgcn_s_barrier(); asm volatile("" ::: "memory"); } while (0)
template <int MODE  >
__device__ __forceinline__ void nsa_attn_pass(const Frame& F, const bf16_t* Kg, const bf16_t* Vtg, const bf16x8 (&qf)[2][2], const unsigned long long (&selm)[2], int tq[2], int bg, int qb, f32x4 (&outacc)[2][4], const float (&gate)[2]) {
    const int lane = F.lane, tid = F.tid, fr = lane & 15, fq = lane >> 4;
    LAS unsigned char* L = F.lds;
    const int j0 = (MODE == 0) ? 0 : (qb - 8 > 0 ? qb - 8 : 0), j1 = qb;
    f32x4 O[2][4]; float mrun[2], lrun[2];
#pragma unroll
    for (int i = 0; i < 2; ++i) { mrun[i] = -INFINITY; lrun[i] = 0.f;
#pragma unroll
        for (int dt = 0; dt < 4; ++dt) O[i][dt] = (f32x4){0.f, 0.f, 0.f, 0.f}; }
    const int wv_ = F.wave;
#define SA_ISSUE(jt_) do { LAS unsigned char* slot_ = L + (((jt_) - j0) % SA_NS) * SA_BUF; \
        _Pragma("unroll") for (int i_ = 0; i_ < 2; ++i_) { const int pc_ = 2 * wv_ + i_, P_ = pc_ & 7; const int row_ = 8 * P_ + (lane >> 3), c16_ = (lane & 7) ^ ((row_ >> 1) & 7); \
            const bf16_t* src_ = (pc_ < 8) ? Kg + ((size_t)bg * SEQ + (size_t)(jt_) * 64) * 64 + row_ * 64 + c16_ * 8 : Vtg + ((size_t)bg * 64 + (jt_)) * 4096 + row_ * 64 + c16_ * 8; \
            __builtin_amdgcn_global_load_lds((const unsigned*)src_, (LAS unsigned*)(slot_ + (pc_ < 8 ? SA_K : SA_V) + P_ * 1024), 16, 0, 0); } } while (0)
    __syncthreads();
#pragma unroll 1
    for (int d_ = 0; d_ < 2 * SA_GB; ++d_) if (j0 + d_ <= j1) SA_ISSUE(j0 + d_);
    if (j0 + 2 * SA_GB - 1 <= j1) asm volatile("s_waitcnt vmcnt(8)" ::: "memory");
    else asm volatile("s_waitcnt vmcnt(0)" ::: "memory");
    SA_BAR();
#pragma unroll 1
    for (int jg = j0; jg <= j1; jg += SA_GB) {
#pragma unroll 1
      for (int j = jg; j < jg + SA_GB && j <= j1; ++j) {
        LAS unsigned char* Lb = L + ((j - j0) % SA_NS) * SA_BUF;
        const bool edge = (j == j1) || (MODE == 1 && j == qb - 8);
#pragma unroll
        for (int i = 0; i < 2; ++i) {
            const int t = tq[i];
            bool colok;
            if (MODE == 0) colok = (selm[i] >> j) & 1ull; else colok = true;
            if (__ballot(colok) == 0ull) continue;
            f32x4 s[4];
#pragma unroll
            for (int kt = 0; kt < 4; ++kt) { s[kt] = (f32x4){0.f, 0.f, 0.f, 0.f};
                const int key_ = 16 * kt + fr, sw_ = (key_ >> 1) & 7;
                const bf16x8 k0 = *(const LAS bf16x8*)(Lb + SA_K + key_ * 128 + ((fq ^ sw_) * 16)), k1 = *(const LAS bf16x8*)(Lb + SA_K + key_ * 128 + (((4 + fq) ^ sw_) * 16));
                s[kt] = MFMA16(k0, qf[i][0], s[kt]); s[kt] = MFMA16(k1, qf[i][1], s[kt]); }
            constexpr float SC = 0.125f * 1.4426950408889634f;
            float mx = -INFINITY;
            if (edge) {
#pragma unroll
                for (int kt = 0; kt < 4; ++kt)
#pragma unroll
                    for (int r = 0; r < 4; ++r) { const int kpos = 64 * j + 16 * kt + 4 * fq + r; bool vis = (kpos <= t); if (MODE == 1) vis = vis && (kpos > t - WINDOW);
                        s[kt][r] = vis ? s[kt][r] : -INFINITY; mx = fmaxf(mx, s[kt][r]); }
            } else {
#pragma unroll
                for (int kt = 0; kt < 4; ++kt) mx = fmaxf(fmaxf(mx, fmaxf(s[kt][0], s[kt][1])), fmaxf(s[kt][2], s[kt][3]));
            }
            mx = colok ? mx * SC : -INFINITY;
            mx = fmaxf(mx, __shfl_xor(mx, 16)); mx = fmaxf(mx, __shfl_xor(mx, 32));
            const float mnew = fmaxf(mrun[i], mx);
            const float alpha = (mrun[i] == -INFINITY) ? 0.f : __builtin_amdgcn_exp2f(mrun[i] - mnew);
            const float msub = (colok && mnew != -INFINITY) ? mnew : INFINITY;
            mrun[i] = mnew;
            float p[16]; float psum = 0.f;
#pragma unroll
            for (int kt = 0; kt < 4; ++kt)
#pragma unroll
                for (int r = 0; r < 4; ++r) { const float e = __builtin_amdgcn_exp2f(__builtin_fmaf(s[kt][r], SC, -msub)); p[4 * kt + r] = e; psum += e; }
            lrun[i] = lrun[i] * alpha + psum;
#pragma unroll
            for (int dt = 0; dt < 4; ++dt) O[i][dt] = O[i][dt] * alpha;
#pragma unroll
            for (int ks = 0; ks < 2; ++ks) { u32x4 pw; pw.x = pk2(p[8 * ks], p[8 * ks + 1]); pw.y = pk2(p[8 * ks + 2], p[8 * ks + 3]); pw.z = pk2(p[8 * ks + 4], p[8 * ks + 5]); pw.w = pk2(p[8 * ks + 6], p[8 * ks + 7]);
                const bf16x8 pb = __builtin_bit_cast(bf16x8, pw);
#pragma unroll
                for (int dt = 0; dt < 4; ++dt) { const int d_ = 16 * dt + fr, sw_ = (d_ >> 1) & 7, c_ = 4 * ks + (fq >> 1);
                    const u32x2 v0 = *(const LAS u32x2*)(Lb + SA_V + d_ * 128 + ((c_ ^ sw_) * 16) + 8 * (fq & 1)), v1 = *(const LAS u32x2*)(Lb + SA_V + d_ * 128 + (((c_ + 2) ^ sw_) * 16) + 8 * (fq & 1));
                    u32x4 vw; vw.x = v0.x; vw.y = v0.y; vw.z = v1.x; vw.w = v1.y; O[i][dt] = MFMA16(__builtin_bit_cast(bf16x8, vw), pb, O[i][dt]); } }
        }
      }
      asm volatile("s_waitcnt vmcnt(0)" ::: "memory");
      SA_BAR();
#pragma unroll 1
      for (int d_ = 0; d_ < SA_GB; ++d_) if (jg + 2 * SA_GB + d_ <= j1) SA_ISSUE(jg + 2 * SA_GB + d_);
    }
#undef SA_ISSUE
#pragma unroll
    for (int i = 0; i < 2; ++i) { float l = lrun[i]; l += __shfl_xor(l, 16); l += __shfl_xor(l, 32); const float sc = gate[i] * frcp(fmaxf(l, 1e-30f));
#pragma unroll
        for (int dt = 0; dt < 4; ++dt) outacc[i][dt] += O[i][dt] * sc; }
}
__device__ __forceinline__ void nsa_attn_phase(const Frame& F, const Args& a, bool do_store = true) {
    const bf16_t* F1 = (const bf16_t*)(F.ws + WS_BIG); const bf16_t* QR = (const bf16_t*)(F.ws + WS_BIG + B1_QR);
    const bf16_t* KS = (const bf16_t*)(F.ws + WS_BIG + B1_KS); const bf16_t* VST = (const bf16_t*)(F.ws + WS_BIG + B1_VST); const bf16_t* KW = (const bf16_t*)(F.ws + WS_BIG + B1_KW); const bf16_t* VWT = (const bf16_t*)(F.ws + WS_BIG + B1_VWT);
    const unsigned long long* SEL = (const unsigned long long*)((unsigned char*)a.out + R2_SEL); bf16_t* ONSA = (bf16_t*)(F.ws + WS_XN);
    const int lane = F.lane, wave = F.wave, fr = lane & 15, fq = lane >> 4;
    for (int c = F.bid; c < 256; c += F.G) {
        const int bg = c & 15, kq = c >> 4, b = bg >> 1, g = bg & 1;
#pragma unroll 1
        for (int rep = 0; rep < 8; ++rep) {
            const int hb = 16 * rep + ((rep & 1) ? 15 - kq : kq);
            const int qb = hb >> 1;
            int tq[2]; bf16x8 qf[2][2]; unsigned long long selm[2]; float gs[2], gw_[2]; f32x4 outacc[2][4]; size_t mrow[2]; int Hh;
            Hh = g * 8 + (fr & 7);
#pragma unroll
            for (int i = 0; i < 2; ++i) { tq[i] = 32 * hb + 4 * wave + 2 * i + (fr >> 3); mrow[i] = (size_t)b * SEQ + tq[i];
                qf[i][0] = *(const bf16x8*)(QR + mrow[i] * 1024 + Hh * 64 + 8 * fq); qf[i][1] = *(const bf16x8*)(QR + mrow[i] * 1024 + Hh * 64 + 32 + 8 * fq);
                selm[i] = SEL[(size_t)bg * SEQ + tq[i]];
                gs[i] = sigmoidf_(bf2f(F1[mrow[i] * F1_LD + 1792 + Hh * 3 + 1])); gw_[i] = sigmoidf_(bf2f(F1[mrow[i] * F1_LD + 1792 + Hh * 3 + 2]));
#pragma unroll
                for (int dt = 0; dt < 4; ++dt) outacc[i][dt] = (f32x4){0.f, 0.f, 0.f, 0.f}; }
            nsa_attn_pass<0>(F, KS, VST, qf, selm, tq, bg, qb, outacc, gs);
            nsa_attn_pass<1>(F, KW, VWT, qf, selm, tq, bg, qb, outacc, gw_);
            if (do_store)
#pragma unroll
            for (int i = 0; i < 2; ++i)
#pragma unroll
                for (int dt = 0; dt < 4; ++dt) { bf16_t* p = ONSA + mrow[i] * 1024 + Hh * 64 + 16 * dt + 4 * fq; const u32x2 old = *(const u32x2*)p;
                    u32x2 w; w.x = pk2(bflo(old.x) + outacc[i][dt][0], bfhi(old.x) + outacc[i][dt][1]); w.y = pk2(bflo(old.y) + outacc[i][dt][2], bfhi(old.y) + outacc[i][dt][3]); *(u32x2*)p = w; }
        }
    }
}
__device__ __forceinline__ void chk_gdn(const Frame& F, const Args& a, int b, int h, int ntok, unsigned* cnt) {
    const bf16_t* F0 = (const bf16_t*)(F.ws + WS_BIG); const bf16_t* OAB = (const bf16_t*)(F.ws + WS_XN);
    LAS float* S = (LAS float*)F.lds;
    LAS float* qkv = S + 16384;
    LAS float* kS = qkv + 384;
    LAS float* ov = kS + 128;
    const int tid = F.tid; const float* convw = a.in[IN_GCONV];

#pragma unroll 1
for (int i = tid; i < 16384; i += NTHREADS) S[i] = 0.f;
    __syncthreads();
    unsigned bad = 0;

#pragma unroll 1
for (int t = 0; t < ntok; ++t) {
        const size_t m = (size_t)b * SEQ + t;
        if (tid < 384) { const int X = tid >> 7, c = tid & 127, col = X * 512 + h * 128 + c; float acc = 0.f;

#pragma unroll 1
for (int i = 0; i < 4; ++i) if (t - 3 + i >= 0) acc += convw[i * 1536 + col] * bf2f(F0[(m - 3 + i) * F0_LD + col]);
            qkv[tid] = acc / (1.f + expf(-acc)); }
        __syncthreads();
        float sq = 0.f, sk = 0.f;
#pragma unroll 1
for (int i = 0; i < 128; ++i) { sq += qkv[i] * qkv[i]; sk += qkv[128 + i] * qkv[128 + i]; }
        const float rq = 1.f / sqrtf(sq + 1e-6f) / sqrtf(128.f), rk = 1.f / sqrtf(sk + 1e-6f);
        const float beta = 1.f / (1.f + expf(-bf2f(F0[m * F0_LD + F0_BA + h])));
        const float aa = bf2f(F0[m * F0_LD + F0_BA + 4 + h]) + a.in[IN_GDT][h];
        const float g = -expf(a.in[IN_GALOG][h]) * (aa > 20.f ? aa : log1pf(expf(aa))); const float eg = expf(g);
        if (tid < 128) { float s = 0.f;
#pragma unroll 1
for (int i = 0; i < 128; ++i) s += qkv[128 + i] * rk * S[i * 128 + tid]; kS[tid] = s; }
        __syncthreads();

#pragma unroll 1
for (int e = tid; e < 16384; e += NTHREADS) { const int i = e >> 7, j = e & 127; const float ki = qkv[128 + i] * rk;
            S[e] = eg * (S[e] - beta * ki * kS[j]) + beta * ki * qkv[256 + j]; }
        __syncthreads();
        if (tid < 128) { float s = 0.f;
#pragma unroll 1
for (int i = 0; i < 128; ++i) s += qkv[i] * rq * S[i * 128 + tid]; ov[tid] = s; }
        __syncthreads();
        if (tid < 128) { float ss = 0.f;
#pragma unroll 1
for (int i = 0; i < 128; ++i) ss += ov[i] * ov[i];
            const float rstd = 1.f / sqrtf(ss / 128.f + NORM_EPS); const float z = bf2f(F0[m * F0_LD + 1536 + h * 128 + tid]);
            const float ref = ov[tid] * rstd * a.in[IN_GNORM][tid] * (z / (1.f + expf(-z))); const float got = bf2f(OAB[m * 1024 + h * 128 + tid]);
            if (!(fabsf(got - ref) <= 0.04f + 0.04f * fabsf(ref))) bad++; }
        __syncthreads();
    }
    if (bad) atomicAdd(cnt, bad);
}
__device__ __forceinline__ void chk_rwkv(const Frame& F, const Args& a, int b, int h, int ntok, unsigned* cnt) {
    const bf16_t* F0 = (const bf16_t*)(F.ws + WS_BIG); const bf16_t* OAB = (const bf16_t*)(F.ws + WS_XN);
    LAS float* S = (LAS float*)F.lds;
    LAS float* xs = S + 4096;
    LAS float* op = xs + 448;
    const int tid = F.tid; unsigned bad = 0;

#pragma unroll 1
for (int i = tid; i < 4096; i += NTHREADS) S[i] = 0.f;
    __syncthreads();

#pragma unroll 1
for (int t = 0; t < ntok; ++t) {
        const size_t m = (size_t)b * SEQ + t;
        if (tid < 448) { int mi; if (tid < 192) mi = (tid >> 6) * 512 + h * 64 + (tid & 63); else mi = 1536 + (tid - 192);
            const float f = bf2f(F0[m * F0_LD + F0_RWKV + mi]); const float fp = t > 0 ? bf2f(F0[(m - 1) * F0_LD + F0_RWKV + mi]) : 0.f;
            xs[tid] = f + (fp - f) * a.in[IN_RMU][mi]; }
        __syncthreads();
        if (tid < 64) { const int hc = h * 64 + tid; float lw = a.in[IN_RW0][hc], la = a.in[IN_RA0][hc], gg = 0.f;

#pragma unroll 1
for (int j = 0; j < 64; ++j) { lw += tanhf(xs[192 + j]) * a.in[IN_RW2][j * 512 + hc]; la += xs[256 + j] * a.in[IN_RA2][j * 512 + hc]; }

#pragma unroll 1
for (int j = 0; j < 128; ++j) gg += (1.f / (1.f + expf(-xs[320 + j]))) * a.in[IN_RG2][j * 512 + hc];
            const float sp = (-lw > 20.f) ? -lw : log1pf(expf(-lw)); const float wlog = -sp - 0.5f;
            const float av = 1.f / (1.f + expf(-la));
            op[tid] = expf(-expf(wlog)); op[64 + tid] = xs[64 + tid] * a.in[IN_RKK][hc]; op[256 + tid] = av;
            op[192 + tid] = xs[64 + tid] * (1.f + (av - 1.f) * a.in[IN_RKA][hc]); op[320 + tid] = gg; }
        __syncthreads();
        float ss = 0.f;
#pragma unroll 1
for (int i = 0; i < 64; ++i) ss += op[64 + i] * op[64 + i];
        const float rinv = 1.f / sqrtf(ss + 1e-6f);
        float bon = 0.f;
#pragma unroll 1
for (int i = 0; i < 64; ++i) bon += xs[i] * op[192 + i] * a.in[IN_RRK][h * 64 + i];
        if (tid < 64) { float sa = 0.f;
#pragma unroll 1
for (int k = 0; k < 64; ++k) sa -= S[tid * 64 + k] * op[64 + k] * rinv;
            float y = 0.f; const float vv = xs[128 + tid];

#pragma unroll 1
for (int k = 0; k < 64; ++k) { const float kk = op[64 + k] * rinv; const float sn = S[tid * 64 + k] * op[k] + sa * kk * op[256 + k] + vv * op[192 + k]; S[tid * 64 + k] = sn; y += sn * xs[k]; }
            op[384 + tid] = y; }
        __syncthreads();
        if (tid < 64) { float mean = 0.f;
#pragma unroll 1
for (int i = 0; i < 64; ++i) mean += op[384 + i]; mean /= 64.f; float var = 0.f;
#pragma unroll 1
for (int i = 0; i < 64; ++i) { const float d = op[384 + i] - mean; var += d * d; } var /= 64.f;
            const int hc = h * 64 + tid;
            const float yn = (op[384 + tid] - mean) / sqrtf(var + RWKV_LN_EPS) * a.in[IN_RLNW][hc] + a.in[IN_RLNB][hc];
            const float ref = (yn + bon * xs[128 + tid]) * op[320 + tid]; const float got = bf2f(OAB[m * 1024 + 512 + hc]);
            if (!(fabsf(got - ref) <= 0.04f + 0.04f * fabsf(ref))) bad++; }
        __syncthreads();
    }
    if (bad) atomicAdd(cnt, bad);
}

__device__ __forceinline__ float chk_rope_val(const bf16_t* row, int base, int d, float posf) {
    if (d >= 16) return bf2f(row[base + d]);
    const int i = d & 7; const float ang = posf * ROPE_INVF[i]; const float cs = cosf(ang), sn = sinf(ang);
    const float x1 = bf2f(row[base + i]), x2 = bf2f(row[base + 8 + i]);
    return d < 8 ? x1 * cs - x2 * sn : x2 * cs + x1 * sn;
}
__device__ __forceinline__ void chk_nsa(const Frame& F, const Args& a, int b, int g, int t, unsigned* cnt) {
    const bf16_t* F1 = (const bf16_t*)(F.ws + WS_BIG); const bf16_t* ONSA = (const bf16_t*)(F.ws + WS_XN);
    const int* pos = (const int*)a.in[IN_POS];
    LAS float* kc = (LAS float*)F.lds;
    LAS float* vc = kc + 8192;
    LAS float* hb = vc + 8192;
    LAS float* sb = hb + 512;
    LAS float* red = sb + 4096;
    LAS float* qv = red + 512;
    LAS float* impv = qv + 64;
    LAS float* ocv = impv + 64;
    LAS float* misc = ocv + 512;
    LAS unsigned* selw = (LAS unsigned*)(misc + 8);
    const int tid = F.tid; const size_t mb = (size_t)b * SEQ; const size_t m = mb + t;
    const int nk = t >= 31 ? (t - 31) / 16 + 1 : 0;
    unsigned bad = 0;
#pragma unroll 1
    for (int i = 0; i < nk; ++i) {
        { const int path = tid >> 8, hid = tid & 255; const float* w1 = a.in[path ? IN_NW1V : IN_NW1K]; const float* pe = a.in[path ? IN_NPEV : IN_NPEK]; float acc = 0.f;
#pragma unroll 1
          for (int sl = 0; sl < 32; ++sl) { const bf16_t* row = F1 + (mb + 16 * i + sl) * F1_LD + 1024 + path * 128 + g * 64;
#pragma unroll 1
              for (int d = 0; d < 64; ++d) acc += (bf2f(row[d]) + pe[sl * 64 + d]) * w1[(size_t)(sl * 64 + d) * 256 + hid]; }
          hb[tid] = acc / (1.f + expf(-acc)); }
        __syncthreads();
        if (tid < 128) { const int path = tid >> 6, d = tid & 63; const float* w2 = a.in[path ? IN_NW2V : IN_NW2K]; float acc = 0.f;
#pragma unroll 1
            for (int hid = 0; hid < 256; ++hid) acc += hb[path * 256 + hid] * w2[hid * 64 + d];
            (path ? vc : kc)[i * 64 + d] = acc; }
        __syncthreads();
    }
    if (tid < nk * 8) { const int i = tid >> 3, dd = tid & 7; const float ang = (float)pos[mb + 31 + 16 * i] * ROPE_INVF[dd]; const float cs = cosf(ang), sn = sinf(ang);
        const float x1 = kc[i * 64 + dd], x2 = kc[i * 64 + 8 + dd]; kc[i * 64 + dd] = x1 * cs - x2 * sn; kc[i * 64 + 8 + dd] = x2 * cs + x1 * sn; }
    if (tid < 64) impv[tid] = 0.f;
    __syncthreads();
    const float posq = (float)pos[m];
#pragma unroll 1
    for (int hh = 0; hh < 8; ++hh) { const int H = g * 8 + hh;
        if (tid < 64) qv[tid] = chk_rope_val(F1 + m * F1_LD, H * 64, tid, posq) * 0.125f;
        __syncthreads();
        if (tid < nk) { float s = 0.f;
#pragma unroll 1
            for (int d = 0; d < 64; ++d) s += qv[d] * kc[tid * 64 + d]; sb[tid] = s; }
        __syncthreads();
        if (tid == 0) { float mx = -INFINITY;
#pragma unroll 1
            for (int i = 0; i < nk; ++i) mx = fmaxf(mx, sb[i]); float sum = 0.f;
#pragma unroll 1
            for (int i = 0; i < nk; ++i) sum += expf(sb[i] - mx); misc[0] = mx; misc[1] = fmaxf(sum, 1e-30f); }
        __syncthreads();
        if (tid < nk) sb[tid] = expf(sb[tid] - misc[0]) / misc[1];
        __syncthreads();
        if (tid < 64) { float o = 0.f;
#pragma unroll 1
            for (int i = 0; i < nk; ++i) o += sb[i] * vc[i * 64 + tid]; ocv[hh * 64 + tid] = o;
            float im = 0.f;
#pragma unroll 1
            for (int i = 4 * tid - 1; i <= 4 * tid + 3; ++i) if (i >= 0 && i < nk) im += sb[i] * ((i == 4 * tid - 1 || i == 4 * tid + 3) ? 0.5f : 1.f);
            impv[tid] += im; }
        __syncthreads();
    }
    if (tid == 0) { const int cur = t >> 6; unsigned lo = 0u, hi = 0u;
#pragma unroll 1
        for (int r = 0; r < 16; ++r) { int best = -1; float bv = 0.f;
#pragma unroll 1
            for (int j = 0; j < 64; ++j) { const bool taken = j < 32 ? ((lo >> j) & 1u) : ((hi >> (j - 32)) & 1u); if (taken) continue;
                const bool valid = j <= cur, forced = (j == 0) || (j == cur) || (j == cur - 1);
                const float sc = valid ? (forced ? INFINITY : impv[j]) : -INFINITY;
                if (best < 0 || sc > bv) { best = j; bv = sc; } }
            if (best < 32) lo |= 1u << best; else hi |= 1u << (best - 32); }
        selw[0] = lo; selw[1] = hi; }
    __syncthreads();
#pragma unroll 1
    for (int hh = 0; hh < 8; ++hh) { const int H = g * 8 + hh;
        if (tid < 64) qv[tid] = chk_rope_val(F1 + m * F1_LD, H * 64, tid, posq) * 0.125f;
        __syncthreads();
        float osw[2] = {0.f, 0.f};
#pragma unroll 1
        for (int br = 0; br < 2; ++br) {
            const int kbase = 1024 + (br == 0 ? 2 : 4) * 128 + g * 64, vbase = kbase + 128;
            float lmx = -INFINITY;
#pragma unroll 1
            for (int kp = tid; kp < 4096; kp += NTHREADS) { float s = -INFINITY; const int j = kp >> 6;
                bool vis = kp <= t; if (br == 0) vis = vis && (j < 32 ? ((selw[0] >> j) & 1u) : ((selw[1] >> (j - 32)) & 1u)); else vis = vis && (kp > t - WINDOW);
                if (vis) { s = 0.f; const float pk = (float)pos[mb + kp];
#pragma unroll 1
                    for (int d = 0; d < 64; ++d) s += qv[d] * chk_rope_val(F1 + (mb + kp) * F1_LD, kbase, d, pk); }
                sb[kp] = s; lmx = fmaxf(lmx, s); }
            red[tid] = lmx; __syncthreads();
            if (tid == 0) { float mx = -INFINITY;
#pragma unroll 1
                for (int i = 0; i < NTHREADS; ++i) mx = fmaxf(mx, red[i]); misc[0] = mx; }
            __syncthreads();
            float ls = 0.f;
#pragma unroll 1
            for (int kp = tid; kp < 4096; kp += NTHREADS) { const float e = (sb[kp] == -INFINITY) ? 0.f : expf(sb[kp] - misc[0]); sb[kp] = e; ls += e; }
            red[tid] = ls; __syncthreads();
            if (tid == 0) { float sm = 0.f;
#pragma unroll 1
                for (int i = 0; i < NTHREADS; ++i) sm += red[i]; misc[1] = fmaxf(sm, 1e-30f); }
            __syncthreads();
            if (tid < 64) { float o = 0.f;
#pragma unroll 1
                for (int kp = 0; kp <= t; ++kp) if (sb[kp] != 0.f) o += sb[kp] * bf2f(F1[(mb + kp) * F1_LD + vbase + tid]); osw[br] = o / misc[1]; }
            __syncthreads();
        }
        if (tid < 64) { const float g0 = 1.f / (1.f + expf(-bf2f(F1[m * F1_LD + 1792 + H * 3 + 0]))), g1 = 1.f / (1.f + expf(-bf2f(F1[m * F1_LD + 1792 + H * 3 + 1]))), g2 = 1.f / (1.f + expf(-bf2f(F1[m * F1_LD + 1792 + H * 3 + 2])));
            const float ref = g0 * ocv[hh * 64 + tid] + g1 * osw[0] + g2 * osw[1]; const float got = bf2f(ONSA[m * 1024 + H * 64 + tid]);
            if (!(fabsf(got - ref) <= 0.004f + 0.05f * fabsf(ref))) bad++; }
        __syncthreads();
    }
    if (bad) atomicAdd(cnt, bad);
}
__global__ void __launch_bounds__(NTHREADS, 2) mk_fwd(Args args) {
    extern __shared__ __attribute__((aligned(16))) unsigned char lds[];
    cg::grid_group grid = cg::this_grid();
    Frame F; F.lds = (LAS unsigned char*)lds; F.tid = threadIdx.x; F.lane = F.tid & 63; F.wave = __builtin_amdgcn_readfirstlane(F.tid >> 6);
    F.G = gridDim.x; F.bid = blockIdx.x; F.ws = args.ws; F.ctl = (unsigned*)(args.ws + WS_CTL);
    unsigned char* ws = args.ws;
    if (F.tid < 16) ((LAS unsigned*)(F.lds + XB_LDS_OFF))[F.tid] = 0u;
    __syncthreads();
    XcdBarrier xbar = xcd_barrier_post(F.ctl + CW_BAR, (volatile LAS unsigned*)(F.lds + XB_LDS_OFF));
    const bool big = F.G >= 192;
    p0_prologue(fresh(F), args, big);
    rwkvc_build_images(fresh(F), args);
    if (!big) p0_layer1_weights(fresh(F), args, 0, 0, -1);
    grid.sync();
    enum { K_GEMM = 0, K_GDNPREP, K_RPREP_UNUSED, K_SCAN, K_ROW, K_NSAPREP, K_CMP2, K_CMPATTN, K_ATTN };
    constexpr int NPH = 27;
#ifdef PROBE_TIME_KIND
    unsigned long long tacc_ = 0;
#endif
#pragma unroll 1
    for (int ph = 1; ph <= NPH; ++ph) {
#ifdef PROBE_TIME_KIND
        const unsigned long long tst_ = __builtin_amdgcn_s_memrealtime();
#endif
        int kind, sub = 0;
        if (ph == 1) { kind = K_GEMM; sub = 0; }
        else if (ph == 2) kind = K_GDNPREP;
        else if (ph <= 11) { kind = K_SCAN; sub = ph - 4; }
        else if (ph == 12) { kind = K_GEMM; sub = 1; }
        else if (ph == 13) { kind = K_ROW; sub = 0; }
        else if (ph == 14) { kind = K_GEMM; sub = 2; }
        else if (ph == 15) { kind = K_GEMM; sub = 3; }
        else if (ph == 16) { kind = K_ROW; sub = 1; }
        else if (ph == 17) { kind = K_GEMM; sub = 4; }
        else if (ph == 18) kind = K_NSAPREP;
        else if (ph == 19) { kind = K_GEMM; sub = 5; }
        else if (ph == 20) kind = K_CMP2;
        else if (ph == 21) kind = K_CMPATTN;
        else if (ph == 22) kind = K_ATTN;
        else if (ph == 23) { kind = K_GEMM; sub = 7; }
        else if (ph == 24) { kind = K_ROW; sub = 2; }
        else if (ph == 25) { kind = K_GEMM; sub = 8; }
        else if (ph == 26) { kind = K_GEMM; sub = 9; }
        else { kind = K_ROW; sub = 3; }
        kind = __builtin_amdgcn_readfirstlane(kind); sub = __builtin_amdgcn_readfirstlane(sub);
        if (kind == K_GEMM) {
            const int ng = (sub == 5) ? 2 : 1;
#pragma unroll 1
            for (int gi = 0; gi < ng; ++gi) {
                const int gx = sub + gi;
                const size_t offA = (gx == 3 || gx == 9) ? WS_BIG : gx == 5 ? WS_BIG + B1_ACMPK : gx == 6 ? WS_BIG + B1_ACMPV : WS_XN;
                const size_t offB = gx == 0 ? WS_W_IN0 : gx == 1 ? WS_W_OUT0 : gx == 2 ? WS_W_UP0 : gx == 3 ? WS_W_DN0 : gx == 4 ? WS_W_IN1 : gx == 5 ? WS_W_C1K : gx == 6 ? WS_W_C1V : gx == 7 ? WS_W_OUT1 : gx == 8 ? WS_W_UP1 : WS_W_DN1;
                unsigned char* Op = (gx == 5) ? (unsigned char*)args.out + R2_HCMP : (gx == 6) ? (unsigned char*)args.out + R2_HCMP + (size_t)4096 * 256 * 2 : (gx == 3 || gx == 9) ? ws + WS_XN : ws + WS_BIG;
                const int Mr = (gx == 5 || gx == 6) ? 4096 : MTOK;
                const int Nn = (gx == 0 || gx == 2 || gx == 8) ? 4096 : (gx == 4) ? 2048 : (gx == 5 || gx == 6) ? 256 : 1024;
                const int Kk = (gx == 3 || gx == 9) ? 4096 : (gx == 5 || gx == 6) ? 2048 : 1024;
                const int ldo = (gx == 0) ? F0_LD : (gx == 4) ? F1_LD : Nn;
                const int act = (gx == 2 || gx == 8) ? 2 : (gx == 5 || gx == 6) ? 3 : 0;
                const int cshift = (gx == 6) ? 128 : 0;
                pg8::Gemm g_{(const bf16_t*)(ws + offA), (const bf16_t*)(ws + offB), Mr, Nn, Kk};
                pg8::StaticOrder S_; S_.init(Mr, Nn, F.G, (F.bid + cshift) % F.G);
                pg8::EpiBf16R E_{(bf16_t*)Op, ldo, act};
                pg8::gemm_phase<pg8::EpiBf16R, pg8::StaticOrder, true, true>(F.lds, g_, S_, E_);
            }
        } else if (kind == K_GDNPREP) {
            gdn_prep_phase(fresh(F), args);
        } else if (kind == K_SCAN) {
            const int sg = sub;
            if (sg >= 0) {
                for (int u = F.bid; u < 96; u += F.G) {
                    if (u < 64) rwkvc_chain_unit(fresh(F), args, u, sg); else gdn_scan_unit(fresh(F), args, u - 64, 8 * sg, 8 * sg + 8);
                    __syncthreads(); }
            }
            const bool split = big && sg >= 0;
            const int pb0 = split ? 96 : 0, pnb = split ? F.G - 96 : F.G;
            if (sg < 7 && F.bid >= pb0) rwkvc_prep_phase(fresh(F), args, sg + 1, pb0, pnb);
            if (big && sg >= 0) {
                const int c0 = (448 - F.G) > 96 ? (448 - F.G) : 96;
                if (sg < 6) { if (F.bid >= c0) p0_layer1_weights(fresh(F), args, c0, F.G - c0, sg); }
                else if (sg == 7 && F.bid >= 96) { p0_layer0_rest(fresh(F), args, 96, F.G - 96, 0); p0_layer0_rest(fresh(F), args, 96, F.G - 96, 1); p0_layer0_rest(fresh(F), args, 96, F.G - 96, 2); }
            }
        } else if (kind == K_ROW) {
            if (sub == 0) row_pass<false, true>(fresh(F), (const bf16_t*)(ws + WS_BIG), args.in[IN_X], args.in[IN_NMPOST], ws + WS_R2, args.in[IN_NFPRE], (bf16_t*)(ws + WS_XN));
            else if (sub == 3) row_pass<true, false>(fresh(F), (const bf16_t*)(ws + WS_XN), ws + WS_R2, args.in[IN_NFPOST] + 1024, args.out, nullptr, nullptr);
            else row_pass<true, true>(fresh(F), (const bf16_t*)(ws + (sub == 1 ? WS_XN : WS_BIG)), ws + WS_R2, sub == 1 ? args.in[IN_NFPOST] : args.in[IN_NMPOST] + 1024, ws + WS_R2,
                                      sub == 1 ? args.in[IN_NMPRE] + 1024 : args.in[IN_NFPRE] + 1024, (bf16_t*)(ws + WS_XN));
        } else if (kind == K_NSAPREP) {
            nsa_prep_phase(fresh(F), args);
        } else if (kind == K_CMP2) {
            nsa_cmp2_phase(fresh(F), args);
        } else if (kind == K_CMPATTN) {
            nsa_cmp_attn_phase(fresh(F), args);
        } else {
            nsa_attn_phase(fresh(F), args);
        }
        if (ph != NPH) xcd_barrier(xbar);
#ifdef PROBE_TIME_KIND
        if ((PROBE_TIME_KIND < 100 && kind == PROBE_TIME_KIND) || (PROBE_TIME_KIND >= 100 && ph == PROBE_TIME_KIND - 100)) tacc_ += __builtin_amdgcn_s_memrealtime() - tst_;
#endif
    }
#ifdef PROBE_TIME_KIND
    if (F.bid == 0) { const unsigned long long tgt_ = __builtin_amdgcn_s_memrealtime() + 4ull * tacc_; while (__builtin_amdgcn_s_memrealtime() < tgt_) __builtin_amdgcn_s_sleep(20); }
#endif
}
extern "C" void kernel_launch(void* const* d_in, const int* in_sizes, int n_in, void* d_out, int out_size, void* d_ws, size_t ws_size, hipStream_t stream) {
    static int grid = 0;
    if (grid == 0) {
        if (n_in != 33 || out_size != MTOK * D_MODEL || ws_size < WS_END) { fprintf(stderr, "kernel_launch: unexpected problem (n_in %d out %d ws %zu)\n", n_in, out_size, ws_size); grid = -1; return; }
        int dev = 0, cus = 0, per_cu = 0;
        (void)hipGetDevice(&dev); (void)hipDeviceGetAttribute(&cus, hipDeviceAttributeMultiprocessorCount, dev);
        (void)hipFuncSetAttribute((const void*)mk_fwd, hipFuncAttributeMaxDynamicSharedMemorySize, LDS_BYTES);
        (void)hipOccupancyMaxActiveBlocksPerMultiprocessor(&per_cu, (const void*)mk_fwd, NTHREADS, LDS_BYTES);
        if (per_cu < 1) { fprintf(stderr, "kernel_launch: occupancy query says %d blocks/CU\n", per_cu); grid = -1; return; }
        grid = cus;
        fprintf(stderr, "kernel_launch: grid %d (cus %d, per_cu %d) ws %zu\n", grid, cus, per_cu, ws_size);
    }
    if (grid < 0) return;
    (void)hipMemsetAsync((char*)d_ws + WS_CTL, 0, 1 * MiB, stream);
    Args a{};
    for (int i = 0; i < 33; ++i) a.in[i] = (const float*)d_in[i];
    a.out = (float*)d_out; a.ws = (unsigned char*)d_ws; a.ph_lo = 0; a.ph_hi = 100;
    void* kargs[] = {&a};
    hipError_t e = hipLaunchCooperativeKernel((void*)mk_fwd, dim3(grid), dim3(NTHREADS), kargs, LDS_BYTES, stream);
    if (e != hipSuccess) fprintf(stderr, "cooperative launch failed: %s (grid %d)\n", hipGetErrorString(e), grid);
}
```

```cpp
#include <hip/hip_runtime.h>
#include <hip/hip_cooperative_groups.h>
#include <cstdio>
#include <cstdint>
namespace cg = cooperative_groups;

constexpr int D_MODEL = 1024, BATCH = 8, SEQ = 4096, MTOK = BATCH * SEQ;
constexpr int GDN_HEADS = 4, GDN_DK = 128, GDN_DV = 128, GDN_CHUNK = 64;
constexpr int RWKV_HEADS = 8, RWKV_N = 64;
constexpr int NSA_HEADS = 16, NSA_GROUPS = 2, NSA_HD = 64, CMP_LEN = 32, CMP_STRIDE = 16, CMP_HIDDEN = 256;
constexpr int SEL_BLOCK = 64, SEL_TOPN = 16, WINDOW = 512;
constexpr int D_FF = 4096;
constexpr float NORM_EPS = 1e-6f, RWKV_LN_EPS = 64e-5f;
constexpr int AB_IN_W = 3848, NSA_IN_W = 1840;
constexpr int F0_LD = 4096;
constexpr int F1_LD = 2048;
constexpr int F0_RWKV = 2048, F0_BA = 3840;

typedef unsigned short bf16_t;
typedef short bf16x8 __attribute__((ext_vector_type(8)));
typedef float f32x4 __attribute__((ext_vector_type(4)));
typedef float f32x2 __attribute__((ext_vector_type(2)));
typedef unsigned u32x4 __attribute__((ext_vector_type(4)));
typedef unsigned u32x2 __attribute__((ext_vector_type(2)));
#define LAS __attribute__((address_space(3)))

typedef __bf16 hwbf16x2 __attribute__((ext_vector_type(2)));
__device__ __forceinline__ unsigned pk2(float lo, float hi) { const f32x2 v = {lo, hi}; const hwbf16x2 b = __builtin_convertvector(v, hwbf16x2); return __builtin_bit_cast(unsigned, b); }
__device__ __forceinline__ unsigned f2bf(float f) { return pk2(f, 0.f) & 0xffffu; }
__device__ __forceinline__ float bf2f(bf16_t h) { return __builtin_bit_cast(float, (unsigned)h << 16); }
__device__ __forceinline__ float bflo(unsigned u) { return __builtin_bit_cast(float, u << 16); }
__device__ __forceinline__ float bfhi(unsigned u) { return __builtin_bit_cast(float, u & 0xffff0000u); }
__device__ __forceinline__ float wave_sum(float v) {
#pragma unroll
    for (int o = 1; o < 64; o <<= 1) v += __shfl_xor(v, o);
    return v;
}
__device__ __forceinline__ float frcp(float x) { return __builtin_amdgcn_rcpf(x); }
__device__ __forceinline__ float sigmoidf_(float x) { return frcp(1.f + __expf(-x)); }
__device__ __forceinline__ float siluf_(float x) { return x * frcp(1.f + __expf(-x)); }
__device__ __forceinline__ float softplusf_(float x) { return x > 20.f ? x : log1pf(__expf(x)); }

__device__ __forceinline__ float fast_tanhf(float x) { const float e = __expf(2.f * x); return 1.f - 2.f * frcp(e + 1.f); }
__device__ __forceinline__ float fast_softplusf(float x) { return x > 20.f ? x : __logf(1.f + __expf(x)); }
__device__ __forceinline__ float dpp_f(float v, const int ctrl_sel) {
    const int i = __builtin_bit_cast(int, v);
    int r;
    if (ctrl_sel == 0) r = __builtin_amdgcn_update_dpp(i, i, 0xB1, 0xF, 0xF, false);
    else if (ctrl_sel == 1) r = __builtin_amdgcn_update_dpp(i, i, 0x4E, 0xF, 0xF, false);
    else r = __builtin_amdgcn_update_dpp(i, i, 0x141, 0xF, 0xF, false);
    return __builtin_bit_cast(float, r);
}
__device__ __forceinline__ float red8_dpp(float v) { v += dpp_f(v, 0); v += dpp_f(v, 1); v += dpp_f(v, 2); return v; }
namespace pg8 {
#define PG8_LAS __attribute__((address_space(3)))
constexpr int BM = 256, BK = 64, HALF = 128, HTB = HALF * BK * 2  , STAGE_BYTES = 8 * HTB, NXCD = 8, WGM = 8;

__host__ __device__ __forceinline__ int lds_byte(int r, int c) { const int st = (r >> 4) * 2 + (c >> 5), rr = r & 15, cc = c & 31, ob = rr * 64 + cc * 2; return st * 1024 + (ob ^ (((ob >> 9) & 1) << 5)); }
__host__ __device__ __forceinline__ void stage_rc(int b, int& R, int& C) { const int st = b / 1024, sb = b % 1024, swz = sb ^ (((sb >> 9) & 1) << 5); R = (st >> 1) * 16 + swz / 64; C = (st & 1) * 32 + (swz % 64) / 2; }
__host__ __device__ __forceinline__ int perm32(int rho) { const int n = rho >> 4, i = rho & 15; return 8 * (i >> 2) + 4 * n + (i & 3); }

struct Unit { int pm, pn; };
struct Gemm { const bf16_t* A; const bf16_t* Bt; int M, N, K; };

struct StaticOrder {
    int nM, nN, nwg, G, c;
    __host__ __device__ void init(int M, int N, int G_, int c_) { nM = M / BM; nN = N / BM; nwg = nM * nN; G = G_; c = c_; }
    __host__ __device__ bool next(int i, Unit& u) const {
        const long L = (long)i * G + c; if (L >= nwg) return false;
        int wgid = (int)L; { const int q = nwg / NXCD, r = nwg % NXCD, xcd = wgid % NXCD, off = wgid / NXCD; wgid = (xcd < r ? xcd * (q + 1) : r * (q + 1) + (xcd - r) * q) + off; }
        const int nig = WGM * nN, gid = wgid / nig, fm = gid * WGM, gsz = (nM - fm) < WGM ? (nM - fm) : WGM;
        u.pm = fm + ((wgid % nig) % gsz); u.pn = (wgid % nig) / gsz; return true;
    }
    __device__ __forceinline__ void a_ready(const Unit&) const {}
    __device__ __forceinline__ void done(const Unit&) const {}
};


__device__ __forceinline__ unsigned cvt_pk_bf16(float lo, float hi) { unsigned r; asm volatile("v_cvt_pk_bf16_f32 %0, %1, %2" : "=v"(r) : "v"(lo), "v"(hi)); return r; }
template <int ACT  > struct EpiBf16 {
    static constexpr bool PERM = true, AFTER_DRAIN = false;
    bf16_t* O; int ldc;
    __device__ __forceinline__ void operator()(const f32x4 (&acc)[2][2][4][2], const Unit& u, int wr, int wc, int fr, int fq) const {
        const int row0 = u.pm * BM + wr * 64 + fr; const int col0 = u.pn * BM + wc * 32 + 8 * fq;
#pragma unroll
        for (int ai = 0; ai < 2; ++ai)
#pragma unroll
            for (int m = 0; m < 4; ++m) { bf16_t* rowp = O + (size_t)(row0 + ai * HALF + m * 16) * ldc + col0;
#pragma unroll
                for (int bj = 0; bj < 2; ++bj) { f32x4 v0 = acc[ai][bj][m][0], v1 = acc[ai][bj][m][1];
                    if (ACT == 2) {
#pragma unroll
                        for (int e = 0; e < 4; ++e) { float a = v0[e] > 0.f ? v0[e] : 0.f; v0[e] = a * a; float b = v1[e] > 0.f ? v1[e] : 0.f; v1[e] = b * b; } }
                    if (ACT == 3) {
#pragma unroll
                        for (int e = 0; e < 4; ++e) { v0[e] = v0[e] * __builtin_amdgcn_rcpf(1.f + __expf(-v0[e])); v1[e] = v1[e] * __builtin_amdgcn_rcpf(1.f + __expf(-v1[e])); } }
                    u32x4 w; w.x = cvt_pk_bf16(v0[0], v0[1]); w.y = cvt_pk_bf16(v0[2], v0[3]); w.z = cvt_pk_bf16(v1[0], v1[1]); w.w = cvt_pk_bf16(v1[2], v1[3]);
                    *(u32x4*)(rowp + bj * HALF) = w; } }
    }
};
struct EpiBf16R {
    static constexpr bool PERM = true, AFTER_DRAIN = false;
    bf16_t* O; int ldc; int act;
    __device__ __forceinline__ void operator()(const f32x4 (&acc)[2][2][4][2], const Unit& u, int wr, int wc, int fr, int fq) const {
        if (act == 0) { EpiBf16<0> e{O, ldc}; e(acc, u, wr, wc, fr, fq); }
        else if (act == 2) { EpiBf16<2> e{O, ldc}; e(acc, u, wr, wc, fr, fq); }
        else { EpiBf16<3> e{O, ldc}; e(acc, u, wr, wc, fr, fq); }
    }
};
template <class Epi, class Sched, bool ALIGN_EPI = false, bool SP2 = false>
__device__ __forceinline__ void gemm_phase(PG8_LAS unsigned char* lds, const Gemm g, const Sched& S, const Epi& E) {
    int tid_ = threadIdx.x; asm volatile("" : "+v"(tid_));
    const int tid = tid_, wid = __builtin_amdgcn_readfirstlane(tid >> 6), lane = tid & 63, wr = wid >> 2, wc = wid & 3, fr = lane & 15, fq = lane >> 4;
    const int K = g.K, nt = K / BK;
    unsigned voffA[2], voffB[2];
#pragma unroll
    for (int i = 0; i < 2; ++i) { int R, C; stage_rc(tid * 16 + i * 8192, R, C); const int Rb = Epi::PERM ? ((R & ~31) + perm32(R & 31)) : R;
        voffA[i] = (unsigned)(R * K + C) * 2u; voffB[i] = (unsigned)(Rb * K + C) * 2u; }
    const size_t kstep = (size_t)(BK * 2);
    const size_t hstep = (size_t)HALF * K * 2;
    const size_t tstep = 2 * hstep;
    const unsigned ldsw = (unsigned)wid * 1024u;
    const int aoff = lds_byte(wr * 64 + fr, fq * 8), boff = lds_byte(wc * 32 + fr, fq * 8);
#define PG8_SA(b, h) (((b) * 2 + (h)) * HTB)
#define PG8_SB(b, h) ((4 + (b) * 2 + (h)) * HTB)
#define PG8_STAGE(bufoff, gbase, voff) do { _Pragma("unroll") for (int _i = 0; _i < 2; ++_i) \
        __builtin_amdgcn_global_load_lds((const unsigned*)((const char*)(gbase) + (voff)[_i]), (PG8_LAS unsigned*)(lds + (bufoff) + ldsw + _i * 8192), 16, 0, 0); } while (0)
#define PG8_LDA(dst, b, h) do { _Pragma("unroll") for (int m = 0; m < 4; ++m) _Pragma("unroll") for (int k = 0; k < 2; ++k) dst[m][k] = *(const PG8_LAS bf16x8*)(lds + PG8_SA(b, h) + aoff + m * 2048 + k * 1024); } while (0)
#define PG8_LDB(dst, b, h) do { _Pragma("unroll") for (int n = 0; n < 2; ++n) _Pragma("unroll") for (int k = 0; k < 2; ++k) dst[n][k] = *(const PG8_LAS bf16x8*)(lds + PG8_SB(b, h) + boff + n * 2048 + k * 1024); } while (0)
#define PG8_MMA(ai, bj, At, Bt) do { __builtin_amdgcn_s_setprio(1); _Pragma("unroll") for (int m = 0; m < 4; ++m) _Pragma("unroll") for (int n = 0; n < 2; ++n) _Pragma("unroll") for (int k = 0; k < 2; ++k) \
        acc[ai][bj][m][n] = __builtin_amdgcn_mfma_f32_16x16x32_bf16(Bt[n][k], At[m][k], acc[ai][bj][m][n], 0, 0, 0); __builtin_amdgcn_s_setprio(0); } while (0)
#define PG8_WAIT_V(n) asm volatile("s_waitcnt vmcnt(" #n ")" ::: "memory")
#define PG8_WAIT_L(n) asm volatile("s_waitcnt lgkmcnt(" #n ")" ::: "memory")
#define PG8_BAR __builtin_amdgcn_s_barrier()
#define PG8_SCHED __builtin_amdgcn_sched_barrier(0)
    Unit cur, nxt; int ui = 0;
    if (!S.next(0, cur)) return;
    f32x4 acc[2][2][4][2];
#pragma unroll
    for (int a = 0; a < 2; ++a)
#pragma unroll
        for (int b = 0; b < 2; ++b)
#pragma unroll
            for (int m = 0; m < 4; ++m)
#pragma unroll
                for (int n = 0; n < 2; ++n) acc[a][b][m][n] = (f32x4){0.f, 0.f, 0.f, 0.f};
    bf16x8 At[4][2], B0[2][2], B1[2][2];
    const char* cA = (const char*)g.A + (size_t)cur.pm * tstep; const char* cB = (const char*)g.Bt + (size_t)cur.pn * tstep;
    S.a_ready(cur);
    if constexpr (SP2) {
        PG8_STAGE(PG8_SB(0, 0), cB, voffB); PG8_STAGE(PG8_SB(0, 1), cB + hstep, voffB); PG8_STAGE(PG8_SA(0, 0), cA, voffA); PG8_STAGE(PG8_SA(0, 1), cA + hstep, voffA);
        if (wr == 1) PG8_BAR;
        PG8_WAIT_V(2); PG8_BAR;
        PG8_STAGE(PG8_SB(1, 0), cB + kstep, voffB); PG8_STAGE(PG8_SA(1, 0), cA + kstep, voffA); PG8_STAGE(PG8_SB(1, 1), cB + hstep + kstep, voffB);
        PG8_WAIT_V(6); PG8_BAR;
    } else {
        PG8_STAGE(PG8_SB(0, 0), cB, voffB); PG8_STAGE(PG8_SA(0, 0), cA, voffA); PG8_STAGE(PG8_SB(0, 1), cB + hstep, voffB); PG8_STAGE(PG8_SA(0, 1), cA + hstep, voffA);
        if (wr == 1) PG8_BAR;
        PG8_WAIT_V(4); PG8_BAR;
        PG8_STAGE(PG8_SB(1, 0), cB + kstep, voffB); PG8_STAGE(PG8_SA(1, 0), cA + kstep, voffA); PG8_STAGE(PG8_SB(1, 1), cB + hstep + kstep, voffB);
        PG8_WAIT_V(6); PG8_BAR;
    }
    for (;;) {
        const bool has_next = S.next(ui + 1, nxt);
        const char* nA = has_next ? (const char*)g.A + (size_t)nxt.pm * tstep : cA; const char* nB = has_next ? (const char*)g.Bt + (size_t)nxt.pn * tstep : cB;
        for (int t = 0; t < nt; t += 2) {
            const bool last = (t == nt - 2);
            const char* a1 = cA + (size_t)(t + 1) * kstep;
            const char* a2 = last ? nA : cA + (size_t)(t + 2) * kstep; const char* b2 = last ? nB : cB + (size_t)(t + 2) * kstep;
            const char* a3 = a2 + kstep; const char* b3 = b2 + kstep;
            if (last && has_next) S.a_ready(nxt);
            if constexpr (SP2) {
            PG8_LDB(B0, 0, 0); PG8_LDB(B1, 0, 1); PG8_SCHED; PG8_LDA(At, 0, 0); PG8_STAGE(PG8_SA(1, 1), a1 + hstep, voffA);
            PG8_WAIT_V(8); PG8_WAIT_L(0); PG8_BAR; PG8_MMA(0, 0, At, B0); PG8_MMA(0, 1, At, B1); PG8_BAR; PG8_SCHED;
            PG8_LDA(At, 0, 1); PG8_STAGE(PG8_SB(0, 0), b2, voffB); PG8_STAGE(PG8_SB(0, 1), b2 + hstep, voffB); PG8_STAGE(PG8_SA(0, 0), a2, voffA);
            PG8_WAIT_V(8); PG8_WAIT_L(0); PG8_BAR; PG8_MMA(1, 0, At, B0); PG8_MMA(1, 1, At, B1); PG8_BAR; PG8_SCHED;
            PG8_LDB(B0, 1, 0); PG8_LDB(B1, 1, 1); PG8_SCHED; PG8_LDA(At, 1, 0); PG8_STAGE(PG8_SA(0, 1), a2 + hstep, voffA);
            PG8_WAIT_V(8); PG8_WAIT_L(0); PG8_BAR; PG8_MMA(0, 0, At, B0); PG8_MMA(0, 1, At, B1); PG8_BAR; PG8_SCHED;
            PG8_LDA(At, 1, 1); PG8_STAGE(PG8_SB(1, 0), b3, voffB); PG8_STAGE(PG8_SB(1, 1), b3 + hstep, voffB); PG8_STAGE(PG8_SA(1, 0), a3, voffA);
            PG8_WAIT_V(8); PG8_WAIT_L(0); PG8_BAR; PG8_MMA(1, 0, At, B0); PG8_MMA(1, 1, At, B1); PG8_BAR; PG8_SCHED;
            } else {
            PG8_LDB(B0, 0, 0); PG8_SCHED; PG8_LDA(At, 0, 0); PG8_STAGE(PG8_SA(1, 1), a1 + hstep, voffA);
            PG8_WAIT_L(8); PG8_BAR; PG8_WAIT_L(0); PG8_MMA(0, 0, At, B0); PG8_BAR; PG8_SCHED;
            PG8_LDB(B1, 0, 1); PG8_STAGE(PG8_SB(0, 0), b2, voffB);
            PG8_BAR; PG8_WAIT_L(0); PG8_MMA(0, 1, At, B1); PG8_BAR;
            PG8_LDA(At, 0, 1); PG8_STAGE(PG8_SA(0, 0), a2, voffA);
            PG8_BAR; PG8_WAIT_L(0); PG8_MMA(1, 0, At, B0); PG8_BAR; PG8_SCHED;
            PG8_STAGE(PG8_SB(0, 1), b2 + hstep, voffB);
            PG8_WAIT_V(6); PG8_BAR; PG8_MMA(1, 1, At, B1); PG8_BAR;
            PG8_LDB(B0, 1, 0); PG8_SCHED; PG8_LDA(At, 1, 0); PG8_STAGE(PG8_SA(0, 1), a2 + hstep, voffA);
            PG8_WAIT_L(8); PG8_BAR; PG8_WAIT_L(0); PG8_MMA(0, 0, At, B0); PG8_BAR; PG8_SCHED;
            PG8_LDB(B1, 1, 1); PG8_STAGE(PG8_SB(1, 0), b3, voffB);
            PG8_BAR; PG8_WAIT_L(0); PG8_MMA(0, 1, At, B1); PG8_BAR;
            PG8_LDA(At, 1, 1); PG8_STAGE(PG8_SA(1, 0), a3, voffA);
            PG8_BAR; PG8_WAIT_L(0); PG8_MMA(1, 0, At, B0); PG8_BAR; PG8_SCHED;
            PG8_STAGE(PG8_SB(1, 1), b3 + hstep, voffB);
            PG8_WAIT_V(6); PG8_BAR; PG8_MMA(1, 1, At, B1); PG8_BAR;
            }
        }
        if constexpr (ALIGN_EPI) { if (wr == 0) PG8_BAR; }
        if constexpr (!Epi::AFTER_DRAIN) { E(acc, cur, wr, wc, fr, fq); S.done(cur); }
        if (!has_next) break;
#pragma unroll
        for (int a = 0; a < 2; ++a)
#pragma unroll
            for (int b = 0; b < 2; ++b)
#pragma unroll
                for (int m = 0; m < 4; ++m)
#pragma unroll
                    for (int n = 0; n < 2; ++n) acc[a][b][m][n] = (f32x4){0.f, 0.f, 0.f, 0.f};
        cur = nxt; cA = nA; cB = nB; ++ui;
        if constexpr (ALIGN_EPI) { if (wr == 1) PG8_BAR; }
    }
    PG8_WAIT_V(0);
    if constexpr (!ALIGN_EPI) { if (wr == 0) PG8_BAR; }
    PG8_BAR;
    if constexpr (Epi::AFTER_DRAIN) { E.fused(acc, cur, wr, wc, fr, fq, lds, wid, lane); S.done(cur); }
#undef PG8_SA
#undef PG8_SB
#undef PG8_STAGE
#undef PG8_LDA
#undef PG8_LDB
#undef PG8_MMA
#undef PG8_WAIT_V
#undef PG8_WAIT_L
#undef PG8_BAR
#undef PG8_SCHED
}
}

constexpr size_t MiB = 1u << 20;
constexpr size_t WS_CTL = 0;
constexpr size_t WS_W_IN0 = 1 * MiB, WS_W_OUT0 = 9 * MiB, WS_W_UP0 = 11 * MiB, WS_W_DN0 = 19 * MiB;
constexpr size_t WS_W_IN1 = 27 * MiB, WS_W_OUT1 = 31 * MiB, WS_W_UP1 = 33 * MiB, WS_W_DN1 = 41 * MiB;
constexpr size_t WS_W_C1K = 49 * MiB, WS_W_C1V = 50 * MiB, WS_W_C2K = 51 * MiB, WS_W_C2V = 51 * MiB + 65536;
constexpr size_t WS_XN = 56 * MiB;
constexpr size_t WS_BIG = 120 * MiB;
constexpr size_t WS_R2 = 376 * MiB;
constexpr size_t WS_RSCR2 = 440 * MiB;
constexpr size_t WS_END = 476 * MiB;
constexpr int NWAVES = 8, NTHREADS = 512;
constexpr int LDS_BYTES = 147456;
constexpr int XB_LDS_OFF = LDS_BYTES - 64;
constexpr int CW_BAR = 4096;

struct Args {
    const float* in[33]; float* out; unsigned char* ws; int ph_lo, ph_hi;
};
struct Frame {
    LAS unsigned char* lds;
    int tid, lane, wave, G, bid;
    unsigned char* ws;
    unsigned* ctl;
};
__device__ __forceinline__ Frame fresh(const Frame& F) { Frame G = F; int t = threadIdx.x; asm volatile("" : "+v"(t)); G.tid = t; G.lane = t & 63; G.wave = __builtin_amdgcn_readfirstlane(t >> 6); return G; }
enum { IN_X = 0, IN_POS, IN_NMPRE, IN_NMPOST, IN_NFPRE, IN_NFPOST, IN_WUP, IN_WDN, IN_ABIN, IN_ABOUT, IN_GCONV, IN_GALOG, IN_GDT, IN_GNORM,
       IN_RMU, IN_RW0, IN_RW2, IN_RA0, IN_RA2, IN_RG2, IN_RKK, IN_RKA, IN_RRK, IN_RLNW, IN_RLNB, IN_NWIN, IN_NWOUT, IN_NPEK, IN_NW1K, IN_NW2K, IN_NPEV, IN_NW1V, IN_NW2V };

template <bool LIGHT = false> __device__ __forceinline__ void transpose_item(const float* W, int K, int Nsrc, int src_col0, int cnt, bf16_t* WT, int dst_row0, LAS float* scr, int item, int lane) {
    const int nblk = (cnt + 31) / 32, kb = item / nblk, nb = item % nblk, k0 = 64 * kb, n0 = 32 * nb;
    const int nl = lane & 31; const bool okn = (n0 + nl) < cnt;
    const float* wp = W + (size_t)(k0 + (lane >> 5)) * Nsrc + src_col0 + n0 + nl;
    if constexpr (LIGHT) {
#pragma unroll 8
        for (int i = 0; i < 32; ++i) scr[(2 * i + (lane >> 5)) * 33 + nl] = okn ? wp[(size_t)(2 * i) * Nsrc] : 0.f;
    } else {
        float wv[32];
#pragma unroll
        for (int i = 0; i < 32; ++i) wv[i] = okn ? wp[(size_t)(2 * i) * Nsrc] : 0.f;
#pragma unroll
        for (int i = 0; i < 32; ++i) scr[(2 * i + (lane >> 5)) * 33 + nl] = wv[i];
    }
    asm volatile("s_waitcnt lgkmcnt(0)" ::: "memory");
    const int c = lane & 7;
#pragma unroll
    for (int j = 0; j < 4; ++j) { const int n = (lane >> 3) + 8 * j; const LAS float* s = scr + (8 * c) * 33 + n;
        u32x4 o; o.x = pk2(s[0 * 33], s[1 * 33]); o.y = pk2(s[2 * 33], s[3 * 33]); o.z = pk2(s[4 * 33], s[5 * 33]); o.w = pk2(s[6 * 33], s[7 * 33]);
        if (n0 + n < cnt) *(u32x4*)(WT + (size_t)(dst_row0 + n0 + n) * K + k0 + 8 * c) = o; }
    asm volatile("s_waitcnt lgkmcnt(0)" ::: "memory");
}
template <bool LIGHT = false> __device__ __forceinline__ void transpose_seg(const Frame& F, const float* W, int K, int Nsrc, int src_col0, int cnt, bf16_t* WT, int dst_row0, int bid0 = 0, int nb = 0) {
    LAS float* scr = (LAS float*)(F.lds + F.wave * 16384);
    const int gw = (F.bid - bid0) * NWAVES + F.wave, NGW = (nb ? nb : F.G) * NWAVES;
    const int nitems = (K / 64) * ((cnt + 31) / 32);
    for (int it = gw; it < nitems; it += NGW) transpose_item<LIGHT>(W, K, Nsrc, src_col0, cnt, WT, dst_row0, scr, it, F.lane);
}
__device__ __forceinline__ void zero_rows(const Frame& F, bf16_t* WT, int K, int row0, int nrows, int bid0 = 0, int nb = 0) {
    const int gw = (F.bid - bid0) * NWAVES + F.wave, NGW = (nb ? nb : F.G) * NWAVES;
    unsigned z = 0u; asm volatile("" : "+v"(z));
    for (int r = gw; r < nrows; r += NGW) { u32x4* p = (u32x4*)(WT + (size_t)(row0 + r) * K); for (int j = F.lane; j < K / 8; j += 64) p[j] = (u32x4){z, z, z, z}; }
}
__device__ __forceinline__ void rms_row_to_bf16(const float* xrow, const float* w, bf16_t* orow, int lane) {
    const f32x4* xr = (const f32x4*)xrow + lane; const f32x4* wr = (const f32x4*)w + lane;
    f32x4 v[4]; float s = 0.f;
#pragma unroll
    for (int j = 0; j < 4; ++j) { v[j] = xr[64 * j]; s += (v[j].x * v[j].x + v[j].y * v[j].y) + (v[j].z * v[j].z + v[j].w * v[j].w); }
    const float rstd = 1.f / sqrtf(wave_sum(s) * (1.f / D_MODEL) + NORM_EPS);
    unsigned long long* o8 = (unsigned long long*)orow + lane;
#pragma unroll
    for (int j = 0; j < 4; ++j) { const f32x4 g = wr[64 * j];
        o8[64 * j] = (unsigned long long)pk2(v[j].x * rstd * g.x, v[j].y * rstd * g.y) | ((unsigned long long)pk2(v[j].z * rstd * g.z, v[j].w * rstd * g.w) << 32); }
}
__device__ __forceinline__ void p0_prologue(const Frame& F, const Args& a, bool defer) {
    unsigned char* ws = F.ws;
    const float* abin = a.in[IN_ABIN];
    transpose_seg(F, abin, 1024, AB_IN_W, 0, 2048, (bf16_t*)(ws + WS_W_IN0), 0);
    transpose_seg(F, abin, 1024, AB_IN_W, 2056, 1792, (bf16_t*)(ws + WS_W_IN0), 2048);
    transpose_seg(F, abin, 1024, AB_IN_W, 2048, 8, (bf16_t*)(ws + WS_W_IN0), 3840);
    zero_rows(F, (bf16_t*)(ws + WS_W_IN0), 1024, 3848, 4096 - 3848);
    if (!defer) {
        transpose_seg(F, a.in[IN_ABOUT], 1024, 1024, 0, 1024, (bf16_t*)(ws + WS_W_OUT0), 0);
        transpose_seg(F, a.in[IN_WUP], 1024, 4096, 0, 4096, (bf16_t*)(ws + WS_W_UP0), 0);
        transpose_seg(F, a.in[IN_WDN], 4096, 1024, 0, 1024, (bf16_t*)(ws + WS_W_DN0), 0);
    }
    const int gw = F.bid * NWAVES + F.wave, NGW = F.G * NWAVES;
    const float* x = a.in[IN_X]; bf16_t* XN = (bf16_t*)(ws + WS_XN);
    for (int m = gw; m < MTOK; m += 2 * NGW) {
        const int m2 = m + NGW;
        const f32x4* xr0 = (const f32x4*)(x + (size_t)m * D_MODEL) + F.lane; const f32x4* xr1 = (const f32x4*)(x + (size_t)(m2 < MTOK ? m2 : m) * D_MODEL) + F.lane; const f32x4* wr = (const f32x4*)a.in[IN_NMPRE] + F.lane;
        f32x4 v0[4], v1[4]; float s0 = 0.f, s1 = 0.f;
#pragma unroll
        for (int j = 0; j < 4; ++j) { v0[j] = xr0[64 * j]; v1[j] = xr1[64 * j]; }
#pragma unroll
        for (int j = 0; j < 4; ++j) { s0 += (v0[j].x * v0[j].x + v0[j].y * v0[j].y) + (v0[j].z * v0[j].z + v0[j].w * v0[j].w); s1 += (v1[j].x * v1[j].x + v1[j].y * v1[j].y) + (v1[j].z * v1[j].z + v1[j].w * v1[j].w); }
        const float r0 = 1.f / sqrtf(wave_sum(s0) * (1.f / D_MODEL) + NORM_EPS), r1 = 1.f / sqrtf(wave_sum(s1) * (1.f / D_MODEL) + NORM_EPS);
        unsigned long long* o0 = (unsigned long long*)(XN + (size_t)m * D_MODEL) + F.lane; unsigned long long* o1 = (unsigned long long*)(XN + (size_t)m2 * D_MODEL) + F.lane;
#pragma unroll
        for (int j = 0; j < 4; ++j) { const f32x4 g = wr[64 * j];
            o0[64 * j] = (unsigned long long)pk2(v0[j].x * r0 * g.x, v0[j].y * r0 * g.y) | ((unsigned long long)pk2(v0[j].z * r0 * g.z, v0[j].w * r0 * g.w) << 32);
            if (m2 < MTOK) o1[64 * j] = (unsigned long long)pk2(v1[j].x * r1 * g.x, v1[j].y * r1 * g.y) | ((unsigned long long)pk2(v1[j].z * r1 * g.z, v1[j].w * r1 * g.w) << 32); }
    }
}

__device__ __forceinline__ void p0_layer0_rest(const Frame& F, const Args& a, int bid0, int nb, int part) {
    unsigned char* ws = F.ws;
    if (part == 0) transpose_seg<false>(F, a.in[IN_ABOUT], 1024, 1024, 0, 1024, (bf16_t*)(ws + WS_W_OUT0), 0, bid0, nb);
    if (part == 1) transpose_seg<false>(F, a.in[IN_WUP], 1024, 4096, 0, 4096, (bf16_t*)(ws + WS_W_UP0), 0, bid0, nb);
    if (part == 2) transpose_seg<false>(F, a.in[IN_WDN], 4096, 1024, 0, 1024, (bf16_t*)(ws + WS_W_DN0), 0, bid0, nb);
}
__device__ __forceinline__ void p0_layer1_weights(const Frame& F, const Args& a, int bid0, int nb, int part) {
    unsigned char* ws = F.ws;
    if (part < 0 || part == 0) {
        transpose_seg<false>(F, a.in[IN_NWIN], 1024, NSA_IN_W, 0, NSA_IN_W, (bf16_t*)(ws + WS_W_IN1), 0, bid0, nb);
        zero_rows(F, (bf16_t*)(ws + WS_W_IN1), 1024, NSA_IN_W, 2048 - NSA_IN_W, bid0, nb);
        transpose_seg<false>(F, a.in[IN_NWOUT], 1024, 1024, 0, 1024, (bf16_t*)(ws + WS_W_OUT1), 0, bid0, nb); }
    if (part < 0 || part == 1) transpose_seg<false>(F, a.in[IN_WUP] + (size_t)1024 * 4096, 1024, 4096, 0, 2048, (bf16_t*)(ws + WS_W_UP1), 0, bid0, nb);
    if (part < 0 || part == 2) transpose_seg<false>(F, a.in[IN_WUP] + (size_t)1024 * 4096, 1024, 4096, 2048, 2048, (bf16_t*)(ws + WS_W_UP1), 2048, bid0, nb);
    if (part < 0 || part == 3) transpose_seg<false>(F, a.in[IN_WDN] + (size_t)1024 * 4096, 4096, 1024, 0, 512, (bf16_t*)(ws + WS_W_DN1), 0, bid0, nb);
    if (part < 0 || part == 4) transpose_seg<false>(F, a.in[IN_WDN] + (size_t)1024 * 4096, 4096, 1024, 512, 512, (bf16_t*)(ws + WS_W_DN1), 512, bid0, nb);
    if (part < 0 || part == 5) {
        transpose_seg<false>(F, a.in[IN_NW1K], 2048, 256, 0, 256, (bf16_t*)(ws + WS_W_C1K), 0, bid0, nb);
        transpose_seg<false>(F, a.in[IN_NW1V], 2048, 256, 0, 256, (bf16_t*)(ws + WS_W_C1V), 0, bid0, nb);
        transpose_seg<false>(F, a.in[IN_NW2K], 256, 64, 0, 64, (bf16_t*)(ws + WS_W_C2K), 0, bid0, nb);
        transpose_seg<false>(F, a.in[IN_NW2V], 256, 64, 0, 64, (bf16_t*)(ws + WS_W_C2V), 0, bid0, nb); }
}

#define XB_TMO      128
#define XB_XCNT(j)  (256  + 64 * (j))
#define XB_XSUB(j)  (1280 + 64 * (j))
#define XB_XGEN(j)  (2304 + 64 * (j))
#define XB_TOP      3328
#define XB_TOPGEN   3392
#define XCD_BAR_WORDS 3456
#define XB_SPIN_CAP (1u << 18)

__device__ __forceinline__ unsigned xb_ld(unsigned* p)              { return __hip_atomic_load(p, __ATOMIC_RELAXED, __HIP_MEMORY_SCOPE_AGENT); }
__device__ __forceinline__ unsigned xb_add(unsigned* p, unsigned v) { return __hip_atomic_fetch_add(p, v, __ATOMIC_RELAXED, __HIP_MEMORY_SCOPE_AGENT); }
__device__ __forceinline__ unsigned xb_xcc_id() { return (unsigned)__builtin_amdgcn_s_getreg((3 << 11) | 20) & 0xFu; }
#define XB_SPIN(cond, bar) do { unsigned _sp = 0; while (cond) { __builtin_amdgcn_s_sleep(1); \
    if ((++_sp & 255u) == 0u) { if (xb_ld(&(bar)[XB_TMO])) break; if (_sp > XB_SPIN_CAP) { atomicAdd(&(bar)[XB_TMO], 1u); break; } } } } while (0)

struct XcdBarrier {
    unsigned* bar; unsigned x;
    volatile LAS unsigned* st;
};

__device__ __forceinline__ XcdBarrier xcd_barrier_post(unsigned* bar, volatile LAS unsigned* st) {
    XcdBarrier b; b.bar = bar; b.x = xb_xcc_id(); b.st = st;
    if (threadIdx.x == 0) (void)xb_add(&bar[XB_XCNT(b.x)], 1u);
    return b;
}
__device__ __forceinline__ void xcd_barrier_complete(unsigned* bar, unsigned x, unsigned& nloc, unsigned& nx) {
    const unsigned G = gridDim.x * gridDim.y * gridDim.z;
    unsigned sum, cnt, mine, sp = 0u;
    for (;;) {
        sum = 0u; cnt = 0u; mine = 0u;
#pragma unroll
        for (unsigned j = 0; j < 16; ++j) { const unsigned c = xb_ld(&bar[XB_XCNT(j)]); sum += c; cnt += (c > 0u) ? 1u : 0u; mine = (j == x) ? c : mine; }
        if (sum == G) break;
        __builtin_amdgcn_s_sleep(1);
        if ((++sp & 255u) == 0u) { if (xb_ld(&bar[XB_TMO])) break; if (sp > XB_SPIN_CAP) { atomicAdd(&bar[XB_TMO], 1u); break; } }
    }
    nloc = mine > 0u ? mine : 1u; nx = cnt > 0u ? cnt : 1u;
}

__device__ __forceinline__ void xcd_barrier(const XcdBarrier& b) {
    asm volatile("s_waitcnt vmcnt(0)" ::: "memory");
    __syncthreads();
    if (threadIdx.x == 0) {
        unsigned* bar = b.bar; const unsigned bx = xb_xcc_id();
        __builtin_amdgcn_s_waitcnt(0);
        unsigned nloc = b.st[0], nx = b.st[1];
        if (nloc == 0u) { xcd_barrier_complete(bar, bx, nloc, nx); b.st[0] = nloc; b.st[1] = nx; }
        const unsigned old = xb_add(&bar[XB_XSUB(bx)], 1u);
        const unsigned gen = old / nloc;
        if (old + 1u == (gen + 1u) * nloc) {
            __builtin_amdgcn_fence(__ATOMIC_RELEASE, "agent");
            asm volatile("s_waitcnt vmcnt(0)" ::: "memory");
            const unsigned og = xb_add(&bar[XB_TOP], 1u);
            const unsigned tg = og / nx;
            if (og + 1u == (tg + 1u) * nx) xb_add(&bar[XB_TOPGEN], 1u);
            else XB_SPIN(xb_ld(&bar[XB_TOPGEN]) == tg, bar);
            __builtin_amdgcn_fence(__ATOMIC_ACQUIRE, "agent");
            xb_add(&bar[XB_XGEN(bx)], 1u);
            asm volatile("s_waitcnt vmcnt(0)" ::: "memory");
        } else {
            XB_SPIN(xb_ld(&bar[XB_XGEN(bx)]) == gen, bar);
            __builtin_amdgcn_fence(__ATOMIC_ACQUIRE, "agent");
            asm volatile("s_waitcnt vmcnt(0)" ::: "memory");
        }
    }
    __syncthreads();
}
constexpr size_t GDN_UNIT_ELEMS = 8192;
constexpr size_t WS_INTRA = WS_R2, WS_GLAST = WS_R2 + 16 * MiB;
constexpr int GP_ROWB = 272;
constexpr int GP_QB = 0, GP_KB = 17408, GP_VB = 34816, GP_AM = 52224, GP_SC = 68608, GP_HALF = 69632;
#define MFMA16(a, b, c) __builtin_amdgcn_mfma_f32_16x16x32_bf16((a), (b), (c), 0, 0, 0)

__device__ __forceinline__ bf16x8 lds_aperm(const LAS unsigned char* rowp, int k0, int fq) {
    const u32x2 a = *(const LAS u32x2*)(rowp + (k0 + 4 * fq) * 2), b = *(const LAS u32x2*)(rowp + (k0 + 16 + 4 * fq) * 2);
    u32x4 v; v.x = a.x; v.y = a.y; v.z = b.x; v.w = b.y; return __builtin_bit_cast(bf16x8, v);
}
__device__ __forceinline__ bf16x8 acc_bperm(const f32x4& lo, const f32x4& hi) {
    u32x4 v; v.x = pk2(lo[0], lo[1]); v.y = pk2(lo[2], lo[3]); v.z = pk2(hi[0], hi[1]); v.w = pk2(hi[2], hi[3]); return __builtin_bit_cast(bf16x8, v);
}
__device__ __forceinline__ void gdn_prep_phase(const Frame& F, const Args& a) {
    const bf16_t* F0 = (const bf16_t*)(F.ws + WS_BIG);
    bf16_t* Ut = (bf16_t*)a.out; bf16_t* Wm = Ut + (size_t)2048 * GDN_UNIT_ELEMS; bf16_t* QG = Wm + (size_t)2048 * GDN_UNIT_ELEMS; bf16_t* KGt = QG + (size_t)2048 * GDN_UNIT_ELEMS;
    bf16_t* INTRA = (bf16_t*)(F.ws + WS_INTRA); float* GLAST = (float*)(F.ws + WS_GLAST);
    const float* convw = a.in[IN_GCONV];
    const int hb = F.wave >> 2, wq = F.wave & 3, lane = F.lane, fr = lane & 15, fq = lane >> 4;
    LAS unsigned char* L = F.lds + hb * GP_HALF;
    LAS float* betaL = (LAS float*)(L + GP_SC); LAS float* gcL = betaL + 64;
    LAS bf16_t* Ab = (LAS bf16_t*)(L + GP_AM);
    const int nhalf = F.G * 2, hid = F.bid * 2 + hb;
    LAS float* CW = (LAS float*)(F.lds + 2 * GP_HALF);
    { const int hh = (hid >> 6) & 3;
      for (int e = F.tid; e < 1536; e += NTHREADS) { const int X = e >> 9, i = (e >> 7) & 3, c = e & 127; CW[e] = convw[i * 1536 + X * 512 + hh * 128 + c]; } }
    __syncthreads();
#if defined(PROBE_GP_S1) || defined(PROBE_GP_S2) || defined(PROBE_GP_S3) || defined(PROBE_GP_S1C) || defined(PROBE_GP_S3C)
    const int nrep_ = __builtin_amdgcn_readfirstlane(2 + (int)__hip_atomic_load(F.ctl + 6, __ATOMIC_RELAXED, __HIP_MEMORY_SCOPE_AGENT));
#endif
    for (int u = hid; u < 2048; u += nhalf) {
        const int n = u & 63, h = (u >> 6) & 3, b = u >> 8;
        const size_t m0 = (size_t)b * SEQ + (size_t)n * 64;
        const int tl0 = 16 * wq + 4 * fq;
        float bb = 0.f, aa = 0.f;
        if (wq == 0) { const size_t m = m0 + lane; bb = bf2f(F0[m * F0_LD + F0_BA + h]); aa = bf2f(F0[m * F0_LD + F0_BA + 4 + h]); }
#if defined(PROBE_GP_S1) || defined(PROBE_GP_S1C)
#pragma unroll 1
        for (int rep_ = 0; rep_ < nrep_; ++rep_) {
#endif
        u32x4 rows[3][7];
        {
            const bool lowvalid = (n * 64 + tl0) > 0;
#ifdef PROBE_GP_S1C
            const size_t m0p = (size_t)((b + 4 * (1 - rep_)) & 7) * SEQ + (size_t)n * 64;
            const bf16_t* base = F0 + (m0p + tl0) * F0_LD + h * 128 + 8 * fr;
#else
            const bf16_t* base = F0 + (m0 + tl0) * F0_LD + h * 128 + 8 * fr;
#endif
#pragma unroll
            for (int X = 0; X < 3; ++X)
#pragma unroll
                for (int r = 0; r < 7; ++r) {
                    const long ro = (r < 3 && !lowvalid) ? 0 : (long)(r - 3) * F0_LD;
                    rows[X][r] = *(const u32x4*)(base + ro + X * 512);
                }
            if (!lowvalid) {
#pragma unroll
                for (int X = 0; X < 3; ++X)
#pragma unroll
                    for (int r = 0; r < 3; ++r) rows[X][r] = (u32x4){0u, 0u, 0u, 0u};
            }
        }
        if (wq == 0) {
            int lane = F.lane; asm volatile("" : "+v"(lane));
            const float beta = sigmoidf_(bb);
            float g = -__expf(a.in[IN_GALOG][h]) * fast_softplusf(aa + a.in[IN_GDT][h]);
#pragma unroll
            for (int o = 1; o < 64; o <<= 1) { const float t = __shfl_up(g, o); if (lane >= o) g += t; }
            betaL[lane] = beta; gcL[lane] = g;
            if (lane == 63) GLAST[u] = __expf(g);
        }
#pragma unroll
        for (int X = 0; X < 3; ++X) {
            float acc[4][8];
#pragma unroll
            for (int j = 0; j < 4; ++j)
#pragma unroll
                for (int e = 0; e < 8; ++e) acc[j][e] = 0.f;
#pragma unroll
            for (int i = 0; i < 4; ++i) {
                const f32x4 w0 = *(const LAS f32x4*)(CW + (X * 4 + i) * 128 + 8 * fr), w1 = *(const LAS f32x4*)(CW + (X * 4 + i) * 128 + 8 * fr + 4);
#pragma unroll
                for (int j = 0; j < 4; ++j) { const u32x4 xv = rows[X][j + i];
                    acc[j][0] += w0[0] * bflo(xv.x); acc[j][1] += w0[1] * bfhi(xv.x); acc[j][2] += w0[2] * bflo(xv.y); acc[j][3] += w0[3] * bfhi(xv.y);
                    acc[j][4] += w1[0] * bflo(xv.z); acc[j][5] += w1[1] * bfhi(xv.z); acc[j][6] += w1[2] * bflo(xv.w); acc[j][7] += w1[3] * bfhi(xv.w); }
            }
#pragma unroll
            for (int j = 0; j < 4; ++j) {
                float ss = 0.f;
#pragma unroll
                for (int e = 0; e < 8; ++e) { acc[j][e] = siluf_(acc[j][e]); ss += acc[j][e] * acc[j][e]; }
                float sc = 1.f;
                if (X < 2) {
#pragma unroll
                    for (int o = 1; o < 16; o <<= 1) ss += __shfl_xor(ss, o);
                    sc = rsqrtf(ss + 1e-6f) * (X == 0 ? 0.08838834764831845f : 1.f);
                }
                u32x4 o4; o4.x = pk2(acc[j][0] * sc, acc[j][1] * sc); o4.y = pk2(acc[j][2] * sc, acc[j][3] * sc); o4.z = pk2(acc[j][4] * sc, acc[j][5] * sc); o4.w = pk2(acc[j][6] * sc, acc[j][7] * sc);
                *(LAS u32x4*)(L + (X == 0 ? GP_QB : X == 1 ? GP_KB : GP_VB) + (tl0 + j) * GP_ROWB + fr * 16) = o4;
            }
        }
#if defined(PROBE_GP_S1) || defined(PROBE_GP_S1C)
        }
#endif
        __syncthreads();
#ifdef PROBE_GP_S2
#pragma unroll 1
        for (int rep_ = 0; rep_ < nrep_; ++rep_)
#endif
        {
            bf16x8 ka[4], qa[4];
#pragma unroll
            for (int ks = 0; ks < 4; ++ks) { ka[ks] = *(const LAS bf16x8*)(L + GP_KB + (16 * wq + fr) * GP_ROWB + (32 * ks + 8 * fq) * 2);
                                             qa[ks] = *(const LAS bf16x8*)(L + GP_QB + (16 * wq + fr) * GP_ROWB + (32 * ks + 8 * fq) * 2); }
            {
                const float eg = __expf(gcL[16 * wq + fr]);
#pragma unroll
                for (int ks = 0; ks < 4; ++ks) { const u32x4 qv = __builtin_bit_cast(u32x4, qa[ks]); u32x4 o4;
                    o4.x = pk2(bflo(qv.x) * eg, bfhi(qv.x) * eg); o4.y = pk2(bflo(qv.y) * eg, bfhi(qv.y) * eg); o4.z = pk2(bflo(qv.z) * eg, bfhi(qv.z) * eg); o4.w = pk2(bflo(qv.w) * eg, bfhi(qv.w) * eg);
                    *(u32x4*)(QG + (size_t)u * GDN_UNIT_ELEMS + (16 * wq + fr) * 128 + 32 * ks + 8 * fq) = o4; }
            }
            bf16_t* intra_u = INTRA + (size_t)u * 4096;
#pragma unroll
            for (int nt = 0; nt < 4; ++nt) {
                if (nt <= wq) {
                    f32x4 ckk = (f32x4){0.f, 0.f, 0.f, 0.f}, cqk = (f32x4){0.f, 0.f, 0.f, 0.f};
#pragma unroll
                    for (int ks = 0; ks < 4; ++ks) { const bf16x8 kb = *(const LAS bf16x8*)(L + GP_KB + (16 * nt + fr) * GP_ROWB + (32 * ks + 8 * fq) * 2);
                        ckk = MFMA16(ka[ks], kb, ckk); cqk = MFMA16(qa[ks], kb, cqk); }
                    const int j = 16 * nt + fr; const float gj = gcL[j];
#pragma unroll
                    for (int r = 0; r < 4; ++r) { const int i = 16 * wq + 4 * fq + r; const float d = __expf(gcL[i] - gj);
                        Ab[i * 72 + j] = (bf16_t)f2bf((i > j) ? betaL[i] * ckk[r] * d : 0.f);
                        intra_u[i * 64 + j] = (bf16_t)f2bf((i >= j) ? cqk[r] * d : 0.f); }
                } else {
#pragma unroll
                    for (int r = 0; r < 4; ++r) intra_u[(16 * wq + 4 * fq + r) * 64 + 16 * nt + fr] = 0;
                }
            }
        }
        __syncthreads();
#if defined(PROBE_GP_S3) || defined(PROBE_GP_S3C)
#pragma unroll 1
        for (int rep_ = 0; rep_ < nrep_; ++rep_)
#endif
        {
            int lane = F.lane; asm volatile("" : "+v"(lane));
            const int fr = lane & 15, fq = lane >> 4;
            const bool isk = wq >= 2; const int cb = (wq & 1) * 64;
#ifdef PROBE_GP_S3C
            bf16_t* Ut = rep_ == 0 ? (bf16_t*)(F.ws + WS_XN) : (bf16_t*)a.out; bf16_t* KGt = rep_ == 0 ? (bf16_t*)(F.ws + WS_XN) + (size_t)2048 * GDN_UNIT_ELEMS : (bf16_t*)a.out + (size_t)3 * 2048 * GDN_UNIT_ELEMS;
#endif
            LAS unsigned char* X = L + (isk ? GP_KB : GP_VB);
            LAS unsigned char* AbB = L + GP_AM; LAS unsigned char* Tb = L + GP_AM + 9216;
            {
                const int blk = fq, c = fr;
                float x[16];
#pragma unroll
                for (int k = 0; k < 16; ++k) x[k] = (k == c) ? 1.f : 0.f;
#pragma unroll
                for (int j = 15; j >= 1; --j) {
                    const LAS unsigned char* rowp = AbB + (16 * blk + j) * 144 + 32 * blk;
                    const u32x4 a0 = *(const LAS u32x4*)rowp;
                    float av[16];
                    av[0] = bflo(a0.x); av[1] = bfhi(a0.x); av[2] = bflo(a0.y); av[3] = bfhi(a0.y); av[4] = bflo(a0.z); av[5] = bfhi(a0.z); av[6] = bflo(a0.w); av[7] = bfhi(a0.w);
                    if (j > 8) { const u32x4 a1 = *(const LAS u32x4*)(rowp + 16);
                        av[8] = bflo(a1.x); av[9] = bfhi(a1.x); av[10] = bflo(a1.y); av[11] = bfhi(a1.y); av[12] = bflo(a1.z); av[13] = bfhi(a1.z); av[14] = bflo(a1.w); av[15] = bfhi(a1.w); }
#pragma unroll
                    for (int k = 0; k < j; ++k) x[k] -= x[j] * av[k];
                }
                u32x4 t0, t1;
                t0.x = pk2(x[0], x[1]); t0.y = pk2(x[2], x[3]); t0.z = pk2(x[4], x[5]); t0.w = pk2(x[6], x[7]);
                t1.x = pk2(x[8], x[9]); t1.y = pk2(x[10], x[11]); t1.z = pk2(x[12], x[13]); t1.w = pk2(x[14], x[15]);
                *(LAS u32x4*)(Tb + lane * 32) = t0; *(LAS u32x4*)(Tb + lane * 32 + 16) = t1;
            }
            f32x4 R[4][4];
            const float gl = gcL[63];
#pragma unroll
            for (int blk = 0; blk < 4; ++blk) {
                const f32x4 be = *(const LAS f32x4*)(betaL + 16 * blk + 4 * fq), gc4 = *(const LAS f32x4*)(gcL + 16 * blk + 4 * fq);
                f32x4 sc, kg;
#pragma unroll
                for (int r = 0; r < 4; ++r) { sc[r] = isk ? be[r] * __expf(gc4[r]) : be[r]; kg[r] = __expf(gl - gc4[r]); }
#pragma unroll
                for (int nt = 0; nt < 4; ++nt) {
                    const int col = cb + 16 * nt + fr;
                    f32x4 v;
#pragma unroll
                    for (int r = 0; r < 4; ++r) v[r] = bf2f(*(const LAS bf16_t*)(X + (16 * blk + 4 * fq + r) * GP_ROWB + col * 2));
                    if (isk) { u32x2 o; o.x = pk2(v[0] * kg[0], v[1] * kg[1]); o.y = pk2(v[2] * kg[2], v[3] * kg[3]);
                        *(u32x2*)(KGt + (size_t)u * GDN_UNIT_ELEMS + col * 64 + 16 * blk + 4 * fq) = o; }
#pragma unroll
                    for (int r = 0; r < 4; ++r) R[blk][nt][r] = v[r] * sc[r];
                }
            }
            const f32x4 zero4 = (f32x4){0.f, 0.f, 0.f, 0.f};
            bf16x8 tf[4];
#pragma unroll
            for (int blk = 0; blk < 4; ++blk) { const u32x2 t = *(const LAS u32x2*)(Tb + (16 * blk + fr) * 32 + 8 * fq); u32x4 v; v.x = t.x; v.y = t.y; v.z = 0u; v.w = 0u; tf[blk] = __builtin_bit_cast(bf16x8, v); }
            const bf16x8 a1 = lds_aperm(AbB + (16 + fr) * 144, 0, fq), a2 = lds_aperm(AbB + (32 + fr) * 144, 0, fq), a3a = lds_aperm(AbB + (48 + fr) * 144, 0, fq), a3b = lds_aperm(AbB + (48 + fr) * 144, 32, fq);
#pragma unroll
            for (int nt = 0; nt < 4; ++nt) {
                R[0][nt] = MFMA16(tf[0], acc_bperm(R[0][nt], zero4), zero4);
                u32x4 n0 = __builtin_bit_cast(u32x4, acc_bperm(R[0][nt], zero4)); n0.x ^= 0x80008000u; n0.y ^= 0x80008000u;
                f32x4 t1 = MFMA16(a1, __builtin_bit_cast(bf16x8, n0), R[1][nt]);
                R[1][nt] = MFMA16(tf[1], acc_bperm(t1, zero4), zero4);
                u32x4 n01 = __builtin_bit_cast(u32x4, acc_bperm(R[0][nt], R[1][nt])); n01.x ^= 0x80008000u; n01.y ^= 0x80008000u; n01.z ^= 0x80008000u; n01.w ^= 0x80008000u;
                f32x4 t2 = MFMA16(a2, __builtin_bit_cast(bf16x8, n01), R[2][nt]);
                R[2][nt] = MFMA16(tf[2], acc_bperm(t2, zero4), zero4);
                u32x4 n2 = __builtin_bit_cast(u32x4, acc_bperm(R[2][nt], zero4)); n2.x ^= 0x80008000u; n2.y ^= 0x80008000u;
                f32x4 t3 = MFMA16(a3a, __builtin_bit_cast(bf16x8, n01), R[3][nt]);
                t3 = MFMA16(a3b, __builtin_bit_cast(bf16x8, n2), t3);
                R[3][nt] = MFMA16(tf[3], acc_bperm(t3, zero4), zero4);
            }
#pragma unroll
            for (int blk = 0; blk < 4; ++blk)
#pragma unroll
                for (int nt = 0; nt < 4; ++nt) {
                    const int col = cb + 16 * nt + fr;
                    if (isk) { bf16_t* dst = Wm + (size_t)u * GDN_UNIT_ELEMS + (size_t)(16 * blk + 4 * fq) * 128 + col;
#pragma unroll
                        for (int r = 0; r < 4; ++r) dst[r * 128] = (bf16_t)f2bf(R[blk][nt][r]);
                    } else { u32x2 o; o.x = pk2(R[blk][nt][0], R[blk][nt][1]); o.y = pk2(R[blk][nt][2], R[blk][nt][3]);
                        *(u32x2*)(Ut + (size_t)u * GDN_UNIT_ELEMS + col * 64 + 16 * blk + 4 * fq) = o; }
                }
        }
        __syncthreads();
    }
}

constexpr int GS_W = 0, GS_Q = 17408, GS_I = 34816, GS_K = 44032, GS_U = 62464, GS_Z = 80896;
constexpr int GS_SSQ = GS_Z + 17408;
static_assert(GS_SSQ + 4096 <= XB_LDS_OFF, "gdn scan lds");
__device__ __forceinline__ float red16_dpp(float v) {
    v += dpp_f(v, 0); v += dpp_f(v, 1); v += dpp_f(v, 2);
    const int i = __builtin_bit_cast(int, v); v += __builtin_bit_cast(float, __builtin_amdgcn_update_dpp(i, i, 0x140, 0xF, 0xF, false));
    return v;
}
constexpr size_t WS_GSTATE = WS_R2 + 18 * MiB;
__device__ __forceinline__ void gdn_scan_unit(const Frame& F, const Args& a, int bh, int n0, int n1, bool dry = false) {
    const bf16_t* F0 = (const bf16_t*)(F.ws + WS_BIG);
    const bf16_t* Ut = (const bf16_t*)a.out; const bf16_t* Wm = Ut + (size_t)2048 * GDN_UNIT_ELEMS; const bf16_t* QG = Wm + (size_t)2048 * GDN_UNIT_ELEMS; const bf16_t* KGt = QG + (size_t)2048 * GDN_UNIT_ELEMS;
    const bf16_t* INTRA = (const bf16_t*)(F.ws + WS_INTRA); const float* GLAST = (const float*)(F.ws + WS_GLAST);
    bf16_t* OAB = (bf16_t*)(F.ws + WS_XN);
    const int w = F.wave, lane = F.lane, fr = lane & 15, fq = lane >> 4;
    const int h = bh & 3, b = bh >> 2;
    LAS unsigned char* L = F.lds;
    LAS float* ssq = (LAS float*)(L + GS_SSQ);
    LAS float* glp = ssq + 1000;
#define GS_BAR() do { asm volatile("s_waitcnt lgkmcnt(0)" ::: "memory"); __builtin_amdgcn_s_barrier(); asm volatile("" ::: "memory"); } while (0)
    if (w >= 4) {
        const int lt = F.tid - 256;
        struct GsSet { u32x4 pw[4], pq[4], pz[4], pk[4], pu[4], pi[2]; float pgl; };
        GsSet A, B;
#define GS_FETCH(P_, n_) do { const size_t u_ = (size_t)bh * 64 + (n_); \
            _Pragma("unroll") for (int i_ = 0; i_ < 4; ++i_) { const int e_ = lt + 256 * i_; P_.pw[i_] = *(const u32x4*)(Wm + u_ * GDN_UNIT_ELEMS + (size_t)e_ * 8); P_.pq[i_] = *(const u32x4*)(QG + u_ * GDN_UNIT_ELEMS + (size_t)e_ * 8); \
                P_.pk[i_] = *(const u32x4*)(KGt + u_ * GDN_UNIT_ELEMS + (size_t)e_ * 8); P_.pu[i_] = *(const u32x4*)(Ut + u_ * GDN_UNIT_ELEMS + (size_t)e_ * 8); \
                P_.pz[i_] = *(const u32x4*)(F0 + ((size_t)b * SEQ + (size_t)(n_) * 64 + (e_ >> 4)) * F0_LD + 1536 + h * 128 + (e_ & 15) * 8); } \
            _Pragma("unroll") for (int i_ = 0; i_ < 2; ++i_) P_.pi[i_] = *(const u32x4*)(INTRA + u_ * 4096 + (size_t)(lt + 256 * i_) * 8); \
            P_.pgl = GLAST[u_]; } while (0)
#define GS_STORE(P_, n_) do { \
            _Pragma("unroll") for (int i_ = 0; i_ < 4; ++i_) { const int e_ = lt + 256 * i_; \
                *(LAS u32x4*)(L + GS_W + (e_ >> 4) * 272 + (e_ & 15) * 16) = P_.pw[i_]; *(LAS u32x4*)(L + GS_Q + (e_ >> 4) * 272 + (e_ & 15) * 16) = P_.pq[i_]; *(LAS u32x4*)(L + GS_Z + (e_ >> 4) * 272 + (e_ & 15) * 16) = P_.pz[i_]; \
                *(LAS u32x4*)(L + GS_K + (e_ >> 3) * 144 + (e_ & 7) * 16) = P_.pk[i_]; *(LAS u32x4*)(L + GS_U + (e_ >> 3) * 144 + (e_ & 7) * 16) = P_.pu[i_]; } \
            _Pragma("unroll") for (int i_ = 0; i_ < 2; ++i_) { const int e_ = lt + 256 * i_; *(LAS u32x4*)(L + GS_I + (e_ >> 3) * 144 + (e_ & 7) * 16) = P_.pi[i_]; } \
            if (lt == 0) glp[(n_) & 1] = P_.pgl; } while (0)
        GS_FETCH(A, n0);
        if (n0 + 1 < n1) GS_FETCH(B, n0 + 1);
        __syncthreads();
        GS_STORE(A, n0);
        GS_BAR();
#pragma unroll 1
        for (int n = n0; n < n1; n += 2) {
            if (n + 2 < n1) GS_FETCH(A, n + 2);
            GS_BAR();
            if (n + 1 < n1) GS_STORE(B, n + 1);
            GS_BAR();
            if (n + 3 < n1) GS_FETCH(B, n + 3);
            GS_BAR();
            if (n + 2 < n1) GS_STORE(A, n + 2);
            GS_BAR();
        }
#undef GS_FETCH
#undef GS_STORE
    } else {
        f32x4 S[2][8]; f32x4* GST = (f32x4*)(F.ws + WS_GSTATE) + ((size_t)bh * 8 + 2 * w) * 512;
#pragma unroll
        for (int nt = 0; nt < 2; ++nt)
#pragma unroll
            for (int d = 0; d < 8; ++d) S[nt][d] = (n0 == 0) ? (f32x4){0.f, 0.f, 0.f, 0.f} : GST[nt * 512 + d * 64 + lane];
        float gnw[2]; gnw[0] = a.in[IN_GNORM][32 * w + fr]; gnw[1] = a.in[IN_GNORM][32 * w + 16 + fr];
        __syncthreads();
        GS_BAR();
#pragma unroll 1
        for (int n = n0; n < n1; ++n) {
            const float gl = glp[n & 1];
            bf16x8 Sb[2][4];
#pragma unroll
            for (int nt = 0; nt < 2; ++nt)
#pragma unroll
                for (int ks = 0; ks < 4; ++ks) Sb[nt][ks] = acc_bperm(S[nt][2 * ks], S[nt][2 * ks + 1]);
            f32x4 vn[2][4], o[2][4];
#pragma unroll
            for (int mt = 0; mt < 4; ++mt) { f32x4 p0 = (f32x4){0.f, 0.f, 0.f, 0.f}, p1 = p0, q0 = p0, q1 = p0;
                const LAS unsigned char* wrow = L + GS_W + (16 * mt + fr) * 272; const LAS unsigned char* qrow = L + GS_Q + (16 * mt + fr) * 272;
#pragma unroll
                for (int ks = 0; ks < 4; ++ks) { const bf16x8 wa = lds_aperm(wrow, 32 * ks, fq), qa = lds_aperm(qrow, 32 * ks, fq);
                    p0 = MFMA16(wa, Sb[0][ks], p0); p1 = MFMA16(wa, Sb[1][ks], p1); q0 = MFMA16(qa, Sb[0][ks], q0); q1 = MFMA16(qa, Sb[1][ks], q1); }
                const u32x2 u0 = *(const LAS u32x2*)(L + GS_U + (32 * w + fr) * 144 + (16 * mt + 4 * fq) * 2), u1 = *(const LAS u32x2*)(L + GS_U + (32 * w + 16 + fr) * 144 + (16 * mt + 4 * fq) * 2);
                vn[0][mt] = (f32x4){bflo(u0.x) - p0[0], bfhi(u0.x) - p0[1], bflo(u0.y) - p0[2], bfhi(u0.y) - p0[3]};
                vn[1][mt] = (f32x4){bflo(u1.x) - p1[0], bfhi(u1.x) - p1[1], bflo(u1.y) - p1[2], bfhi(u1.y) - p1[3]};
                o[0][mt] = q0; o[1][mt] = q1; }
            bf16x8 Vb[2][2];
#pragma unroll
            for (int nt = 0; nt < 2; ++nt)
#pragma unroll
                for (int ks = 0; ks < 2; ++ks) Vb[nt][ks] = acc_bperm(vn[nt][2 * ks], vn[nt][2 * ks + 1]);
#pragma unroll
            for (int mt = 0; mt < 4; ++mt) { const LAS unsigned char* irow = L + GS_I + (16 * mt + fr) * 144;
#pragma unroll
                for (int ks = 0; ks < 2; ++ks) { const bf16x8 ia = lds_aperm(irow, 32 * ks, fq); o[0][mt] = MFMA16(ia, Vb[0][ks], o[0][mt]); o[1][mt] = MFMA16(ia, Vb[1][ks], o[1][mt]); } }
#pragma unroll
            for (int d = 0; d < 8; ++d) { S[0][d] = S[0][d] * gl; S[1][d] = S[1][d] * gl; const LAS unsigned char* krow = L + GS_K + (16 * d + fr) * 144;
#pragma unroll
                for (int ks = 0; ks < 2; ++ks) { const bf16x8 ka = lds_aperm(krow, 32 * ks, fq); S[0][d] = MFMA16(ka, Vb[0][ks], S[0][d]); S[1][d] = MFMA16(ka, Vb[1][ks], S[1][d]); } }
            LAS float* sq = ssq + (n & 1) * 256;
            float zv[2][16];
#pragma unroll
            for (int mt = 0; mt < 4; ++mt)
#pragma unroll
                for (int r = 0; r < 4; ++r) { const int t = 16 * mt + 4 * fq + r; const float s = red16_dpp(o[0][mt][r] * o[0][mt][r] + o[1][mt][r] * o[1][mt][r]); if (fr == 0) sq[w * 64 + t] = s;
                    zv[0][4 * mt + r] = bf2f(*(const LAS bf16_t*)(L + GS_Z + t * 272 + (32 * w + fr) * 2)); zv[1][4 * mt + r] = bf2f(*(const LAS bf16_t*)(L + GS_Z + t * 272 + (32 * w + 16 + fr) * 2)); }
            GS_BAR();
#pragma unroll
            for (int mt = 0; mt < 4; ++mt)
#pragma unroll
                for (int r = 0; r < 4; ++r) { const int t = 16 * mt + 4 * fq + r; const float s = (sq[t] + sq[64 + t]) + (sq[128 + t] + sq[192 + t]);
                    const float rstd = rsqrtf(s * (1.f / 128.f) + NORM_EPS);
                    const size_t m = (size_t)b * SEQ + (size_t)n * 64 + t;
                    if (!dry) { OAB[m * 1024 + h * 128 + 32 * w + fr] = (bf16_t)f2bf(o[0][mt][r] * rstd * gnw[0] * siluf_(zv[0][4 * mt + r]));
                                OAB[m * 1024 + h * 128 + 32 * w + 16 + fr] = (bf16_t)f2bf(o[1][mt][r] * rstd * gnw[1] * siluf_(zv[1][4 * mt + r])); } }
            GS_BAR();
        }
#pragma unroll
        for (int nt = 0; nt < 2; ++nt)
#pragma unroll
            for (int d = 0; d < 8; ++d) if (!dry) GST[nt * 512 + d * 64 + lane] = S[nt][d];
    }
#undef GS_BAR
}
constexpr int RW_L = 16;
constexpr int RW_W2T = 0, RW_A2T = 9216, RW_G2T = 18432;
constexpr int RW_OPS = 35840, RW_OPS_SZ = 24576;
constexpr int RW_YB = RW_OPS + 2 * RW_OPS_SZ, RW_YB_SZ = 4096;
constexpr int RW_XS = RW_YB + 2 * RW_YB_SZ, RW_XS_W = 2240;
constexpr int RW_XS_AD = 576, RW_XS_GD = 1152;
constexpr int RW_POST = RW_XS + 4 * RW_XS_W, RW_POST_SZ = 8192;
static_assert(RW_POST + 3 * RW_POST_SZ <= XB_LDS_OFF, "rwkv lds");
#define RW_BAR() do { asm volatile("s_waitcnt lgkmcnt(0)" ::: "memory"); __builtin_amdgcn_s_barrier(); asm volatile("" ::: "memory"); } while (0)
__device__ __forceinline__ float wave_sum_rl(float v) {
    v = red16_dpp(v);
    const int i = __builtin_bit_cast(int, v);
    return (__builtin_bit_cast(float, __builtin_amdgcn_readlane(i, 0)) + __builtin_bit_cast(float, __builtin_amdgcn_readlane(i, 16))) + (__builtin_bit_cast(float, __builtin_amdgcn_readlane(i, 32)) + __builtin_bit_cast(float, __builtin_amdgcn_readlane(i, 48)));
}

__device__ __forceinline__ void rwkv_unit(const Frame& F, const Args& a, int bh) {
    const bf16_t* F0 = (const bf16_t*)(F.ws + WS_BIG);
    bf16_t* OAB = (bf16_t*)(F.ws + WS_XN);
    const int h = bh & 7, b = bh >> 3, tid = F.tid, lane = F.lane, wave = F.wave, fr = lane & 15, fq = lane >> 4;
    LAS unsigned char* L = F.lds;
    for (int idx = tid; idx < 64 * 64; idx += NTHREADS) { const int j = idx >> 6, c = idx & 63;
        *(LAS bf16_t*)(L + RW_W2T + c * 144 + j * 2) = (bf16_t)f2bf(a.in[IN_RW2][j * 512 + h * 64 + c]);
        *(LAS bf16_t*)(L + RW_A2T + c * 144 + j * 2) = (bf16_t)f2bf(a.in[IN_RA2][j * 512 + h * 64 + c]); }
    for (int idx = tid; idx < 128 * 64; idx += NTHREADS) { const int j = idx >> 6, c = idx & 63;
        *(LAS bf16_t*)(L + RW_G2T + c * 272 + j * 2) = (bf16_t)f2bf(a.in[IN_RG2][j * 512 + h * 64 + c]); }
    RW_BAR();
    const size_t mb = (size_t)b * SEQ;
    if (wave < 4) {
        f32x2 S0[4], S1[4];
#pragma unroll
        for (int k = 0; k < 4; ++k) { S0[k] = (f32x2){0.f, 0.f}; S1[k] = (f32x2){0.f, 0.f}; }
        const int cg = lane & 7, row0 = 16 * wave + 2 * (lane >> 3);
        RW_BAR();
#pragma unroll 1
        for (int c = 0; c < SEQ / RW_L; ++c) {
            LAS unsigned char* ops = L + RW_OPS + (c & 1) * RW_OPS_SZ; LAS float* yb = (LAS float*)(L + RW_YB + (c & 1) * RW_YB_SZ);
            f32x4 wA, wB, kkA, kkB, bA, bB, kA, kB, rA, rB; f32x2 vv;
#define RW_LOADOPS(s_) do { const LAS float* po_ = (const LAS float*)(ops + (s_) * 1536) + 8 * cg; \
                wA = *(const LAS f32x4*)(po_); wB = *(const LAS f32x4*)(po_ + 4); kkA = *(const LAS f32x4*)(po_ + 64); kkB = *(const LAS f32x4*)(po_ + 68); \
                bA = *(const LAS f32x4*)(po_ + 128); bB = *(const LAS f32x4*)(po_ + 132); kA = *(const LAS f32x4*)(po_ + 192); kB = *(const LAS f32x4*)(po_ + 196); \
                rA = *(const LAS f32x4*)(po_ + 256); rB = *(const LAS f32x4*)(po_ + 260); vv = *(const LAS f32x2*)((const LAS float*)(ops + (s_) * 1536) + 320 + row0); } while (0)
            RW_LOADOPS(0);
#pragma unroll 1
            for (int s = 0; s < RW_L; ++s) {
                const f32x2 kk2[4] = {{kkA[0], kkA[1]}, {kkA[2], kkA[3]}, {kkB[0], kkB[1]}, {kkB[2], kkB[3]}};
                const f32x2 w2[4] = {{wA[0], wA[1]}, {wA[2], wA[3]}, {wB[0], wB[1]}, {wB[2], wB[3]}};
                const f32x2 b2[4] = {{bA[0], bA[1]}, {bA[2], bA[3]}, {bB[0], bB[1]}, {bB[2], bB[3]}};
                const f32x2 k2[4] = {{kA[0], kA[1]}, {kA[2], kA[3]}, {kB[0], kB[1]}, {kB[2], kB[3]}};
                const f32x2 r2[4] = {{rA[0], rA[1]}, {rA[2], rA[3]}, {rB[0], rB[1]}, {rB[2], rB[3]}};
                const f32x2 v0 = {vv[0], vv[0]}, v1 = {vv[1], vv[1]};
                if (s + 1 < RW_L) RW_LOADOPS(s + 1);
                f32x2 a0 = S0[0] * kk2[0] + S0[1] * kk2[1], a1 = S1[0] * kk2[0] + S1[1] * kk2[1];
                a0 = a0 + S0[2] * kk2[2] + S0[3] * kk2[3]; a1 = a1 + S1[2] * kk2[2] + S1[3] * kk2[3];
                const float sa0 = red8_dpp(a0[0] + a0[1]), sa1 = red8_dpp(a1[0] + a1[1]);
                const f32x2 n0 = {-sa0, -sa0}, n1 = {-sa1, -sa1};
                f32x2 y0 = {0.f, 0.f}, y1 = {0.f, 0.f};
#pragma unroll
                for (int q = 0; q < 4; ++q) { S0[q] = S0[q] * w2[q] + n0 * b2[q] + v0 * k2[q]; S1[q] = S1[q] * w2[q] + n1 * b2[q] + v1 * k2[q]; y0 = y0 + S0[q] * r2[q]; y1 = y1 + S1[q] * r2[q]; }
                const float ys0 = red8_dpp(y0[0] + y0[1]), ys1 = red8_dpp(y1[0] + y1[1]);
                if (cg == 0) *(LAS f32x2*)(yb + s * 64 + row0) = (f32x2){ys0, ys1};
            }
#undef RW_LOADOPS
            RW_BAR();
        }
        RW_BAR();
    } else {
        const int p = wave - 4, hc = h * 64 + lane;
        LAS unsigned char* XS = L + RW_XS + p * RW_XS_W;
        const float w0c = a.in[IN_RW0][hc], a0c = a.in[IN_RA0][hc], kkc = a.in[IN_RKK][hc], kac = a.in[IN_RKA][hc], rkc = a.in[IN_RRK][hc], lnw = a.in[IN_RLNW][hc], lnb = a.in[IN_RLNB][hc];
        float mu[7];
#pragma unroll
        for (int g = 0; g < 3; ++g) mu[g] = a.in[IN_RMU][g * 512 + hc];
#pragma unroll
        for (int g = 3; g < 7; ++g) mu[g] = a.in[IN_RMU][1536 + (g - 3) * 64 + lane];
        bf16_t fv[5][7];
#define RW_FETCH(cn_) do { const long t0_ = (long)(cn_) * RW_L + 4 * p - 1; \
            _Pragma("unroll") for (int j_ = 0; j_ < 5; ++j_) { const long t_ = t0_ + j_; \
                _Pragma("unroll") for (int g_ = 0; g_ < 7; ++g_) { const int col_ = F0_RWKV + (g_ < 3 ? g_ * 512 + h * 64 : 1536 + (g_ - 3) * 64) + lane; fv[j_][g_] = (t_ >= 0) ? F0[(mb + t_) * F0_LD + col_] : (bf16_t)0; } } } while (0)
        RW_FETCH(0);
#pragma unroll 1
        for (int c = -1; c <= SEQ / RW_L; ++c) {
            const bool prep_on = (c + 1 < SEQ / RW_L), post_on = (c >= 1);
            if (post_on) {
                const LAS float* yb = (const LAS float*)(L + RW_YB + ((c - 1) & 1) * RW_YB_SZ); const LAS float* pg = (const LAS float*)(L + RW_POST + ((c - 1) % 3) * RW_POST_SZ);
#pragma unroll
                for (int j = 0; j < 4; ++j) { const int tau = 4 * p + j; const float y = yb[tau * 64 + lane];
                    const float mean = wave_sum_rl(y) * (1.f / 64.f); const float d = y - mean; const float var = wave_sum_rl(d * d) * (1.f / 64.f);
                    const float o = (d * rsqrtf(var + RWKV_LN_EPS) * lnw + lnb + pg[1024 + tau * 64 + lane]) * pg[tau * 64 + lane];
                    OAB[(mb + (size_t)(c - 1) * RW_L + tau) * 1024 + 512 + hc] = (bf16_t)f2bf(o); }
            }
            if (prep_on) {
                LAS unsigned char* nops = L + RW_OPS + ((c + 1) & 1) * RW_OPS_SZ; LAS float* pg_n = (LAS float*)(L + RW_POST + ((c + 1) % 3) * RW_POST_SZ);
                float xr[4], xk[4], xv[4];
#pragma unroll
                for (int j = 0; j < 4; ++j) {
                    float xs[7];
#pragma unroll
                    for (int g = 0; g < 7; ++g) { const float f = bf2f(fv[j + 1][g]), fp = bf2f(fv[j][g]); xs[g] = f + (fp - f) * mu[g]; }
                    xr[j] = xs[0]; xk[j] = xs[1]; xv[j] = xs[2];
                    *(LAS bf16_t*)(XS + j * 144 + lane * 2) = (bf16_t)f2bf(fast_tanhf(xs[3]));
                    *(LAS bf16_t*)(XS + RW_XS_AD + j * 144 + lane * 2) = (bf16_t)f2bf(xs[4]);
                    *(LAS bf16_t*)(XS + RW_XS_GD + j * 272 + lane * 2) = (bf16_t)f2bf(sigmoidf_(xs[5]));
                    *(LAS bf16_t*)(XS + RW_XS_GD + j * 272 + 128 + lane * 2) = (bf16_t)f2bf(sigmoidf_(xs[6]));
                }
                if (c + 2 < SEQ / RW_L) RW_FETCH(c + 2);
                asm volatile("s_waitcnt lgkmcnt(0)" ::: "memory");
                f32x4 cw = (f32x4){0.f, 0.f, 0.f, 0.f}, ca = cw, cgt = cw;
                {
                    bf16x8 xa[2], xb[2], xg[4];
#pragma unroll
                    for (int ks = 0; ks < 2; ++ks) { xa[ks] = *(const LAS bf16x8*)(XS + (fr & 3) * 144 + (32 * ks + 8 * fq) * 2); xb[ks] = *(const LAS bf16x8*)(XS + RW_XS_AD + (fr & 3) * 144 + (32 * ks + 8 * fq) * 2); }
#pragma unroll
                    for (int ks = 0; ks < 4; ++ks) xg[ks] = *(const LAS bf16x8*)(XS + RW_XS_GD + (fr & 3) * 272 + (32 * ks + 8 * fq) * 2);
#pragma unroll
                    for (int nt = 0; nt < 4; ++nt) {
                        f32x4 tw = (f32x4){0.f, 0.f, 0.f, 0.f}, ta = tw, tg = tw;
#pragma unroll
                        for (int ks = 0; ks < 2; ++ks) { tw = MFMA16(xa[ks], *(const LAS bf16x8*)(L + RW_W2T + (16 * nt + fr) * 144 + (32 * ks + 8 * fq) * 2), tw);
                                                         ta = MFMA16(xb[ks], *(const LAS bf16x8*)(L + RW_A2T + (16 * nt + fr) * 144 + (32 * ks + 8 * fq) * 2), ta); }
#pragma unroll
                        for (int ks = 0; ks < 4; ++ks) tg = MFMA16(xg[ks], *(const LAS bf16x8*)(L + RW_G2T + (16 * nt + fr) * 272 + (32 * ks + 8 * fq) * 2), tg);
                        if (fq == nt) { cw = tw; ca = ta; cgt = tg; }
                    }
                }
#pragma unroll
                for (int j = 0; j < 4; ++j) { const int tau = 4 * p + j; LAS float* o = (LAS float*)(nops + tau * 1536);
                    const float lw = cw[j] + w0c; const float wlog = -fast_softplusf(-lw) - 0.5f; const float wdec = __expf(-__expf(wlog));
                    const float av = sigmoidf_(ca[j] + a0c);
                    const float kkraw = xk[j] * kkc, kp = xk[j] * (1.f + (av - 1.f) * kac);
                    const float rinv = rsqrtf(wave_sum_rl(kkraw * kkraw) + 1e-6f);
                    const float bn = wave_sum_rl(xr[j] * kp * rkc);
                    const float kkn = kkraw * rinv;
                    o[lane] = wdec; o[64 + lane] = kkn; o[128 + lane] = kkn * av; o[192 + lane] = kp; o[256 + lane] = xr[j]; o[320 + lane] = xv[j];
                    pg_n[tau * 64 + lane] = cgt[j]; pg_n[1024 + tau * 64 + lane] = xv[j] * bn; }
            }
            RW_BAR();
        }
#undef RW_FETCH
    }
    __syncthreads();
}
constexpr int RC_KR = 0, RC_BKT = 4096, RC_VT = 8192, RC_MBB = 10240, RC_MKB = 11264, RC_MBR = 11776, RC_MKR = 12288, RC_WL = 12800, RC_PG = 13056, RC_PBV = 15104, RC_REC = 17408;
constexpr int RC_SEG_CHUNKS = 32, RC_NSEG = (SEQ / 16) / RC_SEG_CHUNKS;
constexpr size_t WS_RSCR = WS_R2 + 21 * MiB;
constexpr size_t WS_RSTATE = WS_R2 + 17 * MiB;
constexpr size_t WS_RIMG = WS_R2 + 20 * MiB;
constexpr int RP_PRM = 35840;
constexpr int RP_MU = RP_PRM + 1280;
constexpr int RP_WAVE = RP_MU + 1792, RP_WAVE_SZ = 9216;
static_assert(RP_WAVE + 8 * RP_WAVE_SZ <= XB_LDS_OFF, "rwkv prep lds");
__device__ __forceinline__ float dpp_shr_f(float v, const int n) {
    const int i = __builtin_bit_cast(int, v); int r;
    if (n == 1) r = __builtin_amdgcn_update_dpp(0, i, 0x111, 0xF, 0xF, true); else if (n == 2) r = __builtin_amdgcn_update_dpp(0, i, 0x112, 0xF, 0xF, true);
    else if (n == 4) r = __builtin_amdgcn_update_dpp(0, i, 0x114, 0xF, 0xF, true); else r = __builtin_amdgcn_update_dpp(0, i, 0x118, 0xF, 0xF, true);
    return __builtin_bit_cast(float, r);
}
__device__ __forceinline__ void rwkvc_prep_phase(const Frame& F, const Args& a, int sg, int bid0, int nb) {
    const bf16_t* F0 = (const bf16_t*)(F.ws + WS_BIG);
    unsigned char* SCR = F.ws + ((sg & 1) ? WS_RSCR2 : WS_RSCR);
    const int tid = F.tid, wave = F.wave;
    LAS unsigned char* L = F.lds;
    for (int blk = F.bid - bid0; blk < 256; blk += nb) {
        const int bh = blk >> 2, h = bh & 7, b = bh >> 3;
        const size_t mb = (size_t)b * SEQ;
        LAS unsigned char* XS = L + RP_WAVE + wave * RP_WAVE_SZ;
            int ln_ = F.lane; asm volatile("" : "+v"(ln_));
            const int lane = ln_, fr = ln_ & 15, fq = ln_ >> 4;
            const int cs = (blk & 3) * 8 + wave;
            const int t0 = (sg * RC_SEG_CHUNKS + cs) * 16;
            unsigned char* rec = SCR + ((size_t)bh * RC_SEG_CHUNKS + cs) * RC_REC;
            const bf16_t* rowc = F0 + (mb + t0 + fr) * F0_LD + F0_RWKV;
            const bool hasp = (t0 + fr) > 0; const bf16_t* rowp = rowc - (hasp ? F0_LD : 0);
            const bf16_t* rc4 = rowc + 4 * fq; const bf16_t* rp4 = rowp + 4 * fq; const LAS float* mul4 = (const LAS float*)(L + RP_MU) + 4 * fq;
            unsigned char* pbkt = rec + RC_BKT + fq * 256 + (fr >> 2) * 16 + (fr & 3) * 2;
            unsigned char* pvt = rec + RC_VT + fq * 128 + fr * 2;
            unsigned char* pwl = rec + RC_WL + fq * 16;
            unsigned char* ppg = rec + RC_PG + fr * 128 + fq * 8;
            LAS unsigned char* xs4 = XS + fr * 144 + fq * 8;
            u32x2 rawc[7][4], rawp[7][4];
#pragma unroll
            for (int g = 3; g < 7; ++g)
#pragma unroll
                for (int mt = 0; mt < 4; ++mt) { const int coff = 1536 + 64 * (g - 3) + 16 * mt; rawc[g][mt] = *(const u32x2*)(rc4 + coff); rawp[g][mt] = *(const u32x2*)(rp4 + coff); }
        __syncthreads();
        {
            const u32x4* src = (const u32x4*)(F.ws + WS_RIMG + (size_t)h * 35840);
            u32x4 t4[5];
#pragma unroll
            for (int i = 0; i < 5; ++i) { const int e = tid + NTHREADS * i; t4[i] = (e < 2240) ? src[e] : (u32x4){0u, 0u, 0u, 0u}; }
#pragma unroll
            for (int i = 0; i < 5; ++i) { const int e = tid + NTHREADS * i; if (e < 2240) *(LAS u32x4*)(L + e * 16) = t4[i]; }
        }
        if (tid < 320) { const int wh = tid >> 6, c = tid & 63; const float* src = wh == 0 ? a.in[IN_RW0] : wh == 1 ? a.in[IN_RA0] : wh == 2 ? a.in[IN_RKK] : wh == 3 ? a.in[IN_RKA] : a.in[IN_RRK];
            ((LAS float*)(L + RP_PRM))[tid] = src[h * 64 + c]; }
        if (tid < 448) ((LAS float*)(L + RP_MU))[tid] = a.in[IN_RMU][tid < 192 ? (tid >> 6) * 512 + h * 64 + (tid & 63) : 1536 + (tid - 192)];
        __syncthreads();
        const LAS float* PRM = (const LAS float*)(L + RP_PRM);
        {
#pragma unroll
            for (int g = 0; g < 4; ++g) {
                const int coff = 1536 + 64 * g;
#pragma unroll
                for (int mt = 0; mt < 4; ++mt) { const int j0 = 16 * mt + 4 * fq;
                    const u32x2 fc = rawc[3 + g][mt]; u32x2 fp = rawp[3 + g][mt]; if (!hasp) fp = (u32x2){0u, 0u};
                    const f32x4 mu = *(const LAS f32x4*)(mul4 + 192 + 64 * g + 16 * mt);
                    float x[4] = {bflo(fc.x), bfhi(fc.x), bflo(fc.y), bfhi(fc.y)}; const float xp[4] = {bflo(fp.x), bfhi(fp.x), bflo(fp.y), bfhi(fp.y)};
#pragma unroll
                    for (int e = 0; e < 4; ++e) { x[e] = x[e] + (xp[e] - x[e]) * mu[e]; x[e] = (g == 0) ? fast_tanhf(x[e]) : (g == 1) ? x[e] : sigmoidf_(x[e]); }
                    u32x2 o; o.x = pk2(x[0], x[1]); o.y = pk2(x[2], x[3]);
                    LAS unsigned char* dst = (g == 0) ? XS + fr * 144 + j0 * 2 : (g == 1) ? XS + 2304 + fr * 144 + j0 * 2 : XS + 4608 + fr * 272 + (g - 2) * 128 + j0 * 2;
                    *(LAS u32x2*)dst = o; } }
#pragma unroll
            for (int g = 0; g < 3; ++g)
#pragma unroll
                for (int mt = 0; mt < 4; ++mt) { const int coff = g * 512 + h * 64 + 16 * mt; rawc[g][mt] = *(const u32x2*)(rc4 + coff); rawp[g][mt] = *(const u32x2*)(rp4 + coff); }
            asm volatile("s_waitcnt lgkmcnt(0)" ::: "memory");
            float vr[16], vk[16], vv[16], ve[16], vkk[16], vb[16];
            float ss = 0.f, bn = 0.f;
            bf16x8 xw[2], xa[2], xg[4];
#pragma unroll
            for (int ks = 0; ks < 2; ++ks) { xw[ks] = *(const LAS bf16x8*)(XS + fr * 144 + (32 * ks + 8 * fq) * 2); xa[ks] = *(const LAS bf16x8*)(XS + 2304 + fr * 144 + (32 * ks + 8 * fq) * 2); }
#pragma unroll
            for (int ks = 0; ks < 4; ++ks) xg[ks] = *(const LAS bf16x8*)(XS + 4608 + fr * 272 + (32 * ks + 8 * fq) * 2);
#pragma unroll
            for (int mt = 0; mt < 4; ++mt) {
#pragma unroll
                for (int g = 0; g < 3; ++g) { const int coff = g * 512 + 16 * mt;
                    const u32x2 fc = rawc[g][mt]; u32x2 fp = rawp[g][mt]; if (!hasp) fp = (u32x2){0u, 0u};
                    const f32x4 mu = *(const LAS f32x4*)(mul4 + 64 * g + 16 * mt);
                    const float x[4] = {bflo(fc.x), bfhi(fc.x), bflo(fc.y), bfhi(fc.y)}; const float xp[4] = {bflo(fp.x), bfhi(fp.x), bflo(fp.y), bfhi(fp.y)};
#pragma unroll
                    for (int e = 0; e < 4; ++e) { const float xs = x[e] + (xp[e] - x[e]) * mu[e]; if (g == 0) vr[4 * mt + e] = xs; else if (g == 1) vk[4 * mt + e] = xs; else vv[4 * mt + e] = xs; } }
                f32x4 cw = (f32x4){0.f, 0.f, 0.f, 0.f}, ca = cw, cg = cw;
#pragma unroll
                for (int ks = 0; ks < 2; ++ks) { cw = MFMA16(*(const LAS bf16x8*)(L + RW_W2T + (16 * mt + fr) * 144 + (32 * ks + 8 * fq) * 2), xw[ks], cw);
                                                 ca = MFMA16(*(const LAS bf16x8*)(L + RW_A2T + (16 * mt + fr) * 144 + (32 * ks + 8 * fq) * 2), xa[ks], ca); }
#pragma unroll
                for (int ks = 0; ks < 4; ++ks) cg = MFMA16(*(const LAS bf16x8*)(L + RW_G2T + (16 * mt + fr) * 272 + (32 * ks + 8 * fq) * 2), xg[ks], cg);
#pragma unroll
                for (int r = 0; r < 4; ++r) { const int q = 4 * mt + r, c = 16 * mt + 4 * fq + r;
                    const float lw = cw[r] + PRM[c]; ve[q] = 0.6065306597126334f * sigmoidf_(lw);
                    const float av = sigmoidf_(ca[r] + PRM[64 + c]);
                    const float kraw = vk[q] * PRM[128 + c]; vk[q] = vk[q] * (1.f + (av - 1.f) * PRM[192 + c]);
                    vkk[q] = kraw; vb[q] = av; ss += kraw * kraw; bn += vr[q] * vk[q] * PRM[256 + c]; }
                { u32x2 og; og.x = pk2(cg[0], cg[1]); og.y = pk2(cg[2], cg[3]); *(u32x2*)(ppg + mt * 32) = og; }
                asm volatile("" ::: "memory");
            }
            ss += __shfl_xor(ss, 16); ss += __shfl_xor(ss, 32); bn += __shfl_xor(bn, 16); bn += __shfl_xor(bn, 32);
            const float rinv = rsqrtf(ss + 1e-6f);
#pragma unroll
            for (int mt = 0; mt < 4; ++mt) { u32x2 ob; ob.x = pk2(vv[4 * mt] * bn, vv[4 * mt + 1] * bn); ob.y = pk2(vv[4 * mt + 2] * bn, vv[4 * mt + 3] * bn); *(u32x2*)(ppg + 2048 + mt * 32) = ob; }
#pragma unroll
            for (int ks = 0; ks < 2; ++ks) {
                float kkt[8], rt[8], bh_[8], kh[8];
#pragma unroll
                for (int i = 0; i < 8; ++i) { const int q = 8 * ks + i;
                    float cl = ve[q];
                    cl += dpp_shr_f(cl, 1); cl += dpp_shr_f(cl, 2); cl += dpp_shr_f(cl, 4); cl += dpp_shr_f(cl, 8);
                    const float clL = __shfl(cl, (lane & 48) | 15);
                    const float kkn = vkk[q] * rinv, bq = kkn * vb[q];
                    const float W = __expf(-cl), Wp = __expf(ve[q] - cl), Wi = __expf(cl), WLr = __expf(cl - clL);
                    kkt[i] = kkn * Wp; rt[i] = vr[q] * W; bh_[i] = bq * Wi; kh[i] = vk[q] * Wi;
                    *(bf16_t*)(pbkt + (q >> 2) * 1024 + (q & 3) * 64) = (bf16_t)f2bf(-bq * WLr);
                    *(bf16_t*)(pbkt + (q >> 2) * 1024 + (q & 3) * 64 + 8) = (bf16_t)f2bf(vk[q] * WLr);
                    *(bf16_t*)(pvt + (q >> 2) * 512 + (q & 3) * 32) = (bf16_t)f2bf(vv[q]);
                    if (fr == 15) *(float*)(pwl + (q >> 2) * 64 + (q & 3) * 4) = W;
                }
                u32x4 o1, o2;
                o1.x = pk2(kkt[0], kkt[1]); o1.y = pk2(kkt[2], kkt[3]); o1.z = pk2(kkt[4], kkt[5]); o1.w = pk2(kkt[6], kkt[7]);
                o2.x = pk2(rt[0], rt[1]); o2.y = pk2(rt[2], rt[3]); o2.z = pk2(rt[4], rt[5]); o2.w = pk2(rt[6], rt[7]);
                *(u32x4*)(rec + RC_KR + fr * 128 + ks * 64 + fq * 16) = o1; *(u32x4*)(rec + RC_KR + 2048 + fr * 128 + ks * 64 + fq * 16) = o2;
#pragma unroll
                for (int m2 = 0; m2 < 2; ++m2) { const int mt = 2 * ks + m2; LAS unsigned char* xo = xs4 + mt * 32;
                    *(LAS u32x2*)(xo) = (u32x2){o1[2 * m2], o1[2 * m2 + 1]};
                    *(LAS u32x2*)(xo + 2304) = (u32x2){o2[2 * m2], o2[2 * m2 + 1]};
                    u32x2 o; o.x = pk2(bh_[4 * m2], bh_[4 * m2 + 1]); o.y = pk2(bh_[4 * m2 + 2], bh_[4 * m2 + 3]); *(LAS u32x2*)(xo + 4608) = o;
                    o.x = pk2(kh[4 * m2], kh[4 * m2 + 1]); o.y = pk2(kh[4 * m2 + 2], kh[4 * m2 + 3]); *(LAS u32x2*)(xo + 6912) = o; }
                asm volatile("" ::: "memory");
            }
            asm volatile("s_waitcnt lgkmcnt(0)" ::: "memory");
            f32x4 mbb = (f32x4){0.f, 0.f, 0.f, 0.f}, mkb = mbb, mbr = mbb, mkr = mbb;
#pragma unroll
            for (int ks = 0; ks < 2; ++ks) { const int off = fr * 144 + (32 * ks + 8 * fq) * 2;
                const bf16x8 akk = *(const LAS bf16x8*)(XS + off), ar = *(const LAS bf16x8*)(XS + 2304 + off), bb = *(const LAS bf16x8*)(XS + 4608 + off), bk = *(const LAS bf16x8*)(XS + 6912 + off);
                mbb = MFMA16(akk, bb, mbb); mkb = MFMA16(akk, bk, mkb); mbr = MFMA16(ar, bb, mbr); mkr = MFMA16(ar, bk, mkr); }
            {
                float T[16]; const float mf0 = mbb[0], mf1 = mbb[1], mf2 = mbb[2], mf3 = mbb[3];
                const int mb_[4] = {__builtin_bit_cast(int, mf0), __builtin_bit_cast(int, mf1), __builtin_bit_cast(int, mf2), __builtin_bit_cast(int, mf3)};
#pragma unroll
                for (int t = 0; t < 16; ++t) T[t] = (t == fr) ? 1.f : 0.f;
#pragma unroll
                for (int t = 1; t < 16; ++t) { float s0 = T[t], s1 = 0.f;
#pragma unroll
                    for (int j = 0; j < t; ++j) { const float m = __builtin_bit_cast(float, __builtin_amdgcn_readlane(mb_[t & 3], j + 16 * (t >> 2)));
                        if (j & 1) s1 -= m * T[j]; else s0 -= m * T[j]; }
                    T[t] = s0 + s1; }
                if (fq == 0) {
#pragma unroll
                    for (int t = 0; t < 16; ++t) { const bf16_t tv = (bf16_t)f2bf(T[t]); *(bf16_t*)(rec + RC_MBB + t * 64 + (fr >> 2) * 16 + (fr & 3) * 2) = tv; *(bf16_t*)(rec + RC_MBB + t * 64 + (fr >> 2) * 16 + 8 + (fr & 3) * 2) = tv; }
                }
            }
#pragma unroll
            for (int r = 0; r < 4; ++r) { const int t = 4 * fq + r, j = fr;
                *(bf16_t*)(rec + RC_MKB + t * 32 + j * 2) = (bf16_t)f2bf((j < t) ? mkb[r] : 0.f);
                *(bf16_t*)(rec + RC_MBR + t * 32 + j * 2) = (bf16_t)f2bf((j <= t) ? mbr[r] : 0.f);
                *(bf16_t*)(rec + RC_MKR + t * 32 + j * 2) = (bf16_t)f2bf((j <= t) ? mkr[r] : 0.f); }
            asm volatile("s_waitcnt lgkmcnt(0)" ::: "memory");
        }
    }
}

constexpr int RCH_X = 0;
constexpr int RCH_ST = 4096;
constexpr int RCH_RING = 8192, RCH_NSLOT = 6, RCH_PF = 5;
static_assert(RCH_RING + RCH_NSLOT * RC_REC <= XB_LDS_OFF, "rwkv chain lds");
#define RCH_BAR() do { asm volatile("s_waitcnt lgkmcnt(0)" ::: "memory"); __builtin_amdgcn_s_barrier(); asm volatile("" ::: "memory"); } while (0)
__device__ __forceinline__ void rwkvc_chain_unit(const Frame& F, const Args& a, int bh, int sg, bool dry = false) {
    const unsigned char* SCR = F.ws + ((sg & 1) ? WS_RSCR2 : WS_RSCR);
    bf16_t* OAB = (bf16_t*)(F.ws + WS_XN); f32x4* STATE = (f32x4*)(F.ws + WS_RSTATE);
    const int lane = F.lane, w = F.wave, fr = lane & 15, fq = lane >> 4, h = bh & 7, b = bh >> 3;
    LAS unsigned char* L = F.lds;
    const size_t mb = (size_t)b * SEQ;
    const unsigned char* seg = SCR + ((size_t)bh * RC_SEG_CHUNKS) * RC_REC;
    if (w >= 4) {
        const int p = w - 4;
#define RCH_ISSUE(ch_) do { int l16_ = lane * 16; asm volatile("" : "+v"(l16_)); const unsigned char* src_ = seg + (size_t)(ch_) * RC_REC + l16_; LAS unsigned char* dst_ = L + RCH_RING + ((ch_) % RCH_NSLOT) * RC_REC; \
            _Pragma("unroll") for (int i_ = 0; i_ < 5; ++i_) { const int pc_ = p + 4 * i_; if (pc_ < 17) __builtin_amdgcn_global_load_lds((const unsigned*)(src_ + pc_ * 1024), (LAS unsigned*)(dst_ + pc_ * 1024), 16, 0, 0); } } while (0)
#pragma unroll 1
        for (int ch = 0; ch < RCH_PF; ++ch) RCH_ISSUE(ch);
        if (p == 0) asm volatile("s_waitcnt vmcnt(20)" ::: "memory"); else asm volatile("s_waitcnt vmcnt(16)" ::: "memory");
        RCH_BAR();
#pragma unroll 1
        for (int cs = 0; cs < RC_SEG_CHUNKS; ++cs) {
            if (cs + RCH_PF < RC_SEG_CHUNKS) { RCH_ISSUE(cs + RCH_PF);
                if (p == 0) asm volatile("s_waitcnt vmcnt(20)" ::: "memory"); else asm volatile("s_waitcnt vmcnt(16)" ::: "memory"); }
            else asm volatile("s_waitcnt vmcnt(0)" ::: "memory");
            RCH_BAR();
        }
#undef RCH_ISSUE
    } else {
        LAS float* XT = (LAS float*)(L + RCH_X + w * 1024); LAS float* STT = (LAS float*)(L + RCH_ST);
        f32x4 acc[4];
#pragma unroll
        for (int mt = 0; mt < 4; ++mt) acc[mt] = (sg == 0) ? (f32x4){0.f, 0.f, 0.f, 0.f} : STATE[((size_t)bh * 4 + w) * 256 + mt * 64 + lane];
        const int v = 16 * w + fr, hc = h * 64 + v;
        const float lnw = a.in[IN_RLNW][hc], lnb = a.in[IN_RLNB][hc];
        RCH_BAR();
#pragma unroll 1
        for (int cs = 0; cs < RC_SEG_CHUNKS; ++cs) {
            const LAS unsigned char* rec = L + RCH_RING + (cs % RCH_NSLOT) * RC_REC;
            const u32x4 z4 = (u32x4){0u, 0u, 0u, 0u}; const int f2 = fq & 1;
            bf16x8 sb[2];
#pragma unroll
            for (int ks = 0; ks < 2; ++ks) { u32x4 pk; pk.x = pk2(acc[2 * ks][0], acc[2 * ks][1]); pk.y = pk2(acc[2 * ks][2], acc[2 * ks][3]); pk.z = pk2(acc[2 * ks + 1][0], acc[2 * ks + 1][1]); pk.w = pk2(acc[2 * ks + 1][2], acc[2 * ks + 1][3]); sb[ks] = __builtin_bit_cast(bf16x8, pk); }
            f32x4 rhs = (f32x4){0.f, 0.f, 0.f, 0.f}, y1 = rhs;
#pragma unroll
            for (int ks = 0; ks < 2; ++ks) { rhs = MFMA16(*(const LAS bf16x8*)(rec + RC_KR + fr * 128 + ks * 64 + fq * 16), sb[ks], rhs); y1 = MFMA16(*(const LAS bf16x8*)(rec + RC_KR + 2048 + fr * 128 + ks * 64 + fq * 16), sb[ks], y1); }
            u32x4 vt8 = *(const LAS u32x4*)(rec + RC_VT + v * 32 + f2 * 16), mkb = *(const LAS u32x4*)(rec + RC_MKB + fr * 32 + f2 * 16), mkr = *(const LAS u32x4*)(rec + RC_MKR + fr * 32 + f2 * 16), mbr = *(const LAS u32x4*)(rec + RC_MBR + fr * 32 + f2 * 16);
            if (fq >= 2) { vt8 = z4; mkb = z4; mkr = z4; mbr = z4; }
            rhs = MFMA16(__builtin_bit_cast(bf16x8, mkb), __builtin_bit_cast(bf16x8, vt8), rhs);
            y1 = MFMA16(__builtin_bit_cast(bf16x8, mkr), __builtin_bit_cast(bf16x8, vt8), y1);
            f32x4 u4;
            { u32x4 rb; rb.x = pk2(rhs[0], rhs[1]); rb.y = pk2(rhs[2], rhs[3]); rb.z = 0u; rb.w = 0u;
              const f32x4 zf = {0.f, 0.f, 0.f, 0.f}; u4 = MFMA16(*(const LAS bf16x8*)(rec + RC_MBB + fr * 64 + fq * 16), __builtin_bit_cast(bf16x8, rb), zf); }
            *(LAS f32x4*)(XT + fr * 16 + 4 * fq) = u4;
            asm volatile("s_waitcnt lgkmcnt(0)" ::: "memory");
            u32x4 ub;
            { const f32x4 ua = *(const LAS f32x4*)(XT + fr * 16 + 8 * f2), ubb = *(const LAS f32x4*)(XT + fr * 16 + 8 * f2 + 4);
              ub.x = pk2(ua[0], ua[1]); ub.y = pk2(ua[2], ua[3]); ub.z = pk2(ubb[0], ubb[1]); ub.w = pk2(ubb[2], ubb[3]); if (fq >= 2) ub = z4; }
            f32x4 yv = (f32x4){0.f, 0.f, 0.f, 0.f};
            yv = MFMA16(__builtin_bit_cast(bf16x8, mbr), __builtin_bit_cast(bf16x8, ub), yv);
            const f32x4 y = y1 - yv;
            u32x4 uvb; const u32x2 vt4 = *(const LAS u32x2*)(rec + RC_VT + v * 32 + fq * 8);
            uvb.x = pk2(u4[0], u4[1]); uvb.y = pk2(u4[2], u4[3]);
            uvb.z = vt4.x; uvb.w = vt4.y;
#pragma unroll
            for (int mt = 0; mt < 4; ++mt) { const f32x4 wl = *(const LAS f32x4*)(rec + RC_WL + (16 * mt + 4 * fq) * 4);
                acc[mt] = MFMA16(*(const LAS bf16x8*)(rec + RC_BKT + (16 * mt + fr) * 64 + fq * 16), __builtin_bit_cast(bf16x8, uvb), acc[mt] * wl); }
            float pgv[4], pbv[4];
#pragma unroll
            for (int r = 0; r < 4; ++r) { pgv[r] = bf2f(*(const LAS bf16_t*)(rec + RC_PG + (4 * fq + r) * 128 + v * 2)); pbv[r] = bf2f(*(const LAS bf16_t*)(rec + RC_PBV + (4 * fq + r) * 128 + v * 2)); }
            LAS float* st = STT + (cs & 1) * 128;
#pragma unroll
            for (int r = 0; r < 4; ++r) { const float s1 = red16_dpp(y[r]), s2 = red16_dpp(y[r] * y[r]); if (fr == 0) { st[(w * 16 + 4 * fq + r) * 2] = s1; st[(w * 16 + 4 * fq + r) * 2 + 1] = s2; } }
            RCH_BAR();
#pragma unroll
            for (int r = 0; r < 4; ++r) { const int t = 4 * fq + r; float s1 = 0.f, s2 = 0.f;
#pragma unroll
                for (int ww = 0; ww < 4; ++ww) { const f32x2 sv = *(const LAS f32x2*)(st + (ww * 16 + t) * 2); s1 += sv[0]; s2 += sv[1]; }
                const float mean = s1 * (1.f / 64.f), var = fmaxf(s2 * (1.f / 64.f) - mean * mean, 0.f);
                const float o = ((y[r] - mean) * rsqrtf(var + RWKV_LN_EPS) * lnw + lnb + pbv[r]) * pgv[r];
                if (!dry) OAB[(mb + (size_t)(sg * RC_SEG_CHUNKS + cs) * 16 + t) * 1024 + 512 + hc] = (bf16_t)f2bf(o); }
        }
#pragma unroll
        for (int mt = 0; mt < 4; ++mt) if (!dry) STATE[((size_t)bh * 4 + w) * 256 + mt * 64 + lane] = acc[mt];
    }
    __syncthreads();
}

__device__ __forceinline__ void rwkvc_build_images(const Frame& F, const Args& a) {
    const int gt = F.bid * NTHREADS + F.tid, NT = F.G * NTHREADS;
    for (int e = gt; e < 8 * 256 * 64; e += NT) {
        const int c = e & 63, jj = (e >> 6) & 255, h = e >> 14;
        unsigned char* img = F.ws + WS_RIMG + (size_t)h * 35840;
        if (jj < 64) *(bf16_t*)(img + RW_W2T + c * 144 + jj * 2) = (bf16_t)f2bf(a.in[IN_RW2][jj * 512 + h * 64 + c]);
        else if (jj < 128) *(bf16_t*)(img + RW_A2T + c * 144 + (jj - 64) * 2) = (bf16_t)f2bf(a.in[IN_RA2][(jj - 64) * 512 + h * 64 + c]);
        else *(bf16_t*)(img + RW_G2T + c * 272 + (jj - 128) * 2) = (bf16_t)f2bf(a.in[IN_RG2][(jj - 128) * 512 + h * 64 + c]);
    }
}
template <bool RES_BF16, bool OUT_BF16>
__device__ __forceinline__ void row_pass(const Frame& F, const bf16_t* mix, const void* resid_, const float* w_post, void* hout_, const float* w_next, bf16_t* xn) {
    const int gw = F.bid * NWAVES + F.wave, NGW = F.G * NWAVES, lane = F.lane;
    for (int mA = gw; mA < MTOK; mA += 2 * NGW) {
        const int mB = (mA + NGW < MTOK) ? mA + NGW : mA; const bool two = (mB != mA);
        const u32x2* mrA = (const u32x2*)(mix + (size_t)mA * D_MODEL) + lane; const u32x2* mrB = (const u32x2*)(mix + (size_t)mB * D_MODEL) + lane;
        u32x2 pa[4], pb[4]; f32x4 ha[4], hb[4];
#pragma unroll
        for (int j = 0; j < 4; ++j) { pa[j] = mrA[64 * j]; pb[j] = mrB[64 * j]; }
        if (RES_BF16) {
            const u32x2* rA = (const u32x2*)((const bf16_t*)resid_ + (size_t)mA * D_MODEL) + lane; const u32x2* rB = (const u32x2*)((const bf16_t*)resid_ + (size_t)mB * D_MODEL) + lane;
#pragma unroll
            for (int j = 0; j < 4; ++j) { const u32x2 qa = rA[64 * j], qb = rB[64 * j]; ha[j] = (f32x4){bflo(qa.x), bfhi(qa.x), bflo(qa.y), bfhi(qa.y)}; hb[j] = (f32x4){bflo(qb.x), bfhi(qb.x), bflo(qb.y), bfhi(qb.y)}; }
        } else {
            const f32x4* rA = (const f32x4*)((const float*)resid_ + (size_t)mA * D_MODEL) + lane; const f32x4* rB = (const f32x4*)((const float*)resid_ + (size_t)mB * D_MODEL) + lane;
#pragma unroll
            for (int j = 0; j < 4; ++j) { ha[j] = rA[64 * j]; hb[j] = rB[64 * j]; }
        }
        f32x4 va[4], vb[4]; float sa = 0.f, sb = 0.f;
#pragma unroll
        for (int j = 0; j < 4; ++j) { va[j] = (f32x4){bflo(pa[j].x), bfhi(pa[j].x), bflo(pa[j].y), bfhi(pa[j].y)}; vb[j] = (f32x4){bflo(pb[j].x), bfhi(pb[j].x), bflo(pb[j].y), bfhi(pb[j].y)};
            sa += (va[j].x * va[j].x + va[j].y * va[j].y) + (va[j].z * va[j].z + va[j].w * va[j].w); sb += (vb[j].x * vb[j].x + vb[j].y * vb[j].y) + (vb[j].z * vb[j].z + vb[j].w * vb[j].w); }
        const float ra = 1.f / sqrtf(wave_sum(sa) * (1.f / D_MODEL) + NORM_EPS), rb = 1.f / sqrtf(wave_sum(sb) * (1.f / D_MODEL) + NORM_EPS);
        float s2a = 0.f, s2b = 0.f;
#pragma unroll
        for (int j = 0; j < 4; ++j) { const f32x4 g = ((const f32x4*)w_post)[lane + 64 * j]; ha[j] = ha[j] + va[j] * ra * g; hb[j] = hb[j] + vb[j] * rb * g;
            s2a += (ha[j].x * ha[j].x + ha[j].y * ha[j].y) + (ha[j].z * ha[j].z + ha[j].w * ha[j].w); s2b += (hb[j].x * hb[j].x + hb[j].y * hb[j].y) + (hb[j].z * hb[j].z + hb[j].w * hb[j].w); }
        if (OUT_BF16) {
            u32x2* hoA = (u32x2*)((bf16_t*)hout_ + (size_t)mA * D_MODEL) + lane; u32x2* hoB = (u32x2*)((bf16_t*)hout_ + (size_t)mB * D_MODEL) + lane;
#pragma unroll
            for (int j = 0; j < 4; ++j) { u32x2 o; o.x = pk2(ha[j].x, ha[j].y); o.y = pk2(ha[j].z, ha[j].w); hoA[64 * j] = o; if (two) { o.x = pk2(hb[j].x, hb[j].y); o.y = pk2(hb[j].z, hb[j].w); hoB[64 * j] = o; } }
        } else {
            f32x4* hoA = (f32x4*)((float*)hout_ + (size_t)mA * D_MODEL) + lane; f32x4* hoB = (f32x4*)((float*)hout_ + (size_t)mB * D_MODEL) + lane;
#pragma unroll
            for (int j = 0; j < 4; ++j) { hoA[64 * j] = ha[j]; if (two) hoB[64 * j] = hb[j]; }
        }
        if (w_next) {
            const float qa = 1.f / sqrtf(wave_sum(s2a) * (1.f / D_MODEL) + NORM_EPS), qb = 1.f / sqrtf(wave_sum(s2b) * (1.f / D_MODEL) + NORM_EPS);
            unsigned long long* oA = (unsigned long long*)(xn + (size_t)mA * D_MODEL) + lane; unsigned long long* oB = (unsigned long long*)(xn + (size_t)mB * D_MODEL) + lane;
#pragma unroll
            for (int j = 0; j < 4; ++j) { const f32x4 g = ((const f32x4*)w_next)[lane + 64 * j];
                oA[64 * j] = (unsigned long long)pk2(ha[j].x * qa * g.x, ha[j].y * qa * g.y) | ((unsigned long long)pk2(ha[j].z * qa * g.z, ha[j].w * qa * g.w) << 32);
                if (two) oB[64 * j] = (unsigned long long)pk2(hb[j].x * qb * g.x, hb[j].y * qb * g.y) | ((unsigned long long)pk2(hb[j].z * qb * g.z, hb[j].w * qb * g.w) << 32); }
        }
    }
}
constexpr size_t B1_ACMPK = 128 * MiB, B1_ACMPV = 144 * MiB, B1_KS = 160 * MiB, B1_VST = 168 * MiB, B1_KW = 176 * MiB, B1_VWT = 184 * MiB, B1_QR = 192 * MiB;
constexpr size_t R2_HCMP = 0, R2_KC = 8 * MiB, R2_VCT = 9 * MiB, R2_SEL = 12 * MiB;
__device__ __constant__ float ROPE_INVF[8] = {1.0f, 0.1939227432012558f, 0.03760603070259094f, 0.007292664609849453f, 0.0014142135623842478f, 0.00027424818836152554f, 5.3182957344688475e-05f, 1.0313385246263351e-05f};

__device__ __forceinline__ void nsa_prep_phase(const Frame& F, const Args& a) {
    const bf16_t* F1 = (const bf16_t*)(F.ws + WS_BIG);
    bf16_t* ACMPK = (bf16_t*)(F.ws + WS_BIG + B1_ACMPK); bf16_t* ACMPV = (bf16_t*)(F.ws + WS_BIG + B1_ACMPV);
    bf16_t* KS = (bf16_t*)(F.ws + WS_BIG + B1_KS); bf16_t* VST = (bf16_t*)(F.ws + WS_BIG + B1_VST); bf16_t* KW = (bf16_t*)(F.ws + WS_BIG + B1_KW); bf16_t* VWT = (bf16_t*)(F.ws + WS_BIG + B1_VWT);
    bf16_t* QR = (bf16_t*)(F.ws + WS_BIG + B1_QR);
    const int* pos = (const int*)a.in[IN_POS];
    const int lane = F.lane, wave = F.wave, tid = F.tid;
    LAS unsigned char* Lvs = F.lds;
    LAS unsigned char* Lvw = F.lds + 16384;
    for (int u = F.bid; u < BATCH * 64; u += F.G) {
        const int b = u >> 6, blk = u & 63;
#pragma unroll 1
        for (int tt = 0; tt < 8; ++tt) {
            const int tl = 8 * wave + tt, t = blk * 64 + tl; const size_t m = (size_t)b * SEQ + t;
            const float p = (float)pos[m];
            const float ang = p * ROPE_INVF[lane & 7];
            const float cs = __cosf(ang), sn = __sinf(ang);
            const bf16_t* row = F1 + m * F1_LD;
            { const int hh = lane >> 2, qd = lane & 3; const u32x4 v0 = *(const u32x4*)(row + hh * 64 + qd * 16), v1 = *(const u32x4*)(row + hh * 64 + qd * 16 + 8);
              u32x4 o0 = v0, o1 = v1;
              float x1[8], x2[8], c8[8], s8[8];
#pragma unroll
              for (int i = 0; i < 8; ++i) { c8[i] = __shfl(cs, i); s8[i] = __shfl(sn, i); }
              if (qd == 0) {
                  x1[0] = bflo(v0.x); x1[1] = bfhi(v0.x); x1[2] = bflo(v0.y); x1[3] = bfhi(v0.y); x1[4] = bflo(v0.z); x1[5] = bfhi(v0.z); x1[6] = bflo(v0.w); x1[7] = bfhi(v0.w);
                  x2[0] = bflo(v1.x); x2[1] = bfhi(v1.x); x2[2] = bflo(v1.y); x2[3] = bfhi(v1.y); x2[4] = bflo(v1.z); x2[5] = bfhi(v1.z); x2[6] = bflo(v1.w); x2[7] = bfhi(v1.w);
                  float y1[8], y2[8];
#pragma unroll
                  for (int i = 0; i < 8; ++i) { y1[i] = x1[i] * c8[i] - x2[i] * s8[i]; y2[i] = x2[i] * c8[i] + x1[i] * s8[i]; }
                  o0.x = pk2(y1[0], y1[1]); o0.y = pk2(y1[2], y1[3]); o0.z = pk2(y1[4], y1[5]); o0.w = pk2(y1[6], y1[7]);
                  o1.x = pk2(y2[0], y2[1]); o1.y = pk2(y2[2], y2[3]); o1.z = pk2(y2[4], y2[5]); o1.w = pk2(y2[6], y2[7]); }
              *(u32x4*)(QR + m * 1024 + hh * 64 + qd * 16) = o0; *(u32x4*)(QR + m * 1024 + hh * 64 + qd * 16 + 8) = o1;
            }
            const int g = lane >> 5, d = 2 * (lane & 31); const int bg = b * 2 + g;
            const unsigned kc = *(const unsigned*)(row + 1024 + 0 * 128 + g * 64 + d), vc = *(const unsigned*)(row + 1024 + 1 * 128 + g * 64 + d);
            unsigned ks = *(const unsigned*)(row + 1024 + 2 * 128 + g * 64 + d); const unsigned vs = *(const unsigned*)(row + 1024 + 3 * 128 + g * 64 + d);
            unsigned kw = *(const unsigned*)(row + 1024 + 4 * 128 + g * 64 + d); const unsigned vw = *(const unsigned*)(row + 1024 + 5 * 128 + g * 64 + d);
            {
              const int l5 = lane & 31; const bool x1role = l5 < 4; const int i0 = 2 * (l5 & 3);
              const float c0 = __shfl(cs, i0), c1 = __shfl(cs, i0 + 1), s0 = __shfl(sn, i0), s1 = __shfl(sn, i0 + 1);
              const unsigned oks = __shfl_xor(ks, 4), okw = __shfl_xor(kw, 4);
              if (l5 < 8) { const float sg = x1role ? -1.f : 1.f;
                  ks = pk2(bflo(ks) * c0 + sg * bflo(oks) * s0, bfhi(ks) * c1 + sg * bfhi(oks) * s1);
                  kw = pk2(bflo(kw) * c0 + sg * bflo(okw) * s0, bfhi(kw) * c1 + sg * bfhi(okw) * s1); } }
            *(unsigned*)(KS + ((size_t)bg * SEQ + t) * 64 + d) = ks; *(unsigned*)(KW + ((size_t)bg * SEQ + t) * 64 + d) = kw;
            *(LAS unsigned*)(Lvs + tl * 256 + lane * 4) = vs; *(LAS unsigned*)(Lvw + tl * 256 + lane * 4) = vw;
            {
              const int i0 = t >> 4, s0 = t & 15;
              const float* pek = a.in[IN_NPEK]; const float* pev = a.in[IN_NPEV];
              if (i0 < 255) { *(unsigned*)(ACMPK + ((size_t)bg * 256 + i0) * 2048 + s0 * 64 + d) = pk2(bflo(kc) + pek[s0 * 64 + d], bfhi(kc) + pek[s0 * 64 + d + 1]);
                              *(unsigned*)(ACMPV + ((size_t)bg * 256 + i0) * 2048 + s0 * 64 + d) = pk2(bflo(vc) + pev[s0 * 64 + d], bfhi(vc) + pev[s0 * 64 + d + 1]); }
              if (i0 >= 1) { const int s1 = 16 + s0;
                              *(unsigned*)(ACMPK + ((size_t)bg * 256 + i0 - 1) * 2048 + s1 * 64 + d) = pk2(bflo(kc) + pek[s1 * 64 + d], bfhi(kc) + pek[s1 * 64 + d + 1]);
                              *(unsigned*)(ACMPV + ((size_t)bg * 256 + i0 - 1) * 2048 + s1 * 64 + d) = pk2(bflo(vc) + pev[s1 * 64 + d], bfhi(vc) + pev[s1 * 64 + d + 1]); }
            }
        }
        if (blk == 63) {
            for (int i = tid; i < 2 * 2048 / 8; i += NTHREADS) { const int g = i >> 8, o = (i & 255) * 8;
                *(u32x4*)(ACMPK + ((size_t)(b * 2 + g) * 256 + 255) * 2048 + o) = (u32x4){0u, 0u, 0u, 0u}; *(u32x4*)(ACMPV + ((size_t)(b * 2 + g) * 256 + 255) * 2048 + o) = (u32x4){0u, 0u, 0u, 0u}; }
        }
        __syncthreads();
        if (tid < 256) { const int which = tid >> 7, gd = tid & 127, g = gd >> 6, d = gd & 63; LAS unsigned char* Lv = which ? Lvw : Lvs;
            bf16_t* dst = (which ? VWT : VST) + (((size_t)(b * 2 + g) * 64 + blk) * 64 + d) * 64;
#pragma unroll
            for (int q8 = 0; q8 < 8; ++q8) { unsigned short e[8];
#pragma unroll
                for (int k = 0; k < 8; ++k) e[k] = *(const LAS bf16_t*)(Lv + (8 * q8 + k) * 256 + gd * 2);
                u32x4 o; o.x = e[0] | ((unsigned)e[1] << 16); o.y = e[2] | ((unsigned)e[3] << 16); o.z = e[4] | ((unsigned)e[5] << 16); o.w = e[6] | ((unsigned)e[7] << 16);
                *(u32x4*)(dst + 8 * q8) = o; } }
        __syncthreads();
    }
}

constexpr int C1_PITCH = 528, C1_HALF = 64 * C1_PITCH, C1_BUF = 2 * C1_HALF;
static_assert(2 * C1_BUF <= XB_LDS_OFF && 8 * 16 * 64 * 16 <= XB_LDS_OFF, "cmp1 lds");
__device__ __forceinline__ void nsa_cmp1_phase(const Frame& F, const Args& a) {
    bf16_t* HC = (bf16_t*)((unsigned char*)a.out + R2_HCMP);
    const int lane = F.lane, fr = lane & 15, fq = lane >> 4, w = F.wave, tid = F.tid;
    LAS unsigned char* L = F.lds;
    LAS f32x4* PART = (LAS f32x4*)F.lds;
    for (int it = F.bid; it < 512; it += F.G) {
        const int which = it >> 8, j_ = (it & 255) >> 3, nt64 = j_ & 3, mt64 = (j_ >> 2) * 8 + (it & 7);
        const unsigned char* Ab = (const unsigned char*)(F.ws + WS_BIG + (which ? B1_ACMPV : B1_ACMPK)) + (size_t)(64 * mt64) * 4096;
        const unsigned char* Wb = (const unsigned char*)(F.ws + (which ? WS_W_C1V : WS_W_C1K)) + (size_t)(64 * nt64) * 4096;
        u32x4 st[8];
#define C1_FETCH(c_) do { _Pragma("unroll") for (int i_ = 0; i_ < 8; ++i_) { const int e_ = tid + 512 * i_; \
            st[i_] = *(const u32x4*)(((e_ >> 11) ? Wb : Ab) + (size_t)((e_ >> 5) & 63) * 4096 + (c_) * 512 + (e_ & 31) * 16); } } while (0)
#define C1_STORE(b_) do { _Pragma("unroll") for (int i_ = 0; i_ < 8; ++i_) { const int e_ = tid + 512 * i_; \
            *(LAS u32x4*)(L + (b_) * C1_BUF + (e_ >> 11) * C1_HALF + ((e_ >> 5) & 63) * C1_PITCH + (e_ & 31) * 16) = st[i_]; } } while (0)
        f32x4 acc[4][4];
#pragma unroll
        for (int nt = 0; nt < 4; ++nt)
#pragma unroll
            for (int mt = 0; mt < 4; ++mt) acc[nt][mt] = (f32x4){0.f, 0.f, 0.f, 0.f};
        C1_FETCH(0);
        __syncthreads();
        C1_STORE(0);
        __syncthreads();
#pragma unroll 1
        for (int c = 0; c < 8; ++c) {
            if (c < 7) C1_FETCH(c + 1);
            const LAS unsigned char* B = L + (c & 1) * C1_BUF + 64 * w + 16 * fq;
            bf16x8 af[4], wf[4];
#pragma unroll
            for (int t = 0; t < 4; ++t) { af[t] = *(const LAS bf16x8*)(B + (16 * t + fr) * C1_PITCH); wf[t] = *(const LAS bf16x8*)(B + C1_HALF + (16 * t + fr) * C1_PITCH); }
#pragma unroll
            for (int nt = 0; nt < 4; ++nt)
#pragma unroll
                for (int mt = 0; mt < 4; ++mt) acc[nt][mt] = MFMA16(wf[nt], af[mt], acc[nt][mt]);
            if (c < 7) C1_STORE((c + 1) & 1);
            __syncthreads();
        }
#undef C1_FETCH
#undef C1_STORE
#pragma unroll
        for (int nt = 0; nt < 4; ++nt)
#pragma unroll
            for (int mt = 0; mt < 4; ++mt) PART[(w * 16 + nt * 4 + mt) * 64 + lane] = acc[nt][mt];
        __syncthreads();
#pragma unroll
        for (int q = 0; q < 2; ++q) {
            const int tl = 2 * w + q, nt = tl >> 2, mt = tl & 3;
            f32x4 s = PART[tl * 64 + lane];
#pragma unroll
            for (int ww = 1; ww < 8; ++ww) s += PART[(ww * 16 + tl) * 64 + lane];
            u32x2 o; o.x = pk2(siluf_(s[0]), siluf_(s[1])); o.y = pk2(siluf_(s[2]), siluf_(s[3]));
            *(u32x2*)(HC + ((size_t)which * 4096 + 64 * mt64 + 16 * mt + fr) * 256 + 64 * nt64 + 16 * nt + 4 * fq) = o;
        }
    }
}
__device__ __forceinline__ void nsa_cmp2_phase(const Frame& F, const Args& a) {
    const bf16_t* HC = (const bf16_t*)((unsigned char*)a.out + R2_HCMP); bf16_t* KC = (bf16_t*)((unsigned char*)a.out + R2_KC); bf16_t* VCT = (bf16_t*)((unsigned char*)a.out + R2_VCT);
    const int* pos = (const int*)a.in[IN_POS];
    const int gw = F.bid * NWAVES + F.wave, NGW = F.G * NWAVES, lane = F.lane, fr = lane & 15, fq = lane >> 4;
    for (int it = gw; it < 512; it += NGW) {
        const int which = it >> 8, rt = it & 255;
        const bf16_t* A = HC + ((size_t)which * 4096 + 16 * rt) * 256; const bf16_t* Bt = (const bf16_t*)(F.ws + (which ? WS_W_C2V : WS_W_C2K));
        f32x4 c[4];
#pragma unroll
        for (int nt = 0; nt < 4; ++nt) c[nt] = (f32x4){0.f, 0.f, 0.f, 0.f};
#pragma unroll
        for (int ks = 0; ks < 8; ++ks) { const bf16x8 af = *(const bf16x8*)(A + fr * 256 + 32 * ks + 8 * fq);
#pragma unroll
            for (int nt = 0; nt < 4; ++nt) { const bf16x8 bf = *(const bf16x8*)(Bt + (16 * nt + fr) * 256 + 32 * ks + 8 * fq); c[nt] = MFMA16(af, bf, c[nt]); } }
        const int bg = rt >> 4, b = bg >> 1;
        if (which == 0) {
#pragma unroll
            for (int r = 0; r < 4; ++r) { const int i = (16 * rt + 4 * fq + r) & 255; int pi = 31 + 16 * i; if (pi > SEQ - 1) pi = SEQ - 1;
                const float ang = (float)pos[(size_t)b * SEQ + pi] * ROPE_INVF[fr & 7]; const float cs = __cosf(ang), sn = __sinf(ang);
                const float own = c[0][r], oth = __shfl_xor(own, 8);
                c[0][r] = (fr < 8) ? own * cs - oth * sn : own * cs + oth * sn;
#pragma unroll
                for (int nt = 0; nt < 4; ++nt) KC[((size_t)bg * 256 + i) * 64 + 16 * nt + fr] = (bf16_t)f2bf(c[nt][r]); }
        } else {
            const int i0 = (16 * rt + 4 * fq) & 255;
#pragma unroll
            for (int nt = 0; nt < 4; ++nt) { u32x2 p; p.x = pk2(c[nt][0], c[nt][1]); p.y = pk2(c[nt][2], c[nt][3]); *(u32x2*)(VCT + ((size_t)bg * 64 + 16 * nt + fr) * 256 + i0) = p; }
        }
    }
}
constexpr int CA_KC = 0, CA_KC_PITCH = 144;
constexpr int CA_VT = 36864, CA_VT_PITCH = 528;
__device__ __forceinline__ void nsa_cmp_attn_phase(const Frame& F, const Args& a) {
    const bf16_t* F1 = (const bf16_t*)(F.ws + WS_BIG); const bf16_t* QR = (const bf16_t*)(F.ws + WS_BIG + B1_QR);
    const bf16_t* KC = (const bf16_t*)((unsigned char*)a.out + R2_KC); const bf16_t* VCT = (const bf16_t*)((unsigned char*)a.out + R2_VCT);
    unsigned long long* SEL = (unsigned long long*)((unsigned char*)a.out + R2_SEL); bf16_t* ONSA = (bf16_t*)(F.ws + WS_XN);
    const int lane = F.lane, wave = F.wave, tid = F.tid, fr = lane & 15, fq = lane >> 4;
    LAS unsigned char* L = F.lds;
    for (int bgk = F.bid; bgk < 256; bgk += F.G) {
        const int bg = bgk & 15, kq = bgk >> 4, b = bg >> 1, g = bg & 1;
        __syncthreads();
        for (int i = tid; i < 256 * 8; i += NTHREADS) { const int key = i >> 3, ch = i & 7; *(LAS u32x4*)(L + CA_KC + key * CA_KC_PITCH + ch * 16) = *(const u32x4*)(KC + ((size_t)bg * 256 + key) * 64 + ch * 8); }
        for (int i = tid; i < 64 * 32; i += NTHREADS) { const int d = i >> 5, ch = i & 31; *(LAS u32x4*)(L + CA_VT + d * CA_VT_PITCH + ch * 16) = *(const u32x4*)(VCT + ((size_t)bg * 64 + d) * 256 + ch * 8); }
        __syncthreads();
#pragma unroll 1
        for (int rep = 0; rep < 2; ++rep) {
            const int idx = wave * 16 + kq; const int tt = rep == 0 ? idx : 255 - idx;
            const int t0 = 16 * tt, t = t0 + fr; const size_t m = (size_t)b * SEQ + t;
            const int nk = tt;
            const int nkt = (nk + 15) >> 4;
            float iaA[16], iaB[16];
#pragma unroll
            for (int kt = 0; kt < 16; ++kt) { iaA[kt] = 0.f; iaB[kt] = 0.f; }
#pragma unroll 1
            for (int hh = 0; hh < 8; ++hh) {
                const int H = g * 8 + hh;
                const bf16x8 q0 = *(const bf16x8*)(QR + m * 1024 + H * 64 + 8 * fq), q1 = *(const bf16x8*)(QR + m * 1024 + H * 64 + 32 + 8 * fq);
                float mrun = -INFINITY, lrun = 0.f;
#pragma unroll 1
                for (int kt = 0; kt < nkt; ++kt) {
                    const bf16x8 k0 = *(const LAS bf16x8*)(L + CA_KC + (16 * kt + fr) * CA_KC_PITCH + 16 * fq), k1 = *(const LAS bf16x8*)(L + CA_KC + (16 * kt + fr) * CA_KC_PITCH + 64 + 16 * fq);
                    f32x4 sv = (f32x4){0.f, 0.f, 0.f, 0.f}; sv = MFMA16(k0, q0, sv); sv = MFMA16(k1, q1, sv);
                    float tm = -INFINITY;
#pragma unroll
                    for (int r = 0; r < 4; ++r) { const int key = 16 * kt + 4 * fq + r; const bool vis = (16 * key + 31) <= t; sv[r] = vis ? sv[r] * 0.125f : -INFINITY; tm = fmaxf(tm, sv[r]); }
                    const float mn = fmaxf(mrun, tm);
                    if (mn != -INFINITY) { float add = 0.f;
#pragma unroll
                        for (int r = 0; r < 4; ++r) add += (sv[r] == -INFINITY) ? 0.f : __expf(sv[r] - mn);
                        lrun = lrun * ((mrun == -INFINITY) ? 0.f : __expf(mrun - mn)) + add; mrun = mn; }
                }
                float mx = fmaxf(mrun, __shfl_xor(mrun, 16)); mx = fmaxf(mx, __shfl_xor(mx, 32));
                const float mref = (mx == -INFINITY) ? 0.f : mx;
                float sum = (mrun == -INFINITY) ? 0.f : lrun * __expf(mrun - mref);
                sum += __shfl_xor(sum, 16); sum += __shfl_xor(sum, 32);
                const float inv = frcp(fmaxf(sum, 1e-30f));
                f32x4 o[4];
#pragma unroll
                for (int dt = 0; dt < 4; ++dt) o[dt] = (f32x4){0.f, 0.f, 0.f, 0.f};
#pragma unroll
                for (int ks = 0; ks < 8; ++ks) if (2 * ks < nkt) {
                    float p[8];
#pragma unroll
                    for (int half = 0; half < 2; ++half) { const int kt = 2 * ks + half;
                        const bf16x8 k0 = *(const LAS bf16x8*)(L + CA_KC + (16 * kt + fr) * CA_KC_PITCH + 16 * fq), k1 = *(const LAS bf16x8*)(L + CA_KC + (16 * kt + fr) * CA_KC_PITCH + 64 + 16 * fq);
                        f32x4 sv = (f32x4){0.f, 0.f, 0.f, 0.f}; sv = MFMA16(k0, q0, sv); sv = MFMA16(k1, q1, sv);
#pragma unroll
                        for (int r = 0; r < 4; ++r) { const int key = 16 * kt + 4 * fq + r; const bool vis = (16 * key + 31) <= t; p[4 * half + r] = vis ? __expf(sv[r] * 0.125f - mref) * inv : 0.f; } }
                    iaA[2 * ks] += (p[0] + p[1]) + (p[2] + 0.5f * p[3]); iaB[2 * ks] += p[3]; iaA[2 * ks + 1] += (p[4] + p[5]) + (p[6] + 0.5f * p[7]); iaB[2 * ks + 1] += p[7];
                    u32x4 pw; pw.x = pk2(p[0], p[1]); pw.y = pk2(p[2], p[3]); pw.z = pk2(p[4], p[5]); pw.w = pk2(p[6], p[7]);
                    const bf16x8 pb = __builtin_bit_cast(bf16x8, pw);
#pragma unroll
                    for (int dt = 0; dt < 4; ++dt) { const u32x2 v0 = *(const LAS u32x2*)(L + CA_VT + (16 * dt + fr) * CA_VT_PITCH + (32 * ks + 4 * fq) * 2), v1 = *(const LAS u32x2*)(L + CA_VT + (16 * dt + fr) * CA_VT_PITCH + (32 * ks + 16 + 4 * fq) * 2);
                        u32x4 vw; vw.x = v0.x; vw.y = v0.y; vw.z = v1.x; vw.w = v1.y; o[dt] = MFMA16(__builtin_bit_cast(bf16x8, vw), pb, o[dt]); }
                    __builtin_amdgcn_sched_barrier(0); }
                const float gate = sigmoidf_(bf2f(F1[m * F1_LD + 1792 + H * 3 + 0]));
#pragma unroll
                for (int dt = 0; dt < 4; ++dt) { u32x2 w; w.x = pk2(o[dt][0] * gate, o[dt][1] * gate); w.y = pk2(o[dt][2] * gate, o[dt][3] * gate); *(u32x2*)(ONSA + m * 1024 + H * 64 + 16 * dt + 4 * fq) = w; }
            }
            float imp[16];
#pragma unroll
            for (int kt = 0; kt < 16; ++kt) { const float up = __shfl(iaB[kt], (lane + 48) & 63); imp[kt] = up; }
            { float carry = 0.f;
#pragma unroll
              for (int kt = 0; kt < 16; ++kt) { const float prev3 = (fq == 0) ? carry : imp[kt]; carry = imp[kt]; imp[kt] = 0.5f * prev3 + iaA[kt]; } }
            const int cur = t >> 6;
            unsigned long long mask = 0ull;
            if (t0 < 1024) {
#pragma unroll
                for (int kt = 0; kt < 16; ++kt) { const int j = 4 * kt + fq; if (j <= cur) mask |= 1ull << j; }
            } else {
                float cv[16];
#pragma unroll
                for (int kt = 0; kt < 16; ++kt) { const int j = 4 * kt + fq; const bool forced = (j == 0) || (j == cur) || (j == cur - 1); cv[kt] = (j <= cur && !forced) ? imp[kt] : -INFINITY; }
                int rank[16];
#pragma unroll
                for (int kt = 0; kt < 16; ++kt) rank[kt] = 0;
#pragma unroll 1
                for (int f2 = 0; f2 < 4; ++f2) {
#pragma unroll
                    for (int k2 = 0; k2 < 16; ++k2) { const float ov = __shfl(cv[k2], fr + 16 * f2); const int j2 = 4 * k2 + f2;
#pragma unroll
                        for (int kt = 0; kt < 16; ++kt) { const int j = 4 * kt + fq; rank[kt] += (ov > cv[kt] || (ov == cv[kt] && j2 < j)) ? 1 : 0; } } }
#pragma unroll
                for (int kt = 0; kt < 16; ++kt) { const int j = 4 * kt + fq; const bool forced = (j == 0) || (j == cur) || (j == cur - 1);
                    if (forced || (cv[kt] != -INFINITY && rank[kt] < SEL_TOPN - 3)) mask |= 1ull << j; }
            }
            { unsigned lo = (unsigned)mask, hi = (unsigned)(mask >> 32);
              lo |= __shfl_xor(lo, 16); hi |= __shfl_xor(hi, 16); lo |= __shfl_xor(lo, 32); hi |= __shfl_xor(hi, 32);
              if (fq == 0) SEL[(size_t)bg * SEQ + t] = ((unsigned long long)hi << 32) | lo; }
        }
    }
}

constexpr int SA_K = 0, SA_V = 8192, SA_BUF = 16384, SA_NS = 8, SA_GB = 4;
#define SA_BAR() do { asm volatile("s_waitcnt lgkmcnt(0)" ::: "memory"); __builtin_amdgcn_s_barrier(); asm volatile("" ::: "memory"); } while (0)
__device__ __forceinline__ float xfq_max(float v) {
    unsigned vi = __builtin_bit_cast(unsigned, v);
    auto r = __builtin_amdgcn_permlane16_swap(vi, vi, false, false);
    const unsigned a0 = r[0], a1 = r[1];
    v = fmaxf(__builtin_bit_cast(float, a0), __builtin_bit_cast(float, a1));
    vi = __builtin_bit_cast(unsigned, v);
    auto r2 = __builtin_amdgcn_permlane32_swap(vi, vi, false, false);
    const unsigned b0 = r2[0], b1 = r2[1];
    return fmaxf(__builtin_bit_cast(float, b0), __builtin_bit_cast(float, b1));
}
template <int MODE  >
__device__ __forceinline__ void nsa_attn_pass(const Frame& F, const bf16_t* Kg, const bf16_t* Vtg, const bf16x8 (&qf)[2][2], const unsigned long long (&selm)[2], int tq[2], int bg, int qb, f32x4 (&outacc)[2][4], const float (&gate)[2]) {
    const int lane = F.lane, tid = F.tid, fr = lane & 15, fq = lane >> 4;
    LAS unsigned char* L = F.lds;
    const int j0 = (MODE == 0) ? 0 : (qb - 8 > 0 ? qb - 8 : 0), j1 = qb;
    f32x4 O[2][4]; float mrun[2], lrun[2];
#pragma unroll
    for (int i = 0; i < 2; ++i) { mrun[i] = -INFINITY; lrun[i] = 0.f;
#pragma unroll
        for (int dt = 0; dt < 4; ++dt) O[i][dt] = (f32x4){0.f, 0.f, 0.f, 0.f}; }
    const int wv_ = F.wave;
#define SA_ISSUE(jt_) do { LAS unsigned char* slot_ = L + (((jt_) - j0) % SA_NS) * SA_BUF; \
        _Pragma("unroll") for (int i_ = 0; i_ < 2; ++i_) { const int pc_ = 2 * wv_ + i_, P_ = pc_ & 7; const int row_ = 8 * P_ + (lane >> 3), c16_ = (lane & 7) ^ ((row_ >> 1) & 7); \
            const bf16_t* src_ = (pc_ < 8) ? Kg + ((size_t)bg * SEQ + (size_t)(jt_) * 64) * 64 + row_ * 64 + c16_ * 8 : Vtg + ((size_t)bg * 64 + (jt_)) * 4096 + row_ * 64 + c16_ * 8; \
            __builtin_amdgcn_global_load_lds((const unsigned*)src_, (LAS unsigned*)(slot_ + (pc_ < 8 ? SA_K : SA_V) + P_ * 1024), 16, 0, 0); } } while (0)
    __syncthreads();
#pragma unroll 1
    for (int d_ = 0; d_ < 2 * SA_GB; ++d_) if (j0 + d_ <= j1) SA_ISSUE(j0 + d_);
    if (j0 + 2 * SA_GB - 1 <= j1) asm volatile("s_waitcnt vmcnt(8)" ::: "memory");
    else asm volatile("s_waitcnt vmcnt(0)" ::: "memory");
    SA_BAR();
#pragma unroll 1
    for (int jg = j0; jg <= j1; jg += SA_GB) {
#pragma unroll 1
      for (int j = jg; j < jg + SA_GB && j <= j1; ++j) {
        LAS unsigned char* Lb = L + ((j - j0) % SA_NS) * SA_BUF;
        const bool edge = (j == j1) || (MODE == 1 && j == qb - 8);
        bool colok[2];
#pragma unroll
        for (int i = 0; i < 2; ++i) colok[i] = (MODE == 0) ? (bool)((selm[i] >> j) & 1ull) : true;
        if (MODE == 0 && __ballot(colok[0] || colok[1]) == 0ull) continue;
        f32x4 s[2][4];
#pragma unroll
        for (int kt = 0; kt < 4; ++kt) {
            const int key_ = 16 * kt + fr, sw_ = (key_ >> 1) & 7;
            const bf16x8 k0 = *(const LAS bf16x8*)(Lb + SA_K + key_ * 128 + ((fq ^ sw_) * 16)), k1 = *(const LAS bf16x8*)(Lb + SA_K + key_ * 128 + (((4 + fq) ^ sw_) * 16));
            const f32x4 z4 = (f32x4){0.f, 0.f, 0.f, 0.f};
#pragma unroll
            for (int i = 0; i < 2; ++i) { s[i][kt] = MFMA16(k0, qf[i][0], z4); s[i][kt] = MFMA16(k1, qf[i][1], s[i][kt]); }
        }
        constexpr float SC = 0.125f * 1.4426950408889634f;
        bf16x8 pb[2][2];
#pragma unroll
        for (int i = 0; i < 2; ++i) {
            const int t = tq[i];
            float mx;
            if (edge) {
                mx = -INFINITY;
#pragma unroll
                for (int kt = 0; kt < 4; ++kt)
#pragma unroll
                    for (int r = 0; r < 4; ++r) { const int kpos = 64 * j + 16 * kt + 4 * fq + r; bool vis = (kpos <= t); if (MODE == 1) vis = vis && (kpos > t - WINDOW);
                        s[i][kt][r] = vis ? s[i][kt][r] : -INFINITY; mx = fmaxf(mx, s[i][kt][r]); }
            } else {
                const float m0 = __builtin_fmaxf(__builtin_fmaxf(s[i][0][0], s[i][0][1]), s[i][0][2]), m1 = __builtin_fmaxf(__builtin_fmaxf(s[i][0][3], s[i][1][0]), s[i][1][1]);
                const float m2 = __builtin_fmaxf(__builtin_fmaxf(s[i][1][2], s[i][1][3]), s[i][2][0]), m3 = __builtin_fmaxf(__builtin_fmaxf(s[i][2][1], s[i][2][2]), s[i][2][3]);
                const float m4 = __builtin_fmaxf(__builtin_fmaxf(s[i][3][0], s[i][3][1]), s[i][3][2]);
                mx = __builtin_fmaxf(__builtin_fmaxf(__builtin_fmaxf(m0, m1), __builtin_fmaxf(m2, m3)), __builtin_fmaxf(m4, s[i][3][3]));
            }
            mx = colok[i] ? mx * SC : -INFINITY;
            mx = xfq_max(mx);
            const float mnew = fmaxf(mrun[i], mx);
            if (__ballot(mnew != mrun[i]) != 0ull) {
                const float alpha = (mrun[i] == -INFINITY) ? 0.f : __builtin_amdgcn_exp2f(mrun[i] - mnew);
                lrun[i] *= alpha;
#pragma unroll
                for (int dt = 0; dt < 4; ++dt) O[i][dt] = O[i][dt] * alpha;
                mrun[i] = mnew;
            }
            const float msub = (colok[i] && mnew != -INFINITY) ? mnew : INFINITY;
            float p[16]; float ps0 = 0.f, ps1 = 0.f;
#pragma unroll
            for (int kt = 0; kt < 4; ++kt) {
                p[4 * kt + 0] = __builtin_amdgcn_exp2f(__builtin_fmaf(s[i][kt][0], SC, -msub)); p[4 * kt + 1] = __builtin_amdgcn_exp2f(__builtin_fmaf(s[i][kt][1], SC, -msub));
                p[4 * kt + 2] = __builtin_amdgcn_exp2f(__builtin_fmaf(s[i][kt][2], SC, -msub)); p[4 * kt + 3] = __builtin_amdgcn_exp2f(__builtin_fmaf(s[i][kt][3], SC, -msub));
                ps0 += p[4 * kt + 0] + p[4 * kt + 1]; ps1 += p[4 * kt + 2] + p[4 * kt + 3]; }
            lrun[i] += ps0 + ps1;
#pragma unroll
            for (int ks = 0; ks < 2; ++ks) { u32x4 pw; pw.x = pk2(p[8 * ks], p[8 * ks + 1]); pw.y = pk2(p[8 * ks + 2], p[8 * ks + 3]); pw.z = pk2(p[8 * ks + 4], p[8 * ks + 5]); pw.w = pk2(p[8 * ks + 6], p[8 * ks + 7]);
                pb[i][ks] = __builtin_bit_cast(bf16x8, pw); }
        }
#pragma unroll
        for (int ks = 0; ks < 2; ++ks)
#pragma unroll
            for (int dt = 0; dt < 4; ++dt) { const int d_ = 16 * dt + fr, sw_ = (d_ >> 1) & 7, c_ = 4 * ks + (fq >> 1);
                const u32x2 v0 = *(const LAS u32x2*)(Lb + SA_V + d_ * 128 + ((c_ ^ sw_) * 16) + 8 * (fq & 1)), v1 = *(const LAS u32x2*)(Lb + SA_V + d_ * 128 + (((c_ + 2) ^ sw_) * 16) + 8 * (fq & 1));
                u32x4 vw; vw.x = v0.x; vw.y = v0.y; vw.z = v1.x; vw.w = v1.y; const bf16x8 vf = __builtin_bit_cast(bf16x8, vw);
#pragma unroll
                for (int i = 0; i < 2; ++i) O[i][dt] = MFMA16(vf, pb[i][ks], O[i][dt]); }
      }
      asm volatile("s_waitcnt vmcnt(0)" ::: "memory");
      SA_BAR();
#pragma unroll 1
      for (int d_ = 0; d_ < SA_GB; ++d_) if (jg + 2 * SA_GB + d_ <= j1) SA_ISSUE(jg + 2 * SA_GB + d_);
    }
#undef SA_ISSUE
#pragma unroll
    for (int i = 0; i < 2; ++i) { float l = lrun[i]; l += __shfl_xor(l, 16); l += __shfl_xor(l, 32); const float sc = gate[i] * frcp(fmaxf(l, 1e-30f));
#pragma unroll
        for (int dt = 0; dt < 4; ++dt) outacc[i][dt] += O[i][dt] * sc; }
}
__device__ __forceinline__ void nsa_attn_phase(const Frame& F, const Args& a, bool do_store = true) {
    const bf16_t* F1 = (const bf16_t*)(F.ws + WS_BIG); const bf16_t* QR = (const bf16_t*)(F.ws + WS_BIG + B1_QR);
    const bf16_t* KS = (const bf16_t*)(F.ws + WS_BIG + B1_KS); const bf16_t* VST = (const bf16_t*)(F.ws + WS_BIG + B1_VST); const bf16_t* KW = (const bf16_t*)(F.ws + WS_BIG + B1_KW); const bf16_t* VWT = (const bf16_t*)(F.ws + WS_BIG + B1_VWT);
    const unsigned long long* SEL = (const unsigned long long*)((unsigned char*)a.out + R2_SEL); bf16_t* ONSA = (bf16_t*)(F.ws + WS_XN);
    const int lane = F.lane, wave = F.wave, fr = lane & 15, fq = lane >> 4;
    for (int c = F.bid; c < 256; c += F.G) {
        const int bg = c & 15, kq = c >> 4, b = bg >> 1, g = bg & 1;
#pragma unroll 1
        for (int rep = 0; rep < 8; ++rep) {
            const int hb = 16 * rep + ((rep & 1) ? 15 - kq : kq);
            const int qb = hb >> 1;
            int tq[2]; bf16x8 qf[2][2]; unsigned long long selm[2]; float gs[2], gw_[2]; f32x4 outacc[2][4]; size_t mrow[2]; int Hh;
            Hh = g * 8 + (fr & 7);
#pragma unroll
            for (int i = 0; i < 2; ++i) { tq[i] = 32 * hb + 4 * wave + 2 * i + (fr >> 3); mrow[i] = (size_t)b * SEQ + tq[i];
                qf[i][0] = *(const bf16x8*)(QR + mrow[i] * 1024 + Hh * 64 + 8 * fq); qf[i][1] = *(const bf16x8*)(QR + mrow[i] * 1024 + Hh * 64 + 32 + 8 * fq);
                selm[i] = SEL[(size_t)bg * SEQ + tq[i]];
                gs[i] = sigmoidf_(bf2f(F1[mrow[i] * F1_LD + 1792 + Hh * 3 + 1])); gw_[i] = sigmoidf_(bf2f(F1[mrow[i] * F1_LD + 1792 + Hh * 3 + 2]));
#pragma unroll
                for (int dt = 0; dt < 4; ++dt) outacc[i][dt] = (f32x4){0.f, 0.f, 0.f, 0.f}; }
#ifdef PROBE_ATT_REP
            { float gz_[2]; gz_[0] = gz_[1] = __builtin_bit_cast(float, __hip_atomic_load(F.ctl + 6, __ATOMIC_RELAXED, __HIP_MEMORY_SCOPE_AGENT));
#pragma unroll 1
              for (int rp_ = 0; rp_ < 2; ++rp_) {
                if (PROBE_ATT_REP == 0) nsa_attn_pass<0>(F, KS, VST, qf, selm, tq, bg, qb, outacc, rp_ ? gs : gz_);
                else nsa_attn_pass<1>(F, KW, VWT, qf, selm, tq, bg, qb, outacc, rp_ ? gw_ : gz_); }
              if (PROBE_ATT_REP == 0) nsa_attn_pass<1>(F, KW, VWT, qf, selm, tq, bg, qb, outacc, gw_);
              else nsa_attn_pass<0>(F, KS, VST, qf, selm, tq, bg, qb, outacc, gs); }
#else
            nsa_attn_pass<0>(F, KS, VST, qf, selm, tq, bg, qb, outacc, gs);
            nsa_attn_pass<1>(F, KW, VWT, qf, selm, tq, bg, qb, outacc, gw_);
#endif
            if (do_store)
#pragma unroll
            for (int i = 0; i < 2; ++i)
#pragma unroll
                for (int dt = 0; dt < 4; ++dt) { bf16_t* p = ONSA + mrow[i] * 1024 + Hh * 64 + 16 * dt + 4 * fq; const u32x2 old = *(const u32x2*)p;
                    u32x2 w; w.x = pk2(bflo(old.x) + outacc[i][dt][0], bfhi(old.x) + outacc[i][dt][1]); w.y = pk2(bflo(old.y) + outacc[i][dt][2], bfhi(old.y) + outacc[i][dt][3]); *(u32x2*)p = w; }
        }
    }
}
__device__ __forceinline__ void chk_gdn(const Frame& F, const Args& a, int b, int h, int ntok, unsigned* cnt) {
    const bf16_t* F0 = (const bf16_t*)(F.ws + WS_BIG); const bf16_t* OAB = (const bf16_t*)(F.ws + WS_XN);
    LAS float* S = (LAS float*)F.lds;
    LAS float* qkv = S + 16384;
    LAS float* kS = qkv + 384;
    LAS float* ov = kS + 128;
    const int tid = F.tid; const float* convw = a.in[IN_GCONV];

#pragma unroll 1
for (int i = tid; i < 16384; i += NTHREADS) S[i] = 0.f;
    __syncthreads();
    unsigned bad = 0;

#pragma unroll 1
for (int t = 0; t < ntok; ++t) {
        const size_t m = (size_t)b * SEQ + t;
        if (tid < 384) { const int X = tid >> 7, c = tid & 127, col = X * 512 + h * 128 + c; float acc = 0.f;

#pragma unroll 1
for (int i = 0; i < 4; ++i) if (t - 3 + i >= 0) acc += convw[i * 1536 + col] * bf2f(F0[(m - 3 + i) * F0_LD + col]);
            qkv[tid] = acc / (1.f + expf(-acc)); }
        __syncthreads();
        float sq = 0.f, sk = 0.f;
#pragma unroll 1
for (int i = 0; i < 128; ++i) { sq += qkv[i] * qkv[i]; sk += qkv[128 + i] * qkv[128 + i]; }
        const float rq = 1.f / sqrtf(sq + 1e-6f) / sqrtf(128.f), rk = 1.f / sqrtf(sk + 1e-6f);
        const float beta = 1.f / (1.f + expf(-bf2f(F0[m * F0_LD + F0_BA + h])));
        const float aa = bf2f(F0[m * F0_LD + F0_BA + 4 + h]) + a.in[IN_GDT][h];
        const float g = -expf(a.in[IN_GALOG][h]) * (aa > 20.f ? aa : log1pf(expf(aa))); const float eg = expf(g);
        if (tid < 128) { float s = 0.f;
#pragma unroll 1
for (int i = 0; i < 128; ++i) s += qkv[128 + i] * rk * S[i * 128 + tid]; kS[tid] = s; }
        __syncthreads();

#pragma unroll 1
for (int e = tid; e < 16384; e += NTHREADS) { const int i = e >> 7, j = e & 127; const float ki = qkv[128 + i] * rk;
            S[e] = eg * (S[e] - beta * ki * kS[j]) + beta * ki * qkv[256 + j]; }
        __syncthreads();
        if (tid < 128) { float s = 0.f;
#pragma unroll 1
for (int i = 0; i < 128; ++i) s += qkv[i] * rq * S[i * 128 + tid]; ov[tid] = s; }
        __syncthreads();
        if (tid < 128) { float ss = 0.f;
#pragma unroll 1
for (int i = 0; i < 128; ++i) ss += ov[i] * ov[i];
            const float rstd = 1.f / sqrtf(ss / 128.f + NORM_EPS); const float z = bf2f(F0[m * F0_LD + 1536 + h * 128 + tid]);
            const float ref = ov[tid] * rstd * a.in[IN_GNORM][tid] * (z / (1.f + expf(-z))); const float got = bf2f(OAB[m * 1024 + h * 128 + tid]);
            if (!(fabsf(got - ref) <= 0.04f + 0.04f * fabsf(ref))) bad++; }
        __syncthreads();
    }
    if (bad) atomicAdd(cnt, bad);
}
__device__ __forceinline__ void chk_rwkv(const Frame& F, const Args& a, int b, int h, int ntok, unsigned* cnt) {
    const bf16_t* F0 = (const bf16_t*)(F.ws + WS_BIG); const bf16_t* OAB = (const bf16_t*)(F.ws + WS_XN);
    LAS float* S = (LAS float*)F.lds;
    LAS float* xs = S + 4096;
    LAS float* op = xs + 448;
    const int tid = F.tid; unsigned bad = 0;

#pragma unroll 1
for (int i = tid; i < 4096; i += NTHREADS) S[i] = 0.f;
    __syncthreads();

#pragma unroll 1
for (int t = 0; t < ntok; ++t) {
        const size_t m = (size_t)b * SEQ + t;
        if (tid < 448) { int mi; if (tid < 192) mi = (tid >> 6) * 512 + h * 64 + (tid & 63); else mi = 1536 + (tid - 192);
            const float f = bf2f(F0[m * F0_LD + F0_RWKV + mi]); const float fp = t > 0 ? bf2f(F0[(m - 1) * F0_LD + F0_RWKV + mi]) : 0.f;
            xs[tid] = f + (fp - f) * a.in[IN_RMU][mi]; }
        __syncthreads();
        if (tid < 64) { const int hc = h * 64 + tid; float lw = a.in[IN_RW0][hc], la = a.in[IN_RA0][hc], gg = 0.f;

#pragma unroll 1
for (int j = 0; j < 64; ++j) { lw += tanhf(xs[192 + j]) * a.in[IN_RW2][j * 512 + hc]; la += xs[256 + j] * a.in[IN_RA2][j * 512 + hc]; }

#pragma unroll 1
for (int j = 0; j < 128; ++j) gg += (1.f / (1.f + expf(-xs[320 + j]))) * a.in[IN_RG2][j * 512 + hc];
            const float sp = (-lw > 20.f) ? -lw : log1pf(expf(-lw)); const float wlog = -sp - 0.5f;
            const float av = 1.f / (1.f + expf(-la));
            op[tid] = expf(-expf(wlog)); op[64 + tid] = xs[64 + tid] * a.in[IN_RKK][hc]; op[256 + tid] = av;
            op[192 + tid] = xs[64 + tid] * (1.f + (av - 1.f) * a.in[IN_RKA][hc]); op[320 + tid] = gg; }
        __syncthreads();
        float ss = 0.f;
#pragma unroll 1
for (int i = 0; i < 64; ++i) ss += op[64 + i] * op[64 + i];
        const float rinv = 1.f / sqrtf(ss + 1e-6f);
        float bon = 0.f;
#pragma unroll 1
for (int i = 0; i < 64; ++i) bon += xs[i] * op[192 + i] * a.in[IN_RRK][h * 64 + i];
        if (tid < 64) { float sa = 0.f;
#pragma unroll 1
for (int k = 0; k < 64; ++k) sa -= S[tid * 64 + k] * op[64 + k] * rinv;
            float y = 0.f; const float vv = xs[128 + tid];

#pragma unroll 1
for (int k = 0; k < 64; ++k) { const float kk = op[64 + k] * rinv; const float sn = S[tid * 64 + k] * op[k] + sa * kk * op[256 + k] + vv * op[192 + k]; S[tid * 64 + k] = sn; y += sn * xs[k]; }
            op[384 + tid] = y; }
        __syncthreads();
        if (tid < 64) { float mean = 0.f;
#pragma unroll 1
for (int i = 0; i < 64; ++i) mean += op[384 + i]; mean /= 64.f; float var = 0.f;
#pragma unroll 1
for (int i = 0; i < 64; ++i) { const float d = op[384 + i] - mean; var += d * d; } var /= 64.f;
            const int hc = h * 64 + tid;
            const float yn = (op[384 + tid] - mean) / sqrtf(var + RWKV_LN_EPS) * a.in[IN_RLNW][hc] + a.in[IN_RLNB][hc];
            const float ref = (yn + bon * xs[128 + tid]) * op[320 + tid]; const float got = bf2f(OAB[m * 1024 + 512 + hc]);
            if (!(fabsf(got - ref) <= 0.04f + 0.04f * fabsf(ref))) bad++; }
        __syncthreads();
    }
    if (bad) atomicAdd(cnt, bad);
}

__device__ __forceinline__ float chk_rope_val(const bf16_t* row, int base, int d, float posf) {
    if (d >= 16) return bf2f(row[base + d]);
    const int i = d & 7; const float ang = posf * ROPE_INVF[i]; const float cs = cosf(ang), sn = sinf(ang);
    const float x1 = bf2f(row[base + i]), x2 = bf2f(row[base + 8 + i]);
    return d < 8 ? x1 * cs - x2 * sn : x2 * cs + x1 * sn;
}
__device__ __forceinline__ void chk_nsa(const Frame& F, const Args& a, int b, int g, int t, unsigned* cnt) {
    const bf16_t* F1 = (const bf16_t*)(F.ws + WS_BIG); const bf16_t* ONSA = (const bf16_t*)(F.ws + WS_XN);
    const int* pos = (const int*)a.in[IN_POS];
    LAS float* kc = (LAS float*)F.lds;
    LAS float* vc = kc + 8192;
    LAS float* hb = vc + 8192;
    LAS float* sb = hb + 512;
    LAS float* red = sb + 4096;
    LAS float* qv = red + 512;
    LAS float* impv = qv + 64;
    LAS float* ocv = impv + 64;
    LAS float* misc = ocv + 512;
    LAS unsigned* selw = (LAS unsigned*)(misc + 8);
    const int tid = F.tid; const size_t mb = (size_t)b * SEQ; const size_t m = mb + t;
    const int nk = t >= 31 ? (t - 31) / 16 + 1 : 0;
    unsigned bad = 0;
#pragma unroll 1
    for (int i = 0; i < nk; ++i) {
        { const int path = tid >> 8, hid = tid & 255; const float* w1 = a.in[path ? IN_NW1V : IN_NW1K]; const float* pe = a.in[path ? IN_NPEV : IN_NPEK]; float acc = 0.f;
#pragma unroll 1
          for (int sl = 0; sl < 32; ++sl) { const bf16_t* row = F1 + (mb + 16 * i + sl) * F1_LD + 1024 + path * 128 + g * 64;
#pragma unroll 1
              for (int d = 0; d < 64; ++d) acc += (bf2f(row[d]) + pe[sl * 64 + d]) * w1[(size_t)(sl * 64 + d) * 256 + hid]; }
          hb[tid] = acc / (1.f + expf(-acc)); }
        __syncthreads();
        if (tid < 128) { const int path = tid >> 6, d = tid & 63; const float* w2 = a.in[path ? IN_NW2V : IN_NW2K]; float acc = 0.f;
#pragma unroll 1
            for (int hid = 0; hid < 256; ++hid) acc += hb[path * 256 + hid] * w2[hid * 64 + d];
            (path ? vc : kc)[i * 64 + d] = acc; }
        __syncthreads();
    }
    if (tid < nk * 8) { const int i = tid >> 3, dd = tid & 7; const float ang = (float)pos[mb + 31 + 16 * i] * ROPE_INVF[dd]; const float cs = cosf(ang), sn = sinf(ang);
        const float x1 = kc[i * 64 + dd], x2 = kc[i * 64 + 8 + dd]; kc[i * 64 + dd] = x1 * cs - x2 * sn; kc[i * 64 + 8 + dd] = x2 * cs + x1 * sn; }
    if (tid < 64) impv[tid] = 0.f;
    __syncthreads();
    const float posq = (float)pos[m];
#pragma unroll 1
    for (int hh = 0; hh < 8; ++hh) { const int H = g * 8 + hh;
        if (tid < 64) qv[tid] = chk_rope_val(F1 + m * F1_LD, H * 64, tid, posq) * 0.125f;
        __syncthreads();
        if (tid < nk) { float s = 0.f;
#pragma unroll 1
            for (int d = 0; d < 64; ++d) s += qv[d] * kc[tid * 64 + d]; sb[tid] = s; }
        __syncthreads();
        if (tid == 0) { float mx = -INFINITY;
#pragma unroll 1
            for (int i = 0; i < nk; ++i) mx = fmaxf(mx, sb[i]); float sum = 0.f;
#pragma unroll 1
            for (int i = 0; i < nk; ++i) sum += expf(sb[i] - mx); misc[0] = mx; misc[1] = fmaxf(sum, 1e-30f); }
        __syncthreads();
        if (tid < nk) sb[tid] = expf(sb[tid] - misc[0]) / misc[1];
        __syncthreads();
        if (tid < 64) { float o = 0.f;
#pragma unroll 1
            for (int i = 0; i < nk; ++i) o += sb[i] * vc[i * 64 + tid]; ocv[hh * 64 + tid] = o;
            float im = 0.f;
#pragma unroll 1
            for (int i = 4 * tid - 1; i <= 4 * tid + 3; ++i) if (i >= 0 && i < nk) im += sb[i] * ((i == 4 * tid - 1 || i == 4 * tid + 3) ? 0.5f : 1.f);
            impv[tid] += im; }
        __syncthreads();
    }
    if (tid == 0) { const int cur = t >> 6; unsigned lo = 0u, hi = 0u;
#pragma unroll 1
        for (int r = 0; r < 16; ++r) { int best = -1; float bv = 0.f;
#pragma unroll 1
            for (int j = 0; j < 64; ++j) { const bool taken = j < 32 ? ((lo >> j) & 1u) : ((hi >> (j - 32)) & 1u); if (taken) continue;
                const bool valid = j <= cur, forced = (j == 0) || (j == cur) || (j == cur - 1);
                const float sc = valid ? (forced ? INFINITY : impv[j]) : -INFINITY;
                if (best < 0 || sc > bv) { best = j; bv = sc; } }
            if (best < 32) lo |= 1u << best; else hi |= 1u << (best - 32); }
        selw[0] = lo; selw[1] = hi; }
    __syncthreads();
#pragma unroll 1
    for (int hh = 0; hh < 8; ++hh) { const int H = g * 8 + hh;
        if (tid < 64) qv[tid] = chk_rope_val(F1 + m * F1_LD, H * 64, tid, posq) * 0.125f;
        __syncthreads();
        float osw[2] = {0.f, 0.f};
#pragma unroll 1
        for (int br = 0; br < 2; ++br) {
            const int kbase = 1024 + (br == 0 ? 2 : 4) * 128 + g * 64, vbase = kbase + 128;
            float lmx = -INFINITY;
#pragma unroll 1
            for (int kp = tid; kp < 4096; kp += NTHREADS) { float s = -INFINITY; const int j = kp >> 6;
                bool vis = kp <= t; if (br == 0) vis = vis && (j < 32 ? ((selw[0] >> j) & 1u) : ((selw[1] >> (j - 32)) & 1u)); else vis = vis && (kp > t - WINDOW);
                if (vis) { s = 0.f; const float pk = (float)pos[mb + kp];
#pragma unroll 1
                    for (int d = 0; d < 64; ++d) s += qv[d] * chk_rope_val(F1 + (mb + kp) * F1_LD, kbase, d, pk); }
                sb[kp] = s; lmx = fmaxf(lmx, s); }
            red[tid] = lmx; __syncthreads();
            if (tid == 0) { float mx = -INFINITY;
#pragma unroll 1
                for (int i = 0; i < NTHREADS; ++i) mx = fmaxf(mx, red[i]); misc[0] = mx; }
            __syncthreads();
            float ls = 0.f;
#pragma unroll 1
            for (int kp = tid; kp < 4096; kp += NTHREADS) { const float e = (sb[kp] == -INFINITY) ? 0.f : expf(sb[kp] - misc[0]); sb[kp] = e; ls += e; }
            red[tid] = ls; __syncthreads();
            if (tid == 0) { float sm = 0.f;
#pragma unroll 1
                for (int i = 0; i < NTHREADS; ++i) sm += red[i]; misc[1] = fmaxf(sm, 1e-30f); }
            __syncthreads();
            if (tid < 64) { float o = 0.f;
#pragma unroll 1
                for (int kp = 0; kp <= t; ++kp) if (sb[kp] != 0.f) o += sb[kp] * bf2f(F1[(mb + kp) * F1_LD + vbase + tid]); osw[br] = o / misc[1]; }
            __syncthreads();
        }
        if (tid < 64) { const float g0 = 1.f / (1.f + expf(-bf2f(F1[m * F1_LD + 1792 + H * 3 + 0]))), g1 = 1.f / (1.f + expf(-bf2f(F1[m * F1_LD + 1792 + H * 3 + 1]))), g2 = 1.f / (1.f + expf(-bf2f(F1[m * F1_LD + 1792 + H * 3 + 2])));
            const float ref = g0 * ocv[hh * 64 + tid] + g1 * osw[0] + g2 * osw[1]; const float got = bf2f(ONSA[m * 1024 + H * 64 + tid]);
            if (!(fabsf(got - ref) <= 0.004f + 0.05f * fabsf(ref))) bad++; }
        __syncthreads();
    }
    if (bad) atomicAdd(cnt, bad);
}
__global__ void __launch_bounds__(NTHREADS, 2) mk_fwd(Args args) {
    extern __shared__ __attribute__((aligned(16))) unsigned char lds[];
    cg::grid_group grid = cg::this_grid();
#ifdef PROBE_TIME_KIND
    const unsigned long long tkern0_ = __builtin_amdgcn_s_memrealtime();
#endif
    Frame F; F.lds = (LAS unsigned char*)lds; F.tid = threadIdx.x; F.lane = F.tid & 63; F.wave = __builtin_amdgcn_readfirstlane(F.tid >> 6);
    F.G = gridDim.x; F.bid = blockIdx.x; F.ws = args.ws; F.ctl = (unsigned*)(args.ws + WS_CTL);
    unsigned char* ws = args.ws;
    if (F.tid < 16) ((LAS unsigned*)(F.lds + XB_LDS_OFF))[F.tid] = 0u;
    __syncthreads();
    XcdBarrier xbar = xcd_barrier_post(F.ctl + CW_BAR, (volatile LAS unsigned*)(F.lds + XB_LDS_OFF));
    const bool big = F.G >= 192;
    p0_prologue(fresh(F), args, big);
    rwkvc_build_images(fresh(F), args);
    if (!big) p0_layer1_weights(fresh(F), args, 0, 0, -1);
    grid.sync();
#if defined(PROBE_TIME_KIND) && PROBE_TIME_KIND == 99
    if (F.bid == 0) { const unsigned long long el_ = __builtin_amdgcn_s_memrealtime() - tkern0_; const unsigned long long tgt_ = __builtin_amdgcn_s_memrealtime() + 4ull * el_; while (__builtin_amdgcn_s_memrealtime() < tgt_) __builtin_amdgcn_s_sleep(20); }
#endif
    enum { K_GEMM = 0, K_GDNPREP, K_RPREP_UNUSED, K_SCAN, K_ROW, K_NSAPREP, K_CMP2, K_CMPATTN, K_ATTN, K_CMP1 };
    constexpr int NPH = 27;
#ifdef PROBE_TIME_KIND
    unsigned long long tacc_ = 0;
#endif
#pragma unroll 1
    for (int ph = 1; ph <= NPH; ++ph) {
#ifdef PROBE_TIME_KIND
        const unsigned long long tst_ = __builtin_amdgcn_s_memrealtime();
#endif
        int kind, sub = 0;
        if (ph == 1) { kind = K_GEMM; sub = 0; }
        else if (ph == 2) kind = K_GDNPREP;
        else if (ph <= 11) { kind = K_SCAN; sub = ph - 4; }
        else if (ph == 12) { kind = K_GEMM; sub = 1; }
        else if (ph == 13) { kind = K_ROW; sub = 0; }
        else if (ph == 14) { kind = K_GEMM; sub = 2; }
        else if (ph == 15) { kind = K_GEMM; sub = 3; }
        else if (ph == 16) { kind = K_ROW; sub = 1; }
        else if (ph == 17) { kind = K_GEMM; sub = 4; }
        else if (ph == 18) kind = K_NSAPREP;
        else if (ph == 19) kind = K_CMP1;
        else if (ph == 20) kind = K_CMP2;
        else if (ph == 21) kind = K_CMPATTN;
        else if (ph == 22) kind = K_ATTN;
        else if (ph == 23) { kind = K_GEMM; sub = 7; }
        else if (ph == 24) { kind = K_ROW; sub = 2; }
        else if (ph == 25) { kind = K_GEMM; sub = 8; }
        else if (ph == 26) { kind = K_GEMM; sub = 9; }
        else { kind = K_ROW; sub = 3; }
        kind = __builtin_amdgcn_readfirstlane(kind); sub = __builtin_amdgcn_readfirstlane(sub);
        if (kind == K_GEMM) {
            const int ng = (sub == 5) ? 2 : 1;
#pragma unroll 1
            for (int gi = 0; gi < ng; ++gi) {
                const int gx = sub + gi;
                const size_t offA = (gx == 3 || gx == 9) ? WS_BIG : gx == 5 ? WS_BIG + B1_ACMPK : gx == 6 ? WS_BIG + B1_ACMPV : WS_XN;
                const size_t offB = gx == 0 ? WS_W_IN0 : gx == 1 ? WS_W_OUT0 : gx == 2 ? WS_W_UP0 : gx == 3 ? WS_W_DN0 : gx == 4 ? WS_W_IN1 : gx == 5 ? WS_W_C1K : gx == 6 ? WS_W_C1V : gx == 7 ? WS_W_OUT1 : gx == 8 ? WS_W_UP1 : WS_W_DN1;
                unsigned char* Op = (gx == 5) ? (unsigned char*)args.out + R2_HCMP : (gx == 6) ? (unsigned char*)args.out + R2_HCMP + (size_t)4096 * 256 * 2 : (gx == 3 || gx == 9) ? ws + WS_XN : ws + WS_BIG;
                const int Mr = (gx == 5 || gx == 6) ? 4096 : MTOK;
                const int Nn = (gx == 0 || gx == 2 || gx == 8) ? 4096 : (gx == 4) ? 2048 : (gx == 5 || gx == 6) ? 256 : 1024;
                const int Kk = (gx == 3 || gx == 9) ? 4096 : (gx == 5 || gx == 6) ? 2048 : 1024;
                const int ldo = (gx == 0) ? F0_LD : (gx == 4) ? F1_LD : Nn;
                const int act = (gx == 2 || gx == 8) ? 2 : (gx == 5 || gx == 6) ? 3 : 0;
                const int cshift = (gx == 6) ? 128 : 0;
                pg8::Gemm g_{(const bf16_t*)(ws + offA), (const bf16_t*)(ws + offB), Mr, Nn, Kk};
                pg8::StaticOrder S_; S_.init(Mr, Nn, F.G, (F.bid + cshift) % F.G);
                pg8::EpiBf16R E_{(bf16_t*)Op, ldo, act};
                pg8::gemm_phase<pg8::EpiBf16R, pg8::StaticOrder, true, true>(F.lds, g_, S_, E_);
            }
        } else if (kind == K_GDNPREP) {
            gdn_prep_phase(fresh(F), args);
        } else if (kind == K_SCAN) {
            const int sg = sub;
            if (sg >= 0) {
                for (int u = F.bid; u < 96; u += F.G) {
                    if (u < 64) rwkvc_chain_unit(fresh(F), args, u, sg); else gdn_scan_unit(fresh(F), args, u - 64, 8 * sg, 8 * sg + 8);
                    __syncthreads(); }
            }
            const bool split = big && sg >= 0;
            const int pb0 = split ? 96 : 0, pnb = split ? F.G - 96 : F.G;
            if (sg < 7 && F.bid >= pb0) rwkvc_prep_phase(fresh(F), args, sg + 1, pb0, pnb);
            if (big && sg >= 0) {
                const int c0 = (448 - F.G) > 96 ? (448 - F.G) : 96;
                if (sg < 6) { if (F.bid >= c0) p0_layer1_weights(fresh(F), args, c0, F.G - c0, sg); }
                else if (sg == 7 && F.bid >= 96) { p0_layer0_rest(fresh(F), args, 96, F.G - 96, 0); p0_layer0_rest(fresh(F), args, 96, F.G - 96, 1); p0_layer0_rest(fresh(F), args, 96, F.G - 96, 2); }
            }
        } else if (kind == K_ROW) {
            if (sub == 0) row_pass<false, true>(fresh(F), (const bf16_t*)(ws + WS_BIG), args.in[IN_X], args.in[IN_NMPOST], ws + WS_R2, args.in[IN_NFPRE], (bf16_t*)(ws + WS_XN));
            else if (sub == 3) row_pass<true, false>(fresh(F), (const bf16_t*)(ws + WS_XN), ws + WS_R2, args.in[IN_NFPOST] + 1024, args.out, nullptr, nullptr);
            else row_pass<true, true>(fresh(F), (const bf16_t*)(ws + (sub == 1 ? WS_XN : WS_BIG)), ws + WS_R2, sub == 1 ? args.in[IN_NFPOST] : args.in[IN_NMPOST] + 1024, ws + WS_R2,
                                      sub == 1 ? args.in[IN_NMPRE] + 1024 : args.in[IN_NFPRE] + 1024, (bf16_t*)(ws + WS_XN));
        } else if (kind == K_NSAPREP) {
            nsa_prep_phase(fresh(F), args);
        } else if (kind == K_CMP1) {
#ifdef PROBE_REP_CMP1
            { const int nrep_ = __builtin_amdgcn_readfirstlane(PROBE_REP_CMP1 + (int)__hip_atomic_load(F.ctl + 6, __ATOMIC_RELAXED, __HIP_MEMORY_SCOPE_AGENT));
#pragma unroll 1
              for (int rep_ = 0; rep_ < nrep_; ++rep_) { nsa_cmp1_phase(fresh(F), args); __syncthreads(); } }
#else
            nsa_cmp1_phase(fresh(F), args);
#endif
        } else if (kind == K_CMP2) {
            nsa_cmp2_phase(fresh(F), args);
        } else if (kind == K_CMPATTN) {
            nsa_cmp_attn_phase(fresh(F), args);
        } else {
            nsa_attn_phase(fresh(F), args);
        }
        if (ph != NPH) xcd_barrier(xbar);
#ifdef PROBE_TIME_KIND
        if ((PROBE_TIME_KIND < 100 && kind == PROBE_TIME_KIND) || (PROBE_TIME_KIND >= 100 && ph == PROBE_TIME_KIND - 100)) tacc_ += __builtin_amdgcn_s_memrealtime() - tst_;
#endif
    }
#ifdef PROBE_ATT_COUNT
    if (F.bid == PROBE_ATT_COUNT) { const unsigned cnt_ = __hip_atomic_load(F.ctl + 8, __ATOMIC_RELAXED, __HIP_MEMORY_SCOPE_AGENT);
        const unsigned long long tgt_ = __builtin_amdgcn_s_memrealtime() + 400ull * cnt_; while (__builtin_amdgcn_s_memrealtime() < tgt_) __builtin_amdgcn_s_sleep(20); }
#endif
#ifdef PROBE_TIME_KIND
    if (F.bid == 0) { const unsigned long long tgt_ = __builtin_amdgcn_s_memrealtime() + 4ull * tacc_; while (__builtin_amdgcn_s_memrealtime() < tgt_) __builtin_amdgcn_s_sleep(20); }
#endif
}
extern "C" void kernel_launch(void* const* d_in, const int* in_sizes, int n_in, void* d_out, int out_size, void* d_ws, size_t ws_size, hipStream_t stream) {
    static int grid = 0;
    if (grid == 0) {
        if (n_in != 33 || out_size != MTOK * D_MODEL || ws_size < WS_END) { fprintf(stderr, "kernel_launch: unexpected problem (n_in %d out %d ws %zu)\n", n_in, out_size, ws_size); grid = -1; return; }
        int dev = 0, cus = 0, per_cu = 0;
        (void)hipGetDevice(&dev); (void)hipDeviceGetAttribute(&cus, hipDeviceAttributeMultiprocessorCount, dev);
        (void)hipFuncSetAttribute((const void*)mk_fwd, hipFuncAttributeMaxDynamicSharedMemorySize, LDS_BYTES);
        (void)hipOccupancyMaxActiveBlocksPerMultiprocessor(&per_cu, (const void*)mk_fwd, NTHREADS, LDS_BYTES);
        if (per_cu < 1) { fprintf(stderr, "kernel_launch: occupancy query says %d blocks/CU\n", per_cu); grid = -1; return; }
        grid = cus;
        fprintf(stderr, "kernel_launch: grid %d (cus %d, per_cu %d) ws %zu\n", grid, cus, per_cu, ws_size);
    }
    if (grid < 0) return;
    (void)hipMemsetAsync((char*)d_ws + WS_CTL, 0, 1 * MiB, stream);
    Args a{};
    for (int i = 0; i < 33; ++i) a.in[i] = (const float*)d_in[i];
    a.out = (float*)d_out; a.ws = (unsigned char*)d_ws; a.ph_lo = 0; a.ph_hi = 100;
    void* kargs[] = {&a};
    hipError_t e = hipLaunchCooperativeKernel((void*)mk_fwd, dim3(grid), dim3(NTHREADS), kargs, LDS_BYTES, stream);
    if (e != hipSuccess) fprintf(stderr, "cooperative launch failed: %s (grid %d)\n", hipGetErrorString(e), grid);
}
```

```cpp
#include <hip/hip_runtime.h>
#include <hip/hip_cooperative_groups.h>
#include <cstdio>
#include <cstdint>
namespace cg = cooperative_groups;

constexpr int D_MODEL = 1024, BATCH = 8, SEQ = 4096, MTOK = BATCH * SEQ;
constexpr int GDN_HEADS = 4, GDN_DK = 128, GDN_DV = 128, GDN_CHUNK = 64;
constexpr int RWKV_HEADS = 8, RWKV_N = 64;
constexpr int NSA_HEADS = 16, NSA_GROUPS = 2, NSA_HD = 64, CMP_LEN = 32, CMP_STRIDE = 16, CMP_HIDDEN = 256;
constexpr int SEL_BLOCK = 64, SEL_TOPN = 16, WINDOW = 512;
constexpr int D_FF = 4096;
constexpr float NORM_EPS = 1e-6f, RWKV_LN_EPS = 64e-5f;
constexpr int AB_IN_W = 3848, NSA_IN_W = 1840;
constexpr int F0_LD = 4096;
constexpr int F1_LD = 2048;
constexpr int F0_RWKV = 2048, F0_BA = 3840;

typedef unsigned short bf16_t;
typedef short bf16x8 __attribute__((ext_vector_type(8)));
typedef float f32x4 __attribute__((ext_vector_type(4)));
typedef float f32x2 __attribute__((ext_vector_type(2)));
typedef unsigned u32x4 __attribute__((ext_vector_type(4)));
typedef unsigned u32x2 __attribute__((ext_vector_type(2)));
#define LAS __attribute__((address_space(3)))

typedef __bf16 hwbf16x2 __attribute__((ext_vector_type(2)));
__device__ __forceinline__ unsigned pk2(float lo, float hi) { const f32x2 v = {lo, hi}; const hwbf16x2 b = __builtin_convertvector(v, hwbf16x2); return __builtin_bit_cast(unsigned, b); }
__device__ __forceinline__ unsigned f2bf(float f) { return pk2(f, 0.f) & 0xffffu; }
__device__ __forceinline__ float bf2f(bf16_t h) { return __builtin_bit_cast(float, (unsigned)h << 16); }
__device__ __forceinline__ float bflo(unsigned u) { return __builtin_bit_cast(float, u << 16); }
__device__ __forceinline__ float bfhi(unsigned u) { return __builtin_bit_cast(float, u & 0xffff0000u); }
__device__ __forceinline__ float wave_sum(float v) {
#pragma unroll
    for (int o = 1; o < 64; o <<= 1) v += __shfl_xor(v, o);
    return v;
}
__device__ __forceinline__ float frcp(float x) { return __builtin_amdgcn_rcpf(x); }
__device__ __forceinline__ float sigmoidf_(float x) { return frcp(1.f + __expf(-x)); }
__device__ __forceinline__ float siluf_(float x) { return x * frcp(1.f + __expf(-x)); }
__device__ __forceinline__ float softplusf_(float x) { return x > 20.f ? x : log1pf(__expf(x)); }

__device__ __forceinline__ float fast_tanhf(float x) { const float e = __expf(2.f * x); return 1.f - 2.f * frcp(e + 1.f); }
__device__ __forceinline__ float fast_softplusf(float x) { return x > 20.f ? x : __logf(1.f + __expf(x)); }
__device__ __forceinline__ float dpp_f(float v, const int ctrl_sel) {
    const int i = __builtin_bit_cast(int, v);
    int r;
    if (ctrl_sel == 0) r = __builtin_amdgcn_update_dpp(i, i, 0xB1, 0xF, 0xF, false);
    else if (ctrl_sel == 1) r = __builtin_amdgcn_update_dpp(i, i, 0x4E, 0xF, 0xF, false);
    else r = __builtin_amdgcn_update_dpp(i, i, 0x141, 0xF, 0xF, false);
    return __builtin_bit_cast(float, r);
}
__device__ __forceinline__ float red8_dpp(float v) { v += dpp_f(v, 0); v += dpp_f(v, 1); v += dpp_f(v, 2); return v; }
namespace pg8 {
#define PG8_LAS __attribute__((address_space(3)))
constexpr int BM = 256, BK = 64, HALF = 128, HTB = HALF * BK * 2  , STAGE_BYTES = 8 * HTB, NXCD = 8, WGM = 8;

__host__ __device__ __forceinline__ int lds_byte(int r, int c) { const int st = (r >> 4) * 2 + (c >> 5), rr = r & 15, cc = c & 31, ob = rr * 64 + cc * 2; return st * 1024 + (ob ^ (((ob >> 9) & 1) << 5)); }
__host__ __device__ __forceinline__ void stage_rc(int b, int& R, int& C) { const int st = b / 1024, sb = b % 1024, swz = sb ^ (((sb >> 9) & 1) << 5); R = (st >> 1) * 16 + swz / 64; C = (st & 1) * 32 + (swz % 64) / 2; }
__host__ __device__ __forceinline__ int perm32(int rho) { const int n = rho >> 4, i = rho & 15; return 8 * (i >> 2) + 4 * n + (i & 3); }

struct Unit { int pm, pn; };
struct Gemm { const bf16_t* A; const bf16_t* Bt; int M, N, K; };

struct StaticOrder {
    int nM, nN, nwg, G, c;
    __host__ __device__ void init(int M, int N, int G_, int c_) { nM = M / BM; nN = N / BM; nwg = nM * nN; G = G_; c = c_; }
    __host__ __device__ bool next(int i, Unit& u) const {
        const long L = (long)i * G + c; if (L >= nwg) return false;
        int wgid = (int)L; { const int q = nwg / NXCD, r = nwg % NXCD, xcd = wgid % NXCD, off = wgid / NXCD; wgid = (xcd < r ? xcd * (q + 1) : r * (q + 1) + (xcd - r) * q) + off; }
        const int nig = WGM * nN, gid = wgid / nig, fm = gid * WGM, gsz = (nM - fm) < WGM ? (nM - fm) : WGM;
        u.pm = fm + ((wgid % nig) % gsz); u.pn = (wgid % nig) / gsz; return true;
    }
    __device__ __forceinline__ void a_ready(const Unit&) const {}
    __device__ __forceinline__ void done(const Unit&) const {}
};


__device__ __forceinline__ unsigned cvt_pk_bf16(float lo, float hi) { unsigned r; asm volatile("v_cvt_pk_bf16_f32 %0, %1, %2" : "=v"(r) : "v"(lo), "v"(hi)); return r; }
template <int ACT  > struct EpiBf16 {
    static constexpr bool PERM = true, AFTER_DRAIN = false;
    bf16_t* O; int ldc;
    __device__ __forceinline__ void operator()(const f32x4 (&acc)[2][2][4][2], const Unit& u, int wr, int wc, int fr, int fq) const {
        const int row0 = u.pm * BM + wr * 64 + fr; const int col0 = u.pn * BM + wc * 32 + 8 * fq;
#pragma unroll
        for (int ai = 0; ai < 2; ++ai)
#pragma unroll
            for (int m = 0; m < 4; ++m) { bf16_t* rowp = O + (size_t)(row0 + ai * HALF + m * 16) * ldc + col0;
#pragma unroll
                for (int bj = 0; bj < 2; ++bj) { f32x4 v0 = acc[ai][bj][m][0], v1 = acc[ai][bj][m][1];
                    if (ACT == 2) {
#pragma unroll
                        for (int e = 0; e < 4; ++e) { float a = v0[e] > 0.f ? v0[e] : 0.f; v0[e] = a * a; float b = v1[e] > 0.f ? v1[e] : 0.f; v1[e] = b * b; } }
                    if (ACT == 3) {
#pragma unroll
                        for (int e = 0; e < 4; ++e) { v0[e] = v0[e] * __builtin_amdgcn_rcpf(1.f + __expf(-v0[e])); v1[e] = v1[e] * __builtin_amdgcn_rcpf(1.f + __expf(-v1[e])); } }
                    u32x4 w; w.x = cvt_pk_bf16(v0[0], v0[1]); w.y = cvt_pk_bf16(v0[2], v0[3]); w.z = cvt_pk_bf16(v1[0], v1[1]); w.w = cvt_pk_bf16(v1[2], v1[3]);
                    *(u32x4*)(rowp + bj * HALF) = w; } }
    }
};
struct EpiBf16R {
    static constexpr bool PERM = true, AFTER_DRAIN = false;
    bf16_t* O; int ldc; int act;
    __device__ __forceinline__ void operator()(const f32x4 (&acc)[2][2][4][2], const Unit& u, int wr, int wc, int fr, int fq) const {
        if (act == 0) { EpiBf16<0> e{O, ldc}; e(acc, u, wr, wc, fr, fq); }
        else if (act == 2) { EpiBf16<2> e{O, ldc}; e(acc, u, wr, wc, fr, fq); }
        else { EpiBf16<3> e{O, ldc}; e(acc, u, wr, wc, fr, fq); }
    }
};
template <class Epi, class Sched, bool ALIGN_EPI = false, bool SP2 = false>
__device__ __forceinline__ void gemm_phase(PG8_LAS unsigned char* lds, const Gemm g, const Sched& S, const Epi& E) {
    int tid_ = threadIdx.x; asm volatile("" : "+v"(tid_));
    const int tid = tid_, wid = __builtin_amdgcn_readfirstlane(tid >> 6), lane = tid & 63, wr = wid >> 2, wc = wid & 3, fr = lane & 15, fq = lane >> 4;
    const int K = g.K, nt = K / BK;
    unsigned voffA[2], voffB[2];
#pragma unroll
    for (int i = 0; i < 2; ++i) { int R, C; stage_rc(tid * 16 + i * 8192, R, C); const int Rb = Epi::PERM ? ((R & ~31) + perm32(R & 31)) : R;
        voffA[i] = (unsigned)(R * K + C) * 2u; voffB[i] = (unsigned)(Rb * K + C) * 2u; }
    const size_t kstep = (size_t)(BK * 2);
    const size_t hstep = (size_t)HALF * K * 2;
    const size_t tstep = 2 * hstep;
    const unsigned ldsw = (unsigned)wid * 1024u;
    const int aoff = lds_byte(wr * 64 + fr, fq * 8), boff = lds_byte(wc * 32 + fr, fq * 8);
#define PG8_SA(b, h) (((b) * 2 + (h)) * HTB)
#define PG8_SB(b, h) ((4 + (b) * 2 + (h)) * HTB)
#define PG8_STAGE(bufoff, gbase, voff) do { _Pragma("unroll") for (int _i = 0; _i < 2; ++_i) \
        __builtin_amdgcn_global_load_lds((const unsigned*)((const char*)(gbase) + (voff)[_i]), (PG8_LAS unsigned*)(lds + (bufoff) + ldsw + _i * 8192), 16, 0, 0); } while (0)
#define PG8_LDA(dst, b, h) do { _Pragma("unroll") for (int m = 0; m < 4; ++m) _Pragma("unroll") for (int k = 0; k < 2; ++k) dst[m][k] = *(const PG8_LAS bf16x8*)(lds + PG8_SA(b, h) + aoff + m * 2048 + k * 1024); } while (0)
#define PG8_LDB(dst, b, h) do { _Pragma("unroll") for (int n = 0; n < 2; ++n) _Pragma("unroll") for (int k = 0; k < 2; ++k) dst[n][k] = *(const PG8_LAS bf16x8*)(lds + PG8_SB(b, h) + boff + n * 2048 + k * 1024); } while (0)
#define PG8_MMA(ai, bj, At, Bt) do { __builtin_amdgcn_s_setprio(1); _Pragma("unroll") for (int m = 0; m < 4; ++m) _Pragma("unroll") for (int n = 0; n < 2; ++n) _Pragma("unroll") for (int k = 0; k < 2; ++k) \
        acc[ai][bj][m][n] = __builtin_amdgcn_mfma_f32_16x16x32_bf16(Bt[n][k], At[m][k], acc[ai][bj][m][n], 0, 0, 0); __builtin_amdgcn_s_setprio(0); } while (0)
#define PG8_WAIT_V(n) asm volatile("s_waitcnt vmcnt(" #n ")" ::: "memory")
#define PG8_WAIT_L(n) asm volatile("s_waitcnt lgkmcnt(" #n ")" ::: "memory")
#define PG8_BAR __builtin_amdgcn_s_barrier()
#define PG8_SCHED __builtin_amdgcn_sched_barrier(0)
    Unit cur, nxt; int ui = 0;
    if (!S.next(0, cur)) return;
    f32x4 acc[2][2][4][2];
#pragma unroll
    for (int a = 0; a < 2; ++a)
#pragma unroll
        for (int b = 0; b < 2; ++b)
#pragma unroll
            for (int m = 0; m < 4; ++m)
#pragma unroll
                for (int n = 0; n < 2; ++n) acc[a][b][m][n] = (f32x4){0.f, 0.f, 0.f, 0.f};
    bf16x8 At[4][2], B0[2][2], B1[2][2];
    const char* cA = (const char*)g.A + (size_t)cur.pm * tstep; const char* cB = (const char*)g.Bt + (size_t)cur.pn * tstep;
    S.a_ready(cur);
    if constexpr (SP2) {
        PG8_STAGE(PG8_SB(0, 0), cB, voffB); PG8_STAGE(PG8_SB(0, 1), cB + hstep, voffB); PG8_STAGE(PG8_SA(0, 0), cA, voffA); PG8_STAGE(PG8_SA(0, 1), cA + hstep, voffA);
        if (wr == 1) PG8_BAR;
        PG8_WAIT_V(2); PG8_BAR;
        PG8_STAGE(PG8_SB(1, 0), cB + kstep, voffB); PG8_STAGE(PG8_SA(1, 0), cA + kstep, voffA); PG8_STAGE(PG8_SB(1, 1), cB + hstep + kstep, voffB);
        PG8_WAIT_V(6); PG8_BAR;
    } else {
        PG8_STAGE(PG8_SB(0, 0), cB, voffB); PG8_STAGE(PG8_SA(0, 0), cA, voffA); PG8_STAGE(PG8_SB(0, 1), cB + hstep, voffB); PG8_STAGE(PG8_SA(0, 1), cA + hstep, voffA);
        if (wr == 1) PG8_BAR;
        PG8_WAIT_V(4); PG8_BAR;
        PG8_STAGE(PG8_SB(1, 0), cB + kstep, voffB); PG8_STAGE(PG8_SA(1, 0), cA + kstep, voffA); PG8_STAGE(PG8_SB(1, 1), cB + hstep + kstep, voffB);
        PG8_WAIT_V(6); PG8_BAR;
    }
    for (;;) {
        const bool has_next = S.next(ui + 1, nxt);
        const char* nA = has_next ? (const char*)g.A + (size_t)nxt.pm * tstep : cA; const char* nB = has_next ? (const char*)g.Bt + (size_t)nxt.pn * tstep : cB;
        for (int t = 0; t < nt; t += 2) {
            const bool last = (t == nt - 2);
            const char* a1 = cA + (size_t)(t + 1) * kstep;
            const char* a2 = last ? nA : cA + (size_t)(t + 2) * kstep; const char* b2 = last ? nB : cB + (size_t)(t + 2) * kstep;
            const char* a3 = a2 + kstep; const char* b3 = b2 + kstep;
            if (last && has_next) S.a_ready(nxt);
            if constexpr (SP2) {
            PG8_LDB(B0, 0, 0); PG8_LDB(B1, 0, 1); PG8_SCHED; PG8_LDA(At, 0, 0); PG8_STAGE(PG8_SA(1, 1), a1 + hstep, voffA);
            PG8_WAIT_V(8); PG8_WAIT_L(0); PG8_BAR; PG8_MMA(0, 0, At, B0); PG8_MMA(0, 1, At, B1); PG8_BAR; PG8_SCHED;
            PG8_LDA(At, 0, 1); PG8_STAGE(PG8_SB(0, 0), b2, voffB); PG8_STAGE(PG8_SB(0, 1), b2 + hstep, voffB); PG8_STAGE(PG8_SA(0, 0), a2, voffA);
            PG8_WAIT_V(8); PG8_WAIT_L(0); PG8_BAR; PG8_MMA(1, 0, At, B0); PG8_MMA(1, 1, At, B1); PG8_BAR; PG8_SCHED;
            PG8_LDB(B0, 1, 0); PG8_LDB(B1, 1, 1); PG8_SCHED; PG8_LDA(At, 1, 0); PG8_STAGE(PG8_SA(0, 1), a2 + hstep, voffA);
            PG8_WAIT_V(8); PG8_WAIT_L(0); PG8_BAR; PG8_MMA(0, 0, At, B0); PG8_MMA(0, 1, At, B1); PG8_BAR; PG8_SCHED;
            PG8_LDA(At, 1, 1); PG8_STAGE(PG8_SB(1, 0), b3, voffB); PG8_STAGE(PG8_SB(1, 1), b3 + hstep, voffB); PG8_STAGE(PG8_SA(1, 0), a3, voffA);
            PG8_WAIT_V(8); PG8_WAIT_L(0); PG8_BAR; PG8_MMA(1, 0, At, B0); PG8_MMA(1, 1, At, B1); PG8_BAR; PG8_SCHED;
            } else {
            PG8_LDB(B0, 0, 0); PG8_SCHED; PG8_LDA(At, 0, 0); PG8_STAGE(PG8_SA(1, 1), a1 + hstep, voffA);
            PG8_WAIT_L(8); PG8_BAR; PG8_WAIT_L(0); PG8_MMA(0, 0, At, B0); PG8_BAR; PG8_SCHED;
            PG8_LDB(B1, 0, 1); PG8_STAGE(PG8_SB(0, 0), b2, voffB);
            PG8_BAR; PG8_WAIT_L(0); PG8_MMA(0, 1, At, B1); PG8_BAR;
            PG8_LDA(At, 0, 1); PG8_STAGE(PG8_SA(0, 0), a2, voffA);
            PG8_BAR; PG8_WAIT_L(0); PG8_MMA(1, 0, At, B0); PG8_BAR; PG8_SCHED;
            PG8_STAGE(PG8_SB(0, 1), b2 + hstep, voffB);
            PG8_WAIT_V(6); PG8_BAR; PG8_MMA(1, 1, At, B1); PG8_BAR;
            PG8_LDB(B0, 1, 0); PG8_SCHED; PG8_LDA(At, 1, 0); PG8_STAGE(PG8_SA(0, 1), a2 + hstep, voffA);
            PG8_WAIT_L(8); PG8_BAR; PG8_WAIT_L(0); PG8_MMA(0, 0, At, B0); PG8_BAR; PG8_SCHED;
            PG8_LDB(B1, 1, 1); PG8_STAGE(PG8_SB(1, 0), b3, voffB);
            PG8_BAR; PG8_WAIT_L(0); PG8_MMA(0, 1, At, B1); PG8_BAR;
            PG8_LDA(At, 1, 1); PG8_STAGE(PG8_SA(1, 0), a3, voffA);
            PG8_BAR; PG8_WAIT_L(0); PG8_MMA(1, 0, At, B0); PG8_BAR; PG8_SCHED;
            PG8_STAGE(PG8_SB(1, 1), b3 + hstep, voffB);
            PG8_WAIT_V(6); PG8_BAR; PG8_MMA(1, 1, At, B1); PG8_BAR;
            }
        }
        if constexpr (ALIGN_EPI) { if (wr == 0) PG8_BAR; }
        if constexpr (!Epi::AFTER_DRAIN) { E(acc, cur, wr, wc, fr, fq); S.done(cur); }
        if (!has_next) break;
#pragma unroll
        for (int a = 0; a < 2; ++a)
#pragma unroll
            for (int b = 0; b < 2; ++b)
#pragma unroll
                for (int m = 0; m < 4; ++m)
#pragma unroll
                    for (int n = 0; n < 2; ++n) acc[a][b][m][n] = (f32x4){0.f, 0.f, 0.f, 0.f};
        cur = nxt; cA = nA; cB = nB; ++ui;
        if constexpr (ALIGN_EPI) { if (wr == 1) PG8_BAR; }
    }
    PG8_WAIT_V(0);
    if constexpr (!ALIGN_EPI) { if (wr == 0) PG8_BAR; }
    PG8_BAR;
    if constexpr (Epi::AFTER_DRAIN) { E.fused(acc, cur, wr, wc, fr, fq, lds, wid, lane); S.done(cur); }
#undef PG8_SA
#undef PG8_SB
#undef PG8_STAGE
#undef PG8_LDA
#undef PG8_LDB
#undef PG8_MMA
#undef PG8_WAIT_V
#undef PG8_WAIT_L
#undef PG8_BAR
#undef PG8_SCHED
}
}

constexpr size_t MiB = 1u << 20;
constexpr size_t WS_CTL = 0;
constexpr size_t WS_W_IN0 = 1 * MiB, WS_W_OUT0 = 9 * MiB, WS_W_UP0 = 11 * MiB, WS_W_DN0 = 19 * MiB;
constexpr size_t WS_W_IN1 = 27 * MiB, WS_W_OUT1 = 31 * MiB, WS_W_UP1 = 33 * MiB, WS_W_DN1 = 41 * MiB;
constexpr size_t WS_W_C1K = 49 * MiB, WS_W_C1V = 50 * MiB, WS_W_C2K = 51 * MiB, WS_W_C2V = 51 * MiB + 65536;
constexpr size_t WS_XN = 56 * MiB;
constexpr size_t WS_BIG = 120 * MiB;
constexpr size_t WS_R2 = 376 * MiB;
constexpr size_t WS_RSCR2 = 440 * MiB;
constexpr size_t WS_END = 476 * MiB;
constexpr int NWAVES = 8, NTHREADS = 512;
constexpr int LDS_BYTES = 147456;
constexpr int XB_LDS_OFF = LDS_BYTES - 64;
constexpr int CW_BAR = 4096;

struct Args {
    const float* in[33]; float* out; unsigned char* ws; int ph_lo, ph_hi;
};
struct Frame {
    LAS unsigned char* lds;
    int tid, lane, wave, G, bid;
    unsigned char* ws;
    unsigned* ctl;
};
__device__ __forceinline__ Frame fresh(const Frame& F) { Frame G = F; int t = threadIdx.x; asm volatile("" : "+v"(t)); G.tid = t; G.lane = t & 63; G.wave = __builtin_amdgcn_readfirstlane(t >> 6); return G; }
enum { IN_X = 0, IN_POS, IN_NMPRE, IN_NMPOST, IN_NFPRE, IN_NFPOST, IN_WUP, IN_WDN, IN_ABIN, IN_ABOUT, IN_GCONV, IN_GALOG, IN_GDT, IN_GNORM,
       IN_RMU, IN_RW0, IN_RW2, IN_RA0, IN_RA2, IN_RG2, IN_RKK, IN_RKA, IN_RRK, IN_RLNW, IN_RLNB, IN_NWIN, IN_NWOUT, IN_NPEK, IN_NW1K, IN_NW2K, IN_NPEV, IN_NW1V, IN_NW2V };

template <bool LIGHT = false> __device__ __forceinline__ void transpose_item(const float* W, int K, int Nsrc, int src_col0, int cnt, bf16_t* WT, int dst_row0, LAS float* scr, int item, int lane) {
    const int nblk = (cnt + 31) / 32, kb = item / nblk, nb = item % nblk, k0 = 64 * kb, n0 = 32 * nb;
    const int nl = lane & 31; const bool okn = (n0 + nl) < cnt;
    const float* wp = W + (size_t)(k0 + (lane >> 5)) * Nsrc + src_col0 + n0 + nl;
    if constexpr (LIGHT) {
#pragma unroll 8
        for (int i = 0; i < 32; ++i) scr[(2 * i + (lane >> 5)) * 33 + nl] = okn ? wp[(size_t)(2 * i) * Nsrc] : 0.f;
    } else {
        float wv[32];
#pragma unroll
        for (int i = 0; i < 32; ++i) wv[i] = okn ? wp[(size_t)(2 * i) * Nsrc] : 0.f;
#pragma unroll
        for (int i = 0; i < 32; ++i) scr[(2 * i + (lane >> 5)) * 33 + nl] = wv[i];
    }
    asm volatile("s_waitcnt lgkmcnt(0)" ::: "memory");
    const int c = lane & 7;
#pragma unroll
    for (int j = 0; j < 4; ++j) { const int n = (lane >> 3) + 8 * j; const LAS float* s = scr + (8 * c) * 33 + n;
        u32x4 o; o.x = pk2(s[0 * 33], s[1 * 33]); o.y = pk2(s[2 * 33], s[3 * 33]); o.z = pk2(s[4 * 33], s[5 * 33]); o.w = pk2(s[6 * 33], s[7 * 33]);
        if (n0 + n < cnt) *(u32x4*)(WT + (size_t)(dst_row0 + n0 + n) * K + k0 + 8 * c) = o; }
    asm volatile("s_waitcnt lgkmcnt(0)" ::: "memory");
}
template <bool LIGHT = false> __device__ __forceinline__ void transpose_seg(const Frame& F, const float* W, int K, int Nsrc, int src_col0, int cnt, bf16_t* WT, int dst_row0, int bid0 = 0, int nb = 0) {
    LAS float* scr = (LAS float*)(F.lds + F.wave * 16384);
    const int gw = (F.bid - bid0) * NWAVES + F.wave, NGW = (nb ? nb : F.G) * NWAVES;
    const int nitems = (K / 64) * ((cnt + 31) / 32);
    for (int it = gw; it < nitems; it += NGW) transpose_item<LIGHT>(W, K, Nsrc, src_col0, cnt, WT, dst_row0, scr, it, F.lane);
}
__device__ __forceinline__ void zero_rows(const Frame& F, bf16_t* WT, int K, int row0, int nrows, int bid0 = 0, int nb = 0) {
    const int gw = (F.bid - bid0) * NWAVES + F.wave, NGW = (nb ? nb : F.G) * NWAVES;
    unsigned z = 0u; asm volatile("" : "+v"(z));
    for (int r = gw; r < nrows; r += NGW) { u32x4* p = (u32x4*)(WT + (size_t)(row0 + r) * K); for (int j = F.lane; j < K / 8; j += 64) p[j] = (u32x4){z, z, z, z}; }
}
__device__ __forceinline__ void rms_row_to_bf16(const float* xrow, const float* w, bf16_t* orow, int lane) {
    const f32x4* xr = (const f32x4*)xrow + lane; const f32x4* wr = (const f32x4*)w + lane;
    f32x4 v[4]; float s = 0.f;
#pragma unroll
    for (int j = 0; j < 4; ++j) { v[j] = xr[64 * j]; s += (v[j].x * v[j].x + v[j].y * v[j].y) + (v[j].z * v[j].z + v[j].w * v[j].w); }
    const float rstd = 1.f / sqrtf(wave_sum(s) * (1.f / D_MODEL) + NORM_EPS);
    unsigned long long* o8 = (unsigned long long*)orow + lane;
#pragma unroll
    for (int j = 0; j < 4; ++j) { const f32x4 g = wr[64 * j];
        o8[64 * j] = (unsigned long long)pk2(v[j].x * rstd * g.x, v[j].y * rstd * g.y) | ((unsigned long long)pk2(v[j].z * rstd * g.z, v[j].w * rstd * g.w) << 32); }
}
__device__ __forceinline__ void p0_prologue(const Frame& F, const Args& a, bool defer) {
    unsigned char* ws = F.ws;
    const float* abin = a.in[IN_ABIN];
    transpose_seg(F, abin, 1024, AB_IN_W, 0, 2048, (bf16_t*)(ws + WS_W_IN0), 0);
    transpose_seg(F, abin, 1024, AB_IN_W, 2056, 1792, (bf16_t*)(ws + WS_W_IN0), 2048);
    transpose_seg(F, abin, 1024, AB_IN_W, 2048, 8, (bf16_t*)(ws + WS_W_IN0), 3840);
    zero_rows(F, (bf16_t*)(ws + WS_W_IN0), 1024, 3848, 4096 - 3848);
    if (!defer) {
        transpose_seg(F, a.in[IN_ABOUT], 1024, 1024, 0, 1024, (bf16_t*)(ws + WS_W_OUT0), 0);
        transpose_seg(F, a.in[IN_WUP], 1024, 4096, 0, 4096, (bf16_t*)(ws + WS_W_UP0), 0);
        transpose_seg(F, a.in[IN_WDN], 4096, 1024, 0, 1024, (bf16_t*)(ws + WS_W_DN0), 0);
    }
    const int gw = F.bid * NWAVES + F.wave, NGW = F.G * NWAVES;
    const float* x = a.in[IN_X]; bf16_t* XN = (bf16_t*)(ws + WS_XN);
    for (int m = gw; m < MTOK; m += 2 * NGW) {
        const int m2 = m + NGW;
        const f32x4* xr0 = (const f32x4*)(x + (size_t)m * D_MODEL) + F.lane; const f32x4* xr1 = (const f32x4*)(x + (size_t)(m2 < MTOK ? m2 : m) * D_MODEL) + F.lane; const f32x4* wr = (const f32x4*)a.in[IN_NMPRE] + F.lane;
        f32x4 v0[4], v1[4]; float s0 = 0.f, s1 = 0.f;
#pragma unroll
        for (int j = 0; j < 4; ++j) { v0[j] = xr0[64 * j]; v1[j] = xr1[64 * j]; }
#pragma unroll
        for (int j = 0; j < 4; ++j) { s0 += (v0[j].x * v0[j].x + v0[j].y * v0[j].y) + (v0[j].z * v0[j].z + v0[j].w * v0[j].w); s1 += (v1[j].x * v1[j].x + v1[j].y * v1[j].y) + (v1[j].z * v1[j].z + v1[j].w * v1[j].w); }
        const float r0 = 1.f / sqrtf(wave_sum(s0) * (1.f / D_MODEL) + NORM_EPS), r1 = 1.f / sqrtf(wave_sum(s1) * (1.f / D_MODEL) + NORM_EPS);
        unsigned long long* o0 = (unsigned long long*)(XN + (size_t)m * D_MODEL) + F.lane; unsigned long long* o1 = (unsigned long long*)(XN + (size_t)m2 * D_MODEL) + F.lane;
#pragma unroll
        for (int j = 0; j < 4; ++j) { const f32x4 g = wr[64 * j];
            o0[64 * j] = (unsigned long long)pk2(v0[j].x * r0 * g.x, v0[j].y * r0 * g.y) | ((unsigned long long)pk2(v0[j].z * r0 * g.z, v0[j].w * r0 * g.w) << 32);
            if (m2 < MTOK) o1[64 * j] = (unsigned long long)pk2(v1[j].x * r1 * g.x, v1[j].y * r1 * g.y) | ((unsigned long long)pk2(v1[j].z * r1 * g.z, v1[j].w * r1 * g.w) << 32); }
    }
}

__device__ __forceinline__ void p0_layer0_rest(const Frame& F, const Args& a, int bid0, int nb, int part) {
    unsigned char* ws = F.ws;
    if (part == 0) transpose_seg<false>(F, a.in[IN_ABOUT], 1024, 1024, 0, 1024, (bf16_t*)(ws + WS_W_OUT0), 0, bid0, nb);
    if (part == 1) transpose_seg<false>(F, a.in[IN_WUP], 1024, 4096, 0, 4096, (bf16_t*)(ws + WS_W_UP0), 0, bid0, nb);
    if (part == 2) transpose_seg<false>(F, a.in[IN_WDN], 4096, 1024, 0, 1024, (bf16_t*)(ws + WS_W_DN0), 0, bid0, nb);
}
__device__ __forceinline__ void p0_layer1_weights(const Frame& F, const Args& a, int bid0, int nb, int part) {
    unsigned char* ws = F.ws;
    if (part < 0 || part == 0) {
        transpose_seg<false>(F, a.in[IN_NWIN], 1024, NSA_IN_W, 0, NSA_IN_W, (bf16_t*)(ws + WS_W_IN1), 0, bid0, nb);
        zero_rows(F, (bf16_t*)(ws + WS_W_IN1), 1024, NSA_IN_W, 2048 - NSA_IN_W, bid0, nb);
        transpose_seg<false>(F, a.in[IN_NWOUT], 1024, 1024, 0, 1024, (bf16_t*)(ws + WS_W_OUT1), 0, bid0, nb); }
    if (part < 0 || part == 1) transpose_seg<false>(F, a.in[IN_WUP] + (size_t)1024 * 4096, 1024, 4096, 0, 2048, (bf16_t*)(ws + WS_W_UP1), 0, bid0, nb);
    if (part < 0 || part == 2) transpose_seg<false>(F, a.in[IN_WUP] + (size_t)1024 * 4096, 1024, 4096, 2048, 2048, (bf16_t*)(ws + WS_W_UP1), 2048, bid0, nb);
    if (part < 0 || part == 3) transpose_seg<false>(F, a.in[IN_WDN] + (size_t)1024 * 4096, 4096, 1024, 0, 512, (bf16_t*)(ws + WS_W_DN1), 0, bid0, nb);
    if (part < 0 || part == 4) transpose_seg<false>(F, a.in[IN_WDN] + (size_t)1024 * 4096, 4096, 1024, 512, 512, (bf16_t*)(ws + WS_W_DN1), 512, bid0, nb);
    if (part < 0 || part == 5) {
        transpose_seg<false>(F, a.in[IN_NW1K], 2048, 256, 0, 256, (bf16_t*)(ws + WS_W_C1K), 0, bid0, nb);
        transpose_seg<false>(F, a.in[IN_NW1V], 2048, 256, 0, 256, (bf16_t*)(ws + WS_W_C1V), 0, bid0, nb);
        transpose_seg<false>(F, a.in[IN_NW2K], 256, 64, 0, 64, (bf16_t*)(ws + WS_W_C2K), 0, bid0, nb);
        transpose_seg<false>(F, a.in[IN_NW2V], 256, 64, 0, 64, (bf16_t*)(ws + WS_W_C2V), 0, bid0, nb); }
}

#define XB_TMO      128
#define XB_XCNT(j)  (256  + 64 * (j))
#define XB_XSUB(j)  (1280 + 64 * (j))
#define XB_XGEN(j)  (2304 + 64 * (j))
#define XB_TOP      3328
#define XB_TOPGEN   3392
#define XCD_BAR_WORDS 3456
#define XB_SPIN_CAP (1u << 18)

__device__ __forceinline__ unsigned xb_ld(unsigned* p)              { return __hip_atomic_load(p, __ATOMIC_RELAXED, __HIP_MEMORY_SCOPE_AGENT); }
__device__ __forceinline__ unsigned xb_add(unsigned* p, unsigned v) { return __hip_atomic_fetch_add(p, v, __ATOMIC_RELAXED, __HIP_MEMORY_SCOPE_AGENT); }
__device__ __forceinline__ unsigned xb_xcc_id() { return (unsigned)__builtin_amdgcn_s_getreg((3 << 11) | 20) & 0xFu; }
#define XB_SPIN(cond, bar) do { unsigned _sp = 0; while (cond) { __builtin_amdgcn_s_sleep(1); \
    if ((++_sp & 255u) == 0u) { if (xb_ld(&(bar)[XB_TMO])) break; if (_sp > XB_SPIN_CAP) { atomicAdd(&(bar)[XB_TMO], 1u); break; } } } } while (0)

struct XcdBarrier {
    unsigned* bar; unsigned x;
    volatile LAS unsigned* st;
};

__device__ __forceinline__ XcdBarrier xcd_barrier_post(unsigned* bar, volatile LAS unsigned* st) {
    XcdBarrier b; b.bar = bar; b.x = xb_xcc_id(); b.st = st;
    if (threadIdx.x == 0) (void)xb_add(&bar[XB_XCNT(b.x)], 1u);
    return b;
}
__device__ __forceinline__ void xcd_barrier_complete(unsigned* bar, unsigned x, unsigned& nloc, unsigned& nx) {
    const unsigned G = gridDim.x * gridDim.y * gridDim.z;
    unsigned sum, cnt, mine, sp = 0u;
    for (;;) {
        sum = 0u; cnt = 0u; mine = 0u;
#pragma unroll
        for (unsigned j = 0; j < 16; ++j) { const unsigned c = xb_ld(&bar[XB_XCNT(j)]); sum += c; cnt += (c > 0u) ? 1u : 0u; mine = (j == x) ? c : mine; }
        if (sum == G) break;
        __builtin_amdgcn_s_sleep(1);
        if ((++sp & 255u) == 0u) { if (xb_ld(&bar[XB_TMO])) break; if (sp > XB_SPIN_CAP) { atomicAdd(&bar[XB_TMO], 1u); break; } }
    }
    nloc = mine > 0u ? mine : 1u; nx = cnt > 0u ? cnt : 1u;
}

__device__ __forceinline__ void xcd_barrier(const XcdBarrier& b) {
    asm volatile("s_waitcnt vmcnt(0)" ::: "memory");
    __syncthreads();
    if (threadIdx.x == 0) {
        unsigned* bar = b.bar; const unsigned bx = xb_xcc_id();
        __builtin_amdgcn_s_waitcnt(0);
        unsigned nloc = b.st[0], nx = b.st[1];
        if (nloc == 0u) { xcd_barrier_complete(bar, bx, nloc, nx); b.st[0] = nloc; b.st[1] = nx; }
        const unsigned old = xb_add(&bar[XB_XSUB(bx)], 1u);
        const unsigned gen = old / nloc;
        if (old + 1u == (gen + 1u) * nloc) {
            __builtin_amdgcn_fence(__ATOMIC_RELEASE, "agent");
            asm volatile("s_waitcnt vmcnt(0)" ::: "memory");
            const unsigned og = xb_add(&bar[XB_TOP], 1u);
            const unsigned tg = og / nx;
            if (og + 1u == (tg + 1u) * nx) xb_add(&bar[XB_TOPGEN], 1u);
            else XB_SPIN(xb_ld(&bar[XB_TOPGEN]) == tg, bar);
            __builtin_amdgcn_fence(__ATOMIC_ACQUIRE, "agent");
            xb_add(&bar[XB_XGEN(bx)], 1u);
            asm volatile("s_waitcnt vmcnt(0)" ::: "memory");
        } else {
            XB_SPIN(xb_ld(&bar[XB_XGEN(bx)]) == gen, bar);
            __builtin_amdgcn_fence(__ATOMIC_ACQUIRE, "agent");
            asm volatile("s_waitcnt vmcnt(0)" ::: "memory");
        }
    }
    __syncthreads();
}
constexpr size_t GDN_UNIT_ELEMS = 8192;
constexpr size_t WS_INTRA = WS_R2, WS_GLAST = WS_R2 + 16 * MiB;
constexpr int GP_ROWB = 272;
constexpr int GP_QB = 0, GP_KB = 17408, GP_VB = 34816, GP_AM = 52224, GP_SC = 68608, GP_HALF = 69632;
#define MFMA16(a, b, c) __builtin_amdgcn_mfma_f32_16x16x32_bf16((a), (b), (c), 0, 0, 0)

__device__ __forceinline__ bf16x8 lds_aperm(const LAS unsigned char* rowp, int k0, int fq) {
    const u32x2 a = *(const LAS u32x2*)(rowp + (k0 + 4 * fq) * 2), b = *(const LAS u32x2*)(rowp + (k0 + 16 + 4 * fq) * 2);
    u32x4 v; v.x = a.x; v.y = a.y; v.z = b.x; v.w = b.y; return __builtin_bit_cast(bf16x8, v);
}
__device__ __forceinline__ bf16x8 acc_bperm(const f32x4& lo, const f32x4& hi) {
    u32x4 v; v.x = pk2(lo[0], lo[1]); v.y = pk2(lo[2], lo[3]); v.z = pk2(hi[0], hi[1]); v.w = pk2(hi[2], hi[3]); return __builtin_bit_cast(bf16x8, v);
}
__device__ __forceinline__ void gdn_prep_phase(const Frame& F, const Args& a) {
    const bf16_t* F0 = (const bf16_t*)(F.ws + WS_BIG);
    bf16_t* Ut = (bf16_t*)a.out; bf16_t* Wm = Ut + (size_t)2048 * GDN_UNIT_ELEMS; bf16_t* QG = Wm + (size_t)2048 * GDN_UNIT_ELEMS; bf16_t* KGt = QG + (size_t)2048 * GDN_UNIT_ELEMS;
    bf16_t* INTRA = (bf16_t*)(F.ws + WS_INTRA); float* GLAST = (float*)(F.ws + WS_GLAST);
    const float* convw = a.in[IN_GCONV];
    const int hb = F.wave >> 2, wq = F.wave & 3, lane = F.lane, fr = lane & 15, fq = lane >> 4;
    LAS unsigned char* L = F.lds + hb * GP_HALF;
    LAS float* betaL = (LAS float*)(L + GP_SC); LAS float* gcL = betaL + 64;
    LAS bf16_t* Ab = (LAS bf16_t*)(L + GP_AM);
    const int nhalf = F.G * 2, hid = F.bid * 2 + hb;
    LAS float* CW = (LAS float*)(F.lds + 2 * GP_HALF);
    { const int hh = (hid >> 6) & 3;
      for (int e = F.tid; e < 1536; e += NTHREADS) { const int X = e >> 9, i = (e >> 7) & 3, c = e & 127; CW[e] = convw[i * 1536 + X * 512 + hh * 128 + c]; } }
    __syncthreads();
#if defined(PROBE_GP_S1) || defined(PROBE_GP_S2) || defined(PROBE_GP_S3) || defined(PROBE_GP_S1C) || defined(PROBE_GP_S3C)
    const int nrep_ = __builtin_amdgcn_readfirstlane(2 + (int)__hip_atomic_load(F.ctl + 6, __ATOMIC_RELAXED, __HIP_MEMORY_SCOPE_AGENT));
#endif
    for (int u = hid; u < 2048; u += nhalf) {
        const int n = u & 63, h = (u >> 6) & 3, b = u >> 8;
        const size_t m0 = (size_t)b * SEQ + (size_t)n * 64;
        const int tl0 = 16 * wq + 4 * fq;
        float bb = 0.f, aa = 0.f;
        if (wq == 0) { const size_t m = m0 + lane; bb = bf2f(F0[m * F0_LD + F0_BA + h]); aa = bf2f(F0[m * F0_LD + F0_BA + 4 + h]); }
#if defined(PROBE_GP_S1) || defined(PROBE_GP_S1C)
#pragma unroll 1
        for (int rep_ = 0; rep_ < nrep_; ++rep_) {
#endif
        u32x4 rows[3][7];
        {
            const bool lowvalid = (n * 64 + tl0) > 0;
#ifdef PROBE_GP_S1C
            const size_t m0p = (size_t)((b + 4 * (1 - rep_)) & 7) * SEQ + (size_t)n * 64;
            const bf16_t* base = F0 + (m0p + tl0) * F0_LD + h * 128 + 8 * fr;
#else
            const bf16_t* base = F0 + (m0 + tl0) * F0_LD + h * 128 + 8 * fr;
#endif
#pragma unroll
            for (int X = 0; X < 3; ++X)
#pragma unroll
                for (int r = 0; r < 7; ++r) {
                    const long ro = (r < 3 && !lowvalid) ? 0 : (long)(r - 3) * F0_LD;
                    rows[X][r] = *(const u32x4*)(base + ro + X * 512);
                }
            if (!lowvalid) {
#pragma unroll
                for (int X = 0; X < 3; ++X)
#pragma unroll
                    for (int r = 0; r < 3; ++r) rows[X][r] = (u32x4){0u, 0u, 0u, 0u};
            }
        }
        if (wq == 0) {
            int lane = F.lane; asm volatile("" : "+v"(lane));
            const float beta = sigmoidf_(bb);
            float g = -__expf(a.in[IN_GALOG][h]) * fast_softplusf(aa + a.in[IN_GDT][h]);
#pragma unroll
            for (int o = 1; o < 64; o <<= 1) { const float t = __shfl_up(g, o); if (lane >= o) g += t; }
            betaL[lane] = beta; gcL[lane] = g;
            if (lane == 63) GLAST[u] = __expf(g);
        }
#pragma unroll
        for (int X = 0; X < 3; ++X) {
            float acc[4][8];
#pragma unroll
            for (int j = 0; j < 4; ++j)
#pragma unroll
                for (int e = 0; e < 8; ++e) acc[j][e] = 0.f;
#pragma unroll
            for (int i = 0; i < 4; ++i) {
                const f32x4 w0 = *(const LAS f32x4*)(CW + (X * 4 + i) * 128 + 8 * fr), w1 = *(const LAS f32x4*)(CW + (X * 4 + i) * 128 + 8 * fr + 4);
#pragma unroll
                for (int j = 0; j < 4; ++j) { const u32x4 xv = rows[X][j + i];
                    acc[j][0] += w0[0] * bflo(xv.x); acc[j][1] += w0[1] * bfhi(xv.x); acc[j][2] += w0[2] * bflo(xv.y); acc[j][3] += w0[3] * bfhi(xv.y);
                    acc[j][4] += w1[0] * bflo(xv.z); acc[j][5] += w1[1] * bfhi(xv.z); acc[j][6] += w1[2] * bflo(xv.w); acc[j][7] += w1[3] * bfhi(xv.w); }
            }
#pragma unroll
            for (int j = 0; j < 4; ++j) {
                float ss = 0.f;
#pragma unroll
                for (int e = 0; e < 8; ++e) { acc[j][e] = siluf_(acc[j][e]); ss += acc[j][e] * acc[j][e]; }
                float sc = 1.f;
                if (X < 2) {
#pragma unroll
                    for (int o = 1; o < 16; o <<= 1) ss += __shfl_xor(ss, o);
                    sc = rsqrtf(ss + 1e-6f) * (X == 0 ? 0.08838834764831845f : 1.f);
                }
                u32x4 o4; o4.x = pk2(acc[j][0] * sc, acc[j][1] * sc); o4.y = pk2(acc[j][2] * sc, acc[j][3] * sc); o4.z = pk2(acc[j][4] * sc, acc[j][5] * sc); o4.w = pk2(acc[j][6] * sc, acc[j][7] * sc);
                *(LAS u32x4*)(L + (X == 0 ? GP_QB : X == 1 ? GP_KB : GP_VB) + (tl0 + j) * GP_ROWB + fr * 16) = o4;
            }
        }
#if defined(PROBE_GP_S1) || defined(PROBE_GP_S1C)
        }
#endif
        __syncthreads();
#ifdef PROBE_GP_S2
#pragma unroll 1
        for (int rep_ = 0; rep_ < nrep_; ++rep_)
#endif
        {
            bf16x8 ka[4], qa[4];
#pragma unroll
            for (int ks = 0; ks < 4; ++ks) { ka[ks] = *(const LAS bf16x8*)(L + GP_KB + (16 * wq + fr) * GP_ROWB + (32 * ks + 8 * fq) * 2);
                                             qa[ks] = *(const LAS bf16x8*)(L + GP_QB + (16 * wq + fr) * GP_ROWB + (32 * ks + 8 * fq) * 2); }
            {
                const float eg = __expf(gcL[16 * wq + fr]);
#pragma unroll
                for (int ks = 0; ks < 4; ++ks) { const u32x4 qv = __builtin_bit_cast(u32x4, qa[ks]); u32x4 o4;
                    o4.x = pk2(bflo(qv.x) * eg, bfhi(qv.x) * eg); o4.y = pk2(bflo(qv.y) * eg, bfhi(qv.y) * eg); o4.z = pk2(bflo(qv.z) * eg, bfhi(qv.z) * eg); o4.w = pk2(bflo(qv.w) * eg, bfhi(qv.w) * eg);
                    *(u32x4*)(QG + (size_t)u * GDN_UNIT_ELEMS + (16 * wq + fr) * 128 + 32 * ks + 8 * fq) = o4; }
            }
            bf16_t* intra_u = INTRA + (size_t)u * 4096;
#pragma unroll
            for (int nt = 0; nt < 4; ++nt) {
                if (nt <= wq) {
                    f32x4 ckk = (f32x4){0.f, 0.f, 0.f, 0.f}, cqk = (f32x4){0.f, 0.f, 0.f, 0.f};
#pragma unroll
                    for (int ks = 0; ks < 4; ++ks) { const bf16x8 kb = *(const LAS bf16x8*)(L + GP_KB + (16 * nt + fr) * GP_ROWB + (32 * ks + 8 * fq) * 2);
                        ckk = MFMA16(ka[ks], kb, ckk); cqk = MFMA16(qa[ks], kb, cqk); }
                    const int j = 16 * nt + fr; const float gj = gcL[j];
#pragma unroll
                    for (int r = 0; r < 4; ++r) { const int i = 16 * wq + 4 * fq + r; const float d = __expf(gcL[i] - gj);
                        Ab[i * 72 + j] = (bf16_t)f2bf((i > j) ? betaL[i] * ckk[r] * d : 0.f);
                        intra_u[i * 64 + j] = (bf16_t)f2bf((i >= j) ? cqk[r] * d : 0.f); }
                } else {
#pragma unroll
                    for (int r = 0; r < 4; ++r) intra_u[(16 * wq + 4 * fq + r) * 64 + 16 * nt + fr] = 0;
                }
            }
        }
        __syncthreads();
#if defined(PROBE_GP_S3) || defined(PROBE_GP_S3C)
#pragma unroll 1
        for (int rep_ = 0; rep_ < nrep_; ++rep_)
#endif
        {
            int lane = F.lane; asm volatile("" : "+v"(lane));
            const int fr = lane & 15, fq = lane >> 4;
            const bool isk = wq >= 2; const int cb = (wq & 1) * 64;
#ifdef PROBE_GP_S3C
            bf16_t* Ut = rep_ == 0 ? (bf16_t*)(F.ws + WS_XN) : (bf16_t*)a.out; bf16_t* KGt = rep_ == 0 ? (bf16_t*)(F.ws + WS_XN) + (size_t)2048 * GDN_UNIT_ELEMS : (bf16_t*)a.out + (size_t)3 * 2048 * GDN_UNIT_ELEMS;
#endif
            LAS unsigned char* X = L + (isk ? GP_KB : GP_VB);
            LAS unsigned char* AbB = L + GP_AM; LAS unsigned char* Tb = L + GP_AM + 9216;
            {
                const int blk = fq, c = fr;
                float x[16];
#pragma unroll
                for (int k = 0; k < 16; ++k) x[k] = (k == c) ? 1.f : 0.f;
#pragma unroll
                for (int j = 15; j >= 1; --j) {
                    const LAS unsigned char* rowp = AbB + (16 * blk + j) * 144 + 32 * blk;
                    const u32x4 a0 = *(const LAS u32x4*)rowp;
                    float av[16];
                    av[0] = bflo(a0.x); av[1] = bfhi(a0.x); av[2] = bflo(a0.y); av[3] = bfhi(a0.y); av[4] = bflo(a0.z); av[5] = bfhi(a0.z); av[6] = bflo(a0.w); av[7] = bfhi(a0.w);
                    if (j > 8) { const u32x4 a1 = *(const LAS u32x4*)(rowp + 16);
                        av[8] = bflo(a1.x); av[9] = bfhi(a1.x); av[10] = bflo(a1.y); av[11] = bfhi(a1.y); av[12] = bflo(a1.z); av[13] = bfhi(a1.z); av[14] = bflo(a1.w); av[15] = bfhi(a1.w); }
#pragma unroll
                    for (int k = 0; k < j; ++k) x[k] -= x[j] * av[k];
                }
                u32x4 t0, t1;
                t0.x = pk2(x[0], x[1]); t0.y = pk2(x[2], x[3]); t0.z = pk2(x[4], x[5]); t0.w = pk2(x[6], x[7]);
                t1.x = pk2(x[8], x[9]); t1.y = pk2(x[10], x[11]); t1.z = pk2(x[12], x[13]); t1.w = pk2(x[14], x[15]);
                *(LAS u32x4*)(Tb + lane * 32) = t0; *(LAS u32x4*)(Tb + lane * 32 + 16) = t1;
            }
            f32x4 R[4][4];
            const float gl = gcL[63];
#pragma unroll
            for (int blk = 0; blk < 4; ++blk) {
                const f32x4 be = *(const LAS f32x4*)(betaL + 16 * blk + 4 * fq), gc4 = *(const LAS f32x4*)(gcL + 16 * blk + 4 * fq);
                f32x4 sc, kg;
#pragma unroll
                for (int r = 0; r < 4; ++r) { sc[r] = isk ? be[r] * __expf(gc4[r]) : be[r]; kg[r] = __expf(gl - gc4[r]); }
#pragma unroll
                for (int nt = 0; nt < 4; ++nt) {
                    const int col = cb + 16 * nt + fr;
                    f32x4 v;
#pragma unroll
                    for (int r = 0; r < 4; ++r) v[r] = bf2f(*(const LAS bf16_t*)(X + (16 * blk + 4 * fq + r) * GP_ROWB + col * 2));
                    if (isk) { u32x2 o; o.x = pk2(v[0] * kg[0], v[1] * kg[1]); o.y = pk2(v[2] * kg[2], v[3] * kg[3]);
                        *(u32x2*)(KGt + (size_t)u * GDN_UNIT_ELEMS + col * 64 + 16 * blk + 4 * fq) = o; }
#pragma unroll
                    for (int r = 0; r < 4; ++r) R[blk][nt][r] = v[r] * sc[r];
                }
            }
            const f32x4 zero4 = (f32x4){0.f, 0.f, 0.f, 0.f};
            bf16x8 tf[4];
#pragma unroll
            for (int blk = 0; blk < 4; ++blk) { const u32x2 t = *(const LAS u32x2*)(Tb + (16 * blk + fr) * 32 + 8 * fq); u32x4 v; v.x = t.x; v.y = t.y; v.z = 0u; v.w = 0u; tf[blk] = __builtin_bit_cast(bf16x8, v); }
            const bf16x8 a1 = lds_aperm(AbB + (16 + fr) * 144, 0, fq), a2 = lds_aperm(AbB + (32 + fr) * 144, 0, fq), a3a = lds_aperm(AbB + (48 + fr) * 144, 0, fq), a3b = lds_aperm(AbB + (48 + fr) * 144, 32, fq);
#pragma unroll
            for (int nt = 0; nt < 4; ++nt) {
                R[0][nt] = MFMA16(tf[0], acc_bperm(R[0][nt], zero4), zero4);
                u32x4 n0 = __builtin_bit_cast(u32x4, acc_bperm(R[0][nt], zero4)); n0.x ^= 0x80008000u; n0.y ^= 0x80008000u;
                f32x4 t1 = MFMA16(a1, __builtin_bit_cast(bf16x8, n0), R[1][nt]);
                R[1][nt] = MFMA16(tf[1], acc_bperm(t1, zero4), zero4);
                u32x4 n01 = __builtin_bit_cast(u32x4, acc_bperm(R[0][nt], R[1][nt])); n01.x ^= 0x80008000u; n01.y ^= 0x80008000u; n01.z ^= 0x80008000u; n01.w ^= 0x80008000u;
                f32x4 t2 = MFMA16(a2, __builtin_bit_cast(bf16x8, n01), R[2][nt]);
                R[2][nt] = MFMA16(tf[2], acc_bperm(t2, zero4), zero4);
                u32x4 n2 = __builtin_bit_cast(u32x4, acc_bperm(R[2][nt], zero4)); n2.x ^= 0x80008000u; n2.y ^= 0x80008000u;
                f32x4 t3 = MFMA16(a3a, __builtin_bit_cast(bf16x8, n01), R[3][nt]);
                t3 = MFMA16(a3b, __builtin_bit_cast(bf16x8, n2), t3);
                R[3][nt] = MFMA16(tf[3], acc_bperm(t3, zero4), zero4);
            }
#pragma unroll
            for (int blk = 0; blk < 4; ++blk)
#pragma unroll
                for (int nt = 0; nt < 4; ++nt) {
                    const int col = cb + 16 * nt + fr;
                    if (isk) { bf16_t* dst = Wm + (size_t)u * GDN_UNIT_ELEMS + (size_t)(16 * blk + 4 * fq) * 128 + col;
#pragma unroll
                        for (int r = 0; r < 4; ++r) dst[r * 128] = (bf16_t)f2bf(R[blk][nt][r]);
                    } else { u32x2 o; o.x = pk2(R[blk][nt][0], R[blk][nt][1]); o.y = pk2(R[blk][nt][2], R[blk][nt][3]);
                        *(u32x2*)(Ut + (size_t)u * GDN_UNIT_ELEMS + col * 64 + 16 * blk + 4 * fq) = o; }
                }
        }
        __syncthreads();
    }
}

constexpr int GS_W = 0, GS_Q = 17408, GS_I = 34816, GS_K = 44032, GS_U = 62464, GS_Z = 80896;
constexpr int GS_SSQ = GS_Z + 17408;
static_assert(GS_SSQ + 4096 <= XB_LDS_OFF, "gdn scan lds");
__device__ __forceinline__ float red16_dpp(float v) {
    v += dpp_f(v, 0); v += dpp_f(v, 1); v += dpp_f(v, 2);
    const int i = __builtin_bit_cast(int, v); v += __builtin_bit_cast(float, __builtin_amdgcn_update_dpp(i, i, 0x140, 0xF, 0xF, false));
    return v;
}
constexpr size_t WS_GSTATE = WS_R2 + 18 * MiB;
__device__ __forceinline__ void gdn_scan_unit(const Frame& F, const Args& a, int bh, int n0, int n1, bool dry = false) {
    const bf16_t* F0 = (const bf16_t*)(F.ws + WS_BIG);
    const bf16_t* Ut = (const bf16_t*)a.out; const bf16_t* Wm = Ut + (size_t)2048 * GDN_UNIT_ELEMS; const bf16_t* QG = Wm + (size_t)2048 * GDN_UNIT_ELEMS; const bf16_t* KGt = QG + (size_t)2048 * GDN_UNIT_ELEMS;
    const bf16_t* INTRA = (const bf16_t*)(F.ws + WS_INTRA); const float* GLAST = (const float*)(F.ws + WS_GLAST);
    bf16_t* OAB = (bf16_t*)(F.ws + WS_XN);
    const int w = F.wave, lane = F.lane, fr = lane & 15, fq = lane >> 4;
    const int h = bh & 3, b = bh >> 2;
    LAS unsigned char* L = F.lds;
    LAS float* ssq = (LAS float*)(L + GS_SSQ);
    LAS float* glp = ssq + 1000;
#define GS_BAR() do { asm volatile("s_waitcnt lgkmcnt(0)" ::: "memory"); __builtin_amdgcn_s_barrier(); asm volatile("" ::: "memory"); } while (0)
    if (w >= 4) {
        const int lt = F.tid - 256;
        struct GsSet { u32x4 pw[4], pq[4], pz[4], pk[4], pu[4], pi[2]; float pgl; };
        GsSet A, B;
#define GS_FETCH(P_, n_) do { const size_t u_ = (size_t)bh * 64 + (n_); \
            _Pragma("unroll") for (int i_ = 0; i_ < 4; ++i_) { const int e_ = lt + 256 * i_; P_.pw[i_] = *(const u32x4*)(Wm + u_ * GDN_UNIT_ELEMS + (size_t)e_ * 8); P_.pq[i_] = *(const u32x4*)(QG + u_ * GDN_UNIT_ELEMS + (size_t)e_ * 8); \
                P_.pk[i_] = *(const u32x4*)(KGt + u_ * GDN_UNIT_ELEMS + (size_t)e_ * 8); P_.pu[i_] = *(const u32x4*)(Ut + u_ * GDN_UNIT_ELEMS + (size_t)e_ * 8); \
                P_.pz[i_] = *(const u32x4*)(F0 + ((size_t)b * SEQ + (size_t)(n_) * 64 + (e_ >> 4)) * F0_LD + 1536 + h * 128 + (e_ & 15) * 8); } \
            _Pragma("unroll") for (int i_ = 0; i_ < 2; ++i_) P_.pi[i_] = *(const u32x4*)(INTRA + u_ * 4096 + (size_t)(lt + 256 * i_) * 8); \
            P_.pgl = GLAST[u_]; } while (0)
#define GS_STORE(P_, n_) do { \
            _Pragma("unroll") for (int i_ = 0; i_ < 4; ++i_) { const int e_ = lt + 256 * i_; \
                *(LAS u32x4*)(L + GS_W + (e_ >> 4) * 272 + (e_ & 15) * 16) = P_.pw[i_]; *(LAS u32x4*)(L + GS_Q + (e_ >> 4) * 272 + (e_ & 15) * 16) = P_.pq[i_]; *(LAS u32x4*)(L + GS_Z + (e_ >> 4) * 272 + (e_ & 15) * 16) = P_.pz[i_]; \
                *(LAS u32x4*)(L + GS_K + (e_ >> 3) * 144 + (e_ & 7) * 16) = P_.pk[i_]; *(LAS u32x4*)(L + GS_U + (e_ >> 3) * 144 + (e_ & 7) * 16) = P_.pu[i_]; } \
            _Pragma("unroll") for (int i_ = 0; i_ < 2; ++i_) { const int e_ = lt + 256 * i_; *(LAS u32x4*)(L + GS_I + (e_ >> 3) * 144 + (e_ & 7) * 16) = P_.pi[i_]; } \
            if (lt == 0) glp[(n_) & 1] = P_.pgl; } while (0)
        GS_FETCH(A, n0);
        if (n0 + 1 < n1) GS_FETCH(B, n0 + 1);
        __syncthreads();
        GS_STORE(A, n0);
        GS_BAR();
#pragma unroll 1
        for (int n = n0; n < n1; n += 2) {
            if (n + 2 < n1) GS_FETCH(A, n + 2);
            GS_BAR();
            if (n + 1 < n1) GS_STORE(B, n + 1);
            GS_BAR();
            if (n + 3 < n1) GS_FETCH(B, n + 3);
            GS_BAR();
            if (n + 2 < n1) GS_STORE(A, n + 2);
            GS_BAR();
        }
#undef GS_FETCH
#undef GS_STORE
    } else {
        f32x4 S[2][8]; f32x4* GST = (f32x4*)(F.ws + WS_GSTATE) + ((size_t)bh * 8 + 2 * w) * 512;
#pragma unroll
        for (int nt = 0; nt < 2; ++nt)
#pragma unroll
            for (int d = 0; d < 8; ++d) S[nt][d] = (n0 == 0) ? (f32x4){0.f, 0.f, 0.f, 0.f} : GST[nt * 512 + d * 64 + lane];
        float gnw[2]; gnw[0] = a.in[IN_GNORM][32 * w + fr]; gnw[1] = a.in[IN_GNORM][32 * w + 16 + fr];
        __syncthreads();
        GS_BAR();
#pragma unroll 1
        for (int n = n0; n < n1; ++n) {
            const float gl = glp[n & 1];
            bf16x8 Sb[2][4];
#pragma unroll
            for (int nt = 0; nt < 2; ++nt)
#pragma unroll
                for (int ks = 0; ks < 4; ++ks) Sb[nt][ks] = acc_bperm(S[nt][2 * ks], S[nt][2 * ks + 1]);
            f32x4 vn[2][4], o[2][4];
#pragma unroll
            for (int mt = 0; mt < 4; ++mt) { f32x4 p0 = (f32x4){0.f, 0.f, 0.f, 0.f}, p1 = p0, q0 = p0, q1 = p0;
                const LAS unsigned char* wrow = L + GS_W + (16 * mt + fr) * 272; const LAS unsigned char* qrow = L + GS_Q + (16 * mt + fr) * 272;
#pragma unroll
                for (int ks = 0; ks < 4; ++ks) { const bf16x8 wa = lds_aperm(wrow, 32 * ks, fq), qa = lds_aperm(qrow, 32 * ks, fq);
                    p0 = MFMA16(wa, Sb[0][ks], p0); p1 = MFMA16(wa, Sb[1][ks], p1); q0 = MFMA16(qa, Sb[0][ks], q0); q1 = MFMA16(qa, Sb[1][ks], q1); }
                const u32x2 u0 = *(const LAS u32x2*)(L + GS_U + (32 * w + fr) * 144 + (16 * mt + 4 * fq) * 2), u1 = *(const LAS u32x2*)(L + GS_U + (32 * w + 16 + fr) * 144 + (16 * mt + 4 * fq) * 2);
                vn[0][mt] = (f32x4){bflo(u0.x) - p0[0], bfhi(u0.x) - p0[1], bflo(u0.y) - p0[2], bfhi(u0.y) - p0[3]};
                vn[1][mt] = (f32x4){bflo(u1.x) - p1[0], bfhi(u1.x) - p1[1], bflo(u1.y) - p1[2], bfhi(u1.y) - p1[3]};
                o[0][mt] = q0; o[1][mt] = q1; }
            bf16x8 Vb[2][2];
#pragma unroll
            for (int nt = 0; nt < 2; ++nt)
#pragma unroll
                for (int ks = 0; ks < 2; ++ks) Vb[nt][ks] = acc_bperm(vn[nt][2 * ks], vn[nt][2 * ks + 1]);
#pragma unroll
            for (int mt = 0; mt < 4; ++mt) { const LAS unsigned char* irow = L + GS_I + (16 * mt + fr) * 144;
#pragma unroll
                for (int ks = 0; ks < 2; ++ks) { const bf16x8 ia = lds_aperm(irow, 32 * ks, fq); o[0][mt] = MFMA16(ia, Vb[0][ks], o[0][mt]); o[1][mt] = MFMA16(ia, Vb[1][ks], o[1][mt]); } }
#pragma unroll
            for (int d = 0; d < 8; ++d) { S[0][d] = S[0][d] * gl; S[1][d] = S[1][d] * gl; const LAS unsigned char* krow = L + GS_K + (16 * d + fr) * 144;
#pragma unroll
                for (int ks = 0; ks < 2; ++ks) { const bf16x8 ka = lds_aperm(krow, 32 * ks, fq); S[0][d] = MFMA16(ka, Vb[0][ks], S[0][d]); S[1][d] = MFMA16(ka, Vb[1][ks], S[1][d]); } }
            LAS float* sq = ssq + (n & 1) * 256;
            float zv[2][16];
#pragma unroll
            for (int mt = 0; mt < 4; ++mt)
#pragma unroll
                for (int r = 0; r < 4; ++r) { const int t = 16 * mt + 4 * fq + r; const float s = red16_dpp(o[0][mt][r] * o[0][mt][r] + o[1][mt][r] * o[1][mt][r]); if (fr == 0) sq[w * 64 + t] = s;
                    zv[0][4 * mt + r] = bf2f(*(const LAS bf16_t*)(L + GS_Z + t * 272 + (32 * w + fr) * 2)); zv[1][4 * mt + r] = bf2f(*(const LAS bf16_t*)(L + GS_Z + t * 272 + (32 * w + 16 + fr) * 2)); }
            GS_BAR();
#pragma unroll
            for (int mt = 0; mt < 4; ++mt)
#pragma unroll
                for (int r = 0; r < 4; ++r) { const int t = 16 * mt + 4 * fq + r; const float s = (sq[t] + sq[64 + t]) + (sq[128 + t] + sq[192 + t]);
                    const float rstd = rsqrtf(s * (1.f / 128.f) + NORM_EPS);
                    const size_t m = (size_t)b * SEQ + (size_t)n * 64 + t;
                    if (!dry) { OAB[m * 1024 + h * 128 + 32 * w + fr] = (bf16_t)f2bf(o[0][mt][r] * rstd * gnw[0] * siluf_(zv[0][4 * mt + r]));
                                OAB[m * 1024 + h * 128 + 32 * w + 16 + fr] = (bf16_t)f2bf(o[1][mt][r] * rstd * gnw[1] * siluf_(zv[1][4 * mt + r])); } }
            GS_BAR();
        }
#pragma unroll
        for (int nt = 0; nt < 2; ++nt)
#pragma unroll
            for (int d = 0; d < 8; ++d) if (!dry) GST[nt * 512 + d * 64 + lane] = S[nt][d];
    }
#undef GS_BAR
}
constexpr int RW_L = 16;
constexpr int RW_W2T = 0, RW_A2T = 9216, RW_G2T = 18432;
constexpr int RW_OPS = 35840, RW_OPS_SZ = 24576;
constexpr int RW_YB = RW_OPS + 2 * RW_OPS_SZ, RW_YB_SZ = 4096;
constexpr int RW_XS = RW_YB + 2 * RW_YB_SZ, RW_XS_W = 2240;
constexpr int RW_XS_AD = 576, RW_XS_GD = 1152;
constexpr int RW_POST = RW_XS + 4 * RW_XS_W, RW_POST_SZ = 8192;
static_assert(RW_POST + 3 * RW_POST_SZ <= XB_LDS_OFF, "rwkv lds");
#define RW_BAR() do { asm volatile("s_waitcnt lgkmcnt(0)" ::: "memory"); __builtin_amdgcn_s_barrier(); asm volatile("" ::: "memory"); } while (0)
__device__ __forceinline__ float wave_sum_rl(float v) {
    v = red16_dpp(v);
    const int i = __builtin_bit_cast(int, v);
    return (__builtin_bit_cast(float, __builtin_amdgcn_readlane(i, 0)) + __builtin_bit_cast(float, __builtin_amdgcn_readlane(i, 16))) + (__builtin_bit_cast(float, __builtin_amdgcn_readlane(i, 32)) + __builtin_bit_cast(float, __builtin_amdgcn_readlane(i, 48)));
}

__device__ __forceinline__ void rwkv_unit(const Frame& F, const Args& a, int bh) {
    const bf16_t* F0 = (const bf16_t*)(F.ws + WS_BIG);
    bf16_t* OAB = (bf16_t*)(F.ws + WS_XN);
    const int h = bh & 7, b = bh >> 3, tid = F.tid, lane = F.lane, wave = F.wave, fr = lane & 15, fq = lane >> 4;
    LAS unsigned char* L = F.lds;
    for (int idx = tid; idx < 64 * 64; idx += NTHREADS) { const int j = idx >> 6, c = idx & 63;
        *(LAS bf16_t*)(L + RW_W2T + c * 144 + j * 2) = (bf16_t)f2bf(a.in[IN_RW2][j * 512 + h * 64 + c]);
        *(LAS bf16_t*)(L + RW_A2T + c * 144 + j * 2) = (bf16_t)f2bf(a.in[IN_RA2][j * 512 + h * 64 + c]); }
    for (int idx = tid; idx < 128 * 64; idx += NTHREADS) { const int j = idx >> 6, c = idx & 63;
        *(LAS bf16_t*)(L + RW_G2T + c * 272 + j * 2) = (bf16_t)f2bf(a.in[IN_RG2][j * 512 + h * 64 + c]); }
    RW_BAR();
    const size_t mb = (size_t)b * SEQ;
    if (wave < 4) {
        f32x2 S0[4], S1[4];
#pragma unroll
        for (int k = 0; k < 4; ++k) { S0[k] = (f32x2){0.f, 0.f}; S1[k] = (f32x2){0.f, 0.f}; }
        const int cg = lane & 7, row0 = 16 * wave + 2 * (lane >> 3);
        RW_BAR();
#pragma unroll 1
        for (int c = 0; c < SEQ / RW_L; ++c) {
            LAS unsigned char* ops = L + RW_OPS + (c & 1) * RW_OPS_SZ; LAS float* yb = (LAS float*)(L + RW_YB + (c & 1) * RW_YB_SZ);
            f32x4 wA, wB, kkA, kkB, bA, bB, kA, kB, rA, rB; f32x2 vv;
#define RW_LOADOPS(s_) do { const LAS float* po_ = (const LAS float*)(ops + (s_) * 1536) + 8 * cg; \
                wA = *(const LAS f32x4*)(po_); wB = *(const LAS f32x4*)(po_ + 4); kkA = *(const LAS f32x4*)(po_ + 64); kkB = *(const LAS f32x4*)(po_ + 68); \
                bA = *(const LAS f32x4*)(po_ + 128); bB = *(const LAS f32x4*)(po_ + 132); kA = *(const LAS f32x4*)(po_ + 192); kB = *(const LAS f32x4*)(po_ + 196); \
                rA = *(const LAS f32x4*)(po_ + 256); rB = *(const LAS f32x4*)(po_ + 260); vv = *(const LAS f32x2*)((const LAS float*)(ops + (s_) * 1536) + 320 + row0); } while (0)
            RW_LOADOPS(0);
#pragma unroll 1
            for (int s = 0; s < RW_L; ++s) {
                const f32x2 kk2[4] = {{kkA[0], kkA[1]}, {kkA[2], kkA[3]}, {kkB[0], kkB[1]}, {kkB[2], kkB[3]}};
                const f32x2 w2[4] = {{wA[0], wA[1]}, {wA[2], wA[3]}, {wB[0], wB[1]}, {wB[2], wB[3]}};
                const f32x2 b2[4] = {{bA[0], bA[1]}, {bA[2], bA[3]}, {bB[0], bB[1]}, {bB[2], bB[3]}};
                const f32x2 k2[4] = {{kA[0], kA[1]}, {kA[2], kA[3]}, {kB[0], kB[1]}, {kB[2], kB[3]}};
                const f32x2 r2[4] = {{rA[0], rA[1]}, {rA[2], rA[3]}, {rB[0], rB[1]}, {rB[2], rB[3]}};
                const f32x2 v0 = {vv[0], vv[0]}, v1 = {vv[1], vv[1]};
                if (s + 1 < RW_L) RW_LOADOPS(s + 1);
                f32x2 a0 = S0[0] * kk2[0] + S0[1] * kk2[1], a1 = S1[0] * kk2[0] + S1[1] * kk2[1];
                a0 = a0 + S0[2] * kk2[2] + S0[3] * kk2[3]; a1 = a1 + S1[2] * kk2[2] + S1[3] * kk2[3];
                const float sa0 = red8_dpp(a0[0] + a0[1]), sa1 = red8_dpp(a1[0] + a1[1]);
                const f32x2 n0 = {-sa0, -sa0}, n1 = {-sa1, -sa1};
                f32x2 y0 = {0.f, 0.f}, y1 = {0.f, 0.f};
#pragma unroll
                for (int q = 0; q < 4; ++q) { S0[q] = S0[q] * w2[q] + n0 * b2[q] + v0 * k2[q]; S1[q] = S1[q] * w2[q] + n1 * b2[q] + v1 * k2[q]; y0 = y0 + S0[q] * r2[q]; y1 = y1 + S1[q] * r2[q]; }
                const float ys0 = red8_dpp(y0[0] + y0[1]), ys1 = red8_dpp(y1[0] + y1[1]);
                if (cg == 0) *(LAS f32x2*)(yb + s * 64 + row0) = (f32x2){ys0, ys1};
            }
#undef RW_LOADOPS
            RW_BAR();
        }
        RW_BAR();
    } else {
        const int p = wave - 4, hc = h * 64 + lane;
        LAS unsigned char* XS = L + RW_XS + p * RW_XS_W;
        const float w0c = a.in[IN_RW0][hc], a0c = a.in[IN_RA0][hc], kkc = a.in[IN_RKK][hc], kac = a.in[IN_RKA][hc], rkc = a.in[IN_RRK][hc], lnw = a.in[IN_RLNW][hc], lnb = a.in[IN_RLNB][hc];
        float mu[7];
#pragma unroll
        for (int g = 0; g < 3; ++g) mu[g] = a.in[IN_RMU][g * 512 + hc];
#pragma unroll
        for (int g = 3; g < 7; ++g) mu[g] = a.in[IN_RMU][1536 + (g - 3) * 64 + lane];
        bf16_t fv[5][7];
#define RW_FETCH(cn_) do { const long t0_ = (long)(cn_) * RW_L + 4 * p - 1; \
            _Pragma("unroll") for (int j_ = 0; j_ < 5; ++j_) { const long t_ = t0_ + j_; \
                _Pragma("unroll") for (int g_ = 0; g_ < 7; ++g_) { const int col_ = F0_RWKV + (g_ < 3 ? g_ * 512 + h * 64 : 1536 + (g_ - 3) * 64) + lane; fv[j_][g_] = (t_ >= 0) ? F0[(mb + t_) * F0_LD + col_] : (bf16_t)0; } } } while (0)
        RW_FETCH(0);
#pragma unroll 1
        for (int c = -1; c <= SEQ / RW_L; ++c) {
            const bool prep_on = (c + 1 < SEQ / RW_L), post_on = (c >= 1);
            if (post_on) {
                const LAS float* yb = (const LAS float*)(L + RW_YB + ((c - 1) & 1) * RW_YB_SZ); const LAS float* pg = (const LAS float*)(L + RW_POST + ((c - 1) % 3) * RW_POST_SZ);
#pragma unroll
                for (int j = 0; j < 4; ++j) { const int tau = 4 * p + j; const float y = yb[tau * 64 + lane];
                    const float mean = wave_sum_rl(y) * (1.f / 64.f); const float d = y - mean; const float var = wave_sum_rl(d * d) * (1.f / 64.f);
                    const float o = (d * rsqrtf(var + RWKV_LN_EPS) * lnw + lnb + pg[1024 + tau * 64 + lane]) * pg[tau * 64 + lane];
                    OAB[(mb + (size_t)(c - 1) * RW_L + tau) * 1024 + 512 + hc] = (bf16_t)f2bf(o); }
            }
            if (prep_on) {
                LAS unsigned char* nops = L + RW_OPS + ((c + 1) & 1) * RW_OPS_SZ; LAS float* pg_n = (LAS float*)(L + RW_POST + ((c + 1) % 3) * RW_POST_SZ);
                float xr[4], xk[4], xv[4];
#pragma unroll
                for (int j = 0; j < 4; ++j) {
                    float xs[7];
#pragma unroll
                    for (int g = 0; g < 7; ++g) { const float f = bf2f(fv[j + 1][g]), fp = bf2f(fv[j][g]); xs[g] = f + (fp - f) * mu[g]; }
                    xr[j] = xs[0]; xk[j] = xs[1]; xv[j] = xs[2];
                    *(LAS bf16_t*)(XS + j * 144 + lane * 2) = (bf16_t)f2bf(fast_tanhf(xs[3]));
                    *(LAS bf16_t*)(XS + RW_XS_AD + j * 144 + lane * 2) = (bf16_t)f2bf(xs[4]);
                    *(LAS bf16_t*)(XS + RW_XS_GD + j * 272 + lane * 2) = (bf16_t)f2bf(sigmoidf_(xs[5]));
                    *(LAS bf16_t*)(XS + RW_XS_GD + j * 272 + 128 + lane * 2) = (bf16_t)f2bf(sigmoidf_(xs[6]));
                }
                if (c + 2 < SEQ / RW_L) RW_FETCH(c + 2);
                asm volatile("s_waitcnt lgkmcnt(0)" ::: "memory");
                f32x4 cw = (f32x4){0.f, 0.f, 0.f, 0.f}, ca = cw, cgt = cw;
                {
                    bf16x8 xa[2], xb[2], xg[4];
#pragma unroll
                    for (int ks = 0; ks < 2; ++ks) { xa[ks] = *(const LAS bf16x8*)(XS + (fr & 3) * 144 + (32 * ks + 8 * fq) * 2); xb[ks] = *(const LAS bf16x8*)(XS + RW_XS_AD + (fr & 3) * 144 + (32 * ks + 8 * fq) * 2); }
#pragma unroll
                    for (int ks = 0; ks < 4; ++ks) xg[ks] = *(const LAS bf16x8*)(XS + RW_XS_GD + (fr & 3) * 272 + (32 * ks + 8 * fq) * 2);
#pragma unroll
                    for (int nt = 0; nt < 4; ++nt) {
                        f32x4 tw = (f32x4){0.f, 0.f, 0.f, 0.f}, ta = tw, tg = tw;
#pragma unroll
                        for (int ks = 0; ks < 2; ++ks) { tw = MFMA16(xa[ks], *(const LAS bf16x8*)(L + RW_W2T + (16 * nt + fr) * 144 + (32 * ks + 8 * fq) * 2), tw);
                                                         ta = MFMA16(xb[ks], *(const LAS bf16x8*)(L + RW_A2T + (16 * nt + fr) * 144 + (32 * ks + 8 * fq) * 2), ta); }
#pragma unroll
                        for (int ks = 0; ks < 4; ++ks) tg = MFMA16(xg[ks], *(const LAS bf16x8*)(L + RW_G2T + (16 * nt + fr) * 272 + (32 * ks + 8 * fq) * 2), tg);
                        if (fq == nt) { cw = tw; ca = ta; cgt = tg; }
                    }
                }
#pragma unroll
                for (int j = 0; j < 4; ++j) { const int tau = 4 * p + j; LAS float* o = (LAS float*)(nops + tau * 1536);
                    const float lw = cw[j] + w0c; const float wlog = -fast_softplusf(-lw) - 0.5f; const float wdec = __expf(-__expf(wlog));
                    const float av = sigmoidf_(ca[j] + a0c);
                    const float kkraw = xk[j] * kkc, kp = xk[j] * (1.f + (av - 1.f) * kac);
                    const float rinv = rsqrtf(wave_sum_rl(kkraw * kkraw) + 1e-6f);
                    const float bn = wave_sum_rl(xr[j] * kp * rkc);
                    const float kkn = kkraw * rinv;
                    o[lane] = wdec; o[64 + lane] = kkn; o[128 + lane] = kkn * av; o[192 + lane] = kp; o[256 + lane] = xr[j]; o[320 + lane] = xv[j];
                    pg_n[tau * 64 + lane] = cgt[j]; pg_n[1024 + tau * 64 + lane] = xv[j] * bn; }
            }
            RW_BAR();
        }
#undef RW_FETCH
    }
    __syncthreads();
}
constexpr int RC_KR = 0, RC_BKT = 4096, RC_VT = 8192, RC_MBB = 10240, RC_MKB = 11264, RC_MBR = 11776, RC_MKR = 12288, RC_WL = 12800, RC_PG = 13056, RC_PBV = 15104, RC_REC = 17408;
constexpr int RC_SEG_CHUNKS = 32, RC_NSEG = (SEQ / 16) / RC_SEG_CHUNKS;
constexpr size_t WS_RSCR = WS_R2 + 21 * MiB;
constexpr size_t WS_RSTATE = WS_R2 + 17 * MiB;
constexpr size_t WS_RIMG = WS_R2 + 20 * MiB;
constexpr int RP_PRM = 35840;
constexpr int RP_MU = RP_PRM + 1280;
constexpr int RP_WAVE = RP_MU + 1792, RP_WAVE_SZ = 9216;
static_assert(RP_WAVE + 8 * RP_WAVE_SZ <= XB_LDS_OFF, "rwkv prep lds");
__device__ __forceinline__ float dpp_shr_f(float v, const int n) {
    const int i = __builtin_bit_cast(int, v); int r;
    if (n == 1) r = __builtin_amdgcn_update_dpp(0, i, 0x111, 0xF, 0xF, true); else if (n == 2) r = __builtin_amdgcn_update_dpp(0, i, 0x112, 0xF, 0xF, true);
    else if (n == 4) r = __builtin_amdgcn_update_dpp(0, i, 0x114, 0xF, 0xF, true); else r = __builtin_amdgcn_update_dpp(0, i, 0x118, 0xF, 0xF, true);
    return __builtin_bit_cast(float, r);
}
__device__ __forceinline__ void rwkvc_prep_phase(const Frame& F, const Args& a, int sg, int bid0, int nb) {
    const bf16_t* F0 = (const bf16_t*)(F.ws + WS_BIG);
    unsigned char* SCR = F.ws + ((sg & 1) ? WS_RSCR2 : WS_RSCR);
    const int tid = F.tid, wave = F.wave;
    LAS unsigned char* L = F.lds;
    int prev_h = -1;
    for (int blk = F.bid - bid0; blk < 256; blk += nb) {
        const int bh = blk >> 2, h = bh & 7, b = bh >> 3;
        const size_t mb = (size_t)b * SEQ;
        LAS unsigned char* XS = L + RP_WAVE + wave * RP_WAVE_SZ;
            int ln_ = F.lane; asm volatile("" : "+v"(ln_));
            const int lane = ln_, fr = ln_ & 15, fq = ln_ >> 4;
            const int cs = (blk & 3) * 8 + wave;
            const int t0 = (sg * RC_SEG_CHUNKS + cs) * 16;
            unsigned char* rec = SCR + ((size_t)bh * RC_SEG_CHUNKS + cs) * RC_REC;
            const bf16_t* rowc = F0 + (mb + t0 + fr) * F0_LD + F0_RWKV;
            const bool hasp = (t0 + fr) > 0; const bf16_t* rowp = rowc - (hasp ? F0_LD : 0);
            const bf16_t* rc4 = rowc + 4 * fq; const bf16_t* rp4 = rowp + 4 * fq; const LAS float* mul4 = (const LAS float*)(L + RP_MU) + 4 * fq;
            unsigned char* pbkt = rec + RC_BKT + fq * 256 + (fr >> 2) * 16 + (fr & 3) * 2;
            unsigned char* pvt = rec + RC_VT + fq * 128 + fr * 2;
            unsigned char* pwl = rec + RC_WL + fq * 16;
            unsigned char* ppg = rec + RC_PG + fr * 128 + fq * 8;
            LAS unsigned char* xs4 = XS + fr * 144 + fq * 8;
            u32x2 rawc[7][4], rawp[7][4];
#pragma unroll
            for (int g = 3; g < 7; ++g)
#pragma unroll
                for (int mt = 0; mt < 4; ++mt) { const int coff = 1536 + 64 * (g - 3) + 16 * mt; rawc[g][mt] = *(const u32x2*)(rc4 + coff); rawp[g][mt] = *(const u32x2*)(rp4 + coff); }
        if (h != prev_h) {
        __syncthreads();
        {
            const u32x4* src = (const u32x4*)(F.ws + WS_RIMG + (size_t)h * 35840);
            u32x4 t4[5];
#pragma unroll
            for (int i = 0; i < 5; ++i) { const int e = tid + NTHREADS * i; t4[i] = (e < 2240) ? src[e] : (u32x4){0u, 0u, 0u, 0u}; }
#pragma unroll
            for (int i = 0; i < 5; ++i) { const int e = tid + NTHREADS * i; if (e < 2240) *(LAS u32x4*)(L + e * 16) = t4[i]; }
        }
        if (tid < 320) { const int wh = tid >> 6, c = tid & 63; const float* src = wh == 0 ? a.in[IN_RW0] : wh == 1 ? a.in[IN_RA0] : wh == 2 ? a.in[IN_RKK] : wh == 3 ? a.in[IN_RKA] : a.in[IN_RRK];
            ((LAS float*)(L + RP_PRM))[tid] = src[h * 64 + c]; }
        if (tid < 448) ((LAS float*)(L + RP_MU))[tid] = a.in[IN_RMU][tid < 192 ? (tid >> 6) * 512 + h * 64 + (tid & 63) : 1536 + (tid - 192)];
        __syncthreads();
        prev_h = h; }
        const LAS float* PRM = (const LAS float*)(L + RP_PRM);
        {
#pragma unroll
            for (int g = 0; g < 4; ++g) {
                const int coff = 1536 + 64 * g;
#pragma unroll
                for (int mt = 0; mt < 4; ++mt) { const int j0 = 16 * mt + 4 * fq;
                    const u32x2 fc = rawc[3 + g][mt]; u32x2 fp = rawp[3 + g][mt]; if (!hasp) fp = (u32x2){0u, 0u};
                    const f32x4 mu = *(const LAS f32x4*)(mul4 + 192 + 64 * g + 16 * mt);
                    float x[4] = {bflo(fc.x), bfhi(fc.x), bflo(fc.y), bfhi(fc.y)}; const float xp[4] = {bflo(fp.x), bfhi(fp.x), bflo(fp.y), bfhi(fp.y)};
#pragma unroll
                    for (int e = 0; e < 4; ++e) { x[e] = x[e] + (xp[e] - x[e]) * mu[e]; x[e] = (g == 0) ? fast_tanhf(x[e]) : (g == 1) ? x[e] : sigmoidf_(x[e]); }
                    u32x2 o; o.x = pk2(x[0], x[1]); o.y = pk2(x[2], x[3]);
                    LAS unsigned char* dst = (g == 0) ? XS + fr * 144 + j0 * 2 : (g == 1) ? XS + 2304 + fr * 144 + j0 * 2 : XS + 4608 + fr * 272 + (g - 2) * 128 + j0 * 2;
                    *(LAS u32x2*)dst = o; } }
#pragma unroll
            for (int g = 0; g < 3; ++g)
#pragma unroll
                for (int mt = 0; mt < 4; ++mt) { const int coff = g * 512 + h * 64 + 16 * mt; rawc[g][mt] = *(const u32x2*)(rc4 + coff); rawp[g][mt] = *(const u32x2*)(rp4 + coff); }
            asm volatile("s_waitcnt lgkmcnt(0)" ::: "memory");
            float vr[16], vk[16], vv[16], ve[16], vkk[16], vb[16];
            float ss = 0.f, bn = 0.f;
            bf16x8 xw[2], xa[2], xg[4];
#pragma unroll
            for (int ks = 0; ks < 2; ++ks) { xw[ks] = *(const LAS bf16x8*)(XS + fr * 144 + (32 * ks + 8 * fq) * 2); xa[ks] = *(const LAS bf16x8*)(XS + 2304 + fr * 144 + (32 * ks + 8 * fq) * 2); }
#pragma unroll
            for (int ks = 0; ks < 4; ++ks) xg[ks] = *(const LAS bf16x8*)(XS + 4608 + fr * 272 + (32 * ks + 8 * fq) * 2);
#pragma unroll
            for (int mt = 0; mt < 4; ++mt) {
#pragma unroll
                for (int g = 0; g < 3; ++g) { const int coff = g * 512 + 16 * mt;
                    const u32x2 fc = rawc[g][mt]; u32x2 fp = rawp[g][mt]; if (!hasp) fp = (u32x2){0u, 0u};
                    const f32x4 mu = *(const LAS f32x4*)(mul4 + 64 * g + 16 * mt);
                    const float x[4] = {bflo(fc.x), bfhi(fc.x), bflo(fc.y), bfhi(fc.y)}; const float xp[4] = {bflo(fp.x), bfhi(fp.x), bflo(fp.y), bfhi(fp.y)};
#pragma unroll
                    for (int e = 0; e < 4; ++e) { const float xs = x[e] + (xp[e] - x[e]) * mu[e]; if (g == 0) vr[4 * mt + e] = xs; else if (g == 1) vk[4 * mt + e] = xs; else vv[4 * mt + e] = xs; } }
                f32x4 cw = (f32x4){0.f, 0.f, 0.f, 0.f}, ca = cw, cg = cw;
#pragma unroll
                for (int ks = 0; ks < 2; ++ks) { cw = MFMA16(*(const LAS bf16x8*)(L + RW_W2T + (16 * mt + fr) * 144 + (32 * ks + 8 * fq) * 2), xw[ks], cw);
                                                 ca = MFMA16(*(const LAS bf16x8*)(L + RW_A2T + (16 * mt + fr) * 144 + (32 * ks + 8 * fq) * 2), xa[ks], ca); }
#pragma unroll
                for (int ks = 0; ks < 4; ++ks) cg = MFMA16(*(const LAS bf16x8*)(L + RW_G2T + (16 * mt + fr) * 272 + (32 * ks + 8 * fq) * 2), xg[ks], cg);
#pragma unroll
                for (int r = 0; r < 4; ++r) { const int q = 4 * mt + r, c = 16 * mt + 4 * fq + r;
                    const float lw = cw[r] + PRM[c]; ve[q] = 0.6065306597126334f * sigmoidf_(lw);
                    const float av = sigmoidf_(ca[r] + PRM[64 + c]);
                    const float kraw = vk[q] * PRM[128 + c]; vk[q] = vk[q] * (1.f + (av - 1.f) * PRM[192 + c]);
                    vkk[q] = kraw; vb[q] = av; ss += kraw * kraw; bn += vr[q] * vk[q] * PRM[256 + c]; }
                { u32x2 og; og.x = pk2(cg[0], cg[1]); og.y = pk2(cg[2], cg[3]); *(u32x2*)(ppg + mt * 32) = og; }
                asm volatile("" ::: "memory");
            }
            ss += __shfl_xor(ss, 16); ss += __shfl_xor(ss, 32); bn += __shfl_xor(bn, 16); bn += __shfl_xor(bn, 32);
            const float rinv = rsqrtf(ss + 1e-6f);
#pragma unroll
            for (int mt = 0; mt < 4; ++mt) { u32x2 ob; ob.x = pk2(vv[4 * mt] * bn, vv[4 * mt + 1] * bn); ob.y = pk2(vv[4 * mt + 2] * bn, vv[4 * mt + 3] * bn); *(u32x2*)(ppg + 2048 + mt * 32) = ob; }
#pragma unroll
            for (int ks = 0; ks < 2; ++ks) {
                float kkt[8], rt[8], bh_[8], kh[8];
#pragma unroll
                for (int i = 0; i < 8; ++i) { const int q = 8 * ks + i;
                    float cl = ve[q];
                    cl += dpp_shr_f(cl, 1); cl += dpp_shr_f(cl, 2); cl += dpp_shr_f(cl, 4); cl += dpp_shr_f(cl, 8);
                    const float clL = __shfl(cl, (lane & 48) | 15);
                    const float kkn = vkk[q] * rinv, bq = kkn * vb[q];
                    const float W = __expf(-cl), Wp = __expf(ve[q] - cl), Wi = __expf(cl), WLr = __expf(cl - clL);
                    kkt[i] = kkn * Wp; rt[i] = vr[q] * W; bh_[i] = bq * Wi; kh[i] = vk[q] * Wi;
                    *(bf16_t*)(pbkt + (q >> 2) * 1024 + (q & 3) * 64) = (bf16_t)f2bf(-bq * WLr);
                    *(bf16_t*)(pbkt + (q >> 2) * 1024 + (q & 3) * 64 + 8) = (bf16_t)f2bf(vk[q] * WLr);
                    *(bf16_t*)(pvt + (q >> 2) * 512 + (q & 3) * 32) = (bf16_t)f2bf(vv[q]);
                    if (fr == 15) *(float*)(pwl + (q >> 2) * 64 + (q & 3) * 4) = W;
                }
                u32x4 o1, o2;
                o1.x = pk2(kkt[0], kkt[1]); o1.y = pk2(kkt[2], kkt[3]); o1.z = pk2(kkt[4], kkt[5]); o1.w = pk2(kkt[6], kkt[7]);
                o2.x = pk2(rt[0], rt[1]); o2.y = pk2(rt[2], rt[3]); o2.z = pk2(rt[4], rt[5]); o2.w = pk2(rt[6], rt[7]);
                *(u32x4*)(rec + RC_KR + fr * 128 + ks * 64 + fq * 16) = o1; *(u32x4*)(rec + RC_KR + 2048 + fr * 128 + ks * 64 + fq * 16) = o2;
#pragma unroll
                for (int m2 = 0; m2 < 2; ++m2) { const int mt = 2 * ks + m2; LAS unsigned char* xo = xs4 + mt * 32;
                    *(LAS u32x2*)(xo) = (u32x2){o1[2 * m2], o1[2 * m2 + 1]};
                    *(LAS u32x2*)(xo + 2304) = (u32x2){o2[2 * m2], o2[2 * m2 + 1]};
                    u32x2 o; o.x = pk2(bh_[4 * m2], bh_[4 * m2 + 1]); o.y = pk2(bh_[4 * m2 + 2], bh_[4 * m2 + 3]); *(LAS u32x2*)(xo + 4608) = o;
                    o.x = pk2(kh[4 * m2], kh[4 * m2 + 1]); o.y = pk2(kh[4 * m2 + 2], kh[4 * m2 + 3]); *(LAS u32x2*)(xo + 6912) = o; }
                asm volatile("" ::: "memory");
            }
            asm volatile("s_waitcnt lgkmcnt(0)" ::: "memory");
            f32x4 mbb = (f32x4){0.f, 0.f, 0.f, 0.f}, mkb = mbb, mbr = mbb, mkr = mbb;
#pragma unroll
            for (int ks = 0; ks < 2; ++ks) { const int off = fr * 144 + (32 * ks + 8 * fq) * 2;
                const bf16x8 akk = *(const LAS bf16x8*)(XS + off), ar = *(const LAS bf16x8*)(XS + 2304 + off), bb = *(const LAS bf16x8*)(XS + 4608 + off), bk = *(const LAS bf16x8*)(XS + 6912 + off);
                mbb = MFMA16(akk, bb, mbb); mkb = MFMA16(akk, bk, mkb); mbr = MFMA16(ar, bb, mbr); mkr = MFMA16(ar, bk, mkr); }
            {
                float T[16]; const float mf0 = mbb[0], mf1 = mbb[1], mf2 = mbb[2], mf3 = mbb[3];
                const int mb_[4] = {__builtin_bit_cast(int, mf0), __builtin_bit_cast(int, mf1), __builtin_bit_cast(int, mf2), __builtin_bit_cast(int, mf3)};
#pragma unroll
                for (int t = 0; t < 16; ++t) T[t] = (t == fr) ? 1.f : 0.f;
#pragma unroll
                for (int t = 1; t < 16; ++t) { float s0 = T[t], s1 = 0.f;
#pragma unroll
                    for (int j = 0; j < t; ++j) { const float m = __builtin_bit_cast(float, __builtin_amdgcn_readlane(mb_[t & 3], j + 16 * (t >> 2)));
                        if (j & 1) s1 -= m * T[j]; else s0 -= m * T[j]; }
                    T[t] = s0 + s1; }
                if (fq == 0) {
#pragma unroll
                    for (int t = 0; t < 16; ++t) { const bf16_t tv = (bf16_t)f2bf(T[t]); *(bf16_t*)(rec + RC_MBB + t * 64 + (fr >> 2) * 16 + (fr & 3) * 2) = tv; *(bf16_t*)(rec + RC_MBB + t * 64 + (fr >> 2) * 16 + 8 + (fr & 3) * 2) = tv; }
                }
            }
#pragma unroll
            for (int r = 0; r < 4; ++r) { const int t = 4 * fq + r, j = fr;
                *(bf16_t*)(rec + RC_MKB + t * 32 + j * 2) = (bf16_t)f2bf((j < t) ? mkb[r] : 0.f);
                *(bf16_t*)(rec + RC_MBR + t * 32 + j * 2) = (bf16_t)f2bf((j <= t) ? mbr[r] : 0.f);
                *(bf16_t*)(rec + RC_MKR + t * 32 + j * 2) = (bf16_t)f2bf((j <= t) ? mkr[r] : 0.f); }
            asm volatile("s_waitcnt lgkmcnt(0)" ::: "memory");
        }
    }
}

constexpr int RCH_X = 0;
constexpr int RCH_ST = 4096;
constexpr int RCH_RING = 8192, RCH_NSLOT = 6, RCH_PF = 5;
static_assert(RCH_RING + RCH_NSLOT * RC_REC <= XB_LDS_OFF, "rwkv chain lds");
#define RCH_BAR() do { asm volatile("s_waitcnt lgkmcnt(0)" ::: "memory"); __builtin_amdgcn_s_barrier(); asm volatile("" ::: "memory"); } while (0)
__device__ __forceinline__ void rwkvc_chain_unit(const Frame& F, const Args& a, int bh, int sg, bool dry = false) {
    const unsigned char* SCR = F.ws + ((sg & 1) ? WS_RSCR2 : WS_RSCR);
    bf16_t* OAB = (bf16_t*)(F.ws + WS_XN); f32x4* STATE = (f32x4*)(F.ws + WS_RSTATE);
    const int lane = F.lane, w = F.wave, fr = lane & 15, fq = lane >> 4, h = bh & 7, b = bh >> 3;
    LAS unsigned char* L = F.lds;
    const size_t mb = (size_t)b * SEQ;
    const unsigned char* seg = SCR + ((size_t)bh * RC_SEG_CHUNKS) * RC_REC;
    if (w >= 4) {
        const int p = w - 4;
#define RCH_ISSUE(ch_) do { int l16_ = lane * 16; asm volatile("" : "+v"(l16_)); const unsigned char* src_ = seg + (size_t)(ch_) * RC_REC + l16_; LAS unsigned char* dst_ = L + RCH_RING + ((ch_) % RCH_NSLOT) * RC_REC; \
            _Pragma("unroll") for (int i_ = 0; i_ < 5; ++i_) { const int pc_ = p + 4 * i_; if (pc_ < 17) __builtin_amdgcn_global_load_lds((const unsigned*)(src_ + pc_ * 1024), (LAS unsigned*)(dst_ + pc_ * 1024), 16, 0, 0); } } while (0)
#pragma unroll 1
        for (int ch = 0; ch < RCH_PF; ++ch) RCH_ISSUE(ch);
        if (p == 0) asm volatile("s_waitcnt vmcnt(20)" ::: "memory"); else asm volatile("s_waitcnt vmcnt(16)" ::: "memory");
        RCH_BAR();
#pragma unroll 1
        for (int cs = 0; cs < RC_SEG_CHUNKS; ++cs) {
            if (cs + RCH_PF < RC_SEG_CHUNKS) { RCH_ISSUE(cs + RCH_PF);
                if (p == 0) asm volatile("s_waitcnt vmcnt(20)" ::: "memory"); else asm volatile("s_waitcnt vmcnt(16)" ::: "memory"); }
            else asm volatile("s_waitcnt vmcnt(0)" ::: "memory");
            RCH_BAR();
        }
#undef RCH_ISSUE
    } else {
        LAS float* XT = (LAS float*)(L + RCH_X + w * 1024); LAS float* STT = (LAS float*)(L + RCH_ST);
        f32x4 acc[4];
#pragma unroll
        for (int mt = 0; mt < 4; ++mt) acc[mt] = (sg == 0) ? (f32x4){0.f, 0.f, 0.f, 0.f} : STATE[((size_t)bh * 4 + w) * 256 + mt * 64 + lane];
        const int v = 16 * w + fr, hc = h * 64 + v;
        const float lnw = a.in[IN_RLNW][hc], lnb = a.in[IN_RLNB][hc];
        RCH_BAR();
#pragma unroll 1
        for (int cs = 0; cs < RC_SEG_CHUNKS; ++cs) {
            const LAS unsigned char* rec = L + RCH_RING + (cs % RCH_NSLOT) * RC_REC;
            const u32x4 z4 = (u32x4){0u, 0u, 0u, 0u}; const int f2 = fq & 1;
            bf16x8 sb[2];
#pragma unroll
            for (int ks = 0; ks < 2; ++ks) { u32x4 pk; pk.x = pk2(acc[2 * ks][0], acc[2 * ks][1]); pk.y = pk2(acc[2 * ks][2], acc[2 * ks][3]); pk.z = pk2(acc[2 * ks + 1][0], acc[2 * ks + 1][1]); pk.w = pk2(acc[2 * ks + 1][2], acc[2 * ks + 1][3]); sb[ks] = __builtin_bit_cast(bf16x8, pk); }
            f32x4 rhs = (f32x4){0.f, 0.f, 0.f, 0.f}, y1 = rhs;
#pragma unroll
            for (int ks = 0; ks < 2; ++ks) { rhs = MFMA16(*(const LAS bf16x8*)(rec + RC_KR + fr * 128 + ks * 64 + fq * 16), sb[ks], rhs); y1 = MFMA16(*(const LAS bf16x8*)(rec + RC_KR + 2048 + fr * 128 + ks * 64 + fq * 16), sb[ks], y1); }
            u32x4 vt8 = *(const LAS u32x4*)(rec + RC_VT + v * 32 + f2 * 16), mkb = *(const LAS u32x4*)(rec + RC_MKB + fr * 32 + f2 * 16), mkr = *(const LAS u32x4*)(rec + RC_MKR + fr * 32 + f2 * 16), mbr = *(const LAS u32x4*)(rec + RC_MBR + fr * 32 + f2 * 16);
            if (fq >= 2) { vt8 = z4; mkb = z4; mkr = z4; mbr = z4; }
            rhs = MFMA16(__builtin_bit_cast(bf16x8, mkb), __builtin_bit_cast(bf16x8, vt8), rhs);
            y1 = MFMA16(__builtin_bit_cast(bf16x8, mkr), __builtin_bit_cast(bf16x8, vt8), y1);
            f32x4 u4;
            { u32x4 rb; rb.x = pk2(rhs[0], rhs[1]); rb.y = pk2(rhs[2], rhs[3]); rb.z = 0u; rb.w = 0u;
              const f32x4 zf = {0.f, 0.f, 0.f, 0.f}; u4 = MFMA16(*(const LAS bf16x8*)(rec + RC_MBB + fr * 64 + fq * 16), __builtin_bit_cast(bf16x8, rb), zf); }
            *(LAS f32x4*)(XT + fr * 16 + 4 * fq) = u4;
            asm volatile("s_waitcnt lgkmcnt(0)" ::: "memory");
            u32x4 ub;
            { const f32x4 ua = *(const LAS f32x4*)(XT + fr * 16 + 8 * f2), ubb = *(const LAS f32x4*)(XT + fr * 16 + 8 * f2 + 4);
              ub.x = pk2(ua[0], ua[1]); ub.y = pk2(ua[2], ua[3]); ub.z = pk2(ubb[0], ubb[1]); ub.w = pk2(ubb[2], ubb[3]); if (fq >= 2) ub = z4; }
            f32x4 yv = (f32x4){0.f, 0.f, 0.f, 0.f};
            yv = MFMA16(__builtin_bit_cast(bf16x8, mbr), __builtin_bit_cast(bf16x8, ub), yv);
            const f32x4 y = y1 - yv;
            u32x4 uvb; const u32x2 vt4 = *(const LAS u32x2*)(rec + RC_VT + v * 32 + fq * 8);
            uvb.x = pk2(u4[0], u4[1]); uvb.y = pk2(u4[2], u4[3]);
            uvb.z = vt4.x; uvb.w = vt4.y;
#pragma unroll
            for (int mt = 0; mt < 4; ++mt) { const f32x4 wl = *(const LAS f32x4*)(rec + RC_WL + (16 * mt + 4 * fq) * 4);
                acc[mt] = MFMA16(*(const LAS bf16x8*)(rec + RC_BKT + (16 * mt + fr) * 64 + fq * 16), __builtin_bit_cast(bf16x8, uvb), acc[mt] * wl); }
            float pgv[4], pbv[4];
#pragma unroll
            for (int r = 0; r < 4; ++r) { pgv[r] = bf2f(*(const LAS bf16_t*)(rec + RC_PG + (4 * fq + r) * 128 + v * 2)); pbv[r] = bf2f(*(const LAS bf16_t*)(rec + RC_PBV + (4 * fq + r) * 128 + v * 2)); }
            LAS float* st = STT + (cs & 1) * 128;
#pragma unroll
            for (int r = 0; r < 4; ++r) { const float s1 = red16_dpp(y[r]), s2 = red16_dpp(y[r] * y[r]); if (fr == 0) { st[(w * 16 + 4 * fq + r) * 2] = s1; st[(w * 16 + 4 * fq + r) * 2 + 1] = s2; } }
            RCH_BAR();
#pragma unroll
            for (int r = 0; r < 4; ++r) { const int t = 4 * fq + r; float s1 = 0.f, s2 = 0.f;
#pragma unroll
                for (int ww = 0; ww < 4; ++ww) { const f32x2 sv = *(const LAS f32x2*)(st + (ww * 16 + t) * 2); s1 += sv[0]; s2 += sv[1]; }
                const float mean = s1 * (1.f / 64.f), var = fmaxf(s2 * (1.f / 64.f) - mean * mean, 0.f);
                const float o = ((y[r] - mean) * rsqrtf(var + RWKV_LN_EPS) * lnw + lnb + pbv[r]) * pgv[r];
                if (!dry) OAB[(mb + (size_t)(sg * RC_SEG_CHUNKS + cs) * 16 + t) * 1024 + 512 + hc] = (bf16_t)f2bf(o); }
        }
#pragma unroll
        for (int mt = 0; mt < 4; ++mt) if (!dry) STATE[((size_t)bh * 4 + w) * 256 + mt * 64 + lane] = acc[mt];
    }
    __syncthreads();
}

__device__ __forceinline__ void rwkvc_build_images(const Frame& F, const Args& a) {
    const int gt = F.bid * NTHREADS + F.tid, NT = F.G * NTHREADS;
    for (int e = gt; e < 8 * 256 * 64; e += NT) {
        const int c = e & 63, jj = (e >> 6) & 255, h = e >> 14;
        unsigned char* img = F.ws + WS_RIMG + (size_t)h * 35840;
        if (jj < 64) *(bf16_t*)(img + RW_W2T + c * 144 + jj * 2) = (bf16_t)f2bf(a.in[IN_RW2][jj * 512 + h * 64 + c]);
        else if (jj < 128) *(bf16_t*)(img + RW_A2T + c * 144 + (jj - 64) * 2) = (bf16_t)f2bf(a.in[IN_RA2][(jj - 64) * 512 + h * 64 + c]);
        else *(bf16_t*)(img + RW_G2T + c * 272 + (jj - 128) * 2) = (bf16_t)f2bf(a.in[IN_RG2][(jj - 128) * 512 + h * 64 + c]);
    }
}
template <bool RES_BF16, bool OUT_BF16>
__device__ __forceinline__ void row_pass(const Frame& F, const bf16_t* mix, const void* resid_, const float* w_post, void* hout_, const float* w_next, bf16_t* xn) {
    const int gw = F.bid * NWAVES + F.wave, NGW = F.G * NWAVES, lane = F.lane;
    for (int mA = gw; mA < MTOK; mA += 2 * NGW) {
        const int mB = (mA + NGW < MTOK) ? mA + NGW : mA; const bool two = (mB != mA);
        const u32x2* mrA = (const u32x2*)(mix + (size_t)mA * D_MODEL) + lane; const u32x2* mrB = (const u32x2*)(mix + (size_t)mB * D_MODEL) + lane;
        u32x2 pa[4], pb[4]; f32x4 ha[4], hb[4];
#pragma unroll
        for (int j = 0; j < 4; ++j) { pa[j] = mrA[64 * j]; pb[j] = mrB[64 * j]; }
        if (RES_BF16) {
            const u32x2* rA = (const u32x2*)((const bf16_t*)resid_ + (size_t)mA * D_MODEL) + lane; const u32x2* rB = (const u32x2*)((const bf16_t*)resid_ + (size_t)mB * D_MODEL) + lane;
#pragma unroll
            for (int j = 0; j < 4; ++j) { const u32x2 qa = rA[64 * j], qb = rB[64 * j]; ha[j] = (f32x4){bflo(qa.x), bfhi(qa.x), bflo(qa.y), bfhi(qa.y)}; hb[j] = (f32x4){bflo(qb.x), bfhi(qb.x), bflo(qb.y), bfhi(qb.y)}; }
        } else {
            const f32x4* rA = (const f32x4*)((const float*)resid_ + (size_t)mA * D_MODEL) + lane; const f32x4* rB = (const f32x4*)((const float*)resid_ + (size_t)mB * D_MODEL) + lane;
#pragma unroll
            for (int j = 0; j < 4; ++j) { ha[j] = rA[64 * j]; hb[j] = rB[64 * j]; }
        }
        f32x4 va[4], vb[4]; float sa = 0.f, sb = 0.f;
#pragma unroll
        for (int j = 0; j < 4; ++j) { va[j] = (f32x4){bflo(pa[j].x), bfhi(pa[j].x), bflo(pa[j].y), bfhi(pa[j].y)}; vb[j] = (f32x4){bflo(pb[j].x), bfhi(pb[j].x), bflo(pb[j].y), bfhi(pb[j].y)};
            sa += (va[j].x * va[j].x + va[j].y * va[j].y) + (va[j].z * va[j].z + va[j].w * va[j].w); sb += (vb[j].x * vb[j].x + vb[j].y * vb[j].y) + (vb[j].z * vb[j].z + vb[j].w * vb[j].w); }
        const float ra = 1.f / sqrtf(wave_sum(sa) * (1.f / D_MODEL) + NORM_EPS), rb = 1.f / sqrtf(wave_sum(sb) * (1.f / D_MODEL) + NORM_EPS);
        float s2a = 0.f, s2b = 0.f;
#pragma unroll
        for (int j = 0; j < 4; ++j) { const f32x4 g = ((const f32x4*)w_post)[lane + 64 * j]; ha[j] = ha[j] + va[j] * ra * g; hb[j] = hb[j] + vb[j] * rb * g;
            s2a += (ha[j].x * ha[j].x + ha[j].y * ha[j].y) + (ha[j].z * ha[j].z + ha[j].w * ha[j].w); s2b += (hb[j].x * hb[j].x + hb[j].y * hb[j].y) + (hb[j].z * hb[j].z + hb[j].w * hb[j].w); }
        if (OUT_BF16) {
            u32x2* hoA = (u32x2*)((bf16_t*)hout_ + (size_t)mA * D_MODEL) + lane; u32x2* hoB = (u32x2*)((bf16_t*)hout_ + (size_t)mB * D_MODEL) + lane;
#pragma unroll
            for (int j = 0; j < 4; ++j) { u32x2 o; o.x = pk2(ha[j].x, ha[j].y); o.y = pk2(ha[j].z, ha[j].w); hoA[64 * j] = o; if (two) { o.x = pk2(hb[j].x, hb[j].y); o.y = pk2(hb[j].z, hb[j].w); hoB[64 * j] = o; } }
        } else {
            f32x4* hoA = (f32x4*)((float*)hout_ + (size_t)mA * D_MODEL) + lane; f32x4* hoB = (f32x4*)((float*)hout_ + (size_t)mB * D_MODEL) + lane;
#pragma unroll
            for (int j = 0; j < 4; ++j) { hoA[64 * j] = ha[j]; if (two) hoB[64 * j] = hb[j]; }
        }
        if (w_next) {
            const float qa = 1.f / sqrtf(wave_sum(s2a) * (1.f / D_MODEL) + NORM_EPS), qb = 1.f / sqrtf(wave_sum(s2b) * (1.f / D_MODEL) + NORM_EPS);
            unsigned long long* oA = (unsigned long long*)(xn + (size_t)mA * D_MODEL) + lane; unsigned long long* oB = (unsigned long long*)(xn + (size_t)mB * D_MODEL) + lane;
#pragma unroll
            for (int j = 0; j < 4; ++j) { const f32x4 g = ((const f32x4*)w_next)[lane + 64 * j];
                oA[64 * j] = (unsigned long long)pk2(ha[j].x * qa * g.x, ha[j].y * qa * g.y) | ((unsigned long long)pk2(ha[j].z * qa * g.z, ha[j].w * qa * g.w) << 32);
                if (two) oB[64 * j] = (unsigned long long)pk2(hb[j].x * qb * g.x, hb[j].y * qb * g.y) | ((unsigned long long)pk2(hb[j].z * qb * g.z, hb[j].w * qb * g.w) << 32); }
        }
    }
}
constexpr size_t B1_ACMPK = 128 * MiB, B1_ACMPV = 144 * MiB, B1_KS = 160 * MiB, B1_VST = 168 * MiB, B1_KW = 176 * MiB, B1_VWT = 184 * MiB, B1_QR = 192 * MiB;
constexpr size_t R2_HCMP = 0, R2_KC = 8 * MiB, R2_VCT = 9 * MiB, R2_SEL = 12 * MiB;
__device__ __constant__ float ROPE_INVF[8] = {1.0f, 0.1939227432012558f, 0.03760603070259094f, 0.007292664609849453f, 0.0014142135623842478f, 0.00027424818836152554f, 5.3182957344688475e-05f, 1.0313385246263351e-05f};

__device__ __forceinline__ void nsa_prep_phase(const Frame& F, const Args& a) {
    const bf16_t* F1 = (const bf16_t*)(F.ws + WS_BIG);
    bf16_t* ACMPK = (bf16_t*)(F.ws + WS_BIG + B1_ACMPK); bf16_t* ACMPV = (bf16_t*)(F.ws + WS_BIG + B1_ACMPV);
    bf16_t* KS = (bf16_t*)(F.ws + WS_BIG + B1_KS); bf16_t* VST = (bf16_t*)(F.ws + WS_BIG + B1_VST); bf16_t* KW = (bf16_t*)(F.ws + WS_BIG + B1_KW); bf16_t* VWT = (bf16_t*)(F.ws + WS_BIG + B1_VWT);
    bf16_t* QR = (bf16_t*)(F.ws + WS_BIG + B1_QR);
    const int* pos = (const int*)a.in[IN_POS];
    const int lane = F.lane, wave = F.wave, tid = F.tid;
    LAS unsigned char* Lvs = F.lds;
    LAS unsigned char* Lvw = F.lds + 16384;
    for (int u = F.bid; u < BATCH * 64; u += F.G) {
        const int b = u >> 6, blk = u & 63;
#pragma unroll 1
        for (int tt = 0; tt < 8; ++tt) {
            const int tl = 8 * wave + tt, t = blk * 64 + tl; const size_t m = (size_t)b * SEQ + t;
            const float p = (float)pos[m];
            const float ang = p * ROPE_INVF[lane & 7];
            const float cs = __cosf(ang), sn = __sinf(ang);
            const bf16_t* row = F1 + m * F1_LD;
            { const int hh = lane >> 2, qd = lane & 3; const u32x4 v0 = *(const u32x4*)(row + hh * 64 + qd * 16), v1 = *(const u32x4*)(row + hh * 64 + qd * 16 + 8);
              u32x4 o0 = v0, o1 = v1;
              float x1[8], x2[8], c8[8], s8[8];
#pragma unroll
              for (int i = 0; i < 8; ++i) { c8[i] = __shfl(cs, i); s8[i] = __shfl(sn, i); }
              if (qd == 0) {
                  x1[0] = bflo(v0.x); x1[1] = bfhi(v0.x); x1[2] = bflo(v0.y); x1[3] = bfhi(v0.y); x1[4] = bflo(v0.z); x1[5] = bfhi(v0.z); x1[6] = bflo(v0.w); x1[7] = bfhi(v0.w);
                  x2[0] = bflo(v1.x); x2[1] = bfhi(v1.x); x2[2] = bflo(v1.y); x2[3] = bfhi(v1.y); x2[4] = bflo(v1.z); x2[5] = bfhi(v1.z); x2[6] = bflo(v1.w); x2[7] = bfhi(v1.w);
                  float y1[8], y2[8];
#pragma unroll
                  for (int i = 0; i < 8; ++i) { y1[i] = x1[i] * c8[i] - x2[i] * s8[i]; y2[i] = x2[i] * c8[i] + x1[i] * s8[i]; }
                  o0.x = pk2(y1[0], y1[1]); o0.y = pk2(y1[2], y1[3]); o0.z = pk2(y1[4], y1[5]); o0.w = pk2(y1[6], y1[7]);
                  o1.x = pk2(y2[0], y2[1]); o1.y = pk2(y2[2], y2[3]); o1.z = pk2(y2[4], y2[5]); o1.w = pk2(y2[6], y2[7]); }
              *(u32x4*)(QR + m * 1024 + hh * 64 + qd * 16) = o0; *(u32x4*)(QR + m * 1024 + hh * 64 + qd * 16 + 8) = o1;
            }
            const int g = lane >> 5, d = 2 * (lane & 31); const int bg = b * 2 + g;
            const unsigned kc = *(const unsigned*)(row + 1024 + 0 * 128 + g * 64 + d), vc = *(const unsigned*)(row + 1024 + 1 * 128 + g * 64 + d);
            unsigned ks = *(const unsigned*)(row + 1024 + 2 * 128 + g * 64 + d); const unsigned vs = *(const unsigned*)(row + 1024 + 3 * 128 + g * 64 + d);
            unsigned kw = *(const unsigned*)(row + 1024 + 4 * 128 + g * 64 + d); const unsigned vw = *(const unsigned*)(row + 1024 + 5 * 128 + g * 64 + d);
            {
              const int l5 = lane & 31; const bool x1role = l5 < 4; const int i0 = 2 * (l5 & 3);
              const float c0 = __shfl(cs, i0), c1 = __shfl(cs, i0 + 1), s0 = __shfl(sn, i0), s1 = __shfl(sn, i0 + 1);
              const unsigned oks = __shfl_xor(ks, 4), okw = __shfl_xor(kw, 4);
              if (l5 < 8) { const float sg = x1role ? -1.f : 1.f;
                  ks = pk2(bflo(ks) * c0 + sg * bflo(oks) * s0, bfhi(ks) * c1 + sg * bfhi(oks) * s1);
                  kw = pk2(bflo(kw) * c0 + sg * bflo(okw) * s0, bfhi(kw) * c1 + sg * bfhi(okw) * s1); } }
            *(unsigned*)(KS + ((size_t)bg * SEQ + t) * 64 + d) = ks; *(unsigned*)(KW + ((size_t)bg * SEQ + t) * 64 + d) = kw;
            *(LAS unsigned*)(Lvs + tl * 256 + lane * 4) = vs; *(LAS unsigned*)(Lvw + tl * 256 + lane * 4) = vw;
            {
              const int i0 = t >> 4, s0 = t & 15;
              const float* pek = a.in[IN_NPEK]; const float* pev = a.in[IN_NPEV];
              if (i0 < 255) { *(unsigned*)(ACMPK + ((size_t)bg * 256 + i0) * 2048 + s0 * 64 + d) = pk2(bflo(kc) + pek[s0 * 64 + d], bfhi(kc) + pek[s0 * 64 + d + 1]);
                              *(unsigned*)(ACMPV + ((size_t)bg * 256 + i0) * 2048 + s0 * 64 + d) = pk2(bflo(vc) + pev[s0 * 64 + d], bfhi(vc) + pev[s0 * 64 + d + 1]); }
              if (i0 >= 1) { const int s1 = 16 + s0;
                              *(unsigned*)(ACMPK + ((size_t)bg * 256 + i0 - 1) * 2048 + s1 * 64 + d) = pk2(bflo(kc) + pek[s1 * 64 + d], bfhi(kc) + pek[s1 * 64 + d + 1]);
                              *(unsigned*)(ACMPV + ((size_t)bg * 256 + i0 - 1) * 2048 + s1 * 64 + d) = pk2(bflo(vc) + pev[s1 * 64 + d], bfhi(vc) + pev[s1 * 64 + d + 1]); }
            }
        }
        if (blk == 63) {
            for (int i = tid; i < 2 * 2048 / 8; i += NTHREADS) { const int g = i >> 8, o = (i & 255) * 8;
                *(u32x4*)(ACMPK + ((size_t)(b * 2 + g) * 256 + 255) * 2048 + o) = (u32x4){0u, 0u, 0u, 0u}; *(u32x4*)(ACMPV + ((size_t)(b * 2 + g) * 256 + 255) * 2048 + o) = (u32x4){0u, 0u, 0u, 0u}; }
        }
        __syncthreads();
        if (tid < 256) { const int which = tid >> 7, gd = tid & 127, g = gd >> 6, d = gd & 63; LAS unsigned char* Lv = which ? Lvw : Lvs;
            bf16_t* dst = (which ? VWT : VST) + (((size_t)(b * 2 + g) * 64 + blk) * 64 + d) * 64;
#pragma unroll
            for (int q8 = 0; q8 < 8; ++q8) { unsigned short e[8];
#pragma unroll
                for (int k = 0; k < 8; ++k) e[k] = *(const LAS bf16_t*)(Lv + (8 * q8 + k) * 256 + gd * 2);
                u32x4 o; o.x = e[0] | ((unsigned)e[1] << 16); o.y = e[2] | ((unsigned)e[3] << 16); o.z = e[4] | ((unsigned)e[5] << 16); o.w = e[6] | ((unsigned)e[7] << 16);
                *(u32x4*)(dst + 8 * q8) = o; } }
        __syncthreads();
    }
}

constexpr int C1_PITCH = 528, C1_HALF = 64 * C1_PITCH, C1_BUF = 2 * C1_HALF;
static_assert(2 * C1_BUF <= XB_LDS_OFF && 8 * 16 * 64 * 16 <= XB_LDS_OFF, "cmp1 lds");
__device__ __forceinline__ void nsa_cmp1_phase(const Frame& F, const Args& a) {
    bf16_t* HC = (bf16_t*)((unsigned char*)a.out + R2_HCMP);
    const int lane = F.lane, fr = lane & 15, fq = lane >> 4, w = F.wave, tid = F.tid;
    LAS unsigned char* L = F.lds;
    LAS f32x4* PART = (LAS f32x4*)F.lds;
    for (int it = F.bid; it < 512; it += F.G) {
        const int which = it >> 8, j_ = (it & 255) >> 3, nt64 = j_ & 3, mt64 = (j_ >> 2) * 8 + (it & 7);
        const unsigned char* Ab = (const unsigned char*)(F.ws + WS_BIG + (which ? B1_ACMPV : B1_ACMPK)) + (size_t)(64 * mt64) * 4096;
        const unsigned char* Wb = (const unsigned char*)(F.ws + (which ? WS_W_C1V : WS_W_C1K)) + (size_t)(64 * nt64) * 4096;
        u32x4 st[8];
#define C1_FETCH(c_) do { _Pragma("unroll") for (int i_ = 0; i_ < 8; ++i_) { const int e_ = tid + 512 * i_; \
            st[i_] = *(const u32x4*)(((e_ >> 11) ? Wb : Ab) + (size_t)((e_ >> 5) & 63) * 4096 + (c_) * 512 + (e_ & 31) * 16); } } while (0)
#define C1_STORE(b_) do { _Pragma("unroll") for (int i_ = 0; i_ < 8; ++i_) { const int e_ = tid + 512 * i_; \
            *(LAS u32x4*)(L + (b_) * C1_BUF + (e_ >> 11) * C1_HALF + ((e_ >> 5) & 63) * C1_PITCH + (e_ & 31) * 16) = st[i_]; } } while (0)
        f32x4 acc[4][4];
#pragma unroll
        for (int nt = 0; nt < 4; ++nt)
#pragma unroll
            for (int mt = 0; mt < 4; ++mt) acc[nt][mt] = (f32x4){0.f, 0.f, 0.f, 0.f};
        C1_FETCH(0);
        __syncthreads();
        C1_STORE(0);
        __syncthreads();
#pragma unroll 1
        for (int c = 0; c < 8; ++c) {
            if (c < 7) C1_FETCH(c + 1);
            const LAS unsigned char* B = L + (c & 1) * C1_BUF + 64 * w + 16 * fq;
            bf16x8 af[4], wf[4];
#pragma unroll
            for (int t = 0; t < 4; ++t) { af[t] = *(const LAS bf16x8*)(B + (16 * t + fr) * C1_PITCH); wf[t] = *(const LAS bf16x8*)(B + C1_HALF + (16 * t + fr) * C1_PITCH); }
#pragma unroll
            for (int nt = 0; nt < 4; ++nt)
#pragma unroll
                for (int mt = 0; mt < 4; ++mt) acc[nt][mt] = MFMA16(wf[nt], af[mt], acc[nt][mt]);
            if (c < 7) C1_STORE((c + 1) & 1);
            __syncthreads();
        }
#undef C1_FETCH
#undef C1_STORE
#pragma unroll
        for (int nt = 0; nt < 4; ++nt)
#pragma unroll
            for (int mt = 0; mt < 4; ++mt) PART[(w * 16 + nt * 4 + mt) * 64 + lane] = acc[nt][mt];
        __syncthreads();
#pragma unroll
        for (int q = 0; q < 2; ++q) {
            const int tl = 2 * w + q, nt = tl >> 2, mt = tl & 3;
            f32x4 s = PART[tl * 64 + lane];
#pragma unroll
            for (int ww = 1; ww < 8; ++ww) s += PART[(ww * 16 + tl) * 64 + lane];
            u32x2 o; o.x = pk2(siluf_(s[0]), siluf_(s[1])); o.y = pk2(siluf_(s[2]), siluf_(s[3]));
            *(u32x2*)(HC + ((size_t)which * 4096 + 64 * mt64 + 16 * mt + fr) * 256 + 64 * nt64 + 16 * nt + 4 * fq) = o;
        }
    }
}
__device__ __forceinline__ void nsa_cmp2_phase(const Frame& F, const Args& a) {
    const bf16_t* HC = (const bf16_t*)((unsigned char*)a.out + R2_HCMP); bf16_t* KC = (bf16_t*)((unsigned char*)a.out + R2_KC); bf16_t* VCT = (bf16_t*)((unsigned char*)a.out + R2_VCT);
    const int* pos = (const int*)a.in[IN_POS];
    const int gw = F.wave * F.G + F.bid, NGW = F.G * NWAVES, lane = F.lane, fr = lane & 15, fq = lane >> 4;
    for (int it = gw; it < 512; it += NGW) {
        const int which = it >> 8, rt = it & 255;
        const bf16_t* A = HC + ((size_t)which * 4096 + 16 * rt) * 256; const bf16_t* Bt = (const bf16_t*)(F.ws + (which ? WS_W_C2V : WS_W_C2K));
        f32x4 c[4];
#pragma unroll
        for (int nt = 0; nt < 4; ++nt) c[nt] = (f32x4){0.f, 0.f, 0.f, 0.f};
#pragma unroll
        for (int ks = 0; ks < 8; ++ks) { const bf16x8 af = *(const bf16x8*)(A + fr * 256 + 32 * ks + 8 * fq);
#pragma unroll
            for (int nt = 0; nt < 4; ++nt) { const bf16x8 bf = *(const bf16x8*)(Bt + (16 * nt + fr) * 256 + 32 * ks + 8 * fq); c[nt] = MFMA16(af, bf, c[nt]); } }
        const int bg = rt >> 4, b = bg >> 1;
        if (which == 0) {
#pragma unroll
            for (int r = 0; r < 4; ++r) { const int i = (16 * rt + 4 * fq + r) & 255; int pi = 31 + 16 * i; if (pi > SEQ - 1) pi = SEQ - 1;
                const float ang = (float)pos[(size_t)b * SEQ + pi] * ROPE_INVF[fr & 7]; const float cs = __cosf(ang), sn = __sinf(ang);
                const float own = c[0][r], oth = __shfl_xor(own, 8);
                c[0][r] = (fr < 8) ? own * cs - oth * sn : own * cs + oth * sn;
#pragma unroll
                for (int nt = 0; nt < 4; ++nt) KC[((size_t)bg * 256 + i) * 64 + 16 * nt + fr] = (bf16_t)f2bf(c[nt][r]); }
        } else {
            const int i0 = (16 * rt + 4 * fq) & 255;
#pragma unroll
            for (int nt = 0; nt < 4; ++nt) { u32x2 p; p.x = pk2(c[nt][0], c[nt][1]); p.y = pk2(c[nt][2], c[nt][3]); *(u32x2*)(VCT + ((size_t)bg * 64 + 16 * nt + fr) * 256 + i0) = p; }
        }
    }
}
constexpr int CA_KC = 0, CA_KC_PITCH = 144;
constexpr int CA_VT = 36864, CA_VT_PITCH = 528;
__device__ __forceinline__ void nsa_cmp_attn_phase(const Frame& F, const Args& a) {
    const bf16_t* F1 = (const bf16_t*)(F.ws + WS_BIG); const bf16_t* QR = (const bf16_t*)(F.ws + WS_BIG + B1_QR);
    const bf16_t* KC = (const bf16_t*)((unsigned char*)a.out + R2_KC); const bf16_t* VCT = (const bf16_t*)((unsigned char*)a.out + R2_VCT);
    unsigned long long* SEL = (unsigned long long*)((unsigned char*)a.out + R2_SEL); bf16_t* ONSA = (bf16_t*)(F.ws + WS_XN);
    const int lane = F.lane, wave = F.wave, tid = F.tid, fr = lane & 15, fq = lane >> 4;
    LAS unsigned char* L = F.lds;
    for (int bgk = F.bid; bgk < 256; bgk += F.G) {
        const int bg = bgk & 15, kq = bgk >> 4, b = bg >> 1, g = bg & 1;
        __syncthreads();
        for (int i = tid; i < 256 * 8; i += NTHREADS) { const int key = i >> 3, ch = i & 7; *(LAS u32x4*)(L + CA_KC + key * CA_KC_PITCH + ch * 16) = *(const u32x4*)(KC + ((size_t)bg * 256 + key) * 64 + ch * 8); }
        for (int i = tid; i < 64 * 32; i += NTHREADS) { const int d = i >> 5, ch = i & 31; *(LAS u32x4*)(L + CA_VT + d * CA_VT_PITCH + ch * 16) = *(const u32x4*)(VCT + ((size_t)bg * 64 + d) * 256 + ch * 8); }
        __syncthreads();
#pragma unroll 1
        for (int rep = 0; rep < 2; ++rep) {
            const int idx = wave * 16 + kq; const int tt = rep == 0 ? idx : 255 - idx;
            const int t0 = 16 * tt, t = t0 + fr; const size_t m = (size_t)b * SEQ + t;
            const int nk = tt;
            const int nkt = (nk + 15) >> 4;
            float iaA[16], iaB[16];
#pragma unroll
            for (int kt = 0; kt < 16; ++kt) { iaA[kt] = 0.f; iaB[kt] = 0.f; }
            bf16x8 q0n = *(const bf16x8*)(QR + m * 1024 + (g * 8) * 64 + 8 * fq), q1n = *(const bf16x8*)(QR + m * 1024 + (g * 8) * 64 + 32 + 8 * fq);
            bf16_t gtn = F1[m * F1_LD + 1792 + (g * 8) * 3 + 0];
#pragma unroll 1
            for (int hh = 0; hh < 8; ++hh) {
                const int H = g * 8 + hh, Hn = g * 8 + (hh < 7 ? hh + 1 : 7);
                const bf16x8 q0 = q0n, q1 = q1n; const bf16_t gtc = gtn;
                q0n = *(const bf16x8*)(QR + m * 1024 + Hn * 64 + 8 * fq); q1n = *(const bf16x8*)(QR + m * 1024 + Hn * 64 + 32 + 8 * fq);
                gtn = F1[m * F1_LD + 1792 + Hn * 3 + 0];
                float mrun = -INFINITY, lrun = 0.f;
#pragma unroll 1
                for (int kt = 0; kt < nkt; ++kt) {
                    const bf16x8 k0 = *(const LAS bf16x8*)(L + CA_KC + (16 * kt + fr) * CA_KC_PITCH + 16 * fq), k1 = *(const LAS bf16x8*)(L + CA_KC + (16 * kt + fr) * CA_KC_PITCH + 64 + 16 * fq);
                    f32x4 sv = (f32x4){0.f, 0.f, 0.f, 0.f}; sv = MFMA16(k0, q0, sv); sv = MFMA16(k1, q1, sv);
                    float tm = -INFINITY;
#pragma unroll
                    for (int r = 0; r < 4; ++r) { const int key = 16 * kt + 4 * fq + r; const bool vis = (16 * key + 31) <= t; sv[r] = vis ? sv[r] * 0.125f : -INFINITY; tm = fmaxf(tm, sv[r]); }
                    const float mn = fmaxf(mrun, tm);
                    if (mn != -INFINITY) { float add = 0.f;
#pragma unroll
                        for (int r = 0; r < 4; ++r) add += (sv[r] == -INFINITY) ? 0.f : __expf(sv[r] - mn);
                        lrun = lrun * ((mrun == -INFINITY) ? 0.f : __expf(mrun - mn)) + add; mrun = mn; }
                }
                float mx = fmaxf(mrun, __shfl_xor(mrun, 16)); mx = fmaxf(mx, __shfl_xor(mx, 32));
                const float mref = (mx == -INFINITY) ? 0.f : mx;
                float sum = (mrun == -INFINITY) ? 0.f : lrun * __expf(mrun - mref);
                sum += __shfl_xor(sum, 16); sum += __shfl_xor(sum, 32);
                const float inv = frcp(fmaxf(sum, 1e-30f));
                f32x4 o[4];
#pragma unroll
                for (int dt = 0; dt < 4; ++dt) o[dt] = (f32x4){0.f, 0.f, 0.f, 0.f};
#pragma unroll
                for (int ks = 0; ks < 8; ++ks) if (2 * ks < nkt) {
                    float p[8];
#pragma unroll
                    for (int half = 0; half < 2; ++half) { const int kt = 2 * ks + half;
                        const bf16x8 k0 = *(const LAS bf16x8*)(L + CA_KC + (16 * kt + fr) * CA_KC_PITCH + 16 * fq), k1 = *(const LAS bf16x8*)(L + CA_KC + (16 * kt + fr) * CA_KC_PITCH + 64 + 16 * fq);
                        f32x4 sv = (f32x4){0.f, 0.f, 0.f, 0.f}; sv = MFMA16(k0, q0, sv); sv = MFMA16(k1, q1, sv);
#pragma unroll
                        for (int r = 0; r < 4; ++r) { const int key = 16 * kt + 4 * fq + r; const bool vis = (16 * key + 31) <= t; p[4 * half + r] = vis ? __expf(sv[r] * 0.125f - mref) * inv : 0.f; } }
                    iaA[2 * ks] += (p[0] + p[1]) + (p[2] + 0.5f * p[3]); iaB[2 * ks] += p[3]; iaA[2 * ks + 1] += (p[4] + p[5]) + (p[6] + 0.5f * p[7]); iaB[2 * ks + 1] += p[7];
                    u32x4 pw; pw.x = pk2(p[0], p[1]); pw.y = pk2(p[2], p[3]); pw.z = pk2(p[4], p[5]); pw.w = pk2(p[6], p[7]);
                    const bf16x8 pb = __builtin_bit_cast(bf16x8, pw);
#pragma unroll
                    for (int dt = 0; dt < 4; ++dt) { const u32x2 v0 = *(const LAS u32x2*)(L + CA_VT + (16 * dt + fr) * CA_VT_PITCH + (32 * ks + 4 * fq) * 2), v1 = *(const LAS u32x2*)(L + CA_VT + (16 * dt + fr) * CA_VT_PITCH + (32 * ks + 16 + 4 * fq) * 2);
                        u32x4 vw; vw.x = v0.x; vw.y = v0.y; vw.z = v1.x; vw.w = v1.y; o[dt] = MFMA16(__builtin_bit_cast(bf16x8, vw), pb, o[dt]); }
                    __builtin_amdgcn_sched_barrier(0); }
                const float gate = sigmoidf_(bf2f(gtc));
#pragma unroll
                for (int dt = 0; dt < 4; ++dt) { u32x2 w; w.x = pk2(o[dt][0] * gate, o[dt][1] * gate); w.y = pk2(o[dt][2] * gate, o[dt][3] * gate); *(u32x2*)(ONSA + m * 1024 + H * 64 + 16 * dt + 4 * fq) = w; }
            }
            float imp[16];
#pragma unroll
            for (int kt = 0; kt < 16; ++kt) { const float up = __shfl(iaB[kt], (lane + 48) & 63); imp[kt] = up; }
            { float carry = 0.f;
#pragma unroll
              for (int kt = 0; kt < 16; ++kt) { const float prev3 = (fq == 0) ? carry : imp[kt]; carry = imp[kt]; imp[kt] = 0.5f * prev3 + iaA[kt]; } }
            const int cur = t >> 6;
            unsigned long long mask = 0ull;
            if (t0 < 1024) {
#pragma unroll
                for (int kt = 0; kt < 16; ++kt) { const int j = 4 * kt + fq; if (j <= cur) mask |= 1ull << j; }
            } else {
                float cv[16];
#pragma unroll
                for (int kt = 0; kt < 16; ++kt) { const int j = 4 * kt + fq; const bool forced = (j == 0) || (j == cur) || (j == cur - 1); cv[kt] = (j <= cur && !forced) ? imp[kt] : -INFINITY; }
                int rank[16];
#pragma unroll
                for (int kt = 0; kt < 16; ++kt) rank[kt] = 0;
#pragma unroll 1
                for (int f2 = 0; f2 < 4; ++f2) {
#pragma unroll
                    for (int k2 = 0; k2 < 16; ++k2) { const float ov = __shfl(cv[k2], fr + 16 * f2); const int j2 = 4 * k2 + f2;
#pragma unroll
                        for (int kt = 0; kt < 16; ++kt) { const int j = 4 * kt + fq; rank[kt] += (ov > cv[kt] || (ov == cv[kt] && j2 < j)) ? 1 : 0; } } }
#pragma unroll
                for (int kt = 0; kt < 16; ++kt) { const int j = 4 * kt + fq; const bool forced = (j == 0) || (j == cur) || (j == cur - 1);
                    if (forced || (cv[kt] != -INFINITY && rank[kt] < SEL_TOPN - 3)) mask |= 1ull << j; }
            }
            { unsigned lo = (unsigned)mask, hi = (unsigned)(mask >> 32);
              lo |= __shfl_xor(lo, 16); hi |= __shfl_xor(hi, 16); lo |= __shfl_xor(lo, 32); hi |= __shfl_xor(hi, 32);
              if (fq == 0) SEL[(size_t)bg * SEQ + t] = ((unsigned long long)hi << 32) | lo; }
        }
    }
}

constexpr int SA_K = 0, SA_V = 8192, SA_BUF = 16384, SA_NS = 8, SA_GB = 4;
#define SA_BAR() do { asm volatile("s_waitcnt lgkmcnt(0)" ::: "memory"); __builtin_amdgcn_s_barrier(); asm volatile("" ::: "memory"); } while (0)
__device__ __forceinline__ float xfq_max(float v) {
    unsigned vi = __builtin_bit_cast(unsigned, v);
    auto r = __builtin_amdgcn_permlane16_swap(vi, vi, false, false);
    const unsigned a0 = r[0], a1 = r[1];
    v = fmaxf(__builtin_bit_cast(float, a0), __builtin_bit_cast(float, a1));
    vi = __builtin_bit_cast(unsigned, v);
    auto r2 = __builtin_amdgcn_permlane32_swap(vi, vi, false, false);
    const unsigned b0 = r2[0], b1 = r2[1];
    return fmaxf(__builtin_bit_cast(float, b0), __builtin_bit_cast(float, b1));
}
template <int MODE  >
__device__ __forceinline__ void nsa_attn_pass(const Frame& F, const bf16_t* Kg, const bf16_t* Vtg, const bf16x8 (&qf)[2][2], const unsigned long long (&selm)[2], int tq[2], int bg, int qb, f32x4 (&outacc)[2][4], const float (&gate)[2]) {
    const int lane = F.lane, tid = F.tid, fr = lane & 15, fq = lane >> 4;
    LAS unsigned char* L = F.lds;
    const int j0 = (MODE == 0) ? 0 : (qb - 8 > 0 ? qb - 8 : 0), j1 = qb;
    f32x4 O[2][4]; float mrun[2], lrun[2];
#pragma unroll
    for (int i = 0; i < 2; ++i) { mrun[i] = -INFINITY; lrun[i] = 0.f;
#pragma unroll
        for (int dt = 0; dt < 4; ++dt) O[i][dt] = (f32x4){0.f, 0.f, 0.f, 0.f}; }
    const int wv_ = F.wave;
#define SA_ISSUE(jt_) do { LAS unsigned char* slot_ = L + (((jt_) - j0) % SA_NS) * SA_BUF; \
        _Pragma("unroll") for (int i_ = 0; i_ < 2; ++i_) { const int pc_ = 2 * wv_ + i_, P_ = pc_ & 7; const int row_ = 8 * P_ + (lane >> 3), c16_ = (lane & 7) ^ ((row_ >> 1) & 7); \
            const bf16_t* src_ = (pc_ < 8) ? Kg + ((size_t)bg * SEQ + (size_t)(jt_) * 64) * 64 + row_ * 64 + c16_ * 8 : Vtg + ((size_t)bg * 64 + (jt_)) * 4096 + row_ * 64 + c16_ * 8; \
            __builtin_amdgcn_global_load_lds((const unsigned*)src_, (LAS unsigned*)(slot_ + (pc_ < 8 ? SA_K : SA_V) + P_ * 1024), 16, 0, 0); } } while (0)
    __syncthreads();
#pragma unroll 1
    for (int d_ = 0; d_ < 2 * SA_GB; ++d_) if (j0 + d_ <= j1) SA_ISSUE(j0 + d_);
    if (j0 + 2 * SA_GB - 1 <= j1) asm volatile("s_waitcnt vmcnt(8)" ::: "memory");
    else asm volatile("s_waitcnt vmcnt(0)" ::: "memory");
    SA_BAR();
#pragma unroll 1
    for (int jg = j0; jg <= j1; jg += SA_GB) {
#pragma unroll 1
      for (int j = jg; j < jg + SA_GB && j <= j1; ++j) {
        LAS unsigned char* Lb = L + ((j - j0) % SA_NS) * SA_BUF;
        const bool edge = (j == j1) || (MODE == 1 && j == qb - 8);
        bool colok[2];
#pragma unroll
        for (int i = 0; i < 2; ++i) colok[i] = (MODE == 0) ? (bool)((selm[i] >> j) & 1ull) : true;
        if (MODE == 0 && __ballot(colok[0] || colok[1]) == 0ull) continue;
        f32x4 s[2][4];
#pragma unroll
        for (int kt = 0; kt < 4; ++kt) {
            const int key_ = 16 * kt + fr, sw_ = (key_ >> 1) & 7;
            const bf16x8 k0 = *(const LAS bf16x8*)(Lb + SA_K + key_ * 128 + ((fq ^ sw_) * 16)), k1 = *(const LAS bf16x8*)(Lb + SA_K + key_ * 128 + (((4 + fq) ^ sw_) * 16));
            const f32x4 z4 = (f32x4){0.f, 0.f, 0.f, 0.f};
#pragma unroll
            for (int i = 0; i < 2; ++i) { s[i][kt] = MFMA16(k0, qf[i][0], z4); s[i][kt] = MFMA16(k1, qf[i][1], s[i][kt]); }
        }
        constexpr float SC = 0.125f * 1.4426950408889634f;
        bf16x8 pb[2][2];
#pragma unroll
        for (int i = 0; i < 2; ++i) {
            const int t = tq[i];
            float mx;
            if (edge) {
                mx = -INFINITY;
#pragma unroll
                for (int kt = 0; kt < 4; ++kt)
#pragma unroll
                    for (int r = 0; r < 4; ++r) { const int kpos = 64 * j + 16 * kt + 4 * fq + r; bool vis = (kpos <= t); if (MODE == 1) vis = vis && (kpos > t - WINDOW);
                        s[i][kt][r] = vis ? s[i][kt][r] : -INFINITY; mx = fmaxf(mx, s[i][kt][r]); }
            } else {
                const float m0 = __builtin_fmaxf(__builtin_fmaxf(s[i][0][0], s[i][0][1]), s[i][0][2]), m1 = __builtin_fmaxf(__builtin_fmaxf(s[i][0][3], s[i][1][0]), s[i][1][1]);
                const float m2 = __builtin_fmaxf(__builtin_fmaxf(s[i][1][2], s[i][1][3]), s[i][2][0]), m3 = __builtin_fmaxf(__builtin_fmaxf(s[i][2][1], s[i][2][2]), s[i][2][3]);
                const float m4 = __builtin_fmaxf(__builtin_fmaxf(s[i][3][0], s[i][3][1]), s[i][3][2]);
                mx = __builtin_fmaxf(__builtin_fmaxf(__builtin_fmaxf(m0, m1), __builtin_fmaxf(m2, m3)), __builtin_fmaxf(m4, s[i][3][3]));
            }
            mx = colok[i] ? mx * SC : -INFINITY;
            mx = xfq_max(mx);
            const float mnew = fmaxf(mrun[i], mx);
            if (__ballot(mnew != mrun[i]) != 0ull) {
                const float alpha = (mrun[i] == -INFINITY) ? 0.f : __builtin_amdgcn_exp2f(mrun[i] - mnew);
                lrun[i] *= alpha;
#pragma unroll
                for (int dt = 0; dt < 4; ++dt) O[i][dt] = O[i][dt] * alpha;
                mrun[i] = mnew;
            }
            const float msub = (colok[i] && mnew != -INFINITY) ? mnew : INFINITY;
            float p[16]; float ps0 = 0.f, ps1 = 0.f;
#pragma unroll
            for (int kt = 0; kt < 4; ++kt) {
                p[4 * kt + 0] = __builtin_amdgcn_exp2f(__builtin_fmaf(s[i][kt][0], SC, -msub)); p[4 * kt + 1] = __builtin_amdgcn_exp2f(__builtin_fmaf(s[i][kt][1], SC, -msub));
                p[4 * kt + 2] = __builtin_amdgcn_exp2f(__builtin_fmaf(s[i][kt][2], SC, -msub)); p[4 * kt + 3] = __builtin_amdgcn_exp2f(__builtin_fmaf(s[i][kt][3], SC, -msub));
                ps0 += p[4 * kt + 0] + p[4 * kt + 1]; ps1 += p[4 * kt + 2] + p[4 * kt + 3]; }
            lrun[i] += ps0 + ps1;
#pragma unroll
            for (int ks = 0; ks < 2; ++ks) { u32x4 pw; pw.x = pk2(p[8 * ks], p[8 * ks + 1]); pw.y = pk2(p[8 * ks + 2], p[8 * ks + 3]); pw.z = pk2(p[8 * ks + 4], p[8 * ks + 5]); pw.w = pk2(p[8 * ks + 6], p[8 * ks + 7]);
                pb[i][ks] = __builtin_bit_cast(bf16x8, pw); }
        }
#pragma unroll
        for (int ks = 0; ks < 2; ++ks)
#pragma unroll
            for (int dt = 0; dt < 4; ++dt) { const int d_ = 16 * dt + fr, sw_ = (d_ >> 1) & 7, c_ = 4 * ks + (fq >> 1);
                const u32x2 v0 = *(const LAS u32x2*)(Lb + SA_V + d_ * 128 + ((c_ ^ sw_) * 16) + 8 * (fq & 1)), v1 = *(const LAS u32x2*)(Lb + SA_V + d_ * 128 + (((c_ + 2) ^ sw_) * 16) + 8 * (fq & 1));
                u32x4 vw; vw.x = v0.x; vw.y = v0.y; vw.z = v1.x; vw.w = v1.y; const bf16x8 vf = __builtin_bit_cast(bf16x8, vw);
#pragma unroll
                for (int i = 0; i < 2; ++i) O[i][dt] = MFMA16(vf, pb[i][ks], O[i][dt]); }
      }
      asm volatile("s_waitcnt vmcnt(0)" ::: "memory");
      SA_BAR();
#pragma unroll 1
      for (int d_ = 0; d_ < SA_GB; ++d_) if (jg + 2 * SA_GB + d_ <= j1) SA_ISSUE(jg + 2 * SA_GB + d_);
    }
#undef SA_ISSUE
#pragma unroll
    for (int i = 0; i < 2; ++i) { float l = lrun[i]; l += __shfl_xor(l, 16); l += __shfl_xor(l, 32); const float sc = gate[i] * frcp(fmaxf(l, 1e-30f));
#pragma unroll
        for (int dt = 0; dt < 4; ++dt) outacc[i][dt] += O[i][dt] * sc; }
}
__device__ __forceinline__ void nsa_attn_phase(const Frame& F, const Args& a, bool do_store = true) {
    const bf16_t* F1 = (const bf16_t*)(F.ws + WS_BIG); const bf16_t* QR = (const bf16_t*)(F.ws + WS_BIG + B1_QR);
    const bf16_t* KS = (const bf16_t*)(F.ws + WS_BIG + B1_KS); const bf16_t* VST = (const bf16_t*)(F.ws + WS_BIG + B1_VST); const bf16_t* KW = (const bf16_t*)(F.ws + WS_BIG + B1_KW); const bf16_t* VWT = (const bf16_t*)(F.ws + WS_BIG + B1_VWT);
    const unsigned long long* SEL = (const unsigned long long*)((unsigned char*)a.out + R2_SEL); bf16_t* ONSA = (bf16_t*)(F.ws + WS_XN);
    const int lane = F.lane, wave = F.wave, fr = lane & 15, fq = lane >> 4;
    for (int c = F.bid; c < 256; c += F.G) {
        const int bg = c & 15, kq = c >> 4, b = bg >> 1, g = bg & 1;
#pragma unroll 1
        for (int rep = 0; rep < 8; ++rep) {
            const int hb = 16 * rep + ((rep & 1) ? 15 - kq : kq);
            const int qb = hb >> 1;
            int tq[2]; bf16x8 qf[2][2]; unsigned long long selm[2]; float gs[2], gw_[2]; f32x4 outacc[2][4]; size_t mrow[2]; int Hh;
            Hh = g * 8 + (fr & 7);
#pragma unroll
            for (int i = 0; i < 2; ++i) { tq[i] = 32 * hb + 4 * wave + 2 * i + (fr >> 3); mrow[i] = (size_t)b * SEQ + tq[i];
                qf[i][0] = *(const bf16x8*)(QR + mrow[i] * 1024 + Hh * 64 + 8 * fq); qf[i][1] = *(const bf16x8*)(QR + mrow[i] * 1024 + Hh * 64 + 32 + 8 * fq);
                selm[i] = SEL[(size_t)bg * SEQ + tq[i]];
                gs[i] = sigmoidf_(bf2f(F1[mrow[i] * F1_LD + 1792 + Hh * 3 + 1])); gw_[i] = sigmoidf_(bf2f(F1[mrow[i] * F1_LD + 1792 + Hh * 3 + 2]));
#pragma unroll
                for (int dt = 0; dt < 4; ++dt) outacc[i][dt] = (f32x4){0.f, 0.f, 0.f, 0.f}; }
#ifdef PROBE_ATT_REP
            { float gz_[2]; gz_[0] = gz_[1] = __builtin_bit_cast(float, __hip_atomic_load(F.ctl + 6, __ATOMIC_RELAXED, __HIP_MEMORY_SCOPE_AGENT));
#pragma unroll 1
              for (int rp_ = 0; rp_ < 2; ++rp_) {
                if (PROBE_ATT_REP == 0) nsa_attn_pass<0>(F, KS, VST, qf, selm, tq, bg, qb, outacc, rp_ ? gs : gz_);
                else nsa_attn_pass<1>(F, KW, VWT, qf, selm, tq, bg, qb, outacc, rp_ ? gw_ : gz_); }
              if (PROBE_ATT_REP == 0) nsa_attn_pass<1>(F, KW, VWT, qf, selm, tq, bg, qb, outacc, gw_);
              else nsa_attn_pass<0>(F, KS, VST, qf, selm, tq, bg, qb, outacc, gs); }
#else
            nsa_attn_pass<0>(F, KS, VST, qf, selm, tq, bg, qb, outacc, gs);
            nsa_attn_pass<1>(F, KW, VWT, qf, selm, tq, bg, qb, outacc, gw_);
#endif
            if (do_store)
#pragma unroll
            for (int i = 0; i < 2; ++i)
#pragma unroll
                for (int dt = 0; dt < 4; ++dt) { bf16_t* p = ONSA + mrow[i] * 1024 + Hh * 64 + 16 * dt + 4 * fq; const u32x2 old = *(const u32x2*)p;
                    u32x2 w; w.x = pk2(bflo(old.x) + outacc[i][dt][0], bfhi(old.x) + outacc[i][dt][1]); w.y = pk2(bflo(old.y) + outacc[i][dt][2], bfhi(old.y) + outacc[i][dt][3]); *(u32x2*)p = w; }
        }
    }
}
__device__ __forceinline__ void chk_gdn(const Frame& F, const Args& a, int b, int h, int ntok, unsigned* cnt) {
    const bf16_t* F0 = (const bf16_t*)(F.ws + WS_BIG); const bf16_t* OAB = (const bf16_t*)(F.ws + WS_XN);
    LAS float* S = (LAS float*)F.lds;
    LAS float* qkv = S + 16384;
    LAS float* kS = qkv + 384;
    LAS float* ov = kS + 128;
    const int tid = F.tid; const float* convw = a.in[IN_GCONV];

#pragma unroll 1
for (int i = tid; i < 16384; i += NTHREADS) S[i] = 0.f;
    __syncthreads();
    unsigned bad = 0;

#pragma unroll 1
for (int t = 0; t < ntok; ++t) {
        const size_t m = (size_t)b * SEQ + t;
        if (tid < 384) { const int X = tid >> 7, c = tid & 127, col = X * 512 + h * 128 + c; float acc = 0.f;

#pragma unroll 1
for (int i = 0; i < 4; ++i) if (t - 3 + i >= 0) acc += convw[i * 1536 + col] * bf2f(F0[(m - 3 + i) * F0_LD + col]);
            qkv[tid] = acc / (1.f + expf(-acc)); }
        __syncthreads();
        float sq = 0.f, sk = 0.f;
#pragma unroll 1
for (int i = 0; i < 128; ++i) { sq += qkv[i] * qkv[i]; sk += qkv[128 + i] * qkv[128 + i]; }
        const float rq = 1.f / sqrtf(sq + 1e-6f) / sqrtf(128.f), rk = 1.f / sqrtf(sk + 1e-6f);
        const float beta = 1.f / (1.f + expf(-bf2f(F0[m * F0_LD + F0_BA + h])));
        const float aa = bf2f(F0[m * F0_LD + F0_BA + 4 + h]) + a.in[IN_GDT][h];
        const float g = -expf(a.in[IN_GALOG][h]) * (aa > 20.f ? aa : log1pf(expf(aa))); const float eg = expf(g);
        if (tid < 128) { float s = 0.f;
#pragma unroll 1
for (int i = 0; i < 128; ++i) s += qkv[128 + i] * rk * S[i * 128 + tid]; kS[tid] = s; }
        __syncthreads();

#pragma unroll 1
for (int e = tid; e < 16384; e += NTHREADS) { const int i = e >> 7, j = e & 127; const float ki = qkv[128 + i] * rk;
            S[e] = eg * (S[e] - beta * ki * kS[j]) + beta * ki * qkv[256 + j]; }
        __syncthreads();
        if (tid < 128) { float s = 0.f;
#pragma unroll 1
for (int i = 0; i < 128; ++i) s += qkv[i] * rq * S[i * 128 + tid]; ov[tid] = s; }
        __syncthreads();
        if (tid < 128) { float ss = 0.f;
#pragma unroll 1
for (int i = 0; i < 128; ++i) ss += ov[i] * ov[i];
            const float rstd = 1.f / sqrtf(ss / 128.f + NORM_EPS); const float z = bf2f(F0[m * F0_LD + 1536 + h * 128 + tid]);
            const float ref = ov[tid] * rstd * a.in[IN_GNORM][tid] * (z / (1.f + expf(-z))); const float got = bf2f(OAB[m * 1024 + h * 128 + tid]);
            if (!(fabsf(got - ref) <= 0.04f + 0.04f * fabsf(ref))) bad++; }
        __syncthreads();
    }
    if (bad) atomicAdd(cnt, bad);
}
__device__ __forceinline__ void chk_rwkv(const Frame& F, const Args& a, int b, int h, int ntok, unsigned* cnt) {
    const bf16_t* F0 = (const bf16_t*)(F.ws + WS_BIG); const bf16_t* OAB = (const bf16_t*)(F.ws + WS_XN);
    LAS float* S = (LAS float*)F.lds;
    LAS float* xs = S + 4096;
    LAS float* op = xs + 448;
    const int tid = F.tid; unsigned bad = 0;

#pragma unroll 1
for (int i = tid; i < 4096; i += NTHREADS) S[i] = 0.f;
    __syncthreads();

#pragma unroll 1
for (int t = 0; t < ntok; ++t) {
        const size_t m = (size_t)b * SEQ + t;
        if (tid < 448) { int mi; if (tid < 192) mi = (tid >> 6) * 512 + h * 64 + (tid & 63); else mi = 1536 + (tid - 192);
            const float f = bf2f(F0[m * F0_LD + F0_RWKV + mi]); const float fp = t > 0 ? bf2f(F0[(m - 1) * F0_LD + F0_RWKV + mi]) : 0.f;
            xs[tid] = f + (fp - f) * a.in[IN_RMU][mi]; }
        __syncthreads();
        if (tid < 64) { const int hc = h * 64 + tid; float lw = a.in[IN_RW0][hc], la = a.in[IN_RA0][hc], gg = 0.f;

#pragma unroll 1
for (int j = 0; j < 64; ++j) { lw += tanhf(xs[192 + j]) * a.in[IN_RW2][j * 512 + hc]; la += xs[256 + j] * a.in[IN_RA2][j * 512 + hc]; }

#pragma unroll 1
for (int j = 0; j < 128; ++j) gg += (1.f / (1.f + expf(-xs[320 + j]))) * a.in[IN_RG2][j * 512 + hc];
            const float sp = (-lw > 20.f) ? -lw : log1pf(expf(-lw)); const float wlog = -sp - 0.5f;
            const float av = 1.f / (1.f + expf(-la));
            op[tid] = expf(-expf(wlog)); op[64 + tid] = xs[64 + tid] * a.in[IN_RKK][hc]; op[256 + tid] = av;
            op[192 + tid] = xs[64 + tid] * (1.f + (av - 1.f) * a.in[IN_RKA][hc]); op[320 + tid] = gg; }
        __syncthreads();
        float ss = 0.f;
#pragma unroll 1
for (int i = 0; i < 64; ++i) ss += op[64 + i] * op[64 + i];
        const float rinv = 1.f / sqrtf(ss + 1e-6f);
        float bon = 0.f;
#pragma unroll 1
for (int i = 0; i < 64; ++i) bon += xs[i] * op[192 + i] * a.in[IN_RRK][h * 64 + i];
        if (tid < 64) { float sa = 0.f;
#pragma unroll 1
for (int k = 0; k < 64; ++k) sa -= S[tid * 64 + k] * op[64 + k] * rinv;
            float y = 0.f; const float vv = xs[128 + tid];

#pragma unroll 1
for (int k = 0; k < 64; ++k) { const float kk = op[64 + k] * rinv; const float sn = S[tid * 64 + k] * op[k] + sa * kk * op[256 + k] + vv * op[192 + k]; S[tid * 64 + k] = sn; y += sn * xs[k]; }
            op[384 + tid] = y; }
        __syncthreads();
        if (tid < 64) { float mean = 0.f;
#pragma unroll 1
for (int i = 0; i < 64; ++i) mean += op[384 + i]; mean /= 64.f; float var = 0.f;
#pragma unroll 1
for (int i = 0; i < 64; ++i) { const float d = op[384 + i] - mean; var += d * d; } var /= 64.f;
            const int hc = h * 64 + tid;
            const float yn = (op[384 + tid] - mean) / sqrtf(var + RWKV_LN_EPS) * a.in[IN_RLNW][hc] + a.in[IN_RLNB][hc];
            const float ref = (yn + bon * xs[128 + tid]) * op[320 + tid]; const float got = bf2f(OAB[m * 1024 + 512 + hc]);
            if (!(fabsf(got - ref) <= 0.04f + 0.04f * fabsf(ref))) bad++; }
        __syncthreads();
    }
    if (bad) atomicAdd(cnt, bad);
}

__device__ __forceinline__ float chk_rope_val(const bf16_t* row, int base, int d, float posf) {
    if (d >= 16) return bf2f(row[base + d]);
    const int i = d & 7; const float ang = posf * ROPE_INVF[i]; const float cs = cosf(ang), sn = sinf(ang);
    const float x1 = bf2f(row[base + i]), x2 = bf2f(row[base + 8 + i]);
    return d < 8 ? x1 * cs - x2 * sn : x2 * cs + x1 * sn;
}
__device__ __forceinline__ void chk_nsa(const Frame& F, const Args& a, int b, int g, int t, unsigned* cnt) {
    const bf16_t* F1 = (const bf16_t*)(F.ws + WS_BIG); const bf16_t* ONSA = (const bf16_t*)(F.ws + WS_XN);
    const int* pos = (const int*)a.in[IN_POS];
    LAS float* kc = (LAS float*)F.lds;
    LAS float* vc = kc + 8192;
    LAS float* hb = vc + 8192;
    LAS float* sb = hb + 512;
    LAS float* red = sb + 4096;
    LAS float* qv = red + 512;
    LAS float* impv = qv + 64;
    LAS float* ocv = impv + 64;
    LAS float* misc = ocv + 512;
    LAS unsigned* selw = (LAS unsigned*)(misc + 8);
    const int tid = F.tid; const size_t mb = (size_t)b * SEQ; const size_t m = mb + t;
    const int nk = t >= 31 ? (t - 31) / 16 + 1 : 0;
    unsigned bad = 0;
#pragma unroll 1
    for (int i = 0; i < nk; ++i) {
        { const int path = tid >> 8, hid = tid & 255; const float* w1 = a.in[path ? IN_NW1V : IN_NW1K]; const float* pe = a.in[path ? IN_NPEV : IN_NPEK]; float acc = 0.f;
#pragma unroll 1
          for (int sl = 0; sl < 32; ++sl) { const bf16_t* row = F1 + (mb + 16 * i + sl) * F1_LD + 1024 + path * 128 + g * 64;
#pragma unroll 1
              for (int d = 0; d < 64; ++d) acc += (bf2f(row[d]) + pe[sl * 64 + d]) * w1[(size_t)(sl * 64 + d) * 256 + hid]; }
          hb[tid] = acc / (1.f + expf(-acc)); }
        __syncthreads();
        if (tid < 128) { const int path = tid >> 6, d = tid & 63; const float* w2 = a.in[path ? IN_NW2V : IN_NW2K]; float acc = 0.f;
#pragma unroll 1
            for (int hid = 0; hid < 256; ++hid) acc += hb[path * 256 + hid] * w2[hid * 64 + d];
            (path ? vc : kc)[i * 64 + d] = acc; }
        __syncthreads();
    }
    if (tid < nk * 8) { const int i = tid >> 3, dd = tid & 7; const float ang = (float)pos[mb + 31 + 16 * i] * ROPE_INVF[dd]; const float cs = cosf(ang), sn = sinf(ang);
        const float x1 = kc[i * 64 + dd], x2 = kc[i * 64 + 8 + dd]; kc[i * 64 + dd] = x1 * cs - x2 * sn; kc[i * 64 + 8 + dd] = x2 * cs + x1 * sn; }
    if (tid < 64) impv[tid] = 0.f;
    __syncthreads();
    const float posq = (float)pos[m];
#pragma unroll 1
    for (int hh = 0; hh < 8; ++hh) { const int H = g * 8 + hh;
        if (tid < 64) qv[tid] = chk_rope_val(F1 + m * F1_LD, H * 64, tid, posq) * 0.125f;
        __syncthreads();
        if (tid < nk) { float s = 0.f;
#pragma unroll 1
            for (int d = 0; d < 64; ++d) s += qv[d] * kc[tid * 64 + d]; sb[tid] = s; }
        __syncthreads();
        if (tid == 0) { float mx = -INFINITY;
#pragma unroll 1
            for (int i = 0; i < nk; ++i) mx = fmaxf(mx, sb[i]); float sum = 0.f;
#pragma unroll 1
            for (int i = 0; i < nk; ++i) sum += expf(sb[i] - mx); misc[0] = mx; misc[1] = fmaxf(sum, 1e-30f); }
        __syncthreads();
        if (tid < nk) sb[tid] = expf(sb[tid] - misc[0]) / misc[1];
        __syncthreads();
        if (tid < 64) { float o = 0.f;
#pragma unroll 1
            for (int i = 0; i < nk; ++i) o += sb[i] * vc[i * 64 + tid]; ocv[hh * 64 + tid] = o;
            float im = 0.f;
#pragma unroll 1
            for (int i = 4 * tid - 1; i <= 4 * tid + 3; ++i) if (i >= 0 && i < nk) im += sb[i] * ((i == 4 * tid - 1 || i == 4 * tid + 3) ? 0.5f : 1.f);
            impv[tid] += im; }
        __syncthreads();
    }
    if (tid == 0) { const int cur = t >> 6; unsigned lo = 0u, hi = 0u;
#pragma unroll 1
        for (int r = 0; r < 16; ++r) { int best = -1; float bv = 0.f;
#pragma unroll 1
            for (int j = 0; j < 64; ++j) { const bool taken = j < 32 ? ((lo >> j) & 1u) : ((hi >> (j - 32)) & 1u); if (taken) continue;
                const bool valid = j <= cur, forced = (j == 0) || (j == cur) || (j == cur - 1);
                const float sc = valid ? (forced ? INFINITY : impv[j]) : -INFINITY;
                if (best < 0 || sc > bv) { best = j; bv = sc; } }
            if (best < 32) lo |= 1u << best; else hi |= 1u << (best - 32); }
        selw[0] = lo; selw[1] = hi; }
    __syncthreads();
#pragma unroll 1
    for (int hh = 0; hh < 8; ++hh) { const int H = g * 8 + hh;
        if (tid < 64) qv[tid] = chk_rope_val(F1 + m * F1_LD, H * 64, tid, posq) * 0.125f;
        __syncthreads();
        float osw[2] = {0.f, 0.f};
#pragma unroll 1
        for (int br = 0; br < 2; ++br) {
            const int kbase = 1024 + (br == 0 ? 2 : 4) * 128 + g * 64, vbase = kbase + 128;
            float lmx = -INFINITY;
#pragma unroll 1
            for (int kp = tid; kp < 4096; kp += NTHREADS) { float s = -INFINITY; const int j = kp >> 6;
                bool vis = kp <= t; if (br == 0) vis = vis && (j < 32 ? ((selw[0] >> j) & 1u) : ((selw[1] >> (j - 32)) & 1u)); else vis = vis && (kp > t - WINDOW);
                if (vis) { s = 0.f; const float pk = (float)pos[mb + kp];
#pragma unroll 1
                    for (int d = 0; d < 64; ++d) s += qv[d] * chk_rope_val(F1 + (mb + kp) * F1_LD, kbase, d, pk); }
                sb[kp] = s; lmx = fmaxf(lmx, s); }
            red[tid] = lmx; __syncthreads();
            if (tid == 0) { float mx = -INFINITY;
#pragma unroll 1
                for (int i = 0; i < NTHREADS; ++i) mx = fmaxf(mx, red[i]); misc[0] = mx; }
            __syncthreads();
            float ls = 0.f;
#pragma unroll 1
            for (int kp = tid; kp < 4096; kp += NTHREADS) { const float e = (sb[kp] == -INFINITY) ? 0.f : expf(sb[kp] - misc[0]); sb[kp] = e; ls += e; }
            red[tid] = ls; __syncthreads();
            if (tid == 0) { float sm = 0.f;
#pragma unroll 1
                for (int i = 0; i < NTHREADS; ++i) sm += red[i]; misc[1] = fmaxf(sm, 1e-30f); }
            __syncthreads();
            if (tid < 64) { float o = 0.f;
#pragma unroll 1
                for (int kp = 0; kp <= t; ++kp) if (sb[kp] != 0.f) o += sb[kp] * bf2f(F1[(mb + kp) * F1_LD + vbase + tid]); osw[br] = o / misc[1]; }
            __syncthreads();
        }
        if (tid < 64) { const float g0 = 1.f / (1.f + expf(-bf2f(F1[m * F1_LD + 1792 + H * 3 + 0]))), g1 = 1.f / (1.f + expf(-bf2f(F1[m * F1_LD + 1792 + H * 3 + 1]))), g2 = 1.f / (1.f + expf(-bf2f(F1[m * F1_LD + 1792 + H * 3 + 2])));
            const float ref = g0 * ocv[hh * 64 + tid] + g1 * osw[0] + g2 * osw[1]; const float got = bf2f(ONSA[m * 1024 + H * 64 + tid]);
            if (!(fabsf(got - ref) <= 0.004f + 0.05f * fabsf(ref))) bad++; }
        __syncthreads();
    }
    if (bad) atomicAdd(cnt, bad);
}
__global__ void __launch_bounds__(NTHREADS, 2) mk_fwd(Args args) {
    extern __shared__ __attribute__((aligned(16))) unsigned char lds[];
    cg::grid_group grid = cg::this_grid();
#ifdef PROBE_TIME_KIND
    const unsigned long long tkern0_ = __builtin_amdgcn_s_memrealtime();
#endif
    Frame F; F.lds = (LAS unsigned char*)lds; F.tid = threadIdx.x; F.lane = F.tid & 63; F.wave = __builtin_amdgcn_readfirstlane(F.tid >> 6);
    F.G = gridDim.x; F.bid = blockIdx.x; F.ws = args.ws; F.ctl = (unsigned*)(args.ws + WS_CTL);
    unsigned char* ws = args.ws;
    if (F.tid < 16) ((LAS unsigned*)(F.lds + XB_LDS_OFF))[F.tid] = 0u;
    __syncthreads();
    XcdBarrier xbar = xcd_barrier_post(F.ctl + CW_BAR, (volatile LAS unsigned*)(F.lds + XB_LDS_OFF));
    const bool big = F.G >= 192;
    p0_prologue(fresh(F), args, big);
    rwkvc_build_images(fresh(F), args);
    if (!big) p0_layer1_weights(fresh(F), args, 0, 0, -1);
    if (args.ph_lo == 0x7fffffff) grid.sync();
    xcd_barrier(xbar);
#if defined(PROBE_TIME_KIND) && PROBE_TIME_KIND == 99
    if (F.bid == 0) { const unsigned long long el_ = __builtin_amdgcn_s_memrealtime() - tkern0_; const unsigned long long tgt_ = __builtin_amdgcn_s_memrealtime() + 4ull * el_; while (__builtin_amdgcn_s_memrealtime() < tgt_) __builtin_amdgcn_s_sleep(20); }
#endif
    enum { K_GEMM = 0, K_GDNPREP, K_RPREP_UNUSED, K_SCAN, K_ROW, K_NSAPREP, K_CMP2, K_CMPATTN, K_ATTN, K_CMP1 };
    constexpr int NPH = 27;
#ifdef PROBE_TIME_KIND
    unsigned long long tacc_ = 0;
#endif
#pragma unroll 1
    for (int ph = 1; ph <= NPH; ++ph) {
#ifdef PROBE_TIME_KIND
        const unsigned long long tst_ = __builtin_amdgcn_s_memrealtime();
#endif
        int kind, sub = 0;
        if (ph == 1) { kind = K_GEMM; sub = 0; }
        else if (ph == 2) kind = K_GDNPREP;
        else if (ph <= 11) { kind = K_SCAN; sub = ph - 4; }
        else if (ph == 12) { kind = K_GEMM; sub = 1; }
        else if (ph == 13) { kind = K_ROW; sub = 0; }
        else if (ph == 14) { kind = K_GEMM; sub = 2; }
        else if (ph == 15) { kind = K_GEMM; sub = 3; }
        else if (ph == 16) { kind = K_ROW; sub = 1; }
        else if (ph == 17) { kind = K_GEMM; sub = 4; }
        else if (ph == 18) kind = K_NSAPREP;
        else if (ph == 19) kind = K_CMP1;
        else if (ph == 20) kind = K_CMP2;
        else if (ph == 21) kind = K_CMPATTN;
        else if (ph == 22) kind = K_ATTN;
        else if (ph == 23) { kind = K_GEMM; sub = 7; }
        else if (ph == 24) { kind = K_ROW; sub = 2; }
        else if (ph == 25) { kind = K_GEMM; sub = 8; }
        else if (ph == 26) { kind = K_GEMM; sub = 9; }
        else { kind = K_ROW; sub = 3; }
        kind = __builtin_amdgcn_readfirstlane(kind); sub = __builtin_amdgcn_readfirstlane(sub);
        if (kind == K_GEMM) {
            const int ng = (sub == 5) ? 2 : 1;
#pragma unroll 1
            for (int gi = 0; gi < ng; ++gi) {
                const int gx = sub + gi;
                const size_t offA = (gx == 3 || gx == 9) ? WS_BIG : gx == 5 ? WS_BIG + B1_ACMPK : gx == 6 ? WS_BIG + B1_ACMPV : WS_XN;
                const size_t offB = gx == 0 ? WS_W_IN0 : gx == 1 ? WS_W_OUT0 : gx == 2 ? WS_W_UP0 : gx == 3 ? WS_W_DN0 : gx == 4 ? WS_W_IN1 : gx == 5 ? WS_W_C1K : gx == 6 ? WS_W_C1V : gx == 7 ? WS_W_OUT1 : gx == 8 ? WS_W_UP1 : WS_W_DN1;
                unsigned char* Op = (gx == 5) ? (unsigned char*)args.out + R2_HCMP : (gx == 6) ? (unsigned char*)args.out + R2_HCMP + (size_t)4096 * 256 * 2 : (gx == 3 || gx == 9) ? ws + WS_XN : ws + WS_BIG;
                const int Mr = (gx == 5 || gx == 6) ? 4096 : MTOK;
                const int Nn = (gx == 0 || gx == 2 || gx == 8) ? 4096 : (gx == 4) ? 2048 : (gx == 5 || gx == 6) ? 256 : 1024;
                const int Kk = (gx == 3 || gx == 9) ? 4096 : (gx == 5 || gx == 6) ? 2048 : 1024;
                const int ldo = (gx == 0) ? F0_LD : (gx == 4) ? F1_LD : Nn;
                const int act = (gx == 2 || gx == 8) ? 2 : (gx == 5 || gx == 6) ? 3 : 0;
                const int cshift = (gx == 6) ? 128 : 0;
                pg8::Gemm g_{(const bf16_t*)(ws + offA), (const bf16_t*)(ws + offB), Mr, Nn, Kk};
                pg8::StaticOrder S_; S_.init(Mr, Nn, F.G, (F.bid + cshift) % F.G);
                pg8::EpiBf16R E_{(bf16_t*)Op, ldo, act};
                pg8::gemm_phase<pg8::EpiBf16R, pg8::StaticOrder, true, true>(F.lds, g_, S_, E_);
            }
        } else if (kind == K_GDNPREP) {
            gdn_prep_phase(fresh(F), args);
        } else if (kind == K_SCAN) {
            const int sg = sub;
            if (sg >= 0) {
                for (int u = F.bid; u < 96; u += F.G) {
                    if (u < 64) rwkvc_chain_unit(fresh(F), args, u, sg); else gdn_scan_unit(fresh(F), args, u - 64, 8 * sg, 8 * sg + 8);
                    __syncthreads(); }
            }
            const bool split = big && sg >= 0;
            const int pb0 = split ? 96 : 0, pnb = split ? F.G - 96 : F.G;
            if (sg < 7 && F.bid >= pb0) rwkvc_prep_phase(fresh(F), args, sg + 1, pb0, pnb);
            if (big && sg >= 0) {
                const int c0 = (448 - F.G) > 96 ? (448 - F.G) : 96;
                if (sg < 6) { if (F.bid >= c0) p0_layer1_weights(fresh(F), args, c0, F.G - c0, sg); }
                else if (sg == 7 && F.bid >= 96) { p0_layer0_rest(fresh(F), args, 96, F.G - 96, 0); p0_layer0_rest(fresh(F), args, 96, F.G - 96, 1); p0_layer0_rest(fresh(F), args, 96, F.G - 96, 2); }
            }
        } else if (kind == K_ROW) {
            if (sub == 0) row_pass<false, true>(fresh(F), (const bf16_t*)(ws + WS_BIG), args.in[IN_X], args.in[IN_NMPOST], ws + WS_R2, args.in[IN_NFPRE], (bf16_t*)(ws + WS_XN));
            else if (sub == 3) row_pass<true, false>(fresh(F), (const bf16_t*)(ws + WS_XN), ws + WS_R2, args.in[IN_NFPOST] + 1024, args.out, nullptr, nullptr);
            else row_pass<true, true>(fresh(F), (const bf16_t*)(ws + (sub == 1 ? WS_XN : WS_BIG)), ws + WS_R2, sub == 1 ? args.in[IN_NFPOST] : args.in[IN_NMPOST] + 1024, ws + WS_R2,
                                      sub == 1 ? args.in[IN_NMPRE] + 1024 : args.in[IN_NFPRE] + 1024, (bf16_t*)(ws + WS_XN));
        } else if (kind == K_NSAPREP) {
            nsa_prep_phase(fresh(F), args);
        } else if (kind == K_CMP1) {
#ifdef PROBE_REP_CMP1
            { const int nrep_ = __builtin_amdgcn_readfirstlane(PROBE_REP_CMP1 + (int)__hip_atomic_load(F.ctl + 6, __ATOMIC_RELAXED, __HIP_MEMORY_SCOPE_AGENT));
#pragma unroll 1
              for (int rep_ = 0; rep_ < nrep_; ++rep_) { nsa_cmp1_phase(fresh(F), args); __syncthreads(); } }
#else
            nsa_cmp1_phase(fresh(F), args);
#endif
        } else if (kind == K_CMP2) {
            nsa_cmp2_phase(fresh(F), args);
        } else if (kind == K_CMPATTN) {
            nsa_cmp_attn_phase(fresh(F), args);
        } else {
            nsa_attn_phase(fresh(F), args);
        }
        if (ph != NPH) xcd_barrier(xbar);
#ifdef PROBE_TIME_KIND
        if ((PROBE_TIME_KIND < 100 && kind == PROBE_TIME_KIND) || (PROBE_TIME_KIND >= 100 && ph == PROBE_TIME_KIND - 100)) tacc_ += __builtin_amdgcn_s_memrealtime() - tst_;
#endif
    }
#ifdef PROBE_ATT_COUNT
    if (F.bid == PROBE_ATT_COUNT) { const unsigned cnt_ = __hip_atomic_load(F.ctl + 8, __ATOMIC_RELAXED, __HIP_MEMORY_SCOPE_AGENT);
        const unsigned long long tgt_ = __builtin_amdgcn_s_memrealtime() + 400ull * cnt_; while (__builtin_amdgcn_s_memrealtime() < tgt_) __builtin_amdgcn_s_sleep(20); }
#endif
#ifdef PROBE_TIME_KIND
    if (F.bid == 0) { const unsigned long long tgt_ = __builtin_amdgcn_s_memrealtime() + 4ull * tacc_; while (__builtin_amdgcn_s_memrealtime() < tgt_) __builtin_amdgcn_s_sleep(20); }
#endif
}
extern "C" void kernel_launch(void* const* d_in, const int* in_sizes, int n_in, void* d_out, int out_size, void* d_ws, size_t ws_size, hipStream_t stream) {
    static int grid = 0;
    if (grid == 0) {
        if (n_in != 33 || out_size != MTOK * D_MODEL || ws_size < WS_END) { fprintf(stderr, "kernel_launch: unexpected problem (n_in %d out %d ws %zu)\n", n_in, out_size, ws_size); grid = -1; return; }
        int dev = 0, cus = 0, per_cu = 0;
        (void)hipGetDevice(&dev); (void)hipDeviceGetAttribute(&cus, hipDeviceAttributeMultiprocessorCount, dev);
        (void)hipFuncSetAttribute((const void*)mk_fwd, hipFuncAttributeMaxDynamicSharedMemorySize, LDS_BYTES);
        (void)hipOccupancyMaxActiveBlocksPerMultiprocessor(&per_cu, (const void*)mk_fwd, NTHREADS, LDS_BYTES);
        if (per_cu < 1) { fprintf(stderr, "kernel_launch: occupancy query says %d blocks/CU\n", per_cu); grid = -1; return; }
        grid = cus;
        fprintf(stderr, "kernel_launch: grid %d (cus %d, per_cu %d) ws %zu\n", grid, cus, per_cu, ws_size);
    }
    if (grid < 0) return;
    (void)hipMemsetAsync((char*)d_ws + WS_CTL, 0, 1 * MiB, stream);
    Args a{};
    for (int i = 0; i < 33; ++i) a.in[i] = (const float*)d_in[i];
    a.out = (float*)d_out; a.ws = (unsigned char*)d_ws; a.ph_lo = 0; a.ph_hi = 100;
    void* kargs[] = {&a};
    hipError_t e = hipLaunchCooperativeKernel((void*)mk_fwd, dim3(grid), dim3(NTHREADS), kargs, LDS_BYTES, stream);
    if (e != hipSuccess) fprintf(stderr, "cooperative launch failed: %s (grid %d)\n", hipGetErrorString(e), grid);
}
```
